# Optimizing an MI355X kernel written in HIP

```python
import math
import jax, jax.numpy as jnp
from jax import lax
import numpy as np

D_MODEL = 1024
BATCH = 2
SEQ = 8192
DEPTH = 2

GRID_W = 64
CTX_LEN = 256
EPS = 1e-6

LRU_HEADS = 8
LRU_WIDTH = D_MODEL // 2
LRU_HEAD_DIM = LRU_WIDTH // LRU_HEADS
CONV_W = 4
CONV_LEFT = 2
LRU_C = 8.0
CMLP_GROUPS = 8
CMLP_WIDTH = D_MODEL // 2
CMLP_GROUP_DIM = CMLP_WIDTH // CMLP_GROUPS
CHUNK = 128
AB_IN_WIDTH = 2 * LRU_WIDTH + 2 * CMLP_WIDTH
AB_MIX_WIDTH = LRU_WIDTH + CMLP_WIDTH

DIFF_HEADS = 8
DIFF_QK_DIM = D_MODEL // DIFF_HEADS // 2
DIFF_V_DIM = 2 * DIFF_QK_DIM
ROPE_BASE = 10000.0
Q_BLOCK = 128

N_EXPERTS = 16
EXPERT_FF = 2048
CAPACITY_FACTOR = 2

N_EVEN = (DEPTH + 1) // 2
N_ODD = DEPTH // 2

kernel_name = 'hybrid_rglru_chunkmlp_diffattn_ecmoe_prefix_dit'


def rmsnorm(x, g):
    xf = x.astype(jnp.float32)
    y = xf * lax.rsqrt(jnp.mean(xf * xf, axis=-1, keepdims=True) + EPS)
    return (y * g.astype(jnp.float32)).astype(x.dtype)


def centred_dwconv(x, w, b):
    L = x.shape[1]
    xp = jnp.pad(x, ((0, 0), (CONV_LEFT, CONV_W - 1 - CONV_LEFT), (0, 0)))
    y = b
    for j in range(CONV_W):
        y = y + xp[:, j:j + L] * w[j]
    return y


def rglru_coeffs(x, w_a, b_a, w_x, b_x, lam):
    B_, L, W = x.shape
    xh = x.reshape(B_, L, LRU_HEADS, LRU_HEAD_DIM)
    r = jax.nn.sigmoid((jnp.einsum('blhi,hij->blhj', xh, w_a).reshape(B_, L, W) + b_a).astype(jnp.float32))
    i = jax.nn.sigmoid((jnp.einsum('blhi,hij->blhj', xh, w_x).reshape(B_, L, W) + b_x).astype(jnp.float32))
    log_a = -LRU_C * r * jax.nn.softplus(-lam.astype(jnp.float32))
    a = jnp.exp(log_a)
    u = jnp.sqrt(-jnp.expm1(2.0 * log_a)) * i * x.astype(jnp.float32)
    return a, u


def linear_scan(a, u, h0):
    u = u.at[:, 0].add(a[:, 0] * h0)

    def combine(left, right):
        a_l, u_l = left
        a_r, u_r = right
        return a_l * a_r, a_r * u_l + u_r

    _, h = lax.associative_scan(combine, (a, u), axis=1)
    return h


def rglru_direction(x_ctx, x_lat, w_a, b_a, w_x, b_x, lam, reverse):
    order = (lambda t: jnp.flip(t, axis=1)) if reverse else (lambda t: t)
    a_c, u_c = rglru_coeffs(order(x_ctx), w_a, b_a, w_x, b_x, lam)
    h_c = linear_scan(a_c, u_c, jnp.zeros_like(u_c[:, 0]))
    a_l, u_l = rglru_coeffs(order(x_lat), w_a, b_a, w_x, b_x, lam)
    h_l = linear_scan(a_l, u_l, h_c[:, -1])
    return order(h_c), order(h_l)


def chunk_spatial_gating(u, v, v_g, w_s, b_s):
    B_, L, _ = u.shape
    u = jax.nn.gelu(u)
    v = rmsnorm(jax.nn.gelu(v).reshape(B_, L, CMLP_GROUPS, CMLP_GROUP_DIM),
                v_g.reshape(CMLP_GROUPS, CMLP_GROUP_DIM))
    v = v.reshape(B_, L // CHUNK, CHUNK, CMLP_GROUPS, CMLP_GROUP_DIM)
    mixed = jnp.einsum('gpq,bnqgc->bnpgc', w_s, v) + b_s.T[:, :, None]
    return u * mixed.reshape(B_, L, CMLP_WIDTH)


def mixer_rglru_chunkmlp(h_ctx, h_lat, w_in, conv_w, conv_b, w_a, b_a, w_x, b_x, lam,
                         v_g, w_s, b_s, w_out, need_ctx):
    def project(h):
        z = h @ w_in
        return jnp.split(z, [LRU_WIDTH, 2 * LRU_WIDTH, 2 * LRU_WIDTH + CMLP_WIDTH], axis=-1)

    gate_c, rec_c, u_c, v_c = project(h_ctx)
    gate_l, rec_l, u_l, v_l = project(h_lat)
    rec_c = centred_dwconv(rec_c, conv_w, conv_b)
    rec_l = centred_dwconv(rec_l, conv_w, conv_b)
    fwd_c, fwd_l = rglru_direction(rec_c, rec_l, w_a[0], b_a[0], w_x[0], b_x[0], lam[0], False)
    bwd_c, bwd_l = rglru_direction(rec_c, rec_l, w_a[1], b_a[1], w_x[1], b_x[1], lam[1], True)

    def merge(gate, rnn, u, v):
        y_rnn = jax.nn.gelu(gate) * rnn.astype(gate.dtype)
        y_cm = chunk_spatial_gating(u, v, v_g, w_s, b_s)
        return jnp.concatenate([y_rnn, y_cm], axis=-1) @ w_out

    y_l = merge(gate_l, fwd_l + bwd_l, u_l, v_l)
    if not need_ctx:
        return None, y_l
    y_c = merge(gate_c, fwd_c + bwd_c, u_c, v_c)
    return y_c, y_l


def rope_2d(x, row, col):
    half = DIFF_QK_DIM // 2
    inv = ROPE_BASE ** (-jnp.arange(0, half, 2, dtype=jnp.float32) / half)
    ang = jnp.concatenate([row[:, None] * inv, col[:, None] * inv], axis=-1)
    cos = jnp.cos(ang)[None, :, None, None, :]
    sin = jnp.sin(ang)[None, :, None, None, :]
    x1, x2 = jnp.split(x.astype(jnp.float32), 2, axis=-1)
    return jnp.concatenate([x1 * cos - x2 * sin, x1 * sin + x2 * cos], axis=-1).astype(x.dtype)


def diff_attend(q, k, v, lam):
    s = jnp.einsum('bqhmd,bkhmd->bhmqk', q * (DIFF_QK_DIM ** -0.5), k).astype(jnp.float32)
    p = jax.nn.softmax(s, axis=-1)
    w = p[:, :, 0] - lam * p[:, :, 1]
    return jnp.einsum('bhqk,bkhd->bqhd', w.astype(v.dtype), v)


def mixer_diff_attention(h_ctx, h_lat, row, col, w_qkv, lam_q1, lam_k1, lam_q2, lam_k2,
                         subln_g, w_out, lam_init, need_ctx):
    B_, L, _ = h_lat.shape

    def project(h):
        Lh = h.shape[1]
        q, k, v = jnp.split(h @ w_qkv, 3, axis=-1)
        return (q.reshape(B_, Lh, DIFF_HEADS, 2, DIFF_QK_DIM),
                k.reshape(B_, Lh, DIFF_HEADS, 2, DIFF_QK_DIM),
                v.reshape(B_, Lh, DIFF_HEADS, DIFF_V_DIM))

    q_c, k_c, v_c = project(h_ctx)
    q_l, k_l, v_l = project(h_lat)
    q_l = rope_2d(q_l, row, col)
    k_l = rope_2d(k_l, row, col)
    lam = (jnp.exp(jnp.sum(lam_q1.astype(jnp.float32) * lam_k1.astype(jnp.float32)))
           - jnp.exp(jnp.sum(lam_q2.astype(jnp.float32) * lam_k2.astype(jnp.float32))) + lam_init)

    k_all = jnp.concatenate([k_c, k_l], axis=1)
    v_all = jnp.concatenate([v_c, v_l], axis=1)
    nb = L // Q_BLOCK
    q_blocks = q_l.reshape(B_, nb, Q_BLOCK, DIFF_HEADS, 2, DIFF_QK_DIM).swapaxes(0, 1)
    o = lax.map(lambda qb: diff_attend(qb, k_all, v_all, lam), q_blocks)
    o_l = o.swapaxes(0, 1).reshape(B_, L, DIFF_HEADS, DIFF_V_DIM)

    def finish(o_h):
        Lo = o_h.shape[1]
        o_h = rmsnorm(o_h, subln_g) * (1.0 - lam_init)
        return o_h.reshape(B_, Lo, DIFF_HEADS * DIFF_V_DIM) @ w_out

    y_l = finish(o_l)
    if not need_ctx:
        return None, y_l
    y_c = finish(diff_attend(q_c, k_c, v_c, lam))
    return y_c, y_l


def expert_choice_ffn(h, w_router, w1, w3, w2):
    B_, L, D = h.shape
    cap = CAPACITY_FACTOR * L // N_EXPERTS
    aff = jax.nn.softmax((h @ w_router).astype(jnp.float32), axis=-1)
    g, idx = lax.top_k(aff.transpose(0, 2, 1), cap)
    xs = jax.vmap(lambda hb, ib: hb[ib])(h, idx)
    hid = jax.nn.silu(jnp.einsum('becd,edf->becf', xs, w1)) * jnp.einsum('becd,edf->becf', xs, w3)
    y = jnp.einsum('becf,efd->becd', hid, w2) * g[..., None].astype(hid.dtype)
    return jax.vmap(lambda ib, yb: jnp.zeros((L, D), yb.dtype).at[ib.reshape(-1)].add(yb.reshape(-1, D)))(idx, y)


def setup_inputs(seed: int = 0) -> dict:
    key = jax.random.key(seed)
    ks = iter(jax.random.split(key, 40))

    def nrm(shape, scale):
        return jax.random.normal(next(ks), shape, jnp.float32) * scale

    D = D_MODEL
    a8 = jax.random.uniform(next(ks), (N_EVEN, 2, LRU_WIDTH), jnp.float32, minval=0.9, maxval=0.999)
    a = a8 ** (1.0 / LRU_C)
    lru_lam = jnp.log(a) - jnp.log1p(-a)
    return {
        'x': nrm((BATCH, SEQ, D), 1.0),
        'c': nrm((BATCH, D), 1.0),
        'ctx': nrm((BATCH, CTX_LEN, D), 1.0),
        'c_ctx': nrm((D,), 1.0),
        'ada_w': nrm((DEPTH, D, 6 * D), D ** -0.5),
        'ada_b': nrm((DEPTH, 6 * D), 0.02),
        'norm_mix_g': 1.0 + nrm((DEPTH, D), 0.02),
        'norm_ffn_g': 1.0 + nrm((DEPTH, D), 0.02),
        'ab_w_in': nrm((N_EVEN, D, AB_IN_WIDTH), D ** -0.5),
        'ab_conv_w': nrm((N_EVEN, CONV_W, LRU_WIDTH), CONV_W ** -0.5),
        'ab_conv_b': nrm((N_EVEN, LRU_WIDTH), 0.02),
        'lru_w_a': nrm((N_EVEN, 2, LRU_HEADS, LRU_HEAD_DIM, LRU_HEAD_DIM), LRU_HEAD_DIM ** -0.5),
        'lru_b_a': nrm((N_EVEN, 2, LRU_WIDTH), 0.1),
        'lru_w_x': nrm((N_EVEN, 2, LRU_HEADS, LRU_HEAD_DIM, LRU_HEAD_DIM), LRU_HEAD_DIM ** -0.5),
        'lru_b_x': nrm((N_EVEN, 2, LRU_WIDTH), 0.1),
        'lru_lam': lru_lam,
        'cm_v_g': 1.0 + nrm((N_EVEN, CMLP_WIDTH), 0.02),
        'cm_w_s': nrm((N_EVEN, CMLP_GROUPS, CHUNK, CHUNK), CHUNK ** -0.5),
        'cm_b_s': 1.0 + nrm((N_EVEN, CMLP_GROUPS, CHUNK), 0.02),
        'ab_w_out': nrm((N_EVEN, AB_MIX_WIDTH, D), AB_MIX_WIDTH ** -0.5),
        'da_w_qkv': nrm((N_ODD, D, 3 * D), D ** -0.5),
        'da_lam_q1': nrm((N_ODD, DIFF_QK_DIM), 0.1),
        'da_lam_k1': nrm((N_ODD, DIFF_QK_DIM), 0.1),
        'da_lam_q2': nrm((N_ODD, DIFF_QK_DIM), 0.1),
        'da_lam_k2': nrm((N_ODD, DIFF_QK_DIM), 0.1),
        'da_subln_g': 1.0 + nrm((N_ODD, DIFF_V_DIM), 0.02),
        'da_w_out': nrm((N_ODD, DIFF_HEADS * DIFF_V_DIM, D), (DIFF_HEADS * DIFF_V_DIM) ** -0.5),
        'moe_w_router': nrm((DEPTH, D, N_EXPERTS), D ** -0.5),
        'moe_w1': nrm((DEPTH, N_EXPERTS, D, EXPERT_FF), D ** -0.5),
        'moe_w3': nrm((DEPTH, N_EXPERTS, D, EXPERT_FF), D ** -0.5),
        'moe_w2': nrm((DEPTH, N_EXPERTS, EXPERT_FF, D), EXPERT_FF ** -0.5),
        'final_g': 1.0 + nrm((D,), 0.02),
    }


def reference(x, c, ctx, c_ctx, ada_w, ada_b, norm_mix_g, norm_ffn_g,
              ab_w_in, ab_conv_w, ab_conv_b, lru_w_a, lru_b_a, lru_w_x, lru_b_x, lru_lam,
              cm_v_g, cm_w_s, cm_b_s, ab_w_out,
              da_w_qkv, da_lam_q1, da_lam_k1, da_lam_q2, da_lam_k2, da_subln_g, da_w_out,
              moe_w_router, moe_w1, moe_w3, moe_w2, final_g):
    S = x.shape[1]
    rows = S // GRID_W
    row = jnp.repeat(jnp.arange(rows), GRID_W).astype(jnp.float32)
    col = jnp.tile(jnp.arange(GRID_W), rows).astype(jnp.float32)
    silu_c = jax.nn.silu(c)
    silu_cc = jax.nn.silu(c_ctx)
    x_lat, x_ctx = x, ctx
    for l in range(DEPTH):
        last = l == DEPTH - 1
        mod_l = (silu_c @ ada_w[l] + ada_b[l])[:, None, :]
        mod_c = (silu_cc @ ada_w[l] + ada_b[l])[None, None, :]
        sh1_l, sc1_l, g1_l, sh2_l, sc2_l, g2_l = jnp.split(mod_l, 6, axis=-1)
        sh1_c, sc1_c, g1_c, sh2_c, sc2_c, g2_c = jnp.split(mod_c, 6, axis=-1)

        h_l = rmsnorm(x_lat, norm_mix_g[l]) * (1.0 + sc1_l) + sh1_l
        h_c = rmsnorm(x_ctx, norm_mix_g[l]) * (1.0 + sc1_c) + sh1_c
        j = l // 2
        if l % 2 == 0:
            y_c, y_l = mixer_rglru_chunkmlp(
                h_c, h_l, ab_w_in[j], ab_conv_w[j], ab_conv_b[j], lru_w_a[j], lru_b_a[j],
                lru_w_x[j], lru_b_x[j], lru_lam[j], cm_v_g[j], cm_w_s[j], cm_b_s[j], ab_w_out[j],
                not last)
        else:
            lam_init = 0.8 - 0.6 * math.exp(-0.3 * l)
            y_c, y_l = mixer_diff_attention(
                h_c, h_l, row, col, da_w_qkv[j], da_lam_q1[j], da_lam_k1[j], da_lam_q2[j],
                da_lam_k2[j], da_subln_g[j], da_w_out[j], lam_init, not last)

        x_lat = x_lat + (g1_l * y_l).astype(x_lat.dtype)
        h_l = rmsnorm(x_lat, norm_ffn_g[l]) * (1.0 + sc2_l) + sh2_l
        x_lat = x_lat + (g2_l * expert_choice_ffn(h_l, moe_w_router[l], moe_w1[l], moe_w3[l], moe_w2[l])).astype(x_lat.dtype)
        if not last:
            x_ctx = x_ctx + (g1_c * y_c).astype(x_ctx.dtype)
            h_c = rmsnorm(x_ctx, norm_ffn_g[l]) * (1.0 + sc2_c) + sh2_c
            x_ctx = x_ctx + (g2_c * expert_choice_ffn(h_c, moe_w_router[l], moe_w1[l], moe_w3[l], moe_w2[l])).astype(x_ctx.dtype)
    return rmsnorm(x_lat, final_g)
```

```cpp
#include <hip/hip_runtime.h>
#include <hip/hip_cooperative_groups.h>
#include <hip/hip_bf16.h>
#include <cstdio>
#include <cstdint>
#include <cmath>
namespace cg = cooperative_groups;

#ifndef MK_N_LAUNCHES
#define MK_N_LAUNCHES 0
#endif

constexpr int DM = 1024, NB = 2, SEQ = 8192, CTXL = 256, LR = SEQ + CTXL, NR = NB * LR, NLAT = NB * SEQ;
constexpr int NE = 16, FF = 2048, EROWS = 2304;
constexpr float EPS = 1e-6f;
constexpr int NTILE64 = NR / 64;
constexpr int NPH = 20;

constexpr size_t MiB = 1u << 20;
constexpr size_t WS_CTL = 0, WS_MOD = 1 * MiB, WS_ROPE = 2 * MiB, WS_LRUW = 4 * MiB, WS_CMWS = 4 * MiB + 512 * 1024, WS_SUM = 5 * MiB, WS_AFF = 8 * MiB, WS_INV = 10 * MiB,
                 WS_GATE = 12 * MiB, WS_WIN = 14 * MiB, WS_WOUT0 = 18 * MiB, WS_WQKV = 20 * MiB, WS_WOUT1 = 26 * MiB, WS_W13 = 32 * MiB, WS_W2 = 288 * MiB, WS_H = 416 * MiB,
                 WS_X = 450 * MiB, WS_XS = 516 * MiB, WS_ACT = 588 * MiB, WS_END = 758 * MiB;
static_assert(true, "");
constexpr size_t ACT_Z = 0, ACT_YCAT = 66 * MiB, ACT_HID = 0, ACT_Q = 0, ACT_K = 33 * MiB, ACT_V = 66 * MiB, ACT_O1 = 99 * MiB, ACT_O2 = 131 * MiB, ACT_A = 0;

#define GAS __attribute__((address_space(1)))
#define LAS __attribute__((address_space(3)))
typedef unsigned short bf16_t;
typedef short bf16x8 __attribute__((ext_vector_type(8)));
typedef float f32x4 __attribute__((ext_vector_type(4)));
typedef float f32x2 __attribute__((ext_vector_type(2)));
typedef unsigned u32x4 __attribute__((ext_vector_type(4)));
typedef unsigned u32x2 __attribute__((ext_vector_type(2)));

__device__ __forceinline__ unsigned f2bf(float f) { unsigned u = __builtin_bit_cast(unsigned, f); return (u + 0x7fffu + ((u >> 16) & 1u)) >> 16; }
__device__ __forceinline__ unsigned pk2(float lo, float hi) { return f2bf(lo) | (f2bf(hi) << 16); }
__device__ __forceinline__ float bf2f(unsigned short b) { return __builtin_bit_cast(float, (unsigned)b << 16); }
__device__ __forceinline__ float bflo(unsigned w) { return __builtin_bit_cast(float, w << 16); }
__device__ __forceinline__ float bfhi(unsigned w) { return __builtin_bit_cast(float, w & 0xffff0000u); }
__device__ __forceinline__ float gelu_tanh(float x) {
    const float u2 = 2.0f * 0.7978845608028654f * (x + 0.044715f * x * x * x);
    const float e = __builtin_amdgcn_exp2f(u2 * 1.4426950408889634f);
    return x - x * __builtin_amdgcn_rcpf(1.0f + e);
}
__device__ __forceinline__ float silu_f(float a) { return a * __builtin_amdgcn_rcpf(1.0f + __builtin_amdgcn_exp2f(-a * 1.4426950408889634f)); }
__device__ __forceinline__ float sigmoid_f(float a) { return 1.0f / (1.0f + __expf(-a)); }

namespace pg8 {
#define PG8_LAS __attribute__((address_space(3)))
constexpr int BM = 256, BK = 64, HALF = 128, HTB = HALF * BK * 2, STAGE_BYTES = 8 * HTB, NXCD = 8, WGM = 8;
__host__ __device__ __forceinline__ int lds_byte(int r, int c) { const int st = (r >> 4) * 2 + (c >> 5), rr = r & 15, cc = c & 31, ob = rr * 64 + cc * 2; return st * 1024 + (ob ^ (((ob >> 9) & 1) << 5)); }
__host__ __device__ __forceinline__ void stage_rc(int b, int& R, int& C) { const int st = b / 1024, sb = b % 1024, swz = sb ^ (((sb >> 9) & 1) << 5); R = (st >> 1) * 16 + swz / 64; C = (st & 1) * 32 + (swz % 64) / 2; }
__host__ __device__ __forceinline__ int perm32(int rho) { const int n = rho >> 4, i = rho & 15; return 8 * (i >> 2) + 4 * n + (i & 3); }

struct Unit { int pm, pn, grp; };
struct Gemm { const bf16_t* A; const bf16_t* Bt; int K; size_t ga, gb; };

struct GOrder {
    int nM, nN, upg, nwg, G, c;
    __device__ void init(int nM_, int nN_, int ngrp, int G_, int c_) { nM = nM_; nN = nN_; upg = nM * nN; nwg = upg * ngrp; G = G_; c = c_; }
    __device__ bool next(int i, Unit& u) const {
        const long L = (long)i * G + c; if (L >= nwg) return false;
        int wgid = (int)L; { const int q = nwg / NXCD, r = nwg % NXCD, xcd = wgid % NXCD, off = wgid / NXCD; wgid = (xcd < r ? xcd * (q + 1) : r * (q + 1) + (xcd - r) * q) + off; }
        u.grp = wgid / upg; const int w = wgid % upg;
        const int nig = WGM * nN, gid = w / nig, fm = gid * WGM, gsz = (nM - fm) < WGM ? (nM - fm) : WGM;
        u.pm = fm + ((w % nig) % gsz); u.pn = (w % nig) / gsz; return true;
    }
};

__device__ __forceinline__ unsigned cvt_pk_bf16(float lo, float hi) { unsigned r; asm volatile("v_cvt_pk_bf16_f32 %0, %1, %2" : "=v"(r) : "v"(lo), "v"(hi)); return r; }

template <class Epi, class Sched>
__device__ __forceinline__ void gemm_phase(PG8_LAS unsigned char* lds, const Gemm g, const Sched& S, const Epi& E) {
    const int tid = threadIdx.x, wid = __builtin_amdgcn_readfirstlane(tid >> 6), lane = tid & 63, wr = wid >> 2, wc = wid & 3, fr = lane & 15, fq = lane >> 4;
    const int K = g.K, nt = K / BK;
    unsigned voffA[2], voffB[2];
#pragma unroll
    for (int i = 0; i < 2; ++i) { int R, C; stage_rc(tid * 16 + i * 8192, R, C); const int Rb = (R & ~31) + perm32(R & 31);
        voffA[i] = (unsigned)(R * K + C) * 2u; voffB[i] = (unsigned)(Rb * K + C) * 2u; }
    const size_t kstep = (size_t)(BK * 2);
    const size_t hstep = (size_t)HALF * K * 2;
    const size_t tstep = 2 * hstep;
    const unsigned ldsw = (unsigned)wid * 1024u;
    const int aoff = lds_byte(wr * 64 + fr, fq * 8), boff = lds_byte(wc * 32 + fr, fq * 8);
#define PG8_SA(b, h) (((b) * 2 + (h)) * HTB)
#define PG8_SB(b, h) ((4 + (b) * 2 + (h)) * HTB)
#define PG8_STAGE(bufoff, gbase, voff) do { _Pragma("unroll") for (int _i = 0; _i < 2; ++_i) \
        __builtin_amdgcn_global_load_lds((const unsigned*)((const char*)(gbase) + (voff)[_i]), (PG8_LAS unsigned*)(lds + (bufoff) + ldsw + _i * 8192), 16, 0, 0); } while (0)
#define PG8_LDA(dst, b, h) do { _Pragma("unroll") for (int m = 0; m < 4; ++m) _Pragma("unroll") for (int k = 0; k < 2; ++k) dst[m][k] = *(const PG8_LAS bf16x8*)(lds + PG8_SA(b, h) + aoff + m * 2048 + k * 1024); } while (0)
#define PG8_LDB(dst, b, h) do { _Pragma("unroll") for (int n = 0; n < 2; ++n) _Pragma("unroll") for (int k = 0; k < 2; ++k) dst[n][k] = *(const PG8_LAS bf16x8*)(lds + PG8_SB(b, h) + boff + n * 2048 + k * 1024); } while (0)
#define PG8_MMA(ai, bj, At, Bt) do { __builtin_amdgcn_s_setprio(1); _Pragma("unroll") for (int m = 0; m < 4; ++m) _Pragma("unroll") for (int n = 0; n < 2; ++n) _Pragma("unroll") for (int k = 0; k < 2; ++k) \
        acc[ai][bj][m][n] = __builtin_amdgcn_mfma_f32_16x16x32_bf16(Bt[n][k], At[m][k], acc[ai][bj][m][n], 0, 0, 0); __builtin_amdgcn_s_setprio(0); } while (0)
#define PG8_WAIT_V(n) asm volatile("s_waitcnt vmcnt(" #n ")" ::: "memory")
#define PG8_WAIT_L(n) asm volatile("s_waitcnt lgkmcnt(" #n ")" ::: "memory")
#define PG8_BAR __builtin_amdgcn_s_barrier()
#define PG8_SCHED __builtin_amdgcn_sched_barrier(0)
    Unit cur, nxt; int ui = 0;
    if (!S.next(0, cur)) return;
    f32x4 acc[2][2][4][2];
#pragma unroll
    for (int a = 0; a < 2; ++a)
#pragma unroll
        for (int b = 0; b < 2; ++b)
#pragma unroll
            for (int m = 0; m < 4; ++m)
#pragma unroll
                for (int n = 0; n < 2; ++n) acc[a][b][m][n] = (f32x4){0.f, 0.f, 0.f, 0.f};
    bf16x8 At[4][2], B0[2][2], B1[2][2];
    const char* cA = (const char*)g.A + (size_t)cur.grp * g.ga + (size_t)cur.pm * tstep; const char* cB = (const char*)g.Bt + (size_t)cur.grp * g.gb + (size_t)cur.pn * tstep;
    PG8_STAGE(PG8_SB(0, 0), cB, voffB); PG8_STAGE(PG8_SB(0, 1), cB + hstep, voffB); PG8_STAGE(PG8_SA(0, 0), cA, voffA); PG8_STAGE(PG8_SA(0, 1), cA + hstep, voffA);
    if (wr == 1) PG8_BAR;
    PG8_WAIT_V(2); PG8_BAR;
    PG8_STAGE(PG8_SB(1, 0), cB + kstep, voffB); PG8_STAGE(PG8_SA(1, 0), cA + kstep, voffA); PG8_STAGE(PG8_SB(1, 1), cB + hstep + kstep, voffB);
    PG8_WAIT_V(6); PG8_BAR;
    for (;;) {
        const bool has_next = S.next(ui + 1, nxt);
        const char* nA = has_next ? (const char*)g.A + (size_t)nxt.grp * g.ga + (size_t)nxt.pm * tstep : cA; const char* nB = has_next ? (const char*)g.Bt + (size_t)nxt.grp * g.gb + (size_t)nxt.pn * tstep : cB;
        for (int t = 0; t < nt; t += 2) {
            const bool last = (t == nt - 2);
            const char* a1 = cA + (size_t)(t + 1) * kstep;
            const char* a2 = last ? nA : cA + (size_t)(t + 2) * kstep; const char* b2 = last ? nB : cB + (size_t)(t + 2) * kstep;
            const char* a3 = a2 + kstep; const char* b3 = b2 + kstep;
            PG8_LDB(B0, 0, 0); PG8_LDB(B1, 0, 1); PG8_SCHED; PG8_LDA(At, 0, 0); PG8_STAGE(PG8_SA(1, 1), a1 + hstep, voffA);
            PG8_WAIT_V(8); PG8_WAIT_L(0); PG8_BAR; PG8_MMA(0, 0, At, B0); PG8_MMA(0, 1, At, B1); PG8_BAR; PG8_SCHED;
            PG8_LDA(At, 0, 1); PG8_STAGE(PG8_SB(0, 0), b2, voffB); PG8_STAGE(PG8_SB(0, 1), b2 + hstep, voffB); PG8_STAGE(PG8_SA(0, 0), a2, voffA);
            PG8_WAIT_V(8); PG8_WAIT_L(0); PG8_BAR; PG8_MMA(1, 0, At, B0); PG8_MMA(1, 1, At, B1); PG8_BAR; PG8_SCHED;
            PG8_LDB(B0, 1, 0); PG8_LDB(B1, 1, 1); PG8_SCHED; PG8_LDA(At, 1, 0); PG8_STAGE(PG8_SA(0, 1), a2 + hstep, voffA);
            PG8_WAIT_V(8); PG8_WAIT_L(0); PG8_BAR; PG8_MMA(0, 0, At, B0); PG8_MMA(0, 1, At, B1); PG8_BAR; PG8_SCHED;
            PG8_LDA(At, 1, 1); PG8_STAGE(PG8_SB(1, 0), b3, voffB); PG8_STAGE(PG8_SB(1, 1), b3 + hstep, voffB); PG8_STAGE(PG8_SA(1, 0), a3, voffA);
            PG8_WAIT_V(8); PG8_WAIT_L(0); PG8_BAR; PG8_MMA(1, 0, At, B0); PG8_MMA(1, 1, At, B1); PG8_BAR; PG8_SCHED;
        }
        if (wr == 0) PG8_BAR;
        E(acc, cur, wr, wc, fr, fq);
        if (!has_next) break;
#pragma unroll
        for (int a = 0; a < 2; ++a)
#pragma unroll
            for (int b = 0; b < 2; ++b)
#pragma unroll
                for (int m = 0; m < 4; ++m)
#pragma unroll
                    for (int n = 0; n < 2; ++n) acc[a][b][m][n] = (f32x4){0.f, 0.f, 0.f, 0.f};
        cur = nxt; cA = nA; cB = nB; ++ui;
        if (wr == 1) PG8_BAR;
    }
    PG8_WAIT_V(0);
    PG8_BAR;
#undef PG8_SA
#undef PG8_SB
#undef PG8_STAGE
#undef PG8_LDA
#undef PG8_LDB
#undef PG8_MMA
#undef PG8_WAIT_V
#undef PG8_WAIT_L
#undef PG8_BAR
#undef PG8_SCHED
}

struct EpiWin {
    bf16_t* Z;
    __device__ __forceinline__ void operator()(const f32x4 (&acc)[2][2][4][2], const Unit& u, int wr, int wc, int fr, int fq) const {
        const int row0 = u.pm * BM + wr * 64 + fr, col0 = u.pn * BM + wc * 32 + 8 * fq; const bool act = (u.pn < 2) || (u.pn >= 4);
#pragma unroll
        for (int ai = 0; ai < 2; ++ai)
#pragma unroll
            for (int m = 0; m < 4; ++m) { bf16_t* rowp = Z + (size_t)(row0 + ai * HALF + m * 16) * 2048 + col0;
#pragma unroll
                for (int bj = 0; bj < 2; ++bj) { f32x4 v0 = acc[ai][bj][m][0], v1 = acc[ai][bj][m][1];
                    if (act) {
#pragma unroll
                        for (int i = 0; i < 4; ++i) { v0[i] = gelu_tanh(v0[i]); v1[i] = gelu_tanh(v1[i]); } }
                    u32x4 w; w.x = cvt_pk_bf16(v0[0], v0[1]); w.y = cvt_pk_bf16(v0[2], v0[3]); w.z = cvt_pk_bf16(v1[0], v1[1]); w.w = cvt_pk_bf16(v1[2], v1[3]);
                    *(u32x4*)(rowp + bj * HALF) = w; } }
    }
};
struct EpiRes {
    float* X; const float* xin; const float* cin; const float* g1; int mode;
    __device__ __forceinline__ void operator()(const f32x4 (&acc)[2][2][4][2], const Unit& u, int wr, int wc, int fr, int fq) const {
        const float* basep; float* outp; int rt;
        if (mode == 0) { const int b = u.pm / 33, jt = u.pm % 33; outp = X + (size_t)u.pm * BM * DM;
            if (jt == 0) { basep = cin + (size_t)b * CTXL * DM; rt = 2; } else { basep = xin + ((size_t)b * SEQ + (size_t)(jt - 1) * BM) * DM; rt = b; } }
        else { const int b = u.pm / 32, t0 = (u.pm % 32) * BM; outp = X + ((size_t)b * LR + CTXL + t0) * DM; basep = outp; rt = b; }
        const int rr0 = wr * 64 + fr, col0 = u.pn * BM + wc * 32 + 8 * fq;
        f32x4 gv[2][2];
#pragma unroll
        for (int bj = 0; bj < 2; ++bj)
#pragma unroll
            for (int n = 0; n < 2; ++n) gv[bj][n] = *(const f32x4*)(g1 + (size_t)rt * 6144 + col0 + bj * HALF + 4 * n);
#pragma unroll
        for (int ai = 0; ai < 2; ++ai)
#pragma unroll
            for (int m = 0; m < 4; ++m) { const size_t off = (size_t)(rr0 + ai * HALF + m * 16) * DM + col0;
#pragma unroll
                for (int bj = 0; bj < 2; ++bj)
#pragma unroll
                    for (int n = 0; n < 2; ++n) { const f32x4 bs = *(const f32x4*)(basep + off + bj * HALF + 4 * n);
                        *(f32x4*)(outp + off + bj * HALF + 4 * n) = bs + gv[bj][n] * acc[ai][bj][m][n]; } }
    }
};
constexpr float C2 = 0.125f * 1.4426950408889634f;
struct EpiQKV {
    bf16_t* Q; const float* cs;
    __device__ __forceinline__ void operator()(const f32x4 (&acc)[2][2][4][2], const Unit& u, int wr, int wc, int fr, int fq) const {
        const int b = u.pm / 33, jt = u.pm % 33; const bool lat = jt != 0; const int t0 = (jt - 1) * BM;
        const int sec = u.pn >> 2; bf16_t* dst = Q + (size_t)sec * ((ACT_K - ACT_Q) / 2);
        const int rr0 = wr * 64 + fr, colt = (u.pn & 3) * BM + wc * 32 + 8 * fq; const float sc = sec == 0 ? C2 : 1.0f; const bool rope = lat && sec < 2;
#pragma unroll
        for (int ai = 0; ai < 2; ++ai)
#pragma unroll
            for (int m = 0; m < 4; ++m) { const int rr = rr0 + ai * HALF + m * 16; bf16_t* rowp = dst + ((size_t)u.pm * BM + rr) * DM + colt;
#pragma unroll
                for (int bj = 0; bj < 2; ++bj) { f32x4 v0 = acc[ai][bj][m][0], v1 = acc[ai][bj][m][1];
                    if (rope) { const int p0 = ((colt + bj * HALF) & 63) >> 1; const float* cp = cs + ((size_t)(t0 + rr) * 32 + p0) * 2;
                        const f32x4 c01 = *(const f32x4*)cp, c23 = *(const f32x4*)(cp + 4);
                        const float a0 = v0[0] * c01[0] - v0[1] * c01[1], a1 = v0[0] * c01[1] + v0[1] * c01[0];
                        const float a2 = v0[2] * c01[2] - v0[3] * c01[3], a3 = v0[2] * c01[3] + v0[3] * c01[2];
                        const float b0 = v1[0] * c23[0] - v1[1] * c23[1], b1 = v1[0] * c23[1] + v1[1] * c23[0];
                        const float b2 = v1[2] * c23[2] - v1[3] * c23[3], b3 = v1[2] * c23[3] + v1[3] * c23[2];
                        v0 = (f32x4){a0, a1, a2, a3}; v1 = (f32x4){b0, b1, b2, b3}; }
                    v0 = v0 * sc; v1 = v1 * sc;
                    u32x4 w; w.x = cvt_pk_bf16(v0[0], v0[1]); w.y = cvt_pk_bf16(v0[2], v0[3]); w.z = cvt_pk_bf16(v1[0], v1[1]); w.w = cvt_pk_bf16(v1[2], v1[3]);
                    *(u32x4*)(rowp + bj * HALF) = w; }
                asm volatile("" ::: "memory"); }
        (void)b;
    }
};
struct EpiSwiGLU {
    bf16_t* HID;
    __device__ __forceinline__ void operator()(const f32x4 (&acc)[2][2][4][2], const Unit& u, int wr, int wc, int fr, int fq) const {
        const int row0 = u.pm * BM + wr * 64 + fr, f0 = u.pn * 128 + wc * 16 + 4 * fq;
#pragma unroll
        for (int ai = 0; ai < 2; ++ai)
#pragma unroll
            for (int m = 0; m < 4; ++m) { bf16_t* rowp = HID + ((size_t)u.grp * EROWS + row0 + ai * HALF + m * 16) * FF + f0;
#pragma unroll
                for (int bj = 0; bj < 2; ++bj) { const f32x4 a = acc[ai][bj][m][0], bb = acc[ai][bj][m][1];
                    u32x2 w; w.x = cvt_pk_bf16(silu_f(a[0]) * bb[0], silu_f(a[1]) * bb[1]); w.y = cvt_pk_bf16(silu_f(a[2]) * bb[2], silu_f(a[3]) * bb[3]);
                    *(u32x2*)(rowp + bj * 64) = w; } }
    }
};
struct EpiMoeOut {
    bf16_t* YB; const float* gate;
    __device__ __forceinline__ void operator()(const f32x4 (&acc)[2][2][4][2], const Unit& u, int wr, int wc, int fr, int fq) const {
        const int row0 = u.pm * BM + wr * 64 + fr, col0 = u.pn * BM + wc * 32 + 8 * fq;
#pragma unroll
        for (int ai = 0; ai < 2; ++ai)
#pragma unroll
            for (int m = 0; m < 4; ++m) { const size_t er = (size_t)u.grp * EROWS + row0 + ai * HALF + m * 16; const float gt = gate[er]; bf16_t* rowp = YB + er * DM + col0;
#pragma unroll
                for (int bj = 0; bj < 2; ++bj) { const f32x4 v0 = acc[ai][bj][m][0] * gt, v1 = acc[ai][bj][m][1] * gt;
                    u32x4 w; w.x = cvt_pk_bf16(v0[0], v0[1]); w.y = cvt_pk_bf16(v0[2], v0[3]); w.z = cvt_pk_bf16(v1[0], v1[1]); w.w = cvt_pk_bf16(v1[2], v1[3]);
                    *(u32x4*)(rowp + bj * HALF) = w; } }
    }
};
}

namespace attn_body {
using bf16=__hip_bfloat16;
using s16x4=__attribute__((ext_vector_type(4)))short;
using f32x16=__attribute__((ext_vector_type(16)))float;
constexpr int D=64,PITCH=1024;
constexpr int NW=8,QBLK=32,QB=QBLK*NW,KVBLK=64;
constexpr int NT=LR/KVBLK;
__device__ __forceinline__ int crow(int r,int hi){return (r&3)+8*(r>>2)+4*hi;}
#define SBAR() __builtin_amdgcn_sched_barrier(0)
constexpr int NSLOT=3, SLOTB=8192;
constexpr int LDS_K=0, LDS_V=NSLOT*SLOTB, LDS_WS=2*NSLOT*SLOTB, LDS_OST=LDS_WS+NW*64*4, LDS_BYTES=LDS_OST+NW*4096;
__device__ __forceinline__ void glds16(const void*gsrc,unsigned lds_dst){unsigned keep;
  asm volatile("s_mov_b32 %0, m0\n\ts_mov_b32 m0, %2\n\ts_nop 0\n\tglobal_load_lds_dwordx4 %1, off\n\ts_mov_b32 m0, %0":"=&s"(keep):"v"(gsrc),"s"(lds_dst):"memory");}
__device__ __forceinline__ float max3f(float a,float b,float c){float r;asm("v_max3_f32 %0, %1, %2, %3":"=v"(r):"v"(a),"v"(b),"v"(c));return r;}
__device__ __forceinline__ float max2f(float a,float b){float r;asm("v_max_f32_e32 %0, %1, %2":"=v"(r):"v"(a),"v"(b));return r;}
__device__ __forceinline__ float fadd_s(float a,float b){float r;asm("v_add_f32_e32 %0, %1, %2":"=v"(r):"v"(a),"v"(b));return r;}
__device__ __forceinline__ float fsub_s(float a,float b){float r;asm("v_sub_f32_e32 %0, %1, %2":"=v"(r):"v"(a),"v"(b));return r;}
typedef float f32x2_t __attribute__((ext_vector_type(2))); typedef __bf16 bf16x2_t __attribute__((ext_vector_type(2)));
__device__ __forceinline__ unsigned cvtpk_s(float lo,float hi){f32x2_t v={lo,hi};bf16x2_t b=__builtin_convertvector(v,bf16x2_t);return __builtin_bit_cast(unsigned,b);}
#define WAIT_BAR(N) asm volatile("s_waitcnt vmcnt(" #N ") lgkmcnt(0)\n\ts_barrier":::"memory")
__device__ __forceinline__ void qkt(f32x16&p0,f32x16&p1,const char*Kslot,const bf16x8*qr,const f32x16&negm,int r32,int hi){
  const char*kb=Kslot+hi*1024+r32*16;
  #pragma unroll
  for(int d0=0;d0<4;++d0){
    const bf16x8 b0=*reinterpret_cast<const bf16x8*>(kb+d0*2048);
    const bf16x8 b1=*reinterpret_cast<const bf16x8*>(kb+d0*2048+512);
    if(d0==0){p0=__builtin_amdgcn_mfma_f32_32x32x16_bf16(b0,qr[0],negm,0,0,0);p1=__builtin_amdgcn_mfma_f32_32x32x16_bf16(b1,qr[0],negm,0,0,0);}
    else{p0=__builtin_amdgcn_mfma_f32_32x32x16_bf16(b0,qr[d0],p0,0,0,0);p1=__builtin_amdgcn_mfma_f32_32x32x16_bf16(b1,qr[d0],p1,0,0,0);}}
}
typedef __attribute__((address_space(3))) const char* lds_cptr;
typedef short v4i16_t __attribute__((ext_vector_type(4)));
__device__ __forceinline__ void kload8(bf16x8*kf,lds_cptr kp){
  kf[0]=*(const __attribute__((address_space(3))) bf16x8*)(kp);      kf[1]=*(const __attribute__((address_space(3))) bf16x8*)(kp+512);
  kf[2]=*(const __attribute__((address_space(3))) bf16x8*)(kp+2048); kf[3]=*(const __attribute__((address_space(3))) bf16x8*)(kp+2560);
  kf[4]=*(const __attribute__((address_space(3))) bf16x8*)(kp+4096); kf[5]=*(const __attribute__((address_space(3))) bf16x8*)(kp+4608);
  kf[6]=*(const __attribute__((address_space(3))) bf16x8*)(kp+6144); kf[7]=*(const __attribute__((address_space(3))) bf16x8*)(kp+6656);
}
__device__ __forceinline__ void kload2(bf16x8*kf,lds_cptr kp,int j){ kf[2*j]=*(const __attribute__((address_space(3))) bf16x8*)(kp+j*2048); kf[2*j+1]=*(const __attribute__((address_space(3))) bf16x8*)(kp+j*2048+512); }
__device__ __forceinline__ s16x4 vtr(lds_cptr p){ return __builtin_bit_cast(s16x4,__builtin_amdgcn_ds_read_tr16_b64_v4i16((__attribute__((address_space(3))) v4i16_t*)p)); }
__device__ __forceinline__ float rowmax(const f32x16&p0,const f32x16&p1){
  float a=max3f(p0[0],p0[1],p1[0]),b=max3f(p0[2],p0[3],p1[1]);a=max3f(a,p1[2],p1[3]);
  #pragma unroll
  for(int r=4;r<16;r+=4){a=max3f(a,p0[r],p0[r+1]);b=max3f(b,p0[r+2],p0[r+3]);a=max3f(a,p1[r],p1[r+1]);b=max3f(b,p1[r+2],p1[r+3]);}
  const float m=max2f(a,b);
  auto rr=__builtin_amdgcn_permlane32_swap(__float_as_uint(m),__float_as_uint(m),false,false);
  return max2f(__uint_as_float(rr[0]),__uint_as_float(rr[1]));
}
__device__ __forceinline__ void pv(f32x16*o,int vb,bf16x8 pa0,bf16x8 pa1,bf16x8 pa2,bf16x8 pa3){
  #pragma unroll
  for(int d0=0;d0<2;++d0){s16x4 lo[4],hi[4];
    #pragma unroll
    for(int ks=0;ks<4;++ks){
      asm volatile("ds_read_b64_tr_b16 %0,%1 offset:%c2":"=&v"(lo[ks]):"v"(vb),"i"(d0*4096+ks*1024):"memory");
      asm volatile("ds_read_b64_tr_b16 %0,%1 offset:%c2":"=&v"(hi[ks]):"v"(vb),"i"(d0*4096+ks*1024+512):"memory");}
    asm volatile("s_waitcnt lgkmcnt(0)":::"memory");SBAR();
    #define PK(k) (bf16x8){lo[k][0],lo[k][1],lo[k][2],lo[k][3],hi[k][0],hi[k][1],hi[k][2],hi[k][3]}
    o[d0]=__builtin_amdgcn_mfma_f32_32x32x16_bf16(pa0,PK(0),o[d0],0,0,0);
    o[d0]=__builtin_amdgcn_mfma_f32_32x32x16_bf16(pa1,PK(1),o[d0],0,0,0);
    o[d0]=__builtin_amdgcn_mfma_f32_32x32x16_bf16(pa2,PK(2),o[d0],0,0,0);
    o[d0]=__builtin_amdgcn_mfma_f32_32x32x16_bf16(pa3,PK(3),o[d0],0,0,0);
    #undef PK
  }
}
template<int THRL> __device__ __forceinline__ void attn_unit(const bf16*Qw,const bf16*__restrict__ Kh,const bf16*__restrict__ Vh,bf16*Ow,char*shm){
  const int tid=threadIdx.x,lane=tid&63,r32=lane&31,hi=lane>>5; const int wid=__builtin_amdgcn_readfirstlane(tid>>6);
  constexpr int DMp=PITCH;
  const unsigned lds0=(unsigned)(uintptr_t)shm;
  float*wsf=(float*)(shm+LDS_WS)+wid*64;
  const bf16*ksrc=Kh+(long)lane*DMp+wid*8;
  const bf16*vsrc=Vh+(long)(16*(wid&3)+(lane>>2))*DMp+(wid>>2)*32+(lane&3)*8;
  const unsigned kdst=lds0+LDS_K+wid*1024, vdst=lds0+LDS_V+wid*1024;
  #define DMA_K(t,slot) glds16(ksrc+(long)(t)*KVBLK*DMp,(unsigned)__builtin_amdgcn_readfirstlane(kdst+(slot)))
  #define DMA_V(t,slot) glds16(vsrc+(long)(t)*KVBLK*DMp,(unsigned)__builtin_amdgcn_readfirstlane(vdst+(slot)))
  const int vb0=(int)(lds0+LDS_V)+((lane>>4)&1)*32+(lane&3)*8+(4*hi+((lane&15)>>2))*64;
  const char*Kbase=shm+LDS_K; bf16x8 kf[8];
  const lds_cptr shm3=(lds_cptr)shm; const lds_cptr kp0=shm3+LDS_K+hi*1024+r32*16; const lds_cptr vp0=shm3+LDS_V+((lane>>4)&1)*32+(lane&3)*8+(4*hi+((lane&15)>>2))*64;
  DMA_K(0,0);DMA_V(0,0);DMA_K(1,SLOTB);
  bf16x8 qr[4];
  #pragma unroll
  for(int d0=0;d0<4;++d0)qr[d0]=*reinterpret_cast<const bf16x8*>(&Qw[(long)r32*DMp+d0*16+hi*8]);
  float mhat=0.f,l_reg=0.f;f32x16 o[2];o[0]=f32x16{};o[1]=f32x16{};f32x16 negm=f32x16{};asm volatile("":"+v"(negm));
  bool resc=false;
  #define START(P0,P1) do{ const float rm=rowmax(P0,P1); resc=false; \
    { const float dl=rm; mhat=fadd_s(mhat,dl); \
      _Pragma("unroll") for(int r=0;r<16;++r){P0[r]=fsub_s(P0[r],dl);P1[r]=fsub_s(P1[r],dl);} \
      _Pragma("unroll") for(int r=0;r<16;++r)negm[r]=-mhat; asm volatile("":"+v"(negm)); } \
    _Pragma("unroll") for(int r=0;r<16;++r)P0[r]=__builtin_amdgcn_exp2f(P0[r]); }while(0)
  #define RESC() do{ if(resc){ asm volatile("s_waitcnt lgkmcnt(0)":::"memory"); \
      _Pragma("unroll") for(int d_=0;d_<2;++d_) _Pragma("unroll") for(int r=0;r<16;++r)o[d_][r]*=wsf[crow(r,hi)]; } }while(0)
  f32x16 pA0,pA1,pB0,pB1;
  int sl_prev=0,sl_cur=0,sl_next=SLOTB;
  #define ROT() do{sl_prev=sl_cur;sl_cur=sl_next;sl_next=(sl_next==(NSLOT-1)*SLOTB)?0:sl_next+SLOTB;}while(0)
  DMA_K(2,2*SLOTB);
  WAIT_BAR(3);
  qkt(pA0,pA1,Kbase,qr,negm,r32,hi);asm volatile("s_nop 15\n\ts_nop 7":"+v"(pA0),"+v"(pA1));
  START(pA0,pA1);
  _Pragma("unroll") for(int r=0;r<16;++r)pA1[r]=__builtin_amdgcn_exp2f(pA1[r]);
  WAIT_BAR(0);
  DMA_K(3,0);DMA_V(1,SLOTB);
  ROT();
  kload8(kf,kp0+sl_cur);
  WAIT_BAR(2);
  s16x4 vlo[8],vhi[8]; u32x4 pw0,pw1,pw2,pw3;
  #define PKW(P,B) cvtpk_s(P[B],P[B+1])
  #define PAF(k) __builtin_bit_cast(bf16x8,pw##k)
  #define VFR(i) (bf16x8){vlo[i][0],vlo[i][1],vlo[i][2],vlo[i][3],vhi[i][0],vhi[i][1],vhi[i][2],vhi[i][3]}
  #define PIN(x) asm volatile("":"+v"(x))
  #define MX3(a,b,c) __builtin_fmaxf(__builtin_fmaxf((a),(b)),(c))
  #define GAPA(MF,A0,A1,A2,A3,W0,W1,PW) do{ MF; sacc+=A0; sacc+=A1; sacc+=A2; sacc+=A3; PIN(sacc); W0; W1; PIN(PW); SBAR(); }while(0)
  #define EX(v) __builtin_amdgcn_exp2f(v)
  #define GAPB(MF,X,B) do{ MF; X[B]=EX(X[B]); X[B+1]=EX(X[B+1]); X[B+2]=EX(X[B+2]); X[B+3]=EX(X[B+3]); PIN(X); SBAR(); }while(0)
  #define VRD(i) do{ vlo[i]=vtr(vp_+(((i)>>2)*4096+((i)&3)*1024)); vhi[i]=vtr(vp_+(((i)>>2)*4096+((i)&3)*1024+512)); }while(0)
  #define KRD(G,j) do{ if(G){ kload2(kf,kp0+sl_next,j); SBAR(); } }while(0)
  #define STEP(C0,C1,P0,P1,t,GK,GV,GL) do{ SBAR(); \
    const lds_cptr vp_=vp0+sl_prev; \
    VRD(0); SBAR(); float sacc=(P0[0]+P0[1]); \
    GAPA(C0=__builtin_amdgcn_mfma_f32_32x32x16_bf16(kf[0],qr[0],negm,0,0,0), P0[2],P0[3],P0[4],P0[5],     pw0[0]=PKW(P0,0), pw0[1]=PKW(P0,2), pw0); \
    VRD(4); SBAR(); GAPA(C1=__builtin_amdgcn_mfma_f32_32x32x16_bf16(kf[1],qr[0],negm,0,0,0), P0[6],P0[7],P0[8],P0[9],     pw0[2]=PKW(P0,4), pw0[3]=PKW(P0,6), pw0); \
    VRD(1); SBAR(); GAPA(C0=__builtin_amdgcn_mfma_f32_32x32x16_bf16(kf[2],qr[1],C0,0,0,0),   P0[10],P0[11],P0[12],P0[13], pw1[0]=PKW(P0,8), pw1[1]=PKW(P0,10), pw1); \
    VRD(5); SBAR(); GAPA(C1=__builtin_amdgcn_mfma_f32_32x32x16_bf16(kf[3],qr[1],C1,0,0,0),   P0[14],P0[15],P1[0],P1[1],   pw1[2]=PKW(P0,12),pw1[3]=PKW(P0,14), pw1); \
    VRD(2); SBAR(); GAPA(C0=__builtin_amdgcn_mfma_f32_32x32x16_bf16(kf[4],qr[2],C0,0,0,0),   P1[2],P1[3],P1[4],P1[5],     pw2[0]=PKW(P1,0), pw2[1]=PKW(P1,2), pw2); \
    VRD(6); SBAR(); GAPA(C1=__builtin_amdgcn_mfma_f32_32x32x16_bf16(kf[5],qr[2],C1,0,0,0),   P1[6],P1[7],P1[8],P1[9],     pw2[2]=PKW(P1,4), pw2[3]=PKW(P1,6), pw2); \
    VRD(3); SBAR(); GAPA(C0=__builtin_amdgcn_mfma_f32_32x32x16_bf16(kf[6],qr[3],C0,0,0,0),   P1[10],P1[11],P1[12],P1[13], pw3[0]=PKW(P1,8), pw3[1]=PKW(P1,10), pw3); \
    VRD(7); SBAR(); GAPA(C1=__builtin_amdgcn_mfma_f32_32x32x16_bf16(kf[7],qr[3],C1,0,0,0),   P1[14],P1[15],0.f,0.f,       pw3[2]=PKW(P1,12),pw3[3]=PKW(P1,14), pw3); \
    l_reg+=sacc; \
    if(GK){DMA_K((t)+3,sl_cur);} if(GV){DMA_V((t)+1,sl_next);} \
    { float a=MX3(C0[0],C0[1],C1[0]),b=MX3(C0[2],C0[3],C1[1]); a=MX3(a,C1[2],C1[3]); \
      _Pragma("unroll") for(int r=4;r<16;r+=4){a=MX3(a,C0[r],C0[r+1]);b=MX3(b,C0[r+2],C0[r+3]);a=MX3(a,C1[r],C1[r+1]);b=MX3(b,C1[r+2],C1[r+3]);} \
      float rm=__builtin_fmaxf(a,b); { auto rr=__builtin_amdgcn_permlane32_swap(__float_as_uint(rm),__float_as_uint(rm),false,false); rm=__builtin_fmaxf(__uint_as_float(rr[0]),__uint_as_float(rr[1])); } \
      resc=false; \
      if(__builtin_expect(__any(rm>(float)THRL),0)){ const float dl=__builtin_fmaxf(rm,0.f); mhat+=dl; \
        _Pragma("unroll") for(int r=0;r<16;++r){C0[r]-=dl;C1[r]-=dl;} \
        _Pragma("unroll") for(int r=0;r<16;++r)negm[r]=-mhat; asm volatile("":"+v"(negm)); \
        const float f=__builtin_amdgcn_exp2f(-dl); l_reg*=f; if(hi==0)wsf[r32]=f; resc=true; } } \
    SBAR(); \
    GAPB(o[0]=__builtin_amdgcn_mfma_f32_32x32x16_bf16(PAF(0),VFR(0),o[0],0,0,0), C0,0); \
    GAPB(o[1]=__builtin_amdgcn_mfma_f32_32x32x16_bf16(PAF(0),VFR(4),o[1],0,0,0), C0,4); \
    KRD(GL,0); GAPB(o[0]=__builtin_amdgcn_mfma_f32_32x32x16_bf16(PAF(1),VFR(1),o[0],0,0,0), C0,8); \
    KRD(GL,1); GAPB(o[1]=__builtin_amdgcn_mfma_f32_32x32x16_bf16(PAF(1),VFR(5),o[1],0,0,0), C0,12); \
    KRD(GL,2); GAPB(o[0]=__builtin_amdgcn_mfma_f32_32x32x16_bf16(PAF(2),VFR(2),o[0],0,0,0), C1,0); \
    KRD(GL,3); GAPB(o[1]=__builtin_amdgcn_mfma_f32_32x32x16_bf16(PAF(2),VFR(6),o[1],0,0,0), C1,4); \
    GAPB(o[0]=__builtin_amdgcn_mfma_f32_32x32x16_bf16(PAF(3),VFR(3),o[0],0,0,0), C1,8); \
    GAPB(o[1]=__builtin_amdgcn_mfma_f32_32x32x16_bf16(PAF(3),VFR(7),o[1],0,0,0), C1,12); \
    }while(0)
  int t=1;
  for(;t+5<NT;t+=2){
    STEP(pB0,pB1,pA0,pA1,t,true,true,true);     WAIT_BAR(2); RESC(); ROT();
    STEP(pA0,pA1,pB0,pB1,t+1,true,true,true);   WAIT_BAR(2); RESC(); ROT();
  }
  #define ENDW(tt) do{ if((tt)+3<NT){WAIT_BAR(2);} else if((tt)+2<NT){WAIT_BAR(1);} else {WAIT_BAR(0);} }while(0)
  for(;t+1<NT;t+=2){
    STEP(pB0,pB1,pA0,pA1,t,(t+3<NT),(t+1<NT),(t+1<NT));       ENDW(t);   RESC(); ROT();
    STEP(pA0,pA1,pB0,pB1,t+1,(t+4<NT),(t+2<NT),(t+2<NT));     ENDW(t+1); RESC(); ROT();
  }
  STEP(pB0,pB1,pA0,pA1,NT-1,false,false,false); RESC();
  { float sacc=pB0[0]+pB0[1]; _Pragma("unroll") for(int r=2;r<16;++r)sacc+=pB0[r]; _Pragma("unroll") for(int r=0;r<16;++r)sacc+=pB1[r]; l_reg+=sacc;
    pw0=(u32x4){PKW(pB0,0),PKW(pB0,2),PKW(pB0,4),PKW(pB0,6)};pw1=(u32x4){PKW(pB0,8),PKW(pB0,10),PKW(pB0,12),PKW(pB0,14)};pw2=(u32x4){PKW(pB1,0),PKW(pB1,2),PKW(pB1,4),PKW(pB1,6)};pw3=(u32x4){PKW(pB1,8),PKW(pB1,10),PKW(pB1,12),PKW(pB1,14)};
    SBAR(); pv(o,vb0+sl_cur,PAF(0),PAF(1),PAF(2),PAF(3)); }
  #undef PKW
  #undef PAF
  #undef VFR
  #undef PIN
  #undef MX3
  #undef GAPA
  #undef GAPB
  #undef EX
  #undef VRD
  #undef KRD
  #undef STEP
  #undef ENDW
  {auto rr=__builtin_amdgcn_permlane32_swap(__float_as_uint(l_reg),__float_as_uint(l_reg),false,false);l_reg=__uint_as_float(rr[0])+__uint_as_float(rr[1]);}
  if(hi==0)wsf[32+r32]=l_reg;asm volatile("s_waitcnt lgkmcnt(0)":::"memory");
  float rli[16];
  #pragma unroll
  for(int r=0;r<16;++r)rli[r]=__builtin_amdgcn_rcpf(wsf[32+crow(r,hi)]);
  { bf16*stg=(bf16*)(shm+LDS_OST)+wid*2048;
    #pragma unroll
    for(int r=0;r<16;++r){const int orow=crow(r,hi);
      #pragma unroll
      for(int d0=0;d0<2;++d0)stg[orow*64+d0*32+r32]=__float2bfloat16(o[d0][r]*rli[r]);}
    asm volatile("s_waitcnt lgkmcnt(0)":::"memory");
    #pragma unroll
    for(int i=0;i<4;++i){const int row=i*8+(lane>>3),ch=lane&7; const u32x4 v=*(const u32x4*)(stg+row*64+ch*8); *(u32x4*)(Ow+(long)row*DMp+ch*8)=v;} }
  asm volatile("s_waitcnt lgkmcnt(0)\n\ts_barrier":::"memory");
  #undef DMA_K
  #undef DMA_V
  #undef START
  #undef RESC
  #undef ROT
}
#undef SBAR
#undef WAIT_BAR
}

constexpr int NWAVES = 8, LDS_BYTES = 147456, RING_BYTES = 131072;
struct Params { const float* in[32]; float* out; unsigned char* ws; int ph_lo, ph_hi; };
enum { I_X = 0, I_C, I_CTX, I_CCTX, I_ADAW, I_ADAB, I_NMIXG, I_NFFNG, I_WIN, I_CONVW, I_CONVB, I_LRUWA, I_LRUBA, I_LRUWX, I_LRUBX, I_LRULAM, I_CMVG, I_CMWS, I_CMBS, I_WOUT0,
       I_WQKV, I_LQ1, I_LK1, I_LQ2, I_LK2, I_SUBLN, I_WOUT1, I_ROUTER, I_W1, I_W3, I_W2, I_FINALG };

typedef const __attribute__((address_space(4))) Params* KParams;
__device__ __forceinline__ Params kparams() {
#if defined(__HIP_DEVICE_COMPILE__)
    KParams q = (KParams)__builtin_amdgcn_kernarg_segment_ptr(); asm volatile("" : "+s"(q)); return *q;
#else
    return Params{};
#endif
}
struct Ctx {
    LAS unsigned char* lds; int tid, lane, wave, vcu, G;
};
__device__ __forceinline__ float wave_sum(float v) {
#pragma unroll
    for (int o = 1; o < 64; o <<= 1) v += __shfl_xor(v, o);
    return v;
}
#define LDS_WAIT() asm volatile("s_waitcnt lgkmcnt(0)" ::: "memory")

__device__ __forceinline__ int dest_row(int n, int mode) {
    if (mode == 1) return n < 2048 ? ((n & ~63) + 2 * (n & 31) + ((n >> 5) & 1)) : n;
    if (mode == 2) return 8 * (n >> 2) + (n & 3);
    if (mode == 3) return 8 * (n >> 2) + 4 + (n & 3);
    return n;
}
__device__ __forceinline__ void p0_transpose_item(const float* W, int K, int N, bf16_t* WT, int mode, LAS float* scr, int item, int lane) {
    const int nblk = N / 32, kb = item / nblk, nb = item % nblk, k0 = 64 * kb, n0 = 32 * nb;
#pragma unroll 8
    for (int i = 0; i < 32; ++i) { const int kk = 2 * i + (lane >> 5); scr[kk * 33 + (lane & 31)] = W[(size_t)(k0 + kk) * N + n0 + (lane & 31)]; }
    LDS_WAIT(); asm volatile("" ::: "memory");
    const int c = lane & 7;
#pragma unroll
    for (int j = 0; j < 4; ++j) { const int n = (lane >> 3) + 8 * j; const LAS float* s = scr + (8 * c) * 33 + n;
        u32x4 o; o.x = pk2(s[0 * 33], s[1 * 33]); o.y = pk2(s[2 * 33], s[3 * 33]); o.z = pk2(s[4 * 33], s[5 * 33]); o.w = pk2(s[6 * 33], s[7 * 33]);
        *(GAS u32x4*)(WT + (size_t)dest_row(n0 + n, mode) * K + k0 + 8 * c) = o; }
    LDS_WAIT(); asm volatile("" ::: "memory");
}
__device__ __forceinline__ void p0_prologue(const Ctx& F, const Params& p) {
    unsigned char* ws = p.ws;
    LAS float* sil = (LAS float*)(F.lds + 8 * 16384);
    for (int i = F.tid; i < 3 * DM; i += 512) { const float v = i < 2 * DM ? p.in[I_C][i] : p.in[I_CCTX][i - 2 * DM]; sil[i] = silu_f(v); }
    __syncthreads();
    {
        float* mod = (float*)(ws + WS_MOD);
        const int task = F.wave * F.G + F.vcu;
        if (task < 768) {
            const int l = task / 384, cgp = task % 384, kq = F.lane >> 4, n = cgp * 16 + (F.lane & 15);
            const float* W = p.in[I_ADAW] + (size_t)l * DM * 6144 + n;
            float a0 = 0.f, a1 = 0.f, a2 = 0.f;
#pragma unroll 16
            for (int k = kq; k < DM; k += 4) { const float w = W[(size_t)k * 6144]; a0 += sil[k] * w; a1 += sil[DM + k] * w; a2 += sil[2 * DM + k] * w; }
            a0 += __shfl_xor(a0, 16); a0 += __shfl_xor(a0, 32); a1 += __shfl_xor(a1, 16); a1 += __shfl_xor(a1, 32); a2 += __shfl_xor(a2, 16); a2 += __shfl_xor(a2, 32);
            if (F.lane < 16) { const float bb = p.in[I_ADAB][l * 6144 + n]; mod[(l * 3 + 0) * 6144 + n] = a0 + bb; mod[(l * 3 + 1) * 6144 + n] = a1 + bb; mod[(l * 3 + 2) * 6144 + n] = a2 + bb; }
        }
    }
    {
        const int gt = F.vcu * 512 + F.tid, NT_ = F.G * 512;
        float* cs = (float*)(ws + WS_ROPE);
        for (int i = gt; i < SEQ * 32; i += NT_) { const int t = i >> 5, pp = i & 31; const float inv = powf(10000.0f, -(float)(2 * (pp & 15)) / 32.0f);
            const float ang = (float)(pp < 16 ? (t >> 6) : (t & 63)) * inv; float s, c; sincosf(ang, &s, &c); cs[2 * i] = c; cs[2 * i + 1] = s; }
        bf16_t* lw = (bf16_t*)(ws + WS_LRUW);
        for (int o = gt; o < 2 * 2 * 8 * 64 * 64; o += NT_) { const int i = o & 63, j = (o >> 6) & 63, h = (o >> 12) & 7, g2 = (o >> 15) & 1, d = o >> 16;
            const float* src = g2 ? p.in[I_LRUWX] : p.in[I_LRUWA]; lw[o] = (bf16_t)f2bf(src[((d * 8 + h) * 64 + i) * 64 + j]); }
        bf16_t* cw = (bf16_t*)(ws + WS_CMWS);
        for (int o = gt; o < 8 * 128 * 128; o += NT_) cw[o] = (bf16_t)f2bf(p.in[I_CMWS][o]);
    }
    LAS float* scr = (LAS float*)(F.lds + F.wave * 16384);
    const int gw = F.vcu * NWAVES + F.wave, NGW = F.G * NWAVES;
    constexpr int I_IN = 1024, I_O0 = 512, I_QK = 1536, I_O1 = 512, I_SMALL = I_IN + I_O0 + I_QK + I_O1, I_MOE = 1024, NITEMS = I_SMALL + 3 * 32 * I_MOE;
    for (int it = gw; it < NITEMS; it += NGW) {
        int r = it;
        if (r < I_SMALL) {
            if (r < I_IN) { p0_transpose_item(p.in[I_WIN], DM, 2048, (bf16_t*)(ws + WS_WIN), 0, scr, r, F.lane); continue; } r -= I_IN;
            if (r < I_O0) { p0_transpose_item(p.in[I_WOUT0], DM, DM, (bf16_t*)(ws + WS_WOUT0), 0, scr, r, F.lane); continue; } r -= I_O0;
            if (r < I_QK) { p0_transpose_item(p.in[I_WQKV], DM, 3072, (bf16_t*)(ws + WS_WQKV), 1, scr, r, F.lane); continue; } r -= I_QK;
            p0_transpose_item(p.in[I_WOUT1], DM, DM, (bf16_t*)(ws + WS_WOUT1), 0, scr, r, F.lane); continue;
        }
        r -= I_SMALL; const int which = r / (32 * I_MOE), le = (r / I_MOE) % 32, item = r % I_MOE;
        if (which == 0) p0_transpose_item(p.in[I_W1] + (size_t)le * DM * FF, DM, FF, (bf16_t*)(ws + WS_W13) + (size_t)le * 4096 * DM, 2, scr, item, F.lane);
        else if (which == 1) p0_transpose_item(p.in[I_W3] + (size_t)le * DM * FF, DM, FF, (bf16_t*)(ws + WS_W13) + (size_t)le * 4096 * DM, 3, scr, item, F.lane);
        else p0_transpose_item(p.in[I_W2] + (size_t)le * FF * DM, FF, DM, (bf16_t*)(ws + WS_W2) + (size_t)le * DM * FF, 0, scr, item, F.lane);
    }
}

__device__ __forceinline__ void ld_row(const float* pr, int lane, f32x4 (&v)[4]) {
#pragma unroll
    for (int j = 0; j < 4; ++j) v[j] = *(const f32x4*)(pr + 4 * lane + 256 * j);
}
__device__ __forceinline__ float row_rstd(const f32x4 (&v)[4]) {
    float s = 0.f;
#pragma unroll
    for (int j = 0; j < 4; ++j) s += (v[j][0] * v[j][0] + v[j][1] * v[j][1]) + (v[j][2] * v[j][2] + v[j][3] * v[j][3]);
    return 1.0f / sqrtf(wave_sum(s) * (1.0f / DM) + EPS);
}
__device__ __forceinline__ void mod_norm(f32x4 (&v)[4], float rstd, const float* g, const float* sc, const float* sh, int lane) {
#pragma unroll
    for (int j = 0; j < 4; ++j) { const int c = 4 * lane + 256 * j; const f32x4 gv = *(const f32x4*)(g + c), sv = *(const f32x4*)(sc + c), hv = *(const f32x4*)(sh + c);
        v[j] = v[j] * rstd * gv * (sv + 1.0f) + hv; }
}
__device__ __forceinline__ void st_row_bf16(bf16_t* pr, int lane, const f32x4 (&v)[4]) {
#pragma unroll
    for (int j = 0; j < 4; ++j) { u32x2 w; w.x = pk2(v[j][0], v[j][1]); w.y = pk2(v[j][2], v[j][3]); *(u32x2*)(pr + 4 * lane + 256 * j) = w; }
}
__device__ __forceinline__ void row_info(int R, int& b, int& j, int& rt) { b = R / LR; j = R % LR; rt = j < CTXL ? 2 : b; }

__device__ __forceinline__ void p_norm1_in(const Ctx& F, const Params& p) {
    const float* mod = (const float*)(p.ws + WS_MOD); bf16_t* H = (bf16_t*)(p.ws + WS_H);
    const int gw = F.vcu * NWAVES + F.wave, NGW = F.G * NWAVES;
    for (int R = gw; R < NR; R += NGW) { int b, j, rt; row_info(R, b, j, rt);
        const float* src = j < CTXL ? p.in[I_CTX] + ((size_t)b * CTXL + j) * DM : p.in[I_X] + ((size_t)b * SEQ + (j - CTXL)) * DM;
        f32x4 v[4]; ld_row(src, F.lane, v); const float rstd = row_rstd(v);
        const float* m = mod + (size_t)(0 * 3 + rt) * 6144; mod_norm(v, rstd, p.in[I_NMIXG], m + DM, m, F.lane);
        st_row_bf16(H + (size_t)R * DM, F.lane, v); }
}
__device__ __forceinline__ void p_norm2_router(const Ctx& F, const Params& p, int l, bool with_ctx) {
    const float* mod = (const float*)(p.ws + WS_MOD); bf16_t* H = (bf16_t*)(p.ws + WS_H); const float* X = (const float*)(p.ws + WS_X); float* aff = (float*)(p.ws + WS_AFF);
    LAS float* wr = (LAS float*)F.lds;
    for (int i = F.tid; i < DM * NE / 4; i += 512) ((LAS f32x4*)wr)[i] = ((const f32x4*)(p.in[I_ROUTER] + (size_t)l * DM * NE))[i];
    __syncthreads();
    const int gw = F.vcu * NWAVES + F.wave, NGW = F.G * NWAVES; const int hi5 = (F.lane >> 5) & 1, hi4 = (F.lane >> 4) & 1, hi3 = (F.lane >> 3) & 1, hi2 = (F.lane >> 2) & 1;
    for (int R = gw; R < NR; R += NGW) { int b, j, rt; row_info(R, b, j, rt);
        if (!with_ctx && j < CTXL) continue;
        f32x4 v[4]; ld_row(X + (size_t)R * DM, F.lane, v); const float rstd = row_rstd(v);
        const float* m = mod + (size_t)(l * 3 + rt) * 6144; mod_norm(v, rstd, p.in[I_NFFNG] + l * DM, m + 4 * DM, m + 3 * DM, F.lane);
        st_row_bf16(H + (size_t)R * DM, F.lane, v);
        float a[16];
#pragma unroll
        for (int e = 0; e < 16; ++e) a[e] = 0.f;
#pragma unroll
        for (int jj = 0; jj < 4; ++jj)
#pragma unroll
            for (int i = 0; i < 4; ++i) { const int c = 4 * F.lane + 256 * jj + i; const float hv = v[jj][i];
#pragma unroll
                for (int q = 0; q < 4; ++q) { const f32x4 w = *(const LAS f32x4*)(wr + c * 16 + 4 * q); a[4 * q] += hv * w[0]; a[4 * q + 1] += hv * w[1]; a[4 * q + 2] += hv * w[2]; a[4 * q + 3] += hv * w[3]; }
                if (i & 1) __builtin_amdgcn_sched_barrier(0); }
        float b8[8], b4[4], b2[2], b1;
#pragma unroll
        for (int i = 0; i < 8; ++i) { const float keep = hi5 ? a[i + 8] : a[i], send = hi5 ? a[i] : a[i + 8]; b8[i] = keep + __shfl_xor(send, 32); }
#pragma unroll
        for (int i = 0; i < 4; ++i) { const float keep = hi4 ? b8[i + 4] : b8[i], send = hi4 ? b8[i] : b8[i + 4]; b4[i] = keep + __shfl_xor(send, 16); }
#pragma unroll
        for (int i = 0; i < 2; ++i) { const float keep = hi3 ? b4[i + 2] : b4[i], send = hi3 ? b4[i] : b4[i + 2]; b2[i] = keep + __shfl_xor(send, 8); }
        { const float keep = hi2 ? b2[1] : b2[0], send = hi2 ? b2[0] : b2[1]; b1 = keep + __shfl_xor(send, 4); }
        b1 += __shfl_xor(b1, 1); b1 += __shfl_xor(b1, 2);
        float mx = b1;
#pragma unroll
        for (int o = 4; o < 64; o <<= 1) mx = fmaxf(mx, __shfl_xor(mx, o));
        const float ex = __expf(b1 - mx); float sm = ex;
#pragma unroll
        for (int o = 4; o < 64; o <<= 1) sm += __shfl_xor(sm, o);
        if ((F.lane & 3) == 0) aff[((size_t)b * NE + (F.lane >> 2)) * LR + j] = ex / sm;
    }
    __syncthreads();
}

__device__ __forceinline__ void p_select(const Ctx& F, const Params& p, bool with_ctx) {
    const float* aff = (const float*)(p.ws + WS_AFF); int* inv = (int*)(p.ws + WS_INV); float* gate = (float*)(p.ws + WS_GATE);
    const bf16_t* H = (const bf16_t*)(p.ws + WS_H); bf16_t* XS = (bf16_t*)(p.ws + WS_XS);
    LAS unsigned* hist = (LAS unsigned*)F.lds;
    LAS unsigned* misc = hist + 256;
    LAS unsigned* list = hist + 512;
    LAS unsigned* vals = hist + 512 + 2048;
    const int nitems = with_ctx ? 288 : 256;
    for (int item = blockIdx.x; item < nitems; item += F.G) {
        const bool isl = item < 256; const int prob = isl ? item >> 3 : item - 256, seg = isl ? item & 7 : 0, b = prob >> 4, e = prob & 15;
        const int n = isl ? SEQ : CTXL, kcap = isl ? 1024 : 32, j0 = isl ? CTXL : 0, nj = isl ? 16 : 1;
        const float* av = aff + ((size_t)b * NE + e) * LR + j0;
#pragma unroll 1
        for (int jj = 0; jj < nj; ++jj) { const int tok = F.tid + 512 * jj; vals[tok] = tok < n ? __float_as_uint(av[tok]) : 0u; }
        unsigned prefix = 0u, mask = 0u, kk = (unsigned)kcap;
#pragma unroll 1
        for (int pass = 0; pass < 4; ++pass) { const int shift = 24 - 8 * pass;
            if (F.tid < 256) hist[F.tid] = 0u;
            __syncthreads();
#pragma unroll 1
            for (int jj = 0; jj < nj; ++jj) { const unsigned bt = vals[F.tid + 512 * jj]; if ((bt & mask) == prefix && bt != 0u) atomicAdd((unsigned*)(hist + ((bt >> shift) & 255u)), 1u); }
            __syncthreads();
            if (F.wave == 0) {
                unsigned loc[4], tot = 0u;
#pragma unroll
                for (int q = 0; q < 4; ++q) { loc[q] = hist[255 - 4 * F.lane - q]; tot += loc[q]; }
                unsigned inc = tot;
#pragma unroll
                for (int o = 1; o < 64; o <<= 1) { const unsigned t2 = __shfl_up(inc, o); if (F.lane >= o) inc += t2; }
                unsigned run = inc - tot;
#pragma unroll
                for (int q = 0; q < 4; ++q) { if (run < kk && run + loc[q] >= kk) { misc[0] = (unsigned)(255 - 4 * F.lane - q); misc[1] = kk - run; } run += loc[q]; }
            }
            __syncthreads();
            prefix |= misc[0] << shift; mask |= 0xffu << shift; kk = misc[1];
            __syncthreads();
        }
        const unsigned T = prefix, need_eq = kk, cnt_gt = (unsigned)kcap - need_eq;
        unsigned cnt = 0u;
#pragma unroll 1
        for (int jj = 0; jj < nj; ++jj) { const unsigned bt = vals[F.tid + 512 * jj]; cnt += (bt > T ? 1u : 0u) + (bt == T ? 0x10000u : 0u); }
        unsigned inc = cnt;
#pragma unroll
        for (int o = 1; o < 64; o <<= 1) { const unsigned t2 = __shfl_up(inc, o); if (F.lane >= o) inc += t2; }
        if (F.lane == 63) misc[8 + F.wave] = inc;
        if (F.tid == 0) misc[2] = 0u;
        __syncthreads();
        unsigned base = inc - cnt;
        for (int w = 0; w < F.wave; ++w) base += misc[8 + w];
        unsigned rg = base & 0xffffu, re = base >> 16;
#pragma unroll 1
        for (int jj = 0; jj < nj; ++jj) { const int tok = F.tid + 512 * jj; const unsigned bt = vals[tok]; const bool own = isl ? ((jj >> 1) == seg) : true;
            const bool isgt = bt > T, iseq = bt == T; int slot = -1;
            if (isgt) { slot = (int)rg; } else if (iseq && re < need_eq) { slot = (int)(cnt_gt + re); }
            rg += isgt ? 1u : 0u; re += iseq ? 1u : 0u;
            if (own && tok < n) { const int R = b * LR + j0 + tok; int er = -1;
                if (slot >= 0) { er = isl ? b * 1024 + slot : 2048 + b * 32 + slot; gate[e * EROWS + er] = __uint_as_float(bt);
                    const unsigned pos = atomicAdd((unsigned*)(misc + 2), 1u); list[2 * pos] = (unsigned)R; list[2 * pos + 1] = (unsigned)er; }
                inv[(size_t)R * NE + e] = er; } }
        __syncthreads();
        const int nl = (int)misc[2];
        for (int i = F.wave; i < nl; i += NWAVES) { const unsigned R = list[2 * i], er = list[2 * i + 1];
            const u32x4* sp = (const u32x4*)(H + (size_t)R * DM); u32x4* d = (u32x4*)(XS + ((size_t)e * EROWS + er) * DM);
            const u32x4 v0 = sp[F.lane], v1 = sp[64 + F.lane]; d[F.lane] = v0; d[64 + F.lane] = v1; }
        __syncthreads();
    }
}

__device__ __forceinline__ void p_combine(const Ctx& F, const Params& p, int l, bool final_) {
    const float* mod = (const float*)(p.ws + WS_MOD); bf16_t* H = (bf16_t*)(p.ws + WS_H); float* X = (float*)(p.ws + WS_X); const int* inv = (const int*)(p.ws + WS_INV);
    const bf16_t* YB = (const bf16_t*)(p.ws + WS_XS);
    const int gw = F.vcu * NWAVES + F.wave, NGW = F.G * NWAVES;
    for (int R = gw; R < NR; R += NGW) { int b, j, rt; row_info(R, b, j, rt);
        if (final_ && j < CTXL) continue;
        f32x4 v[4]; ld_row(X + (size_t)R * DM, F.lane, v);
        const int myinv = F.lane < NE ? inv[(size_t)R * NE + F.lane] : -1;
        f32x4 mo[4];
#pragma unroll
        for (int jj = 0; jj < 4; ++jj) mo[jj] = (f32x4){0.f, 0.f, 0.f, 0.f};
#pragma unroll
        for (int e = 0; e < NE; ++e) { const int er = __builtin_amdgcn_readlane(myinv, e);
            if (er >= 0) { const bf16_t* yr = YB + ((size_t)e * EROWS + er) * DM;
#pragma unroll
                for (int jj = 0; jj < 4; ++jj) { const u32x2 w = *(const u32x2*)(yr + 4 * F.lane + 256 * jj); mo[jj][0] += bflo(w.x); mo[jj][1] += bfhi(w.x); mo[jj][2] += bflo(w.y); mo[jj][3] += bfhi(w.y); } } }
        const float* m = mod + (size_t)(l * 3 + rt) * 6144;
#pragma unroll
        for (int jj = 0; jj < 4; ++jj) { const f32x4 g2 = *(const f32x4*)(m + 5 * DM + 4 * F.lane + 256 * jj); v[jj] = v[jj] + g2 * mo[jj]; }
        const float rstd = row_rstd(v);
        if (final_) { float* o = p.out + ((size_t)b * SEQ + (j - CTXL)) * DM;
#pragma unroll
            for (int jj = 0; jj < 4; ++jj) { const int c = 4 * F.lane + 256 * jj; *(f32x4*)(o + c) = v[jj] * rstd * *(const f32x4*)(p.in[I_FINALG] + c); } }
        else {
#pragma unroll
            for (int jj = 0; jj < 4; ++jj) *(f32x4*)(X + (size_t)R * DM + 4 * F.lane + 256 * jj) = v[jj];
            const float* m1 = mod + (size_t)((l + 1) * 3 + rt) * 6144; mod_norm(v, rstd, p.in[I_NMIXG] + (l + 1) * DM, m1 + DM, m1, F.lane);
            st_row_bf16(H + (size_t)R * DM, F.lane, v); }
    }
}

__device__ __forceinline__ void p_lru(const Ctx& F, const Params& p, bool full) {
    const bf16_t* Z = (const bf16_t*)(p.ws + WS_ACT + ACT_Z); bf16_t* YC = (bf16_t*)(p.ws + WS_ACT + ACT_YCAT); const bf16_t* LW = (const bf16_t*)(p.ws + WS_LRUW);
    f32x2* SUM = (f32x2*)(p.ws + WS_SUM);
    LAS float* recS = (LAS float*)F.lds;
    LAS float* xcF = recS + 67 * 64;
    LAS float* aS = xcF + 64 * 64;
    LAS float* uS = aS + 2 * 64 * 64;
    LAS float* cst = uS + 2 * 64 * 64;
    LAS bf16_t* xcB = (LAS bf16_t*)(cst + 1024 + 128);
    const int wave = F.wave, lane = F.lane, tid = F.tid;
    for (int item = blockIdx.x; item < NTILE64 * 8; item += F.G) {
        const int T = item >> 3, h = item & 7, b = T / 132, jt = T % 132; const bool isctx = jt < 4;
        const int R0 = b * LR + jt * 64;
        const int slo = isctx ? 0 : CTXL, shi = isctx ? CTXL : LR;
        const int jbase = jt * 64;
        { const int r = tid >> 3, c8 = tid & 7; const u32x4 w = *(const u32x4*)(Z + (size_t)(R0 + r) * 2048 + 512 + h * 64 + c8 * 8); LAS float* d = recS + (r + 2) * 64 + c8 * 8;
          d[0] = bflo(w.x); d[1] = bfhi(w.x); d[2] = bflo(w.y); d[3] = bfhi(w.y); d[4] = bflo(w.z); d[5] = bfhi(w.z); d[6] = bflo(w.w); d[7] = bfhi(w.w);
          if (tid < 24) { const int hr = tid >> 3; const int rr = hr == 0 ? -2 : (hr == 1 ? -1 : 64); const int jj = jbase + rr; LAS float* d2 = recS + (rr + 2) * 64 + c8 * 8;
              if (jj >= slo && jj < shi) { const u32x4 w2 = *(const u32x4*)(Z + (size_t)(R0 + rr) * 2048 + 512 + h * 64 + c8 * 8);
                  d2[0] = bflo(w2.x); d2[1] = bfhi(w2.x); d2[2] = bflo(w2.y); d2[3] = bfhi(w2.y); d2[4] = bflo(w2.z); d2[5] = bfhi(w2.z); d2[6] = bflo(w2.w); d2[7] = bfhi(w2.w); }
              else {
#pragma unroll
                  for (int i = 0; i < 8; ++i) d2[i] = 0.f; } } }
        __syncthreads();
        { const int r = tid >> 3, c8 = (tid & 7) * 8; const float* cw = p.in[I_CONVW] + h * 64 + c8; const float* cb = p.in[I_CONVB] + h * 64 + c8;
          float y[8];
#pragma unroll
          for (int i = 0; i < 8; ++i) { y[i] = cb[i];
#pragma unroll
              for (int q = 0; q < 4; ++q) y[i] += cw[q * 512 + i] * recS[(r + q) * 64 + c8 + i]; }
#pragma unroll
          for (int i = 0; i < 8; ++i) xcF[r * 64 + c8 + i] = y[i];
          u32x4 w; w.x = pk2(y[0], y[1]); w.y = pk2(y[2], y[3]); w.z = pk2(y[4], y[5]); w.w = pk2(y[6], y[7]);
          *(LAS u32x4*)(xcB + r * 72 + c8) = w; }
        __syncthreads();
        { const int d = wave >> 2, mf = wave & 3, fr = lane & 15, fq = lane >> 4;
          bf16x8 af[2];
#pragma unroll
          for (int ks = 0; ks < 2; ++ks) af[ks] = *(const LAS bf16x8*)(xcB + (16 * mf + fr) * 72 + 32 * ks + 8 * fq);
          f32x4 acc[2][4];
#pragma unroll
          for (int g2 = 0; g2 < 2; ++g2)
#pragma unroll
              for (int nf = 0; nf < 4; ++nf) { acc[g2][nf] = (f32x4){0.f, 0.f, 0.f, 0.f};
#pragma unroll
                  for (int ks = 0; ks < 2; ++ks) { const bf16x8 bfr = *(const bf16x8*)(LW + ((size_t)(((d * 2 + g2) * 8 + h) * 64 + 16 * nf + fr)) * 64 + 32 * ks + 8 * fq);
                      acc[g2][nf] = __builtin_amdgcn_mfma_f32_16x16x32_bf16(af[ks], bfr, acc[g2][nf], 0, 0, 0); } }
#pragma unroll
          for (int nf = 0; nf < 4; ++nf) { const int ch = 16 * nf + fr, gch = d * 512 + h * 64 + ch;
              const float ba = p.in[I_LRUBA][gch], bx = p.in[I_LRUBX][gch], lam = p.in[I_LRULAM][gch];
              const float cA = -8.0f * log1pf(__expf(-lam));
#pragma unroll
              for (int r = 0; r < 4; ++r) { const int tk = 16 * mf + 4 * fq + r;
                  const float rg = sigmoid_f(acc[0][nf][r] + ba), ig = sigmoid_f(acc[1][nf][r] + bx);
                  const float la = rg * cA, a = __expf(la), mult = sqrtf(-expm1f(2.0f * la));
                  aS[(d * 64 + tk) * 64 + ch] = a; uS[(d * 64 + tk) * 64 + ch] = mult * ig * xcF[tk * 64 + ch]; } } }
        if (full) {
            const int dc = tid & 127, d = dc >> 6, ch = dc & 63, sg = tid >> 7;
            const int n = d == 0 ? jt : (isctx ? 3 - jt : 4 + 131 - jt);
            const int i0 = (n * sg) / 4, i1 = (n * (sg + 1)) / 4;
            float P = 1.f, Hs = 0.f;
            for (int i = i0; i < i1; ++i) { const int jp = d == 0 ? i : (isctx ? 3 - i : (i < 4 ? 3 - i : 135 - i));
                const f32x2 s = SUM[((size_t)(b * 132 + jp) * 2 + d) * 512 + h * 64 + ch]; Hs = s.x * Hs + s.y; P = P * s.x; }
            cst[(sg * 128 + dc) * 2] = P; cst[(sg * 128 + dc) * 2 + 1] = Hs;
        }
        __syncthreads();
        if (full && tid < 128) { float s = 0.f;
#pragma unroll
            for (int sg = 0; sg < 4; ++sg) s = cst[(sg * 128 + tid) * 2] * s + cst[(sg * 128 + tid) * 2 + 1];
            cst[1024 + tid] = s; }
        if (tid < 128) { const int d = tid >> 6, ch = tid & 63;
            float hs = full ? cst[1024 + tid] : 0.f, P = 1.f;
            if (d == 0) {
#pragma unroll 8
                for (int t = 0; t < 64; ++t) { const float a = aS[t * 64 + ch]; hs = a * hs + uS[t * 64 + ch]; P *= a; if (full) uS[t * 64 + ch] = hs; }
            } else {
#pragma unroll 8
                for (int t = 63; t >= 0; --t) { const float a = aS[(64 + t) * 64 + ch]; hs = a * hs + uS[(64 + t) * 64 + ch]; P *= a; if (full) uS[(64 + t) * 64 + ch] = hs; }
            }
            if (!full) SUM[((size_t)T * 2 + d) * 512 + h * 64 + ch] = (f32x2){P, hs};
        }
        __syncthreads();
        if (full) { const int r = tid >> 3, c8 = (tid & 7) * 8; const u32x4 gw_ = *(const u32x4*)(Z + (size_t)(R0 + r) * 2048 + h * 64 + c8);
            float gg[8] = {bflo(gw_.x), bfhi(gw_.x), bflo(gw_.y), bfhi(gw_.y), bflo(gw_.z), bfhi(gw_.z), bflo(gw_.w), bfhi(gw_.w)}; float y[8];
#pragma unroll
            for (int i = 0; i < 8; ++i) y[i] = gg[i] * (uS[r * 64 + c8 + i] + uS[(64 + r) * 64 + c8 + i]);
            u32x4 w; w.x = pk2(y[0], y[1]); w.y = pk2(y[2], y[3]); w.z = pk2(y[4], y[5]); w.w = pk2(y[6], y[7]);
            *(u32x4*)(YC + (size_t)(R0 + r) * DM + h * 64 + c8) = w; }
        __syncthreads();
    }
}

__device__ __forceinline__ void p_cm(const Ctx& F, const Params& p) {
    const bf16_t* Z = (const bf16_t*)(p.ws + WS_ACT + ACT_Z); bf16_t* YC = (bf16_t*)(p.ws + WS_ACT + ACT_YCAT); const bf16_t* CW = (const bf16_t*)(p.ws + WS_CMWS);
    LAS bf16_t* vnT = (LAS bf16_t*)F.lds;
    const int wave = F.wave, lane = F.lane, tid = F.tid, fr = lane & 15, fq = lane >> 4;
    for (int item = blockIdx.x; item < (NR / 128) * 8; item += F.G) {
        const int cn = item >> 3, g = item & 7; const int R0 = cn * 128;
        { const int q = tid >> 2, part = tid & 3; const bf16_t* src = Z + (size_t)(R0 + q) * 2048 + 1536 + g * 64 + part * 16;
          const u32x4 w0 = *(const u32x4*)src, w1 = *(const u32x4*)(src + 8);
          float v[16] = {bflo(w0.x), bfhi(w0.x), bflo(w0.y), bfhi(w0.y), bflo(w0.z), bfhi(w0.z), bflo(w0.w), bfhi(w0.w), bflo(w1.x), bfhi(w1.x), bflo(w1.y), bfhi(w1.y), bflo(w1.z), bfhi(w1.z), bflo(w1.w), bfhi(w1.w)};
          float ss = 0.f;
#pragma unroll
          for (int i = 0; i < 16; ++i) ss += v[i] * v[i];
          ss += __shfl_xor(ss, 1); ss += __shfl_xor(ss, 2);
          const float rstd = 1.0f / sqrtf(ss * (1.0f / 64.0f) + EPS); const float* vg = p.in[I_CMVG] + g * 64 + part * 16;
#pragma unroll
          for (int i = 0; i < 16; ++i) vnT[(part * 16 + i) * 136 + q] = (bf16_t)f2bf(v[i] * rstd * vg[i]); }
        __syncthreads();
        f32x4 acc[4];
#pragma unroll
        for (int nf = 0; nf < 4; ++nf) acc[nf] = (f32x4){0.f, 0.f, 0.f, 0.f};
#pragma unroll
        for (int ks = 0; ks < 4; ++ks) { const bf16x8 af = *(const bf16x8*)(CW + ((size_t)g * 128 + 16 * wave + fr) * 128 + 32 * ks + 8 * fq);
#pragma unroll
            for (int nf = 0; nf < 4; ++nf) { const bf16x8 bfr = *(const LAS bf16x8*)(vnT + (16 * nf + fr) * 136 + 32 * ks + 8 * fq);
                acc[nf] = __builtin_amdgcn_mfma_f32_16x16x32_bf16(af, bfr, acc[nf], 0, 0, 0); } }
#pragma unroll
        for (int r = 0; r < 4; ++r) { const int pp = 16 * wave + 4 * fq + r; const float bs = p.in[I_CMBS][g * 128 + pp];
#pragma unroll
            for (int nf = 0; nf < 4; ++nf) { const int c = 16 * nf + fr; const float ug = bf2f(Z[(size_t)(R0 + pp) * 2048 + 1024 + g * 64 + c]);
                YC[(size_t)(R0 + pp) * DM + 512 + g * 64 + c] = (bf16_t)f2bf(ug * (acc[nf][r] + bs)); } }
        __syncthreads();
    }
}

__device__ __forceinline__ void p_attn(const Ctx& F, const Params& p, unsigned char* lds_generic) {
    using abf = attn_body::bf16;
    const abf* Q = (const abf*)(p.ws + WS_ACT + ACT_Q); const abf* Kb = (const abf*)(p.ws + WS_ACT + ACT_K); const abf* Vb = (const abf*)(p.ws + WS_ACT + ACT_V);
    const int wid = F.wave;
    for (int i = 0; i < 8; ++i) { const int combo = i * 8 + (F.vcu >> 5), qb = F.vcu & 31;
        const int b = combo >> 5, h = (combo >> 2) & 7, m = (combo >> 1) & 1, half = combo & 1;
        abf* O = (abf*)(p.ws + WS_ACT + (m ? ACT_O2 : ACT_O1));
        const abf* Qw = Q + ((size_t)b * LR + CTXL + qb * 256 + wid * 32) * DM + (h * 2 + m) * 64;
        const abf* Kh = Kb + (size_t)b * LR * DM + (h * 2 + m) * 64;
        const abf* Vh = Vb + (size_t)b * LR * DM + h * 128 + half * 64;
        abf* Ow = O + ((size_t)b * SEQ + qb * 256 + wid * 32) * DM + h * 128 + half * 64;
        attn_body::attn_unit<8>(Qw, Kh, Vh, Ow, (char*)lds_generic); }
}
__device__ __forceinline__ void p_attn_combine(const Ctx& F, const Params& p) {
    const bf16_t* O1 = (const bf16_t*)(p.ws + WS_ACT + ACT_O1); const bf16_t* O2 = (const bf16_t*)(p.ws + WS_ACT + ACT_O2); bf16_t* A = (bf16_t*)(p.ws + WS_ACT + ACT_A);
    const float lam_init = 0.8f - 0.6f * expf(-0.3f);
    float s1 = F.lane < 64 ? p.in[I_LQ1][F.lane] * p.in[I_LK1][F.lane] : 0.f, s2 = p.in[I_LQ2][F.lane] * p.in[I_LK2][F.lane];
    s1 = wave_sum(s1); s2 = wave_sum(s2);
    const float lam = expf(s1) - expf(s2) + lam_init, osc = 1.0f - lam_init;
    f32x4 gsub[4];
#pragma unroll
    for (int q = 0; q < 4; ++q) gsub[q] = *(const f32x4*)(p.in[I_SUBLN] + 16 * (F.lane & 7) + 4 * q);
    const int gw = F.vcu * NWAVES + F.wave, NGW = F.G * NWAVES;
    for (int r = gw; r < NLAT; r += NGW) {
        const u32x4* a1 = (const u32x4*)(O1 + (size_t)r * DM + 16 * F.lane); const u32x4* a2 = (const u32x4*)(O2 + (size_t)r * DM + 16 * F.lane);
        const u32x4 x0 = a1[0], x1 = a1[1], y0 = a2[0], y1 = a2[1];
        float o[16];
        o[0] = bflo(x0.x) - lam * bflo(y0.x); o[1] = bfhi(x0.x) - lam * bfhi(y0.x); o[2] = bflo(x0.y) - lam * bflo(y0.y); o[3] = bfhi(x0.y) - lam * bfhi(y0.y);
        o[4] = bflo(x0.z) - lam * bflo(y0.z); o[5] = bfhi(x0.z) - lam * bfhi(y0.z); o[6] = bflo(x0.w) - lam * bflo(y0.w); o[7] = bfhi(x0.w) - lam * bfhi(y0.w);
        o[8] = bflo(x1.x) - lam * bflo(y1.x); o[9] = bfhi(x1.x) - lam * bfhi(y1.x); o[10] = bflo(x1.y) - lam * bflo(y1.y); o[11] = bfhi(x1.y) - lam * bfhi(y1.y);
        o[12] = bflo(x1.z) - lam * bflo(y1.z); o[13] = bfhi(x1.z) - lam * bfhi(y1.z); o[14] = bflo(x1.w) - lam * bflo(y1.w); o[15] = bfhi(x1.w) - lam * bfhi(y1.w);
        float ss = 0.f;
#pragma unroll
        for (int i = 0; i < 16; ++i) ss += o[i] * o[i];
        ss += __shfl_xor(ss, 1); ss += __shfl_xor(ss, 2); ss += __shfl_xor(ss, 4);
        const float rstd = osc / sqrtf(ss * (1.0f / 128.0f) + EPS);
        u32x4 w0, w1;
        w0.x = pk2(o[0] * rstd * gsub[0][0], o[1] * rstd * gsub[0][1]); w0.y = pk2(o[2] * rstd * gsub[0][2], o[3] * rstd * gsub[0][3]);
        w0.z = pk2(o[4] * rstd * gsub[1][0], o[5] * rstd * gsub[1][1]); w0.w = pk2(o[6] * rstd * gsub[1][2], o[7] * rstd * gsub[1][3]);
        w1.x = pk2(o[8] * rstd * gsub[2][0], o[9] * rstd * gsub[2][1]); w1.y = pk2(o[10] * rstd * gsub[2][2], o[11] * rstd * gsub[2][3]);
        w1.z = pk2(o[12] * rstd * gsub[3][0], o[13] * rstd * gsub[3][1]); w1.w = pk2(o[14] * rstd * gsub[3][2], o[15] * rstd * gsub[3][3]);
        u32x4* d = (u32x4*)(A + (size_t)r * DM + 16 * F.lane); d[0] = w0; d[1] = w1;
    }
}

__global__ void __launch_bounds__(NWAVES * 64, 2) mk_fwd(Params p_unused) {
    extern __shared__ __attribute__((aligned(16))) unsigned char lds[];
#define MAKE_CTX Ctx F; { int t_ = threadIdx.x; asm volatile("" : "+v"(t_)); F.lds = (LAS unsigned char*)lds; F.tid = t_; F.lane = t_ & 63; F.wave = __builtin_amdgcn_readfirstlane(t_ >> 6); \
    F.G = gridDim.x; const int bx = blockIdx.x; F.vcu = (F.G % 8 == 0) ? (bx % 8) * (F.G / 8) + bx / 8 : bx; }
    int lo, hi; { const Params q0 = kparams(); lo = q0.ph_lo; hi = q0.ph_hi; }
#ifndef PH_MASK
#define PH_MASK 0xFFFFFu
#endif
#define IN(k) (((PH_MASK >> (k)) & 1u) && lo <= (k) && (k) < hi)
#define SEAM(k) do { if (IN(k) && IN((k) + 1)) { cg::this_grid().sync(); } } while (0)
#define PHASE_VARS MAKE_CTX const Params p = kparams(); unsigned char* ws = p.ws; const float* mod = (const float*)(ws + WS_MOD); bf16_t* Hb = (bf16_t*)(ws + WS_H); (void)mod; (void)Hb;

    if (IN(0)) { PHASE_VARS p0_prologue(F, p); } SEAM(0);
    if (IN(1)) { PHASE_VARS p_norm1_in(F, p); } SEAM(1);
    if (IN(2)) { PHASE_VARS
        pg8::Gemm g{Hb, (const bf16_t*)(ws + WS_WIN), DM, 0, 0}; pg8::GOrder S; S.init(NR / 256, 8, 1, F.G, (int)blockIdx.x);
        pg8::EpiWin E{(bf16_t*)(ws + WS_ACT + ACT_Z)}; pg8::gemm_phase(F.lds, g, S, E); } SEAM(2);
    if (IN(3)) { PHASE_VARS p_lru(F, p, false); p_cm(F, p); } SEAM(3);
    if (IN(4)) { PHASE_VARS p_lru(F, p, true); } SEAM(4);
    if (IN(5)) { PHASE_VARS
        pg8::Gemm g{(const bf16_t*)(ws + WS_ACT + ACT_YCAT), (const bf16_t*)(ws + WS_WOUT0), DM, 0, 0}; pg8::GOrder S; S.init(NR / 256, 4, 1, F.G, (int)blockIdx.x);
        pg8::EpiRes E{(float*)(ws + WS_X), p.in[I_X], p.in[I_CTX], mod + 2 * DM, 0}; pg8::gemm_phase(F.lds, g, S, E); } SEAM(5);
    if (IN(6)) { PHASE_VARS p_norm2_router(F, p, 0, true); } SEAM(6);
    if (IN(7)) { PHASE_VARS p_select(F, p, true); } SEAM(7);
    if (IN(8)) { PHASE_VARS
        pg8::Gemm g{(const bf16_t*)(ws + WS_XS), (const bf16_t*)(ws + WS_W13), DM, (size_t)EROWS * DM * 2, (size_t)4096 * DM * 2}; pg8::GOrder S; S.init(9, 16, NE, F.G, (int)blockIdx.x);
        pg8::EpiSwiGLU E{(bf16_t*)(ws + WS_ACT + ACT_HID)}; pg8::gemm_phase(F.lds, g, S, E); } SEAM(8);
    if (IN(9)) { PHASE_VARS
        pg8::Gemm g{(const bf16_t*)(ws + WS_ACT + ACT_HID), (const bf16_t*)(ws + WS_W2), FF, (size_t)EROWS * FF * 2, (size_t)DM * FF * 2}; pg8::GOrder S; S.init(9, 4, NE, F.G, (int)blockIdx.x);
        pg8::EpiMoeOut E{(bf16_t*)(ws + WS_XS), (const float*)(ws + WS_GATE)}; pg8::gemm_phase(F.lds, g, S, E); } SEAM(9);
    if (IN(10)) { PHASE_VARS p_combine(F, p, 0, false); } SEAM(10);
    if (IN(11)) { PHASE_VARS
        pg8::Gemm g{Hb, (const bf16_t*)(ws + WS_WQKV), DM, 0, 0}; pg8::GOrder S; S.init(NR / 256, 12, 1, F.G, (int)blockIdx.x);
        pg8::EpiQKV E{(bf16_t*)(ws + WS_ACT + ACT_Q), (const float*)(ws + WS_ROPE)}; pg8::gemm_phase(F.lds, g, S, E); } SEAM(11);
    if (IN(12)) { PHASE_VARS p_attn(F, p, lds); } SEAM(12);
    if (IN(13)) { PHASE_VARS p_attn_combine(F, p); } SEAM(13);
    if (IN(14)) { PHASE_VARS
        pg8::Gemm g{(const bf16_t*)(ws + WS_ACT + ACT_A), (const bf16_t*)(ws + WS_WOUT1), DM, 0, 0}; pg8::GOrder S; S.init(NLAT / 256, 4, 1, F.G, (int)blockIdx.x);
        pg8::EpiRes E{(float*)(ws + WS_X), nullptr, nullptr, mod + 3 * 6144 + 2 * DM, 1}; pg8::gemm_phase(F.lds, g, S, E); } SEAM(14);
    if (IN(15)) { PHASE_VARS p_norm2_router(F, p, 1, false); } SEAM(15);
    if (IN(16)) { PHASE_VARS p_select(F, p, false); } SEAM(16);
    if (IN(17)) { PHASE_VARS
        pg8::Gemm g{(const bf16_t*)(ws + WS_XS), (const bf16_t*)(ws + WS_W13) + (size_t)NE * 4096 * DM, DM, (size_t)EROWS * DM * 2, (size_t)4096 * DM * 2}; pg8::GOrder S; S.init(8, 16, NE, F.G, (int)blockIdx.x);
        pg8::EpiSwiGLU E{(bf16_t*)(ws + WS_ACT + ACT_HID)}; pg8::gemm_phase(F.lds, g, S, E); } SEAM(17);
    if (IN(18)) { PHASE_VARS
        pg8::Gemm g{(const bf16_t*)(ws + WS_ACT + ACT_HID), (const bf16_t*)(ws + WS_W2) + (size_t)NE * DM * FF, FF, (size_t)EROWS * FF * 2, (size_t)DM * FF * 2}; pg8::GOrder S; S.init(8, 4, NE, F.G, (int)blockIdx.x);
        pg8::EpiMoeOut E{(bf16_t*)(ws + WS_XS), (const float*)(ws + WS_GATE)}; pg8::gemm_phase(F.lds, g, S, E); } SEAM(18);
    if (IN(19)) { PHASE_VARS p_combine(F, p, 1, true); }
#undef IN
#undef SEAM
}

extern "C" void kernel_launch(void* const* d_in, const int* in_sizes, int n_in, void* d_out, int out_size, void* d_ws, size_t ws_size, hipStream_t stream) {
    static int grid = 0;
    if (grid == 0) {
        if (n_in != 32 || out_size != NLAT * DM || ws_size < WS_END) { fprintf(stderr, "kernel_launch: unexpected problem (n_in %d, out %d, ws %zu)\n", n_in, out_size, ws_size); grid = -1; return; }
        int dev = 0, cus = 0, per_cu = 0;
        if (hipGetDevice(&dev) != hipSuccess || hipDeviceGetAttribute(&cus, hipDeviceAttributeMultiprocessorCount, dev) != hipSuccess) { grid = -1; return; }
        if (hipFuncSetAttribute((const void*)mk_fwd, hipFuncAttributeMaxDynamicSharedMemorySize, LDS_BYTES) != hipSuccess) { fprintf(stderr, "kernel_launch: hipFuncSetAttribute failed\n"); grid = -1; return; }
        if (hipOccupancyMaxActiveBlocksPerMultiprocessor(&per_cu, (const void*)mk_fwd, NWAVES * 64, LDS_BYTES) != hipSuccess || per_cu < 1) { fprintf(stderr, "kernel_launch: occupancy query says %d\n", per_cu); per_cu = 1; }
        (void)hipGetLastError();
        grid = cus;
    }
    if (grid < 0) return;
    Params a{};
    for (int i = 0; i < 32; ++i) a.in[i] = (const float*)d_in[i];
    a.out = (float*)d_out; a.ws = (unsigned char*)d_ws;
#if MK_N_LAUNCHES == 1
    a.ph_lo = 0; a.ph_hi = NPH;
    void* args[] = {&a};
    hipError_t e = hipLaunchCooperativeKernel((const void*)mk_fwd, dim3(grid), dim3(NWAVES * 64), args, LDS_BYTES, stream);
    if (e != hipSuccess) fprintf(stderr, "kernel_launch: cooperative launch failed: %s (grid %d)\n", hipGetErrorString(e), grid);
#else
    for (int ph = 0; ph < NPH; ++ph) { a.ph_lo = ph; a.ph_hi = ph + 1; hipLaunchKernelGGL(mk_fwd, dim3(grid), dim3(NWAVES * 64), LDS_BYTES, stream, a); }
#endif
}
```

```cpp
#include <hip/hip_runtime.h>
#include <hip/hip_cooperative_groups.h>
#include <hip/hip_bf16.h>
#include <cstdio>
#include <cstdint>
#include <cmath>
namespace cg = cooperative_groups;

#ifndef MK_N_LAUNCHES
#define MK_N_LAUNCHES 1
#endif

constexpr int DM = 1024, NB = 2, SEQ = 8192, CTXL = 256, LR = SEQ + CTXL, NR = NB * LR, NLAT = NB * SEQ;
constexpr int NE = 16, FF = 2048, EROWS = 2304;
constexpr float EPS = 1e-6f;
constexpr int NTILE64 = NR / 64;
constexpr int NPH = 20;

constexpr size_t MiB = 1u << 20;
constexpr size_t WS_CTL = 0, WS_MOD = 1 * MiB, WS_ROPE = 2 * MiB, WS_LRUW = 4 * MiB, WS_CMWS = 4 * MiB + 512 * 1024, WS_SUM = 5 * MiB, WS_AFF = 8 * MiB, WS_INV = 10 * MiB,
                 WS_GATE = 12 * MiB, WS_WIN = 14 * MiB, WS_WOUT0 = 18 * MiB, WS_WQKV = 20 * MiB, WS_WOUT1 = 26 * MiB, WS_W13 = 32 * MiB, WS_W2 = 288 * MiB, WS_H = 416 * MiB,
                 WS_X = 450 * MiB, WS_XS = 516 * MiB, WS_ACT = 588 * MiB, WS_END = 758 * MiB;
static_assert(true, "");
constexpr size_t ACT_Z = 0, ACT_YCAT = 66 * MiB, ACT_HID = 0, ACT_Q = 0, ACT_K = 33 * MiB, ACT_V = 66 * MiB, ACT_O1 = 99 * MiB, ACT_O2 = 131 * MiB, ACT_A = 0;

#define GAS __attribute__((address_space(1)))
#define LAS __attribute__((address_space(3)))
typedef unsigned short bf16_t;
typedef short bf16x8 __attribute__((ext_vector_type(8)));
typedef float f32x4 __attribute__((ext_vector_type(4)));
typedef float f32x2 __attribute__((ext_vector_type(2)));
typedef unsigned u32x4 __attribute__((ext_vector_type(4)));
typedef unsigned u32x2 __attribute__((ext_vector_type(2)));

__device__ __forceinline__ unsigned f2bf(float f) { unsigned u = __builtin_bit_cast(unsigned, f); return (u + 0x7fffu + ((u >> 16) & 1u)) >> 16; }
__device__ __forceinline__ unsigned pk2(float lo, float hi) { return f2bf(lo) | (f2bf(hi) << 16); }
__device__ __forceinline__ float bf2f(unsigned short b) { return __builtin_bit_cast(float, (unsigned)b << 16); }
__device__ __forceinline__ float bflo(unsigned w) { return __builtin_bit_cast(float, w << 16); }
__device__ __forceinline__ float bfhi(unsigned w) { return __builtin_bit_cast(float, w & 0xffff0000u); }
__device__ __forceinline__ float gelu_tanh(float x) {
    const float u2 = 2.0f * 0.7978845608028654f * (x + 0.044715f * x * x * x);
    const float e = __builtin_amdgcn_exp2f(u2 * 1.4426950408889634f);
    return x - x * __builtin_amdgcn_rcpf(1.0f + e);
}
__device__ __forceinline__ float silu_f(float a) { return a * __builtin_amdgcn_rcpf(1.0f + __builtin_amdgcn_exp2f(-a * 1.4426950408889634f)); }
__device__ __forceinline__ float sigmoid_f(float a) { return 1.0f / (1.0f + __expf(-a)); }

namespace pg8 {
#define PG8_LAS __attribute__((address_space(3)))
constexpr int BM = 256, BK = 64, HALF = 128, HTB = HALF * BK * 2, STAGE_BYTES = 8 * HTB, NXCD = 8, WGM = 8;
__host__ __device__ __forceinline__ int lds_byte(int r, int c) { const int st = (r >> 4) * 2 + (c >> 5), rr = r & 15, cc = c & 31, ob = rr * 64 + cc * 2; return st * 1024 + (ob ^ (((ob >> 9) & 1) << 5)); }
__host__ __device__ __forceinline__ void stage_rc(int b, int& R, int& C) { const int st = b / 1024, sb = b % 1024, swz = sb ^ (((sb >> 9) & 1) << 5); R = (st >> 1) * 16 + swz / 64; C = (st & 1) * 32 + (swz % 64) / 2; }
__host__ __device__ __forceinline__ int perm32(int rho) { const int n = rho >> 4, i = rho & 15; return 8 * (i >> 2) + 4 * n + (i & 3); }

struct Unit { int pm, pn, grp; };
struct Gemm { const bf16_t* A; const bf16_t* Bt; int K; size_t ga, gb; };

struct GOrder {
    int nM, nN, upg, nwg, G, c;
    __device__ void init(int nM_, int nN_, int ngrp, int G_, int c_) { nM = nM_; nN = nN_; upg = nM * nN; nwg = upg * ngrp; G = G_; c = c_; }
    __device__ bool next(int i, Unit& u) const {
        const long L = (long)i * G + c; if (L >= nwg) return false;
        int wgid = (int)L; { const int q = nwg / NXCD, r = nwg % NXCD, xcd = wgid % NXCD, off = wgid / NXCD; wgid = (xcd < r ? xcd * (q + 1) : r * (q + 1) + (xcd - r) * q) + off; }
        u.grp = wgid / upg; const int w = wgid % upg;
        const int nig = WGM * nN, gid = w / nig, fm = gid * WGM, gsz = (nM - fm) < WGM ? (nM - fm) : WGM;
        u.pm = fm + ((w % nig) % gsz); u.pn = (w % nig) / gsz; return true;
    }
};

__device__ __forceinline__ unsigned cvt_pk_bf16(float lo, float hi) { unsigned r; asm volatile("v_cvt_pk_bf16_f32 %0, %1, %2" : "=v"(r) : "v"(lo), "v"(hi)); return r; }

template <class Epi, class Sched>
__device__ __forceinline__ void gemm_phase(PG8_LAS unsigned char* lds, const Gemm g, const Sched& S, const Epi& E) {
    const int tid = threadIdx.x, wid = __builtin_amdgcn_readfirstlane(tid >> 6), lane = tid & 63, wr = wid >> 2, wc = wid & 3, fr = lane & 15, fq = lane >> 4;
    const int K = g.K, nt = K / BK;
    unsigned voffA[2], voffB[2];
#pragma unroll
    for (int i = 0; i < 2; ++i) { int R, C; stage_rc(tid * 16 + i * 8192, R, C); const int Rb = (R & ~31) + perm32(R & 31);
        voffA[i] = (unsigned)(R * K + C) * 2u; voffB[i] = (unsigned)(Rb * K + C) * 2u; }
    const size_t kstep = (size_t)(BK * 2);
    const size_t hstep = (size_t)HALF * K * 2;
    const size_t tstep = 2 * hstep;
    const unsigned ldsw = (unsigned)wid * 1024u;
    const int aoff = lds_byte(wr * 64 + fr, fq * 8), boff = lds_byte(wc * 32 + fr, fq * 8);
#define PG8_SA(b, h) (((b) * 2 + (h)) * HTB)
#define PG8_SB(b, h) ((4 + (b) * 2 + (h)) * HTB)
#define PG8_STAGE(bufoff, gbase, voff) do { _Pragma("unroll") for (int _i = 0; _i < 2; ++_i) \
        __builtin_amdgcn_global_load_lds((const unsigned*)((const char*)(gbase) + (voff)[_i]), (PG8_LAS unsigned*)(lds + (bufoff) + ldsw + _i * 8192), 16, 0, 0); } while (0)
#define PG8_LDA(dst, b, h) do { _Pragma("unroll") for (int m = 0; m < 4; ++m) _Pragma("unroll") for (int k = 0; k < 2; ++k) dst[m][k] = *(const PG8_LAS bf16x8*)(lds + PG8_SA(b, h) + aoff + m * 2048 + k * 1024); } while (0)
#define PG8_LDB(dst, b, h) do { _Pragma("unroll") for (int n = 0; n < 2; ++n) _Pragma("unroll") for (int k = 0; k < 2; ++k) dst[n][k] = *(const PG8_LAS bf16x8*)(lds + PG8_SB(b, h) + boff + n * 2048 + k * 1024); } while (0)
#define PG8_MMA(ai, bj, At, Bt) do { __builtin_amdgcn_s_setprio(1); _Pragma("unroll") for (int m = 0; m < 4; ++m) _Pragma("unroll") for (int n = 0; n < 2; ++n) _Pragma("unroll") for (int k = 0; k < 2; ++k) \
        acc[ai][bj][m][n] = __builtin_amdgcn_mfma_f32_16x16x32_bf16(Bt[n][k], At[m][k], acc[ai][bj][m][n], 0, 0, 0); __builtin_amdgcn_s_setprio(0); } while (0)
#define PG8_WAIT_V(n) asm volatile("s_waitcnt vmcnt(" #n ")" ::: "memory")
#define PG8_WAIT_L(n) asm volatile("s_waitcnt lgkmcnt(" #n ")" ::: "memory")
#define PG8_BAR __builtin_amdgcn_s_barrier()
#define PG8_SCHED __builtin_amdgcn_sched_barrier(0)
    Unit cur, nxt; int ui = 0;
    if (!S.next(0, cur)) return;
    f32x4 acc[2][2][4][2];
#pragma unroll
    for (int a = 0; a < 2; ++a)
#pragma unroll
        for (int b = 0; b < 2; ++b)
#pragma unroll
            for (int m = 0; m < 4; ++m)
#pragma unroll
                for (int n = 0; n < 2; ++n) acc[a][b][m][n] = (f32x4){0.f, 0.f, 0.f, 0.f};
    bf16x8 At[4][2], B0[2][2], B1[2][2];
    const char* cA = (const char*)g.A + (size_t)cur.grp * g.ga + (size_t)cur.pm * tstep; const char* cB = (const char*)g.Bt + (size_t)cur.grp * g.gb + (size_t)cur.pn * tstep;
    PG8_STAGE(PG8_SB(0, 0), cB, voffB); PG8_STAGE(PG8_SB(0, 1), cB + hstep, voffB); PG8_STAGE(PG8_SA(0, 0), cA, voffA); PG8_STAGE(PG8_SA(0, 1), cA + hstep, voffA);
    if (wr == 1) PG8_BAR;
    PG8_WAIT_V(2); PG8_BAR;
    PG8_STAGE(PG8_SB(1, 0), cB + kstep, voffB); PG8_STAGE(PG8_SA(1, 0), cA + kstep, voffA); PG8_STAGE(PG8_SB(1, 1), cB + hstep + kstep, voffB);
    PG8_WAIT_V(6); PG8_BAR;
    for (;;) {
        const bool has_next = S.next(ui + 1, nxt);
        const char* nA = has_next ? (const char*)g.A + (size_t)nxt.grp * g.ga + (size_t)nxt.pm * tstep : cA; const char* nB = has_next ? (const char*)g.Bt + (size_t)nxt.grp * g.gb + (size_t)nxt.pn * tstep : cB;
        for (int t = 0; t < nt; t += 2) {
            const bool last = (t == nt - 2);
            const char* a1 = cA + (size_t)(t + 1) * kstep;
            const char* a2 = last ? nA : cA + (size_t)(t + 2) * kstep; const char* b2 = last ? nB : cB + (size_t)(t + 2) * kstep;
            const char* a3 = a2 + kstep; const char* b3 = b2 + kstep;
            PG8_LDB(B0, 0, 0); PG8_LDB(B1, 0, 1); PG8_SCHED; PG8_LDA(At, 0, 0); PG8_STAGE(PG8_SA(1, 1), a1 + hstep, voffA);
            PG8_WAIT_V(8); PG8_WAIT_L(0); PG8_BAR; PG8_MMA(0, 0, At, B0); PG8_MMA(0, 1, At, B1); PG8_BAR; PG8_SCHED;
            PG8_LDA(At, 0, 1); PG8_STAGE(PG8_SB(0, 0), b2, voffB); PG8_STAGE(PG8_SB(0, 1), b2 + hstep, voffB); PG8_STAGE(PG8_SA(0, 0), a2, voffA);
            PG8_WAIT_V(8); PG8_WAIT_L(0); PG8_BAR; PG8_MMA(1, 0, At, B0); PG8_MMA(1, 1, At, B1); PG8_BAR; PG8_SCHED;
            PG8_LDB(B0, 1, 0); PG8_LDB(B1, 1, 1); PG8_SCHED; PG8_LDA(At, 1, 0); PG8_STAGE(PG8_SA(0, 1), a2 + hstep, voffA);
            PG8_WAIT_V(8); PG8_WAIT_L(0); PG8_BAR; PG8_MMA(0, 0, At, B0); PG8_MMA(0, 1, At, B1); PG8_BAR; PG8_SCHED;
            PG8_LDA(At, 1, 1); PG8_STAGE(PG8_SB(1, 0), b3, voffB); PG8_STAGE(PG8_SB(1, 1), b3 + hstep, voffB); PG8_STAGE(PG8_SA(1, 0), a3, voffA);
            PG8_WAIT_V(8); PG8_WAIT_L(0); PG8_BAR; PG8_MMA(1, 0, At, B0); PG8_MMA(1, 1, At, B1); PG8_BAR; PG8_SCHED;
        }
        if (wr == 0) PG8_BAR;
        E(acc, cur, wr, wc, fr, fq);
        if (!has_next) break;
#pragma unroll
        for (int a = 0; a < 2; ++a)
#pragma unroll
            for (int b = 0; b < 2; ++b)
#pragma unroll
                for (int m = 0; m < 4; ++m)
#pragma unroll
                    for (int n = 0; n < 2; ++n) acc[a][b][m][n] = (f32x4){0.f, 0.f, 0.f, 0.f};
        cur = nxt; cA = nA; cB = nB; ++ui;
        if (wr == 1) PG8_BAR;
    }
    PG8_WAIT_V(0);
    PG8_BAR;
#undef PG8_SA
#undef PG8_SB
#undef PG8_STAGE
#undef PG8_LDA
#undef PG8_LDB
#undef PG8_MMA
#undef PG8_WAIT_V
#undef PG8_WAIT_L
#undef PG8_BAR
#undef PG8_SCHED
}

struct EpiWin {
    bf16_t* Z;
    __device__ __forceinline__ void operator()(const f32x4 (&acc)[2][2][4][2], const Unit& u, int wr, int wc, int fr, int fq) const {
        const int row0 = u.pm * BM + wr * 64 + fr, col0 = u.pn * BM + wc * 32 + 8 * fq; const bool act = (u.pn < 2) || (u.pn >= 4);
#pragma unroll
        for (int ai = 0; ai < 2; ++ai)
#pragma unroll
            for (int m = 0; m < 4; ++m) { bf16_t* rowp = Z + (size_t)(row0 + ai * HALF + m * 16) * 2048 + col0;
#pragma unroll
                for (int bj = 0; bj < 2; ++bj) { f32x4 v0 = acc[ai][bj][m][0], v1 = acc[ai][bj][m][1];
                    if (act) {
#pragma unroll
                        for (int i = 0; i < 4; ++i) { v0[i] = gelu_tanh(v0[i]); v1[i] = gelu_tanh(v1[i]); } }
                    u32x4 w; w.x = cvt_pk_bf16(v0[0], v0[1]); w.y = cvt_pk_bf16(v0[2], v0[3]); w.z = cvt_pk_bf16(v1[0], v1[1]); w.w = cvt_pk_bf16(v1[2], v1[3]);
                    *(u32x4*)(rowp + bj * HALF) = w; } }
    }
};
struct EpiRes {
    float* X; const float* xin; const float* cin; const float* g1; int mode;
    __device__ __forceinline__ void operator()(const f32x4 (&acc)[2][2][4][2], const Unit& u, int wr, int wc, int fr, int fq) const {
        const float* basep; float* outp; int rt;
        if (mode == 0) { const int b = u.pm / 33, jt = u.pm % 33; outp = X + (size_t)u.pm * BM * DM;
            if (jt == 0) { basep = cin + (size_t)b * CTXL * DM; rt = 2; } else { basep = xin + ((size_t)b * SEQ + (size_t)(jt - 1) * BM) * DM; rt = b; } }
        else { const int b = u.pm / 32, t0 = (u.pm % 32) * BM; outp = X + ((size_t)b * LR + CTXL + t0) * DM; basep = outp; rt = b; }
        const int rr0 = wr * 64 + fr, col0 = u.pn * BM + wc * 32 + 8 * fq;
        f32x4 gv[2][2];
#pragma unroll
        for (int bj = 0; bj < 2; ++bj)
#pragma unroll
            for (int n = 0; n < 2; ++n) gv[bj][n] = *(const f32x4*)(g1 + (size_t)rt * 6144 + col0 + bj * HALF + 4 * n);
#pragma unroll
        for (int ai = 0; ai < 2; ++ai)
#pragma unroll
            for (int m = 0; m < 4; ++m) { const size_t off = (size_t)(rr0 + ai * HALF + m * 16) * DM + col0;
#pragma unroll
                for (int bj = 0; bj < 2; ++bj)
#pragma unroll
                    for (int n = 0; n < 2; ++n) { const f32x4 bs = *(const f32x4*)(basep + off + bj * HALF + 4 * n);
                        *(f32x4*)(outp + off + bj * HALF + 4 * n) = bs + gv[bj][n] * acc[ai][bj][m][n]; } }
    }
};
constexpr float C2 = 0.125f * 1.4426950408889634f;
struct EpiQKV {
    bf16_t* Q; const float* cs;
    __device__ __forceinline__ void operator()(const f32x4 (&acc)[2][2][4][2], const Unit& u, int wr, int wc, int fr, int fq) const {
        const int b = u.pm / 33, jt = u.pm % 33; const bool lat = jt != 0; const int t0 = (jt - 1) * BM;
        const int sec = u.pn >> 2; bf16_t* dst = Q + (size_t)sec * ((ACT_K - ACT_Q) / 2);
        const int rr0 = wr * 64 + fr, colt = (u.pn & 3) * BM + wc * 32 + 8 * fq; const float sc = sec == 0 ? C2 : 1.0f; const bool rope = lat && sec < 2;
#pragma unroll
        for (int ai = 0; ai < 2; ++ai)
#pragma unroll
            for (int m = 0; m < 4; ++m) { const int rr = rr0 + ai * HALF + m * 16; bf16_t* rowp = dst + ((size_t)u.pm * BM + rr) * DM + colt;
#pragma unroll
                for (int bj = 0; bj < 2; ++bj) { f32x4 v0 = acc[ai][bj][m][0], v1 = acc[ai][bj][m][1];
                    if (rope) { const int p0 = ((colt + bj * HALF) & 63) >> 1; const float* cp = cs + ((size_t)(t0 + rr) * 32 + p0) * 2;
                        const f32x4 c01 = *(const f32x4*)cp, c23 = *(const f32x4*)(cp + 4);
                        const float a0 = v0[0] * c01[0] - v0[1] * c01[1], a1 = v0[0] * c01[1] + v0[1] * c01[0];
                        const float a2 = v0[2] * c01[2] - v0[3] * c01[3], a3 = v0[2] * c01[3] + v0[3] * c01[2];
                        const float b0 = v1[0] * c23[0] - v1[1] * c23[1], b1 = v1[0] * c23[1] + v1[1] * c23[0];
                        const float b2 = v1[2] * c23[2] - v1[3] * c23[3], b3 = v1[2] * c23[3] + v1[3] * c23[2];
                        v0 = (f32x4){a0, a1, a2, a3}; v1 = (f32x4){b0, b1, b2, b3}; }
                    v0 = v0 * sc; v1 = v1 * sc;
                    u32x4 w; w.x = cvt_pk_bf16(v0[0], v0[1]); w.y = cvt_pk_bf16(v0[2], v0[3]); w.z = cvt_pk_bf16(v1[0], v1[1]); w.w = cvt_pk_bf16(v1[2], v1[3]);
                    *(u32x4*)(rowp + bj * HALF) = w; }
                asm volatile("" ::: "memory"); }
        (void)b;
    }
};
struct EpiSwiGLU {
    bf16_t* HID;
    __device__ __forceinline__ void operator()(const f32x4 (&acc)[2][2][4][2], const Unit& u, int wr, int wc, int fr, int fq) const {
        const int row0 = u.pm * BM + wr * 64 + fr, f0 = u.pn * 128 + wc * 16 + 4 * fq;
#pragma unroll
        for (int ai = 0; ai < 2; ++ai)
#pragma unroll
            for (int m = 0; m < 4; ++m) { bf16_t* rowp = HID + ((size_t)u.grp * EROWS + row0 + ai * HALF + m * 16) * FF + f0;
#pragma unroll
                for (int bj = 0; bj < 2; ++bj) { const f32x4 a = acc[ai][bj][m][0], bb = acc[ai][bj][m][1];
                    u32x2 w; w.x = cvt_pk_bf16(silu_f(a[0]) * bb[0], silu_f(a[1]) * bb[1]); w.y = cvt_pk_bf16(silu_f(a[2]) * bb[2], silu_f(a[3]) * bb[3]);
                    *(u32x2*)(rowp + bj * 64) = w; } }
    }
};
struct EpiMoeOut {
    bf16_t* YB; const float* gate;
    __device__ __forceinline__ void operator()(const f32x4 (&acc)[2][2][4][2], const Unit& u, int wr, int wc, int fr, int fq) const {
        const int row0 = u.pm * BM + wr * 64 + fr, col0 = u.pn * BM + wc * 32 + 8 * fq;
#pragma unroll
        for (int ai = 0; ai < 2; ++ai)
#pragma unroll
            for (int m = 0; m < 4; ++m) { const size_t er = (size_t)u.grp * EROWS + row0 + ai * HALF + m * 16; const float gt = gate[er]; bf16_t* rowp = YB + er * DM + col0;
#pragma unroll
                for (int bj = 0; bj < 2; ++bj) { const f32x4 v0 = acc[ai][bj][m][0] * gt, v1 = acc[ai][bj][m][1] * gt;
                    u32x4 w; w.x = cvt_pk_bf16(v0[0], v0[1]); w.y = cvt_pk_bf16(v0[2], v0[3]); w.z = cvt_pk_bf16(v1[0], v1[1]); w.w = cvt_pk_bf16(v1[2], v1[3]);
                    *(u32x4*)(rowp + bj * HALF) = w; } }
    }
};
}

namespace attn_body {
using bf16=__hip_bfloat16;
using s16x4=__attribute__((ext_vector_type(4)))short;
using f32x16=__attribute__((ext_vector_type(16)))float;
constexpr int D=64,PITCH=1024;
constexpr int NW=8,QBLK=32,QB=QBLK*NW,KVBLK=64;
constexpr int NT=LR/KVBLK;
__device__ __forceinline__ int crow(int r,int hi){return (r&3)+8*(r>>2)+4*hi;}
#define SBAR() __builtin_amdgcn_sched_barrier(0)
constexpr int NSLOT=3, SLOTB=8192;
constexpr int LDS_K=0, LDS_V=NSLOT*SLOTB, LDS_WS=2*NSLOT*SLOTB, LDS_OST=LDS_WS+NW*64*4, LDS_BYTES=LDS_OST+NW*4096;
__device__ __forceinline__ void glds16(const void*gsrc,unsigned lds_dst){unsigned keep;
  asm volatile("s_mov_b32 %0, m0\n\ts_mov_b32 m0, %2\n\ts_nop 0\n\tglobal_load_lds_dwordx4 %1, off\n\ts_mov_b32 m0, %0":"=&s"(keep):"v"(gsrc),"s"(lds_dst):"memory");}
__device__ __forceinline__ float max3f(float a,float b,float c){float r;asm("v_max3_f32 %0, %1, %2, %3":"=v"(r):"v"(a),"v"(b),"v"(c));return r;}
__device__ __forceinline__ float max2f(float a,float b){float r;asm("v_max_f32_e32 %0, %1, %2":"=v"(r):"v"(a),"v"(b));return r;}
__device__ __forceinline__ float fadd_s(float a,float b){float r;asm("v_add_f32_e32 %0, %1, %2":"=v"(r):"v"(a),"v"(b));return r;}
__device__ __forceinline__ float fsub_s(float a,float b){float r;asm("v_sub_f32_e32 %0, %1, %2":"=v"(r):"v"(a),"v"(b));return r;}
typedef float f32x2_t __attribute__((ext_vector_type(2))); typedef __bf16 bf16x2_t __attribute__((ext_vector_type(2)));
__device__ __forceinline__ unsigned cvtpk_s(float lo,float hi){f32x2_t v={lo,hi};bf16x2_t b=__builtin_convertvector(v,bf16x2_t);return __builtin_bit_cast(unsigned,b);}
#define WAIT_BAR(N) asm volatile("s_waitcnt vmcnt(" #N ") lgkmcnt(0)\n\ts_barrier":::"memory")
__device__ __forceinline__ void qkt(f32x16&p0,f32x16&p1,const char*Kslot,const bf16x8*qr,const f32x16&negm,int r32,int hi){
  const char*kb=Kslot+hi*1024+r32*16;
  #pragma unroll
  for(int d0=0;d0<4;++d0){
    const bf16x8 b0=*reinterpret_cast<const bf16x8*>(kb+d0*2048);
    const bf16x8 b1=*reinterpret_cast<const bf16x8*>(kb+d0*2048+512);
    if(d0==0){p0=__builtin_amdgcn_mfma_f32_32x32x16_bf16(b0,qr[0],negm,0,0,0);p1=__builtin_amdgcn_mfma_f32_32x32x16_bf16(b1,qr[0],negm,0,0,0);}
    else{p0=__builtin_amdgcn_mfma_f32_32x32x16_bf16(b0,qr[d0],p0,0,0,0);p1=__builtin_amdgcn_mfma_f32_32x32x16_bf16(b1,qr[d0],p1,0,0,0);}}
}
typedef __attribute__((address_space(3))) const char* lds_cptr;
typedef short v4i16_t __attribute__((ext_vector_type(4)));
__device__ __forceinline__ void kload8(bf16x8*kf,lds_cptr kp){
  kf[0]=*(const __attribute__((address_space(3))) bf16x8*)(kp);      kf[1]=*(const __attribute__((address_space(3))) bf16x8*)(kp+512);
  kf[2]=*(const __attribute__((address_space(3))) bf16x8*)(kp+2048); kf[3]=*(const __attribute__((address_space(3))) bf16x8*)(kp+2560);
  kf[4]=*(const __attribute__((address_space(3))) bf16x8*)(kp+4096); kf[5]=*(const __attribute__((address_space(3))) bf16x8*)(kp+4608);
  kf[6]=*(const __attribute__((address_space(3))) bf16x8*)(kp+6144); kf[7]=*(const __attribute__((address_space(3))) bf16x8*)(kp+6656);
}
__device__ __forceinline__ void kload2(bf16x8*kf,lds_cptr kp,int j){ kf[2*j]=*(const __attribute__((address_space(3))) bf16x8*)(kp+j*2048); kf[2*j+1]=*(const __attribute__((address_space(3))) bf16x8*)(kp+j*2048+512); }
__device__ __forceinline__ s16x4 vtr(lds_cptr p){ return __builtin_bit_cast(s16x4,__builtin_amdgcn_ds_read_tr16_b64_v4i16((__attribute__((address_space(3))) v4i16_t*)p)); }
__device__ __forceinline__ float rowmax(const f32x16&p0,const f32x16&p1){
  float a=max3f(p0[0],p0[1],p1[0]),b=max3f(p0[2],p0[3],p1[1]);a=max3f(a,p1[2],p1[3]);
  #pragma unroll
  for(int r=4;r<16;r+=4){a=max3f(a,p0[r],p0[r+1]);b=max3f(b,p0[r+2],p0[r+3]);a=max3f(a,p1[r],p1[r+1]);b=max3f(b,p1[r+2],p1[r+3]);}
  const float m=max2f(a,b);
  auto rr=__builtin_amdgcn_permlane32_swap(__float_as_uint(m),__float_as_uint(m),false,false);
  return max2f(__uint_as_float(rr[0]),__uint_as_float(rr[1]));
}
__device__ __forceinline__ void pv(f32x16*o,int vb,bf16x8 pa0,bf16x8 pa1,bf16x8 pa2,bf16x8 pa3){
  #pragma unroll
  for(int d0=0;d0<2;++d0){s16x4 lo[4],hi[4];
    #pragma unroll
    for(int ks=0;ks<4;++ks){
      asm volatile("ds_read_b64_tr_b16 %0,%1 offset:%c2":"=&v"(lo[ks]):"v"(vb),"i"(d0*4096+ks*1024):"memory");
      asm volatile("ds_read_b64_tr_b16 %0,%1 offset:%c2":"=&v"(hi[ks]):"v"(vb),"i"(d0*4096+ks*1024+512):"memory");}
    asm volatile("s_waitcnt lgkmcnt(0)":::"memory");SBAR();
    #define PK(k) (bf16x8){lo[k][0],lo[k][1],lo[k][2],lo[k][3],hi[k][0],hi[k][1],hi[k][2],hi[k][3]}
    o[d0]=__builtin_amdgcn_mfma_f32_32x32x16_bf16(pa0,PK(0),o[d0],0,0,0);
    o[d0]=__builtin_amdgcn_mfma_f32_32x32x16_bf16(pa1,PK(1),o[d0],0,0,0);
    o[d0]=__builtin_amdgcn_mfma_f32_32x32x16_bf16(pa2,PK(2),o[d0],0,0,0);
    o[d0]=__builtin_amdgcn_mfma_f32_32x32x16_bf16(pa3,PK(3),o[d0],0,0,0);
    #undef PK
  }
}
template<int THRL> __device__ __forceinline__ void attn_unit(const bf16*Qw,const bf16*__restrict__ Kh,const bf16*__restrict__ Vh,bf16*Ow,char*shm){
  const int tid=threadIdx.x,lane=tid&63,r32=lane&31,hi=lane>>5; const int wid=__builtin_amdgcn_readfirstlane(tid>>6);
  constexpr int DMp=PITCH;
  const unsigned lds0=(unsigned)(uintptr_t)shm;
  float*wsf=(float*)(shm+LDS_WS)+wid*64;
  const bf16*ksrc=Kh+(long)lane*DMp+wid*8;
  const bf16*vsrc=Vh+(long)(16*(wid&3)+(lane>>2))*DMp+(wid>>2)*32+(lane&3)*8;
  const unsigned kdst=lds0+LDS_K+wid*1024, vdst=lds0+LDS_V+wid*1024;
  #define DMA_K(t,slot) glds16(ksrc+(long)(t)*KVBLK*DMp,(unsigned)__builtin_amdgcn_readfirstlane(kdst+(slot)))
  #define DMA_V(t,slot) glds16(vsrc+(long)(t)*KVBLK*DMp,(unsigned)__builtin_amdgcn_readfirstlane(vdst+(slot)))
  const int vb0=(int)(lds0+LDS_V)+((lane>>4)&1)*32+(lane&3)*8+(4*hi+((lane&15)>>2))*64;
  const char*Kbase=shm+LDS_K; bf16x8 kf[8];
  const lds_cptr shm3=(lds_cptr)shm; const lds_cptr kp0=shm3+LDS_K+hi*1024+r32*16; const lds_cptr vp0=shm3+LDS_V+((lane>>4)&1)*32+(lane&3)*8+(4*hi+((lane&15)>>2))*64;
  DMA_K(0,0);DMA_V(0,0);DMA_K(1,SLOTB);
  bf16x8 qr[4];
  #pragma unroll
  for(int d0=0;d0<4;++d0)qr[d0]=*reinterpret_cast<const bf16x8*>(&Qw[(long)r32*DMp+d0*16+hi*8]);
  float mhat=0.f,l_reg=0.f;f32x16 o[2];o[0]=f32x16{};o[1]=f32x16{};f32x16 negm=f32x16{};asm volatile("":"+v"(negm));
  bool resc=false;
  #define START(P0,P1) do{ const float rm=rowmax(P0,P1); resc=false; \
    { const float dl=rm; mhat=fadd_s(mhat,dl); \
      _Pragma("unroll") for(int r=0;r<16;++r){P0[r]=fsub_s(P0[r],dl);P1[r]=fsub_s(P1[r],dl);} \
      _Pragma("unroll") for(int r=0;r<16;++r)negm[r]=-mhat; asm volatile("":"+v"(negm)); } \
    _Pragma("unroll") for(int r=0;r<16;++r)P0[r]=__builtin_amdgcn_exp2f(P0[r]); }while(0)
  #define RESC() do{ if(resc){ asm volatile("s_waitcnt lgkmcnt(0)":::"memory"); \
      _Pragma("unroll") for(int d_=0;d_<2;++d_) _Pragma("unroll") for(int r=0;r<16;++r)o[d_][r]*=wsf[crow(r,hi)]; } }while(0)
  f32x16 pA0,pA1,pB0,pB1;
  int sl_prev=0,sl_cur=0,sl_next=SLOTB;
  #define ROT() do{sl_prev=sl_cur;sl_cur=sl_next;sl_next=(sl_next==(NSLOT-1)*SLOTB)?0:sl_next+SLOTB;}while(0)
  DMA_K(2,2*SLOTB);
  WAIT_BAR(3);
  qkt(pA0,pA1,Kbase,qr,negm,r32,hi);asm volatile("s_nop 15\n\ts_nop 7":"+v"(pA0),"+v"(pA1));
  START(pA0,pA1);
  _Pragma("unroll") for(int r=0;r<16;++r)pA1[r]=__builtin_amdgcn_exp2f(pA1[r]);
  WAIT_BAR(0);
  DMA_K(3,0);DMA_V(1,SLOTB);
  ROT();
  kload8(kf,kp0+sl_cur);
  WAIT_BAR(2);
  s16x4 vlo[8],vhi[8]; u32x4 pw0,pw1,pw2,pw3;
  #define PKW(P,B) cvtpk_s(P[B],P[B+1])
  #define PAF(k) __builtin_bit_cast(bf16x8,pw##k)
  #define VFR(i) (bf16x8){vlo[i][0],vlo[i][1],vlo[i][2],vlo[i][3],vhi[i][0],vhi[i][1],vhi[i][2],vhi[i][3]}
  #define PIN(x) asm volatile("":"+v"(x))
  #define MX3(a,b,c) __builtin_fmaxf(__builtin_fmaxf((a),(b)),(c))
  #define GAPA(MF,A0,A1,A2,A3,W0,W1,PW) do{ MF; sacc+=A0; sacc+=A1; sacc+=A2; sacc+=A3; PIN(sacc); W0; W1; PIN(PW); SBAR(); }while(0)
  #define EX(v) __builtin_amdgcn_exp2f(v)
  #define GAPB(MF,X,B) do{ MF; X[B]=EX(X[B]); X[B+1]=EX(X[B+1]); X[B+2]=EX(X[B+2]); X[B+3]=EX(X[B+3]); PIN(X); SBAR(); }while(0)
  #define VRD(i) do{ vlo[i]=vtr(vp_+(((i)>>2)*4096+((i)&3)*1024)); vhi[i]=vtr(vp_+(((i)>>2)*4096+((i)&3)*1024+512)); }while(0)
  #define KRD(G,j) do{ if(G){ kload2(kf,kp0+sl_next,j); SBAR(); } }while(0)
  #define STEP(C0,C1,P0,P1,t,GK,GV,GL) do{ SBAR(); \
    const lds_cptr vp_=vp0+sl_prev; \
    VRD(0); SBAR(); float sacc=(P0[0]+P0[1]); \
    GAPA(C0=__builtin_amdgcn_mfma_f32_32x32x16_bf16(kf[0],qr[0],negm,0,0,0), P0[2],P0[3],P0[4],P0[5],     pw0[0]=PKW(P0,0), pw0[1]=PKW(P0,2), pw0); \
    VRD(4); SBAR(); GAPA(C1=__builtin_amdgcn_mfma_f32_32x32x16_bf16(kf[1],qr[0],negm,0,0,0), P0[6],P0[7],P0[8],P0[9],     pw0[2]=PKW(P0,4), pw0[3]=PKW(P0,6), pw0); \
    VRD(1); SBAR(); GAPA(C0=__builtin_amdgcn_mfma_f32_32x32x16_bf16(kf[2],qr[1],C0,0,0,0),   P0[10],P0[11],P0[12],P0[13], pw1[0]=PKW(P0,8), pw1[1]=PKW(P0,10), pw1); \
    VRD(5); SBAR(); GAPA(C1=__builtin_amdgcn_mfma_f32_32x32x16_bf16(kf[3],qr[1],C1,0,0,0),   P0[14],P0[15],P1[0],P1[1],   pw1[2]=PKW(P0,12),pw1[3]=PKW(P0,14), pw1); \
    VRD(2); SBAR(); GAPA(C0=__builtin_amdgcn_mfma_f32_32x32x16_bf16(kf[4],qr[2],C0,0,0,0),   P1[2],P1[3],P1[4],P1[5],     pw2[0]=PKW(P1,0), pw2[1]=PKW(P1,2), pw2); \
    VRD(6); SBAR(); GAPA(C1=__builtin_amdgcn_mfma_f32_32x32x16_bf16(kf[5],qr[2],C1,0,0,0),   P1[6],P1[7],P1[8],P1[9],     pw2[2]=PKW(P1,4), pw2[3]=PKW(P1,6), pw2); \
    VRD(3); SBAR(); GAPA(C0=__builtin_amdgcn_mfma_f32_32x32x16_bf16(kf[6],qr[3],C0,0,0,0),   P1[10],P1[11],P1[12],P1[13], pw3[0]=PKW(P1,8), pw3[1]=PKW(P1,10), pw3); \
    VRD(7); SBAR(); GAPA(C1=__builtin_amdgcn_mfma_f32_32x32x16_bf16(kf[7],qr[3],C1,0,0,0),   P1[14],P1[15],0.f,0.f,       pw3[2]=PKW(P1,12),pw3[3]=PKW(P1,14), pw3); \
    l_reg+=sacc; \
    if(GK){DMA_K((t)+3,sl_cur);} if(GV){DMA_V((t)+1,sl_next);} \
    { float a=MX3(C0[0],C0[1],C1[0]),b=MX3(C0[2],C0[3],C1[1]); a=MX3(a,C1[2],C1[3]); \
      _Pragma("unroll") for(int r=4;r<16;r+=4){a=MX3(a,C0[r],C0[r+1]);b=MX3(b,C0[r+2],C0[r+3]);a=MX3(a,C1[r],C1[r+1]);b=MX3(b,C1[r+2],C1[r+3]);} \
      float rm=__builtin_fmaxf(a,b); { auto rr=__builtin_amdgcn_permlane32_swap(__float_as_uint(rm),__float_as_uint(rm),false,false); rm=__builtin_fmaxf(__uint_as_float(rr[0]),__uint_as_float(rr[1])); } \
      resc=false; \
      if(__builtin_expect(__any(rm>(float)THRL),0)){ const float dl=__builtin_fmaxf(rm,0.f); mhat+=dl; \
        _Pragma("unroll") for(int r=0;r<16;++r){C0[r]-=dl;C1[r]-=dl;} \
        _Pragma("unroll") for(int r=0;r<16;++r)negm[r]=-mhat; asm volatile("":"+v"(negm)); \
        const float f=__builtin_amdgcn_exp2f(-dl); l_reg*=f; if(hi==0)wsf[r32]=f; resc=true; } } \
    SBAR(); \
    GAPB(o[0]=__builtin_amdgcn_mfma_f32_32x32x16_bf16(PAF(0),VFR(0),o[0],0,0,0), C0,0); \
    GAPB(o[1]=__builtin_amdgcn_mfma_f32_32x32x16_bf16(PAF(0),VFR(4),o[1],0,0,0), C0,4); \
    KRD(GL,0); GAPB(o[0]=__builtin_amdgcn_mfma_f32_32x32x16_bf16(PAF(1),VFR(1),o[0],0,0,0), C0,8); \
    KRD(GL,1); GAPB(o[1]=__builtin_amdgcn_mfma_f32_32x32x16_bf16(PAF(1),VFR(5),o[1],0,0,0), C0,12); \
    KRD(GL,2); GAPB(o[0]=__builtin_amdgcn_mfma_f32_32x32x16_bf16(PAF(2),VFR(2),o[0],0,0,0), C1,0); \
    KRD(GL,3); GAPB(o[1]=__builtin_amdgcn_mfma_f32_32x32x16_bf16(PAF(2),VFR(6),o[1],0,0,0), C1,4); \
    GAPB(o[0]=__builtin_amdgcn_mfma_f32_32x32x16_bf16(PAF(3),VFR(3),o[0],0,0,0), C1,8); \
    GAPB(o[1]=__builtin_amdgcn_mfma_f32_32x32x16_bf16(PAF(3),VFR(7),o[1],0,0,0), C1,12); \
    }while(0)
  int t=1;
  for(;t+5<NT;t+=2){
    STEP(pB0,pB1,pA0,pA1,t,true,true,true);     WAIT_BAR(2); RESC(); ROT();
    STEP(pA0,pA1,pB0,pB1,t+1,true,true,true);   WAIT_BAR(2); RESC(); ROT();
  }
  #define ENDW(tt) do{ if((tt)+3<NT){WAIT_BAR(2);} else if((tt)+2<NT){WAIT_BAR(1);} else {WAIT_BAR(0);} }while(0)
  for(;t+1<NT;t+=2){
    STEP(pB0,pB1,pA0,pA1,t,(t+3<NT),(t+1<NT),(t+1<NT));       ENDW(t);   RESC(); ROT();
    STEP(pA0,pA1,pB0,pB1,t+1,(t+4<NT),(t+2<NT),(t+2<NT));     ENDW(t+1); RESC(); ROT();
  }
  STEP(pB0,pB1,pA0,pA1,NT-1,false,false,false); RESC();
  { float sacc=pB0[0]+pB0[1]; _Pragma("unroll") for(int r=2;r<16;++r)sacc+=pB0[r]; _Pragma("unroll") for(int r=0;r<16;++r)sacc+=pB1[r]; l_reg+=sacc;
    pw0=(u32x4){PKW(pB0,0),PKW(pB0,2),PKW(pB0,4),PKW(pB0,6)};pw1=(u32x4){PKW(pB0,8),PKW(pB0,10),PKW(pB0,12),PKW(pB0,14)};pw2=(u32x4){PKW(pB1,0),PKW(pB1,2),PKW(pB1,4),PKW(pB1,6)};pw3=(u32x4){PKW(pB1,8),PKW(pB1,10),PKW(pB1,12),PKW(pB1,14)};
    SBAR(); pv(o,vb0+sl_cur,PAF(0),PAF(1),PAF(2),PAF(3)); }
  #undef PKW
  #undef PAF
  #undef VFR
  #undef PIN
  #undef MX3
  #undef GAPA
  #undef GAPB
  #undef EX
  #undef VRD
  #undef KRD
  #undef STEP
  #undef ENDW
  {auto rr=__builtin_amdgcn_permlane32_swap(__float_as_uint(l_reg),__float_as_uint(l_reg),false,false);l_reg=__uint_as_float(rr[0])+__uint_as_float(rr[1]);}
  if(hi==0)wsf[32+r32]=l_reg;asm volatile("s_waitcnt lgkmcnt(0)":::"memory");
  float rli[16];
  #pragma unroll
  for(int r=0;r<16;++r)rli[r]=__builtin_amdgcn_rcpf(wsf[32+crow(r,hi)]);
  { bf16*stg=(bf16*)(shm+LDS_OST)+wid*2048;
    #pragma unroll
    for(int r=0;r<16;++r){const int orow=crow(r,hi);
      #pragma unroll
      for(int d0=0;d0<2;++d0)stg[orow*64+d0*32+r32]=__float2bfloat16(o[d0][r]*rli[r]);}
    asm volatile("s_waitcnt lgkmcnt(0)":::"memory");
    #pragma unroll
    for(int i=0;i<4;++i){const int row=i*8+(lane>>3),ch=lane&7; const u32x4 v=*(const u32x4*)(stg+row*64+ch*8); *(u32x4*)(Ow+(long)row*DMp+ch*8)=v;} }
  asm volatile("s_waitcnt lgkmcnt(0)\n\ts_barrier":::"memory");
  #undef DMA_K
  #undef DMA_V
  #undef START
  #undef RESC
  #undef ROT
}
#undef SBAR
#undef WAIT_BAR
}

constexpr int NWAVES = 8, LDS_BYTES = 147456, RING_BYTES = 131072;
struct Params { const float* in[32]; float* out; unsigned char* ws; int ph_lo, ph_hi; };
enum { I_X = 0, I_C, I_CTX, I_CCTX, I_ADAW, I_ADAB, I_NMIXG, I_NFFNG, I_WIN, I_CONVW, I_CONVB, I_LRUWA, I_LRUBA, I_LRUWX, I_LRUBX, I_LRULAM, I_CMVG, I_CMWS, I_CMBS, I_WOUT0,
       I_WQKV, I_LQ1, I_LK1, I_LQ2, I_LK2, I_SUBLN, I_WOUT1, I_ROUTER, I_W1, I_W3, I_W2, I_FINALG };

typedef const __attribute__((address_space(4))) Params* KParams;
__device__ __forceinline__ Params kparams() {
#if defined(__HIP_DEVICE_COMPILE__)
    KParams q = (KParams)__builtin_amdgcn_kernarg_segment_ptr(); asm volatile("" : "+s"(q)); return *q;
#else
    return Params{};
#endif
}
struct Ctx {
    LAS unsigned char* lds; int tid, lane, wave, vcu, G;
};
__device__ __forceinline__ float wave_sum(float v) {
#pragma unroll
    for (int o = 1; o < 64; o <<= 1) v += __shfl_xor(v, o);
    return v;
}
#define LDS_WAIT() asm volatile("s_waitcnt lgkmcnt(0)" ::: "memory")

__device__ __forceinline__ int dest_row(int n, int mode) {
    if (mode == 1) return n < 2048 ? ((n & ~63) + 2 * (n & 31) + ((n >> 5) & 1)) : n;
    if (mode == 2) return 8 * (n >> 2) + (n & 3);
    if (mode == 3) return 8 * (n >> 2) + 4 + (n & 3);
    return n;
}
__device__ __forceinline__ void p0_transpose_item(const float* W, int K, int N, bf16_t* WT, int mode, LAS float* scr, int item, int lane) {
    const int nblk = N / 32, kb = item / nblk, nb = item % nblk, k0 = 64 * kb, n0 = 32 * nb;
#pragma unroll 8
    for (int i = 0; i < 32; ++i) { const int kk = 2 * i + (lane >> 5); scr[kk * 33 + (lane & 31)] = W[(size_t)(k0 + kk) * N + n0 + (lane & 31)]; }
    LDS_WAIT(); asm volatile("" ::: "memory");
    const int c = lane & 7;
#pragma unroll
    for (int j = 0; j < 4; ++j) { const int n = (lane >> 3) + 8 * j; const LAS float* s = scr + (8 * c) * 33 + n;
        u32x4 o; o.x = pk2(s[0 * 33], s[1 * 33]); o.y = pk2(s[2 * 33], s[3 * 33]); o.z = pk2(s[4 * 33], s[5 * 33]); o.w = pk2(s[6 * 33], s[7 * 33]);
        *(GAS u32x4*)(WT + (size_t)dest_row(n0 + n, mode) * K + k0 + 8 * c) = o; }
    LDS_WAIT(); asm volatile("" ::: "memory");
}
__device__ __forceinline__ void p0_prologue(const Ctx& F, const Params& p) {
    unsigned char* ws = p.ws;
    LAS float* sil = (LAS float*)(F.lds + 8 * 16384);
    for (int i = F.tid; i < 3 * DM; i += 512) { const float v = i < 2 * DM ? p.in[I_C][i] : p.in[I_CCTX][i - 2 * DM]; sil[i] = silu_f(v); }
    __syncthreads();
    {
        float* mod = (float*)(ws + WS_MOD);
        const int task = F.wave * F.G + F.vcu;
        if (task < 768) {
            const int l = task / 384, cgp = task % 384, kq = F.lane >> 4, n = cgp * 16 + (F.lane & 15);
            const float* W = p.in[I_ADAW] + (size_t)l * DM * 6144 + n;
            float a0 = 0.f, a1 = 0.f, a2 = 0.f;
#pragma unroll 16
            for (int k = kq; k < DM; k += 4) { const float w = W[(size_t)k * 6144]; a0 += sil[k] * w; a1 += sil[DM + k] * w; a2 += sil[2 * DM + k] * w; }
            a0 += __shfl_xor(a0, 16); a0 += __shfl_xor(a0, 32); a1 += __shfl_xor(a1, 16); a1 += __shfl_xor(a1, 32); a2 += __shfl_xor(a2, 16); a2 += __shfl_xor(a2, 32);
            if (F.lane < 16) { const float bb = p.in[I_ADAB][l * 6144 + n]; mod[(l * 3 + 0) * 6144 + n] = a0 + bb; mod[(l * 3 + 1) * 6144 + n] = a1 + bb; mod[(l * 3 + 2) * 6144 + n] = a2 + bb; }
        }
    }
    {
        const int gt = F.vcu * 512 + F.tid, NT_ = F.G * 512;
        float* cs = (float*)(ws + WS_ROPE);
        for (int i = gt; i < SEQ * 32; i += NT_) { const int t = i >> 5, pp = i & 31; const float inv = powf(10000.0f, -(float)(2 * (pp & 15)) / 32.0f);
            const float ang = (float)(pp < 16 ? (t >> 6) : (t & 63)) * inv; float s, c; sincosf(ang, &s, &c); cs[2 * i] = c; cs[2 * i + 1] = s; }
        bf16_t* lw = (bf16_t*)(ws + WS_LRUW);
        for (int o = gt; o < 2 * 2 * 8 * 64 * 64; o += NT_) { const int i = o & 63, j = (o >> 6) & 63, h = (o >> 12) & 7, g2 = (o >> 15) & 1, d = o >> 16;
            const float* src = g2 ? p.in[I_LRUWX] : p.in[I_LRUWA]; lw[o] = (bf16_t)f2bf(src[((d * 8 + h) * 64 + i) * 64 + j]); }
        bf16_t* cw = (bf16_t*)(ws + WS_CMWS);
        for (int o = gt; o < 8 * 128 * 128; o += NT_) cw[o] = (bf16_t)f2bf(p.in[I_CMWS][o]);
    }
    LAS float* scr = (LAS float*)(F.lds + F.wave * 16384);
    const int gw = F.vcu * NWAVES + F.wave, NGW = F.G * NWAVES;
    constexpr int I_IN = 1024, I_O0 = 512, I_QK = 1536, I_O1 = 512, I_SMALL = I_IN + I_O0 + I_QK + I_O1, I_MOE = 1024, NITEMS = I_SMALL + 3 * 32 * I_MOE;
    for (int it = gw; it < NITEMS; it += NGW) {
        int r = it;
        if (r < I_SMALL) {
            if (r < I_IN) { p0_transpose_item(p.in[I_WIN], DM, 2048, (bf16_t*)(ws + WS_WIN), 0, scr, r, F.lane); continue; } r -= I_IN;
            if (r < I_O0) { p0_transpose_item(p.in[I_WOUT0], DM, DM, (bf16_t*)(ws + WS_WOUT0), 0, scr, r, F.lane); continue; } r -= I_O0;
            if (r < I_QK) { p0_transpose_item(p.in[I_WQKV], DM, 3072, (bf16_t*)(ws + WS_WQKV), 1, scr, r, F.lane); continue; } r -= I_QK;
            p0_transpose_item(p.in[I_WOUT1], DM, DM, (bf16_t*)(ws + WS_WOUT1), 0, scr, r, F.lane); continue;
        }
        r -= I_SMALL; const int which = r / (32 * I_MOE), le = (r / I_MOE) % 32, item = r % I_MOE;
        if (which == 0) p0_transpose_item(p.in[I_W1] + (size_t)le * DM * FF, DM, FF, (bf16_t*)(ws + WS_W13) + (size_t)le * 4096 * DM, 2, scr, item, F.lane);
        else if (which == 1) p0_transpose_item(p.in[I_W3] + (size_t)le * DM * FF, DM, FF, (bf16_t*)(ws + WS_W13) + (size_t)le * 4096 * DM, 3, scr, item, F.lane);
        else p0_transpose_item(p.in[I_W2] + (size_t)le * FF * DM, FF, DM, (bf16_t*)(ws + WS_W2) + (size_t)le * DM * FF, 0, scr, item, F.lane);
    }
}

__device__ __forceinline__ void ld_row(const float* pr, int lane, f32x4 (&v)[4]) {
#pragma unroll
    for (int j = 0; j < 4; ++j) v[j] = *(const f32x4*)(pr + 4 * lane + 256 * j);
}
__device__ __forceinline__ float row_rstd(const f32x4 (&v)[4]) {
    float s = 0.f;
#pragma unroll
    for (int j = 0; j < 4; ++j) s += (v[j][0] * v[j][0] + v[j][1] * v[j][1]) + (v[j][2] * v[j][2] + v[j][3] * v[j][3]);
    return 1.0f / sqrtf(wave_sum(s) * (1.0f / DM) + EPS);
}
__device__ __forceinline__ void mod_norm(f32x4 (&v)[4], float rstd, const float* g, const float* sc, const float* sh, int lane) {
#pragma unroll
    for (int j = 0; j < 4; ++j) { const int c = 4 * lane + 256 * j; const f32x4 gv = *(const f32x4*)(g + c), sv = *(const f32x4*)(sc + c), hv = *(const f32x4*)(sh + c);
        v[j] = v[j] * rstd * gv * (sv + 1.0f) + hv; }
}
__device__ __forceinline__ void st_row_bf16(bf16_t* pr, int lane, const f32x4 (&v)[4]) {
#pragma unroll
    for (int j = 0; j < 4; ++j) { u32x2 w; w.x = pk2(v[j][0], v[j][1]); w.y = pk2(v[j][2], v[j][3]); *(u32x2*)(pr + 4 * lane + 256 * j) = w; }
}
__device__ __forceinline__ void row_info(int R, int& b, int& j, int& rt) { b = R / LR; j = R % LR; rt = j < CTXL ? 2 : b; }

__device__ __forceinline__ void p_norm1_in(const Ctx& F, const Params& p) {
    const float* mod = (const float*)(p.ws + WS_MOD); bf16_t* H = (bf16_t*)(p.ws + WS_H);
    const int gw = F.vcu * NWAVES + F.wave, NGW = F.G * NWAVES;
    for (int R = gw; R < NR; R += NGW) { int b, j, rt; row_info(R, b, j, rt);
        const float* src = j < CTXL ? p.in[I_CTX] + ((size_t)b * CTXL + j) * DM : p.in[I_X] + ((size_t)b * SEQ + (j - CTXL)) * DM;
        f32x4 v[4]; ld_row(src, F.lane, v); const float rstd = row_rstd(v);
        const float* m = mod + (size_t)(0 * 3 + rt) * 6144; mod_norm(v, rstd, p.in[I_NMIXG], m + DM, m, F.lane);
        st_row_bf16(H + (size_t)R * DM, F.lane, v); }
}
__device__ __forceinline__ void p_norm2_router(const Ctx& F, const Params& p, int l, bool with_ctx) {
    const float* mod = (const float*)(p.ws + WS_MOD); bf16_t* H = (bf16_t*)(p.ws + WS_H); const float* X = (const float*)(p.ws + WS_X); float* aff = (float*)(p.ws + WS_AFF);
    LAS float* wr = (LAS float*)F.lds;
    for (int i = F.tid; i < DM * NE / 4; i += 512) ((LAS f32x4*)wr)[i] = ((const f32x4*)(p.in[I_ROUTER] + (size_t)l * DM * NE))[i];
    __syncthreads();
    const int gw = F.vcu * NWAVES + F.wave, NGW = F.G * NWAVES; const int hi5 = (F.lane >> 5) & 1, hi4 = (F.lane >> 4) & 1, hi3 = (F.lane >> 3) & 1, hi2 = (F.lane >> 2) & 1;
    for (int R = gw; R < NR; R += NGW) { int b, j, rt; row_info(R, b, j, rt);
        if (!with_ctx && j < CTXL) continue;
        f32x4 v[4]; ld_row(X + (size_t)R * DM, F.lane, v); const float rstd = row_rstd(v);
        const float* m = mod + (size_t)(l * 3 + rt) * 6144; mod_norm(v, rstd, p.in[I_NFFNG] + l * DM, m + 4 * DM, m + 3 * DM, F.lane);
        st_row_bf16(H + (size_t)R * DM, F.lane, v);
        float a[16];
#pragma unroll
        for (int e = 0; e < 16; ++e) a[e] = 0.f;
#pragma unroll
        for (int jj = 0; jj < 4; ++jj)
#pragma unroll
            for (int i = 0; i < 4; ++i) { const int c = 4 * F.lane + 256 * jj + i; const float hv = v[jj][i];
#pragma unroll
                for (int q = 0; q < 4; ++q) { const f32x4 w = *(const LAS f32x4*)(wr + c * 16 + 4 * q); a[4 * q] += hv * w[0]; a[4 * q + 1] += hv * w[1]; a[4 * q + 2] += hv * w[2]; a[4 * q + 3] += hv * w[3]; }
                if (i & 1) __builtin_amdgcn_sched_barrier(0); }
        float b8[8], b4[4], b2[2], b1;
#pragma unroll
        for (int i = 0; i < 8; ++i) { const float keep = hi5 ? a[i + 8] : a[i], send = hi5 ? a[i] : a[i + 8]; b8[i] = keep + __shfl_xor(send, 32); }
#pragma unroll
        for (int i = 0; i < 4; ++i) { const float keep = hi4 ? b8[i + 4] : b8[i], send = hi4 ? b8[i] : b8[i + 4]; b4[i] = keep + __shfl_xor(send, 16); }
#pragma unroll
        for (int i = 0; i < 2; ++i) { const float keep = hi3 ? b4[i + 2] : b4[i], send = hi3 ? b4[i] : b4[i + 2]; b2[i] = keep + __shfl_xor(send, 8); }
        { const float keep = hi2 ? b2[1] : b2[0], send = hi2 ? b2[0] : b2[1]; b1 = keep + __shfl_xor(send, 4); }
        b1 += __shfl_xor(b1, 1); b1 += __shfl_xor(b1, 2);
        float mx = b1;
#pragma unroll
        for (int o = 4; o < 64; o <<= 1) mx = fmaxf(mx, __shfl_xor(mx, o));
        const float ex = __expf(b1 - mx); float sm = ex;
#pragma unroll
        for (int o = 4; o < 64; o <<= 1) sm += __shfl_xor(sm, o);
        if ((F.lane & 3) == 0) aff[((size_t)b * NE + (F.lane >> 2)) * LR + j] = ex / sm;
    }
    __syncthreads();
}

__device__ __forceinline__ void p_select(const Ctx& F, const Params& p, bool with_ctx) {
    const float* aff = (const float*)(p.ws + WS_AFF); int* inv = (int*)(p.ws + WS_INV); float* gate = (float*)(p.ws + WS_GATE);
    const bf16_t* H = (const bf16_t*)(p.ws + WS_H); bf16_t* XS = (bf16_t*)(p.ws + WS_XS);
    LAS unsigned* hist = (LAS unsigned*)F.lds;
    LAS unsigned* misc = hist + 256;
    LAS unsigned* list = hist + 512;
    LAS unsigned* vals = hist + 512 + 2048;
    const int nitems = with_ctx ? 288 : 256;
    for (int item = blockIdx.x; item < nitems; item += F.G) {
        const bool isl = item < 256; const int prob = isl ? item >> 3 : item - 256, seg = isl ? item & 7 : 0, b = prob >> 4, e = prob & 15;
        const int n = isl ? SEQ : CTXL, kcap = isl ? 1024 : 32, j0 = isl ? CTXL : 0, nj = isl ? 16 : 1;
        const float* av = aff + ((size_t)b * NE + e) * LR + j0;
#pragma unroll 1
        for (int jj = 0; jj < nj; ++jj) { const int tok = F.tid + 512 * jj; vals[tok] = tok < n ? __float_as_uint(av[tok]) : 0u; }
        unsigned prefix = 0u, mask = 0u, kk = (unsigned)kcap;
#pragma unroll 1
        for (int pass = 0; pass < 4; ++pass) { const int shift = 24 - 8 * pass;
            if (F.tid < 256) hist[F.tid] = 0u;
            __syncthreads();
#pragma unroll 1
            for (int jj = 0; jj < nj; ++jj) { const unsigned bt = vals[F.tid + 512 * jj]; if ((bt & mask) == prefix && bt != 0u) atomicAdd((unsigned*)(hist + ((bt >> shift) & 255u)), 1u); }
            __syncthreads();
            if (F.wave == 0) {
                unsigned loc[4], tot = 0u;
#pragma unroll
                for (int q = 0; q < 4; ++q) { loc[q] = hist[255 - 4 * F.lane - q]; tot += loc[q]; }
                unsigned inc = tot;
#pragma unroll
                for (int o = 1; o < 64; o <<= 1) { const unsigned t2 = __shfl_up(inc, o); if (F.lane >= o) inc += t2; }
                unsigned run = inc - tot;
#pragma unroll
                for (int q = 0; q < 4; ++q) { if (run < kk && run + loc[q] >= kk) { misc[0] = (unsigned)(255 - 4 * F.lane - q); misc[1] = kk - run; } run += loc[q]; }
            }
            __syncthreads();
            prefix |= misc[0] << shift; mask |= 0xffu << shift; kk = misc[1];
            __syncthreads();
        }
        const unsigned T = prefix, need_eq = kk, cnt_gt = (unsigned)kcap - need_eq;
        unsigned cnt = 0u;
#pragma unroll 1
        for (int jj = 0; jj < nj; ++jj) { const unsigned bt = vals[F.tid + 512 * jj]; cnt += (bt > T ? 1u : 0u) + (bt == T ? 0x10000u : 0u); }
        unsigned inc = cnt;
#pragma unroll
        for (int o = 1; o < 64; o <<= 1) { const unsigned t2 = __shfl_up(inc, o); if (F.lane >= o) inc += t2; }
        if (F.lane == 63) misc[8 + F.wave] = inc;
        if (F.tid == 0) misc[2] = 0u;
        __syncthreads();
        unsigned base = inc - cnt;
        for (int w = 0; w < F.wave; ++w) base += misc[8 + w];
        unsigned rg = base & 0xffffu, re = base >> 16;
#pragma unroll 1
        for (int jj = 0; jj < nj; ++jj) { const int tok = F.tid + 512 * jj; const unsigned bt = vals[tok]; const bool own = isl ? ((jj >> 1) == seg) : true;
            const bool isgt = bt > T, iseq = bt == T; int slot = -1;
            if (isgt) { slot = (int)rg; } else if (iseq && re < need_eq) { slot = (int)(cnt_gt + re); }
            rg += isgt ? 1u : 0u; re += iseq ? 1u : 0u;
            if (own && tok < n) { const int R = b * LR + j0 + tok; int er = -1;
                if (slot >= 0) { er = isl ? b * 1024 + slot : 2048 + b * 32 + slot; gate[e * EROWS + er] = __uint_as_float(bt);
                    const unsigned pos = atomicAdd((unsigned*)(misc + 2), 1u); list[2 * pos] = (unsigned)R; list[2 * pos + 1] = (unsigned)er; }
                inv[(size_t)R * NE + e] = er; } }
        __syncthreads();
        const int nl = (int)misc[2];
        for (int i = F.wave; i < nl; i += NWAVES) { const unsigned R = list[2 * i], er = list[2 * i + 1];
            const u32x4* sp = (const u32x4*)(H + (size_t)R * DM); u32x4* d = (u32x4*)(XS + ((size_t)e * EROWS + er) * DM);
            const u32x4 v0 = sp[F.lane], v1 = sp[64 + F.lane]; d[F.lane] = v0; d[64 + F.lane] = v1; }
        __syncthreads();
    }
}

__device__ __forceinline__ void p_combine(const Ctx& F, const Params& p, int l, bool final_) {
    const float* mod = (const float*)(p.ws + WS_MOD); bf16_t* H = (bf16_t*)(p.ws + WS_H); float* X = (float*)(p.ws + WS_X); const int* inv = (const int*)(p.ws + WS_INV);
    const bf16_t* YB = (const bf16_t*)(p.ws + WS_XS);
    const int gw = F.vcu * NWAVES + F.wave, NGW = F.G * NWAVES;
    for (int R = gw; R < NR; R += NGW) { int b, j, rt; row_info(R, b, j, rt);
        if (final_ && j < CTXL) continue;
        f32x4 v[4]; ld_row(X + (size_t)R * DM, F.lane, v);
        const int myinv = F.lane < NE ? inv[(size_t)R * NE + F.lane] : -1;
        f32x4 mo[4];
#pragma unroll
        for (int jj = 0; jj < 4; ++jj) mo[jj] = (f32x4){0.f, 0.f, 0.f, 0.f};
#pragma unroll
        for (int e = 0; e < NE; ++e) { const int er = __builtin_amdgcn_readlane(myinv, e);
            if (er >= 0) { const bf16_t* yr = YB + ((size_t)e * EROWS + er) * DM;
#pragma unroll
                for (int jj = 0; jj < 4; ++jj) { const u32x2 w = *(const u32x2*)(yr + 4 * F.lane + 256 * jj); mo[jj][0] += bflo(w.x); mo[jj][1] += bfhi(w.x); mo[jj][2] += bflo(w.y); mo[jj][3] += bfhi(w.y); } } }
        const float* m = mod + (size_t)(l * 3 + rt) * 6144;
#pragma unroll
        for (int jj = 0; jj < 4; ++jj) { const f32x4 g2 = *(const f32x4*)(m + 5 * DM + 4 * F.lane + 256 * jj); v[jj] = v[jj] + g2 * mo[jj]; }
        const float rstd = row_rstd(v);
        if (final_) { float* o = p.out + ((size_t)b * SEQ + (j - CTXL)) * DM;
#pragma unroll
            for (int jj = 0; jj < 4; ++jj) { const int c = 4 * F.lane + 256 * jj; *(f32x4*)(o + c) = v[jj] * rstd * *(const f32x4*)(p.in[I_FINALG] + c); } }
        else {
#pragma unroll
            for (int jj = 0; jj < 4; ++jj) *(f32x4*)(X + (size_t)R * DM + 4 * F.lane + 256 * jj) = v[jj];
            const float* m1 = mod + (size_t)((l + 1) * 3 + rt) * 6144; mod_norm(v, rstd, p.in[I_NMIXG] + (l + 1) * DM, m1 + DM, m1, F.lane);
            st_row_bf16(H + (size_t)R * DM, F.lane, v); }
    }
}

__device__ __forceinline__ void p_lru(const Ctx& F, const Params& p, bool full) {
    const bf16_t* Z = (const bf16_t*)(p.ws + WS_ACT + ACT_Z); bf16_t* YC = (bf16_t*)(p.ws + WS_ACT + ACT_YCAT); const bf16_t* LW = (const bf16_t*)(p.ws + WS_LRUW);
    f32x2* SUM = (f32x2*)(p.ws + WS_SUM);
    LAS float* recS = (LAS float*)F.lds;
    LAS float* xcF = recS + 67 * 64;
    LAS float* aS = xcF + 64 * 64;
    LAS float* uS = aS + 2 * 64 * 64;
    LAS float* cst = uS + 2 * 64 * 64;
    LAS bf16_t* xcB = (LAS bf16_t*)(cst + 1024 + 128);
    const int wave = F.wave, lane = F.lane, tid = F.tid;
    for (int item = blockIdx.x; item < NTILE64 * 8; item += F.G) {
        const int T = item >> 3, h = item & 7, b = T / 132, jt = T % 132; const bool isctx = jt < 4;
        const int R0 = b * LR + jt * 64;
        const int slo = isctx ? 0 : CTXL, shi = isctx ? CTXL : LR;
        const int jbase = jt * 64;
        { const int r = tid >> 3, c8 = tid & 7; const u32x4 w = *(const u32x4*)(Z + (size_t)(R0 + r) * 2048 + 512 + h * 64 + c8 * 8); LAS float* d = recS + (r + 2) * 64 + c8 * 8;
          d[0] = bflo(w.x); d[1] = bfhi(w.x); d[2] = bflo(w.y); d[3] = bfhi(w.y); d[4] = bflo(w.z); d[5] = bfhi(w.z); d[6] = bflo(w.w); d[7] = bfhi(w.w);
          if (tid < 24) { const int hr = tid >> 3; const int rr = hr == 0 ? -2 : (hr == 1 ? -1 : 64); const int jj = jbase + rr; LAS float* d2 = recS + (rr + 2) * 64 + c8 * 8;
              if (jj >= slo && jj < shi) { const u32x4 w2 = *(const u32x4*)(Z + (size_t)(R0 + rr) * 2048 + 512 + h * 64 + c8 * 8);
                  d2[0] = bflo(w2.x); d2[1] = bfhi(w2.x); d2[2] = bflo(w2.y); d2[3] = bfhi(w2.y); d2[4] = bflo(w2.z); d2[5] = bfhi(w2.z); d2[6] = bflo(w2.w); d2[7] = bfhi(w2.w); }
              else {
#pragma unroll
                  for (int i = 0; i < 8; ++i) d2[i] = 0.f; } } }
        __syncthreads();
        { const int r = tid >> 3, c8 = (tid & 7) * 8; const float* cw = p.in[I_CONVW] + h * 64 + c8; const float* cb = p.in[I_CONVB] + h * 64 + c8;
          float y[8];
#pragma unroll
          for (int i = 0; i < 8; ++i) { y[i] = cb[i];
#pragma unroll
              for (int q = 0; q < 4; ++q) y[i] += cw[q * 512 + i] * recS[(r + q) * 64 + c8 + i]; }
#pragma unroll
          for (int i = 0; i < 8; ++i) xcF[r * 64 + c8 + i] = y[i];
          u32x4 w; w.x = pk2(y[0], y[1]); w.y = pk2(y[2], y[3]); w.z = pk2(y[4], y[5]); w.w = pk2(y[6], y[7]);
          *(LAS u32x4*)(xcB + r * 72 + c8) = w; }
        __syncthreads();
        { const int d = wave >> 2, mf = wave & 3, fr = lane & 15, fq = lane >> 4;
          bf16x8 af[2];
#pragma unroll
          for (int ks = 0; ks < 2; ++ks) af[ks] = *(const LAS bf16x8*)(xcB + (16 * mf + fr) * 72 + 32 * ks + 8 * fq);
          f32x4 acc[2][4];
#pragma unroll
          for (int g2 = 0; g2 < 2; ++g2)
#pragma unroll
              for (int nf = 0; nf < 4; ++nf) { acc[g2][nf] = (f32x4){0.f, 0.f, 0.f, 0.f};
#pragma unroll
                  for (int ks = 0; ks < 2; ++ks) { const bf16x8 bfr = *(const bf16x8*)(LW + ((size_t)(((d * 2 + g2) * 8 + h) * 64 + 16 * nf + fr)) * 64 + 32 * ks + 8 * fq);
                      acc[g2][nf] = __builtin_amdgcn_mfma_f32_16x16x32_bf16(af[ks], bfr, acc[g2][nf], 0, 0, 0); } }
#pragma unroll
          for (int nf = 0; nf < 4; ++nf) { const int ch = 16 * nf + fr, gch = d * 512 + h * 64 + ch;
              const float ba = p.in[I_LRUBA][gch], bx = p.in[I_LRUBX][gch], lam = p.in[I_LRULAM][gch];
              const float cA = -8.0f * log1pf(__expf(-lam));
#pragma unroll
              for (int r = 0; r < 4; ++r) { const int tk = 16 * mf + 4 * fq + r;
                  const float rg = sigmoid_f(acc[0][nf][r] + ba), ig = sigmoid_f(acc[1][nf][r] + bx);
                  const float la = rg * cA, a = __expf(la), mult = sqrtf(-expm1f(2.0f * la));
                  aS[(d * 64 + tk) * 64 + ch] = a; uS[(d * 64 + tk) * 64 + ch] = mult * ig * xcF[tk * 64 + ch]; } } }
        if (full) {
            const int dc = tid & 127, d = dc >> 6, ch = dc & 63, sg = tid >> 7;
            const int n = d == 0 ? jt : (isctx ? 3 - jt : 4 + 131 - jt);
            const int i0 = (n * sg) / 4, i1 = (n * (sg + 1)) / 4;
            float P = 1.f, Hs = 0.f;
            for (int i = i0; i < i1; ++i) { const int jp = d == 0 ? i : (isctx ? 3 - i : (i < 4 ? 3 - i : 135 - i));
                const f32x2 s = SUM[((size_t)(b * 132 + jp) * 2 + d) * 512 + h * 64 + ch]; Hs = s.x * Hs + s.y; P = P * s.x; }
            cst[(sg * 128 + dc) * 2] = P; cst[(sg * 128 + dc) * 2 + 1] = Hs;
        }
        __syncthreads();
        if (full && tid < 128) { float s = 0.f;
#pragma unroll
            for (int sg = 0; sg < 4; ++sg) s = cst[(sg * 128 + tid) * 2] * s + cst[(sg * 128 + tid) * 2 + 1];
            cst[1024 + tid] = s; }
        if (tid < 128) { const int d = tid >> 6, ch = tid & 63;
            float hs = full ? cst[1024 + tid] : 0.f, P = 1.f;
            if (d == 0) {
#pragma unroll 8
                for (int t = 0; t < 64; ++t) { const float a = aS[t * 64 + ch]; hs = a * hs + uS[t * 64 + ch]; P *= a; if (full) uS[t * 64 + ch] = hs; }
            } else {
#pragma unroll 8
                for (int t = 63; t >= 0; --t) { const float a = aS[(64 + t) * 64 + ch]; hs = a * hs + uS[(64 + t) * 64 + ch]; P *= a; if (full) uS[(64 + t) * 64 + ch] = hs; }
            }
            if (!full) SUM[((size_t)T * 2 + d) * 512 + h * 64 + ch] = (f32x2){P, hs};
        }
        __syncthreads();
        if (full) { const int r = tid >> 3, c8 = (tid & 7) * 8; const u32x4 gw_ = *(const u32x4*)(Z + (size_t)(R0 + r) * 2048 + h * 64 + c8);
            float gg[8] = {bflo(gw_.x), bfhi(gw_.x), bflo(gw_.y), bfhi(gw_.y), bflo(gw_.z), bfhi(gw_.z), bflo(gw_.w), bfhi(gw_.w)}; float y[8];
#pragma unroll
            for (int i = 0; i < 8; ++i) y[i] = gg[i] * (uS[r * 64 + c8 + i] + uS[(64 + r) * 64 + c8 + i]);
            u32x4 w; w.x = pk2(y[0], y[1]); w.y = pk2(y[2], y[3]); w.z = pk2(y[4], y[5]); w.w = pk2(y[6], y[7]);
            *(u32x4*)(YC + (size_t)(R0 + r) * DM + h * 64 + c8) = w; }
        __syncthreads();
    }
}

__device__ __forceinline__ void p_cm(const Ctx& F, const Params& p) {
    const bf16_t* Z = (const bf16_t*)(p.ws + WS_ACT + ACT_Z); bf16_t* YC = (bf16_t*)(p.ws + WS_ACT + ACT_YCAT); const bf16_t* CW = (const bf16_t*)(p.ws + WS_CMWS);
    LAS bf16_t* vnT = (LAS bf16_t*)F.lds;
    const int wave = F.wave, lane = F.lane, tid = F.tid, fr = lane & 15, fq = lane >> 4;
    for (int item = blockIdx.x; item < (NR / 128) * 8; item += F.G) {
        const int cn = item >> 3, g = item & 7; const int R0 = cn * 128;
        { const int q = tid >> 2, part = tid & 3; const bf16_t* src = Z + (size_t)(R0 + q) * 2048 + 1536 + g * 64 + part * 16;
          const u32x4 w0 = *(const u32x4*)src, w1 = *(const u32x4*)(src + 8);
          float v[16] = {bflo(w0.x), bfhi(w0.x), bflo(w0.y), bfhi(w0.y), bflo(w0.z), bfhi(w0.z), bflo(w0.w), bfhi(w0.w), bflo(w1.x), bfhi(w1.x), bflo(w1.y), bfhi(w1.y), bflo(w1.z), bfhi(w1.z), bflo(w1.w), bfhi(w1.w)};
          float ss = 0.f;
#pragma unroll
          for (int i = 0; i < 16; ++i) ss += v[i] * v[i];
          ss += __shfl_xor(ss, 1); ss += __shfl_xor(ss, 2);
          const float rstd = 1.0f / sqrtf(ss * (1.0f / 64.0f) + EPS); const float* vg = p.in[I_CMVG] + g * 64 + part * 16;
#pragma unroll
          for (int i = 0; i < 16; ++i) vnT[(part * 16 + i) * 136 + q] = (bf16_t)f2bf(v[i] * rstd * vg[i]); }
        __syncthreads();
        f32x4 acc[4];
#pragma unroll
        for (int nf = 0; nf < 4; ++nf) acc[nf] = (f32x4){0.f, 0.f, 0.f, 0.f};
#pragma unroll
        for (int ks = 0; ks < 4; ++ks) { const bf16x8 af = *(const bf16x8*)(CW + ((size_t)g * 128 + 16 * wave + fr) * 128 + 32 * ks + 8 * fq);
#pragma unroll
            for (int nf = 0; nf < 4; ++nf) { const bf16x8 bfr = *(const LAS bf16x8*)(vnT + (16 * nf + fr) * 136 + 32 * ks + 8 * fq);
                acc[nf] = __builtin_amdgcn_mfma_f32_16x16x32_bf16(af, bfr, acc[nf], 0, 0, 0); } }
#pragma unroll
        for (int r = 0; r < 4; ++r) { const int pp = 16 * wave + 4 * fq + r; const float bs = p.in[I_CMBS][g * 128 + pp];
#pragma unroll
            for (int nf = 0; nf < 4; ++nf) { const int c = 16 * nf + fr; const float ug = bf2f(Z[(size_t)(R0 + pp) * 2048 + 1024 + g * 64 + c]);
                YC[(size_t)(R0 + pp) * DM + 512 + g * 64 + c] = (bf16_t)f2bf(ug * (acc[nf][r] + bs)); } }
        __syncthreads();
    }
}

__device__ __forceinline__ void p_attn(const Ctx& F, const Params& p, unsigned char* lds_generic) {
    using abf = attn_body::bf16;
    const abf* Q = (const abf*)(p.ws + WS_ACT + ACT_Q); const abf* Kb = (const abf*)(p.ws + WS_ACT + ACT_K); const abf* Vb = (const abf*)(p.ws + WS_ACT + ACT_V);
    const int wid = F.wave;
    for (int i = 0; i < 8; ++i) { const int combo = i * 8 + (F.vcu >> 5), qb = F.vcu & 31;
        const int b = combo >> 5, h = (combo >> 2) & 7, m = (combo >> 1) & 1, half = combo & 1;
        abf* O = (abf*)(p.ws + WS_ACT + (m ? ACT_O2 : ACT_O1));
        const abf* Qw = Q + ((size_t)b * LR + CTXL + qb * 256 + wid * 32) * DM + (h * 2 + m) * 64;
        const abf* Kh = Kb + (size_t)b * LR * DM + (h * 2 + m) * 64;
        const abf* Vh = Vb + (size_t)b * LR * DM + h * 128 + half * 64;
        abf* Ow = O + ((size_t)b * SEQ + qb * 256 + wid * 32) * DM + h * 128 + half * 64;
        attn_body::attn_unit<8>(Qw, Kh, Vh, Ow, (char*)lds_generic); }
}
__device__ __forceinline__ void p_attn_combine(const Ctx& F, const Params& p) {
    const bf16_t* O1 = (const bf16_t*)(p.ws + WS_ACT + ACT_O1); const bf16_t* O2 = (const bf16_t*)(p.ws + WS_ACT + ACT_O2); bf16_t* A = (bf16_t*)(p.ws + WS_ACT + ACT_A);
    const float lam_init = 0.8f - 0.6f * expf(-0.3f);
    float s1 = F.lane < 64 ? p.in[I_LQ1][F.lane] * p.in[I_LK1][F.lane] : 0.f, s2 = p.in[I_LQ2][F.lane] * p.in[I_LK2][F.lane];
    s1 = wave_sum(s1); s2 = wave_sum(s2);
    const float lam = expf(s1) - expf(s2) + lam_init, osc = 1.0f - lam_init;
    f32x4 gsub[4];
#pragma unroll
    for (int q = 0; q < 4; ++q) gsub[q] = *(const f32x4*)(p.in[I_SUBLN] + 16 * (F.lane & 7) + 4 * q);
    const int gw = F.vcu * NWAVES + F.wave, NGW = F.G * NWAVES;
    for (int r = gw; r < NLAT; r += NGW) {
        const u32x4* a1 = (const u32x4*)(O1 + (size_t)r * DM + 16 * F.lane); const u32x4* a2 = (const u32x4*)(O2 + (size_t)r * DM + 16 * F.lane);
        const u32x4 x0 = a1[0], x1 = a1[1], y0 = a2[0], y1 = a2[1];
        float o[16];
        o[0] = bflo(x0.x) - lam * bflo(y0.x); o[1] = bfhi(x0.x) - lam * bfhi(y0.x); o[2] = bflo(x0.y) - lam * bflo(y0.y); o[3] = bfhi(x0.y) - lam * bfhi(y0.y);
        o[4] = bflo(x0.z) - lam * bflo(y0.z); o[5] = bfhi(x0.z) - lam * bfhi(y0.z); o[6] = bflo(x0.w) - lam * bflo(y0.w); o[7] = bfhi(x0.w) - lam * bfhi(y0.w);
        o[8] = bflo(x1.x) - lam * bflo(y1.x); o[9] = bfhi(x1.x) - lam * bfhi(y1.x); o[10] = bflo(x1.y) - lam * bflo(y1.y); o[11] = bfhi(x1.y) - lam * bfhi(y1.y);
        o[12] = bflo(x1.z) - lam * bflo(y1.z); o[13] = bfhi(x1.z) - lam * bfhi(y1.z); o[14] = bflo(x1.w) - lam * bflo(y1.w); o[15] = bfhi(x1.w) - lam * bfhi(y1.w);
        float ss = 0.f;
#pragma unroll
        for (int i = 0; i < 16; ++i) ss += o[i] * o[i];
        ss += __shfl_xor(ss, 1); ss += __shfl_xor(ss, 2); ss += __shfl_xor(ss, 4);
        const float rstd = osc / sqrtf(ss * (1.0f / 128.0f) + EPS);
        u32x4 w0, w1;
        w0.x = pk2(o[0] * rstd * gsub[0][0], o[1] * rstd * gsub[0][1]); w0.y = pk2(o[2] * rstd * gsub[0][2], o[3] * rstd * gsub[0][3]);
        w0.z = pk2(o[4] * rstd * gsub[1][0], o[5] * rstd * gsub[1][1]); w0.w = pk2(o[6] * rstd * gsub[1][2], o[7] * rstd * gsub[1][3]);
        w1.x = pk2(o[8] * rstd * gsub[2][0], o[9] * rstd * gsub[2][1]); w1.y = pk2(o[10] * rstd * gsub[2][2], o[11] * rstd * gsub[2][3]);
        w1.z = pk2(o[12] * rstd * gsub[3][0], o[13] * rstd * gsub[3][1]); w1.w = pk2(o[14] * rstd * gsub[3][2], o[15] * rstd * gsub[3][3]);
        u32x4* d = (u32x4*)(A + (size_t)r * DM + 16 * F.lane); d[0] = w0; d[1] = w1;
    }
}

__global__ void __launch_bounds__(NWAVES * 64, 2) mk_fwd(Params p_unused) {
    extern __shared__ __attribute__((aligned(16))) unsigned char lds[];
#define MAKE_CTX Ctx F; { int t_ = threadIdx.x; asm volatile("" : "+v"(t_)); F.lds = (LAS unsigned char*)lds; F.tid = t_; F.lane = t_ & 63; F.wave = __builtin_amdgcn_readfirstlane(t_ >> 6); \
    F.G = gridDim.x; const int bx = blockIdx.x; F.vcu = (F.G % 8 == 0) ? (bx % 8) * (F.G / 8) + bx / 8 : bx; }
    int lo, hi; { const Params q0 = kparams(); lo = q0.ph_lo; hi = q0.ph_hi; }
#ifndef PH_MASK
#define PH_MASK 0xFFFFFu
#endif
#define IN(k) (((PH_MASK >> (k)) & 1u) && lo <= (k) && (k) < hi)
#define SEAM(k) do { if (IN(k) && IN((k) + 1)) { cg::this_grid().sync(); } } while (0)
#define PHASE_VARS MAKE_CTX const Params p = kparams(); unsigned char* ws = p.ws; const float* mod = (const float*)(ws + WS_MOD); bf16_t* Hb = (bf16_t*)(ws + WS_H); (void)mod; (void)Hb;

    if (IN(0)) { PHASE_VARS p0_prologue(F, p); } SEAM(0);
    if (IN(1)) { PHASE_VARS p_norm1_in(F, p); } SEAM(1);
    if (IN(2)) { PHASE_VARS
        pg8::Gemm g{Hb, (const bf16_t*)(ws + WS_WIN), DM, 0, 0}; pg8::GOrder S; S.init(NR / 256, 8, 1, F.G, (int)blockIdx.x);
        pg8::EpiWin E{(bf16_t*)(ws + WS_ACT + ACT_Z)}; pg8::gemm_phase(F.lds, g, S, E); } SEAM(2);
    if (IN(3)) { PHASE_VARS p_lru(F, p, false); p_cm(F, p); } SEAM(3);
    if (IN(4)) { PHASE_VARS p_lru(F, p, true); } SEAM(4);
    if (IN(5)) { PHASE_VARS
        pg8::Gemm g{(const bf16_t*)(ws + WS_ACT + ACT_YCAT), (const bf16_t*)(ws + WS_WOUT0), DM, 0, 0}; pg8::GOrder S; S.init(NR / 256, 4, 1, F.G, (int)blockIdx.x);
        pg8::EpiRes E{(float*)(ws + WS_X), p.in[I_X], p.in[I_CTX], mod + 2 * DM, 0}; pg8::gemm_phase(F.lds, g, S, E); } SEAM(5);
    if (IN(6)) { PHASE_VARS p_norm2_router(F, p, 0, true); } SEAM(6);
    if (IN(7)) { PHASE_VARS p_select(F, p, true); } SEAM(7);
    if (IN(8)) { PHASE_VARS
        pg8::Gemm g{(const bf16_t*)(ws + WS_XS), (const bf16_t*)(ws + WS_W13), DM, (size_t)EROWS * DM * 2, (size_t)4096 * DM * 2}; pg8::GOrder S; S.init(9, 16, NE, F.G, (int)blockIdx.x);
        pg8::EpiSwiGLU E{(bf16_t*)(ws + WS_ACT + ACT_HID)}; pg8::gemm_phase(F.lds, g, S, E); } SEAM(8);
    if (IN(9)) { PHASE_VARS
        pg8::Gemm g{(const bf16_t*)(ws + WS_ACT + ACT_HID), (const bf16_t*)(ws + WS_W2), FF, (size_t)EROWS * FF * 2, (size_t)DM * FF * 2}; pg8::GOrder S; S.init(9, 4, NE, F.G, (int)blockIdx.x);
        pg8::EpiMoeOut E{(bf16_t*)(ws + WS_XS), (const float*)(ws + WS_GATE)}; pg8::gemm_phase(F.lds, g, S, E); } SEAM(9);
    if (IN(10)) { PHASE_VARS p_combine(F, p, 0, false); } SEAM(10);
    if (IN(11)) { PHASE_VARS
        pg8::Gemm g{Hb, (const bf16_t*)(ws + WS_WQKV), DM, 0, 0}; pg8::GOrder S; S.init(NR / 256, 12, 1, F.G, (int)blockIdx.x);
        pg8::EpiQKV E{(bf16_t*)(ws + WS_ACT + ACT_Q), (const float*)(ws + WS_ROPE)}; pg8::gemm_phase(F.lds, g, S, E); } SEAM(11);
    if (IN(12)) { PHASE_VARS p_attn(F, p, lds); } SEAM(12);
    if (IN(13)) { PHASE_VARS p_attn_combine(F, p); } SEAM(13);
    if (IN(14)) { PHASE_VARS
        pg8::Gemm g{(const bf16_t*)(ws + WS_ACT + ACT_A), (const bf16_t*)(ws + WS_WOUT1), DM, 0, 0}; pg8::GOrder S; S.init(NLAT / 256, 4, 1, F.G, (int)blockIdx.x);
        pg8::EpiRes E{(float*)(ws + WS_X), nullptr, nullptr, mod + 3 * 6144 + 2 * DM, 1}; pg8::gemm_phase(F.lds, g, S, E); } SEAM(14);
    if (IN(15)) { PHASE_VARS p_norm2_router(F, p, 1, false); } SEAM(15);
    if (IN(16)) { PHASE_VARS p_select(F, p, false); } SEAM(16);
    if (IN(17)) { PHASE_VARS
        pg8::Gemm g{(const bf16_t*)(ws + WS_XS), (const bf16_t*)(ws + WS_W13) + (size_t)NE * 4096 * DM, DM, (size_t)EROWS * DM * 2, (size_t)4096 * DM * 2}; pg8::GOrder S; S.init(8, 16, NE, F.G, (int)blockIdx.x);
        pg8::EpiSwiGLU E{(bf16_t*)(ws + WS_ACT + ACT_HID)}; pg8::gemm_phase(F.lds, g, S, E); } SEAM(17);
    if (IN(18)) { PHASE_VARS
        pg8::Gemm g{(const bf16_t*)(ws + WS_ACT + ACT_HID), (const bf16_t*)(ws + WS_W2) + (size_t)NE * DM * FF, FF, (size_t)EROWS * FF * 2, (size_t)DM * FF * 2}; pg8::GOrder S; S.init(8, 4, NE, F.G, (int)blockIdx.x);
        pg8::EpiMoeOut E{(bf16_t*)(ws + WS_XS), (const float*)(ws + WS_GATE)}; pg8::gemm_phase(F.lds, g, S, E); } SEAM(18);
    if (IN(19)) { PHASE_VARS p_combine(F, p, 1, true); }
#undef IN
#undef SEAM
}

extern "C" void kernel_launch(void* const* d_in, const int* in_sizes, int n_in, void* d_out, int out_size, void* d_ws, size_t ws_size, hipStream_t stream) {
    static int grid = 0;
    if (grid == 0) {
        if (n_in != 32 || out_size != NLAT * DM || ws_size < WS_END) { fprintf(stderr, "kernel_launch: unexpected problem (n_in %d, out %d, ws %zu)\n", n_in, out_size, ws_size); grid = -1; return; }
        int dev = 0, cus = 0, per_cu = 0;
        if (hipGetDevice(&dev) != hipSuccess || hipDeviceGetAttribute(&cus, hipDeviceAttributeMultiprocessorCount, dev) != hipSuccess) { grid = -1; return; }
        if (hipFuncSetAttribute((const void*)mk_fwd, hipFuncAttributeMaxDynamicSharedMemorySize, LDS_BYTES) != hipSuccess) { fprintf(stderr, "kernel_launch: hipFuncSetAttribute failed\n"); grid = -1; return; }
        if (hipOccupancyMaxActiveBlocksPerMultiprocessor(&per_cu, (const void*)mk_fwd, NWAVES * 64, LDS_BYTES) != hipSuccess || per_cu < 1) { fprintf(stderr, "kernel_launch: occupancy query says %d\n", per_cu); per_cu = 1; }
        (void)hipGetLastError();
        grid = cus;
    }
    if (grid < 0) return;
    Params a{};
    for (int i = 0; i < 32; ++i) a.in[i] = (const float*)d_in[i];
    a.out = (float*)d_out; a.ws = (unsigned char*)d_ws;
#if MK_N_LAUNCHES == 1
    a.ph_lo = 0; a.ph_hi = NPH;
    void* args[] = {&a};
    hipError_t e = hipLaunchCooperativeKernel((const void*)mk_fwd, dim3(grid), dim3(NWAVES * 64), args, LDS_BYTES, stream);
    if (e != hipSuccess) fprintf(stderr, "kernel_launch: cooperative launch failed: %s (grid %d)\n", hipGetErrorString(e), grid);
#else
    for (int ph = 0; ph < NPH; ++ph) { a.ph_lo = ph; a.ph_hi = ph + 1; hipLaunchKernelGGL(mk_fwd, dim3(grid), dim3(NWAVES * 64), LDS_BYTES, stream, a); }
#endif
}
```

```cpp
#include <hip/hip_runtime.h>
#include <hip/hip_cooperative_groups.h>
#include <hip/hip_bf16.h>
#include <cstdio>
#include <cstdint>
#include <cmath>
namespace cg = cooperative_groups;

#ifndef MK_N_LAUNCHES
#define MK_N_LAUNCHES 1
#endif

constexpr int DM = 1024, NB = 2, SEQ = 8192, CTXL = 256, LR = SEQ + CTXL, NR = NB * LR, NLAT = NB * SEQ;
constexpr int NE = 16, FF = 2048, EROWS = 2304;
constexpr float EPS = 1e-6f;
constexpr int NTILE64 = NR / 64;
constexpr int NPH = 20;

constexpr size_t MiB = 1u << 20;
constexpr size_t WS_CTL = 0, WS_MOD = 1 * MiB, WS_ROPE = 2 * MiB, WS_LRUW = 4 * MiB, WS_CMWS = 4 * MiB + 512 * 1024, WS_SUM = 5 * MiB, WS_AFF = 8 * MiB, WS_INV = 10 * MiB,
                 WS_GATE = 12 * MiB, WS_WIN = 14 * MiB, WS_WOUT0 = 18 * MiB, WS_WQKV = 20 * MiB, WS_WOUT1 = 26 * MiB, WS_W13 = 32 * MiB, WS_W2 = 288 * MiB, WS_H = 416 * MiB,
                 WS_X = 450 * MiB, WS_XS = 516 * MiB, WS_ACT = 588 * MiB, WS_END = 758 * MiB;
static_assert(true, "");
constexpr size_t ACT_Z = 0, ACT_YCAT = 66 * MiB, ACT_HID = 0, ACT_Q = 0, ACT_K = 33 * MiB, ACT_V = 66 * MiB, ACT_O1 = 99 * MiB, ACT_O2 = 131 * MiB, ACT_A = 0;

#define GAS __attribute__((address_space(1)))
#define LAS __attribute__((address_space(3)))
typedef unsigned short bf16_t;
typedef short bf16x8 __attribute__((ext_vector_type(8)));
typedef float f32x4 __attribute__((ext_vector_type(4)));
typedef float f32x2 __attribute__((ext_vector_type(2)));
typedef unsigned u32x4 __attribute__((ext_vector_type(4)));
typedef unsigned u32x2 __attribute__((ext_vector_type(2)));

__device__ __forceinline__ unsigned f2bf(float f) { unsigned u = __builtin_bit_cast(unsigned, f); return (u + 0x7fffu + ((u >> 16) & 1u)) >> 16; }
__device__ __forceinline__ unsigned pk2(float lo, float hi) { return f2bf(lo) | (f2bf(hi) << 16); }
__device__ __forceinline__ float bf2f(unsigned short b) { return __builtin_bit_cast(float, (unsigned)b << 16); }
__device__ __forceinline__ float bflo(unsigned w) { return __builtin_bit_cast(float, w << 16); }
__device__ __forceinline__ float bfhi(unsigned w) { return __builtin_bit_cast(float, w & 0xffff0000u); }
__device__ __forceinline__ float gelu_tanh(float x) {
    const float u2 = 2.0f * 0.7978845608028654f * (x + 0.044715f * x * x * x);
    const float e = __builtin_amdgcn_exp2f(u2 * 1.4426950408889634f);
    return x - x * __builtin_amdgcn_rcpf(1.0f + e);
}
__device__ __forceinline__ float silu_f(float a) { return a * __builtin_amdgcn_rcpf(1.0f + __builtin_amdgcn_exp2f(-a * 1.4426950408889634f)); }
__device__ __forceinline__ float sigmoid_f(float a) { return 1.0f / (1.0f + __expf(-a)); }

namespace pg8 {
#define PG8_LAS __attribute__((address_space(3)))
constexpr int BM = 256, BK = 64, HALF = 128, HTB = HALF * BK * 2, STAGE_BYTES = 8 * HTB, NXCD = 8, WGM = 8;
__host__ __device__ __forceinline__ int lds_byte(int r, int c) { const int st = (r >> 4) * 2 + (c >> 5), rr = r & 15, cc = c & 31, ob = rr * 64 + cc * 2; return st * 1024 + (ob ^ (((ob >> 9) & 1) << 5)); }
__host__ __device__ __forceinline__ void stage_rc(int b, int& R, int& C) { const int st = b / 1024, sb = b % 1024, swz = sb ^ (((sb >> 9) & 1) << 5); R = (st >> 1) * 16 + swz / 64; C = (st & 1) * 32 + (swz % 64) / 2; }
__host__ __device__ __forceinline__ int perm32(int rho) { const int n = rho >> 4, i = rho & 15; return 8 * (i >> 2) + 4 * n + (i & 3); }

struct Unit { int pm, pn, grp; };
struct Gemm { const bf16_t* A; const bf16_t* Bt; int K; size_t ga, gb; };

struct GOrder {
    int nM, nN, upg, nwg, G, c;
    __device__ void init(int nM_, int nN_, int ngrp, int G_, int c_) { nM = nM_; nN = nN_; upg = nM * nN; nwg = upg * ngrp; G = G_; c = c_; }
    __device__ bool next(int i, Unit& u) const {
        const long L = (long)i * G + c; if (L >= nwg) return false;
        int wgid = (int)L; { const int q = nwg / NXCD, r = nwg % NXCD, xcd = wgid % NXCD, off = wgid / NXCD; wgid = (xcd < r ? xcd * (q + 1) : r * (q + 1) + (xcd - r) * q) + off; }
        u.grp = wgid / upg; const int w = wgid % upg;
        const int nig = WGM * nN, gid = w / nig, fm = gid * WGM, gsz = (nM - fm) < WGM ? (nM - fm) : WGM;
        u.pm = fm + ((w % nig) % gsz); u.pn = (w % nig) / gsz; return true;
    }
};

__device__ __forceinline__ unsigned cvt_pk_bf16(float lo, float hi) { unsigned r; asm volatile("v_cvt_pk_bf16_f32 %0, %1, %2" : "=v"(r) : "v"(lo), "v"(hi)); return r; }

template <class Epi, class Sched>
__device__ __forceinline__ void gemm_phase(PG8_LAS unsigned char* lds, const Gemm g, const Sched& S, const Epi& E) {
    const int tid = threadIdx.x, wid = __builtin_amdgcn_readfirstlane(tid >> 6), lane = tid & 63, wr = wid >> 2, wc = wid & 3, fr = lane & 15, fq = lane >> 4;
    const int K = g.K, nt = K / BK;
    unsigned voffA[2], voffB[2];
#pragma unroll
    for (int i = 0; i < 2; ++i) { int R, C; stage_rc(tid * 16 + i * 8192, R, C); const int Rb = (R & ~31) + perm32(R & 31);
        voffA[i] = (unsigned)(R * K + C) * 2u; voffB[i] = (unsigned)(Rb * K + C) * 2u; }
    const size_t kstep = (size_t)(BK * 2);
    const size_t hstep = (size_t)HALF * K * 2;
    const size_t tstep = 2 * hstep;
    const unsigned ldsw = (unsigned)wid * 1024u;
    const int aoff = lds_byte(wr * 64 + fr, fq * 8), boff = lds_byte(wc * 32 + fr, fq * 8);
#define PG8_SA(b, h) (((b) * 2 + (h)) * HTB)
#define PG8_SB(b, h) ((4 + (b) * 2 + (h)) * HTB)
#define PG8_STAGE(bufoff, gbase, voff) do { _Pragma("unroll") for (int _i = 0; _i < 2; ++_i) \
        __builtin_amdgcn_global_load_lds((const unsigned*)((const char*)(gbase) + (voff)[_i]), (PG8_LAS unsigned*)(lds + (bufoff) + ldsw + _i * 8192), 16, 0, 0); } while (0)
#define PG8_LDA(dst, b, h) do { _Pragma("unroll") for (int m = 0; m < 4; ++m) _Pragma("unroll") for (int k = 0; k < 2; ++k) dst[m][k] = *(const PG8_LAS bf16x8*)(lds + PG8_SA(b, h) + aoff + m * 2048 + k * 1024); } while (0)
#define PG8_LDB(dst, b, h) do { _Pragma("unroll") for (int n = 0; n < 2; ++n) _Pragma("unroll") for (int k = 0; k < 2; ++k) dst[n][k] = *(const PG8_LAS bf16x8*)(lds + PG8_SB(b, h) + boff + n * 2048 + k * 1024); } while (0)
#define PG8_MMA(ai, bj, At, Bt) do { __builtin_amdgcn_s_setprio(1); _Pragma("unroll") for (int m = 0; m < 4; ++m) _Pragma("unroll") for (int n = 0; n < 2; ++n) _Pragma("unroll") for (int k = 0; k < 2; ++k) \
        acc[ai][bj][m][n] = __builtin_amdgcn_mfma_f32_16x16x32_bf16(Bt[n][k], At[m][k], acc[ai][bj][m][n], 0, 0, 0); __builtin_amdgcn_s_setprio(0); } while (0)
#define PG8_WAIT_V(n) asm volatile("s_waitcnt vmcnt(" #n ")" ::: "memory")
#define PG8_WAIT_L(n) asm volatile("s_waitcnt lgkmcnt(" #n ")" ::: "memory")
#define PG8_BAR __builtin_amdgcn_s_barrier()
#define PG8_SCHED __builtin_amdgcn_sched_barrier(0)
    Unit cur, nxt; int ui = 0;
    if (!S.next(0, cur)) return;
    f32x4 acc[2][2][4][2];
#pragma unroll
    for (int a = 0; a < 2; ++a)
#pragma unroll
        for (int b = 0; b < 2; ++b)
#pragma unroll
            for (int m = 0; m < 4; ++m)
#pragma unroll
                for (int n = 0; n < 2; ++n) acc[a][b][m][n] = (f32x4){0.f, 0.f, 0.f, 0.f};
    bf16x8 At[4][2], B0[2][2], B1[2][2];
    const char* cA = (const char*)g.A + (size_t)cur.grp * g.ga + (size_t)cur.pm * tstep; const char* cB = (const char*)g.Bt + (size_t)cur.grp * g.gb + (size_t)cur.pn * tstep;
    PG8_STAGE(PG8_SB(0, 0), cB, voffB); PG8_STAGE(PG8_SB(0, 1), cB + hstep, voffB); PG8_STAGE(PG8_SA(0, 0), cA, voffA); PG8_STAGE(PG8_SA(0, 1), cA + hstep, voffA);
    if (wr == 1) PG8_BAR;
    PG8_WAIT_V(2); PG8_BAR;
    PG8_STAGE(PG8_SB(1, 0), cB + kstep, voffB); PG8_STAGE(PG8_SA(1, 0), cA + kstep, voffA); PG8_STAGE(PG8_SB(1, 1), cB + hstep + kstep, voffB);
    PG8_WAIT_V(6); PG8_BAR;
    for (;;) {
        const bool has_next = S.next(ui + 1, nxt);
        const char* nA = has_next ? (const char*)g.A + (size_t)nxt.grp * g.ga + (size_t)nxt.pm * tstep : cA; const char* nB = has_next ? (const char*)g.Bt + (size_t)nxt.grp * g.gb + (size_t)nxt.pn * tstep : cB;
        for (int t = 0; t < nt; t += 2) {
            const bool last = (t == nt - 2);
            const char* a1 = cA + (size_t)(t + 1) * kstep;
            const char* a2 = last ? nA : cA + (size_t)(t + 2) * kstep; const char* b2 = last ? nB : cB + (size_t)(t + 2) * kstep;
            const char* a3 = a2 + kstep; const char* b3 = b2 + kstep;
            PG8_LDB(B0, 0, 0); PG8_LDB(B1, 0, 1); PG8_SCHED; PG8_LDA(At, 0, 0); PG8_STAGE(PG8_SA(1, 1), a1 + hstep, voffA);
            PG8_WAIT_V(8); PG8_WAIT_L(0); PG8_BAR; PG8_MMA(0, 0, At, B0); PG8_MMA(0, 1, At, B1); PG8_BAR; PG8_SCHED;
            PG8_LDA(At, 0, 1); PG8_STAGE(PG8_SB(0, 0), b2, voffB); PG8_STAGE(PG8_SB(0, 1), b2 + hstep, voffB); PG8_STAGE(PG8_SA(0, 0), a2, voffA);
            PG8_WAIT_V(8); PG8_WAIT_L(0); PG8_BAR; PG8_MMA(1, 0, At, B0); PG8_MMA(1, 1, At, B1); PG8_BAR; PG8_SCHED;
            PG8_LDB(B0, 1, 0); PG8_LDB(B1, 1, 1); PG8_SCHED; PG8_LDA(At, 1, 0); PG8_STAGE(PG8_SA(0, 1), a2 + hstep, voffA);
            PG8_WAIT_V(8); PG8_WAIT_L(0); PG8_BAR; PG8_MMA(0, 0, At, B0); PG8_MMA(0, 1, At, B1); PG8_BAR; PG8_SCHED;
            PG8_LDA(At, 1, 1); PG8_STAGE(PG8_SB(1, 0), b3, voffB); PG8_STAGE(PG8_SB(1, 1), b3 + hstep, voffB); PG8_STAGE(PG8_SA(1, 0), a3, voffA);
            PG8_WAIT_V(8); PG8_WAIT_L(0); PG8_BAR; PG8_MMA(1, 0, At, B0); PG8_MMA(1, 1, At, B1); PG8_BAR; PG8_SCHED;
        }
        if (wr == 0) PG8_BAR;
        E(acc, cur, wr, wc, fr, fq);
        if (!has_next) break;
#pragma unroll
        for (int a = 0; a < 2; ++a)
#pragma unroll
            for (int b = 0; b < 2; ++b)
#pragma unroll
                for (int m = 0; m < 4; ++m)
#pragma unroll
                    for (int n = 0; n < 2; ++n) acc[a][b][m][n] = (f32x4){0.f, 0.f, 0.f, 0.f};
        cur = nxt; cA = nA; cB = nB; ++ui;
        if (wr == 1) PG8_BAR;
    }
    PG8_WAIT_V(0);
    PG8_BAR;
#undef PG8_SA
#undef PG8_SB
#undef PG8_STAGE
#undef PG8_LDA
#undef PG8_LDB
#undef PG8_MMA
#undef PG8_WAIT_V
#undef PG8_WAIT_L
#undef PG8_BAR
#undef PG8_SCHED
}

struct EpiWin {
    bf16_t* Z;
    __device__ __forceinline__ void operator()(const f32x4 (&acc)[2][2][4][2], const Unit& u, int wr, int wc, int fr, int fq) const {
        const int row0 = u.pm * BM + wr * 64 + fr, col0 = u.pn * BM + wc * 32 + 8 * fq; const bool act = (u.pn < 2) || (u.pn >= 4);
#pragma unroll
        for (int ai = 0; ai < 2; ++ai)
#pragma unroll
            for (int m = 0; m < 4; ++m) { bf16_t* rowp = Z + (size_t)(row0 + ai * HALF + m * 16) * 2048 + col0;
#pragma unroll
                for (int bj = 0; bj < 2; ++bj) { f32x4 v0 = acc[ai][bj][m][0], v1 = acc[ai][bj][m][1];
                    if (act) {
#pragma unroll
                        for (int i = 0; i < 4; ++i) { v0[i] = gelu_tanh(v0[i]); v1[i] = gelu_tanh(v1[i]); } }
                    u32x4 w; w.x = cvt_pk_bf16(v0[0], v0[1]); w.y = cvt_pk_bf16(v0[2], v0[3]); w.z = cvt_pk_bf16(v1[0], v1[1]); w.w = cvt_pk_bf16(v1[2], v1[3]);
                    *(u32x4*)(rowp + bj * HALF) = w; } }
    }
};
struct EpiRes {
    float* X; const float* xin; const float* cin; const float* g1; int mode;
    __device__ __forceinline__ void operator()(const f32x4 (&acc)[2][2][4][2], const Unit& u, int wr, int wc, int fr, int fq) const {
        const float* basep; float* outp; int rt;
        if (mode == 0) { const int b = u.pm / 33, jt = u.pm % 33; outp = X + (size_t)u.pm * BM * DM;
            if (jt == 0) { basep = cin + (size_t)b * CTXL * DM; rt = 2; } else { basep = xin + ((size_t)b * SEQ + (size_t)(jt - 1) * BM) * DM; rt = b; } }
        else { const int b = u.pm / 32, t0 = (u.pm % 32) * BM; outp = X + ((size_t)b * LR + CTXL + t0) * DM; basep = outp; rt = b; }
        const int rr0 = wr * 64 + fr, col0 = u.pn * BM + wc * 32 + 8 * fq;
        f32x4 gv[2][2];
#pragma unroll
        for (int bj = 0; bj < 2; ++bj)
#pragma unroll
            for (int n = 0; n < 2; ++n) gv[bj][n] = *(const f32x4*)(g1 + (size_t)rt * 6144 + col0 + bj * HALF + 4 * n);
#pragma unroll
        for (int ai = 0; ai < 2; ++ai)
#pragma unroll
            for (int m = 0; m < 4; ++m) { const size_t off = (size_t)(rr0 + ai * HALF + m * 16) * DM + col0;
#pragma unroll
                for (int bj = 0; bj < 2; ++bj)
#pragma unroll
                    for (int n = 0; n < 2; ++n) { const f32x4 bs = *(const f32x4*)(basep + off + bj * HALF + 4 * n);
                        *(f32x4*)(outp + off + bj * HALF + 4 * n) = bs + gv[bj][n] * acc[ai][bj][m][n]; } }
    }
};
constexpr float C2 = 0.125f * 1.4426950408889634f;
struct EpiQKV {
    bf16_t* Q; const float* cs;
    __device__ __forceinline__ void operator()(const f32x4 (&acc)[2][2][4][2], const Unit& u, int wr, int wc, int fr, int fq) const {
        const int b = u.pm / 33, jt = u.pm % 33; const bool lat = jt != 0; const int t0 = (jt - 1) * BM;
        const int sec = u.pn >> 2; bf16_t* dst = Q + (size_t)sec * ((ACT_K - ACT_Q) / 2);
        const int rr0 = wr * 64 + fr, colt = (u.pn & 3) * BM + wc * 32 + 8 * fq; const float sc = sec == 0 ? C2 : 1.0f; const bool rope = lat && sec < 2;
#pragma unroll
        for (int ai = 0; ai < 2; ++ai)
#pragma unroll
            for (int m = 0; m < 4; ++m) { const int rr = rr0 + ai * HALF + m * 16; bf16_t* rowp = dst + ((size_t)u.pm * BM + rr) * DM + colt;
#pragma unroll
                for (int bj = 0; bj < 2; ++bj) { f32x4 v0 = acc[ai][bj][m][0], v1 = acc[ai][bj][m][1];
                    if (rope) { const int p0 = ((colt + bj * HALF) & 63) >> 1; const float* cp = cs + ((size_t)(t0 + rr) * 32 + p0) * 2;
                        const f32x4 c01 = *(const f32x4*)cp, c23 = *(const f32x4*)(cp + 4);
                        const float a0 = v0[0] * c01[0] - v0[1] * c01[1], a1 = v0[0] * c01[1] + v0[1] * c01[0];
                        const float a2 = v0[2] * c01[2] - v0[3] * c01[3], a3 = v0[2] * c01[3] + v0[3] * c01[2];
                        const float b0 = v1[0] * c23[0] - v1[1] * c23[1], b1 = v1[0] * c23[1] + v1[1] * c23[0];
                        const float b2 = v1[2] * c23[2] - v1[3] * c23[3], b3 = v1[2] * c23[3] + v1[3] * c23[2];
                        v0 = (f32x4){a0, a1, a2, a3}; v1 = (f32x4){b0, b1, b2, b3}; }
                    v0 = v0 * sc; v1 = v1 * sc;
                    u32x4 w; w.x = cvt_pk_bf16(v0[0], v0[1]); w.y = cvt_pk_bf16(v0[2], v0[3]); w.z = cvt_pk_bf16(v1[0], v1[1]); w.w = cvt_pk_bf16(v1[2], v1[3]);
                    *(u32x4*)(rowp + bj * HALF) = w; }
                asm volatile("" ::: "memory"); }
        (void)b;
    }
};
struct EpiSwiGLU {
    bf16_t* HID;
    __device__ __forceinline__ void operator()(const f32x4 (&acc)[2][2][4][2], const Unit& u, int wr, int wc, int fr, int fq) const {
        const int row0 = u.pm * BM + wr * 64 + fr, f0 = u.pn * 128 + wc * 16 + 4 * fq;
#pragma unroll
        for (int ai = 0; ai < 2; ++ai)
#pragma unroll
            for (int m = 0; m < 4; ++m) { bf16_t* rowp = HID + ((size_t)u.grp * EROWS + row0 + ai * HALF + m * 16) * FF + f0;
#pragma unroll
                for (int bj = 0; bj < 2; ++bj) { const f32x4 a = acc[ai][bj][m][0], bb = acc[ai][bj][m][1];
                    u32x2 w; w.x = cvt_pk_bf16(silu_f(a[0]) * bb[0], silu_f(a[1]) * bb[1]); w.y = cvt_pk_bf16(silu_f(a[2]) * bb[2], silu_f(a[3]) * bb[3]);
                    *(u32x2*)(rowp + bj * 64) = w; } }
    }
};
struct EpiMoeOut {
    bf16_t* YB; const float* gate;
    __device__ __forceinline__ void operator()(const f32x4 (&acc)[2][2][4][2], const Unit& u, int wr, int wc, int fr, int fq) const {
        const int row0 = u.pm * BM + wr * 64 + fr, col0 = u.pn * BM + wc * 32 + 8 * fq;
#pragma unroll
        for (int ai = 0; ai < 2; ++ai)
#pragma unroll
            for (int m = 0; m < 4; ++m) { const size_t er = (size_t)u.grp * EROWS + row0 + ai * HALF + m * 16; const float gt = gate[er]; bf16_t* rowp = YB + er * DM + col0;
#pragma unroll
                for (int bj = 0; bj < 2; ++bj) { const f32x4 v0 = acc[ai][bj][m][0] * gt, v1 = acc[ai][bj][m][1] * gt;
                    u32x4 w; w.x = cvt_pk_bf16(v0[0], v0[1]); w.y = cvt_pk_bf16(v0[2], v0[3]); w.z = cvt_pk_bf16(v1[0], v1[1]); w.w = cvt_pk_bf16(v1[2], v1[3]);
                    *(u32x4*)(rowp + bj * HALF) = w; } }
    }
};
}

namespace attn_body {
using bf16=__hip_bfloat16;
using s16x4=__attribute__((ext_vector_type(4)))short;
using f32x16=__attribute__((ext_vector_type(16)))float;
constexpr int D=64,PITCH=1024;
constexpr int NW=8,QBLK=32,QB=QBLK*NW,KVBLK=64;
constexpr int NT=LR/KVBLK;
__device__ __forceinline__ int crow(int r,int hi){return (r&3)+8*(r>>2)+4*hi;}
#define SBAR() __builtin_amdgcn_sched_barrier(0)
constexpr int NSLOT=3, SLOTB=8192;
constexpr int LDS_K=0, LDS_V=NSLOT*SLOTB, LDS_WS=2*NSLOT*SLOTB, LDS_OST=LDS_WS+NW*64*4, LDS_BYTES=LDS_OST+NW*4096;
__device__ __forceinline__ void glds16(const void*gsrc,unsigned lds_dst){unsigned keep;
  asm volatile("s_mov_b32 %0, m0\n\ts_mov_b32 m0, %2\n\ts_nop 0\n\tglobal_load_lds_dwordx4 %1, off\n\ts_mov_b32 m0, %0":"=&s"(keep):"v"(gsrc),"s"(lds_dst):"memory");}
__device__ __forceinline__ float max3f(float a,float b,float c){float r;asm("v_max3_f32 %0, %1, %2, %3":"=v"(r):"v"(a),"v"(b),"v"(c));return r;}
__device__ __forceinline__ float max2f(float a,float b){float r;asm("v_max_f32_e32 %0, %1, %2":"=v"(r):"v"(a),"v"(b));return r;}
__device__ __forceinline__ float fadd_s(float a,float b){float r;asm("v_add_f32_e32 %0, %1, %2":"=v"(r):"v"(a),"v"(b));return r;}
__device__ __forceinline__ float fsub_s(float a,float b){float r;asm("v_sub_f32_e32 %0, %1, %2":"=v"(r):"v"(a),"v"(b));return r;}
typedef float f32x2_t __attribute__((ext_vector_type(2))); typedef __bf16 bf16x2_t __attribute__((ext_vector_type(2)));
__device__ __forceinline__ unsigned cvtpk_s(float lo,float hi){f32x2_t v={lo,hi};bf16x2_t b=__builtin_convertvector(v,bf16x2_t);return __builtin_bit_cast(unsigned,b);}
#define WAIT_BAR(N) asm volatile("s_waitcnt vmcnt(" #N ") lgkmcnt(0)\n\ts_barrier":::"memory")
__device__ __forceinline__ void qkt(f32x16&p0,f32x16&p1,const char*Kslot,const bf16x8*qr,const f32x16&negm,int r32,int hi){
  const char*kb=Kslot+hi*1024+r32*16;
  #pragma unroll
  for(int d0=0;d0<4;++d0){
    const bf16x8 b0=*reinterpret_cast<const bf16x8*>(kb+d0*2048);
    const bf16x8 b1=*reinterpret_cast<const bf16x8*>(kb+d0*2048+512);
    if(d0==0){p0=__builtin_amdgcn_mfma_f32_32x32x16_bf16(b0,qr[0],negm,0,0,0);p1=__builtin_amdgcn_mfma_f32_32x32x16_bf16(b1,qr[0],negm,0,0,0);}
    else{p0=__builtin_amdgcn_mfma_f32_32x32x16_bf16(b0,qr[d0],p0,0,0,0);p1=__builtin_amdgcn_mfma_f32_32x32x16_bf16(b1,qr[d0],p1,0,0,0);}}
}
typedef __attribute__((address_space(3))) const char* lds_cptr;
typedef short v4i16_t __attribute__((ext_vector_type(4)));
__device__ __forceinline__ void kload8(bf16x8*kf,lds_cptr kp){
  kf[0]=*(const __attribute__((address_space(3))) bf16x8*)(kp);      kf[1]=*(const __attribute__((address_space(3))) bf16x8*)(kp+512);
  kf[2]=*(const __attribute__((address_space(3))) bf16x8*)(kp+2048); kf[3]=*(const __attribute__((address_space(3))) bf16x8*)(kp+2560);
  kf[4]=*(const __attribute__((address_space(3))) bf16x8*)(kp+4096); kf[5]=*(const __attribute__((address_space(3))) bf16x8*)(kp+4608);
  kf[6]=*(const __attribute__((address_space(3))) bf16x8*)(kp+6144); kf[7]=*(const __attribute__((address_space(3))) bf16x8*)(kp+6656);
}
__device__ __forceinline__ void kload2(bf16x8*kf,lds_cptr kp,int j){ kf[2*j]=*(const __attribute__((address_space(3))) bf16x8*)(kp+j*2048); kf[2*j+1]=*(const __attribute__((address_space(3))) bf16x8*)(kp+j*2048+512); }
__device__ __forceinline__ s16x4 vtr(lds_cptr p){ return __builtin_bit_cast(s16x4,__builtin_amdgcn_ds_read_tr16_b64_v4i16((__attribute__((address_space(3))) v4i16_t*)p)); }
__device__ __forceinline__ float rowmax(const f32x16&p0,const f32x16&p1){
  float a=max3f(p0[0],p0[1],p1[0]),b=max3f(p0[2],p0[3],p1[1]);a=max3f(a,p1[2],p1[3]);
  #pragma unroll
  for(int r=4;r<16;r+=4){a=max3f(a,p0[r],p0[r+1]);b=max3f(b,p0[r+2],p0[r+3]);a=max3f(a,p1[r],p1[r+1]);b=max3f(b,p1[r+2],p1[r+3]);}
  const float m=max2f(a,b);
  auto rr=__builtin_amdgcn_permlane32_swap(__float_as_uint(m),__float_as_uint(m),false,false);
  return max2f(__uint_as_float(rr[0]),__uint_as_float(rr[1]));
}
__device__ __forceinline__ void pv(f32x16*o,int vb,bf16x8 pa0,bf16x8 pa1,bf16x8 pa2,bf16x8 pa3){
  #pragma unroll
  for(int d0=0;d0<2;++d0){s16x4 lo[4],hi[4];
    #pragma unroll
    for(int ks=0;ks<4;++ks){
      asm volatile("ds_read_b64_tr_b16 %0,%1 offset:%c2":"=&v"(lo[ks]):"v"(vb),"i"(d0*4096+ks*1024):"memory");
      asm volatile("ds_read_b64_tr_b16 %0,%1 offset:%c2":"=&v"(hi[ks]):"v"(vb),"i"(d0*4096+ks*1024+512):"memory");}
    asm volatile("s_waitcnt lgkmcnt(0)":::"memory");SBAR();
    #define PK(k) (bf16x8){lo[k][0],lo[k][1],lo[k][2],lo[k][3],hi[k][0],hi[k][1],hi[k][2],hi[k][3]}
    o[d0]=__builtin_amdgcn_mfma_f32_32x32x16_bf16(pa0,PK(0),o[d0],0,0,0);
    o[d0]=__builtin_amdgcn_mfma_f32_32x32x16_bf16(pa1,PK(1),o[d0],0,0,0);
    o[d0]=__builtin_amdgcn_mfma_f32_32x32x16_bf16(pa2,PK(2),o[d0],0,0,0);
    o[d0]=__builtin_amdgcn_mfma_f32_32x32x16_bf16(pa3,PK(3),o[d0],0,0,0);
    #undef PK
  }
}
template<int THRL> __device__ __forceinline__ void attn_unit(const bf16*Qw,const bf16*__restrict__ Kh,const bf16*__restrict__ Vh,bf16*Ow,char*shm){
  const int tid=threadIdx.x,lane=tid&63,r32=lane&31,hi=lane>>5; const int wid=__builtin_amdgcn_readfirstlane(tid>>6);
  constexpr int DMp=PITCH;
  const unsigned lds0=(unsigned)(uintptr_t)shm;
  float*wsf=(float*)(shm+LDS_WS)+wid*64;
  const bf16*ksrc=Kh+(long)lane*DMp+wid*8;
  const bf16*vsrc=Vh+(long)(16*(wid&3)+(lane>>2))*DMp+(wid>>2)*32+(lane&3)*8;
  const unsigned kdst=lds0+LDS_K+wid*1024, vdst=lds0+LDS_V+wid*1024;
  #define DMA_K(t,slot) glds16(ksrc+(long)(t)*KVBLK*DMp,(unsigned)__builtin_amdgcn_readfirstlane(kdst+(slot)))
  #define DMA_V(t,slot) glds16(vsrc+(long)(t)*KVBLK*DMp,(unsigned)__builtin_amdgcn_readfirstlane(vdst+(slot)))
  const int vb0=(int)(lds0+LDS_V)+((lane>>4)&1)*32+(lane&3)*8+(4*hi+((lane&15)>>2))*64;
  const char*Kbase=shm+LDS_K; bf16x8 kf[8];
  const lds_cptr shm3=(lds_cptr)shm; const lds_cptr kp0=shm3+LDS_K+hi*1024+r32*16; const lds_cptr vp0=shm3+LDS_V+((lane>>4)&1)*32+(lane&3)*8+(4*hi+((lane&15)>>2))*64;
  DMA_K(0,0);DMA_V(0,0);DMA_K(1,SLOTB);
  bf16x8 qr[4];
  #pragma unroll
  for(int d0=0;d0<4;++d0)qr[d0]=*reinterpret_cast<const bf16x8*>(&Qw[(long)r32*DMp+d0*16+hi*8]);
  float mhat=0.f,l_reg=0.f;f32x16 o[2];o[0]=f32x16{};o[1]=f32x16{};f32x16 negm=f32x16{};asm volatile("":"+v"(negm));
  bool resc=false;
  #define START(P0,P1) do{ const float rm=rowmax(P0,P1); resc=false; \
    { const float dl=rm; mhat=fadd_s(mhat,dl); \
      _Pragma("unroll") for(int r=0;r<16;++r){P0[r]=fsub_s(P0[r],dl);P1[r]=fsub_s(P1[r],dl);} \
      _Pragma("unroll") for(int r=0;r<16;++r)negm[r]=-mhat; asm volatile("":"+v"(negm)); } \
    _Pragma("unroll") for(int r=0;r<16;++r)P0[r]=__builtin_amdgcn_exp2f(P0[r]); }while(0)
  #define RESC() do{ if(resc){ asm volatile("s_waitcnt lgkmcnt(0)":::"memory"); \
      _Pragma("unroll") for(int d_=0;d_<2;++d_) _Pragma("unroll") for(int r=0;r<16;++r)o[d_][r]*=wsf[crow(r,hi)]; } }while(0)
  f32x16 pA0,pA1,pB0,pB1;
  int sl_prev=0,sl_cur=0,sl_next=SLOTB;
  #define ROT() do{sl_prev=sl_cur;sl_cur=sl_next;sl_next=(sl_next==(NSLOT-1)*SLOTB)?0:sl_next+SLOTB;}while(0)
  DMA_K(2,2*SLOTB);
  WAIT_BAR(3);
  qkt(pA0,pA1,Kbase,qr,negm,r32,hi);asm volatile("s_nop 15\n\ts_nop 7":"+v"(pA0),"+v"(pA1));
  START(pA0,pA1);
  _Pragma("unroll") for(int r=0;r<16;++r)pA1[r]=__builtin_amdgcn_exp2f(pA1[r]);
  WAIT_BAR(0);
  DMA_K(3,0);DMA_V(1,SLOTB);
  ROT();
  kload8(kf,kp0+sl_cur);
  WAIT_BAR(2);
  s16x4 vlo[8],vhi[8]; u32x4 pw0,pw1,pw2,pw3;
  #define PKW(P,B) cvtpk_s(P[B],P[B+1])
  #define PAF(k) __builtin_bit_cast(bf16x8,pw##k)
  #define VFR(i) (bf16x8){vlo[i][0],vlo[i][1],vlo[i][2],vlo[i][3],vhi[i][0],vhi[i][1],vhi[i][2],vhi[i][3]}
  #define PIN(x) asm volatile("":"+v"(x))
  #define MX3(a,b,c) __builtin_fmaxf(__builtin_fmaxf((a),(b)),(c))
  #define GAPA(MF,A0,A1,A2,A3,W0,W1,PW) do{ MF; sacc+=A0; sacc+=A1; sacc+=A2; sacc+=A3; PIN(sacc); W0; W1; PIN(PW); SBAR(); }while(0)
  #define EX(v) __builtin_amdgcn_exp2f(v)
  #define GAPB(MF,X,B) do{ MF; X[B]=EX(X[B]); X[B+1]=EX(X[B+1]); X[B+2]=EX(X[B+2]); X[B+3]=EX(X[B+3]); PIN(X); SBAR(); }while(0)
  #define VRD(i) do{ vlo[i]=vtr(vp_+(((i)>>2)*4096+((i)&3)*1024)); vhi[i]=vtr(vp_+(((i)>>2)*4096+((i)&3)*1024+512)); }while(0)
  #define KRD(G,j) do{ if(G){ kload2(kf,kp0+sl_next,j); SBAR(); } }while(0)
  #define STEP(C0,C1,P0,P1,t,GK,GV,GL) do{ SBAR(); \
    const lds_cptr vp_=vp0+sl_prev; \
    VRD(0); SBAR(); float sacc=(P0[0]+P0[1]); \
    GAPA(C0=__builtin_amdgcn_mfma_f32_32x32x16_bf16(kf[0],qr[0],negm,0,0,0), P0[2],P0[3],P0[4],P0[5],     pw0[0]=PKW(P0,0), pw0[1]=PKW(P0,2), pw0); \
    VRD(4); SBAR(); GAPA(C1=__builtin_amdgcn_mfma_f32_32x32x16_bf16(kf[1],qr[0],negm,0,0,0), P0[6],P0[7],P0[8],P0[9],     pw0[2]=PKW(P0,4), pw0[3]=PKW(P0,6), pw0); \
    VRD(1); SBAR(); GAPA(C0=__builtin_amdgcn_mfma_f32_32x32x16_bf16(kf[2],qr[1],C0,0,0,0),   P0[10],P0[11],P0[12],P0[13], pw1[0]=PKW(P0,8), pw1[1]=PKW(P0,10), pw1); \
    VRD(5); SBAR(); GAPA(C1=__builtin_amdgcn_mfma_f32_32x32x16_bf16(kf[3],qr[1],C1,0,0,0),   P0[14],P0[15],P1[0],P1[1],   pw1[2]=PKW(P0,12),pw1[3]=PKW(P0,14), pw1); \
    VRD(2); SBAR(); GAPA(C0=__builtin_amdgcn_mfma_f32_32x32x16_bf16(kf[4],qr[2],C0,0,0,0),   P1[2],P1[3],P1[4],P1[5],     pw2[0]=PKW(P1,0), pw2[1]=PKW(P1,2), pw2); \
    VRD(6); SBAR(); GAPA(C1=__builtin_amdgcn_mfma_f32_32x32x16_bf16(kf[5],qr[2],C1,0,0,0),   P1[6],P1[7],P1[8],P1[9],     pw2[2]=PKW(P1,4), pw2[3]=PKW(P1,6), pw2); \
    VRD(3); SBAR(); GAPA(C0=__builtin_amdgcn_mfma_f32_32x32x16_bf16(kf[6],qr[3],C0,0,0,0),   P1[10],P1[11],P1[12],P1[13], pw3[0]=PKW(P1,8), pw3[1]=PKW(P1,10), pw3); \
    VRD(7); SBAR(); GAPA(C1=__builtin_amdgcn_mfma_f32_32x32x16_bf16(kf[7],qr[3],C1,0,0,0),   P1[14],P1[15],0.f,0.f,       pw3[2]=PKW(P1,12),pw3[3]=PKW(P1,14), pw3); \
    l_reg+=sacc; \
    if(GK){DMA_K((t)+3,sl_cur);} if(GV){DMA_V((t)+1,sl_next);} \
    { float a=MX3(C0[0],C0[1],C1[0]),b=MX3(C0[2],C0[3],C1[1]); a=MX3(a,C1[2],C1[3]); \
      _Pragma("unroll") for(int r=4;r<16;r+=4){a=MX3(a,C0[r],C0[r+1]);b=MX3(b,C0[r+2],C0[r+3]);a=MX3(a,C1[r],C1[r+1]);b=MX3(b,C1[r+2],C1[r+3]);} \
      float rm=__builtin_fmaxf(a,b); { auto rr=__builtin_amdgcn_permlane32_swap(__float_as_uint(rm),__float_as_uint(rm),false,false); rm=__builtin_fmaxf(__uint_as_float(rr[0]),__uint_as_float(rr[1])); } \
      resc=false; \
      if(__builtin_expect(__any(rm>(float)THRL),0)){ const float dl=__builtin_fmaxf(rm,0.f); mhat+=dl; \
        _Pragma("unroll") for(int r=0;r<16;++r){C0[r]-=dl;C1[r]-=dl;} \
        _Pragma("unroll") for(int r=0;r<16;++r)negm[r]=-mhat; asm volatile("":"+v"(negm)); \
        const float f=__builtin_amdgcn_exp2f(-dl); l_reg*=f; if(hi==0)wsf[r32]=f; resc=true; } } \
    SBAR(); \
    GAPB(o[0]=__builtin_amdgcn_mfma_f32_32x32x16_bf16(PAF(0),VFR(0),o[0],0,0,0), C0,0); \
    GAPB(o[1]=__builtin_amdgcn_mfma_f32_32x32x16_bf16(PAF(0),VFR(4),o[1],0,0,0), C0,4); \
    KRD(GL,0); GAPB(o[0]=__builtin_amdgcn_mfma_f32_32x32x16_bf16(PAF(1),VFR(1),o[0],0,0,0), C0,8); \
    KRD(GL,1); GAPB(o[1]=__builtin_amdgcn_mfma_f32_32x32x16_bf16(PAF(1),VFR(5),o[1],0,0,0), C0,12); \
    KRD(GL,2); GAPB(o[0]=__builtin_amdgcn_mfma_f32_32x32x16_bf16(PAF(2),VFR(2),o[0],0,0,0), C1,0); \
    KRD(GL,3); GAPB(o[1]=__builtin_amdgcn_mfma_f32_32x32x16_bf16(PAF(2),VFR(6),o[1],0,0,0), C1,4); \
    GAPB(o[0]=__builtin_amdgcn_mfma_f32_32x32x16_bf16(PAF(3),VFR(3),o[0],0,0,0), C1,8); \
    GAPB(o[1]=__builtin_amdgcn_mfma_f32_32x32x16_bf16(PAF(3),VFR(7),o[1],0,0,0), C1,12); \
    }while(0)
  int t=1;
  for(;t+5<NT;t+=2){
    STEP(pB0,pB1,pA0,pA1,t,true,true,true);     WAIT_BAR(2); RESC(); ROT();
    STEP(pA0,pA1,pB0,pB1,t+1,true,true,true);   WAIT_BAR(2); RESC(); ROT();
  }
  #define ENDW(tt) do{ if((tt)+3<NT){WAIT_BAR(2);} else if((tt)+2<NT){WAIT_BAR(1);} else {WAIT_BAR(0);} }while(0)
  for(;t+1<NT;t+=2){
    STEP(pB0,pB1,pA0,pA1,t,(t+3<NT),(t+1<NT),(t+1<NT));       ENDW(t);   RESC(); ROT();
    STEP(pA0,pA1,pB0,pB1,t+1,(t+4<NT),(t+2<NT),(t+2<NT));     ENDW(t+1); RESC(); ROT();
  }
  STEP(pB0,pB1,pA0,pA1,NT-1,false,false,false); RESC();
  { float sacc=pB0[0]+pB0[1]; _Pragma("unroll") for(int r=2;r<16;++r)sacc+=pB0[r]; _Pragma("unroll") for(int r=0;r<16;++r)sacc+=pB1[r]; l_reg+=sacc;
    pw0=(u32x4){PKW(pB0,0),PKW(pB0,2),PKW(pB0,4),PKW(pB0,6)};pw1=(u32x4){PKW(pB0,8),PKW(pB0,10),PKW(pB0,12),PKW(pB0,14)};pw2=(u32x4){PKW(pB1,0),PKW(pB1,2),PKW(pB1,4),PKW(pB1,6)};pw3=(u32x4){PKW(pB1,8),PKW(pB1,10),PKW(pB1,12),PKW(pB1,14)};
    SBAR(); pv(o,vb0+sl_cur,PAF(0),PAF(1),PAF(2),PAF(3)); }
  #undef PKW
  #undef PAF
  #undef VFR
  #undef PIN
  #undef MX3
  #undef GAPA
  #undef GAPB
  #undef EX
  #undef VRD
  #undef KRD
  #undef STEP
  #undef ENDW
  {auto rr=__builtin_amdgcn_permlane32_swap(__float_as_uint(l_reg),__float_as_uint(l_reg),false,false);l_reg=__uint_as_float(rr[0])+__uint_as_float(rr[1]);}
  if(hi==0)wsf[32+r32]=l_reg;asm volatile("s_waitcnt lgkmcnt(0)":::"memory");
  float rli[16];
  #pragma unroll
  for(int r=0;r<16;++r)rli[r]=__builtin_amdgcn_rcpf(wsf[32+crow(r,hi)]);
  { bf16*stg=(bf16*)(shm+LDS_OST)+wid*2048;
    #pragma unroll
    for(int r=0;r<16;++r){const int orow=crow(r,hi);
      #pragma unroll
      for(int d0=0;d0<2;++d0)stg[orow*64+d0*32+r32]=__float2bfloat16(o[d0][r]*rli[r]);}
    asm volatile("s_waitcnt lgkmcnt(0)":::"memory");
    #pragma unroll
    for(int i=0;i<4;++i){const int row=i*8+(lane>>3),ch=lane&7; const u32x4 v=*(const u32x4*)(stg+row*64+ch*8); *(u32x4*)(Ow+(long)row*DMp+ch*8)=v;} }
  asm volatile("s_waitcnt lgkmcnt(0)\n\ts_barrier":::"memory");
  #undef DMA_K
  #undef DMA_V
  #undef START
  #undef RESC
  #undef ROT
}
#undef SBAR
#undef WAIT_BAR
}

constexpr int NWAVES = 8, LDS_BYTES = 147456, RING_BYTES = 131072;
struct Params { const float* in[32]; float* out; unsigned char* ws; int ph_lo, ph_hi; };
enum { I_X = 0, I_C, I_CTX, I_CCTX, I_ADAW, I_ADAB, I_NMIXG, I_NFFNG, I_WIN, I_CONVW, I_CONVB, I_LRUWA, I_LRUBA, I_LRUWX, I_LRUBX, I_LRULAM, I_CMVG, I_CMWS, I_CMBS, I_WOUT0,
       I_WQKV, I_LQ1, I_LK1, I_LQ2, I_LK2, I_SUBLN, I_WOUT1, I_ROUTER, I_W1, I_W3, I_W2, I_FINALG };

typedef const __attribute__((address_space(4))) Params* KParams;
__device__ __forceinline__ Params kparams() {
#if defined(__HIP_DEVICE_COMPILE__)
    KParams q = (KParams)__builtin_amdgcn_kernarg_segment_ptr(); asm volatile("" : "+s"(q)); return *q;
#else
    return Params{};
#endif
}
struct Ctx {
    LAS unsigned char* lds; int tid, lane, wave, vcu, G;
};
__device__ __forceinline__ float wave_sum(float v) {
#pragma unroll
    for (int o = 1; o < 64; o <<= 1) v += __shfl_xor(v, o);
    return v;
}
#define LDS_WAIT() asm volatile("s_waitcnt lgkmcnt(0)" ::: "memory")

__device__ __forceinline__ int dest_row(int n, int mode) {
    if (mode == 1) return n < 2048 ? ((n & ~63) + 2 * (n & 31) + ((n >> 5) & 1)) : n;
    if (mode == 2) return 8 * (n >> 2) + (n & 3);
    if (mode == 3) return 8 * (n >> 2) + 4 + (n & 3);
    return n;
}
__device__ __forceinline__ void p0_transpose_item(const float* W, int K, int N, bf16_t* WT, int mode, LAS float* scr, int item, int lane) {
    const int nblk = N / 32, kb = item / nblk, nb = item % nblk, k0 = 64 * kb, n0 = 32 * nb;
#pragma unroll 8
    for (int i = 0; i < 32; ++i) { const int kk = 2 * i + (lane >> 5); scr[kk * 33 + (lane & 31)] = W[(size_t)(k0 + kk) * N + n0 + (lane & 31)]; }
    LDS_WAIT(); asm volatile("" ::: "memory");
    const int c = lane & 7;
#pragma unroll
    for (int j = 0; j < 4; ++j) { const int n = (lane >> 3) + 8 * j; const LAS float* s = scr + (8 * c) * 33 + n;
        u32x4 o; o.x = pk2(s[0 * 33], s[1 * 33]); o.y = pk2(s[2 * 33], s[3 * 33]); o.z = pk2(s[4 * 33], s[5 * 33]); o.w = pk2(s[6 * 33], s[7 * 33]);
        *(GAS u32x4*)(WT + (size_t)dest_row(n0 + n, mode) * K + k0 + 8 * c) = o; }
    LDS_WAIT(); asm volatile("" ::: "memory");
}
__device__ __forceinline__ void p0_prologue(const Ctx& F, const Params& p) {
    unsigned char* ws = p.ws;
    LAS float* sil = (LAS float*)(F.lds + 8 * 16384);
    for (int i = F.tid; i < 3 * DM; i += 512) { const float v = i < 2 * DM ? p.in[I_C][i] : p.in[I_CCTX][i - 2 * DM]; sil[i] = silu_f(v); }
    __syncthreads();
    {
        float* mod = (float*)(ws + WS_MOD);
        const int task = F.wave * F.G + F.vcu;
        if (task < 768) {
            const int l = task / 384, cgp = task % 384, kq = F.lane >> 4, n = cgp * 16 + (F.lane & 15);
            const float* W = p.in[I_ADAW] + (size_t)l * DM * 6144 + n;
            float a0 = 0.f, a1 = 0.f, a2 = 0.f;
#pragma unroll 16
            for (int k = kq; k < DM; k += 4) { const float w = W[(size_t)k * 6144]; a0 += sil[k] * w; a1 += sil[DM + k] * w; a2 += sil[2 * DM + k] * w; }
            a0 += __shfl_xor(a0, 16); a0 += __shfl_xor(a0, 32); a1 += __shfl_xor(a1, 16); a1 += __shfl_xor(a1, 32); a2 += __shfl_xor(a2, 16); a2 += __shfl_xor(a2, 32);
            if (F.lane < 16) { const float bb = p.in[I_ADAB][l * 6144 + n]; mod[(l * 3 + 0) * 6144 + n] = a0 + bb; mod[(l * 3 + 1) * 6144 + n] = a1 + bb; mod[(l * 3 + 2) * 6144 + n] = a2 + bb; }
        }
    }
    {
        const int gt = F.vcu * 512 + F.tid, NT_ = F.G * 512;
        float* cs = (float*)(ws + WS_ROPE);
        for (int i = gt; i < SEQ * 32; i += NT_) { const int t = i >> 5, pp = i & 31; const float inv = powf(10000.0f, -(float)(2 * (pp & 15)) / 32.0f);
            const float ang = (float)(pp < 16 ? (t >> 6) : (t & 63)) * inv; float s, c; sincosf(ang, &s, &c); cs[2 * i] = c; cs[2 * i + 1] = s; }
        bf16_t* lw = (bf16_t*)(ws + WS_LRUW);
        for (int o = gt; o < 2 * 2 * 8 * 64 * 64; o += NT_) { const int i = o & 63, j = (o >> 6) & 63, h = (o >> 12) & 7, g2 = (o >> 15) & 1, d = o >> 16;
            const float* src = g2 ? p.in[I_LRUWX] : p.in[I_LRUWA]; lw[o] = (bf16_t)f2bf(src[((d * 8 + h) * 64 + i) * 64 + j]); }
        bf16_t* cw = (bf16_t*)(ws + WS_CMWS);
        for (int o = gt; o < 8 * 128 * 128; o += NT_) cw[o] = (bf16_t)f2bf(p.in[I_CMWS][o]);
    }
    LAS float* scr = (LAS float*)(F.lds + F.wave * 16384);
    const int gw = F.vcu * NWAVES + F.wave, NGW = F.G * NWAVES;
    constexpr int I_IN = 1024, I_O0 = 512, I_QK = 1536, I_O1 = 512, I_SMALL = I_IN + I_O0 + I_QK + I_O1, I_MOE = 1024, NITEMS = I_SMALL + 3 * 32 * I_MOE;
    for (int it = gw; it < NITEMS; it += NGW) {
        int r = it;
        if (r < I_SMALL) {
            if (r < I_IN) { p0_transpose_item(p.in[I_WIN], DM, 2048, (bf16_t*)(ws + WS_WIN), 0, scr, r, F.lane); continue; } r -= I_IN;
            if (r < I_O0) { p0_transpose_item(p.in[I_WOUT0], DM, DM, (bf16_t*)(ws + WS_WOUT0), 0, scr, r, F.lane); continue; } r -= I_O0;
            if (r < I_QK) { p0_transpose_item(p.in[I_WQKV], DM, 3072, (bf16_t*)(ws + WS_WQKV), 1, scr, r, F.lane); continue; } r -= I_QK;
            p0_transpose_item(p.in[I_WOUT1], DM, DM, (bf16_t*)(ws + WS_WOUT1), 0, scr, r, F.lane); continue;
        }
        r -= I_SMALL; const int which = r / (32 * I_MOE), le = (r / I_MOE) % 32, item = r % I_MOE;
        if (which == 0) p0_transpose_item(p.in[I_W1] + (size_t)le * DM * FF, DM, FF, (bf16_t*)(ws + WS_W13) + (size_t)le * 4096 * DM, 2, scr, item, F.lane);
        else if (which == 1) p0_transpose_item(p.in[I_W3] + (size_t)le * DM * FF, DM, FF, (bf16_t*)(ws + WS_W13) + (size_t)le * 4096 * DM, 3, scr, item, F.lane);
        else p0_transpose_item(p.in[I_W2] + (size_t)le * FF * DM, FF, DM, (bf16_t*)(ws + WS_W2) + (size_t)le * DM * FF, 0, scr, item, F.lane);
    }
}

__device__ __forceinline__ void ld_row(const float* pr, int lane, f32x4 (&v)[4]) {
#pragma unroll
    for (int j = 0; j < 4; ++j) v[j] = *(const f32x4*)(pr + 4 * lane + 256 * j);
}
__device__ __forceinline__ float row_rstd(const f32x4 (&v)[4]) {
    float s = 0.f;
#pragma unroll
    for (int j = 0; j < 4; ++j) s += (v[j][0] * v[j][0] + v[j][1] * v[j][1]) + (v[j][2] * v[j][2] + v[j][3] * v[j][3]);
    return 1.0f / sqrtf(wave_sum(s) * (1.0f / DM) + EPS);
}
__device__ __forceinline__ void mod_norm(f32x4 (&v)[4], float rstd, const float* g, const float* sc, const float* sh, int lane) {
#pragma unroll
    for (int j = 0; j < 4; ++j) { const int c = 4 * lane + 256 * j; const f32x4 gv = *(const f32x4*)(g + c), sv = *(const f32x4*)(sc + c), hv = *(const f32x4*)(sh + c);
        v[j] = v[j] * rstd * gv * (sv + 1.0f) + hv; }
}
__device__ __forceinline__ void st_row_bf16(bf16_t* pr, int lane, const f32x4 (&v)[4]) {
#pragma unroll
    for (int j = 0; j < 4; ++j) { u32x2 w; w.x = pk2(v[j][0], v[j][1]); w.y = pk2(v[j][2], v[j][3]); *(u32x2*)(pr + 4 * lane + 256 * j) = w; }
}
__device__ __forceinline__ void row_info(int R, int& b, int& j, int& rt) { b = R / LR; j = R % LR; rt = j < CTXL ? 2 : b; }

__device__ __forceinline__ void p_norm1_in(const Ctx& F, const Params& p) {
    const float* mod = (const float*)(p.ws + WS_MOD); bf16_t* H = (bf16_t*)(p.ws + WS_H);
    const int gw = F.vcu * NWAVES + F.wave, NGW = F.G * NWAVES;
    for (int R = gw; R < NR; R += NGW) { int b, j, rt; row_info(R, b, j, rt);
        const float* src = j < CTXL ? p.in[I_CTX] + ((size_t)b * CTXL + j) * DM : p.in[I_X] + ((size_t)b * SEQ + (j - CTXL)) * DM;
        f32x4 v[4]; ld_row(src, F.lane, v); const float rstd = row_rstd(v);
        const float* m = mod + (size_t)(0 * 3 + rt) * 6144; mod_norm(v, rstd, p.in[I_NMIXG], m + DM, m, F.lane);
        st_row_bf16(H + (size_t)R * DM, F.lane, v); }
}
__device__ __forceinline__ void p_norm2_router(const Ctx& F, const Params& p, int l, bool with_ctx) {
    const float* mod = (const float*)(p.ws + WS_MOD); bf16_t* H = (bf16_t*)(p.ws + WS_H); const float* X = (const float*)(p.ws + WS_X); float* aff = (float*)(p.ws + WS_AFF);
    LAS float* wr = (LAS float*)F.lds;
    for (int i = F.tid; i < DM * NE / 4; i += 512) ((LAS f32x4*)wr)[i] = ((const f32x4*)(p.in[I_ROUTER] + (size_t)l * DM * NE))[i];
    __syncthreads();
    const int gw = F.vcu * NWAVES + F.wave, NGW = F.G * NWAVES; const int hi5 = (F.lane >> 5) & 1, hi4 = (F.lane >> 4) & 1, hi3 = (F.lane >> 3) & 1, hi2 = (F.lane >> 2) & 1;
    for (int R = gw; R < NR; R += NGW) { int b, j, rt; row_info(R, b, j, rt);
        if (!with_ctx && j < CTXL) continue;
        f32x4 v[4]; ld_row(X + (size_t)R * DM, F.lane, v); const float rstd = row_rstd(v);
        const float* m = mod + (size_t)(l * 3 + rt) * 6144; mod_norm(v, rstd, p.in[I_NFFNG] + l * DM, m + 4 * DM, m + 3 * DM, F.lane);
        st_row_bf16(H + (size_t)R * DM, F.lane, v);
        float a[16];
#pragma unroll
        for (int e = 0; e < 16; ++e) a[e] = 0.f;
#pragma unroll
        for (int jj = 0; jj < 4; ++jj)
#pragma unroll
            for (int i = 0; i < 4; ++i) { const int c = 4 * F.lane + 256 * jj + i; const float hv = v[jj][i];
#pragma unroll
                for (int q = 0; q < 4; ++q) { const f32x4 w = *(const LAS f32x4*)(wr + c * 16 + 4 * q); a[4 * q] += hv * w[0]; a[4 * q + 1] += hv * w[1]; a[4 * q + 2] += hv * w[2]; a[4 * q + 3] += hv * w[3]; }
                if (i & 1) __builtin_amdgcn_sched_barrier(0); }
        float b8[8], b4[4], b2[2], b1;
#pragma unroll
        for (int i = 0; i < 8; ++i) { const float keep = hi5 ? a[i + 8] : a[i], send = hi5 ? a[i] : a[i + 8]; b8[i] = keep + __shfl_xor(send, 32); }
#pragma unroll
        for (int i = 0; i < 4; ++i) { const float keep = hi4 ? b8[i + 4] : b8[i], send = hi4 ? b8[i] : b8[i + 4]; b4[i] = keep + __shfl_xor(send, 16); }
#pragma unroll
        for (int i = 0; i < 2; ++i) { const float keep = hi3 ? b4[i + 2] : b4[i], send = hi3 ? b4[i] : b4[i + 2]; b2[i] = keep + __shfl_xor(send, 8); }
        { const float keep = hi2 ? b2[1] : b2[0], send = hi2 ? b2[0] : b2[1]; b1 = keep + __shfl_xor(send, 4); }
        b1 += __shfl_xor(b1, 1); b1 += __shfl_xor(b1, 2);
        float mx = b1;
#pragma unroll
        for (int o = 4; o < 64; o <<= 1) mx = fmaxf(mx, __shfl_xor(mx, o));
        const float ex = __expf(b1 - mx); float sm = ex;
#pragma unroll
        for (int o = 4; o < 64; o <<= 1) sm += __shfl_xor(sm, o);
        if ((F.lane & 3) == 0) aff[((size_t)b * NE + (F.lane >> 2)) * LR + j] = ex / sm;
    }
    __syncthreads();
}

__device__ __forceinline__ void p_select(const Ctx& F, const Params& p, bool with_ctx) {
    const float* aff = (const float*)(p.ws + WS_AFF); int* inv = (int*)(p.ws + WS_INV); float* gate = (float*)(p.ws + WS_GATE);
    const bf16_t* H = (const bf16_t*)(p.ws + WS_H); bf16_t* XS = (bf16_t*)(p.ws + WS_XS);
    LAS unsigned* hist = (LAS unsigned*)F.lds;
    LAS unsigned* misc = hist + 256;
    LAS unsigned* list = hist + 512;
    LAS unsigned* vals = hist + 512 + 2048;
    const int nitems = with_ctx ? 288 : 256;
    for (int item = blockIdx.x; item < nitems; item += F.G) {
        const bool isl = item < 256; const int prob = isl ? item >> 3 : item - 256, seg = isl ? item & 7 : 0, b = prob >> 4, e = prob & 15;
        const int n = isl ? SEQ : CTXL, kcap = isl ? 1024 : 32, j0 = isl ? CTXL : 0, nj = isl ? 16 : 1;
        const float* av = aff + ((size_t)b * NE + e) * LR + j0;
#pragma unroll 1
        for (int jj = 0; jj < nj; ++jj) { const int tok = F.tid + 512 * jj; vals[tok] = tok < n ? __float_as_uint(av[tok]) : 0u; }
        unsigned prefix = 0u, mask = 0u, kk = (unsigned)kcap;
#pragma unroll 1
        for (int pass = 0; pass < 4; ++pass) { const int shift = 24 - 8 * pass;
            if (F.tid < 256) hist[F.tid] = 0u;
            __syncthreads();
#pragma unroll 1
            for (int jj = 0; jj < nj; ++jj) { const unsigned bt = vals[F.tid + 512 * jj]; if ((bt & mask) == prefix && bt != 0u) atomicAdd((unsigned*)(hist + ((bt >> shift) & 255u)), 1u); }
            __syncthreads();
            if (F.wave == 0) {
                unsigned loc[4], tot = 0u;
#pragma unroll
                for (int q = 0; q < 4; ++q) { loc[q] = hist[255 - 4 * F.lane - q]; tot += loc[q]; }
                unsigned inc = tot;
#pragma unroll
                for (int o = 1; o < 64; o <<= 1) { const unsigned t2 = __shfl_up(inc, o); if (F.lane >= o) inc += t2; }
                unsigned run = inc - tot;
#pragma unroll
                for (int q = 0; q < 4; ++q) { if (run < kk && run + loc[q] >= kk) { misc[0] = (unsigned)(255 - 4 * F.lane - q); misc[1] = kk - run; } run += loc[q]; }
            }
            __syncthreads();
            prefix |= misc[0] << shift; mask |= 0xffu << shift; kk = misc[1];
            __syncthreads();
        }
        const unsigned T = prefix, need_eq = kk, cnt_gt = (unsigned)kcap - need_eq;
        unsigned cnt = 0u;
#pragma unroll 1
        for (int jj = 0; jj < nj; ++jj) { const unsigned bt = vals[F.tid + 512 * jj]; cnt += (bt > T ? 1u : 0u) + (bt == T ? 0x10000u : 0u); }
        unsigned inc = cnt;
#pragma unroll
        for (int o = 1; o < 64; o <<= 1) { const unsigned t2 = __shfl_up(inc, o); if (F.lane >= o) inc += t2; }
        if (F.lane == 63) misc[8 + F.wave] = inc;
        if (F.tid == 0) misc[2] = 0u;
        __syncthreads();
        unsigned base = inc - cnt;
        for (int w = 0; w < F.wave; ++w) base += misc[8 + w];
        unsigned rg = base & 0xffffu, re = base >> 16;
#pragma unroll 1
        for (int jj = 0; jj < nj; ++jj) { const int tok = F.tid + 512 * jj; const unsigned bt = vals[tok]; const bool own = isl ? ((jj >> 1) == seg) : true;
            const bool isgt = bt > T, iseq = bt == T; int slot = -1;
            if (isgt) { slot = (int)rg; } else if (iseq && re < need_eq) { slot = (int)(cnt_gt + re); }
            rg += isgt ? 1u : 0u; re += iseq ? 1u : 0u;
            if (own && tok < n) { const int R = b * LR + j0 + tok; int er = -1;
                if (slot >= 0) { er = isl ? b * 1024 + slot : 2048 + b * 32 + slot; gate[e * EROWS + er] = __uint_as_float(bt);
                    const unsigned pos = atomicAdd((unsigned*)(misc + 2), 1u); list[2 * pos] = (unsigned)R; list[2 * pos + 1] = (unsigned)er; }
                inv[(size_t)R * NE + e] = er; } }
        __syncthreads();
        const int nl = (int)misc[2];
        for (int i = F.wave; i < nl; i += NWAVES) { const unsigned R = list[2 * i], er = list[2 * i + 1];
            const u32x4* sp = (const u32x4*)(H + (size_t)R * DM); u32x4* d = (u32x4*)(XS + ((size_t)e * EROWS + er) * DM);
            const u32x4 v0 = sp[F.lane], v1 = sp[64 + F.lane]; d[F.lane] = v0; d[64 + F.lane] = v1; }
        __syncthreads();
    }
}

__device__ __forceinline__ void p_combine(const Ctx& F, const Params& p, int l, bool final_) {
    const float* mod = (const float*)(p.ws + WS_MOD); bf16_t* H = (bf16_t*)(p.ws + WS_H); float* X = (float*)(p.ws + WS_X); const int* inv = (const int*)(p.ws + WS_INV);
    const bf16_t* YB = (const bf16_t*)(p.ws + WS_XS);
    const int gw = F.vcu * NWAVES + F.wave, NGW = F.G * NWAVES;
    for (int R = gw; R < NR; R += NGW) { int b, j, rt; row_info(R, b, j, rt);
        if (final_ && j < CTXL) continue;
        f32x4 v[4]; ld_row(X + (size_t)R * DM, F.lane, v);
        const int myinv = F.lane < NE ? inv[(size_t)R * NE + F.lane] : -1;
        f32x4 mo[4];
#pragma unroll
        for (int jj = 0; jj < 4; ++jj) mo[jj] = (f32x4){0.f, 0.f, 0.f, 0.f};
#pragma unroll
        for (int e = 0; e < NE; ++e) { const int er = __builtin_amdgcn_readlane(myinv, e);
            if (er >= 0) { const bf16_t* yr = YB + ((size_t)e * EROWS + er) * DM;
#pragma unroll
                for (int jj = 0; jj < 4; ++jj) { const u32x2 w = *(const u32x2*)(yr + 4 * F.lane + 256 * jj); mo[jj][0] += bflo(w.x); mo[jj][1] += bfhi(w.x); mo[jj][2] += bflo(w.y); mo[jj][3] += bfhi(w.y); } } }
        const float* m = mod + (size_t)(l * 3 + rt) * 6144;
#pragma unroll
        for (int jj = 0; jj < 4; ++jj) { const f32x4 g2 = *(const f32x4*)(m + 5 * DM + 4 * F.lane + 256 * jj); v[jj] = v[jj] + g2 * mo[jj]; }
        const float rstd = row_rstd(v);
        if (final_) { float* o = p.out + ((size_t)b * SEQ + (j - CTXL)) * DM;
#pragma unroll
            for (int jj = 0; jj < 4; ++jj) { const int c = 4 * F.lane + 256 * jj; *(f32x4*)(o + c) = v[jj] * rstd * *(const f32x4*)(p.in[I_FINALG] + c); } }
        else {
#pragma unroll
            for (int jj = 0; jj < 4; ++jj) *(f32x4*)(X + (size_t)R * DM + 4 * F.lane + 256 * jj) = v[jj];
            const float* m1 = mod + (size_t)((l + 1) * 3 + rt) * 6144; mod_norm(v, rstd, p.in[I_NMIXG] + (l + 1) * DM, m1 + DM, m1, F.lane);
            st_row_bf16(H + (size_t)R * DM, F.lane, v); }
    }
}

__device__ __forceinline__ void p_lru(const Ctx& F, const Params& p, bool full) {
    const bf16_t* Z = (const bf16_t*)(p.ws + WS_ACT + ACT_Z); bf16_t* YC = (bf16_t*)(p.ws + WS_ACT + ACT_YCAT); const bf16_t* LW = (const bf16_t*)(p.ws + WS_LRUW);
    f32x2* SUM = (f32x2*)(p.ws + WS_SUM);
    LAS float* recS = (LAS float*)F.lds;
    LAS float* xcF = recS + 67 * 64;
    LAS float* aS = xcF + 64 * 64;
    LAS float* uS = aS + 2 * 64 * 64;
    LAS float* cst = uS + 2 * 64 * 64;
    LAS bf16_t* xcB = (LAS bf16_t*)(cst + 1024 + 128);
    const int wave = F.wave, lane = F.lane, tid = F.tid;
    for (int item = blockIdx.x; item < NTILE64 * 8; item += F.G) {
        const int T = item >> 3, h = item & 7, b = T / 132, jt = T % 132; const bool isctx = jt < 4;
        const int R0 = b * LR + jt * 64;
        const int slo = isctx ? 0 : CTXL, shi = isctx ? CTXL : LR;
        const int jbase = jt * 64;
        { const int r = tid >> 3, c8 = tid & 7; const u32x4 w = *(const u32x4*)(Z + (size_t)(R0 + r) * 2048 + 512 + h * 64 + c8 * 8); LAS float* d = recS + (r + 2) * 64 + c8 * 8;
          d[0] = bflo(w.x); d[1] = bfhi(w.x); d[2] = bflo(w.y); d[3] = bfhi(w.y); d[4] = bflo(w.z); d[5] = bfhi(w.z); d[6] = bflo(w.w); d[7] = bfhi(w.w);
          if (tid < 24) { const int hr = tid >> 3; const int rr = hr == 0 ? -2 : (hr == 1 ? -1 : 64); const int jj = jbase + rr; LAS float* d2 = recS + (rr + 2) * 64 + c8 * 8;
              if (jj >= slo && jj < shi) { const u32x4 w2 = *(const u32x4*)(Z + (size_t)(R0 + rr) * 2048 + 512 + h * 64 + c8 * 8);
                  d2[0] = bflo(w2.x); d2[1] = bfhi(w2.x); d2[2] = bflo(w2.y); d2[3] = bfhi(w2.y); d2[4] = bflo(w2.z); d2[5] = bfhi(w2.z); d2[6] = bflo(w2.w); d2[7] = bfhi(w2.w); }
              else {
#pragma unroll
                  for (int i = 0; i < 8; ++i) d2[i] = 0.f; } } }
        __syncthreads();
        { const int r = tid >> 3, c8 = (tid & 7) * 8; const float* cw = p.in[I_CONVW] + h * 64 + c8; const float* cb = p.in[I_CONVB] + h * 64 + c8;
          float y[8];
#pragma unroll
          for (int i = 0; i < 8; ++i) { y[i] = cb[i];
#pragma unroll
              for (int q = 0; q < 4; ++q) y[i] += cw[q * 512 + i] * recS[(r + q) * 64 + c8 + i]; }
#pragma unroll
          for (int i = 0; i < 8; ++i) xcF[r * 64 + c8 + i] = y[i];
          u32x4 w; w.x = pk2(y[0], y[1]); w.y = pk2(y[2], y[3]); w.z = pk2(y[4], y[5]); w.w = pk2(y[6], y[7]);
          *(LAS u32x4*)(xcB + r * 72 + c8) = w; }
        __syncthreads();
        { const int d = wave >> 2, mf = wave & 3, fr = lane & 15, fq = lane >> 4;
          bf16x8 af[2];
#pragma unroll
          for (int ks = 0; ks < 2; ++ks) af[ks] = *(const LAS bf16x8*)(xcB + (16 * mf + fr) * 72 + 32 * ks + 8 * fq);
          f32x4 acc[2][4];
#pragma unroll
          for (int g2 = 0; g2 < 2; ++g2)
#pragma unroll
              for (int nf = 0; nf < 4; ++nf) { acc[g2][nf] = (f32x4){0.f, 0.f, 0.f, 0.f};
#pragma unroll
                  for (int ks = 0; ks < 2; ++ks) { const bf16x8 bfr = *(const bf16x8*)(LW + ((size_t)(((d * 2 + g2) * 8 + h) * 64 + 16 * nf + fr)) * 64 + 32 * ks + 8 * fq);
                      acc[g2][nf] = __builtin_amdgcn_mfma_f32_16x16x32_bf16(af[ks], bfr, acc[g2][nf], 0, 0, 0); } }
#pragma unroll
          for (int nf = 0; nf < 4; ++nf) { const int ch = 16 * nf + fr, gch = d * 512 + h * 64 + ch;
              const float ba = p.in[I_LRUBA][gch], bx = p.in[I_LRUBX][gch], lam = p.in[I_LRULAM][gch];
              const float cA = -8.0f * log1pf(__expf(-lam));
#pragma unroll
              for (int r = 0; r < 4; ++r) { const int tk = 16 * mf + 4 * fq + r;
                  const float rg = sigmoid_f(acc[0][nf][r] + ba), ig = sigmoid_f(acc[1][nf][r] + bx);
                  const float la = rg * cA, a = __expf(la), mult = sqrtf(-expm1f(2.0f * la));
                  aS[(d * 64 + tk) * 64 + ch] = a; uS[(d * 64 + tk) * 64 + ch] = mult * ig * xcF[tk * 64 + ch]; } } }
        if (full) {
            const int dc = tid & 127, d = dc >> 6, ch = dc & 63, sg = tid >> 7;
            const int n = d == 0 ? jt : (isctx ? 3 - jt : 4 + 131 - jt);
            const int i0 = (n * sg) / 4, i1 = (n * (sg + 1)) / 4;
            float P = 1.f, Hs = 0.f;
            for (int i = i0; i < i1; ++i) { const int jp = d == 0 ? i : (isctx ? 3 - i : (i < 4 ? 3 - i : 135 - i));
                const f32x2 s = SUM[((size_t)(b * 132 + jp) * 2 + d) * 512 + h * 64 + ch]; Hs = s.x * Hs + s.y; P = P * s.x; }
            cst[(sg * 128 + dc) * 2] = P; cst[(sg * 128 + dc) * 2 + 1] = Hs;
        }
        __syncthreads();
        if (full && tid < 128) { float s = 0.f;
#pragma unroll
            for (int sg = 0; sg < 4; ++sg) s = cst[(sg * 128 + tid) * 2] * s + cst[(sg * 128 + tid) * 2 + 1];
            cst[1024 + tid] = s; }
        if (tid < 128) { const int d = tid >> 6, ch = tid & 63;
            float hs = full ? cst[1024 + tid] : 0.f, P = 1.f;
            if (d == 0) {
#pragma unroll 8
                for (int t = 0; t < 64; ++t) { const float a = aS[t * 64 + ch]; hs = a * hs + uS[t * 64 + ch]; P *= a; if (full) uS[t * 64 + ch] = hs; }
            } else {
#pragma unroll 8
                for (int t = 63; t >= 0; --t) { const float a = aS[(64 + t) * 64 + ch]; hs = a * hs + uS[(64 + t) * 64 + ch]; P *= a; if (full) uS[(64 + t) * 64 + ch] = hs; }
            }
            if (!full) SUM[((size_t)T * 2 + d) * 512 + h * 64 + ch] = (f32x2){P, hs};
        }
        __syncthreads();
        if (full) { const int r = tid >> 3, c8 = (tid & 7) * 8; const u32x4 gw_ = *(const u32x4*)(Z + (size_t)(R0 + r) * 2048 + h * 64 + c8);
            float gg[8] = {bflo(gw_.x), bfhi(gw_.x), bflo(gw_.y), bfhi(gw_.y), bflo(gw_.z), bfhi(gw_.z), bflo(gw_.w), bfhi(gw_.w)}; float y[8];
#pragma unroll
            for (int i = 0; i < 8; ++i) y[i] = gg[i] * (uS[r * 64 + c8 + i] + uS[(64 + r) * 64 + c8 + i]);
            u32x4 w; w.x = pk2(y[0], y[1]); w.y = pk2(y[2], y[3]); w.z = pk2(y[4], y[5]); w.w = pk2(y[6], y[7]);
            *(u32x4*)(YC + (size_t)(R0 + r) * DM + h * 64 + c8) = w; }
        __syncthreads();
    }
}

__device__ __forceinline__ void p_cm(const Ctx& F, const Params& p) {
    const bf16_t* Z = (const bf16_t*)(p.ws + WS_ACT + ACT_Z); bf16_t* YC = (bf16_t*)(p.ws + WS_ACT + ACT_YCAT); const bf16_t* CW = (const bf16_t*)(p.ws + WS_CMWS);
    LAS bf16_t* vnT = (LAS bf16_t*)F.lds;
    const int wave = F.wave, lane = F.lane, tid = F.tid, fr = lane & 15, fq = lane >> 4;
    for (int item = blockIdx.x; item < (NR / 128) * 8; item += F.G) {
        const int cn = item >> 3, g = item & 7; const int R0 = cn * 128;
        { const int q = tid >> 2, part = tid & 3; const bf16_t* src = Z + (size_t)(R0 + q) * 2048 + 1536 + g * 64 + part * 16;
          const u32x4 w0 = *(const u32x4*)src, w1 = *(const u32x4*)(src + 8);
          float v[16] = {bflo(w0.x), bfhi(w0.x), bflo(w0.y), bfhi(w0.y), bflo(w0.z), bfhi(w0.z), bflo(w0.w), bfhi(w0.w), bflo(w1.x), bfhi(w1.x), bflo(w1.y), bfhi(w1.y), bflo(w1.z), bfhi(w1.z), bflo(w1.w), bfhi(w1.w)};
          float ss = 0.f;
#pragma unroll
          for (int i = 0; i < 16; ++i) ss += v[i] * v[i];
          ss += __shfl_xor(ss, 1); ss += __shfl_xor(ss, 2);
          const float rstd = 1.0f / sqrtf(ss * (1.0f / 64.0f) + EPS); const float* vg = p.in[I_CMVG] + g * 64 + part * 16;
#pragma unroll
          for (int i = 0; i < 16; ++i) vnT[(part * 16 + i) * 136 + q] = (bf16_t)f2bf(v[i] * rstd * vg[i]); }
        __syncthreads();
        f32x4 acc[4];
#pragma unroll
        for (int nf = 0; nf < 4; ++nf) acc[nf] = (f32x4){0.f, 0.f, 0.f, 0.f};
#pragma unroll
        for (int ks = 0; ks < 4; ++ks) { const bf16x8 af = *(const bf16x8*)(CW + ((size_t)g * 128 + 16 * wave + fr) * 128 + 32 * ks + 8 * fq);
#pragma unroll
            for (int nf = 0; nf < 4; ++nf) { const bf16x8 bfr = *(const LAS bf16x8*)(vnT + (16 * nf + fr) * 136 + 32 * ks + 8 * fq);
                acc[nf] = __builtin_amdgcn_mfma_f32_16x16x32_bf16(af, bfr, acc[nf], 0, 0, 0); } }
#pragma unroll
        for (int r = 0; r < 4; ++r) { const int pp = 16 * wave + 4 * fq + r; const float bs = p.in[I_CMBS][g * 128 + pp];
#pragma unroll
            for (int nf = 0; nf < 4; ++nf) { const int c = 16 * nf + fr; const float ug = bf2f(Z[(size_t)(R0 + pp) * 2048 + 1024 + g * 64 + c]);
                YC[(size_t)(R0 + pp) * DM + 512 + g * 64 + c] = (bf16_t)f2bf(ug * (acc[nf][r] + bs)); } }
        __syncthreads();
    }
}

__device__ __forceinline__ void p_attn(const Ctx& F, const Params& p, unsigned char* lds_generic) {
    using abf = attn_body::bf16;
    const abf* Q = (const abf*)(p.ws + WS_ACT + ACT_Q); const abf* Kb = (const abf*)(p.ws + WS_ACT + ACT_K); const abf* Vb = (const abf*)(p.ws + WS_ACT + ACT_V);
    const int wid = F.wave;
    for (int i = 0; i < 8; ++i) { const int combo = i * 8 + (F.vcu >> 5), qb = F.vcu & 31;
        const int b = combo >> 5, h = (combo >> 2) & 7, m = (combo >> 1) & 1, half = combo & 1;
        abf* O = (abf*)(p.ws + WS_ACT + (m ? ACT_O2 : ACT_O1));
        const abf* Qw = Q + ((size_t)b * LR + CTXL + qb * 256 + wid * 32) * DM + (h * 2 + m) * 64;
        const abf* Kh = Kb + (size_t)b * LR * DM + (h * 2 + m) * 64;
        const abf* Vh = Vb + (size_t)b * LR * DM + h * 128 + half * 64;
        abf* Ow = O + ((size_t)b * SEQ + qb * 256 + wid * 32) * DM + h * 128 + half * 64;
        attn_body::attn_unit<8>(Qw, Kh, Vh, Ow, (char*)lds_generic); }
}
__device__ __forceinline__ void p_attn_combine(const Ctx& F, const Params& p) {
    const bf16_t* O1 = (const bf16_t*)(p.ws + WS_ACT + ACT_O1); const bf16_t* O2 = (const bf16_t*)(p.ws + WS_ACT + ACT_O2); bf16_t* A = (bf16_t*)(p.ws + WS_ACT + ACT_A);
    const float lam_init = 0.8f - 0.6f * expf(-0.3f);
    float s1 = F.lane < 64 ? p.in[I_LQ1][F.lane] * p.in[I_LK1][F.lane] : 0.f, s2 = p.in[I_LQ2][F.lane] * p.in[I_LK2][F.lane];
    s1 = wave_sum(s1); s2 = wave_sum(s2);
    const float lam = expf(s1) - expf(s2) + lam_init, osc = 1.0f - lam_init;
    f32x4 gsub[4];
#pragma unroll
    for (int q = 0; q < 4; ++q) gsub[q] = *(const f32x4*)(p.in[I_SUBLN] + 16 * (F.lane & 7) + 4 * q);
    const int gw = F.vcu * NWAVES + F.wave, NGW = F.G * NWAVES;
    for (int r = gw; r < NLAT; r += NGW) {
        const u32x4* a1 = (const u32x4*)(O1 + (size_t)r * DM + 16 * F.lane); const u32x4* a2 = (const u32x4*)(O2 + (size_t)r * DM + 16 * F.lane);
        const u32x4 x0 = a1[0], x1 = a1[1], y0 = a2[0], y1 = a2[1];
        float o[16];
        o[0] = bflo(x0.x) - lam * bflo(y0.x); o[1] = bfhi(x0.x) - lam * bfhi(y0.x); o[2] = bflo(x0.y) - lam * bflo(y0.y); o[3] = bfhi(x0.y) - lam * bfhi(y0.y);
        o[4] = bflo(x0.z) - lam * bflo(y0.z); o[5] = bfhi(x0.z) - lam * bfhi(y0.z); o[6] = bflo(x0.w) - lam * bflo(y0.w); o[7] = bfhi(x0.w) - lam * bfhi(y0.w);
        o[8] = bflo(x1.x) - lam * bflo(y1.x); o[9] = bfhi(x1.x) - lam * bfhi(y1.x); o[10] = bflo(x1.y) - lam * bflo(y1.y); o[11] = bfhi(x1.y) - lam * bfhi(y1.y);
        o[12] = bflo(x1.z) - lam * bflo(y1.z); o[13] = bfhi(x1.z) - lam * bfhi(y1.z); o[14] = bflo(x1.w) - lam * bflo(y1.w); o[15] = bfhi(x1.w) - lam * bfhi(y1.w);
        float ss = 0.f;
#pragma unroll
        for (int i = 0; i < 16; ++i) ss += o[i] * o[i];
        ss += __shfl_xor(ss, 1); ss += __shfl_xor(ss, 2); ss += __shfl_xor(ss, 4);
        const float rstd = osc / sqrtf(ss * (1.0f / 128.0f) + EPS);
        u32x4 w0, w1;
        w0.x = pk2(o[0] * rstd * gsub[0][0], o[1] * rstd * gsub[0][1]); w0.y = pk2(o[2] * rstd * gsub[0][2], o[3] * rstd * gsub[0][3]);
        w0.z = pk2(o[4] * rstd * gsub[1][0], o[5] * rstd * gsub[1][1]); w0.w = pk2(o[6] * rstd * gsub[1][2], o[7] * rstd * gsub[1][3]);
        w1.x = pk2(o[8] * rstd * gsub[2][0], o[9] * rstd * gsub[2][1]); w1.y = pk2(o[10] * rstd * gsub[2][2], o[11] * rstd * gsub[2][3]);
        w1.z = pk2(o[12] * rstd * gsub[3][0], o[13] * rstd * gsub[3][1]); w1.w = pk2(o[14] * rstd * gsub[3][2], o[15] * rstd * gsub[3][3]);
        u32x4* d = (u32x4*)(A + (size_t)r * DM + 16 * F.lane); d[0] = w0; d[1] = w1;
    }
}


#define XB_TMO      128
#define XB_XCNT(j)  (256  + 64 * (j))
#define XB_XSUB(j)  (1280 + 64 * (j))
#define XB_XGEN(j)  (2304 + 64 * (j))
#define XB_TOP      3328
#define XB_TOPGEN   3392
#define XCD_BAR_WORDS 3456
#define XB_SPIN_CAP (1u << 18)
__device__ __forceinline__ unsigned xb_ld(unsigned* p)              { return __hip_atomic_load(p, __ATOMIC_RELAXED, __HIP_MEMORY_SCOPE_AGENT); }
__device__ __forceinline__ unsigned xb_add(unsigned* p, unsigned v) { return __hip_atomic_fetch_add(p, v, __ATOMIC_RELAXED, __HIP_MEMORY_SCOPE_AGENT); }
__device__ __forceinline__ unsigned xb_xcc_id() { return (unsigned)__builtin_amdgcn_s_getreg((3 << 11) | 20) & 0xFu; }
#define XB_SPIN(cond, bar) do { unsigned _sp = 0; while (cond) { __builtin_amdgcn_s_sleep(1); \
    if ((++_sp & 255u) == 0u) { if (xb_ld(&(bar)[XB_TMO])) break; if (_sp > XB_SPIN_CAP) { atomicAdd(&(bar)[XB_TMO], 1u); break; } } } } while (0)
struct XcdBarrier { unsigned* bar; unsigned x; volatile LAS unsigned* st; };
__device__ __forceinline__ void xcd_barrier_complete(unsigned* bar, unsigned x, unsigned& nloc, unsigned& nx) {
    const unsigned G = gridDim.x * gridDim.y * gridDim.z;
    unsigned sum, cnt, mine, sp = 0u;
    for (;;) {
        sum = 0u; cnt = 0u; mine = 0u;
#pragma unroll
        for (unsigned j = 0; j < 16; ++j) { const unsigned c = xb_ld(&bar[XB_XCNT(j)]); sum += c; cnt += (c > 0u) ? 1u : 0u; mine = (j == x) ? c : mine; }
        if (sum == G) break;
        __builtin_amdgcn_s_sleep(1);
        if ((++sp & 255u) == 0u) { if (xb_ld(&bar[XB_TMO])) break; if (sp > XB_SPIN_CAP) { atomicAdd(&bar[XB_TMO], 1u); break; } }
    }
    nloc = mine > 0u ? mine : 1u; nx = cnt > 0u ? cnt : 1u;
}
__device__ __forceinline__ void xcd_barrier(const XcdBarrier& b) {
    asm volatile("s_waitcnt vmcnt(0)" ::: "memory");
    __syncthreads();
    if (threadIdx.x == 0) {
        unsigned* bar = b.bar;
        __builtin_amdgcn_s_waitcnt(0);
        unsigned nloc = b.st[0], nx = b.st[1];
        if (nloc == 0u) { xcd_barrier_complete(bar, b.x, nloc, nx); b.st[0] = nloc; b.st[1] = nx; }
        const unsigned old = xb_add(&bar[XB_XSUB(b.x)], 1u);
        const unsigned gen = old / nloc;
        if (old + 1u == (gen + 1u) * nloc) {
            __builtin_amdgcn_fence(__ATOMIC_RELEASE, "agent");
            asm volatile("s_waitcnt vmcnt(0)" ::: "memory");
            const unsigned og = xb_add(&bar[XB_TOP], 1u);
            const unsigned tg = og / nx;
            if (og + 1u == (tg + 1u) * nx) xb_add(&bar[XB_TOPGEN], 1u);
            else XB_SPIN(xb_ld(&bar[XB_TOPGEN]) == tg, bar);
            __builtin_amdgcn_fence(__ATOMIC_ACQUIRE, "agent");
            xb_add(&bar[XB_XGEN(b.x)], 1u);
            asm volatile("s_waitcnt vmcnt(0)" ::: "memory");
        } else {
            XB_SPIN(xb_ld(&bar[XB_XGEN(b.x)]) == gen, bar);
            __builtin_amdgcn_fence(__ATOMIC_ACQUIRE, "agent");
            asm volatile("s_waitcnt vmcnt(0)" ::: "memory");
        }
    }
    __syncthreads();
}

__global__ void __launch_bounds__(NWAVES * 64, 2) mk_fwd(Params p_unused) {
    extern __shared__ __attribute__((aligned(16))) unsigned char lds[];
#define MAKE_CTX Ctx F; { int t_ = threadIdx.x; asm volatile("" : "+v"(t_)); F.lds = (LAS unsigned char*)lds; F.tid = t_; F.lane = t_ & 63; F.wave = __builtin_amdgcn_readfirstlane(t_ >> 6); \
    F.G = gridDim.x; const int bx = blockIdx.x; F.vcu = (F.G % 8 == 0) ? (bx % 8) * (F.G / 8) + bx / 8 : bx; }
    int lo, hi; unsigned* barw; { const Params q0 = kparams(); lo = q0.ph_lo; hi = q0.ph_hi; barw = (unsigned*)(q0.ws + WS_CTL) + 4096; }
    volatile LAS unsigned* bst = (volatile LAS unsigned*)((LAS unsigned char*)lds + RING_BYTES + 12288 + 1024);
    if (threadIdx.x < 2) bst[threadIdx.x] = 0u;
    __syncthreads();
    if (threadIdx.x == 0) (void)xb_add(&barw[XB_XCNT(xb_xcc_id())], 1u);
#ifndef PH_MASK
#define PH_MASK 0xFFFFFu
#endif
#define IN(k) (((PH_MASK >> (k)) & 1u) && lo <= (k) && (k) < hi)
#define SEAM(k) do { if (IN(k) && IN((k) + 1)) { if ((k) == 0) cg::this_grid().sync(); else { XcdBarrier xb_; xb_.bar = barw; xb_.x = xb_xcc_id(); xb_.st = bst; xcd_barrier(xb_); } } } while (0)
#define PHASE_VARS MAKE_CTX const Params p = kparams(); unsigned char* ws = p.ws; const float* mod = (const float*)(ws + WS_MOD); bf16_t* Hb = (bf16_t*)(ws + WS_H); (void)mod; (void)Hb;

    if (IN(0)) { PHASE_VARS p0_prologue(F, p); } SEAM(0);
    if (IN(1)) { PHASE_VARS p_norm1_in(F, p); } SEAM(1);
    if (IN(2)) { PHASE_VARS
        pg8::Gemm g{Hb, (const bf16_t*)(ws + WS_WIN), DM, 0, 0}; pg8::GOrder S; S.init(NR / 256, 8, 1, F.G, (int)blockIdx.x);
        pg8::EpiWin E{(bf16_t*)(ws + WS_ACT + ACT_Z)}; pg8::gemm_phase(F.lds, g, S, E); } SEAM(2);
    if (IN(3)) { PHASE_VARS p_lru(F, p, false); p_cm(F, p); } SEAM(3);
    if (IN(4)) { PHASE_VARS p_lru(F, p, true); } SEAM(4);
    if (IN(5)) { PHASE_VARS
        pg8::Gemm g{(const bf16_t*)(ws + WS_ACT + ACT_YCAT), (const bf16_t*)(ws + WS_WOUT0), DM, 0, 0}; pg8::GOrder S; S.init(NR / 256, 4, 1, F.G, (int)blockIdx.x);
        pg8::EpiRes E{(float*)(ws + WS_X), p.in[I_X], p.in[I_CTX], mod + 2 * DM, 0}; pg8::gemm_phase(F.lds, g, S, E); } SEAM(5);
    if (IN(6)) { PHASE_VARS p_norm2_router(F, p, 0, true); } SEAM(6);
    if (IN(7)) { PHASE_VARS p_select(F, p, true); } SEAM(7);
    if (IN(8)) { PHASE_VARS
        pg8::Gemm g{(const bf16_t*)(ws + WS_XS), (const bf16_t*)(ws + WS_W13), DM, (size_t)EROWS * DM * 2, (size_t)4096 * DM * 2}; pg8::GOrder S; S.init(9, 16, NE, F.G, (int)blockIdx.x);
        pg8::EpiSwiGLU E{(bf16_t*)(ws + WS_ACT + ACT_HID)}; pg8::gemm_phase(F.lds, g, S, E); } SEAM(8);
    if (IN(9)) { PHASE_VARS
        pg8::Gemm g{(const bf16_t*)(ws + WS_ACT + ACT_HID), (const bf16_t*)(ws + WS_W2), FF, (size_t)EROWS * FF * 2, (size_t)DM * FF * 2}; pg8::GOrder S; S.init(9, 4, NE, F.G, (int)blockIdx.x);
        pg8::EpiMoeOut E{(bf16_t*)(ws + WS_XS), (const float*)(ws + WS_GATE)}; pg8::gemm_phase(F.lds, g, S, E); } SEAM(9);
    if (IN(10)) { PHASE_VARS p_combine(F, p, 0, false); } SEAM(10);
    if (IN(11)) { PHASE_VARS
        pg8::Gemm g{Hb, (const bf16_t*)(ws + WS_WQKV), DM, 0, 0}; pg8::GOrder S; S.init(NR / 256, 12, 1, F.G, (int)blockIdx.x);
        pg8::EpiQKV E{(bf16_t*)(ws + WS_ACT + ACT_Q), (const float*)(ws + WS_ROPE)}; pg8::gemm_phase(F.lds, g, S, E); } SEAM(11);
    if (IN(12)) { PHASE_VARS p_attn(F, p, lds); } SEAM(12);
    if (IN(13)) { PHASE_VARS p_attn_combine(F, p); } SEAM(13);
    if (IN(14)) { PHASE_VARS
        pg8::Gemm g{(const bf16_t*)(ws + WS_ACT + ACT_A), (const bf16_t*)(ws + WS_WOUT1), DM, 0, 0}; pg8::GOrder S; S.init(NLAT / 256, 4, 1, F.G, (int)blockIdx.x);
        pg8::EpiRes E{(float*)(ws + WS_X), nullptr, nullptr, mod + 3 * 6144 + 2 * DM, 1}; pg8::gemm_phase(F.lds, g, S, E); } SEAM(14);
    if (IN(15)) { PHASE_VARS p_norm2_router(F, p, 1, false); } SEAM(15);
    if (IN(16)) { PHASE_VARS p_select(F, p, false); } SEAM(16);
    if (IN(17)) { PHASE_VARS
        pg8::Gemm g{(const bf16_t*)(ws + WS_XS), (const bf16_t*)(ws + WS_W13) + (size_t)NE * 4096 * DM, DM, (size_t)EROWS * DM * 2, (size_t)4096 * DM * 2}; pg8::GOrder S; S.init(8, 16, NE, F.G, (int)blockIdx.x);
        pg8::EpiSwiGLU E{(bf16_t*)(ws + WS_ACT + ACT_HID)}; pg8::gemm_phase(F.lds, g, S, E); } SEAM(17);
    if (IN(18)) { PHASE_VARS
        pg8::Gemm g{(const bf16_t*)(ws + WS_ACT + ACT_HID), (const bf16_t*)(ws + WS_W2) + (size_t)NE * DM * FF, FF, (size_t)EROWS * FF * 2, (size_t)DM * FF * 2}; pg8::GOrder S; S.init(8, 4, NE, F.G, (int)blockIdx.x);
        pg8::EpiMoeOut E{(bf16_t*)(ws + WS_XS), (const float*)(ws + WS_GATE)}; pg8::gemm_phase(F.lds, g, S, E); } SEAM(18);
    if (IN(19)) { PHASE_VARS p_combine(F, p, 1, true); }
#undef IN
#undef SEAM
}

extern "C" void kernel_launch(void* const* d_in, const int* in_sizes, int n_in, void* d_out, int out_size, void* d_ws, size_t ws_size, hipStream_t stream) {
    static int grid = 0;
    if (grid == 0) {
        if (n_in != 32 || out_size != NLAT * DM || ws_size < WS_END) { fprintf(stderr, "kernel_launch: unexpected problem (n_in %d, out %d, ws %zu)\n", n_in, out_size, ws_size); grid = -1; return; }
        int dev = 0, cus = 0, per_cu = 0;
        if (hipGetDevice(&dev) != hipSuccess || hipDeviceGetAttribute(&cus, hipDeviceAttributeMultiprocessorCount, dev) != hipSuccess) { grid = -1; return; }
        if (hipFuncSetAttribute((const void*)mk_fwd, hipFuncAttributeMaxDynamicSharedMemorySize, LDS_BYTES) != hipSuccess) { fprintf(stderr, "kernel_launch: hipFuncSetAttribute failed\n"); grid = -1; return; }
        if (hipOccupancyMaxActiveBlocksPerMultiprocessor(&per_cu, (const void*)mk_fwd, NWAVES * 64, LDS_BYTES) != hipSuccess || per_cu < 1) { fprintf(stderr, "kernel_launch: occupancy query says %d\n", per_cu); per_cu = 1; }
        (void)hipGetLastError();
        grid = cus;
    }
    if (grid < 0) return;
    if (hipMemsetAsync((char*)d_ws + WS_CTL, 0, 65536, stream) != hipSuccess) { fprintf(stderr, "kernel_launch: memset failed\n"); return; }
    Params a{};
    for (int i = 0; i < 32; ++i) a.in[i] = (const float*)d_in[i];
    a.out = (float*)d_out; a.ws = (unsigned char*)d_ws;
#if MK_N_LAUNCHES == 1
    a.ph_lo = 0; a.ph_hi = NPH;
    void* args[] = {&a};
    hipError_t e = hipLaunchCooperativeKernel((const void*)mk_fwd, dim3(grid), dim3(NWAVES * 64), args, LDS_BYTES, stream);
    if (e != hipSuccess) fprintf(stderr, "kernel_launch: cooperative launch failed: %s (grid %d)\n", hipGetErrorString(e), grid);
#else
    for (int ph = 0; ph < NPH; ++ph) { a.ph_lo = ph; a.ph_hi = ph + 1; hipLaunchKernelGGL(mk_fwd, dim3(grid), dim3(NWAVES * 64), LDS_BYTES, stream, a); }
#endif
}
```

```cpp
#include <hip/hip_runtime.h>
#include <hip/hip_cooperative_groups.h>
#include <hip/hip_bf16.h>
#include <cstdio>
#include <cstdint>
#include <cmath>
namespace cg = cooperative_groups;

#ifndef MK_N_LAUNCHES
#define MK_N_LAUNCHES 1
#endif

constexpr int DM = 1024, NB = 2, SEQ = 8192, CTXL = 256, LR = SEQ + CTXL, NR = NB * LR, NLAT = NB * SEQ;
constexpr int NE = 16, FF = 2048, EROWS = 2304;
constexpr float EPS = 1e-6f;
constexpr int NTILE64 = NR / 64;
constexpr int NPH = 20;

constexpr size_t MiB = 1u << 20;
constexpr size_t WS_CTL = 0, WS_MOD = 1 * MiB, WS_ROPE = 2 * MiB, WS_LRUW = 4 * MiB, WS_CMWS = 4 * MiB + 512 * 1024, WS_SUM = 5 * MiB, WS_AFF = 8 * MiB, WS_INV = 10 * MiB,
                 WS_GATE = 12 * MiB, WS_MODP = 28 * MiB, WS_CAR = 30 * MiB, WS_WIN = 14 * MiB, WS_WOUT0 = 18 * MiB, WS_WQKV = 20 * MiB, WS_WOUT1 = 26 * MiB, WS_W13 = 32 * MiB, WS_W2 = 288 * MiB, WS_H = 416 * MiB,
                 WS_X = 450 * MiB, WS_XS = 516 * MiB, WS_ACT = 588 * MiB, WS_END = 758 * MiB;
static_assert(true, "");
constexpr size_t ACT_Z = 0, ACT_YCAT = 66 * MiB, ACT_HID = 0, ACT_Q = 0, ACT_K = 33 * MiB, ACT_V = 66 * MiB, ACT_O1 = 99 * MiB, ACT_O2 = 131 * MiB, ACT_A = 0;

#define GAS __attribute__((address_space(1)))
#define LAS __attribute__((address_space(3)))
typedef unsigned short bf16_t;
typedef short bf16x8 __attribute__((ext_vector_type(8)));
typedef float f32x4 __attribute__((ext_vector_type(4)));
typedef float f32x2 __attribute__((ext_vector_type(2)));
typedef unsigned u32x4 __attribute__((ext_vector_type(4)));
typedef unsigned u32x2 __attribute__((ext_vector_type(2)));

__device__ __forceinline__ unsigned f2bf(float f) { unsigned u = __builtin_bit_cast(unsigned, f); return (u + 0x7fffu + ((u >> 16) & 1u)) >> 16; }
typedef float f32x2_hw __attribute__((ext_vector_type(2))); typedef __bf16 bf16x2_hw __attribute__((ext_vector_type(2)));
__device__ __forceinline__ unsigned pk2(float lo, float hi) { f32x2_hw v = {lo, hi}; bf16x2_hw b = __builtin_convertvector(v, bf16x2_hw); return __builtin_bit_cast(unsigned, b); }
__device__ __forceinline__ u32x2 pk4(const f32x4 v) { u32x2 w; w.x = pk2(v[0], v[1]); w.y = pk2(v[2], v[3]); return w; }
__device__ __forceinline__ float bf2f(unsigned short b) { return __builtin_bit_cast(float, (unsigned)b << 16); }
__device__ __forceinline__ float bflo(unsigned w) { return __builtin_bit_cast(float, w << 16); }
__device__ __forceinline__ float bfhi(unsigned w) { return __builtin_bit_cast(float, w & 0xffff0000u); }
__device__ __forceinline__ unsigned f2fp8x4(float a, float b, float c, float d) {
    a = __builtin_amdgcn_fmed3f(a, -448.f, 448.f); b = __builtin_amdgcn_fmed3f(b, -448.f, 448.f); c = __builtin_amdgcn_fmed3f(c, -448.f, 448.f); d = __builtin_amdgcn_fmed3f(d, -448.f, 448.f);
    int w = __builtin_amdgcn_cvt_pk_fp8_f32(a, b, 0, false); w = __builtin_amdgcn_cvt_pk_fp8_f32(c, d, w, true); return (unsigned)w; }
constexpr float W8_SCALE = 32.0f, W8_INV = 1.0f / 32.0f;
__device__ __forceinline__ float gelu_tanh(float x) {
    const float u2 = 2.0f * 0.7978845608028654f * (x + 0.044715f * x * x * x);
    const float e = __builtin_amdgcn_exp2f(u2 * 1.4426950408889634f);
    return x - x * __builtin_amdgcn_rcpf(1.0f + e);
}
__device__ __forceinline__ float silu_f(float a) { return a * __builtin_amdgcn_rcpf(1.0f + __builtin_amdgcn_exp2f(-a * 1.4426950408889634f)); }
__device__ __forceinline__ float sigmoid_f(float a) { return 1.0f / (1.0f + __expf(-a)); }

namespace pg8 {
#define PG8_LAS __attribute__((address_space(3)))
constexpr int BM = 256, BK = 64, HALF = 128, HTB = HALF * BK * 2, STAGE_BYTES = 8 * HTB, NXCD = 8, WGM = 8;
__host__ __device__ __forceinline__ int lds_byte(int r, int c) { const int st = (r >> 4) * 2 + (c >> 5), rr = r & 15, cc = c & 31, ob = rr * 64 + cc * 2; return st * 1024 + (ob ^ (((ob >> 9) & 1) << 5)); }
__host__ __device__ __forceinline__ void stage_rc(int b, int& R, int& C) { const int st = b / 1024, sb = b % 1024, swz = sb ^ (((sb >> 9) & 1) << 5); R = (st >> 1) * 16 + swz / 64; C = (st & 1) * 32 + (swz % 64) / 2; }
__host__ __device__ __forceinline__ int perm32(int rho) { const int n = rho >> 4, i = rho & 15; return 8 * (i >> 2) + 4 * n + (i & 3); }

struct Unit { int pm, pn, grp; };
struct Gemm { const bf16_t* A; const bf16_t* Bt; int K; size_t ga, gb; };

struct GOrder {
    int nM, nN, upg, nwg, G, c;
    __device__ void init(int nM_, int nN_, int ngrp, int G_, int c_) { nM = nM_; nN = nN_; upg = nM * nN; nwg = upg * ngrp; G = G_; c = c_; }
    __device__ bool next(int i, Unit& u) const {
        const long L = (long)i * G + c; if (L >= nwg) return false;
        int wgid = (int)L; { const int q = nwg / NXCD, r = nwg % NXCD, xcd = wgid % NXCD, off = wgid / NXCD; wgid = (xcd < r ? xcd * (q + 1) : r * (q + 1) + (xcd - r) * q) + off; }
        u.grp = wgid / upg; const int w = wgid % upg;
        const int nig = WGM * nN, gid = w / nig, fm = gid * WGM, gsz = (nM - fm) < WGM ? (nM - fm) : WGM;
        u.pm = fm + ((w % nig) % gsz); u.pn = (w % nig) / gsz; return true;
    }
};

__device__ __forceinline__ unsigned cvt_pk_bf16(float lo, float hi) { unsigned r; asm volatile("v_cvt_pk_bf16_f32 %0, %1, %2" : "=v"(r) : "v"(lo), "v"(hi)); return r; }

template <class Epi, class Sched>
__device__ __forceinline__ void gemm_phase(PG8_LAS unsigned char* lds, const Gemm g, const Sched& S, const Epi& E) {
    const int tid = threadIdx.x, wid = __builtin_amdgcn_readfirstlane(tid >> 6), lane = tid & 63, wr = wid >> 2, wc = wid & 3, fr = lane & 15, fq = lane >> 4;
    const int K = g.K, nt = K / BK;
    unsigned voffA[2], voffB[2];
#pragma unroll
    for (int i = 0; i < 2; ++i) { int R, C; stage_rc(tid * 16 + i * 8192, R, C); const int Rb = (R & ~31) + perm32(R & 31);
        voffA[i] = (unsigned)(R * K + C) * 2u; voffB[i] = (unsigned)(Rb * K + C) * 2u; }
    const size_t kstep = (size_t)(BK * 2);
    const size_t hstep = (size_t)HALF * K * 2;
    const size_t tstep = 2 * hstep;
    const unsigned ldsw = (unsigned)wid * 1024u;
    const int aoff = lds_byte(wr * 64 + fr, fq * 8), boff = lds_byte(wc * 32 + fr, fq * 8);
#define PG8_SA(b, h) (((b) * 2 + (h)) * HTB)
#define PG8_SB(b, h) ((4 + (b) * 2 + (h)) * HTB)
#define PG8_STAGE(bufoff, gbase, voff) do { _Pragma("unroll") for (int _i = 0; _i < 2; ++_i) \
        __builtin_amdgcn_global_load_lds((const unsigned*)((const char*)(gbase) + (voff)[_i]), (PG8_LAS unsigned*)(lds + (bufoff) + ldsw + _i * 8192), 16, 0, 0); } while (0)
#define PG8_LDA(dst, b, h) do { _Pragma("unroll") for (int m = 0; m < 4; ++m) _Pragma("unroll") for (int k = 0; k < 2; ++k) dst[m][k] = *(const PG8_LAS bf16x8*)(lds + PG8_SA(b, h) + aoff + m * 2048 + k * 1024); } while (0)
#define PG8_LDB(dst, b, h) do { _Pragma("unroll") for (int n = 0; n < 2; ++n) _Pragma("unroll") for (int k = 0; k < 2; ++k) dst[n][k] = *(const PG8_LAS bf16x8*)(lds + PG8_SB(b, h) + boff + n * 2048 + k * 1024); } while (0)
#define PG8_MMA(ai, bj, At, Bt) do { __builtin_amdgcn_s_setprio(1); _Pragma("unroll") for (int m = 0; m < 4; ++m) _Pragma("unroll") for (int n = 0; n < 2; ++n) _Pragma("unroll") for (int k = 0; k < 2; ++k) \
        acc[ai][bj][m][n] = __builtin_amdgcn_mfma_f32_16x16x32_bf16(Bt[n][k], At[m][k], acc[ai][bj][m][n], 0, 0, 0); __builtin_amdgcn_s_setprio(0); } while (0)
#define PG8_WAIT_V(n) asm volatile("s_waitcnt vmcnt(" #n ")" ::: "memory")
#define PG8_WAIT_L(n) asm volatile("s_waitcnt lgkmcnt(" #n ")" ::: "memory")
#define PG8_BAR __builtin_amdgcn_s_barrier()
#define PG8_SCHED __builtin_amdgcn_sched_barrier(0)
    Unit cur, nxt; int ui = 0;
    if (!S.next(0, cur)) return;
    f32x4 acc[2][2][4][2];
#pragma unroll
    for (int a = 0; a < 2; ++a)
#pragma unroll
        for (int b = 0; b < 2; ++b)
#pragma unroll
            for (int m = 0; m < 4; ++m)
#pragma unroll
                for (int n = 0; n < 2; ++n) acc[a][b][m][n] = (f32x4){0.f, 0.f, 0.f, 0.f};
    bf16x8 At[4][2], B0[2][2], B1[2][2];
    const char* cA = (const char*)g.A + (size_t)cur.grp * g.ga + (size_t)cur.pm * tstep; const char* cB = (const char*)g.Bt + (size_t)cur.grp * g.gb + (size_t)cur.pn * tstep;
    PG8_STAGE(PG8_SB(0, 0), cB, voffB); PG8_STAGE(PG8_SB(0, 1), cB + hstep, voffB); PG8_STAGE(PG8_SA(0, 0), cA, voffA); PG8_STAGE(PG8_SA(0, 1), cA + hstep, voffA);
    if (wr == 1) PG8_BAR;
    PG8_WAIT_V(2); PG8_BAR;
    PG8_STAGE(PG8_SB(1, 0), cB + kstep, voffB); PG8_STAGE(PG8_SA(1, 0), cA + kstep, voffA); PG8_STAGE(PG8_SB(1, 1), cB + hstep + kstep, voffB);
    PG8_WAIT_V(6); PG8_BAR;
    for (;;) {
        const bool has_next = S.next(ui + 1, nxt);
        const char* nA = has_next ? (const char*)g.A + (size_t)nxt.grp * g.ga + (size_t)nxt.pm * tstep : cA; const char* nB = has_next ? (const char*)g.Bt + (size_t)nxt.grp * g.gb + (size_t)nxt.pn * tstep : cB;
        for (int t = 0; t < nt; t += 2) {
            const bool last = (t == nt - 2);
            const char* a1 = cA + (size_t)(t + 1) * kstep;
            const char* a2 = last ? nA : cA + (size_t)(t + 2) * kstep; const char* b2 = last ? nB : cB + (size_t)(t + 2) * kstep;
            const char* a3 = a2 + kstep; const char* b3 = b2 + kstep;
            PG8_LDB(B0, 0, 0); PG8_LDB(B1, 0, 1); PG8_SCHED; PG8_LDA(At, 0, 0); PG8_STAGE(PG8_SA(1, 1), a1 + hstep, voffA);
            PG8_WAIT_V(8); PG8_WAIT_L(0); PG8_BAR; PG8_MMA(0, 0, At, B0); PG8_MMA(0, 1, At, B1); PG8_BAR; PG8_SCHED;
            PG8_LDA(At, 0, 1); PG8_STAGE(PG8_SB(0, 0), b2, voffB); PG8_STAGE(PG8_SB(0, 1), b2 + hstep, voffB); PG8_STAGE(PG8_SA(0, 0), a2, voffA);
            PG8_WAIT_V(8); PG8_WAIT_L(0); PG8_BAR; PG8_MMA(1, 0, At, B0); PG8_MMA(1, 1, At, B1); PG8_BAR; PG8_SCHED;
            PG8_LDB(B0, 1, 0); PG8_LDB(B1, 1, 1); PG8_SCHED; PG8_LDA(At, 1, 0); PG8_STAGE(PG8_SA(0, 1), a2 + hstep, voffA);
            PG8_WAIT_V(8); PG8_WAIT_L(0); PG8_BAR; PG8_MMA(0, 0, At, B0); PG8_MMA(0, 1, At, B1); PG8_BAR; PG8_SCHED;
            PG8_LDA(At, 1, 1); PG8_STAGE(PG8_SB(1, 0), b3, voffB); PG8_STAGE(PG8_SB(1, 1), b3 + hstep, voffB); PG8_STAGE(PG8_SA(1, 0), a3, voffA);
            PG8_WAIT_V(8); PG8_WAIT_L(0); PG8_BAR; PG8_MMA(1, 0, At, B0); PG8_MMA(1, 1, At, B1); PG8_BAR; PG8_SCHED;
        }
        if (wr == 0) PG8_BAR;
        E(acc, cur, wr, wc, fr, fq);
        if (!has_next) break;
#pragma unroll
        for (int a = 0; a < 2; ++a)
#pragma unroll
            for (int b = 0; b < 2; ++b)
#pragma unroll
                for (int m = 0; m < 4; ++m)
#pragma unroll
                    for (int n = 0; n < 2; ++n) acc[a][b][m][n] = (f32x4){0.f, 0.f, 0.f, 0.f};
        cur = nxt; cA = nA; cB = nB; ++ui;
        if (wr == 1) PG8_BAR;
    }
    PG8_WAIT_V(0);
    PG8_BAR;
#undef PG8_SA
#undef PG8_SB
#undef PG8_STAGE
#undef PG8_LDA
#undef PG8_LDB
#undef PG8_MMA
#undef PG8_WAIT_V
#undef PG8_WAIT_L
#undef PG8_BAR
#undef PG8_SCHED
}

typedef int v8i32 __attribute__((ext_vector_type(8)));
typedef float f32x16 __attribute__((ext_vector_type(16)));
__host__ __device__ __forceinline__ int permS(int rho) { const int e = rho & 3, hh = (rho >> 2) & 1, q = rho >> 3; return q < 2 ? 8 * hh + 4 * q + e : 16 + 8 * hh + 4 * (q - 2) + e; }
__host__ __device__ __forceinline__ int permN(int rho) { const int e = rho & 3, hh = (rho >> 2) & 1, q = rho >> 3; return 16 * hh + 4 * q + e; }
struct Gemm8 { const unsigned char* A; const unsigned char* Bt; int K; size_t ga, gb; };
template <bool SWP, class Epi, class Sched>
__device__ __forceinline__ void gemm8_phase(PG8_LAS unsigned char* lds, const Gemm8 g, const Sched& S, const Epi& E) {
    const int tid = threadIdx.x, wid = __builtin_amdgcn_readfirstlane(tid >> 6), lane = tid & 63, wr = wid >> 2, wc = wid & 3;
    const int K = g.K, nt = K / 128;
    unsigned voffA[2], voffB[2];
#pragma unroll
    for (int i = 0; i < 2; ++i) {
        const int bb = tid * 16 + i * 8192, st = bb / 1024, sb = bb % 1024, swz = sb ^ (((sb >> 9) & 1) << 5) ^ (((sb >> 8) & 1) << 4);
        const int R = (st >> 1) * 16 + swz / 64, Cb = (st & 1) * 64 + swz % 64; const int Rb = (R & ~31) + (SWP ? permS(R & 31) : permN(R & 31));
        voffA[i] = (unsigned)(R * K + Cb); voffB[i] = (unsigned)(Rb * K + Cb); }
    const size_t kstep = 128, hstep = (size_t)HALF * K, tstep = 2 * hstep;
    const unsigned ldsw = (unsigned)wid * 1024u;
    const int l31 = lane & 31, hh = lane >> 5;
    const int ra = wr * 64 + l31, rb = wc * 32 + l31;
    const int aoff = ((ra >> 4) * 2) * 1024 + (ra & 15) * 64 + 32 * (hh ^ ((ra & 15) >> 3)), boff = ((rb >> 4) * 2) * 1024 + (rb & 15) * 64 + 32 * (hh ^ ((rb & 15) >> 3));
    const int aswp = 16 * ((ra >> 2) & 1), bswp = 16 * ((rb >> 2) & 1);
#define PG8_SA(b, h) (((b) * 2 + (h)) * HTB)
#define PG8_SB(b, h) ((4 + (b) * 2 + (h)) * HTB)
#define PG8_STAGE(bufoff, gbase, voff) do { _Pragma("unroll") for (int _i = 0; _i < 2; ++_i) \
        __builtin_amdgcn_global_load_lds((const unsigned*)((const char*)(gbase) + (voff)[_i]), (PG8_LAS unsigned*)(lds + (bufoff) + ldsw + _i * 8192), 16, 0, 0); } while (0)
#define PG8_LD32(dst, off, swp) do { const u32x4 lo_ = *(const PG8_LAS u32x4*)(lds + (off) + (swp)); const u32x4 hi_ = *(const PG8_LAS u32x4*)(lds + (off) + (16 - (swp))); \
        dst = (v8i32){(int)lo_.x, (int)lo_.y, (int)lo_.z, (int)lo_.w, (int)hi_.x, (int)hi_.y, (int)hi_.z, (int)hi_.w}; } while (0)
#define PG8_LDA(dst, b, h) do { _Pragma("unroll") for (int m = 0; m < 2; ++m) _Pragma("unroll") for (int k = 0; k < 2; ++k) PG8_LD32(dst[m][k], PG8_SA(b, h) + aoff + m * 4096 + k * 1024, aswp); } while (0)
#define PG8_LDB(dst, b, h) do { _Pragma("unroll") for (int k = 0; k < 2; ++k) PG8_LD32(dst[k], PG8_SB(b, h) + boff + k * 1024, bswp); } while (0)
#define PG8_MMA(ai, bj, At, Bt) do { __builtin_amdgcn_s_setprio(1); _Pragma("unroll") for (int m = 0; m < 2; ++m) _Pragma("unroll") for (int k = 0; k < 2; ++k) \
        acc[ai][bj][m] = __builtin_amdgcn_mfma_scale_f32_32x32x64_f8f6f4(Bt[k], At[m][k], acc[ai][bj][m], 0, 0, 0, 0x7f7f7f7f, 0, 0x7f7f7f7f); \
        asm volatile("" : "+v"(acc[ai][bj][0]), "+v"(acc[ai][bj][1])); __builtin_amdgcn_s_setprio(0); } while (0)
#define PG8_WAIT_V(n) asm volatile("s_waitcnt vmcnt(" #n ")" ::: "memory")
#define PG8_WAIT_L(n) asm volatile("s_waitcnt lgkmcnt(" #n ")" ::: "memory")
#define PG8_BAR __builtin_amdgcn_s_barrier()
#define PG8_SCHED __builtin_amdgcn_sched_barrier(0)
    Unit cur, nxt; int ui = 0;
    if (!S.next(0, cur)) return;
    f32x16 acc[2][2][2];
#pragma unroll
    for (int a = 0; a < 2; ++a)
#pragma unroll
        for (int b = 0; b < 2; ++b)
#pragma unroll
            for (int m = 0; m < 2; ++m) acc[a][b][m] = f32x16{};
    v8i32 At[2][2], B0[2], B1[2];
    const char* cA = (const char*)g.A + (size_t)cur.grp * g.ga + (size_t)cur.pm * tstep; const char* cB = (const char*)g.Bt + (size_t)cur.grp * g.gb + (size_t)cur.pn * tstep;
    PG8_STAGE(PG8_SB(0, 0), cB, voffB); PG8_STAGE(PG8_SB(0, 1), cB + hstep, voffB); PG8_STAGE(PG8_SA(0, 0), cA, voffA); PG8_STAGE(PG8_SA(0, 1), cA + hstep, voffA);
    if (wr == 1) PG8_BAR;
    PG8_WAIT_V(2); PG8_BAR;
    PG8_STAGE(PG8_SB(1, 0), cB + kstep, voffB); PG8_STAGE(PG8_SA(1, 0), cA + kstep, voffA); PG8_STAGE(PG8_SB(1, 1), cB + hstep + kstep, voffB);
    PG8_WAIT_V(6); PG8_BAR;
    for (;;) {
        const bool has_next = S.next(ui + 1, nxt);
        const char* nA = has_next ? (const char*)g.A + (size_t)nxt.grp * g.ga + (size_t)nxt.pm * tstep : cA; const char* nB = has_next ? (const char*)g.Bt + (size_t)nxt.grp * g.gb + (size_t)nxt.pn * tstep : cB;
        for (int t = 0; t < nt; t += 2) {
            const bool last = (t == nt - 2);
            const char* a1 = cA + (size_t)(t + 1) * kstep;
            const char* a2 = last ? nA : cA + (size_t)(t + 2) * kstep; const char* b2 = last ? nB : cB + (size_t)(t + 2) * kstep;
            const char* a3 = a2 + kstep; const char* b3 = b2 + kstep;
            PG8_LDB(B0, 0, 0); PG8_LDB(B1, 0, 1); PG8_SCHED; PG8_LDA(At, 0, 0); PG8_STAGE(PG8_SA(1, 1), a1 + hstep, voffA);
            PG8_WAIT_V(8); PG8_WAIT_L(0); PG8_BAR; PG8_SCHED; PG8_MMA(0, 0, At, B0); PG8_MMA(0, 1, At, B1); PG8_SCHED; PG8_BAR; PG8_SCHED;
            PG8_LDA(At, 0, 1); PG8_STAGE(PG8_SB(0, 0), b2, voffB); PG8_STAGE(PG8_SB(0, 1), b2 + hstep, voffB); PG8_STAGE(PG8_SA(0, 0), a2, voffA);
            PG8_WAIT_V(8); PG8_WAIT_L(0); PG8_BAR; PG8_SCHED; PG8_MMA(1, 0, At, B0); PG8_MMA(1, 1, At, B1); PG8_SCHED; PG8_BAR; PG8_SCHED;
            PG8_LDB(B0, 1, 0); PG8_LDB(B1, 1, 1); PG8_SCHED; PG8_LDA(At, 1, 0); PG8_STAGE(PG8_SA(0, 1), a2 + hstep, voffA);
            PG8_WAIT_V(8); PG8_WAIT_L(0); PG8_BAR; PG8_SCHED; PG8_MMA(0, 0, At, B0); PG8_MMA(0, 1, At, B1); PG8_SCHED; PG8_BAR; PG8_SCHED;
            PG8_LDA(At, 1, 1); PG8_STAGE(PG8_SB(1, 0), b3, voffB); PG8_STAGE(PG8_SB(1, 1), b3 + hstep, voffB); PG8_STAGE(PG8_SA(1, 0), a3, voffA);
            PG8_WAIT_V(8); PG8_WAIT_L(0); PG8_BAR; PG8_SCHED; PG8_MMA(1, 0, At, B0); PG8_MMA(1, 1, At, B1); PG8_SCHED; PG8_BAR; PG8_SCHED;
        }
        if (wr == 0) PG8_BAR;
        E(acc, cur, wr, wc, l31, hh);
        if (!has_next) break;
#pragma unroll
        for (int a = 0; a < 2; ++a)
#pragma unroll
            for (int b = 0; b < 2; ++b)
#pragma unroll
                for (int m = 0; m < 2; ++m) acc[a][b][m] = f32x16{};
        cur = nxt; cA = nA; cB = nB; ++ui;
        if (wr == 1) PG8_BAR;
    }
    PG8_WAIT_V(0);
    PG8_BAR;
#undef PG8_SA
#undef PG8_SB
#undef PG8_STAGE
#undef PG8_LD32
#undef PG8_LDA
#undef PG8_LDB
#undef PG8_MMA
#undef PG8_WAIT_V
#undef PG8_WAIT_L
#undef PG8_BAR
#undef PG8_SCHED
}
struct EpiSwiGLU8 {
    unsigned char* HID;
    __device__ __forceinline__ void operator()(const f32x16 (&acc)[2][2][2], const Unit& u, int wr, int wc, int l31, int hh) const {
        const int row0 = u.pm * BM + wr * 64 + l31, f0 = u.pn * 128 + wc * 16 + 8 * hh;
#pragma unroll
        for (int ai = 0; ai < 2; ++ai)
#pragma unroll
            for (int m = 0; m < 2; ++m) { unsigned char* rowp = HID + ((size_t)u.grp * EROWS + row0 + ai * HALF + m * 32) * FF + f0;
#pragma unroll
                for (int bj = 0; bj < 2; ++bj) { const f32x16& c = acc[ai][bj][m]; float hv[8];
#pragma unroll
                    for (int e = 0; e < 8; ++e) hv[e] = silu_f(c[e] * W8_INV) * (c[8 + e] * W8_INV);
                    u32x2 w; w.x = f2fp8x4(hv[0], hv[1], hv[2], hv[3]); w.y = f2fp8x4(hv[4], hv[5], hv[6], hv[7]);
                    *(u32x2*)(rowp + bj * 64) = w; } }
    }
};
struct EpiMoeOut8 {
    bf16_t* YB; const float* gate;
    __device__ __forceinline__ void operator()(const f32x16 (&acc)[2][2][2], const Unit& u, int wr, int wc, int l31, int hh) const {
        const int row0 = u.pm * BM + wr * 64 + l31, col0 = u.pn * BM + wc * 32 + 16 * hh;
#pragma unroll
        for (int ai = 0; ai < 2; ++ai)
#pragma unroll
            for (int m = 0; m < 2; ++m) { const size_t er = (size_t)u.grp * EROWS + row0 + ai * HALF + m * 32; const float gt = gate[er] * W8_INV; bf16_t* rowp = YB + er * DM + col0;
#pragma unroll
                for (int bj = 0; bj < 2; ++bj) { const f32x16& c = acc[ai][bj][m]; u32x4 w0, w1;
                    w0.x = cvt_pk_bf16(c[0] * gt, c[1] * gt); w0.y = cvt_pk_bf16(c[2] * gt, c[3] * gt); w0.z = cvt_pk_bf16(c[4] * gt, c[5] * gt); w0.w = cvt_pk_bf16(c[6] * gt, c[7] * gt);
                    w1.x = cvt_pk_bf16(c[8] * gt, c[9] * gt); w1.y = cvt_pk_bf16(c[10] * gt, c[11] * gt); w1.z = cvt_pk_bf16(c[12] * gt, c[13] * gt); w1.w = cvt_pk_bf16(c[14] * gt, c[15] * gt);
                    *(u32x4*)(rowp + bj * HALF) = w0; *(u32x4*)(rowp + bj * HALF + 8) = w1; } }
    }
};

struct EpiWin {
    bf16_t* Z;
    __device__ __forceinline__ void operator()(const f32x4 (&acc)[2][2][4][2], const Unit& u, int wr, int wc, int fr, int fq) const {
        const int row0 = u.grp * LR + CTXL + u.pm * BM + wr * 64 + fr, col0 = u.pn * BM + wc * 32 + 8 * fq; const bool act = (u.pn < 2) || (u.pn >= 4);
#pragma unroll
        for (int ai = 0; ai < 2; ++ai)
#pragma unroll
            for (int m = 0; m < 4; ++m) { bf16_t* rowp = Z + (size_t)(row0 + ai * HALF + m * 16) * 2048 + col0;
#pragma unroll
                for (int bj = 0; bj < 2; ++bj) { f32x4 v0 = acc[ai][bj][m][0], v1 = acc[ai][bj][m][1];
                    if (act) {
#pragma unroll
                        for (int i = 0; i < 4; ++i) { v0[i] = gelu_tanh(v0[i]); v1[i] = gelu_tanh(v1[i]); } }
                    u32x4 w; w.x = cvt_pk_bf16(v0[0], v0[1]); w.y = cvt_pk_bf16(v0[2], v0[3]); w.z = cvt_pk_bf16(v1[0], v1[1]); w.w = cvt_pk_bf16(v1[2], v1[3]);
                    *(u32x4*)(rowp + bj * HALF) = w; } }
    }
};
struct EpiRes {
    bf16_t* X; const float* xin; const float* g1; int mode;
    __device__ __forceinline__ void operator()(const f32x4 (&acc)[2][2][4][2], const Unit& u, int wr, int wc, int fr, int fq) const {
        const int b = u.grp; bf16_t* outp = X + ((size_t)b * LR + CTXL + (size_t)u.pm * BM) * DM;
        const float* basep = xin + ((size_t)b * SEQ + (size_t)u.pm * BM) * DM;
        const int rr0 = wr * 64 + fr, col0 = u.pn * BM + wc * 32 + 8 * fq;
        f32x4 gv[2][2];
#pragma unroll
        for (int bj = 0; bj < 2; ++bj)
#pragma unroll
            for (int n = 0; n < 2; ++n) gv[bj][n] = *(const f32x4*)(g1 + (size_t)b * 6144 + col0 + bj * HALF + 4 * n);
#pragma unroll
        for (int ai = 0; ai < 2; ++ai)
#pragma unroll
            for (int m = 0; m < 4; ++m) { const size_t off = (size_t)(rr0 + ai * HALF + m * 16) * DM + col0;
#pragma unroll
                for (int bj = 0; bj < 2; ++bj) { f32x4 b0, b1;
                    if (mode == 0) { b0 = *(const f32x4*)(basep + off + bj * HALF); b1 = *(const f32x4*)(basep + off + bj * HALF + 4); }
                    else { const u32x4 w = *(const u32x4*)(outp + off + bj * HALF); b0 = (f32x4){bflo(w.x), bfhi(w.x), bflo(w.y), bfhi(w.y)}; b1 = (f32x4){bflo(w.z), bfhi(w.z), bflo(w.w), bfhi(w.w)}; }
                    const f32x4 o0 = b0 + gv[bj][0] * acc[ai][bj][m][0], o1 = b1 + gv[bj][1] * acc[ai][bj][m][1];
                    u32x4 wo; wo.x = cvt_pk_bf16(o0[0], o0[1]); wo.y = cvt_pk_bf16(o0[2], o0[3]); wo.z = cvt_pk_bf16(o1[0], o1[1]); wo.w = cvt_pk_bf16(o1[2], o1[3]);
                    *(u32x4*)(outp + off + bj * HALF) = wo; } }
    }
};
constexpr float C2 = 0.125f * 1.4426950408889634f;
struct EpiQKV {
    bf16_t* Q; const float* cs;
    __device__ __forceinline__ void operator()(const f32x4 (&acc)[2][2][4][2], const Unit& u, int wr, int wc, int fr, int fq) const {
        const int t0 = u.pm * BM; const size_t Rb = (size_t)u.grp * LR + CTXL + t0;
        const int sec = u.pn >> 2; bf16_t* dst = Q + (size_t)sec * ((ACT_K - ACT_Q) / 2);
        const int rr0 = wr * 64 + fr, colt = (u.pn & 3) * BM + wc * 32 + 8 * fq; const float sc = sec == 0 ? C2 : 1.0f; const bool rope = sec < 2;
#pragma unroll
        for (int ai = 0; ai < 2; ++ai)
#pragma unroll
            for (int m = 0; m < 4; ++m) { const int rr = rr0 + ai * HALF + m * 16; bf16_t* rowp = dst + (Rb + rr) * DM + colt;
#pragma unroll
                for (int bj = 0; bj < 2; ++bj) { f32x4 v0 = acc[ai][bj][m][0], v1 = acc[ai][bj][m][1];
                    if (rope) { const int p0 = ((colt + bj * HALF) & 63) >> 1, tt = t0 + rr; const float* cp = cs + ((p0 < 16 ? (tt >> 6) * 16 + p0 : (128 + (tt & 63)) * 16 + (p0 - 16))) * 2;
                        const f32x4 c01 = *(const f32x4*)cp, c23 = *(const f32x4*)(cp + 4);
                        const float a0 = v0[0] * c01[0] - v0[1] * c01[1], a1 = v0[0] * c01[1] + v0[1] * c01[0];
                        const float a2 = v0[2] * c01[2] - v0[3] * c01[3], a3 = v0[2] * c01[3] + v0[3] * c01[2];
                        const float b0 = v1[0] * c23[0] - v1[1] * c23[1], b1 = v1[0] * c23[1] + v1[1] * c23[0];
                        const float b2 = v1[2] * c23[2] - v1[3] * c23[3], b3 = v1[2] * c23[3] + v1[3] * c23[2];
                        v0 = (f32x4){a0, a1, a2, a3}; v1 = (f32x4){b0, b1, b2, b3}; }
                    v0 = v0 * sc; v1 = v1 * sc;
                    u32x4 w; w.x = cvt_pk_bf16(v0[0], v0[1]); w.y = cvt_pk_bf16(v0[2], v0[3]); w.z = cvt_pk_bf16(v1[0], v1[1]); w.w = cvt_pk_bf16(v1[2], v1[3]);
                    *(u32x4*)(rowp + bj * HALF) = w; }
                asm volatile("" ::: "memory"); }
    }
};
struct EpiSwiGLU {
    bf16_t* HID;
    __device__ __forceinline__ void operator()(const f32x4 (&acc)[2][2][4][2], const Unit& u, int wr, int wc, int fr, int fq) const {
        const int row0 = u.pm * BM + wr * 64 + fr, f0 = u.pn * 128 + wc * 16 + 4 * fq;
#pragma unroll
        for (int ai = 0; ai < 2; ++ai)
#pragma unroll
            for (int m = 0; m < 4; ++m) { bf16_t* rowp = HID + ((size_t)u.grp * EROWS + row0 + ai * HALF + m * 16) * FF + f0;
#pragma unroll
                for (int bj = 0; bj < 2; ++bj) { const f32x4 a = acc[ai][bj][m][0], bb = acc[ai][bj][m][1];
                    u32x2 w; w.x = cvt_pk_bf16(silu_f(a[0]) * bb[0], silu_f(a[1]) * bb[1]); w.y = cvt_pk_bf16(silu_f(a[2]) * bb[2], silu_f(a[3]) * bb[3]);
                    *(u32x2*)(rowp + bj * 64) = w; } }
    }
};
struct EpiMoeOut {
    bf16_t* YB; const float* gate;
    __device__ __forceinline__ void operator()(const f32x4 (&acc)[2][2][4][2], const Unit& u, int wr, int wc, int fr, int fq) const {
        const int row0 = u.pm * BM + wr * 64 + fr, col0 = u.pn * BM + wc * 32 + 8 * fq;
#pragma unroll
        for (int ai = 0; ai < 2; ++ai)
#pragma unroll
            for (int m = 0; m < 4; ++m) { const size_t er = (size_t)u.grp * EROWS + row0 + ai * HALF + m * 16; const float gt = gate[er]; bf16_t* rowp = YB + er * DM + col0;
#pragma unroll
                for (int bj = 0; bj < 2; ++bj) { const f32x4 v0 = acc[ai][bj][m][0] * gt, v1 = acc[ai][bj][m][1] * gt;
                    u32x4 w; w.x = cvt_pk_bf16(v0[0], v0[1]); w.y = cvt_pk_bf16(v0[2], v0[3]); w.z = cvt_pk_bf16(v1[0], v1[1]); w.w = cvt_pk_bf16(v1[2], v1[3]);
                    *(u32x4*)(rowp + bj * HALF) = w; } }
    }
};
}

namespace attn_body {
using bf16=__hip_bfloat16;
using s16x4=__attribute__((ext_vector_type(4)))short;
using f32x16=__attribute__((ext_vector_type(16)))float;
constexpr int D=64,PITCH=1024;
constexpr int NW=8,QBLK=32,QB=QBLK*NW,KVBLK=64;
constexpr int NT=LR/KVBLK;
__device__ __forceinline__ int crow(int r,int hi){return (r&3)+8*(r>>2)+4*hi;}
#define SBAR() __builtin_amdgcn_sched_barrier(0)
constexpr int NSLOT=3, SLOTB=8192;
constexpr int LDS_K=0, LDS_V=NSLOT*SLOTB, LDS_WS=2*NSLOT*SLOTB, LDS_OST=LDS_WS+NW*64*4, LDS_BYTES=LDS_OST+NW*4096;
__device__ __forceinline__ void glds16(const void*gsrc,unsigned lds_dst){unsigned keep;
  asm volatile("s_mov_b32 %0, m0\n\ts_mov_b32 m0, %2\n\ts_nop 0\n\tglobal_load_lds_dwordx4 %1, off\n\ts_mov_b32 m0, %0":"=&s"(keep):"v"(gsrc),"s"(lds_dst):"memory");}
__device__ __forceinline__ void glds16s(const void*sbase,unsigned voff,unsigned lds_dst){unsigned keep;
  asm volatile("s_mov_b32 %0, m0\n\ts_mov_b32 m0, %2\n\ts_nop 2\n\tglobal_load_lds_dwordx4 %1, %3\n\ts_mov_b32 m0, %0":"=&s"(keep):"v"(voff),"s"(lds_dst),"s"(sbase):"memory");}
__device__ __forceinline__ float max3f(float a,float b,float c){float r;asm("v_max3_f32 %0, %1, %2, %3":"=v"(r):"v"(a),"v"(b),"v"(c));return r;}
__device__ __forceinline__ float max2f(float a,float b){float r;asm("v_max_f32_e32 %0, %1, %2":"=v"(r):"v"(a),"v"(b));return r;}
__device__ __forceinline__ float fadd_s(float a,float b){float r;asm("v_add_f32_e32 %0, %1, %2":"=v"(r):"v"(a),"v"(b));return r;}
__device__ __forceinline__ float fsub_s(float a,float b){float r;asm("v_sub_f32_e32 %0, %1, %2":"=v"(r):"v"(a),"v"(b));return r;}
typedef float f32x2_t __attribute__((ext_vector_type(2))); typedef __bf16 bf16x2_t __attribute__((ext_vector_type(2)));
__device__ __forceinline__ unsigned cvtpk_s(float lo,float hi){f32x2_t v={lo,hi};bf16x2_t b=__builtin_convertvector(v,bf16x2_t);return __builtin_bit_cast(unsigned,b);}
#define WAIT_BAR(N) asm volatile("s_waitcnt vmcnt(" #N ") lgkmcnt(0)\n\ts_barrier":::"memory")
__device__ __forceinline__ void qkt(f32x16&p0,f32x16&p1,const char*Kslot,const bf16x8*qr,const f32x16&negm,int r32,int hi){
  const char*kb=Kslot+hi*1024+r32*16;
  #pragma unroll
  for(int d0=0;d0<4;++d0){
    const bf16x8 b0=*reinterpret_cast<const bf16x8*>(kb+d0*2048);
    const bf16x8 b1=*reinterpret_cast<const bf16x8*>(kb+d0*2048+512);
    if(d0==0){p0=__builtin_amdgcn_mfma_f32_32x32x16_bf16(b0,qr[0],negm,0,0,0);p1=__builtin_amdgcn_mfma_f32_32x32x16_bf16(b1,qr[0],negm,0,0,0);}
    else{p0=__builtin_amdgcn_mfma_f32_32x32x16_bf16(b0,qr[d0],p0,0,0,0);p1=__builtin_amdgcn_mfma_f32_32x32x16_bf16(b1,qr[d0],p1,0,0,0);}}
}
typedef __attribute__((address_space(3))) const char* lds_cptr;
typedef short v4i16_t __attribute__((ext_vector_type(4)));
__device__ __forceinline__ void kload8(bf16x8*kf,lds_cptr kp){
  kf[0]=*(const __attribute__((address_space(3))) bf16x8*)(kp);      kf[1]=*(const __attribute__((address_space(3))) bf16x8*)(kp+512);
  kf[2]=*(const __attribute__((address_space(3))) bf16x8*)(kp+2048); kf[3]=*(const __attribute__((address_space(3))) bf16x8*)(kp+2560);
  kf[4]=*(const __attribute__((address_space(3))) bf16x8*)(kp+4096); kf[5]=*(const __attribute__((address_space(3))) bf16x8*)(kp+4608);
  kf[6]=*(const __attribute__((address_space(3))) bf16x8*)(kp+6144); kf[7]=*(const __attribute__((address_space(3))) bf16x8*)(kp+6656);
}
__device__ __forceinline__ void kload2(bf16x8*kf,lds_cptr kp,int j){ kf[2*j]=*(const __attribute__((address_space(3))) bf16x8*)(kp+j*2048); kf[2*j+1]=*(const __attribute__((address_space(3))) bf16x8*)(kp+j*2048+512); }
__device__ __forceinline__ s16x4 vtr(lds_cptr p){ return __builtin_bit_cast(s16x4,__builtin_amdgcn_ds_read_tr16_b64_v4i16((__attribute__((address_space(3))) v4i16_t*)p)); }
__device__ __forceinline__ float rowmax(const f32x16&p0,const f32x16&p1){
  float a=max3f(p0[0],p0[1],p1[0]),b=max3f(p0[2],p0[3],p1[1]);a=max3f(a,p1[2],p1[3]);
  #pragma unroll
  for(int r=4;r<16;r+=4){a=max3f(a,p0[r],p0[r+1]);b=max3f(b,p0[r+2],p0[r+3]);a=max3f(a,p1[r],p1[r+1]);b=max3f(b,p1[r+2],p1[r+3]);}
  const float m=max2f(a,b);
  auto rr=__builtin_amdgcn_permlane32_swap(__float_as_uint(m),__float_as_uint(m),false,false);
  return max2f(__uint_as_float(rr[0]),__uint_as_float(rr[1]));
}
__device__ __forceinline__ void pv(f32x16*o,int vb,bf16x8 pa0,bf16x8 pa1,bf16x8 pa2,bf16x8 pa3){
  #pragma unroll
  for(int d0=0;d0<2;++d0){s16x4 lo[4],hi[4];
    #pragma unroll
    for(int ks=0;ks<4;++ks){
      asm volatile("ds_read_b64_tr_b16 %0,%1 offset:%c2":"=&v"(lo[ks]):"v"(vb),"i"(d0*4096+ks*1024):"memory");
      asm volatile("ds_read_b64_tr_b16 %0,%1 offset:%c2":"=&v"(hi[ks]):"v"(vb),"i"(d0*4096+ks*1024+512):"memory");}
    asm volatile("s_waitcnt lgkmcnt(0)":::"memory");SBAR();
    #define PK(k) (bf16x8){lo[k][0],lo[k][1],lo[k][2],lo[k][3],hi[k][0],hi[k][1],hi[k][2],hi[k][3]}
    o[d0]=__builtin_amdgcn_mfma_f32_32x32x16_bf16(pa0,PK(0),o[d0],0,0,0);
    o[d0]=__builtin_amdgcn_mfma_f32_32x32x16_bf16(pa1,PK(1),o[d0],0,0,0);
    o[d0]=__builtin_amdgcn_mfma_f32_32x32x16_bf16(pa2,PK(2),o[d0],0,0,0);
    o[d0]=__builtin_amdgcn_mfma_f32_32x32x16_bf16(pa3,PK(3),o[d0],0,0,0);
    #undef PK
  }
}
template<int THRL> __device__ __forceinline__ void attn_unit(const bf16*Qw,const bf16*__restrict__ Kh,const bf16*__restrict__ Vh,bf16*Ow,char*shm){
  const int tid=threadIdx.x,lane=tid&63,r32=lane&31,hi=lane>>5; const int wid=__builtin_amdgcn_readfirstlane(tid>>6);
  constexpr int DMp=PITCH;
  const unsigned lds0=(unsigned)(uintptr_t)shm;
  float*wsf=(float*)(shm+LDS_WS)+wid*64;
  const bf16*ksrc=Kh+(long)lane*DMp+wid*8;
  const bf16*vsrc=Vh+(long)(16*(wid&3)+(lane>>2))*DMp+(wid>>2)*32+(lane&3)*8;
  const unsigned kdst=lds0+LDS_K+wid*1024, vdst=lds0+LDS_V+wid*1024;
  #define DMA_K(t,slot) glds16(ksrc+(long)(t)*KVBLK*DMp,(unsigned)__builtin_amdgcn_readfirstlane(kdst+(slot)))
  #define DMA_V(t,slot) glds16(vsrc+(long)(t)*KVBLK*DMp,(unsigned)__builtin_amdgcn_readfirstlane(vdst+(slot)))
  const int vb0=(int)(lds0+LDS_V)+((lane>>4)&1)*32+(lane&3)*8+(4*hi+((lane&15)>>2))*64;
  const char*Kbase=shm+LDS_K; bf16x8 kf[8];
  const lds_cptr shm3=(lds_cptr)shm; const lds_cptr kp0=shm3+LDS_K+hi*1024+r32*16; const lds_cptr vp0=shm3+LDS_V+((lane>>4)&1)*32+(lane&3)*8+(4*hi+((lane&15)>>2))*64;
  DMA_K(0,0);DMA_V(0,0);DMA_K(1,SLOTB);
  bf16x8 qr[4];
  #pragma unroll
  for(int d0=0;d0<4;++d0)qr[d0]=*reinterpret_cast<const bf16x8*>(&Qw[(long)r32*DMp+d0*16+hi*8]);
  float mhat=0.f,l_reg=0.f;f32x16 o[2];o[0]=f32x16{};o[1]=f32x16{};f32x16 negm=f32x16{};asm volatile("":"+v"(negm));
  bool resc=false;
  #define START(P0,P1) do{ const float rm=rowmax(P0,P1); resc=false; \
    { const float dl=rm; mhat=fadd_s(mhat,dl); \
      _Pragma("unroll") for(int r=0;r<16;++r){P0[r]=fsub_s(P0[r],dl);P1[r]=fsub_s(P1[r],dl);} \
      _Pragma("unroll") for(int r=0;r<16;++r)negm[r]=-mhat; asm volatile("":"+v"(negm)); } \
    _Pragma("unroll") for(int r=0;r<16;++r)P0[r]=__builtin_amdgcn_exp2f(P0[r]); }while(0)
  #define RESC() do{ if(resc){ asm volatile("s_waitcnt lgkmcnt(0)":::"memory"); \
      _Pragma("unroll") for(int d_=0;d_<2;++d_) _Pragma("unroll") for(int r=0;r<16;++r)o[d_][r]*=wsf[crow(r,hi)]; } }while(0)
  f32x16 pA0,pA1,pB0,pB1;
  int sl_prev=0,sl_cur=0,sl_next=SLOTB;
  #define ROT() do{sl_prev=sl_cur;sl_cur=sl_next;sl_next=(sl_next==(NSLOT-1)*SLOTB)?0:sl_next+SLOTB;}while(0)
  DMA_K(2,2*SLOTB);
  WAIT_BAR(3);
  qkt(pA0,pA1,Kbase,qr,negm,r32,hi);asm volatile("s_nop 15\n\ts_nop 7":"+v"(pA0),"+v"(pA1));
  START(pA0,pA1);
  _Pragma("unroll") for(int r=0;r<16;++r)pA1[r]=__builtin_amdgcn_exp2f(pA1[r]);
  WAIT_BAR(0);
  DMA_K(3,0);DMA_V(1,SLOTB);
  ROT();
  kload8(kf,kp0+sl_cur);
  WAIT_BAR(2);
  s16x4 vlo[8],vhi[8]; u32x4 pw0,pw1,pw2,pw3;
  #define PKW(P,B) cvtpk_s(P[B],P[B+1])
  #define PAF(k) __builtin_bit_cast(bf16x8,pw##k)
  #define VFR(i) (bf16x8){vlo[i][0],vlo[i][1],vlo[i][2],vlo[i][3],vhi[i][0],vhi[i][1],vhi[i][2],vhi[i][3]}
  #define PIN(x) asm volatile("":"+v"(x))
  #define MX3(a,b,c) __builtin_fmaxf(__builtin_fmaxf((a),(b)),(c))
  #define GAPA(MF,A0,A1,A2,A3,W0,W1,PW) do{ MF; sacc+=A0; sacc+=A1; sacc+=A2; sacc+=A3; PIN(sacc); W0; W1; PIN(PW); SBAR(); }while(0)
  #define EX(v) __builtin_amdgcn_exp2f(v)
  #define GAPB(MF,X,B) do{ MF; X[B]=EX(X[B]); X[B+1]=EX(X[B+1]); X[B+2]=EX(X[B+2]); X[B+3]=EX(X[B+3]); PIN(X); SBAR(); }while(0)
  #define VRD(i) do{ vlo[i]=vtr(vp_+(((i)>>2)*4096+((i)&3)*1024)); vhi[i]=vtr(vp_+(((i)>>2)*4096+((i)&3)*1024+512)); }while(0)
  #define KRD(G,j) do{ if(G){ kload2(kf,kp0+sl_next,j); SBAR(); } }while(0)
  #define STEP(C0,C1,P0,P1,t,GK,GV,GL) do{ SBAR(); \
    const lds_cptr vp_=vp0+sl_prev; \
    VRD(0); SBAR(); float sacc=(P0[0]+P0[1]); \
    GAPA(C0=__builtin_amdgcn_mfma_f32_32x32x16_bf16(kf[0],qr[0],negm,0,0,0), P0[2],P0[3],P0[4],P0[5],     pw0[0]=PKW(P0,0), pw0[1]=PKW(P0,2), pw0); \
    VRD(4); SBAR(); GAPA(C1=__builtin_amdgcn_mfma_f32_32x32x16_bf16(kf[1],qr[0],negm,0,0,0), P0[6],P0[7],P0[8],P0[9],     pw0[2]=PKW(P0,4), pw0[3]=PKW(P0,6), pw0); \
    VRD(1); SBAR(); GAPA(C0=__builtin_amdgcn_mfma_f32_32x32x16_bf16(kf[2],qr[1],C0,0,0,0),   P0[10],P0[11],P0[12],P0[13], pw1[0]=PKW(P0,8), pw1[1]=PKW(P0,10), pw1); \
    VRD(5); SBAR(); GAPA(C1=__builtin_amdgcn_mfma_f32_32x32x16_bf16(kf[3],qr[1],C1,0,0,0),   P0[14],P0[15],P1[0],P1[1],   pw1[2]=PKW(P0,12),pw1[3]=PKW(P0,14), pw1); \
    VRD(2); SBAR(); GAPA(C0=__builtin_amdgcn_mfma_f32_32x32x16_bf16(kf[4],qr[2],C0,0,0,0),   P1[2],P1[3],P1[4],P1[5],     pw2[0]=PKW(P1,0), pw2[1]=PKW(P1,2), pw2); \
    VRD(6); SBAR(); GAPA(C1=__builtin_amdgcn_mfma_f32_32x32x16_bf16(kf[5],qr[2],C1,0,0,0),   P1[6],P1[7],P1[8],P1[9],     pw2[2]=PKW(P1,4), pw2[3]=PKW(P1,6), pw2); \
    VRD(3); SBAR(); GAPA(C0=__builtin_amdgcn_mfma_f32_32x32x16_bf16(kf[6],qr[3],C0,0,0,0),   P1[10],P1[11],P1[12],P1[13], pw3[0]=PKW(P1,8), pw3[1]=PKW(P1,10), pw3); \
    VRD(7); SBAR(); GAPA(C1=__builtin_amdgcn_mfma_f32_32x32x16_bf16(kf[7],qr[3],C1,0,0,0),   P1[14],P1[15],0.f,0.f,       pw3[2]=PKW(P1,12),pw3[3]=PKW(P1,14), pw3); \
    l_reg+=sacc; \
    if(GK){DMA_K((t)+3,sl_cur);} if(GV){DMA_V((t)+1,sl_next);} \
    { float a=MX3(C0[0],C0[1],C1[0]),b=MX3(C0[2],C0[3],C1[1]); a=MX3(a,C1[2],C1[3]); \
      _Pragma("unroll") for(int r=4;r<16;r+=4){a=MX3(a,C0[r],C0[r+1]);b=MX3(b,C0[r+2],C0[r+3]);a=MX3(a,C1[r],C1[r+1]);b=MX3(b,C1[r+2],C1[r+3]);} \
      float rm=__builtin_fmaxf(a,b); { auto rr=__builtin_amdgcn_permlane32_swap(__float_as_uint(rm),__float_as_uint(rm),false,false); rm=__builtin_fmaxf(__uint_as_float(rr[0]),__uint_as_float(rr[1])); } \
      resc=false; \
      if(__builtin_expect(__any(rm>(float)THRL),0)){ const float dl=__builtin_fmaxf(rm,0.f); mhat+=dl; \
        _Pragma("unroll") for(int r=0;r<16;++r){C0[r]-=dl;C1[r]-=dl;} \
        _Pragma("unroll") for(int r=0;r<16;++r)negm[r]=-mhat; asm volatile("":"+v"(negm)); \
        const float f=__builtin_amdgcn_exp2f(-dl); l_reg*=f; if(hi==0)wsf[r32]=f; resc=true; } } \
    SBAR(); \
    GAPB(o[0]=__builtin_amdgcn_mfma_f32_32x32x16_bf16(PAF(0),VFR(0),o[0],0,0,0), C0,0); \
    GAPB(o[1]=__builtin_amdgcn_mfma_f32_32x32x16_bf16(PAF(0),VFR(4),o[1],0,0,0), C0,4); \
    KRD(GL,0); GAPB(o[0]=__builtin_amdgcn_mfma_f32_32x32x16_bf16(PAF(1),VFR(1),o[0],0,0,0), C0,8); \
    KRD(GL,1); GAPB(o[1]=__builtin_amdgcn_mfma_f32_32x32x16_bf16(PAF(1),VFR(5),o[1],0,0,0), C0,12); \
    KRD(GL,2); GAPB(o[0]=__builtin_amdgcn_mfma_f32_32x32x16_bf16(PAF(2),VFR(2),o[0],0,0,0), C1,0); \
    KRD(GL,3); GAPB(o[1]=__builtin_amdgcn_mfma_f32_32x32x16_bf16(PAF(2),VFR(6),o[1],0,0,0), C1,4); \
    GAPB(o[0]=__builtin_amdgcn_mfma_f32_32x32x16_bf16(PAF(3),VFR(3),o[0],0,0,0), C1,8); \
    GAPB(o[1]=__builtin_amdgcn_mfma_f32_32x32x16_bf16(PAF(3),VFR(7),o[1],0,0,0), C1,12); \
    }while(0)
  int t=1;
  for(;t+5<NT;t+=2){
    STEP(pB0,pB1,pA0,pA1,t,true,true,true);     WAIT_BAR(2); RESC(); ROT();
    STEP(pA0,pA1,pB0,pB1,t+1,true,true,true);   WAIT_BAR(2); RESC(); ROT();
  }
  #define ENDW(tt) do{ if((tt)+3<NT){WAIT_BAR(2);} else if((tt)+2<NT){WAIT_BAR(1);} else {WAIT_BAR(0);} }while(0)
  for(;t+1<NT;t+=2){
    STEP(pB0,pB1,pA0,pA1,t,(t+3<NT),(t+1<NT),(t+1<NT));       ENDW(t);   RESC(); ROT();
    STEP(pA0,pA1,pB0,pB1,t+1,(t+4<NT),(t+2<NT),(t+2<NT));     ENDW(t+1); RESC(); ROT();
  }
  STEP(pB0,pB1,pA0,pA1,NT-1,false,false,false); RESC();
  { float sacc=pB0[0]+pB0[1]; _Pragma("unroll") for(int r=2;r<16;++r)sacc+=pB0[r]; _Pragma("unroll") for(int r=0;r<16;++r)sacc+=pB1[r]; l_reg+=sacc;
    pw0=(u32x4){PKW(pB0,0),PKW(pB0,2),PKW(pB0,4),PKW(pB0,6)};pw1=(u32x4){PKW(pB0,8),PKW(pB0,10),PKW(pB0,12),PKW(pB0,14)};pw2=(u32x4){PKW(pB1,0),PKW(pB1,2),PKW(pB1,4),PKW(pB1,6)};pw3=(u32x4){PKW(pB1,8),PKW(pB1,10),PKW(pB1,12),PKW(pB1,14)};
    SBAR(); pv(o,vb0+sl_cur,PAF(0),PAF(1),PAF(2),PAF(3)); }
  #undef PKW
  #undef PAF
  #undef VFR
  #undef PIN
  #undef MX3
  #undef GAPA
  #undef GAPB
  #undef EX
  #undef VRD
  #undef KRD
  #undef STEP
  #undef ENDW
  {auto rr=__builtin_amdgcn_permlane32_swap(__float_as_uint(l_reg),__float_as_uint(l_reg),false,false);l_reg=__uint_as_float(rr[0])+__uint_as_float(rr[1]);}
  if(hi==0)wsf[32+r32]=l_reg;asm volatile("s_waitcnt lgkmcnt(0)":::"memory");
  float rli[16];
  #pragma unroll
  for(int r=0;r<16;++r)rli[r]=__builtin_amdgcn_rcpf(wsf[32+crow(r,hi)]);
  { bf16*stg=(bf16*)(shm+LDS_OST)+wid*2048;
    #pragma unroll
    for(int r=0;r<16;++r){const int orow=crow(r,hi);
      #pragma unroll
      for(int d0=0;d0<2;++d0)stg[orow*64+d0*32+r32]=__float2bfloat16(o[d0][r]*rli[r]);}
    asm volatile("s_waitcnt lgkmcnt(0)":::"memory");
    #pragma unroll
    for(int i=0;i<4;++i){const int row=i*8+(lane>>3),ch=lane&7; const u32x4 v=*(const u32x4*)(stg+row*64+ch*8); *(u32x4*)(Ow+(long)row*DMp+ch*8)=v;} }
  asm volatile("s_waitcnt lgkmcnt(0)\n\ts_barrier":::"memory");
  #undef DMA_K
  #undef DMA_V
  #undef START
  #undef RESC
  #undef ROT
}

constexpr int VSLOTB=16384;
constexpr int L2_K=0, L2_V=NSLOT*SLOTB, L2_WS=L2_V+NSLOT*VSLOTB, L2_OST=L2_WS+NW*64*4, L2_BYTES=L2_OST+NW*4096;
template<int THRL> __device__ __forceinline__ void attn_unit128(const bf16*Qw,const bf16*__restrict__ Kh,const bf16*__restrict__ Vh,bf16*Ow,char*shm){
  const int tid=threadIdx.x,lane=tid&63,r32=lane&31,hi=lane>>5; const int wid=__builtin_amdgcn_readfirstlane(tid>>6);
  constexpr int DMp=PITCH;
  const unsigned lds0=(unsigned)(uintptr_t)shm;
  float*wsf=(float*)(shm+L2_WS)+wid*64;
  const unsigned koff=(unsigned)(lane*DMp+wid*8)*2u;
  const unsigned voff=(unsigned)((16*(wid&3)+(lane>>2))*DMp+(wid>>2)*32+(lane&3)*8)*2u;
  const unsigned kdst=lds0+L2_K+wid*1024, vdst=lds0+L2_V+wid*1024;
  #define DMA_K(t,slot) glds16s((const char*)Kh+(long)(t)*KVBLK*DMp*2,koff,(unsigned)__builtin_amdgcn_readfirstlane(kdst+(slot)))
  #define DMA_V(t,slot) do{ glds16s((const char*)Vh+(long)(t)*KVBLK*DMp*2,voff,(unsigned)__builtin_amdgcn_readfirstlane(vdst+2*(slot))); glds16s((const char*)Vh+(long)(t)*KVBLK*DMp*2+128,voff,(unsigned)__builtin_amdgcn_readfirstlane(vdst+2*(slot)+8192)); }while(0)
  const char*Kbase=shm+L2_K; bf16x8 kf[8];
  const lds_cptr shm3=(lds_cptr)shm; const lds_cptr kp0=shm3+L2_K+hi*1024+r32*16; const lds_cptr vp0=shm3+L2_V+((lane>>4)&1)*32+(lane&3)*8+(4*hi+((lane&15)>>2))*64;
  DMA_K(0,0);DMA_V(0,0);DMA_K(1,SLOTB);
  bf16x8 qr[4];
  #pragma unroll
  for(int d0=0;d0<4;++d0)qr[d0]=*reinterpret_cast<const bf16x8*>(&Qw[(long)r32*DMp+d0*16+hi*8]);
  float mhat=0.f,l_reg=0.f;f32x16 o[4];o[0]=f32x16{};o[1]=f32x16{};o[2]=f32x16{};o[3]=f32x16{};f32x16 negm=f32x16{};asm volatile("":"+v"(negm));
  bool resc=false;
  #define RESC() do{ if(resc){ asm volatile("s_waitcnt lgkmcnt(0)":::"memory"); \
      _Pragma("unroll") for(int d_=0;d_<4;++d_) _Pragma("unroll") for(int r=0;r<16;++r)o[d_][r]*=wsf[crow(r,hi)]; } }while(0)
  f32x16 c0,c1; u32x4 pw0,pw1,pw2,pw3;
  int sl_prev=0,sl_cur=0,sl_next=SLOTB;
  #define ROT() do{sl_prev=sl_cur;sl_cur=sl_next;sl_next=(sl_next==(NSLOT-1)*SLOTB)?0:sl_next+SLOTB;}while(0)
  #define PKW(P,B) cvtpk_s(P[B],P[B+1])
  #define PAF(k) __builtin_bit_cast(bf16x8,pw##k)
  DMA_K(2,2*SLOTB);
  WAIT_BAR(4);
  qkt(c0,c1,Kbase,qr,negm,r32,hi);asm volatile("s_nop 15\n\ts_nop 7":"+v"(c0),"+v"(c1));
  { const float rm=rowmax(c0,c1); mhat=fadd_s(mhat,rm);
    _Pragma("unroll") for(int r=0;r<16;++r){c0[r]=fsub_s(c0[r],rm);c1[r]=fsub_s(c1[r],rm);}
    _Pragma("unroll") for(int r=0;r<16;++r)negm[r]=-mhat; asm volatile("":"+v"(negm));
    _Pragma("unroll") for(int r=0;r<16;++r){c0[r]=__builtin_amdgcn_exp2f(c0[r]);c1[r]=__builtin_amdgcn_exp2f(c1[r]);}
    float sacc=c0[0]+c0[1]; _Pragma("unroll") for(int r=2;r<16;++r)sacc+=c0[r]; _Pragma("unroll") for(int r=0;r<16;++r)sacc+=c1[r]; l_reg+=sacc;
    pw0=(u32x4){PKW(c0,0),PKW(c0,2),PKW(c0,4),PKW(c0,6)};pw1=(u32x4){PKW(c0,8),PKW(c0,10),PKW(c0,12),PKW(c0,14)};pw2=(u32x4){PKW(c1,0),PKW(c1,2),PKW(c1,4),PKW(c1,6)};pw3=(u32x4){PKW(c1,8),PKW(c1,10),PKW(c1,12),PKW(c1,14)}; }
  WAIT_BAR(0);
  DMA_K(3,0);DMA_V(1,SLOTB);
  ROT();
  kload8(kf,kp0+sl_cur);
  WAIT_BAR(3);
  s16x4 vlo[8],vhi[8];
  #define VFR(i) (bf16x8){vlo[i][0],vlo[i][1],vlo[i][2],vlo[i][3],vhi[i][0],vhi[i][1],vhi[i][2],vhi[i][3]}
  #define PIN(x) asm volatile("":"+v"(x))
  #define MX3(a,b,c) __builtin_fmaxf(__builtin_fmaxf((a),(b)),(c))
  #define EX(v) __builtin_amdgcn_exp2f(v)
  #define VRD(H,i) do{ vlo[i]=vtr(vp_+((2*(H)+((i)>>2))*4096+((i)&3)*1024)); vhi[i]=vtr(vp_+((2*(H)+((i)>>2))*4096+((i)&3)*1024+512)); }while(0)
  #define KRD(G,j) do{ if(G){ kload2(kf,kp0+sl_next,j); SBAR(); } }while(0)
  #define GAPA(MF) do{ MF; SBAR(); }while(0)
  #define GAPB(MF,X,B,VR) do{ MF; X[B]=EX(X[B]); X[B+1]=EX(X[B+1]); X[B+2]=EX(X[B+2]); X[B+3]=EX(X[B+3]); PIN(X); VR; SBAR(); }while(0)
  #define GAPC(MF,X,B) do{ MF; sacc+=X[B]; sacc+=X[B+1]; sacc+=X[B+2]; sacc+=X[B+3]; PIN(sacc); SBAR(); }while(0)
  #define GAPCE(MF,X,B,Y,D) do{ MF; sacc+=X[B]; sacc+=X[B+1]; sacc+=X[B+2]; sacc+=X[B+3]; PIN(sacc); Y[D]=EX(Y[D]); Y[D+1]=EX(Y[D+1]); Y[D+2]=EX(Y[D+2]); Y[D+3]=EX(Y[D+3]); PIN(Y); SBAR(); }while(0)
  #define STEP(t,GK,GV,GL) do{ SBAR(); \
    const lds_cptr vp_=vp0+2*sl_prev; \
      \
    VRD(0,0); SBAR(); GAPA(c0=__builtin_amdgcn_mfma_f32_32x32x16_bf16(kf[0],qr[0],negm,0,0,0)); \
    VRD(0,4); SBAR(); GAPA(c1=__builtin_amdgcn_mfma_f32_32x32x16_bf16(kf[1],qr[0],negm,0,0,0)); \
    VRD(0,1); SBAR(); GAPA(c0=__builtin_amdgcn_mfma_f32_32x32x16_bf16(kf[2],qr[1],c0,0,0,0)); \
    VRD(0,5); SBAR(); GAPA(c1=__builtin_amdgcn_mfma_f32_32x32x16_bf16(kf[3],qr[1],c1,0,0,0)); \
    VRD(0,2); SBAR(); GAPA(c0=__builtin_amdgcn_mfma_f32_32x32x16_bf16(kf[4],qr[2],c0,0,0,0)); \
    VRD(0,6); SBAR(); GAPA(c1=__builtin_amdgcn_mfma_f32_32x32x16_bf16(kf[5],qr[2],c1,0,0,0)); \
    VRD(0,3); SBAR(); GAPA(c0=__builtin_amdgcn_mfma_f32_32x32x16_bf16(kf[6],qr[3],c0,0,0,0)); \
    VRD(0,7); SBAR(); GAPA(c1=__builtin_amdgcn_mfma_f32_32x32x16_bf16(kf[7],qr[3],c1,0,0,0)); \
    if(GK){DMA_K((t)+3,sl_cur);} if(GV){DMA_V((t)+1,sl_next);} \
    SBAR(); \
      \
    float mxa,mxb,rm_; \
    o[0]=__builtin_amdgcn_mfma_f32_32x32x16_bf16(PAF(0),VFR(0),o[0],0,0,0); \
    { mxa=MX3(c0[0],c0[1],c0[2]); mxb=MX3(c0[3],c0[4],c0[5]); mxa=MX3(mxa,c0[6],c0[7]); mxb=MX3(mxb,c0[8],c0[9]); mxa=MX3(mxa,c0[10],c0[11]); mxb=MX3(mxb,c0[12],c0[13]); mxa=MX3(mxa,c0[14],c0[15]); } VRD(1,0); SBAR(); \
    o[1]=__builtin_amdgcn_mfma_f32_32x32x16_bf16(PAF(0),VFR(4),o[1],0,0,0); \
    { mxb=MX3(mxb,c1[0],c1[1]); mxa=MX3(mxa,c1[2],c1[3]); mxb=MX3(mxb,c1[4],c1[5]); mxa=MX3(mxa,c1[6],c1[7]); mxb=MX3(mxb,c1[8],c1[9]); mxa=MX3(mxa,c1[10],c1[11]); mxb=MX3(mxb,c1[12],c1[13]); mxa=MX3(mxa,c1[14],c1[15]); \
      rm_=__builtin_fmaxf(mxa,mxb); { auto rr=__builtin_amdgcn_permlane32_swap(__float_as_uint(rm_),__float_as_uint(rm_),false,false); rm_=__builtin_fmaxf(__uint_as_float(rr[0]),__uint_as_float(rr[1])); } } VRD(1,4); SBAR(); \
    o[0]=__builtin_amdgcn_mfma_f32_32x32x16_bf16(PAF(1),VFR(1),o[0],0,0,0); \
    { resc=false; \
      if(__builtin_expect(__any(rm_>(float)THRL),0)){ const float dl=__builtin_fmaxf(rm_,0.f); mhat+=dl; \
        _Pragma("unroll") for(int r=0;r<16;++r){c0[r]-=dl;c1[r]-=dl;} \
        _Pragma("unroll") for(int r=0;r<16;++r)negm[r]=-mhat; asm volatile("":"+v"(negm)); \
        const float f=__builtin_amdgcn_exp2f(-dl); l_reg*=f; if(hi==0)wsf[r32]=f; resc=true; } } VRD(1,1); SBAR(); \
    GAPB(o[1]=__builtin_amdgcn_mfma_f32_32x32x16_bf16(PAF(1),VFR(5),o[1],0,0,0), c0,0,  VRD(1,5)); \
    GAPB(o[0]=__builtin_amdgcn_mfma_f32_32x32x16_bf16(PAF(2),VFR(2),o[0],0,0,0), c0,4,  VRD(1,2)); \
    GAPB(o[1]=__builtin_amdgcn_mfma_f32_32x32x16_bf16(PAF(2),VFR(6),o[1],0,0,0), c0,8,  VRD(1,6)); \
    GAPB(o[0]=__builtin_amdgcn_mfma_f32_32x32x16_bf16(PAF(3),VFR(3),o[0],0,0,0), c0,12, VRD(1,3)); \
    GAPB(o[1]=__builtin_amdgcn_mfma_f32_32x32x16_bf16(PAF(3),VFR(7),o[1],0,0,0), c1,0,  VRD(1,7)); \
      \
    float sacc=0.f; \
    GAPCE(o[2]=__builtin_amdgcn_mfma_f32_32x32x16_bf16(PAF(0),VFR(0),o[2],0,0,0), c0,0, c1,4); \
    GAPCE(o[3]=__builtin_amdgcn_mfma_f32_32x32x16_bf16(PAF(0),VFR(4),o[3],0,0,0), c0,4, c1,8); \
    pw0[0]=PKW(c0,0); pw0[1]=PKW(c0,2); pw0[2]=PKW(c0,4); pw0[3]=PKW(c0,6); PIN(pw0); SBAR(); \
    KRD(GL,0); GAPCE(o[2]=__builtin_amdgcn_mfma_f32_32x32x16_bf16(PAF(1),VFR(1),o[2],0,0,0), c0,8, c1,12); \
    KRD(GL,1); GAPC(o[3]=__builtin_amdgcn_mfma_f32_32x32x16_bf16(PAF(1),VFR(5),o[3],0,0,0), c0,12); \
    pw1[0]=PKW(c0,8); pw1[1]=PKW(c0,10); pw1[2]=PKW(c0,12); pw1[3]=PKW(c0,14); PIN(pw1); SBAR(); \
    KRD(GL,2); GAPC(o[2]=__builtin_amdgcn_mfma_f32_32x32x16_bf16(PAF(2),VFR(2),o[2],0,0,0), c1,0); \
    KRD(GL,3); GAPC(o[3]=__builtin_amdgcn_mfma_f32_32x32x16_bf16(PAF(2),VFR(6),o[3],0,0,0), c1,4); \
    pw2[0]=PKW(c1,0); pw2[1]=PKW(c1,2); pw2[2]=PKW(c1,4); pw2[3]=PKW(c1,6); PIN(pw2); SBAR(); \
    GAPC(o[2]=__builtin_amdgcn_mfma_f32_32x32x16_bf16(PAF(3),VFR(3),o[2],0,0,0), c1,8); \
    GAPC(o[3]=__builtin_amdgcn_mfma_f32_32x32x16_bf16(PAF(3),VFR(7),o[3],0,0,0), c1,12); \
    pw3[0]=PKW(c1,8); pw3[1]=PKW(c1,10); pw3[2]=PKW(c1,12); pw3[3]=PKW(c1,14); PIN(pw3); SBAR(); \
    l_reg+=sacc; \
    }while(0)
  int t=1;
  for(;t+5<NT;t+=2){
    STEP(t,true,true,true);     WAIT_BAR(3); RESC(); ROT();
    STEP(t+1,true,true,true);   WAIT_BAR(3); RESC(); ROT();
  }
  #define ENDW(tt) do{ if((tt)+3<NT){WAIT_BAR(3);} else if((tt)+2<NT){WAIT_BAR(2);} else {WAIT_BAR(0);} }while(0)
  for(;t+1<NT;t+=2){
    STEP(t,(t+3<NT),(t+1<NT),(t+1<NT));       ENDW(t);   RESC(); ROT();
    STEP(t+1,(t+4<NT),(t+2<NT),(t+2<NT));     ENDW(t+1); RESC(); ROT();
  }
  STEP(NT-1,false,false,false); RESC();
  { int lane_=threadIdx.x&63; asm volatile("":"+v"(lane_));
    const int vb=(int)(lds0+L2_V)+((lane_>>4)&1)*32+(lane_&3)*8+(4*(lane_>>5)+((lane_&15)>>2))*64+2*sl_cur;
    #pragma unroll
    for(int d0=0;d0<4;++d0){s16x4 lo[4],hh[4];
      #pragma unroll
      for(int ks=0;ks<4;++ks){
        asm volatile("ds_read_b64_tr_b16 %0,%1 offset:%c2":"=&v"(lo[ks]):"v"(vb),"i"(d0*4096+ks*1024):"memory");
        asm volatile("ds_read_b64_tr_b16 %0,%1 offset:%c2":"=&v"(hh[ks]):"v"(vb),"i"(d0*4096+ks*1024+512):"memory");}
      asm volatile("s_waitcnt lgkmcnt(0)":::"memory");SBAR();
      #define PK(k) (bf16x8){lo[k][0],lo[k][1],lo[k][2],lo[k][3],hh[k][0],hh[k][1],hh[k][2],hh[k][3]}
      o[d0]=__builtin_amdgcn_mfma_f32_32x32x16_bf16(PAF(0),PK(0),o[d0],0,0,0);
      o[d0]=__builtin_amdgcn_mfma_f32_32x32x16_bf16(PAF(1),PK(1),o[d0],0,0,0);
      o[d0]=__builtin_amdgcn_mfma_f32_32x32x16_bf16(PAF(2),PK(2),o[d0],0,0,0);
      o[d0]=__builtin_amdgcn_mfma_f32_32x32x16_bf16(PAF(3),PK(3),o[d0],0,0,0);
      #undef PK
    } }
  #undef PKW
  #undef PAF
  #undef VFR
  #undef PIN
  #undef MX3
  #undef GAPA
  #undef GAPB
  #undef GAPC
  #undef GAPCE
  #undef EX
  #undef VRD
  #undef KRD
  #undef STEP
  #undef ENDW
  {auto rr=__builtin_amdgcn_permlane32_swap(__float_as_uint(l_reg),__float_as_uint(l_reg),false,false);l_reg=__uint_as_float(rr[0])+__uint_as_float(rr[1]);}
  if(hi==0)wsf[32+r32]=l_reg;asm volatile("s_waitcnt lgkmcnt(0)":::"memory");
  float rli[16];
  #pragma unroll
  for(int r=0;r<16;++r)rli[r]=__builtin_amdgcn_rcpf(wsf[32+crow(r,hi)]);
  { bf16*stg=(bf16*)(shm+L2_OST)+wid*2048;
    #pragma unroll
    for(int hf=0;hf<2;++hf){
      #pragma unroll
      for(int r=0;r<16;++r){const int orow=crow(r,hi);
        #pragma unroll
        for(int d0=0;d0<2;++d0)stg[orow*64+d0*32+r32]=__float2bfloat16(o[2*hf+d0][r]*rli[r]);}
      asm volatile("s_waitcnt lgkmcnt(0)":::"memory");
      #pragma unroll
      for(int i=0;i<4;++i){const int row=i*8+(lane>>3),ch=lane&7; const u32x4 v=*(const u32x4*)(stg+row*64+ch*8); *(u32x4*)(Ow+(long)row*DMp+hf*64+ch*8)=v;}
      asm volatile("s_waitcnt lgkmcnt(0)":::"memory"); } }
  asm volatile("s_waitcnt lgkmcnt(0)\n\ts_barrier":::"memory");
  #undef DMA_K
  #undef DMA_V
  #undef RESC
  #undef ROT
}
#undef SBAR
#undef WAIT_BAR
}

constexpr int NWAVES = 8, LDS_BYTES = 147456, RING_BYTES = 131072;
struct Params { const float* in[32]; float* out; unsigned char* ws; int ph_lo, ph_hi; };
enum { I_X = 0, I_C, I_CTX, I_CCTX, I_ADAW, I_ADAB, I_NMIXG, I_NFFNG, I_WIN, I_CONVW, I_CONVB, I_LRUWA, I_LRUBA, I_LRUWX, I_LRUBX, I_LRULAM, I_CMVG, I_CMWS, I_CMBS, I_WOUT0,
       I_WQKV, I_LQ1, I_LK1, I_LQ2, I_LK2, I_SUBLN, I_WOUT1, I_ROUTER, I_W1, I_W3, I_W2, I_FINALG };

typedef const __attribute__((address_space(4))) Params* KParams;
__device__ __forceinline__ Params kparams() {
#if defined(__HIP_DEVICE_COMPILE__)
    KParams q = (KParams)__builtin_amdgcn_kernarg_segment_ptr(); asm volatile("" : "+s"(q)); return *q;
#else
    return Params{};
#endif
}
struct Ctx {
    LAS unsigned char* lds; int tid, lane, wave, vcu, G;
};
__device__ __forceinline__ float wave_sum(float v) {
#pragma unroll
    for (int o = 1; o < 64; o <<= 1) v += __shfl_xor(v, o);
    return v;
}
#define LDS_WAIT() asm volatile("s_waitcnt lgkmcnt(0)" ::: "memory")

__device__ __forceinline__ int dest_row(int n, int mode) {
    if (mode == 1) return n < 2048 ? ((n & ~63) + 2 * (n & 31) + ((n >> 5) & 1)) : n;
    if (mode == 2) return 32 * (n >> 4) + (n & 15);
    if (mode == 3) return 32 * (n >> 4) + 16 + (n & 15);
    return n;
}
__device__ __forceinline__ void p0_transpose_item(const float* W, int K, int N, bf16_t* WT, int mode, LAS float* scr, int item, int lane) {
    const int nblk = N / 32, kb = item / nblk, nb = item % nblk, k0 = 64 * kb, n0 = 32 * nb;
    float tv[32];
#pragma unroll
    for (int i = 0; i < 32; ++i) { const int kk = 2 * i + (lane >> 5); tv[i] = __builtin_nontemporal_load(&W[(size_t)(k0 + kk) * N + n0 + (lane & 31)]); }
#pragma unroll
    for (int i = 0; i < 32; ++i) { const int kk = 2 * i + (lane >> 5); scr[kk * 33 + (lane & 31)] = tv[i]; }
    LDS_WAIT(); asm volatile("" ::: "memory");
    const int c = lane & 7;
#pragma unroll
    for (int j = 0; j < 4; ++j) { const int n = (lane >> 3) + 8 * j; const LAS float* s = scr + (8 * c) * 33 + n;
        u32x4 o; o.x = pk2(s[0 * 33], s[1 * 33]); o.y = pk2(s[2 * 33], s[3 * 33]); o.z = pk2(s[4 * 33], s[5 * 33]); o.w = pk2(s[6 * 33], s[7 * 33]);
        *(GAS u32x4*)(WT + (size_t)dest_row(n0 + n, mode) * K + k0 + 8 * c) = o; }
    LDS_WAIT(); asm volatile("" ::: "memory");
}
__device__ __forceinline__ void p0_transpose_item8(const float* W, int K, int N, unsigned char* WT, int mode, LAS float* scr, int item, int lane) {
    const int nblk = N / 32, kb = item / nblk, nb = item % nblk, k0 = 64 * kb, n0 = 32 * nb;
    float tv[32];
#pragma unroll
    for (int i = 0; i < 32; ++i) { const int kk = 2 * i + (lane >> 5); tv[i] = __builtin_nontemporal_load(&W[(size_t)(k0 + kk) * N + n0 + (lane & 31)]); }
#pragma unroll
    for (int i = 0; i < 32; ++i) { const int kk = 2 * i + (lane >> 5); scr[kk * 33 + (lane & 31)] = tv[i] * W8_SCALE; }
    LDS_WAIT(); asm volatile("" ::: "memory");
    const int c = lane & 7;
#pragma unroll
    for (int j = 0; j < 4; ++j) { const int n = (lane >> 3) + 8 * j; const LAS float* sp = scr + (8 * c) * 33 + n;
        u32x2 o; o.x = f2fp8x4(sp[0 * 33], sp[1 * 33], sp[2 * 33], sp[3 * 33]); o.y = f2fp8x4(sp[4 * 33], sp[5 * 33], sp[6 * 33], sp[7 * 33]);
        *(GAS u32x2*)(WT + (size_t)dest_row(n0 + n, mode) * K + k0 + 8 * c) = o; }
    LDS_WAIT(); asm volatile("" ::: "memory");
}
__device__ __forceinline__ void p0_prologue(const Ctx& F, const Params& p) {
    unsigned char* ws = p.ws;
    LAS float* sil = (LAS float*)(F.lds + 8 * 16384);
    for (int i = F.tid; i < 3 * DM; i += 512) { const float v = i < 2 * DM ? p.in[I_C][i] : p.in[I_CCTX][i - 2 * DM]; sil[i] = silu_f(v); }
    __syncthreads();
    {
        float* modp = (float*)(ws + WS_MODP);
        for (int task = F.vcu * NWAVES + F.wave; task < 2 * 96 * 8; task += NWAVES * F.G) {
            const int ks = task & 7, cgp = (task >> 3) % 96, l = task / 768, n = cgp * 64 + F.lane;
            const float* W = p.in[I_ADAW] + ((size_t)l * DM + ks * 128) * 6144 + n;
            float a0 = 0.f, a1 = 0.f, a2 = 0.f;
#pragma unroll 32
            for (int k = 0; k < 128; ++k) { const float w = __builtin_nontemporal_load(&W[(size_t)k * 6144]); a0 += sil[ks * 128 + k] * w; a1 += sil[DM + ks * 128 + k] * w; a2 += sil[2 * DM + ks * 128 + k] * w; }
            float* o = modp + ((size_t)(ks * 2 + l) * 3) * 6144 + n; o[0] = a0; o[6144] = a1; o[2 * 6144] = a2;
        }
    }
    {
        const int gt = F.vcu * 512 + F.tid, NT_ = F.G * 512;
        float* cs = (float*)(ws + WS_ROPE);
        for (int i = gt; i < 192 * 16; i += NT_) { const int pos = i >> 4, f = i & 15; const float inv = powf(10000.0f, -(float)(2 * f) / 32.0f);
            const float ang = (float)(pos < 128 ? pos : pos - 128) * inv; float s, c; sincosf(ang, &s, &c); cs[2 * i] = c; cs[2 * i + 1] = s; }
        bf16_t* lw = (bf16_t*)(ws + WS_LRUW);
        for (int o = gt; o < 2 * 2 * 8 * 64 * 64; o += NT_) { const int i = o & 63, j = (o >> 6) & 63, h = (o >> 12) & 7, g2 = (o >> 15) & 1, d = o >> 16;
            const float* src = g2 ? p.in[I_LRUWX] : p.in[I_LRUWA]; lw[o] = (bf16_t)f2bf(src[((d * 8 + h) * 64 + i) * 64 + j]); }
        bf16_t* cw = (bf16_t*)(ws + WS_CMWS);
        for (int o = gt; o < 8 * 128 * 128; o += NT_) cw[o] = (bf16_t)f2bf(p.in[I_CMWS][o]);
    }
    LAS float* scr = (LAS float*)(F.lds + F.wave * 16384);
    const int gw = F.vcu * NWAVES + F.wave, NGW = F.G * NWAVES;
    constexpr int I_IN = 1024, I_O0 = 512, I_QK = 1536, I_O1 = 512, I_SMALL = I_IN + I_O0 + I_QK + I_O1, I_MOE = 1024, NITEMS = I_SMALL + 3 * 32 * I_MOE;
    constexpr int NMODT = 2 * 96 * 8;
    for (int vit = gw; vit < NMODT + NITEMS; vit += NGW) {
        if (vit < NMODT) continue;
        int r = vit - NMODT;
        if (r < I_SMALL) {
            if (r < I_IN) { p0_transpose_item(p.in[I_WIN], DM, 2048, (bf16_t*)(ws + WS_WIN), 0, scr, r, F.lane); continue; } r -= I_IN;
            if (r < I_O0) { p0_transpose_item(p.in[I_WOUT0], DM, DM, (bf16_t*)(ws + WS_WOUT0), 0, scr, r, F.lane); continue; } r -= I_O0;
            if (r < I_QK) { p0_transpose_item(p.in[I_WQKV], DM, 3072, (bf16_t*)(ws + WS_WQKV), 1, scr, r, F.lane); continue; } r -= I_QK;
            p0_transpose_item(p.in[I_WOUT1], DM, DM, (bf16_t*)(ws + WS_WOUT1), 0, scr, r, F.lane); continue;
        }
        r -= I_SMALL; const int which = r / (32 * I_MOE), le = (r / I_MOE) % 32, item = r % I_MOE;
        if (which == 0) p0_transpose_item8(p.in[I_W1] + (size_t)le * DM * FF, DM, FF, ws + WS_W13 + (size_t)le * 4096 * DM, 2, scr, item, F.lane);
        else if (which == 1) p0_transpose_item8(p.in[I_W3] + (size_t)le * DM * FF, DM, FF, ws + WS_W13 + (size_t)le * 4096 * DM, 3, scr, item, F.lane);
        else p0_transpose_item8(p.in[I_W2] + (size_t)le * FF * DM, FF, DM, ws + WS_W2 + (size_t)le * DM * FF, 0, scr, item, F.lane);
    }
}

__device__ __forceinline__ void ld_row(const float* pr, int lane, f32x4 (&v)[4]) {
#pragma unroll
    for (int j = 0; j < 4; ++j) v[j] = *(const f32x4*)(pr + 4 * lane + 256 * j);
}
__device__ __forceinline__ void ld_row_bf(const bf16_t* pr, int lane, f32x4 (&v)[4]) {
#pragma unroll
    for (int j = 0; j < 4; ++j) { const u32x2 w = *(const u32x2*)(pr + 4 * lane + 256 * j); v[j] = (f32x4){bflo(w.x), bfhi(w.x), bflo(w.y), bfhi(w.y)}; }
}
__device__ __forceinline__ float row_rstd(const f32x4 (&v)[4]) {
    float s = 0.f;
#pragma unroll
    for (int j = 0; j < 4; ++j) s += (v[j][0] * v[j][0] + v[j][1] * v[j][1]) + (v[j][2] * v[j][2] + v[j][3] * v[j][3]);
    return 1.0f / sqrtf(wave_sum(s) * (1.0f / DM) + EPS);
}
__device__ __forceinline__ void mod_norm(f32x4 (&v)[4], float rstd, const float* g, const float* sc, const float* sh, int lane) {
#pragma unroll
    for (int j = 0; j < 4; ++j) { const int c = 4 * lane + 256 * j; const f32x4 gv = *(const f32x4*)(g + c), sv = *(const f32x4*)(sc + c), hv = *(const f32x4*)(sh + c);
        v[j] = v[j] * rstd * gv * (sv + 1.0f) + hv; }
}
__device__ __forceinline__ void st_row_bf16(bf16_t* pr, int lane, const f32x4 (&v)[4]) {
#pragma unroll
    for (int j = 0; j < 4; ++j) { u32x2 w; w.x = pk2(v[j][0], v[j][1]); w.y = pk2(v[j][2], v[j][3]); *(u32x2*)(pr + 4 * lane + 256 * j) = w; }
}
__device__ __forceinline__ void row_info(int R, int& b, int& j, int& rt) { b = R / LR; j = R % LR; rt = j < CTXL ? 2 : b; }

__device__ __forceinline__ void stage_mod(const Ctx& F, LAS float* dst, const float* mod_l, const float* g, int sc_chunk, int sh_chunk) {
    float gq[6], sq[6], hq[6];
#pragma unroll
    for (int q = 0; q < 6; ++q) { const int i = F.tid + 512 * q, rt = i >> 10, c = i & 1023; const float* m = mod_l + (size_t)rt * 6144; gq[q] = g[c]; sq[q] = m[sc_chunk * DM + c]; hq[q] = m[sh_chunk * DM + c]; }
#pragma unroll
    for (int q = 0; q < 6; ++q) { const int i = F.tid + 512 * q; dst[i] = gq[q] * (1.0f + sq[q]); dst[3 * DM + i] = hq[q]; }
}
__device__ __forceinline__ void apply_mod(f32x4 (&v)[4], float rstd, const LAS float* ms, int rt, int lane) {
#pragma unroll
    for (int j = 0; j < 4; ++j) { const int c = rt * DM + 4 * lane + 256 * j; v[j] = v[j] * rstd * *(const LAS f32x4*)(ms + c) + *(const LAS f32x4*)(ms + 3 * DM + c); }
}
constexpr int NBR = 4;
__device__ __forceinline__ void p_norm1_in(const Ctx& F, const Params& p) {
    bf16_t* H = (bf16_t*)(p.ws + WS_H);
    LAS float* ms = (LAS float*)F.lds;
    {
        const float* modp = (const float*)(p.ws + WS_MODP); float* modw = (float*)(p.ws + WS_MOD);
        for (int i = blockIdx.x * 512 + F.tid; i < 2 * 3 * 6144; i += F.G * 512) { const int l = i / (3 * 6144), n = i % 6144; float a = p.in[I_ADAB][l * 6144 + n];
#pragma unroll
            for (int ks = 0; ks < 8; ++ks) a += modp[(size_t)ks * 2 * 3 * 6144 + i];
            modw[i] = a; }
#pragma unroll
        for (int q = 0; q < 6; q += 2) {
            float shv[2][8], scv[2][8], b0[2], b1[2], gg[2];
#pragma unroll
            for (int u = 0; u < 2; ++u) { const int i = F.tid + 512 * (q + u), rt = i >> 10, c = i & 1023; b0[u] = p.in[I_ADAB][c]; b1[u] = p.in[I_ADAB][DM + c]; gg[u] = p.in[I_NMIXG][c];
#pragma unroll
                for (int ks = 0; ks < 8; ++ks) { const float* pp = modp + ((size_t)(ks * 2 + 0) * 3 + rt) * 6144; shv[u][ks] = pp[c]; scv[u][ks] = pp[DM + c]; } }
#pragma unroll
            for (int u = 0; u < 2; ++u) { const int i = F.tid + 512 * (q + u); float sh = b0[u], sc = b1[u];
#pragma unroll
                for (int ks = 0; ks < 8; ++ks) { sh += shv[u][ks]; sc += scv[u][ks]; }
                ms[i] = gg[u] * (1.0f + sc); ms[3 * DM + i] = sh; } }
    }
    __syncthreads();
    const int gw = F.vcu * NWAVES + F.wave, NGW = F.G * NWAVES;
    for (int R0 = gw; R0 < NR; R0 += NBR * NGW) {
        f32x4 v[NBR][4]; int rts[NBR];
#pragma unroll
        for (int k = 0; k < NBR; ++k) { const int R = R0 + k * NGW < NR ? R0 + k * NGW : R0; int b, j; row_info(R, b, j, rts[k]);
            const float* src = j < CTXL ? p.in[I_CTX] + ((size_t)b * CTXL + j) * DM : p.in[I_X] + ((size_t)b * SEQ + (j - CTXL)) * DM; ld_row(src, F.lane, v[k]); }
#pragma unroll
        for (int k = 0; k < NBR; ++k) { const int R = R0 + k * NGW; const float rstd = row_rstd(v[k]); apply_mod(v[k], rstd, ms, rts[k], F.lane); if (R < NR) st_row_bf16(H + (size_t)R * DM, F.lane, v[k]); } }
    __syncthreads();
}
__device__ __forceinline__ void p_norm2_router(const Ctx& F, const Params& p, int l, bool with_ctx) {
    const float* mod = (const float*)(p.ws + WS_MOD); bf16_t* H = (bf16_t*)(p.ws + WS_H); const bf16_t* X = (const bf16_t*)(p.ws + WS_X); float* aff = (float*)(p.ws + WS_AFF);
    LAS float* wr = (LAS float*)F.lds;
    LAS float* ms = wr + DM * NE;
    for (int i = F.tid; i < DM * NE / 4; i += 512) { const int c = i >> 2, q = i & 3; ((LAS f32x4*)wr)[q * DM + (c & 3) * 256 + (c >> 2)] = ((const f32x4*)(p.in[I_ROUTER] + (size_t)l * DM * NE))[i]; }
    stage_mod(F, ms, mod + (size_t)l * 3 * 6144, p.in[I_NFFNG] + l * DM, 4, 3);
    __syncthreads();
    const int gw = F.vcu * NWAVES + F.wave, NGW = F.G * NWAVES; const int hi5 = (F.lane >> 5) & 1, hi4 = (F.lane >> 4) & 1, hi3 = (F.lane >> 3) & 1, hi2 = (F.lane >> 2) & 1;
    const int nrows = with_ctx ? NR : NLAT;
    for (int r0 = gw; r0 < nrows; r0 += NBR * NGW) {
        f32x4 v[NBR][4]; int Rs[NBR], bs[NBR], js[NBR], rts[NBR]; bool ok[NBR];
#pragma unroll
        for (int k = 0; k < NBR; ++k) { int r = r0 + k * NGW; ok[k] = r < nrows; if (!ok[k]) r = r0; Rs[k] = with_ctx ? r : (r / SEQ) * LR + CTXL + (r % SEQ); row_info(Rs[k], bs[k], js[k], rts[k]);
            ld_row_bf(X + (size_t)Rs[k] * DM, F.lane, v[k]); }
#pragma unroll
        for (int k = 0; k < NBR; ++k) { const float rstd = row_rstd(v[k]); apply_mod(v[k], rstd, ms, rts[k], F.lane); if (ok[k]) st_row_bf16(H + (size_t)Rs[k] * DM, F.lane, v[k]);
            asm volatile("" : "+v"(v[k][0]), "+v"(v[k][1]), "+v"(v[k][2]), "+v"(v[k][3]) :: "memory"); __builtin_amdgcn_sched_barrier(0); }
#pragma unroll
        for (int k = 0; k < NBR; ++k) {
            float a[16];
#pragma unroll
            for (int e = 0; e < 16; ++e) a[e] = 0.f;
#pragma unroll
            for (int jj = 0; jj < 4; ++jj)
#pragma unroll
                for (int i = 0; i < 4; ++i) { const float hv = v[k][jj][i];
#pragma unroll
                    for (int q = 0; q < 4; ++q) { const f32x4 w = ((const LAS f32x4*)wr)[q * DM + i * 256 + 64 * jj + F.lane]; a[4 * q] += hv * w[0]; a[4 * q + 1] += hv * w[1]; a[4 * q + 2] += hv * w[2]; a[4 * q + 3] += hv * w[3]; }
                    }
            float b8[8], b4[4], b2[2], b1;
#pragma unroll
            for (int i = 0; i < 8; ++i) { const float keep = hi5 ? a[i + 8] : a[i], send = hi5 ? a[i] : a[i + 8]; b8[i] = keep + __shfl_xor(send, 32); }
#pragma unroll
            for (int i = 0; i < 4; ++i) { const float keep = hi4 ? b8[i + 4] : b8[i], send = hi4 ? b8[i] : b8[i + 4]; b4[i] = keep + __shfl_xor(send, 16); }
#pragma unroll
            for (int i = 0; i < 2; ++i) { const float keep = hi3 ? b4[i + 2] : b4[i], send = hi3 ? b4[i] : b4[i + 2]; b2[i] = keep + __shfl_xor(send, 8); }
            { const float keep = hi2 ? b2[1] : b2[0], send = hi2 ? b2[0] : b2[1]; b1 = keep + __shfl_xor(send, 4); }
            b1 += __shfl_xor(b1, 1); b1 += __shfl_xor(b1, 2);
            float mx = b1;
#pragma unroll
            for (int o = 4; o < 64; o <<= 1) mx = fmaxf(mx, __shfl_xor(mx, o));
            const float ex = __expf(b1 - mx); float sm = ex;
#pragma unroll
            for (int o = 4; o < 64; o <<= 1) sm += __shfl_xor(sm, o);
            if ((F.lane & 3) == 0 && ok[k]) aff[((size_t)bs[k] * NE + (F.lane >> 2)) * LR + js[k]] = ex / sm;
            asm volatile("" ::: "memory"); __builtin_amdgcn_sched_barrier(0);
        }
    }
    __syncthreads();
}

__device__ __forceinline__ void p_select(const Ctx& F, const Params& p, bool with_ctx) {
    const float* aff = (const float*)(p.ws + WS_AFF); int* inv = (int*)(p.ws + WS_INV); float* gate = (float*)(p.ws + WS_GATE);
    const bf16_t* H = (const bf16_t*)(p.ws + WS_H); bf16_t* XS = (bf16_t*)(p.ws + WS_XS);
    LAS unsigned* hist = (LAS unsigned*)F.lds;
    LAS unsigned* misc = hist + 256;
    LAS unsigned* list = hist + 512;
    LAS unsigned* vals = hist + 512 + 2048;
    if (with_ctx && (int)blockIdx.x >= F.G - 32) {
        const int prob = (int)blockIdx.x - (F.G - 32), b = prob >> 4, e = prob & 15; const float* av = aff + ((size_t)b * NE + e) * LR;
        if (F.tid < CTXL) vals[F.tid] = __float_as_uint(av[F.tid]);
        __syncthreads();
        if (F.tid < CTXL) { const unsigned mine = vals[F.tid]; int rank = 0;
#pragma unroll 16
            for (int j = 0; j < CTXL; ++j) { const unsigned o = vals[j]; rank += (o > mine || (o == mine && j < F.tid)) ? 1 : 0; }
            const int R = b * LR + F.tid; int er = -1;
            if (rank < 32) { er = 2048 + b * 32 + rank; gate[e * EROWS + er] = __uint_as_float(mine); list[2 * rank] = (unsigned)R; list[2 * rank + 1] = (unsigned)er; }
            inv[(size_t)R * NE + e] = er; }
        __syncthreads();
        for (int i0 = F.wave * 4; i0 < 32; i0 += NWAVES * 4) {
            u32x4 v0[4], v1[4]; unsigned er4[4];
#pragma unroll
            for (int k = 0; k < 4; ++k) { const int i = i0 + k; const unsigned R = list[2 * i]; er4[k] = list[2 * i + 1]; const u32x4* sp = (const u32x4*)(H + (size_t)R * DM); v0[k] = sp[2 * F.lane]; v1[k] = sp[2 * F.lane + 1]; }
#pragma unroll
            for (int k = 0; k < 4; ++k) { u32x4* d = (u32x4*)((unsigned char*)XS + ((size_t)e * EROWS + er4[k]) * DM); u32x4 o;
                o.x = f2fp8x4(bflo(v0[k].x), bfhi(v0[k].x), bflo(v0[k].y), bfhi(v0[k].y)); o.y = f2fp8x4(bflo(v0[k].z), bfhi(v0[k].z), bflo(v0[k].w), bfhi(v0[k].w));
                o.z = f2fp8x4(bflo(v1[k].x), bfhi(v1[k].x), bflo(v1[k].y), bfhi(v1[k].y)); o.w = f2fp8x4(bflo(v1[k].z), bfhi(v1[k].z), bflo(v1[k].w), bfhi(v1[k].w));
                d[F.lane] = o; }
        }
        __syncthreads();
    }
    const int nitems = 256;
    for (int item = blockIdx.x; item < nitems; item += F.G) {
        const bool isl = item < 256; const int prob = isl ? item >> 3 : item - 256, seg = isl ? item & 7 : 0, b = prob >> 4, e = prob & 15;
        const int n = isl ? SEQ : CTXL, kcap = isl ? 1024 : 32, j0 = isl ? CTXL : 0, nj = isl ? 16 : 1;
        const float* av = aff + ((size_t)b * NE + e) * LR + j0;
        { unsigned tmp[16];
#pragma unroll
          for (int jj = 0; jj < 16; ++jj) { const int tok = F.tid + 512 * jj; tmp[jj] = tok < n ? __float_as_uint(av[tok]) : 0u; }
#pragma unroll
          for (int jj = 0; jj < 16; ++jj) vals[F.tid + 512 * jj] = tmp[jj]; }
        unsigned prefix = 0u, mask = 0u, kk = (unsigned)kcap;
#pragma unroll 1
        for (int pass = 0; pass < 4; ++pass) { const int shift = 24 - 8 * pass;
            if (F.tid < 256) hist[F.tid] = 0u;
            __syncthreads();
#pragma unroll 1
            for (int jj = 0; jj < nj; ++jj) { const unsigned bt = vals[F.tid + 512 * jj]; if ((bt & mask) == prefix && bt != 0u) atomicAdd((unsigned*)(hist + ((bt >> shift) & 255u)), 1u); }
            __syncthreads();
            if (F.wave == 0) {
                unsigned loc[4], tot = 0u;
#pragma unroll
                for (int q = 0; q < 4; ++q) { loc[q] = hist[255 - 4 * F.lane - q]; tot += loc[q]; }
                unsigned inc = tot;
#pragma unroll
                for (int o = 1; o < 64; o <<= 1) { const unsigned t2 = __shfl_up(inc, o); if (F.lane >= o) inc += t2; }
                unsigned run = inc - tot;
#pragma unroll
                for (int q = 0; q < 4; ++q) { if (run < kk && run + loc[q] >= kk) { misc[0] = (unsigned)(255 - 4 * F.lane - q); misc[1] = kk - run; } run += loc[q]; }
            }
            __syncthreads();
            prefix |= misc[0] << shift; mask |= 0xffu << shift; kk = misc[1];
            __syncthreads();
        }
        const unsigned T = prefix, need_eq = kk, cnt_gt = (unsigned)kcap - need_eq;
        unsigned cnt = 0u;
#pragma unroll 1
        for (int jj = 0; jj < nj; ++jj) { const unsigned bt = vals[F.tid + 512 * jj]; cnt += (bt > T ? 1u : 0u) + (bt == T ? 0x10000u : 0u); }
        unsigned inc = cnt;
#pragma unroll
        for (int o = 1; o < 64; o <<= 1) { const unsigned t2 = __shfl_up(inc, o); if (F.lane >= o) inc += t2; }
        if (F.lane == 63) misc[8 + F.wave] = inc;
        if (F.tid == 0) misc[2] = 0u;
        __syncthreads();
        unsigned base = inc - cnt;
        for (int w = 0; w < F.wave; ++w) base += misc[8 + w];
        unsigned rg = base & 0xffffu, re = base >> 16;
#pragma unroll 1
        for (int jj = 0; jj < nj; ++jj) { const int tok = F.tid + 512 * jj; const unsigned bt = vals[tok]; const bool own = isl ? ((jj >> 1) == seg) : true;
            const bool isgt = bt > T, iseq = bt == T; int slot = -1;
            if (isgt) { slot = (int)rg; } else if (iseq && re < need_eq) { slot = (int)(cnt_gt + re); }
            rg += isgt ? 1u : 0u; re += iseq ? 1u : 0u;
            if (own && tok < n) { const int R = b * LR + j0 + tok; int er = -1;
                if (slot >= 0) { er = isl ? b * 1024 + slot : 2048 + b * 32 + slot; gate[e * EROWS + er] = __uint_as_float(bt);
                    const unsigned pos = atomicAdd((unsigned*)(misc + 2), 1u); list[2 * pos] = (unsigned)R; list[2 * pos + 1] = (unsigned)er; }
                inv[(size_t)R * NE + e] = er; } }
        __syncthreads();
        const int nl = (int)misc[2];
        for (int i0 = F.wave * 4; i0 < nl; i0 += NWAVES * 4) {
            u32x4 v0[4], v1[4]; unsigned er4[4];
#pragma unroll
            for (int k = 0; k < 4; ++k) { const int i = i0 + k < nl ? i0 + k : nl - 1; const unsigned R = list[2 * i]; er4[k] = list[2 * i + 1];
                const u32x4* sp = (const u32x4*)(H + (size_t)R * DM); v0[k] = sp[2 * F.lane]; v1[k] = sp[2 * F.lane + 1]; }
#pragma unroll
            for (int k = 0; k < 4; ++k) { if (i0 + k < nl) { u32x4* d = (u32x4*)((unsigned char*)XS + ((size_t)e * EROWS + er4[k]) * DM); u32x4 o;
                o.x = f2fp8x4(bflo(v0[k].x), bfhi(v0[k].x), bflo(v0[k].y), bfhi(v0[k].y)); o.y = f2fp8x4(bflo(v0[k].z), bfhi(v0[k].z), bflo(v0[k].w), bfhi(v0[k].w));
                o.z = f2fp8x4(bflo(v1[k].x), bfhi(v1[k].x), bflo(v1[k].y), bfhi(v1[k].y)); o.w = f2fp8x4(bflo(v1[k].z), bfhi(v1[k].z), bflo(v1[k].w), bfhi(v1[k].w));
                d[F.lane] = o; } }
        }
        __syncthreads();
    }
}

__device__ __forceinline__ void p_combine(const Ctx& F, const Params& p, int l, bool final_) {
    const float* mod = (const float*)(p.ws + WS_MOD); bf16_t* H = (bf16_t*)(p.ws + WS_H); bf16_t* X = (bf16_t*)(p.ws + WS_X); const int* inv = (const int*)(p.ws + WS_INV);
    const bf16_t* YB = (const bf16_t*)(p.ws + WS_XS);
    LAS float* ms = (LAS float*)F.lds;
    LAS float* g2s = ms + 6 * DM;
    if (final_) { for (int i = F.tid; i < DM; i += 512) ms[i] = p.in[I_FINALG][i]; }
    else stage_mod(F, ms, mod + (size_t)(l + 1) * 3 * 6144, p.in[I_NMIXG] + (l + 1) * DM, 1, 0);
    { float gq[6];
#pragma unroll
      for (int q = 0; q < 6; ++q) { const int i = F.tid + 512 * q; gq[q] = mod[(size_t)(l * 3 + (i >> 10)) * 6144 + 5 * DM + (i & 1023)]; }
#pragma unroll
      for (int q = 0; q < 6; ++q) g2s[F.tid + 512 * q] = gq[q]; }
    __syncthreads();
    const int gw = F.vcu * NWAVES + F.wave, NGW = F.G * NWAVES;
    constexpr int NB2 = 2, NS = 4;
    const int nrows = final_ ? NLAT : NR;
    for (int r0 = gw; r0 < nrows; r0 += NB2 * NGW) {
        f32x4 v[NB2][4]; int myinv[NB2]; unsigned long long msk[NB2]; int Rs[NB2], bs[NB2], js[NB2], rts[NB2]; bool ok[NB2];
#pragma unroll
        for (int k = 0; k < NB2; ++k) { int r = r0 + k * NGW; ok[k] = r < nrows; if (!ok[k]) r = r0; Rs[k] = final_ ? (r / SEQ) * LR + CTXL + (r % SEQ) : r; row_info(Rs[k], bs[k], js[k], rts[k]);
            myinv[k] = F.lane < NE ? inv[(size_t)Rs[k] * NE + F.lane] : -1; ld_row_bf(X + (size_t)Rs[k] * DM, F.lane, v[k]); }
        u32x2 w[NB2][NS][4]; float wt[NB2][NS];
#pragma unroll
        for (int k = 0; k < NB2; ++k) { msk[k] = __ballot(myinv[k] >= 0);
#pragma unroll
            for (int sidx = 0; sidx < NS; ++sidx) { const bf16_t* yr = YB; wt[k][sidx] = 0.f;
                if (msk[k]) { const int e = __builtin_ctzll(msk[k]); msk[k] &= msk[k] - 1; const int er = __builtin_amdgcn_readlane(myinv[k], e); yr = YB + ((size_t)e * EROWS + er) * DM; wt[k][sidx] = 1.f; }
#pragma unroll
                for (int jj = 0; jj < 4; ++jj) w[k][sidx][jj] = *(const u32x2*)(yr + 4 * F.lane + 256 * jj); } }
#pragma unroll
        for (int k = 0; k < NB2; ++k) {
            f32x4 mo[4];
#pragma unroll
            for (int jj = 0; jj < 4; ++jj) mo[jj] = (f32x4){0.f, 0.f, 0.f, 0.f};
#pragma unroll
            for (int sidx = 0; sidx < NS; ++sidx)
#pragma unroll
                for (int jj = 0; jj < 4; ++jj) { const u32x2 ww = w[k][sidx][jj]; const float t = wt[k][sidx]; mo[jj][0] += t * bflo(ww.x); mo[jj][1] += t * bfhi(ww.x); mo[jj][2] += t * bflo(ww.y); mo[jj][3] += t * bfhi(ww.y); }
            while (msk[k]) { const int e = __builtin_ctzll(msk[k]); msk[k] &= msk[k] - 1; const int er = __builtin_amdgcn_readlane(myinv[k], e); const bf16_t* yr = YB + ((size_t)e * EROWS + er) * DM;
#pragma unroll
                for (int jj = 0; jj < 4; ++jj) { const u32x2 ww = *(const u32x2*)(yr + 4 * F.lane + 256 * jj); mo[jj][0] += bflo(ww.x); mo[jj][1] += bfhi(ww.x); mo[jj][2] += bflo(ww.y); mo[jj][3] += bfhi(ww.y); } }
#pragma unroll
            for (int jj = 0; jj < 4; ++jj) v[k][jj] = v[k][jj] + *(const LAS f32x4*)(g2s + rts[k] * DM + 4 * F.lane + 256 * jj) * mo[jj];
            const float rstd = row_rstd(v[k]);
            if (!ok[k]) continue;
            if (final_) { float* o = p.out + ((size_t)bs[k] * SEQ + (js[k] - CTXL)) * DM;
#pragma unroll
                for (int jj = 0; jj < 4; ++jj) { const int c = 4 * F.lane + 256 * jj; __builtin_nontemporal_store(v[k][jj] * rstd * *(const LAS f32x4*)(ms + c), (f32x4*)(o + c)); } }
            else {
#pragma unroll
                for (int jj = 0; jj < 4; ++jj) *(u32x2*)(X + (size_t)Rs[k] * DM + 4 * F.lane + 256 * jj) = pk4(v[k][jj]);
                apply_mod(v[k], rstd, ms, rts[k], F.lane); st_row_bf16(H + (size_t)Rs[k] * DM, F.lane, v[k]); }
        }
    }
    __syncthreads();
}

__device__ __forceinline__ void p_lru(const Ctx& F, const Params& p, bool full) {
    const bf16_t* Z = (const bf16_t*)(p.ws + WS_ACT + ACT_Z); bf16_t* YC = (bf16_t*)(p.ws + WS_ACT + ACT_YCAT); const bf16_t* LW = (const bf16_t*)(p.ws + WS_LRUW);
    f32x2* SUM = (f32x2*)(p.ws + WS_SUM);
    LAS float* recS = (LAS float*)F.lds;
    LAS float* xcF = recS + 67 * 64;
    LAS float* aS = xcF + 64 * 64;
    LAS float* uS = aS + 2 * 64 * 64;
    LAS float* cst = uS + 2 * 64 * 64;
    LAS bf16_t* xcB = (LAS bf16_t*)(cst + 1024 + 128);
    const int wave = F.wave, lane = F.lane, tid = F.tid;
    const int nitems = NTILE64 * 8;
    const int sr = tid >> 3, sc8 = tid & 7; const int hrr = (tid >> 3) == 0 ? -2 : ((tid >> 3) == 1 ? -1 : 64);
    const int gd = wave >> 2, gmf = wave & 3, gfr = lane & 15, gfq = lane >> 4;
    bf16x8 bw[2][4][2]; float cba[4], cbx[4], ccA[4];
    LAS float* cwS = (LAS float*)(xcB + 64 * 72);
    {   const int h = (int)blockIdx.x & 7;
#pragma unroll
        for (int g2 = 0; g2 < 2; ++g2)
#pragma unroll
            for (int nf = 0; nf < 4; ++nf)
#pragma unroll
                for (int ks = 0; ks < 2; ++ks) bw[g2][nf][ks] = *(const bf16x8*)(LW + ((size_t)(((gd * 2 + g2) * 8 + h) * 64 + 16 * nf + gfr)) * 64 + 32 * ks + 8 * gfq);
#pragma unroll
        for (int nf = 0; nf < 4; ++nf) { const int gch = gd * 512 + h * 64 + 16 * nf + gfr; cba[nf] = p.in[I_LRUBA][gch]; cbx[nf] = p.in[I_LRUBX][gch];
            ccA[nf] = -8.0f * 1.4426950408889634f * log1pf(__expf(-p.in[I_LRULAM][gch])); }
        if (tid < 256) cwS[tid] = p.in[I_CONVW][(tid >> 6) * 512 + h * 64 + (tid & 63)]; else if (tid < 320) cwS[tid] = p.in[I_CONVB][h * 64 + (tid - 256)];
        __syncthreads(); }
    u32x4 wrec = (u32x4){0u, 0u, 0u, 0u}, whalo = (u32x4){0u, 0u, 0u, 0u};
    auto tile_geom = [&](int item, int& T, int& h, int& b, int& jt, int& R0) { T = item >> 3; h = item & 7; b = T / 132; jt = T % 132; R0 = b * LR + jt * 64; };
    auto issue_rec = [&](int item) { int T, h, b, jt, R0; tile_geom(item, T, h, b, jt, R0); const bool isctx = jt < 4; const int slo = isctx ? 0 : CTXL, shi = isctx ? CTXL : LR;
        wrec = *(const u32x4*)(Z + (size_t)(R0 + sr) * 2048 + 512 + h * 64 + sc8 * 8);
        whalo = (u32x4){0u, 0u, 0u, 0u};
        if (tid < 24) { const int jj = jt * 64 + hrr; if (jj >= slo && jj < shi) whalo = *(const u32x4*)(Z + (size_t)(R0 + hrr) * 2048 + 512 + h * 64 + sc8 * 8); } };
    if ((int)blockIdx.x < nitems) issue_rec(blockIdx.x);
    for (int item = blockIdx.x; item < nitems; item += F.G) {
        int T, h, b, jt, R0; tile_geom(item, T, h, b, jt, R0); const bool isctx = jt < 4;
        u32x4 wgate = (u32x4){0u, 0u, 0u, 0u};
        if (full) wgate = *(const u32x4*)(Z + (size_t)(R0 + sr) * 2048 + h * 64 + sc8 * 8);
        { LAS float* d = recS + (sr + 2) * 64 + sc8 * 8; const u32x4 w = wrec;
          d[0] = bflo(w.x); d[1] = bfhi(w.x); d[2] = bflo(w.y); d[3] = bfhi(w.y); d[4] = bflo(w.z); d[5] = bfhi(w.z); d[6] = bflo(w.w); d[7] = bfhi(w.w);
          if (tid < 24) { LAS float* d2 = recS + (hrr + 2) * 64 + sc8 * 8; const u32x4 w2 = whalo;
              d2[0] = bflo(w2.x); d2[1] = bfhi(w2.x); d2[2] = bflo(w2.y); d2[3] = bfhi(w2.y); d2[4] = bflo(w2.z); d2[5] = bfhi(w2.z); d2[6] = bflo(w2.w); d2[7] = bfhi(w2.w); } }
        if (item + F.G < nitems) issue_rec(item + F.G);
        __syncthreads();
        { const int r = sr, c8 = sc8 * 8;
          float y[8];
#pragma unroll
          for (int i = 0; i < 8; ++i) y[i] = cwS[256 + c8 + i];
#pragma unroll
          for (int q = 0; q < 4; ++q) { const f32x4 x0 = *(const LAS f32x4*)(recS + (r + q) * 64 + c8), x1 = *(const LAS f32x4*)(recS + (r + q) * 64 + c8 + 4);
              const f32x4 w0 = *(const LAS f32x4*)(cwS + q * 64 + c8), w1 = *(const LAS f32x4*)(cwS + q * 64 + c8 + 4);
              y[0] += w0[0] * x0[0]; y[1] += w0[1] * x0[1]; y[2] += w0[2] * x0[2]; y[3] += w0[3] * x0[3]; y[4] += w1[0] * x1[0]; y[5] += w1[1] * x1[1]; y[6] += w1[2] * x1[2]; y[7] += w1[3] * x1[3]; }
          *(LAS f32x4*)(xcF + r * 64 + c8) = (f32x4){y[0], y[1], y[2], y[3]}; *(LAS f32x4*)(xcF + r * 64 + c8 + 4) = (f32x4){y[4], y[5], y[6], y[7]};
          u32x4 w; w.x = pk2(y[0], y[1]); w.y = pk2(y[2], y[3]); w.z = pk2(y[4], y[5]); w.w = pk2(y[6], y[7]);
          *(LAS u32x4*)(xcB + r * 72 + c8) = w; }
        __syncthreads();
        { const int d = gd, mf = gmf, fr = gfr, fq = gfq;
          bf16x8 af[2];
#pragma unroll
          for (int ks = 0; ks < 2; ++ks) af[ks] = *(const LAS bf16x8*)(xcB + (16 * mf + fr) * 72 + 32 * ks + 8 * fq);
          f32x4 acc[2][4];
#pragma unroll
          for (int g2 = 0; g2 < 2; ++g2)
#pragma unroll
              for (int nf = 0; nf < 4; ++nf) { acc[g2][nf] = (f32x4){0.f, 0.f, 0.f, 0.f};
#pragma unroll
                  for (int ks = 0; ks < 2; ++ks) acc[g2][nf] = __builtin_amdgcn_mfma_f32_16x16x32_bf16(af[ks], bw[g2][nf][ks], acc[g2][nf], 0, 0, 0); }
#pragma unroll
          for (int nf = 0; nf < 4; ++nf) { const int ch = 16 * nf + fr; const float ba = cba[nf], bx = cbx[nf], cA = ccA[nf];
#pragma unroll
              for (int r = 0; r < 4; ++r) { const int tk = 16 * mf + 4 * fq + r;
                  const float rg = __builtin_amdgcn_rcpf(1.0f + __builtin_amdgcn_exp2f(-1.4426950408889634f * (acc[0][nf][r] + ba)));
                  const float ig = __builtin_amdgcn_rcpf(1.0f + __builtin_amdgcn_exp2f(-1.4426950408889634f * (acc[1][nf][r] + bx)));
                  const float a = __builtin_amdgcn_exp2f(rg * cA), mult = __builtin_amdgcn_sqrtf(fmaf(-a, a, 1.0f));
                  aS[(d * 64 + tk) * 64 + ch] = a; uS[(d * 64 + tk) * 64 + ch] = mult * ig * xcF[tk * 64 + ch]; } } }
        __syncthreads();
        if (full && tid < 128) cst[1024 + tid] = ((const float*)(p.ws + WS_CAR))[((size_t)T * 2 + (tid >> 6)) * 512 + h * 64 + (tid & 63)];
        {
            const int dc = tid & 127, d = dc >> 6, ch = dc & 63, sg = tid >> 7;
            const LAS float* ap = aS + d * 4096 + ch; LAS float* up = uS + d * 4096 + ch;
            const int tfirst = d == 0 ? 16 * sg : 63 - 16 * sg, tstep_ = d == 0 ? 64 : -64;
            float av[16], uv[16];
#pragma unroll
            for (int i = 0; i < 16; ++i) { av[i] = ap[tfirst * 64 + i * tstep_]; uv[i] = up[tfirst * 64 + i * tstep_]; }
            float P = 1.f, hs = 0.f;
#pragma unroll
            for (int i = 0; i < 16; ++i) { hs = av[i] * hs + uv[i]; P *= av[i]; uv[i] = hs; }
            asm volatile("" ::: "memory");
            __syncthreads();
            cst[(sg * 128 + dc) * 2] = P; cst[(sg * 128 + dc) * 2 + 1] = hs;
            __syncthreads();
            float cin = full ? cst[1024 + dc] : 0.f;
            float Pt = 1.f;
#pragma unroll
            for (int q = 0; q < 4; ++q) { const float Pq = cst[(q * 128 + dc) * 2], Hq = cst[(q * 128 + dc) * 2 + 1];
                if (q < sg) cin = Pq * cin + Hq;
                Pt *= Pq; }
            if (!full) { if (sg == 3) SUM[((size_t)T * 2 + d) * 512 + h * 64 + ch] = (f32x2){Pt, cst[(3 * 128 + dc) * 2 + 1] + cst[(3 * 128 + dc) * 2] * cin}; }
            else { float pp = cin;
#pragma unroll
                for (int i = 0; i < 16; ++i) { pp *= ap[tfirst * 64 + i * tstep_]; up[tfirst * 64 + i * tstep_] = uv[i] + pp; } }
        }
        __syncthreads();
        if (full) { const int r = sr, c8 = sc8 * 8; const u32x4 gw_ = wgate;
            float gg[8] = {bflo(gw_.x), bfhi(gw_.x), bflo(gw_.y), bfhi(gw_.y), bflo(gw_.z), bfhi(gw_.z), bflo(gw_.w), bfhi(gw_.w)}; float y[8];
            const f32x4 f0 = *(const LAS f32x4*)(uS + r * 64 + c8), f1 = *(const LAS f32x4*)(uS + r * 64 + c8 + 4), b0 = *(const LAS f32x4*)(uS + (64 + r) * 64 + c8), b1 = *(const LAS f32x4*)(uS + (64 + r) * 64 + c8 + 4);
            y[0] = gg[0] * (f0[0] + b0[0]); y[1] = gg[1] * (f0[1] + b0[1]); y[2] = gg[2] * (f0[2] + b0[2]); y[3] = gg[3] * (f0[3] + b0[3]);
            y[4] = gg[4] * (f1[0] + b1[0]); y[5] = gg[5] * (f1[1] + b1[1]); y[6] = gg[6] * (f1[2] + b1[2]); y[7] = gg[7] * (f1[3] + b1[3]);
            u32x4 w; w.x = pk2(y[0], y[1]); w.y = pk2(y[2], y[3]); w.z = pk2(y[4], y[5]); w.w = pk2(y[6], y[7]);
            *(u32x4*)(YC + (size_t)(R0 + r) * DM + h * 64 + c8) = w; }
        __syncthreads();
    }
}

__device__ __forceinline__ void p_lru_carry(const Ctx& F, const Params& p) {
    const f32x2* SUM = (const f32x2*)(p.ws + WS_SUM); float* CAR = (float*)(p.ws + WS_CAR);
    const int task = (int)blockIdx.x - (F.G - 4);
    if (task < 0) return;
    const int tk = task * NWAVES + F.wave, b = tk >> 4, d = (tk >> 3) & 1, h = tk & 7, ch = h * 64 + F.lane;
    float st = 0.f;
    for (int i0 = 0; i0 < 132; i0 += 33) {
        f32x2 sv[33];
#pragma unroll
        for (int k = 0; k < 33; ++k) { const int i = i0 + k; const int jp = d == 0 ? i : (i < 4 ? 3 - i : 135 - i); sv[k] = SUM[((size_t)(b * 132 + jp) * 2 + d) * 512 + ch]; }
#pragma unroll
        for (int k = 0; k < 33; ++k) { const int i = i0 + k; const int jp = d == 0 ? i : (i < 4 ? 3 - i : 135 - i);
            CAR[((size_t)(b * 132 + jp) * 2 + d) * 512 + ch] = st; st = sv[k].x * st + sv[k].y; }
    }
}

__device__ __forceinline__ void p_cm(const Ctx& F, const Params& p) {
    const int GB = F.G - 8;
    if ((int)blockIdx.x >= GB) return;
    const bf16_t* Z = (const bf16_t*)(p.ws + WS_ACT + ACT_Z); bf16_t* YC = (bf16_t*)(p.ws + WS_ACT + ACT_YCAT); const bf16_t* CW = (const bf16_t*)(p.ws + WS_CMWS);
    LAS bf16_t* vnT = (LAS bf16_t*)F.lds;
    LAS float* mix = (LAS float*)(F.lds + 32768);
    const int wave = F.wave, lane = F.lane, tid = F.tid, fr = lane & 15, fq = lane >> 4;
    const int nitems = (NR / 128) * 8; const int q = tid >> 2, part = tid & 3;
    bf16x8 afr[4]; float bsr[4]; float vgr[16];
    {   const int g = (int)blockIdx.x & 7;
#pragma unroll
        for (int ks = 0; ks < 4; ++ks) afr[ks] = *(const bf16x8*)(CW + ((size_t)g * 128 + 16 * wave + fr) * 128 + 32 * ks + 8 * fq);
#pragma unroll
        for (int r = 0; r < 4; ++r) bsr[r] = p.in[I_CMBS][g * 128 + 16 * wave + 4 * fq + r];
#pragma unroll
        for (int i = 0; i < 16; ++i) vgr[i] = p.in[I_CMVG][g * 64 + part * 16 + i]; }
    u32x4 wv0 = (u32x4){0u, 0u, 0u, 0u}, wv1 = wv0;
    auto issue_v = [&](int item) { const int cn = item >> 3, g = item & 7; const bf16_t* src = Z + (size_t)(cn * 128 + q) * 2048 + 1536 + g * 64 + part * 16; wv0 = *(const u32x4*)src; wv1 = *(const u32x4*)(src + 8); };
    if ((int)blockIdx.x < nitems) issue_v(blockIdx.x);
    for (int item = blockIdx.x; item < nitems; item += GB) {
        const int cn = item >> 3, g = item & 7; const int R0 = cn * 128;
        const bf16_t* usrc = Z + (size_t)(R0 + q) * 2048 + 1024 + g * 64 + part * 16; const u32x4 wu0 = *(const u32x4*)usrc, wu1 = *(const u32x4*)(usrc + 8);
        { const u32x4 w0 = wv0, w1 = wv1;
          float v[16] = {bflo(w0.x), bfhi(w0.x), bflo(w0.y), bfhi(w0.y), bflo(w0.z), bfhi(w0.z), bflo(w0.w), bfhi(w0.w), bflo(w1.x), bfhi(w1.x), bflo(w1.y), bfhi(w1.y), bflo(w1.z), bfhi(w1.z), bflo(w1.w), bfhi(w1.w)};
          float ss = 0.f;
#pragma unroll
          for (int i = 0; i < 16; ++i) ss += v[i] * v[i];
          ss += __shfl_xor(ss, 1); ss += __shfl_xor(ss, 2);
          const float rstd = 1.0f / sqrtf(ss * (1.0f / 64.0f) + EPS);
#pragma unroll
          for (int i = 0; i < 16; ++i) vnT[(part * 16 + i) * 136 + q] = (bf16_t)f2bf(v[i] * rstd * vgr[i]); }
        if (item + GB < nitems) issue_v(item + GB);
        __syncthreads();
        f32x4 acc[4];
#pragma unroll
        for (int nf = 0; nf < 4; ++nf) acc[nf] = (f32x4){0.f, 0.f, 0.f, 0.f};
#pragma unroll
        for (int ks = 0; ks < 4; ++ks)
#pragma unroll
            for (int nf = 0; nf < 4; ++nf) { const bf16x8 bfr = *(const LAS bf16x8*)(vnT + (16 * nf + fr) * 136 + 32 * ks + 8 * fq);
                acc[nf] = __builtin_amdgcn_mfma_f32_16x16x32_bf16(afr[ks], bfr, acc[nf], 0, 0, 0); }
#pragma unroll
        for (int r = 0; r < 4; ++r) { const int pp = 16 * wave + 4 * fq + r;
#pragma unroll
            for (int nf = 0; nf < 4; ++nf) mix[pp * 68 + 16 * nf + fr] = acc[nf][r] + bsr[r]; }
        __syncthreads();
        { float ug[16] = {bflo(wu0.x), bfhi(wu0.x), bflo(wu0.y), bfhi(wu0.y), bflo(wu0.z), bfhi(wu0.z), bflo(wu0.w), bfhi(wu0.w), bflo(wu1.x), bfhi(wu1.x), bflo(wu1.y), bfhi(wu1.y), bflo(wu1.z), bfhi(wu1.z), bflo(wu1.w), bfhi(wu1.w)};
          const LAS float* mr = mix + q * 68 + part * 16; float y[16];
#pragma unroll
          for (int i = 0; i < 16; i += 4) { const f32x4 mv = *(const LAS f32x4*)(mr + i); y[i] = ug[i] * mv[0]; y[i + 1] = ug[i + 1] * mv[1]; y[i + 2] = ug[i + 2] * mv[2]; y[i + 3] = ug[i + 3] * mv[3]; }
          u32x4 o0, o1; o0.x = pk2(y[0], y[1]); o0.y = pk2(y[2], y[3]); o0.z = pk2(y[4], y[5]); o0.w = pk2(y[6], y[7]); o1.x = pk2(y[8], y[9]); o1.y = pk2(y[10], y[11]); o1.z = pk2(y[12], y[13]); o1.w = pk2(y[14], y[15]);
          bf16_t* dst = YC + (size_t)(R0 + q) * DM + 512 + g * 64 + part * 16; *(u32x4*)dst = o0; *(u32x4*)(dst + 8) = o1; }
        __syncthreads();
    }
}

__device__ __forceinline__ void sg_tile(const bf16_t* A, size_t lda, const bf16_t* Bt, size_t ldb, int K, int lane, f32x4 (&acc)[4][2]) {
    const int fr = lane & 15, fq = lane >> 4;
#pragma unroll
    for (int m = 0; m < 4; ++m)
#pragma unroll
        for (int n = 0; n < 2; ++n) acc[m][n] = (f32x4){0.f, 0.f, 0.f, 0.f};
    const bf16_t* ap = A + (size_t)fr * lda + 8 * fq; const bf16_t* bp = Bt + (size_t)fr * ldb + 8 * fq;
#pragma unroll 4
    for (int k = 0; k < K; k += 32) {
        bf16x8 af[4], bfr[2];
#pragma unroll
        for (int m = 0; m < 4; ++m) af[m] = *(const bf16x8*)(ap + (size_t)(16 * m) * lda + k);
#pragma unroll
        for (int n = 0; n < 2; ++n) bfr[n] = *(const bf16x8*)(bp + (size_t)(16 * n) * ldb + k);
#pragma unroll
        for (int m = 0; m < 4; ++m)
#pragma unroll
            for (int n = 0; n < 2; ++n) acc[m][n] = __builtin_amdgcn_mfma_f32_16x16x32_bf16(bfr[n], af[m], acc[m][n], 0, 0, 0);
    }
}
__device__ __forceinline__ size_t ctx_row0(int rt8) { return (size_t)(rt8 >> 2) * LR + (size_t)(rt8 & 3) * 64; }
__device__ __forceinline__ void sg_block64(const Ctx& F, const bf16_t* A, size_t lda, const bf16_t* Bt, size_t ldb, int K, f32x4 (&out)[2]) {
    const int kw = K / NWAVES, fr = F.lane & 15, fq = F.lane >> 4;
    f32x4 acc[4][4];
#pragma unroll
    for (int m = 0; m < 4; ++m)
#pragma unroll
        for (int n = 0; n < 4; ++n) acc[m][n] = (f32x4){0.f, 0.f, 0.f, 0.f};
    const bf16_t* ap = A + (size_t)fr * lda + F.wave * kw + 8 * fq; const bf16_t* bp = Bt + (size_t)fr * ldb + F.wave * kw + 8 * fq;
#pragma unroll 4
    for (int k = 0; k < kw; k += 32) {
        bf16x8 af[4], bfr[4];
#pragma unroll
        for (int m = 0; m < 4; ++m) af[m] = *(const bf16x8*)(ap + (size_t)(16 * m) * lda + k);
#pragma unroll
        for (int n = 0; n < 4; ++n) bfr[n] = *(const bf16x8*)(bp + (size_t)(16 * n) * ldb + k);
#pragma unroll
        for (int m = 0; m < 4; ++m)
#pragma unroll
            for (int n = 0; n < 4; ++n) acc[m][n] = __builtin_amdgcn_mfma_f32_16x16x32_bf16(bfr[n], af[m], acc[m][n], 0, 0, 0);
    }
    LAS float* part = (LAS float*)F.lds;
#pragma unroll
    for (int m = 0; m < 4; ++m)
#pragma unroll
        for (int n = 0; n < 4; ++n) *(LAS f32x4*)(part + ((F.wave * 64 + 16 * m + fr) * 64 + 16 * n + 4 * fq)) = acc[m][n];
    __syncthreads();
    out[0] = (f32x4){0.f, 0.f, 0.f, 0.f}; out[1] = out[0];
#pragma unroll
    for (int w = 0; w < NWAVES; ++w) { out[0] += *(const LAS f32x4*)(part + w * 4096 + F.tid * 8); out[1] += *(const LAS f32x4*)(part + w * 4096 + F.tid * 8 + 4); }
    __syncthreads();
}
__device__ __forceinline__ void p_ctx_dense(const Ctx& F, const Params& p, int which) {
    unsigned char* ws = p.ws; const float* mod = (const float*)(ws + WS_MOD);
    const int ncg = which == 0 ? 32 : (which == 1 ? 16 : 32), nunits = 8 * ncg; const int row = F.tid >> 3, c8 = (F.tid & 7) * 8;
    for (int uidx = F.vcu; uidx < nunits; uidx += F.G) {
        const int rt8 = uidx / ncg, cgp = uidx % ncg; const size_t R0 = ctx_row0(rt8), R = R0 + row; const int c = cgp * 64 + c8; f32x4 v[2];
        if (which == 0) { sg_block64(F, (const bf16_t*)(ws + WS_H) + R0 * DM, DM, (const bf16_t*)(ws + WS_WIN) + (size_t)cgp * 64 * DM, DM, DM, v);
            if (cgp < 8 || cgp >= 16) {
#pragma unroll
                for (int i = 0; i < 4; ++i) { v[0][i] = gelu_tanh(v[0][i]); v[1][i] = gelu_tanh(v[1][i]); } }
            u32x4 w; const u32x2 a = pk4(v[0]), b = pk4(v[1]); w.x = a.x; w.y = a.y; w.z = b.x; w.w = b.y;
            *(u32x4*)((bf16_t*)(ws + WS_ACT + ACT_Z) + R * 2048 + c) = w; }
        else if (which == 1) { sg_block64(F, (const bf16_t*)(ws + WS_ACT + ACT_YCAT) + R0 * DM, DM, (const bf16_t*)(ws + WS_WOUT0) + (size_t)cgp * 64 * DM, DM, DM, v);
            const float* cin = p.in[I_CTX] + ((size_t)(rt8 >> 2) * CTXL + (size_t)(rt8 & 3) * 64 + row) * DM; const float* g1 = mod + 2 * 6144 + 2 * DM;
            const f32x4 o0 = *(const f32x4*)(cin + c) + *(const f32x4*)(g1 + c) * v[0], o1 = *(const f32x4*)(cin + c + 4) + *(const f32x4*)(g1 + c + 4) * v[1];
            u32x4 w; const u32x2 a = pk4(o0), b = pk4(o1); w.x = a.x; w.y = a.y; w.z = b.x; w.w = b.y;
            *(u32x4*)((bf16_t*)(ws + WS_X) + R * DM + c) = w; }
        else { sg_block64(F, (const bf16_t*)(ws + WS_H) + R0 * DM, DM, (const bf16_t*)(ws + WS_WQKV) + (size_t)(1024 + cgp * 64) * DM, DM, DM, v);
            bf16_t* dst = (bf16_t*)(ws + WS_ACT + (cgp < 16 ? ACT_K : ACT_V));
            u32x4 w; const u32x2 a = pk4(v[0]), b = pk4(v[1]); w.x = a.x; w.y = a.y; w.z = b.x; w.w = b.y;
            *(u32x4*)(dst + R * DM + (cgp & 15) * 64 + c8) = w; }
    }
}
__device__ __forceinline__ void p_ctx_moe(const Ctx& F, const Params& p, int which, int layer = 0) {
    unsigned char* ws = p.ws;
    typedef int v8i32 __attribute__((ext_vector_type(8))); typedef float f32x16 __attribute__((ext_vector_type(16)));
    const int l31 = F.lane & 31, hh = F.lane >> 5;
    if (which == 0) {
        LAS unsigned char* As = F.lds;
        for (int uidx = F.vcu; uidx < NE * 16; uidx += F.G) {
            const int e = uidx >> 4, cgp = (uidx & 15) * 8 + F.wave; const size_t er0 = (size_t)e * EROWS + 2048;
            { const u32x4* src = (const u32x4*)(ws + WS_XS + er0 * DM); u32x4 t[8];
#pragma unroll
              for (int i = 0; i < 8; ++i) t[i] = src[F.tid + 512 * i];
#pragma unroll
              for (int i = 0; i < 8; ++i) { const int g = F.tid + 512 * i, r = g >> 6, c = g & 63; *(LAS u32x4*)(As + r * 1024 + 16 * (c ^ (r & 15))) = t[i]; } }
            __syncthreads();
            const unsigned char* bp = ws + WS_W13 + ((size_t)layer * NE * 4096 + (size_t)e * 4096 + (size_t)cgp * 32 + l31) * DM + 32 * hh;
            f32x16 acc[2]; acc[0] = f32x16{}; acc[1] = f32x16{};
#pragma unroll 8
            for (int ks = 0; ks < 16; ++ks) {
                const u32x4 b0 = *(const u32x4*)(bp + 64 * ks), b1 = *(const u32x4*)(bp + 64 * ks + 16); const v8i32 bf = {(int)b0.x, (int)b0.y, (int)b0.z, (int)b0.w, (int)b1.x, (int)b1.y, (int)b1.z, (int)b1.w};
#pragma unroll
                for (int m = 0; m < 2; ++m) { const int r = 32 * m + l31, c0 = 4 * ks + 2 * hh;
                    const u32x4 a0 = *(const LAS u32x4*)(As + r * 1024 + 16 * (c0 ^ (r & 15))), a1 = *(const LAS u32x4*)(As + r * 1024 + 16 * ((c0 + 1) ^ (r & 15)));
                    const v8i32 af = {(int)a0.x, (int)a0.y, (int)a0.z, (int)a0.w, (int)a1.x, (int)a1.y, (int)a1.z, (int)a1.w};
                    acc[m] = __builtin_amdgcn_mfma_scale_f32_32x32x64_f8f6f4(bf, af, acc[m], 0, 0, 0, 0x7f7f7f7f, 0, 0x7f7f7f7f); } }
            unsigned char* HID = ws + WS_ACT + ACT_HID;
#pragma unroll
            for (int m = 0; m < 2; ++m)
#pragma unroll
                for (int q = 0; q < 2; ++q) {
                    float hv[4];
#pragma unroll
                    for (int i = 0; i < 4; ++i) hv[i] = silu_f(acc[m][4 * q + i] * W8_INV) * (acc[m][8 + 4 * q + i] * W8_INV);
                    *(unsigned*)(HID + (er0 + 32 * m + l31) * FF + cgp * 16 + 8 * q + 4 * hh) = f2fp8x4(hv[0], hv[1], hv[2], hv[3]); }
            __syncthreads();
        }
    } else {
        const int row = F.tid >> 3, c8 = (F.tid & 7) * 8; LAS float* part = (LAS float*)F.lds;
        for (int uidx = F.vcu; uidx < NE * 16; uidx += F.G) {
            const int e = uidx >> 4, cgp = uidx & 15; const size_t er0 = (size_t)e * EROWS + 2048;
            const unsigned char* ap = ws + WS_ACT + ACT_HID + (er0 + l31) * FF + F.wave * 256 + 32 * hh;
            const unsigned char* bp = ws + WS_W2 + ((size_t)layer * NE * DM + (size_t)e * DM + (size_t)cgp * 64 + l31) * FF + F.wave * 256 + 32 * hh;
            f32x16 acc[2][2]; acc[0][0] = f32x16{}; acc[0][1] = f32x16{}; acc[1][0] = f32x16{}; acc[1][1] = f32x16{};
#pragma unroll
            for (int k = 0; k < 256; k += 64) {
                v8i32 af[2], bf[2];
#pragma unroll
                for (int m = 0; m < 2; ++m) { const u32x4 a0 = *(const u32x4*)(ap + (size_t)m * 32 * FF + k), a1 = *(const u32x4*)(ap + (size_t)m * 32 * FF + k + 16);
                    af[m] = (v8i32){(int)a0.x, (int)a0.y, (int)a0.z, (int)a0.w, (int)a1.x, (int)a1.y, (int)a1.z, (int)a1.w}; }
#pragma unroll
                for (int n = 0; n < 2; ++n) { const u32x4 b0 = *(const u32x4*)(bp + (size_t)n * 32 * FF + k), b1 = *(const u32x4*)(bp + (size_t)n * 32 * FF + k + 16);
                    bf[n] = (v8i32){(int)b0.x, (int)b0.y, (int)b0.z, (int)b0.w, (int)b1.x, (int)b1.y, (int)b1.z, (int)b1.w}; }
#pragma unroll
                for (int m = 0; m < 2; ++m)
#pragma unroll
                    for (int n = 0; n < 2; ++n) acc[m][n] = __builtin_amdgcn_mfma_scale_f32_32x32x64_f8f6f4(bf[n], af[m], acc[m][n], 0, 0, 0, 0x7f7f7f7f, 0, 0x7f7f7f7f); }
#pragma unroll
            for (int m = 0; m < 2; ++m)
#pragma unroll
                for (int n = 0; n < 2; ++n)
#pragma unroll
                    for (int q = 0; q < 4; ++q) *(LAS f32x4*)(part + ((F.wave * 64 + 32 * m + l31) * 64 + 32 * n + 8 * q + 4 * hh)) = (f32x4){acc[m][n][4 * q], acc[m][n][4 * q + 1], acc[m][n][4 * q + 2], acc[m][n][4 * q + 3]};
            __syncthreads();
            f32x4 v0 = (f32x4){0.f, 0.f, 0.f, 0.f}, v1 = v0;
#pragma unroll
            for (int w = 0; w < NWAVES; ++w) { v0 += *(const LAS f32x4*)(part + w * 4096 + F.tid * 8); v1 += *(const LAS f32x4*)(part + w * 4096 + F.tid * 8 + 4); }
            __syncthreads();
            const float gt = ((const float*)(ws + WS_GATE))[er0 + row] * W8_INV;
            u32x4 w; const u32x2 a = pk4(v0 * gt), b = pk4(v1 * gt); w.x = a.x; w.y = a.y; w.z = b.x; w.w = b.y;
            *(u32x4*)((bf16_t*)(ws + WS_XS) + (er0 + row) * DM + cgp * 64 + c8) = w;
        }
    }
}

__device__ __forceinline__ void p_attn(const Ctx& F, const Params& p, unsigned char* lds_generic) {
    using abf = attn_body::bf16;
    const abf* Q = (const abf*)(p.ws + WS_ACT + ACT_Q); const abf* Kb = (const abf*)(p.ws + WS_ACT + ACT_K); const abf* Vb = (const abf*)(p.ws + WS_ACT + ACT_V);
    const bf16_t* O1 = (const bf16_t*)(p.ws + WS_ACT + ACT_O1); const bf16_t* O2 = (const bf16_t*)(p.ws + WS_ACT + ACT_O2); bf16_t* A = (bf16_t*)(p.ws + WS_XS);
    const int wid = F.wave;
    for (int i = 0; i < 4; ++i) { const int bh = (i >> 1) * 8 + (F.vcu >> 5), qb = F.vcu & 31, sub = (i & 1) * 2 + 1;
        const int b = bh >> 3, h = bh & 7, m = i & 1;
        abf* O = (abf*)(p.ws + WS_ACT + (m ? ACT_O2 : ACT_O1));
        const abf* Qw = Q + ((size_t)b * LR + CTXL + qb * 256 + wid * 32) * DM + (h * 2 + m) * 64;
        const abf* Kh = Kb + (size_t)b * LR * DM + (h * 2 + m) * 64;
        const abf* Vh = Vb + (size_t)b * LR * DM + h * 128;
        abf* Ow = O + ((size_t)b * SEQ + qb * 256 + wid * 32) * DM + h * 128;
        attn_body::attn_unit128<8>(Qw, Kh, Vh, Ow, (char*)lds_generic);
        if (sub == 3) {
            asm volatile("s_waitcnt vmcnt(0)" ::: "memory");
            int lane2 = threadIdx.x & 63; asm volatile("" : "+v"(lane2));
            const float lam_init = 0.8f - 0.6f * expf(-0.3f);
            float s1 = p.in[I_LQ1][lane2] * p.in[I_LK1][lane2], s2 = p.in[I_LQ2][lane2] * p.in[I_LK2][lane2];
            s1 = wave_sum(s1); s2 = wave_sum(s2);
            const float lam = expf(s1) - expf(s2) + lam_init, osc = 1.0f - lam_init;
            const size_t row0 = (size_t)b * SEQ + qb * 256 + wid * 32; const int lr = lane2 >> 3, c16 = 16 * (lane2 & 7);
            f32x4 gsub[4];
#pragma unroll
            for (int q = 0; q < 4; ++q) gsub[q] = *(const f32x4*)(p.in[I_SUBLN] + c16 + 4 * q);
            u32x4 xx[4][4];
#pragma unroll
            for (int k = 0; k < 4; ++k) { const size_t r = row0 + 8 * k + lr; const u32x4* a1 = (const u32x4*)(O1 + r * DM + h * 128 + c16); const u32x4* a2 = (const u32x4*)(O2 + r * DM + h * 128 + c16);
                xx[k][0] = a1[0]; xx[k][1] = a1[1]; xx[k][2] = a2[0]; xx[k][3] = a2[1]; }
#pragma unroll
            for (int k = 0; k < 4; ++k) { const size_t r = row0 + 8 * k + lr;
                const u32x4 x0 = xx[k][0], x1 = xx[k][1], y0 = xx[k][2], y1 = xx[k][3];
                float o[16];
                o[0] = bflo(x0.x) - lam * bflo(y0.x); o[1] = bfhi(x0.x) - lam * bfhi(y0.x); o[2] = bflo(x0.y) - lam * bflo(y0.y); o[3] = bfhi(x0.y) - lam * bfhi(y0.y);
                o[4] = bflo(x0.z) - lam * bflo(y0.z); o[5] = bfhi(x0.z) - lam * bfhi(y0.z); o[6] = bflo(x0.w) - lam * bflo(y0.w); o[7] = bfhi(x0.w) - lam * bfhi(y0.w);
                o[8] = bflo(x1.x) - lam * bflo(y1.x); o[9] = bfhi(x1.x) - lam * bfhi(y1.x); o[10] = bflo(x1.y) - lam * bflo(y1.y); o[11] = bfhi(x1.y) - lam * bfhi(y1.y);
                o[12] = bflo(x1.z) - lam * bflo(y1.z); o[13] = bfhi(x1.z) - lam * bfhi(y1.z); o[14] = bflo(x1.w) - lam * bflo(y1.w); o[15] = bfhi(x1.w) - lam * bfhi(y1.w);
                float ss = 0.f;
#pragma unroll
                for (int q = 0; q < 16; ++q) ss += o[q] * o[q];
                ss += __shfl_xor(ss, 1); ss += __shfl_xor(ss, 2); ss += __shfl_xor(ss, 4);
                const float rstd = osc / sqrtf(ss * (1.0f / 128.0f) + EPS);
                u32x4 w0, w1;
                w0.x = pk2(o[0] * rstd * gsub[0][0], o[1] * rstd * gsub[0][1]); w0.y = pk2(o[2] * rstd * gsub[0][2], o[3] * rstd * gsub[0][3]);
                w0.z = pk2(o[4] * rstd * gsub[1][0], o[5] * rstd * gsub[1][1]); w0.w = pk2(o[6] * rstd * gsub[1][2], o[7] * rstd * gsub[1][3]);
                w1.x = pk2(o[8] * rstd * gsub[2][0], o[9] * rstd * gsub[2][1]); w1.y = pk2(o[10] * rstd * gsub[2][2], o[11] * rstd * gsub[2][3]);
                w1.z = pk2(o[12] * rstd * gsub[3][0], o[13] * rstd * gsub[3][1]); w1.w = pk2(o[14] * rstd * gsub[3][2], o[15] * rstd * gsub[3][3]);
                u32x4* d = (u32x4*)(A + r * DM + h * 128 + c16); d[0] = w0; d[1] = w1; }
        }
    }
}

#define XB_TMO      128
#define XB_XCNT(j)  (256  + 64 * (j))
#define XB_XSUB(j)  (1280 + 64 * (j))
#define XB_XGEN(j)  (2304 + 64 * (j))
#define XB_TOP      3328
#define XB_TOPGEN   3392
#define XCD_BAR_WORDS 3456
#define XB_SPIN_CAP (1u << 18)
__device__ __forceinline__ unsigned xb_ld(unsigned* p)              { return __hip_atomic_load(p, __ATOMIC_RELAXED, __HIP_MEMORY_SCOPE_AGENT); }
__device__ __forceinline__ unsigned xb_add(unsigned* p, unsigned v) { return __hip_atomic_fetch_add(p, v, __ATOMIC_RELAXED, __HIP_MEMORY_SCOPE_AGENT); }
__device__ __forceinline__ unsigned xb_xcc_id() { return (unsigned)__builtin_amdgcn_s_getreg((3 << 11) | 20) & 0xFu; }
#define XB_SPIN(cond, bar) do { unsigned _sp = 0; while (cond) { __builtin_amdgcn_s_sleep(1); \
    if ((++_sp & 255u) == 0u) { if (xb_ld(&(bar)[XB_TMO])) break; if (_sp > XB_SPIN_CAP) { atomicAdd(&(bar)[XB_TMO], 1u); break; } } } } while (0)
struct XcdBarrier { unsigned* bar; unsigned x; volatile LAS unsigned* st; };
__device__ __forceinline__ void xcd_barrier_complete(unsigned* bar, unsigned x, unsigned& nloc, unsigned& nx) {
    const unsigned G = gridDim.x * gridDim.y * gridDim.z;
    unsigned sum, cnt, mine, sp = 0u;
    for (;;) {
        sum = 0u; cnt = 0u; mine = 0u;
#pragma unroll
        for (unsigned j = 0; j < 16; ++j) { const unsigned c = xb_ld(&bar[XB_XCNT(j)]); sum += c; cnt += (c > 0u) ? 1u : 0u; mine = (j == x) ? c : mine; }
        if (sum == G) break;
        __builtin_amdgcn_s_sleep(1);
        if ((++sp & 255u) == 0u) { if (xb_ld(&bar[XB_TMO])) break; if (sp > XB_SPIN_CAP) { atomicAdd(&bar[XB_TMO], 1u); break; } }
    }
    nloc = mine > 0u ? mine : 1u; nx = cnt > 0u ? cnt : 1u;
}
__device__ __forceinline__ void xcd_barrier(const XcdBarrier& b) {
    asm volatile("s_waitcnt vmcnt(0)" ::: "memory");
    __syncthreads();
    if (threadIdx.x == 0) {
        unsigned* bar = b.bar;
        __builtin_amdgcn_s_waitcnt(0);
        unsigned nloc = b.st[0], nx = b.st[1];
        if (nloc == 0u) { xcd_barrier_complete(bar, b.x, nloc, nx); b.st[0] = nloc; b.st[1] = nx; }
        const unsigned old = xb_add(&bar[XB_XSUB(b.x)], 1u);
        const unsigned gen = old / nloc;
        if (old + 1u == (gen + 1u) * nloc) {
            __builtin_amdgcn_fence(__ATOMIC_RELEASE, "agent");
            asm volatile("s_waitcnt vmcnt(0)" ::: "memory");
            const unsigned og = xb_add(&bar[XB_TOP], 1u);
            const unsigned tg = og / nx;
            if (og + 1u == (tg + 1u) * nx) xb_add(&bar[XB_TOPGEN], 1u);
            else XB_SPIN(xb_ld(&bar[XB_TOPGEN]) == tg, bar);
            __builtin_amdgcn_fence(__ATOMIC_ACQUIRE, "agent");
            xb_add(&bar[XB_XGEN(b.x)], 1u);
            asm volatile("s_waitcnt vmcnt(0)" ::: "memory");
        } else {
            XB_SPIN(xb_ld(&bar[XB_XGEN(b.x)]) == gen, bar);
            __builtin_amdgcn_fence(__ATOMIC_ACQUIRE, "agent");
            asm volatile("s_waitcnt vmcnt(0)" ::: "memory");
        }
    }
    __syncthreads();
}


#ifdef FP8_PROBE
typedef int v8i_t __attribute__((ext_vector_type(8)));
typedef float f32x16_t __attribute__((ext_vector_type(16)));
__device__ __forceinline__ int pr_aval(int i, int k) { return ((i * 7 + k * 3) % 5) - 2; }
__device__ __forceinline__ int pr_bval(int k, int j) { return ((k * 5 + j * 11) % 7) - 3; }
__device__ __forceinline__ unsigned pr_enc(int v) { const int a = v < 0 ? -v : v; const unsigned m = a == 0 ? 0x00u : (a == 1 ? 0x38u : (a == 2 ? 0x40u : 0x44u)); return m | (v < 0 ? 0x80u : 0u); }
template <int HYP> __device__ __forceinline__ int pr_kmap(int h, int j) { return HYP == 1 ? 32 * h + j : (HYP == 2 ? 16 * h + (j & 15) + 32 * (j >> 4) : 8 * h + (j & 7) + 16 * (j >> 3)); }
template <int HYP> __device__ __forceinline__ bool pr_test(int lane) {
    const int rc = lane & 31, h = lane >> 5; v8i_t a, b;
#pragma unroll
    for (int d = 0; d < 8; ++d) { unsigned wa = 0u, wb = 0u;
#pragma unroll
        for (int q = 0; q < 4; ++q) { const int k = pr_kmap<HYP>(h, 4 * d + q); wa |= pr_enc(pr_aval(rc, k)) << (8 * q); wb |= pr_enc(pr_bval(k, rc)) << (8 * q); }
        a[d] = (int)wa; b[d] = (int)wb; }
    f32x16_t c = {};
    c = __builtin_amdgcn_mfma_scale_f32_32x32x64_f8f6f4(a, b, c, 0, 0, 0, 0x7f7f7f7f, 0, 0x7f7f7f7f);
    bool ok = true;
#pragma unroll
    for (int r = 0; r < 16; ++r) { const int i = (r & 3) + 8 * (r >> 2) + 4 * h; int e = 0;
        for (int k = 0; k < 64; ++k) e += pr_aval(i, k) * pr_bval(k, rc);
        ok = ok && (c[r] == (float)e); }
    return __all(ok) != 0;
}
#endif
__global__ void __launch_bounds__(NWAVES * 64, 2) mk_fwd(Params p_unused) {
    extern __shared__ __attribute__((aligned(16))) unsigned char lds[];
#define MAKE_CTX Ctx F; { int t_ = threadIdx.x; asm volatile("" : "+v"(t_)); F.lds = (LAS unsigned char*)lds; F.tid = t_; F.lane = t_ & 63; F.wave = __builtin_amdgcn_readfirstlane(t_ >> 6); \
    F.G = gridDim.x; const int bx = blockIdx.x; F.vcu = (F.G % 8 == 0) ? (bx % 8) * (F.G / 8) + bx / 8 : bx; }
    int lo, hi; unsigned* barw; { const Params q0 = kparams(); lo = q0.ph_lo; hi = q0.ph_hi; barw = (unsigned*)(q0.ws + WS_CTL) + 4096; }
    volatile LAS unsigned* bst = (volatile LAS unsigned*)((LAS unsigned char*)lds + RING_BYTES + 12288 + 1024);
    if (threadIdx.x < 2) bst[threadIdx.x] = 0u;
    __syncthreads();
    if (threadIdx.x == 0) (void)xb_add(&barw[XB_XCNT(xb_xcc_id())], 1u);
#ifndef PH_MASK
#define PH_MASK 0xFFFFFu
#endif
#define IN(k) (((PH_MASK >> (k)) & 1u) && lo <= (k) && (k) < hi)
#define SEAM(k) do { if (IN(k) && IN((k) + 1)) { XcdBarrier xb_; xb_.bar = barw; xb_.x = xb_xcc_id(); xb_.st = bst; xcd_barrier(xb_); } } while (0)
#ifndef TS_MASK
#define TS_MASK 0u
#endif
#ifndef TS_SCALE
#define TS_SCALE 10.0f
#endif
    unsigned long long ts_prev = 0ull, ts_acc = 0ull;
    if (TS_MASK) ts_prev = __builtin_amdgcn_s_memrealtime();
#define TS_MARK(k) do { if (TS_MASK) { const unsigned long long t_ = __builtin_amdgcn_s_memrealtime(); if ((TS_MASK >> (k)) & 1u) ts_acc += t_ - ts_prev; ts_prev = t_; } } while (0)
#define PHASE_VARS MAKE_CTX const Params p = kparams(); unsigned char* ws = p.ws; const float* mod = (const float*)(ws + WS_MOD); bf16_t* Hb = (bf16_t*)(ws + WS_H); (void)mod; (void)Hb;

    if (IN(0)) { PHASE_VARS p0_prologue(F, p); } SEAM(0); TS_MARK(0);
    if (IN(1)) { PHASE_VARS p_norm1_in(F, p); } SEAM(1); TS_MARK(1);
    if (IN(2)) { PHASE_VARS
        pg8::Gemm g{Hb + (size_t)CTXL * DM, (const bf16_t*)(ws + WS_WIN), DM, (size_t)LR * DM * 2, 0}; pg8::GOrder S; S.init(32, 8, NB, F.G, (int)blockIdx.x);
        pg8::EpiWin E{(bf16_t*)(ws + WS_ACT + ACT_Z)}; pg8::gemm_phase(F.lds, g, S, E); p_ctx_dense(F, p, 0); } SEAM(2); TS_MARK(2);
    if (IN(3)) { PHASE_VARS p_lru(F, p, false); } SEAM(3); TS_MARK(3);
    if (IN(4)) { PHASE_VARS p_lru_carry(F, p); p_cm(F, p); }
    if (IN(4)) { XcdBarrier xb_; xb_.bar = barw; xb_.x = xb_xcc_id(); xb_.st = bst; xcd_barrier(xb_); }
    if (IN(4)) { PHASE_VARS p_lru(F, p, true); } SEAM(4); TS_MARK(4);
    if (IN(5)) { PHASE_VARS
        pg8::Gemm g{(const bf16_t*)(ws + WS_ACT + ACT_YCAT) + (size_t)CTXL * DM, (const bf16_t*)(ws + WS_WOUT0), DM, (size_t)LR * DM * 2, 0}; pg8::GOrder S; S.init(32, 4, NB, F.G, (int)blockIdx.x);
        pg8::EpiRes E{(bf16_t*)(ws + WS_X), p.in[I_X], mod + 2 * DM, 0}; pg8::gemm_phase(F.lds, g, S, E); p_ctx_dense(F, p, 1); } SEAM(5); TS_MARK(5);
    if (IN(6)) { PHASE_VARS p_norm2_router(F, p, 0, true); } SEAM(6); TS_MARK(6);
    if (IN(7)) { PHASE_VARS p_select(F, p, true); } SEAM(7); TS_MARK(7);
    if (IN(8)) { PHASE_VARS
        pg8::Gemm8 g{ws + WS_XS, ws + WS_W13, DM, (size_t)EROWS * DM, (size_t)4096 * DM}; pg8::GOrder S; S.init(8, 16, NE, F.G, (int)blockIdx.x);
        pg8::EpiSwiGLU8 E{ws + WS_ACT + ACT_HID}; pg8::gemm8_phase<true>(F.lds, g, S, E); p_ctx_moe(F, p, 0); } SEAM(8); TS_MARK(8);
    if (IN(9)) { PHASE_VARS
        pg8::Gemm8 g{ws + WS_ACT + ACT_HID, ws + WS_W2, FF, (size_t)EROWS * FF, (size_t)DM * FF}; pg8::GOrder S; S.init(8, 4, NE, F.G, (int)blockIdx.x);
        pg8::EpiMoeOut8 E{(bf16_t*)(ws + WS_XS), (const float*)(ws + WS_GATE)}; pg8::gemm8_phase<false>(F.lds, g, S, E); p_ctx_moe(F, p, 1); } SEAM(9); TS_MARK(9);
    if (IN(10)) { PHASE_VARS p_combine(F, p, 0, false); } SEAM(10); TS_MARK(10);
    if (IN(11)) { PHASE_VARS
        pg8::Gemm g{Hb + (size_t)CTXL * DM, (const bf16_t*)(ws + WS_WQKV), DM, (size_t)LR * DM * 2, 0}; pg8::GOrder S; S.init(32, 12, NB, F.G, (int)blockIdx.x);
        pg8::EpiQKV E{(bf16_t*)(ws + WS_ACT + ACT_Q), (const float*)(ws + WS_ROPE)}; pg8::gemm_phase(F.lds, g, S, E); p_ctx_dense(F, p, 2); } SEAM(11); TS_MARK(11);
    if (IN(12)) { PHASE_VARS p_attn(F, p, lds); } SEAM(12); TS_MARK(12);
    TS_MARK(13);
    if (IN(14)) { PHASE_VARS
        pg8::Gemm g{(const bf16_t*)(ws + WS_XS), (const bf16_t*)(ws + WS_WOUT1), DM, (size_t)SEQ * DM * 2, 0}; pg8::GOrder S; S.init(32, 4, NB, F.G, (int)blockIdx.x);
        pg8::EpiRes E{(bf16_t*)(ws + WS_X), nullptr, mod + 3 * 6144 + 2 * DM, 1}; pg8::gemm_phase(F.lds, g, S, E); } SEAM(14); TS_MARK(14);
    if (IN(15)) { PHASE_VARS p_norm2_router(F, p, 1, false); } SEAM(15); TS_MARK(15);
    if (IN(16)) { PHASE_VARS p_select(F, p, false); } SEAM(16); TS_MARK(16);
    if (IN(17)) { PHASE_VARS
        pg8::Gemm8 g{ws + WS_XS, ws + WS_W13 + (size_t)NE * 4096 * DM, DM, (size_t)EROWS * DM, (size_t)4096 * DM}; pg8::GOrder S; S.init(8, 16, NE, F.G, (int)blockIdx.x);
        pg8::EpiSwiGLU8 E{ws + WS_ACT + ACT_HID}; pg8::gemm8_phase<true>(F.lds, g, S, E); } SEAM(17); TS_MARK(17);
    if (IN(18)) { PHASE_VARS
        pg8::Gemm8 g{ws + WS_ACT + ACT_HID, ws + WS_W2 + (size_t)NE * DM * FF, FF, (size_t)EROWS * FF, (size_t)DM * FF}; pg8::GOrder S; S.init(8, 4, NE, F.G, (int)blockIdx.x);
        pg8::EpiMoeOut8 E{(bf16_t*)(ws + WS_XS), (const float*)(ws + WS_GATE)}; pg8::gemm8_phase<false>(F.lds, g, S, E); } SEAM(18); TS_MARK(18);
    if (IN(19)) { PHASE_VARS p_combine(F, p, 1, true); }
#ifdef FP8_PROBE
    { XcdBarrier xb_; xb_.bar = barw; xb_.x = xb_xcc_id(); xb_.st = bst; xcd_barrier(xb_);
      if (blockIdx.x == 0 && threadIdx.x < 64) { const int l_ = threadIdx.x; int code = 0; if (pr_test<1>(l_)) code = 1; else if (pr_test<2>(l_)) code = 2; else if (pr_test<3>(l_)) code = 3;
          if (l_ == 0) { const Params p = kparams(); p.out[0] += 20.0f * (float)code; } } }
#endif
    if (TS_MASK) { TS_MARK(19); XcdBarrier xb_; xb_.bar = barw; xb_.x = xb_xcc_id(); xb_.st = bst; xcd_barrier(xb_);
        if (blockIdx.x == 0 && threadIdx.x == 0) { const Params p = kparams(); p.out[0] += (float)ts_acc * 0.01f / TS_SCALE; } }
#undef IN
#undef SEAM
}

extern "C" void kernel_launch(void* const* d_in, const int* in_sizes, int n_in, void* d_out, int out_size, void* d_ws, size_t ws_size, hipStream_t stream) {
    static int grid = 0;
    if (grid == 0) {
        if (n_in != 32 || out_size != NLAT * DM || ws_size < WS_END) { fprintf(stderr, "kernel_launch: unexpected problem (n_in %d, out %d, ws %zu)\n", n_in, out_size, ws_size); grid = -1; return; }
        int dev = 0, cus = 0, per_cu = 0;
        if (hipGetDevice(&dev) != hipSuccess || hipDeviceGetAttribute(&cus, hipDeviceAttributeMultiprocessorCount, dev) != hipSuccess) { grid = -1; return; }
        if (hipFuncSetAttribute((const void*)mk_fwd, hipFuncAttributeMaxDynamicSharedMemorySize, LDS_BYTES) != hipSuccess) { fprintf(stderr, "kernel_launch: hipFuncSetAttribute failed\n"); grid = -1; return; }
        if (hipOccupancyMaxActiveBlocksPerMultiprocessor(&per_cu, (const void*)mk_fwd, NWAVES * 64, LDS_BYTES) != hipSuccess || per_cu < 1) { fprintf(stderr, "kernel_launch: occupancy query says %d\n", per_cu); per_cu = 1; }
        (void)hipGetLastError();
        grid = cus & ~7;
    }
    if (grid < 0) return;
    if (hipMemsetAsync((char*)d_ws + WS_CTL, 0, 65536, stream) != hipSuccess) { fprintf(stderr, "kernel_launch: memset failed\n"); return; }
    Params a{};
    for (int i = 0; i < 32; ++i) a.in[i] = (const float*)d_in[i];
    a.out = (float*)d_out; a.ws = (unsigned char*)d_ws;
#if MK_N_LAUNCHES == 1
    a.ph_lo = 0; a.ph_hi = NPH;
    void* args[] = {&a};
    hipError_t e = hipLaunchCooperativeKernel((const void*)mk_fwd, dim3(grid), dim3(NWAVES * 64), args, LDS_BYTES, stream);
    if (e != hipSuccess) fprintf(stderr, "kernel_launch: cooperative launch failed: %s (grid %d)\n", hipGetErrorString(e), grid);
#else
    for (int ph = 0; ph < NPH; ++ph) { a.ph_lo = ph; a.ph_hi = ph + 1; hipLaunchKernelGGL(mk_fwd, dim3(grid), dim3(NWAVES * 64), LDS_BYTES, stream, a); }
#endif
}
```

```cpp
#include <hip/hip_runtime.h>
#include <hip/hip_cooperative_groups.h>
#include <hip/hip_bf16.h>
#include <cstdio>
#include <cstdint>
#include <cmath>
namespace cg = cooperative_groups;

#ifndef MK_N_LAUNCHES
#define MK_N_LAUNCHES 1
#endif

constexpr int DM = 1024, NB = 2, SEQ = 8192, CTXL = 256, LR = SEQ + CTXL, NR = NB * LR, NLAT = NB * SEQ;
constexpr int NE = 16, FF = 2048, EROWS = 2304;
constexpr float EPS = 1e-6f;
constexpr int NTILE64 = NR / 64;
constexpr int NPH = 20;

constexpr size_t MiB = 1u << 20;
constexpr size_t WS_CTL = 0, WS_MOD = 1 * MiB, WS_ROPE = 2 * MiB, WS_LRUW = 4 * MiB, WS_CMWS = 4 * MiB + 512 * 1024, WS_SUM = 5 * MiB, WS_AFF = 8 * MiB, WS_INV = 10 * MiB,
                 WS_GATE = 12 * MiB, WS_MODP = 28 * MiB, WS_CAR = 30 * MiB, WS_WIN = 14 * MiB, WS_WOUT0 = 18 * MiB, WS_WQKV = 20 * MiB, WS_WOUT1 = 26 * MiB, WS_W13 = 32 * MiB, WS_W2 = 288 * MiB, WS_H = 416 * MiB,
                 WS_X = 450 * MiB, WS_XS = 516 * MiB, WS_ACT = 588 * MiB, WS_END = 758 * MiB;
static_assert(true, "");
constexpr size_t ACT_Z = 0, ACT_YCAT = 66 * MiB, ACT_HID = 0, ACT_Q = 0, ACT_K = 33 * MiB, ACT_V = 66 * MiB, ACT_O1 = 99 * MiB, ACT_O2 = 131 * MiB, ACT_A = 0;

#define GAS __attribute__((address_space(1)))
#define LAS __attribute__((address_space(3)))
typedef unsigned short bf16_t;
typedef short bf16x8 __attribute__((ext_vector_type(8)));
typedef float f32x4 __attribute__((ext_vector_type(4)));
typedef float f32x2 __attribute__((ext_vector_type(2)));
typedef unsigned u32x4 __attribute__((ext_vector_type(4)));
typedef unsigned u32x2 __attribute__((ext_vector_type(2)));

__device__ __forceinline__ unsigned f2bf(float f) { unsigned u = __builtin_bit_cast(unsigned, f); return (u + 0x7fffu + ((u >> 16) & 1u)) >> 16; }
typedef float f32x2_hw __attribute__((ext_vector_type(2))); typedef __bf16 bf16x2_hw __attribute__((ext_vector_type(2)));
__device__ __forceinline__ unsigned pk2(float lo, float hi) { f32x2_hw v = {lo, hi}; bf16x2_hw b = __builtin_convertvector(v, bf16x2_hw); return __builtin_bit_cast(unsigned, b); }
__device__ __forceinline__ u32x2 pk4(const f32x4 v) { u32x2 w; w.x = pk2(v[0], v[1]); w.y = pk2(v[2], v[3]); return w; }
__device__ __forceinline__ float bf2f(unsigned short b) { return __builtin_bit_cast(float, (unsigned)b << 16); }
__device__ __forceinline__ float bflo(unsigned w) { return __builtin_bit_cast(float, w << 16); }
__device__ __forceinline__ float bfhi(unsigned w) { return __builtin_bit_cast(float, w & 0xffff0000u); }
__device__ __forceinline__ unsigned f2fp8x4(float a, float b, float c, float d) {
    a = __builtin_amdgcn_fmed3f(a, -448.f, 448.f); b = __builtin_amdgcn_fmed3f(b, -448.f, 448.f); c = __builtin_amdgcn_fmed3f(c, -448.f, 448.f); d = __builtin_amdgcn_fmed3f(d, -448.f, 448.f);
    int w = __builtin_amdgcn_cvt_pk_fp8_f32(a, b, 0, false); w = __builtin_amdgcn_cvt_pk_fp8_f32(c, d, w, true); return (unsigned)w; }
constexpr float YB_SCALE = 16.0f, YB_INV = 1.0f / 16.0f;
constexpr float W8_SCALE = 32.0f, W8_INV = 1.0f / 32.0f;
__device__ __forceinline__ float gelu_tanh(float x) {
    const float u2 = 2.0f * 0.7978845608028654f * (x + 0.044715f * x * x * x);
    const float e = __builtin_amdgcn_exp2f(u2 * 1.4426950408889634f);
    return x - x * __builtin_amdgcn_rcpf(1.0f + e);
}
__device__ __forceinline__ float silu_f(float a) { return a * __builtin_amdgcn_rcpf(1.0f + __builtin_amdgcn_exp2f(-a * 1.4426950408889634f)); }
__device__ __forceinline__ float sigmoid_f(float a) { return 1.0f / (1.0f + __expf(-a)); }

namespace pg8 {
#define PG8_LAS __attribute__((address_space(3)))
constexpr int BM = 256, BK = 64, HALF = 128, HTB = HALF * BK * 2, STAGE_BYTES = 8 * HTB, NXCD = 8, WGM = 8;
__host__ __device__ __forceinline__ int lds_byte(int r, int c) { const int st = (r >> 4) * 2 + (c >> 5), rr = r & 15, cc = c & 31, ob = rr * 64 + cc * 2; return st * 1024 + (ob ^ (((ob >> 9) & 1) << 5)); }
__host__ __device__ __forceinline__ void stage_rc(int b, int& R, int& C) { const int st = b / 1024, sb = b % 1024, swz = sb ^ (((sb >> 9) & 1) << 5); R = (st >> 1) * 16 + swz / 64; C = (st & 1) * 32 + (swz % 64) / 2; }
__host__ __device__ __forceinline__ int perm32(int rho) { const int n = rho >> 4, i = rho & 15; return 8 * (i >> 2) + 4 * n + (i & 3); }

struct Unit { int pm, pn, grp; };
struct Gemm { const bf16_t* A; const bf16_t* Bt; int K; size_t ga, gb; };

struct GOrder {
    int nM, nN, upg, nwg, G, c;
    __device__ void init(int nM_, int nN_, int ngrp, int G_, int c_) { nM = nM_; nN = nN_; upg = nM * nN; nwg = upg * ngrp; G = G_; c = c_; }
    __device__ bool next(int i, Unit& u) const {
        const long L = (long)i * G + c; if (L >= nwg) return false;
        int wgid = (int)L; { const int q = nwg / NXCD, r = nwg % NXCD, xcd = wgid % NXCD, off = wgid / NXCD; wgid = (xcd < r ? xcd * (q + 1) : r * (q + 1) + (xcd - r) * q) + off; }
        u.grp = wgid / upg; const int w = wgid % upg;
        const int nig = WGM * nN, gid = w / nig, fm = gid * WGM, gsz = (nM - fm) < WGM ? (nM - fm) : WGM;
        u.pm = fm + ((w % nig) % gsz); u.pn = (w % nig) / gsz; return true;
    }
};

__device__ __forceinline__ unsigned cvt_pk_bf16(float lo, float hi) { unsigned r; asm volatile("v_cvt_pk_bf16_f32 %0, %1, %2" : "=v"(r) : "v"(lo), "v"(hi)); return r; }

template <class Epi, class Sched>
__device__ __forceinline__ void gemm_phase(PG8_LAS unsigned char* lds, const Gemm g, const Sched& S, const Epi& E) {
    const int tid = threadIdx.x, wid = __builtin_amdgcn_readfirstlane(tid >> 6), lane = tid & 63, wr = wid >> 2, wc = wid & 3, fr = lane & 15, fq = lane >> 4;
    const int K = g.K, nt = K / BK;
    unsigned voffA[2], voffB[2];
#pragma unroll
    for (int i = 0; i < 2; ++i) { int R, C; stage_rc(tid * 16 + i * 8192, R, C); const int Rb = (R & ~31) + perm32(R & 31);
        voffA[i] = (unsigned)(R * K + C) * 2u; voffB[i] = (unsigned)(Rb * K + C) * 2u; }
    const size_t kstep = (size_t)(BK * 2);
    const size_t hstep = (size_t)HALF * K * 2;
    const size_t tstep = 2 * hstep;
    const unsigned ldsw = (unsigned)wid * 1024u;
    const int aoff = lds_byte(wr * 64 + fr, fq * 8), boff = lds_byte(wc * 32 + fr, fq * 8);
#define PG8_SA(b, h) (((b) * 2 + (h)) * HTB)
#define PG8_SB(b, h) ((4 + (b) * 2 + (h)) * HTB)
#define PG8_STAGE(bufoff, gbase, voff) do { _Pragma("unroll") for (int _i = 0; _i < 2; ++_i) \
        __builtin_amdgcn_global_load_lds((const unsigned*)((const char*)(gbase) + (voff)[_i]), (PG8_LAS unsigned*)(lds + (bufoff) + ldsw + _i * 8192), 16, 0, 0); } while (0)
#define PG8_LDA(dst, b, h) do { _Pragma("unroll") for (int m = 0; m < 4; ++m) _Pragma("unroll") for (int k = 0; k < 2; ++k) dst[m][k] = *(const PG8_LAS bf16x8*)(lds + PG8_SA(b, h) + aoff + m * 2048 + k * 1024); } while (0)
#define PG8_LDB(dst, b, h) do { _Pragma("unroll") for (int n = 0; n < 2; ++n) _Pragma("unroll") for (int k = 0; k < 2; ++k) dst[n][k] = *(const PG8_LAS bf16x8*)(lds + PG8_SB(b, h) + boff + n * 2048 + k * 1024); } while (0)
#define PG8_MMA(ai, bj, At, Bt) do { __builtin_amdgcn_s_setprio(1); _Pragma("unroll") for (int m = 0; m < 4; ++m) _Pragma("unroll") for (int n = 0; n < 2; ++n) _Pragma("unroll") for (int k = 0; k < 2; ++k) \
        acc[ai][bj][m][n] = __builtin_amdgcn_mfma_f32_16x16x32_bf16(Bt[n][k], At[m][k], acc[ai][bj][m][n], 0, 0, 0); __builtin_amdgcn_s_setprio(0); } while (0)
#define PG8_WAIT_V(n) asm volatile("s_waitcnt vmcnt(" #n ")" ::: "memory")
#define PG8_WAIT_L(n) asm volatile("s_waitcnt lgkmcnt(" #n ")" ::: "memory")
#define PG8_BAR __builtin_amdgcn_s_barrier()
#define PG8_SCHED __builtin_amdgcn_sched_barrier(0)
    Unit cur, nxt; int ui = 0;
    if (!S.next(0, cur)) return;
    f32x4 acc[2][2][4][2];
#pragma unroll
    for (int a = 0; a < 2; ++a)
#pragma unroll
        for (int b = 0; b < 2; ++b)
#pragma unroll
            for (int m = 0; m < 4; ++m)
#pragma unroll
                for (int n = 0; n < 2; ++n) acc[a][b][m][n] = (f32x4){0.f, 0.f, 0.f, 0.f};
    bf16x8 At[4][2], B0[2][2], B1[2][2];
    const char* cA = (const char*)g.A + (size_t)cur.grp * g.ga + (size_t)cur.pm * tstep; const char* cB = (const char*)g.Bt + (size_t)cur.grp * g.gb + (size_t)cur.pn * tstep;
    PG8_STAGE(PG8_SB(0, 0), cB, voffB); PG8_STAGE(PG8_SB(0, 1), cB + hstep, voffB); PG8_STAGE(PG8_SA(0, 0), cA, voffA); PG8_STAGE(PG8_SA(0, 1), cA + hstep, voffA);
    if (wr == 1) PG8_BAR;
    PG8_WAIT_V(2); PG8_BAR;
    PG8_STAGE(PG8_SB(1, 0), cB + kstep, voffB); PG8_STAGE(PG8_SA(1, 0), cA + kstep, voffA); PG8_STAGE(PG8_SB(1, 1), cB + hstep + kstep, voffB);
    PG8_WAIT_V(6); PG8_BAR;
    for (;;) {
        const bool has_next = S.next(ui + 1, nxt);
        const char* nA = has_next ? (const char*)g.A + (size_t)nxt.grp * g.ga + (size_t)nxt.pm * tstep : cA; const char* nB = has_next ? (const char*)g.Bt + (size_t)nxt.grp * g.gb + (size_t)nxt.pn * tstep : cB;
        for (int t = 0; t < nt; t += 2) {
            const bool last = (t == nt - 2);
            const char* a1 = cA + (size_t)(t + 1) * kstep;
            const char* a2 = last ? nA : cA + (size_t)(t + 2) * kstep; const char* b2 = last ? nB : cB + (size_t)(t + 2) * kstep;
            const char* a3 = a2 + kstep; const char* b3 = b2 + kstep;
            PG8_LDB(B0, 0, 0); PG8_LDB(B1, 0, 1); PG8_SCHED; PG8_LDA(At, 0, 0); PG8_STAGE(PG8_SA(1, 1), a1 + hstep, voffA);
            PG8_WAIT_V(8); PG8_WAIT_L(0); PG8_BAR; PG8_MMA(0, 0, At, B0); PG8_MMA(0, 1, At, B1); PG8_BAR; PG8_SCHED;
            PG8_LDA(At, 0, 1); PG8_STAGE(PG8_SB(0, 0), b2, voffB); PG8_STAGE(PG8_SB(0, 1), b2 + hstep, voffB); PG8_STAGE(PG8_SA(0, 0), a2, voffA);
            PG8_WAIT_V(8); PG8_WAIT_L(0); PG8_BAR; PG8_MMA(1, 0, At, B0); PG8_MMA(1, 1, At, B1); PG8_BAR; PG8_SCHED;
            PG8_LDB(B0, 1, 0); PG8_LDB(B1, 1, 1); PG8_SCHED; PG8_LDA(At, 1, 0); PG8_STAGE(PG8_SA(0, 1), a2 + hstep, voffA);
            PG8_WAIT_V(8); PG8_WAIT_L(0); PG8_BAR; PG8_MMA(0, 0, At, B0); PG8_MMA(0, 1, At, B1); PG8_BAR; PG8_SCHED;
            PG8_LDA(At, 1, 1); PG8_STAGE(PG8_SB(1, 0), b3, voffB); PG8_STAGE(PG8_SB(1, 1), b3 + hstep, voffB); PG8_STAGE(PG8_SA(1, 0), a3, voffA);
            PG8_WAIT_V(8); PG8_WAIT_L(0); PG8_BAR; PG8_MMA(1, 0, At, B0); PG8_MMA(1, 1, At, B1); PG8_BAR; PG8_SCHED;
        }
        if (wr == 0) PG8_BAR;
        E(acc, cur, wr, wc, fr, fq);
        if (!has_next) break;
#pragma unroll
        for (int a = 0; a < 2; ++a)
#pragma unroll
            for (int b = 0; b < 2; ++b)
#pragma unroll
                for (int m = 0; m < 4; ++m)
#pragma unroll
                    for (int n = 0; n < 2; ++n) acc[a][b][m][n] = (f32x4){0.f, 0.f, 0.f, 0.f};
        cur = nxt; cA = nA; cB = nB; ++ui;
        if (wr == 1) PG8_BAR;
    }
    PG8_WAIT_V(0);
    PG8_BAR;
#undef PG8_SA
#undef PG8_SB
#undef PG8_STAGE
#undef PG8_LDA
#undef PG8_LDB
#undef PG8_MMA
#undef PG8_WAIT_V
#undef PG8_WAIT_L
#undef PG8_BAR
#undef PG8_SCHED
}

typedef int v8i32 __attribute__((ext_vector_type(8)));
typedef float f32x16 __attribute__((ext_vector_type(16)));
__host__ __device__ __forceinline__ int permS(int rho) { const int e = rho & 3, hh = (rho >> 2) & 1, q = rho >> 3; return q < 2 ? 8 * hh + 4 * q + e : 16 + 8 * hh + 4 * (q - 2) + e; }
__host__ __device__ __forceinline__ int permN(int rho) { const int e = rho & 3, hh = (rho >> 2) & 1, q = rho >> 3; return 16 * hh + 4 * q + e; }
struct Gemm8 { const unsigned char* A; const unsigned char* Bt; int K; size_t ga, gb; };
template <bool SWP, class Epi, class Sched>
__device__ __forceinline__ void gemm8_phase(PG8_LAS unsigned char* lds, const Gemm8 g, const Sched& S, const Epi& E) {
    const int tid = threadIdx.x, wid = __builtin_amdgcn_readfirstlane(tid >> 6), lane = tid & 63, wr = wid >> 2, wc = wid & 3;
    const int K = g.K, nt = K / 128;
    unsigned voffA[2], voffB[2];
#pragma unroll
    for (int i = 0; i < 2; ++i) {
        const int bb = tid * 16 + i * 8192, st = bb / 1024, sb = bb % 1024, swz = sb ^ (((sb >> 9) & 1) << 5) ^ (((sb >> 8) & 1) << 4);
        const int R = (st >> 1) * 16 + swz / 64, Cb = (st & 1) * 64 + swz % 64; const int Rb = (R & ~31) + (SWP ? permS(R & 31) : permN(R & 31));
        voffA[i] = (unsigned)(R * K + Cb); voffB[i] = (unsigned)(Rb * K + Cb); }
    const size_t kstep = 128, hstep = (size_t)HALF * K, tstep = 2 * hstep;
    const unsigned ldsw = (unsigned)wid * 1024u;
    const int l31 = lane & 31, hh = lane >> 5;
    const int ra = wr * 64 + l31, rb = wc * 32 + l31;
    const int aoff = ((ra >> 4) * 2) * 1024 + (ra & 15) * 64 + 32 * (hh ^ ((ra & 15) >> 3)), boff = ((rb >> 4) * 2) * 1024 + (rb & 15) * 64 + 32 * (hh ^ ((rb & 15) >> 3));
    const int aswp = 16 * ((ra >> 2) & 1), bswp = 16 * ((rb >> 2) & 1);
#define PG8_SA(b, h) (((b) * 2 + (h)) * HTB)
#define PG8_SB(b, h) ((4 + (b) * 2 + (h)) * HTB)
#define PG8_STAGE(bufoff, gbase, voff) do { _Pragma("unroll") for (int _i = 0; _i < 2; ++_i) \
        __builtin_amdgcn_global_load_lds((const unsigned*)((const char*)(gbase) + (voff)[_i]), (PG8_LAS unsigned*)(lds + (bufoff) + ldsw + _i * 8192), 16, 0, 0); } while (0)
#define PG8_LD32(dst, off, swp) do { const u32x4 lo_ = *(const PG8_LAS u32x4*)(lds + (off) + (swp)); const u32x4 hi_ = *(const PG8_LAS u32x4*)(lds + (off) + (16 - (swp))); \
        dst = (v8i32){(int)lo_.x, (int)lo_.y, (int)lo_.z, (int)lo_.w, (int)hi_.x, (int)hi_.y, (int)hi_.z, (int)hi_.w}; } while (0)
#define PG8_LDA(dst, b, h) do { _Pragma("unroll") for (int m = 0; m < 2; ++m) _Pragma("unroll") for (int k = 0; k < 2; ++k) PG8_LD32(dst[m][k], PG8_SA(b, h) + aoff + m * 4096 + k * 1024, aswp); } while (0)
#define PG8_LDB(dst, b, h) do { _Pragma("unroll") for (int k = 0; k < 2; ++k) PG8_LD32(dst[k], PG8_SB(b, h) + boff + k * 1024, bswp); } while (0)
#define PG8_MMA(ai, bj, At, Bt) do { __builtin_amdgcn_s_setprio(1); _Pragma("unroll") for (int m = 0; m < 2; ++m) _Pragma("unroll") for (int k = 0; k < 2; ++k) \
        acc[ai][bj][m] = __builtin_amdgcn_mfma_scale_f32_32x32x64_f8f6f4(Bt[k], At[m][k], acc[ai][bj][m], 0, 0, 0, 0x7f7f7f7f, 0, 0x7f7f7f7f); \
        asm volatile("" : "+v"(acc[ai][bj][0]), "+v"(acc[ai][bj][1])); __builtin_amdgcn_s_setprio(0); } while (0)
#define PG8_WAIT_V(n) asm volatile("s_waitcnt vmcnt(" #n ")" ::: "memory")
#define PG8_WAIT_L(n) asm volatile("s_waitcnt lgkmcnt(" #n ")" ::: "memory")
#define PG8_BAR __builtin_amdgcn_s_barrier()
#define PG8_SCHED __builtin_amdgcn_sched_barrier(0)
    Unit cur, nxt; int ui = 0;
    if (!S.next(0, cur)) return;
    f32x16 acc[2][2][2];
#pragma unroll
    for (int a = 0; a < 2; ++a)
#pragma unroll
        for (int b = 0; b < 2; ++b)
#pragma unroll
            for (int m = 0; m < 2; ++m) acc[a][b][m] = f32x16{};
    v8i32 At[2][2], B0[2], B1[2];
    const char* cA = (const char*)g.A + (size_t)cur.grp * g.ga + (size_t)cur.pm * tstep; const char* cB = (const char*)g.Bt + (size_t)cur.grp * g.gb + (size_t)cur.pn * tstep;
    PG8_STAGE(PG8_SB(0, 0), cB, voffB); PG8_STAGE(PG8_SB(0, 1), cB + hstep, voffB); PG8_STAGE(PG8_SA(0, 0), cA, voffA); PG8_STAGE(PG8_SA(0, 1), cA + hstep, voffA);
    if (wr == 1) PG8_BAR;
    PG8_WAIT_V(2); PG8_BAR;
    PG8_STAGE(PG8_SB(1, 0), cB + kstep, voffB); PG8_STAGE(PG8_SA(1, 0), cA + kstep, voffA); PG8_STAGE(PG8_SB(1, 1), cB + hstep + kstep, voffB);
    PG8_WAIT_V(6); PG8_BAR;
    for (;;) {
        const bool has_next = S.next(ui + 1, nxt);
        const char* nA = has_next ? (const char*)g.A + (size_t)nxt.grp * g.ga + (size_t)nxt.pm * tstep : cA; const char* nB = has_next ? (const char*)g.Bt + (size_t)nxt.grp * g.gb + (size_t)nxt.pn * tstep : cB;
        for (int t = 0; t < nt; t += 2) {
            const bool last = (t == nt - 2);
            const char* a1 = cA + (size_t)(t + 1) * kstep;
            const char* a2 = last ? nA : cA + (size_t)(t + 2) * kstep; const char* b2 = last ? nB : cB + (size_t)(t + 2) * kstep;
            const char* a3 = a2 + kstep; const char* b3 = b2 + kstep;
            PG8_LDB(B0, 0, 0); PG8_LDB(B1, 0, 1); PG8_SCHED; PG8_LDA(At, 0, 0); PG8_STAGE(PG8_SA(1, 1), a1 + hstep, voffA);
            PG8_WAIT_V(8); PG8_WAIT_L(0); PG8_BAR; PG8_SCHED; PG8_MMA(0, 0, At, B0); PG8_MMA(0, 1, At, B1); PG8_SCHED; PG8_BAR; PG8_SCHED;
            PG8_LDA(At, 0, 1); PG8_STAGE(PG8_SB(0, 0), b2, voffB); PG8_STAGE(PG8_SB(0, 1), b2 + hstep, voffB); PG8_STAGE(PG8_SA(0, 0), a2, voffA);
            PG8_WAIT_V(8); PG8_WAIT_L(0); PG8_BAR; PG8_SCHED; PG8_MMA(1, 0, At, B0); PG8_MMA(1, 1, At, B1); PG8_SCHED; PG8_BAR; PG8_SCHED;
            PG8_LDB(B0, 1, 0); PG8_LDB(B1, 1, 1); PG8_SCHED; PG8_LDA(At, 1, 0); PG8_STAGE(PG8_SA(0, 1), a2 + hstep, voffA);
            PG8_WAIT_V(8); PG8_WAIT_L(0); PG8_BAR; PG8_SCHED; PG8_MMA(0, 0, At, B0); PG8_MMA(0, 1, At, B1); PG8_SCHED; PG8_BAR; PG8_SCHED;
            PG8_LDA(At, 1, 1); PG8_STAGE(PG8_SB(1, 0), b3, voffB); PG8_STAGE(PG8_SB(1, 1), b3 + hstep, voffB); PG8_STAGE(PG8_SA(1, 0), a3, voffA);
            PG8_WAIT_V(8); PG8_WAIT_L(0); PG8_BAR; PG8_SCHED; PG8_MMA(1, 0, At, B0); PG8_MMA(1, 1, At, B1); PG8_SCHED; PG8_BAR; PG8_SCHED;
        }
        if (wr == 0) PG8_BAR;
        E(acc, cur, wr, wc, l31, hh);
        if (!has_next) break;
#pragma unroll
        for (int a = 0; a < 2; ++a)
#pragma unroll
            for (int b = 0; b < 2; ++b)
#pragma unroll
                for (int m = 0; m < 2; ++m) acc[a][b][m] = f32x16{};
        cur = nxt; cA = nA; cB = nB; ++ui;
        if (wr == 1) PG8_BAR;
    }
    PG8_WAIT_V(0);
    PG8_BAR;
#undef PG8_SA
#undef PG8_SB
#undef PG8_STAGE
#undef PG8_LD32
#undef PG8_LDA
#undef PG8_LDB
#undef PG8_MMA
#undef PG8_WAIT_V
#undef PG8_WAIT_L
#undef PG8_BAR
#undef PG8_SCHED
}
struct EpiSwiGLU8 {
    unsigned char* HID;
    __device__ __forceinline__ void operator()(const f32x16 (&acc)[2][2][2], const Unit& u, int wr, int wc, int l31, int hh) const {
        const int row0 = u.pm * BM + wr * 64 + l31, f0 = u.pn * 128 + wc * 16 + 8 * hh;
#pragma unroll
        for (int ai = 0; ai < 2; ++ai)
#pragma unroll
            for (int m = 0; m < 2; ++m) { unsigned char* rowp = HID + ((size_t)u.grp * EROWS + row0 + ai * HALF + m * 32) * FF + f0;
#pragma unroll
                for (int bj = 0; bj < 2; ++bj) { const f32x16& c = acc[ai][bj][m]; float hv[8];
#pragma unroll
                    for (int e = 0; e < 8; ++e) hv[e] = silu_f(c[e] * W8_INV) * (c[8 + e] * W8_INV);
                    u32x2 w; w.x = f2fp8x4(hv[0], hv[1], hv[2], hv[3]); w.y = f2fp8x4(hv[4], hv[5], hv[6], hv[7]);
                    *(u32x2*)(rowp + bj * 64) = w; } }
    }
};
struct EpiMoeOut8 {
    unsigned char* YB; const float* gate;
    __device__ __forceinline__ void operator()(const f32x16 (&acc)[2][2][2], const Unit& u, int wr, int wc, int l31, int hh) const {
        const int row0 = u.pm * BM + wr * 64 + l31, col0 = u.pn * BM + wc * 32 + 16 * hh;
#pragma unroll
        for (int ai = 0; ai < 2; ++ai)
#pragma unroll
            for (int m = 0; m < 2; ++m) { const size_t er = (size_t)u.grp * EROWS + row0 + ai * HALF + m * 32; const float gt = gate[er] * (W8_INV * YB_SCALE); unsigned char* rowp = YB + er * DM + col0;
#pragma unroll
                for (int bj = 0; bj < 2; ++bj) { const f32x16& c = acc[ai][bj][m]; u32x4 w;
                    w.x = f2fp8x4(c[0] * gt, c[1] * gt, c[2] * gt, c[3] * gt); w.y = f2fp8x4(c[4] * gt, c[5] * gt, c[6] * gt, c[7] * gt);
                    w.z = f2fp8x4(c[8] * gt, c[9] * gt, c[10] * gt, c[11] * gt); w.w = f2fp8x4(c[12] * gt, c[13] * gt, c[14] * gt, c[15] * gt);
                    *(u32x4*)(rowp + bj * HALF) = w; } }
    }
};

struct EpiWin {
    bf16_t* Z;
    __device__ __forceinline__ void operator()(const f32x4 (&acc)[2][2][4][2], const Unit& u, int wr, int wc, int fr, int fq) const {
        const int row0 = u.grp * LR + CTXL + u.pm * BM + wr * 64 + fr, col0 = u.pn * BM + wc * 32 + 8 * fq; const bool act = (u.pn < 2) || (u.pn >= 4);
#pragma unroll
        for (int ai = 0; ai < 2; ++ai)
#pragma unroll
            for (int m = 0; m < 4; ++m) { bf16_t* rowp = Z + (size_t)(row0 + ai * HALF + m * 16) * 2048 + col0;
#pragma unroll
                for (int bj = 0; bj < 2; ++bj) { f32x4 v0 = acc[ai][bj][m][0], v1 = acc[ai][bj][m][1];
                    if (act) {
#pragma unroll
                        for (int i = 0; i < 4; ++i) { v0[i] = gelu_tanh(v0[i]); v1[i] = gelu_tanh(v1[i]); } }
                    u32x4 w; w.x = cvt_pk_bf16(v0[0], v0[1]); w.y = cvt_pk_bf16(v0[2], v0[3]); w.z = cvt_pk_bf16(v1[0], v1[1]); w.w = cvt_pk_bf16(v1[2], v1[3]);
                    *(u32x4*)(rowp + bj * HALF) = w; } }
    }
};
struct EpiRes {
    bf16_t* X; const float* xin; const float* g1; int mode;
    __device__ __forceinline__ void operator()(const f32x4 (&acc)[2][2][4][2], const Unit& u, int wr, int wc, int fr, int fq) const {
        const int b = u.grp; bf16_t* outp = X + ((size_t)b * LR + CTXL + (size_t)u.pm * BM) * DM;
        const float* basep = xin + ((size_t)b * SEQ + (size_t)u.pm * BM) * DM;
        const int rr0 = wr * 64 + fr, col0 = u.pn * BM + wc * 32 + 8 * fq;
        f32x4 gv[2][2];
#pragma unroll
        for (int bj = 0; bj < 2; ++bj)
#pragma unroll
            for (int n = 0; n < 2; ++n) gv[bj][n] = *(const f32x4*)(g1 + (size_t)b * 6144 + col0 + bj * HALF + 4 * n);
#pragma unroll
        for (int ai = 0; ai < 2; ++ai)
#pragma unroll
            for (int m = 0; m < 4; ++m) { const size_t off = (size_t)(rr0 + ai * HALF + m * 16) * DM + col0;
#pragma unroll
                for (int bj = 0; bj < 2; ++bj) { f32x4 b0, b1;
                    if (mode == 0) { b0 = *(const f32x4*)(basep + off + bj * HALF); b1 = *(const f32x4*)(basep + off + bj * HALF + 4); }
                    else { const u32x4 w = *(const u32x4*)(outp + off + bj * HALF); b0 = (f32x4){bflo(w.x), bfhi(w.x), bflo(w.y), bfhi(w.y)}; b1 = (f32x4){bflo(w.z), bfhi(w.z), bflo(w.w), bfhi(w.w)}; }
                    const f32x4 o0 = b0 + gv[bj][0] * acc[ai][bj][m][0], o1 = b1 + gv[bj][1] * acc[ai][bj][m][1];
                    u32x4 wo; wo.x = cvt_pk_bf16(o0[0], o0[1]); wo.y = cvt_pk_bf16(o0[2], o0[3]); wo.z = cvt_pk_bf16(o1[0], o1[1]); wo.w = cvt_pk_bf16(o1[2], o1[3]);
                    *(u32x4*)(outp + off + bj * HALF) = wo; } }
    }
};
constexpr float C2 = 0.125f * 1.4426950408889634f;
struct EpiQKV {
    bf16_t* Q; const float* cs;
    __device__ __forceinline__ void operator()(const f32x4 (&acc)[2][2][4][2], const Unit& u, int wr, int wc, int fr, int fq) const {
        const int t0 = u.pm * BM; const size_t Rb = (size_t)u.grp * LR + CTXL + t0;
        const int sec = u.pn >> 2; bf16_t* dst = Q + (size_t)sec * ((ACT_K - ACT_Q) / 2);
        const int rr0 = wr * 64 + fr, colt = (u.pn & 3) * BM + wc * 32 + 8 * fq; const float sc = sec == 0 ? C2 : 1.0f; const bool rope = sec < 2;
#pragma unroll
        for (int ai = 0; ai < 2; ++ai)
#pragma unroll
            for (int m = 0; m < 4; ++m) { const int rr = rr0 + ai * HALF + m * 16; bf16_t* rowp = dst + (Rb + rr) * DM + colt;
#pragma unroll
                for (int bj = 0; bj < 2; ++bj) { f32x4 v0 = acc[ai][bj][m][0], v1 = acc[ai][bj][m][1];
                    if (rope) { const int p0 = ((colt + bj * HALF) & 63) >> 1, tt = t0 + rr; const float* cp = cs + ((p0 < 16 ? (tt >> 6) * 16 + p0 : (128 + (tt & 63)) * 16 + (p0 - 16))) * 2;
                        const f32x4 c01 = *(const f32x4*)cp, c23 = *(const f32x4*)(cp + 4);
                        const float a0 = v0[0] * c01[0] - v0[1] * c01[1], a1 = v0[0] * c01[1] + v0[1] * c01[0];
                        const float a2 = v0[2] * c01[2] - v0[3] * c01[3], a3 = v0[2] * c01[3] + v0[3] * c01[2];
                        const float b0 = v1[0] * c23[0] - v1[1] * c23[1], b1 = v1[0] * c23[1] + v1[1] * c23[0];
                        const float b2 = v1[2] * c23[2] - v1[3] * c23[3], b3 = v1[2] * c23[3] + v1[3] * c23[2];
                        v0 = (f32x4){a0, a1, a2, a3}; v1 = (f32x4){b0, b1, b2, b3}; }
                    v0 = v0 * sc; v1 = v1 * sc;
                    u32x4 w; w.x = cvt_pk_bf16(v0[0], v0[1]); w.y = cvt_pk_bf16(v0[2], v0[3]); w.z = cvt_pk_bf16(v1[0], v1[1]); w.w = cvt_pk_bf16(v1[2], v1[3]);
                    *(u32x4*)(rowp + bj * HALF) = w; }
                asm volatile("" ::: "memory"); }
    }
};
struct EpiSwiGLU {
    bf16_t* HID;
    __device__ __forceinline__ void operator()(const f32x4 (&acc)[2][2][4][2], const Unit& u, int wr, int wc, int fr, int fq) const {
        const int row0 = u.pm * BM + wr * 64 + fr, f0 = u.pn * 128 + wc * 16 + 4 * fq;
#pragma unroll
        for (int ai = 0; ai < 2; ++ai)
#pragma unroll
            for (int m = 0; m < 4; ++m) { bf16_t* rowp = HID + ((size_t)u.grp * EROWS + row0 + ai * HALF + m * 16) * FF + f0;
#pragma unroll
                for (int bj = 0; bj < 2; ++bj) { const f32x4 a = acc[ai][bj][m][0], bb = acc[ai][bj][m][1];
                    u32x2 w; w.x = cvt_pk_bf16(silu_f(a[0]) * bb[0], silu_f(a[1]) * bb[1]); w.y = cvt_pk_bf16(silu_f(a[2]) * bb[2], silu_f(a[3]) * bb[3]);
                    *(u32x2*)(rowp + bj * 64) = w; } }
    }
};
struct EpiMoeOut {
    bf16_t* YB; const float* gate;
    __device__ __forceinline__ void operator()(const f32x4 (&acc)[2][2][4][2], const Unit& u, int wr, int wc, int fr, int fq) const {
        const int row0 = u.pm * BM + wr * 64 + fr, col0 = u.pn * BM + wc * 32 + 8 * fq;
#pragma unroll
        for (int ai = 0; ai < 2; ++ai)
#pragma unroll
            for (int m = 0; m < 4; ++m) { const size_t er = (size_t)u.grp * EROWS + row0 + ai * HALF + m * 16; const float gt = gate[er]; bf16_t* rowp = YB + er * DM + col0;
#pragma unroll
                for (int bj = 0; bj < 2; ++bj) { const f32x4 v0 = acc[ai][bj][m][0] * gt, v1 = acc[ai][bj][m][1] * gt;
                    u32x4 w; w.x = cvt_pk_bf16(v0[0], v0[1]); w.y = cvt_pk_bf16(v0[2], v0[3]); w.z = cvt_pk_bf16(v1[0], v1[1]); w.w = cvt_pk_bf16(v1[2], v1[3]);
                    *(u32x4*)(rowp + bj * HALF) = w; } }
    }
};
}

namespace attn_body {
using bf16=__hip_bfloat16;
using s16x4=__attribute__((ext_vector_type(4)))short;
using f32x16=__attribute__((ext_vector_type(16)))float;
constexpr int D=64,PITCH=1024;
constexpr int NW=8,QBLK=32,QB=QBLK*NW,KVBLK=64;
constexpr int NT=LR/KVBLK;
__device__ __forceinline__ int crow(int r,int hi){return (r&3)+8*(r>>2)+4*hi;}
#define SBAR() __builtin_amdgcn_sched_barrier(0)
constexpr int NSLOT=3, SLOTB=8192;
constexpr int LDS_K=0, LDS_V=NSLOT*SLOTB, LDS_WS=2*NSLOT*SLOTB, LDS_OST=LDS_WS+NW*64*4, LDS_BYTES=LDS_OST+NW*4096;
__device__ __forceinline__ void glds16(const void*gsrc,unsigned lds_dst){unsigned keep;
  asm volatile("s_mov_b32 %0, m0\n\ts_mov_b32 m0, %2\n\ts_nop 0\n\tglobal_load_lds_dwordx4 %1, off\n\ts_mov_b32 m0, %0":"=&s"(keep):"v"(gsrc),"s"(lds_dst):"memory");}
__device__ __forceinline__ void glds16s(const void*sbase,unsigned voff,unsigned lds_dst){unsigned keep;
  asm volatile("s_mov_b32 %0, m0\n\ts_mov_b32 m0, %2\n\ts_nop 2\n\tglobal_load_lds_dwordx4 %1, %3\n\ts_mov_b32 m0, %0":"=&s"(keep):"v"(voff),"s"(lds_dst),"s"(sbase):"memory");}
__device__ __forceinline__ float max3f(float a,float b,float c){float r;asm("v_max3_f32 %0, %1, %2, %3":"=v"(r):"v"(a),"v"(b),"v"(c));return r;}
__device__ __forceinline__ float max2f(float a,float b){float r;asm("v_max_f32_e32 %0, %1, %2":"=v"(r):"v"(a),"v"(b));return r;}
__device__ __forceinline__ float fadd_s(float a,float b){float r;asm("v_add_f32_e32 %0, %1, %2":"=v"(r):"v"(a),"v"(b));return r;}
__device__ __forceinline__ float fsub_s(float a,float b){float r;asm("v_sub_f32_e32 %0, %1, %2":"=v"(r):"v"(a),"v"(b));return r;}
typedef float f32x2_t __attribute__((ext_vector_type(2))); typedef __bf16 bf16x2_t __attribute__((ext_vector_type(2)));
__device__ __forceinline__ unsigned cvtpk_s(float lo,float hi){f32x2_t v={lo,hi};bf16x2_t b=__builtin_convertvector(v,bf16x2_t);return __builtin_bit_cast(unsigned,b);}
#define WAIT_BAR(N) asm volatile("s_waitcnt vmcnt(" #N ") lgkmcnt(0)\n\ts_barrier":::"memory")
__device__ __forceinline__ void qkt(f32x16&p0,f32x16&p1,const char*Kslot,const bf16x8*qr,const f32x16&negm,int r32,int hi){
  const char*kb=Kslot+hi*1024+r32*16;
  #pragma unroll
  for(int d0=0;d0<4;++d0){
    const bf16x8 b0=*reinterpret_cast<const bf16x8*>(kb+d0*2048);
    const bf16x8 b1=*reinterpret_cast<const bf16x8*>(kb+d0*2048+512);
    if(d0==0){p0=__builtin_amdgcn_mfma_f32_32x32x16_bf16(b0,qr[0],negm,0,0,0);p1=__builtin_amdgcn_mfma_f32_32x32x16_bf16(b1,qr[0],negm,0,0,0);}
    else{p0=__builtin_amdgcn_mfma_f32_32x32x16_bf16(b0,qr[d0],p0,0,0,0);p1=__builtin_amdgcn_mfma_f32_32x32x16_bf16(b1,qr[d0],p1,0,0,0);}}
}
typedef __attribute__((address_space(3))) const char* lds_cptr;
typedef short v4i16_t __attribute__((ext_vector_type(4)));
__device__ __forceinline__ void kload8(bf16x8*kf,lds_cptr kp){
  kf[0]=*(const __attribute__((address_space(3))) bf16x8*)(kp);      kf[1]=*(const __attribute__((address_space(3))) bf16x8*)(kp+512);
  kf[2]=*(const __attribute__((address_space(3))) bf16x8*)(kp+2048); kf[3]=*(const __attribute__((address_space(3))) bf16x8*)(kp+2560);
  kf[4]=*(const __attribute__((address_space(3))) bf16x8*)(kp+4096); kf[5]=*(const __attribute__((address_space(3))) bf16x8*)(kp+4608);
  kf[6]=*(const __attribute__((address_space(3))) bf16x8*)(kp+6144); kf[7]=*(const __attribute__((address_space(3))) bf16x8*)(kp+6656);
}
__device__ __forceinline__ void kload2(bf16x8*kf,lds_cptr kp,int j){ kf[2*j]=*(const __attribute__((address_space(3))) bf16x8*)(kp+j*2048); kf[2*j+1]=*(const __attribute__((address_space(3))) bf16x8*)(kp+j*2048+512); }
__device__ __forceinline__ s16x4 vtr(lds_cptr p){ return __builtin_bit_cast(s16x4,__builtin_amdgcn_ds_read_tr16_b64_v4i16((__attribute__((address_space(3))) v4i16_t*)p)); }
__device__ __forceinline__ float rowmax(const f32x16&p0,const f32x16&p1){
  float a=max3f(p0[0],p0[1],p1[0]),b=max3f(p0[2],p0[3],p1[1]);a=max3f(a,p1[2],p1[3]);
  #pragma unroll
  for(int r=4;r<16;r+=4){a=max3f(a,p0[r],p0[r+1]);b=max3f(b,p0[r+2],p0[r+3]);a=max3f(a,p1[r],p1[r+1]);b=max3f(b,p1[r+2],p1[r+3]);}
  const float m=max2f(a,b);
  auto rr=__builtin_amdgcn_permlane32_swap(__float_as_uint(m),__float_as_uint(m),false,false);
  return max2f(__uint_as_float(rr[0]),__uint_as_float(rr[1]));
}
__device__ __forceinline__ void pv(f32x16*o,int vb,bf16x8 pa0,bf16x8 pa1,bf16x8 pa2,bf16x8 pa3){
  #pragma unroll
  for(int d0=0;d0<2;++d0){s16x4 lo[4],hi[4];
    #pragma unroll
    for(int ks=0;ks<4;++ks){
      asm volatile("ds_read_b64_tr_b16 %0,%1 offset:%c2":"=&v"(lo[ks]):"v"(vb),"i"(d0*4096+ks*1024):"memory");
      asm volatile("ds_read_b64_tr_b16 %0,%1 offset:%c2":"=&v"(hi[ks]):"v"(vb),"i"(d0*4096+ks*1024+512):"memory");}
    asm volatile("s_waitcnt lgkmcnt(0)":::"memory");SBAR();
    #define PK(k) (bf16x8){lo[k][0],lo[k][1],lo[k][2],lo[k][3],hi[k][0],hi[k][1],hi[k][2],hi[k][3]}
    o[d0]=__builtin_amdgcn_mfma_f32_32x32x16_bf16(pa0,PK(0),o[d0],0,0,0);
    o[d0]=__builtin_amdgcn_mfma_f32_32x32x16_bf16(pa1,PK(1),o[d0],0,0,0);
    o[d0]=__builtin_amdgcn_mfma_f32_32x32x16_bf16(pa2,PK(2),o[d0],0,0,0);
    o[d0]=__builtin_amdgcn_mfma_f32_32x32x16_bf16(pa3,PK(3),o[d0],0,0,0);
    #undef PK
  }
}
template<int THRL> __device__ __forceinline__ void attn_unit(const bf16*Qw,const bf16*__restrict__ Kh,const bf16*__restrict__ Vh,bf16*Ow,char*shm){
  const int tid=threadIdx.x,lane=tid&63,r32=lane&31,hi=lane>>5; const int wid=__builtin_amdgcn_readfirstlane(tid>>6);
  constexpr int DMp=PITCH;
  const unsigned lds0=(unsigned)(uintptr_t)shm;
  float*wsf=(float*)(shm+LDS_WS)+wid*64;
  const bf16*ksrc=Kh+(long)lane*DMp+wid*8;
  const bf16*vsrc=Vh+(long)(16*(wid&3)+(lane>>2))*DMp+(wid>>2)*32+(lane&3)*8;
  const unsigned kdst=lds0+LDS_K+wid*1024, vdst=lds0+LDS_V+wid*1024;
  #define DMA_K(t,slot) glds16(ksrc+(long)(t)*KVBLK*DMp,(unsigned)__builtin_amdgcn_readfirstlane(kdst+(slot)))
  #define DMA_V(t,slot) glds16(vsrc+(long)(t)*KVBLK*DMp,(unsigned)__builtin_amdgcn_readfirstlane(vdst+(slot)))
  const int vb0=(int)(lds0+LDS_V)+((lane>>4)&1)*32+(lane&3)*8+(4*hi+((lane&15)>>2))*64;
  const char*Kbase=shm+LDS_K; bf16x8 kf[8];
  const lds_cptr shm3=(lds_cptr)shm; const lds_cptr kp0=shm3+LDS_K+hi*1024+r32*16; const lds_cptr vp0=shm3+LDS_V+((lane>>4)&1)*32+(lane&3)*8+(4*hi+((lane&15)>>2))*64;
  DMA_K(0,0);DMA_V(0,0);DMA_K(1,SLOTB);
  bf16x8 qr[4];
  #pragma unroll
  for(int d0=0;d0<4;++d0)qr[d0]=*reinterpret_cast<const bf16x8*>(&Qw[(long)r32*DMp+d0*16+hi*8]);
  float mhat=0.f,l_reg=0.f;f32x16 o[2];o[0]=f32x16{};o[1]=f32x16{};f32x16 negm=f32x16{};asm volatile("":"+v"(negm));
  bool resc=false;
  #define START(P0,P1) do{ const float rm=rowmax(P0,P1); resc=false; \
    { const float dl=rm; mhat=fadd_s(mhat,dl); \
      _Pragma("unroll") for(int r=0;r<16;++r){P0[r]=fsub_s(P0[r],dl);P1[r]=fsub_s(P1[r],dl);} \
      _Pragma("unroll") for(int r=0;r<16;++r)negm[r]=-mhat; asm volatile("":"+v"(negm)); } \
    _Pragma("unroll") for(int r=0;r<16;++r)P0[r]=__builtin_amdgcn_exp2f(P0[r]); }while(0)
  #define RESC() do{ if(resc){ asm volatile("s_waitcnt lgkmcnt(0)":::"memory"); \
      _Pragma("unroll") for(int d_=0;d_<2;++d_) _Pragma("unroll") for(int r=0;r<16;++r)o[d_][r]*=wsf[crow(r,hi)]; } }while(0)
  f32x16 pA0,pA1,pB0,pB1;
  int sl_prev=0,sl_cur=0,sl_next=SLOTB;
  #define ROT() do{sl_prev=sl_cur;sl_cur=sl_next;sl_next=(sl_next==(NSLOT-1)*SLOTB)?0:sl_next+SLOTB;}while(0)
  DMA_K(2,2*SLOTB);
  WAIT_BAR(3);
  qkt(pA0,pA1,Kbase,qr,negm,r32,hi);asm volatile("s_nop 15\n\ts_nop 7":"+v"(pA0),"+v"(pA1));
  START(pA0,pA1);
  _Pragma("unroll") for(int r=0;r<16;++r)pA1[r]=__builtin_amdgcn_exp2f(pA1[r]);
  WAIT_BAR(0);
  DMA_K(3,0);DMA_V(1,SLOTB);
  ROT();
  kload8(kf,kp0+sl_cur);
  WAIT_BAR(2);
  s16x4 vlo[8],vhi[8]; u32x4 pw0,pw1,pw2,pw3;
  #define PKW(P,B) cvtpk_s(P[B],P[B+1])
  #define PAF(k) __builtin_bit_cast(bf16x8,pw##k)
  #define VFR(i) (bf16x8){vlo[i][0],vlo[i][1],vlo[i][2],vlo[i][3],vhi[i][0],vhi[i][1],vhi[i][2],vhi[i][3]}
  #define PIN(x) asm volatile("":"+v"(x))
  #define MX3(a,b,c) __builtin_fmaxf(__builtin_fmaxf((a),(b)),(c))
  #define GAPA(MF,A0,A1,A2,A3,W0,W1,PW) do{ MF; sacc+=A0; sacc+=A1; sacc+=A2; sacc+=A3; PIN(sacc); W0; W1; PIN(PW); SBAR(); }while(0)
  #define EX(v) __builtin_amdgcn_exp2f(v)
  #define GAPB(MF,X,B) do{ MF; X[B]=EX(X[B]); X[B+1]=EX(X[B+1]); X[B+2]=EX(X[B+2]); X[B+3]=EX(X[B+3]); PIN(X); SBAR(); }while(0)
  #define VRD(i) do{ vlo[i]=vtr(vp_+(((i)>>2)*4096+((i)&3)*1024)); vhi[i]=vtr(vp_+(((i)>>2)*4096+((i)&3)*1024+512)); }while(0)
  #define KRD(G,j) do{ if(G){ kload2(kf,kp0+sl_next,j); SBAR(); } }while(0)
  #define STEP(C0,C1,P0,P1,t,GK,GV,GL) do{ SBAR(); \
    const lds_cptr vp_=vp0+sl_prev; \
    VRD(0); SBAR(); float sacc=(P0[0]+P0[1]); \
    GAPA(C0=__builtin_amdgcn_mfma_f32_32x32x16_bf16(kf[0],qr[0],negm,0,0,0), P0[2],P0[3],P0[4],P0[5],     pw0[0]=PKW(P0,0), pw0[1]=PKW(P0,2), pw0); \
    VRD(4); SBAR(); GAPA(C1=__builtin_amdgcn_mfma_f32_32x32x16_bf16(kf[1],qr[0],negm,0,0,0), P0[6],P0[7],P0[8],P0[9],     pw0[2]=PKW(P0,4), pw0[3]=PKW(P0,6), pw0); \
    VRD(1); SBAR(); GAPA(C0=__builtin_amdgcn_mfma_f32_32x32x16_bf16(kf[2],qr[1],C0,0,0,0),   P0[10],P0[11],P0[12],P0[13], pw1[0]=PKW(P0,8), pw1[1]=PKW(P0,10), pw1); \
    VRD(5); SBAR(); GAPA(C1=__builtin_amdgcn_mfma_f32_32x32x16_bf16(kf[3],qr[1],C1,0,0,0),   P0[14],P0[15],P1[0],P1[1],   pw1[2]=PKW(P0,12),pw1[3]=PKW(P0,14), pw1); \
    VRD(2); SBAR(); GAPA(C0=__builtin_amdgcn_mfma_f32_32x32x16_bf16(kf[4],qr[2],C0,0,0,0),   P1[2],P1[3],P1[4],P1[5],     pw2[0]=PKW(P1,0), pw2[1]=PKW(P1,2), pw2); \
    VRD(6); SBAR(); GAPA(C1=__builtin_amdgcn_mfma_f32_32x32x16_bf16(kf[5],qr[2],C1,0,0,0),   P1[6],P1[7],P1[8],P1[9],     pw2[2]=PKW(P1,4), pw2[3]=PKW(P1,6), pw2); \
    VRD(3); SBAR(); GAPA(C0=__builtin_amdgcn_mfma_f32_32x32x16_bf16(kf[6],qr[3],C0,0,0,0),   P1[10],P1[11],P1[12],P1[13], pw3[0]=PKW(P1,8), pw3[1]=PKW(P1,10), pw3); \
    VRD(7); SBAR(); GAPA(C1=__builtin_amdgcn_mfma_f32_32x32x16_bf16(kf[7],qr[3],C1,0,0,0),   P1[14],P1[15],0.f,0.f,       pw3[2]=PKW(P1,12),pw3[3]=PKW(P1,14), pw3); \
    l_reg+=sacc; \
    if(GK){DMA_K((t)+3,sl_cur);} if(GV){DMA_V((t)+1,sl_next);} \
    { float a=MX3(C0[0],C0[1],C1[0]),b=MX3(C0[2],C0[3],C1[1]); a=MX3(a,C1[2],C1[3]); \
      _Pragma("unroll") for(int r=4;r<16;r+=4){a=MX3(a,C0[r],C0[r+1]);b=MX3(b,C0[r+2],C0[r+3]);a=MX3(a,C1[r],C1[r+1]);b=MX3(b,C1[r+2],C1[r+3]);} \
      float rm=__builtin_fmaxf(a,b); { auto rr=__builtin_amdgcn_permlane32_swap(__float_as_uint(rm),__float_as_uint(rm),false,false); rm=__builtin_fmaxf(__uint_as_float(rr[0]),__uint_as_float(rr[1])); } \
      resc=false; \
      if(__builtin_expect(__any(rm>(float)THRL),0)){ const float dl=__builtin_fmaxf(rm,0.f); mhat+=dl; \
        _Pragma("unroll") for(int r=0;r<16;++r){C0[r]-=dl;C1[r]-=dl;} \
        _Pragma("unroll") for(int r=0;r<16;++r)negm[r]=-mhat; asm volatile("":"+v"(negm)); \
        const float f=__builtin_amdgcn_exp2f(-dl); l_reg*=f; if(hi==0)wsf[r32]=f; resc=true; } } \
    SBAR(); \
    GAPB(o[0]=__builtin_amdgcn_mfma_f32_32x32x16_bf16(PAF(0),VFR(0),o[0],0,0,0), C0,0); \
    GAPB(o[1]=__builtin_amdgcn_mfma_f32_32x32x16_bf16(PAF(0),VFR(4),o[1],0,0,0), C0,4); \
    KRD(GL,0); GAPB(o[0]=__builtin_amdgcn_mfma_f32_32x32x16_bf16(PAF(1),VFR(1),o[0],0,0,0), C0,8); \
    KRD(GL,1); GAPB(o[1]=__builtin_amdgcn_mfma_f32_32x32x16_bf16(PAF(1),VFR(5),o[1],0,0,0), C0,12); \
    KRD(GL,2); GAPB(o[0]=__builtin_amdgcn_mfma_f32_32x32x16_bf16(PAF(2),VFR(2),o[0],0,0,0), C1,0); \
    KRD(GL,3); GAPB(o[1]=__builtin_amdgcn_mfma_f32_32x32x16_bf16(PAF(2),VFR(6),o[1],0,0,0), C1,4); \
    GAPB(o[0]=__builtin_amdgcn_mfma_f32_32x32x16_bf16(PAF(3),VFR(3),o[0],0,0,0), C1,8); \
    GAPB(o[1]=__builtin_amdgcn_mfma_f32_32x32x16_bf16(PAF(3),VFR(7),o[1],0,0,0), C1,12); \
    }while(0)
  int t=1;
  for(;t+5<NT;t+=2){
    STEP(pB0,pB1,pA0,pA1,t,true,true,true);     WAIT_BAR(2); RESC(); ROT();
    STEP(pA0,pA1,pB0,pB1,t+1,true,true,true);   WAIT_BAR(2); RESC(); ROT();
  }
  #define ENDW(tt) do{ if((tt)+3<NT){WAIT_BAR(2);} else if((tt)+2<NT){WAIT_BAR(1);} else {WAIT_BAR(0);} }while(0)
  for(;t+1<NT;t+=2){
    STEP(pB0,pB1,pA0,pA1,t,(t+3<NT),(t+1<NT),(t+1<NT));       ENDW(t);   RESC(); ROT();
    STEP(pA0,pA1,pB0,pB1,t+1,(t+4<NT),(t+2<NT),(t+2<NT));     ENDW(t+1); RESC(); ROT();
  }
  STEP(pB0,pB1,pA0,pA1,NT-1,false,false,false); RESC();
  { float sacc=pB0[0]+pB0[1]; _Pragma("unroll") for(int r=2;r<16;++r)sacc+=pB0[r]; _Pragma("unroll") for(int r=0;r<16;++r)sacc+=pB1[r]; l_reg+=sacc;
    pw0=(u32x4){PKW(pB0,0),PKW(pB0,2),PKW(pB0,4),PKW(pB0,6)};pw1=(u32x4){PKW(pB0,8),PKW(pB0,10),PKW(pB0,12),PKW(pB0,14)};pw2=(u32x4){PKW(pB1,0),PKW(pB1,2),PKW(pB1,4),PKW(pB1,6)};pw3=(u32x4){PKW(pB1,8),PKW(pB1,10),PKW(pB1,12),PKW(pB1,14)};
    SBAR(); pv(o,vb0+sl_cur,PAF(0),PAF(1),PAF(2),PAF(3)); }
  #undef PKW
  #undef PAF
  #undef VFR
  #undef PIN
  #undef MX3
  #undef GAPA
  #undef GAPB
  #undef EX
  #undef VRD
  #undef KRD
  #undef STEP
  #undef ENDW
  {auto rr=__builtin_amdgcn_permlane32_swap(__float_as_uint(l_reg),__float_as_uint(l_reg),false,false);l_reg=__uint_as_float(rr[0])+__uint_as_float(rr[1]);}
  if(hi==0)wsf[32+r32]=l_reg;asm volatile("s_waitcnt lgkmcnt(0)":::"memory");
  float rli[16];
  #pragma unroll
  for(int r=0;r<16;++r)rli[r]=__builtin_amdgcn_rcpf(wsf[32+crow(r,hi)]);
  { bf16*stg=(bf16*)(shm+LDS_OST)+wid*2048;
    #pragma unroll
    for(int r=0;r<16;++r){const int orow=crow(r,hi);
      #pragma unroll
      for(int d0=0;d0<2;++d0)stg[orow*64+d0*32+r32]=__float2bfloat16(o[d0][r]*rli[r]);}
    asm volatile("s_waitcnt lgkmcnt(0)":::"memory");
    #pragma unroll
    for(int i=0;i<4;++i){const int row=i*8+(lane>>3),ch=lane&7; const u32x4 v=*(const u32x4*)(stg+row*64+ch*8); *(u32x4*)(Ow+(long)row*DMp+ch*8)=v;} }
  asm volatile("s_waitcnt lgkmcnt(0)\n\ts_barrier":::"memory");
  #undef DMA_K
  #undef DMA_V
  #undef START
  #undef RESC
  #undef ROT
}

constexpr int VSLOTB=16384;
constexpr int L2_K=0, L2_V=NSLOT*SLOTB, L2_WS=L2_V+NSLOT*VSLOTB, L2_OST=L2_WS+NW*64*4, L2_BYTES=L2_OST+NW*4096;
template<int THRL> __device__ __forceinline__ void attn_unit128(const bf16*Qw,const bf16*__restrict__ Kh,const bf16*__restrict__ Vh,bf16*Ow,char*shm){
  const int tid=threadIdx.x,lane=tid&63,r32=lane&31,hi=lane>>5; const int wid=__builtin_amdgcn_readfirstlane(tid>>6);
  constexpr int DMp=PITCH;
  const unsigned lds0=(unsigned)(uintptr_t)shm;
  float*wsf=(float*)(shm+L2_WS)+wid*64;
  const unsigned koff=(unsigned)(lane*DMp+wid*8)*2u;
  const unsigned voff=(unsigned)((16*(wid&3)+(lane>>2))*DMp+(wid>>2)*32+(lane&3)*8)*2u;
  const unsigned kdst=lds0+L2_K+wid*1024, vdst=lds0+L2_V+wid*1024;
  #define DMA_K(t,slot) glds16s((const char*)Kh+(long)(t)*KVBLK*DMp*2,koff,(unsigned)__builtin_amdgcn_readfirstlane(kdst+(slot)))
  #define DMA_V(t,slot) do{ glds16s((const char*)Vh+(long)(t)*KVBLK*DMp*2,voff,(unsigned)__builtin_amdgcn_readfirstlane(vdst+2*(slot))); glds16s((const char*)Vh+(long)(t)*KVBLK*DMp*2+128,voff,(unsigned)__builtin_amdgcn_readfirstlane(vdst+2*(slot)+8192)); }while(0)
  const char*Kbase=shm+L2_K; bf16x8 kf[8];
  const lds_cptr shm3=(lds_cptr)shm; const lds_cptr kp0=shm3+L2_K+hi*1024+r32*16; const lds_cptr vp0=shm3+L2_V+((lane>>4)&1)*32+(lane&3)*8+(4*hi+((lane&15)>>2))*64;
  DMA_K(0,0);DMA_V(0,0);DMA_K(1,SLOTB);
  bf16x8 qr[4];
  #pragma unroll
  for(int d0=0;d0<4;++d0)qr[d0]=*reinterpret_cast<const bf16x8*>(&Qw[(long)r32*DMp+d0*16+hi*8]);
  float mhat=0.f,l_reg=0.f;f32x16 o[4];o[0]=f32x16{};o[1]=f32x16{};o[2]=f32x16{};o[3]=f32x16{};f32x16 negm=f32x16{};asm volatile("":"+v"(negm));
  bool resc=false;
  #define RESC() do{ if(resc){ asm volatile("s_waitcnt lgkmcnt(0)":::"memory"); \
      _Pragma("unroll") for(int d_=0;d_<4;++d_) _Pragma("unroll") for(int r=0;r<16;++r)o[d_][r]*=wsf[crow(r,hi)]; } }while(0)
  f32x16 c0,c1; u32x4 pw0,pw1,pw2,pw3;
  int sl_prev=0,sl_cur=0,sl_next=SLOTB;
  #define ROT() do{sl_prev=sl_cur;sl_cur=sl_next;sl_next=(sl_next==(NSLOT-1)*SLOTB)?0:sl_next+SLOTB;}while(0)
  #define PKW(P,B) cvtpk_s(P[B],P[B+1])
  #define PAF(k) __builtin_bit_cast(bf16x8,pw##k)
  DMA_K(2,2*SLOTB);
  WAIT_BAR(4);
  qkt(c0,c1,Kbase,qr,negm,r32,hi);asm volatile("s_nop 15\n\ts_nop 7":"+v"(c0),"+v"(c1));
  { const float rm=rowmax(c0,c1); mhat=fadd_s(mhat,rm);
    _Pragma("unroll") for(int r=0;r<16;++r){c0[r]=fsub_s(c0[r],rm);c1[r]=fsub_s(c1[r],rm);}
    _Pragma("unroll") for(int r=0;r<16;++r)negm[r]=-mhat; asm volatile("":"+v"(negm));
    _Pragma("unroll") for(int r=0;r<16;++r){c0[r]=__builtin_amdgcn_exp2f(c0[r]);c1[r]=__builtin_amdgcn_exp2f(c1[r]);}
    float sacc=c0[0]+c0[1]; _Pragma("unroll") for(int r=2;r<16;++r)sacc+=c0[r]; _Pragma("unroll") for(int r=0;r<16;++r)sacc+=c1[r]; l_reg+=sacc;
    pw0=(u32x4){PKW(c0,0),PKW(c0,2),PKW(c0,4),PKW(c0,6)};pw1=(u32x4){PKW(c0,8),PKW(c0,10),PKW(c0,12),PKW(c0,14)};pw2=(u32x4){PKW(c1,0),PKW(c1,2),PKW(c1,4),PKW(c1,6)};pw3=(u32x4){PKW(c1,8),PKW(c1,10),PKW(c1,12),PKW(c1,14)}; }
  WAIT_BAR(0);
  DMA_K(3,0);DMA_V(1,SLOTB);
  ROT();
  kload8(kf,kp0+sl_cur);
  WAIT_BAR(3);
  s16x4 vlo[8],vhi[8];
  #define VFR(i) (bf16x8){vlo[i][0],vlo[i][1],vlo[i][2],vlo[i][3],vhi[i][0],vhi[i][1],vhi[i][2],vhi[i][3]}
  #define PIN(x) asm volatile("":"+v"(x))
  #define MX3(a,b,c) __builtin_fmaxf(__builtin_fmaxf((a),(b)),(c))
  #define EX(v) __builtin_amdgcn_exp2f(v)
  #define VRD(H,i) do{ vlo[i]=vtr(vp_+((2*(H)+((i)>>2))*4096+((i)&3)*1024)); vhi[i]=vtr(vp_+((2*(H)+((i)>>2))*4096+((i)&3)*1024+512)); }while(0)
  #define KRD(G,j) do{ if(G){ kload2(kf,kp0+sl_next,j); SBAR(); } }while(0)
  #define GAPA(MF) do{ MF; SBAR(); }while(0)
  #define GAPB(MF,X,B,VR) do{ MF; X[B]=EX(X[B]); X[B+1]=EX(X[B+1]); X[B+2]=EX(X[B+2]); X[B+3]=EX(X[B+3]); PIN(X); VR; SBAR(); }while(0)
  #define GAPC(MF,X,B) do{ MF; sacc+=X[B]; sacc+=X[B+1]; sacc+=X[B+2]; sacc+=X[B+3]; PIN(sacc); SBAR(); }while(0)
  #define GAPCE(MF,X,B,Y,D) do{ MF; sacc+=X[B]; sacc+=X[B+1]; sacc+=X[B+2]; sacc+=X[B+3]; PIN(sacc); Y[D]=EX(Y[D]); Y[D+1]=EX(Y[D+1]); Y[D+2]=EX(Y[D+2]); Y[D+3]=EX(Y[D+3]); PIN(Y); SBAR(); }while(0)
  #define STEP(t,GK,GV,GL) do{ SBAR(); \
    const lds_cptr vp_=vp0+2*sl_prev; \
      \
    VRD(0,0); SBAR(); GAPA(c0=__builtin_amdgcn_mfma_f32_32x32x16_bf16(kf[0],qr[0],negm,0,0,0)); \
    VRD(0,4); SBAR(); GAPA(c1=__builtin_amdgcn_mfma_f32_32x32x16_bf16(kf[1],qr[0],negm,0,0,0)); \
    VRD(0,1); SBAR(); GAPA(c0=__builtin_amdgcn_mfma_f32_32x32x16_bf16(kf[2],qr[1],c0,0,0,0)); \
    VRD(0,5); SBAR(); GAPA(c1=__builtin_amdgcn_mfma_f32_32x32x16_bf16(kf[3],qr[1],c1,0,0,0)); \
    VRD(0,2); SBAR(); GAPA(c0=__builtin_amdgcn_mfma_f32_32x32x16_bf16(kf[4],qr[2],c0,0,0,0)); \
    VRD(0,6); SBAR(); GAPA(c1=__builtin_amdgcn_mfma_f32_32x32x16_bf16(kf[5],qr[2],c1,0,0,0)); \
    VRD(0,3); SBAR(); GAPA(c0=__builtin_amdgcn_mfma_f32_32x32x16_bf16(kf[6],qr[3],c0,0,0,0)); \
    VRD(0,7); SBAR(); GAPA(c1=__builtin_amdgcn_mfma_f32_32x32x16_bf16(kf[7],qr[3],c1,0,0,0)); \
    if(GK){DMA_K((t)+3,sl_cur);} if(GV){DMA_V((t)+1,sl_next);} \
    SBAR(); \
      \
    float mxa,mxb,rm_; \
    o[0]=__builtin_amdgcn_mfma_f32_32x32x16_bf16(PAF(0),VFR(0),o[0],0,0,0); \
    { mxa=MX3(c0[0],c0[1],c0[2]); mxb=MX3(c0[3],c0[4],c0[5]); mxa=MX3(mxa,c0[6],c0[7]); mxb=MX3(mxb,c0[8],c0[9]); mxa=MX3(mxa,c0[10],c0[11]); mxb=MX3(mxb,c0[12],c0[13]); mxa=MX3(mxa,c0[14],c0[15]); } VRD(1,0); SBAR(); \
    o[1]=__builtin_amdgcn_mfma_f32_32x32x16_bf16(PAF(0),VFR(4),o[1],0,0,0); \
    { mxb=MX3(mxb,c1[0],c1[1]); mxa=MX3(mxa,c1[2],c1[3]); mxb=MX3(mxb,c1[4],c1[5]); mxa=MX3(mxa,c1[6],c1[7]); mxb=MX3(mxb,c1[8],c1[9]); mxa=MX3(mxa,c1[10],c1[11]); mxb=MX3(mxb,c1[12],c1[13]); mxa=MX3(mxa,c1[14],c1[15]); \
      rm_=__builtin_fmaxf(mxa,mxb); { auto rr=__builtin_amdgcn_permlane32_swap(__float_as_uint(rm_),__float_as_uint(rm_),false,false); rm_=__builtin_fmaxf(__uint_as_float(rr[0]),__uint_as_float(rr[1])); } } VRD(1,4); SBAR(); \
    o[0]=__builtin_amdgcn_mfma_f32_32x32x16_bf16(PAF(1),VFR(1),o[0],0,0,0); \
    { resc=false; \
      if(__builtin_expect(__any(rm_>(float)THRL),0)){ const float dl=__builtin_fmaxf(rm_,0.f); mhat+=dl; \
        _Pragma("unroll") for(int r=0;r<16;++r){c0[r]-=dl;c1[r]-=dl;} \
        _Pragma("unroll") for(int r=0;r<16;++r)negm[r]=-mhat; asm volatile("":"+v"(negm)); \
        const float f=__builtin_amdgcn_exp2f(-dl); l_reg*=f; if(hi==0)wsf[r32]=f; resc=true; } } VRD(1,1); SBAR(); \
    GAPB(o[1]=__builtin_amdgcn_mfma_f32_32x32x16_bf16(PAF(1),VFR(5),o[1],0,0,0), c0,0,  VRD(1,5)); \
    GAPB(o[0]=__builtin_amdgcn_mfma_f32_32x32x16_bf16(PAF(2),VFR(2),o[0],0,0,0), c0,4,  VRD(1,2)); \
    GAPB(o[1]=__builtin_amdgcn_mfma_f32_32x32x16_bf16(PAF(2),VFR(6),o[1],0,0,0), c0,8,  VRD(1,6)); \
    GAPB(o[0]=__builtin_amdgcn_mfma_f32_32x32x16_bf16(PAF(3),VFR(3),o[0],0,0,0), c0,12, VRD(1,3)); \
    GAPB(o[1]=__builtin_amdgcn_mfma_f32_32x32x16_bf16(PAF(3),VFR(7),o[1],0,0,0), c1,0,  VRD(1,7)); \
      \
    float sacc=0.f; \
    GAPCE(o[2]=__builtin_amdgcn_mfma_f32_32x32x16_bf16(PAF(0),VFR(0),o[2],0,0,0), c0,0, c1,4); \
    GAPCE(o[3]=__builtin_amdgcn_mfma_f32_32x32x16_bf16(PAF(0),VFR(4),o[3],0,0,0), c0,4, c1,8); \
    pw0[0]=PKW(c0,0); pw0[1]=PKW(c0,2); pw0[2]=PKW(c0,4); pw0[3]=PKW(c0,6); PIN(pw0); SBAR(); \
    KRD(GL,0); GAPCE(o[2]=__builtin_amdgcn_mfma_f32_32x32x16_bf16(PAF(1),VFR(1),o[2],0,0,0), c0,8, c1,12); \
    KRD(GL,1); GAPC(o[3]=__builtin_amdgcn_mfma_f32_32x32x16_bf16(PAF(1),VFR(5),o[3],0,0,0), c0,12); \
    pw1[0]=PKW(c0,8); pw1[1]=PKW(c0,10); pw1[2]=PKW(c0,12); pw1[3]=PKW(c0,14); PIN(pw1); SBAR(); \
    KRD(GL,2); GAPC(o[2]=__builtin_amdgcn_mfma_f32_32x32x16_bf16(PAF(2),VFR(2),o[2],0,0,0), c1,0); \
    KRD(GL,3); GAPC(o[3]=__builtin_amdgcn_mfma_f32_32x32x16_bf16(PAF(2),VFR(6),o[3],0,0,0), c1,4); \
    pw2[0]=PKW(c1,0); pw2[1]=PKW(c1,2); pw2[2]=PKW(c1,4); pw2[3]=PKW(c1,6); PIN(pw2); SBAR(); \
    GAPC(o[2]=__builtin_amdgcn_mfma_f32_32x32x16_bf16(PAF(3),VFR(3),o[2],0,0,0), c1,8); \
    GAPC(o[3]=__builtin_amdgcn_mfma_f32_32x32x16_bf16(PAF(3),VFR(7),o[3],0,0,0), c1,12); \
    pw3[0]=PKW(c1,8); pw3[1]=PKW(c1,10); pw3[2]=PKW(c1,12); pw3[3]=PKW(c1,14); PIN(pw3); SBAR(); \
    l_reg+=sacc; \
    }while(0)
  int t=1;
  for(;t+5<NT;t+=2){
    STEP(t,true,true,true);     WAIT_BAR(3); RESC(); ROT();
    STEP(t+1,true,true,true);   WAIT_BAR(3); RESC(); ROT();
  }
  #define ENDW(tt) do{ if((tt)+3<NT){WAIT_BAR(3);} else if((tt)+2<NT){WAIT_BAR(2);} else {WAIT_BAR(0);} }while(0)
  for(;t+1<NT;t+=2){
    STEP(t,(t+3<NT),(t+1<NT),(t+1<NT));       ENDW(t);   RESC(); ROT();
    STEP(t+1,(t+4<NT),(t+2<NT),(t+2<NT));     ENDW(t+1); RESC(); ROT();
  }
  STEP(NT-1,false,false,false); RESC();
  { int lane_=threadIdx.x&63; asm volatile("":"+v"(lane_));
    const int vb=(int)(lds0+L2_V)+((lane_>>4)&1)*32+(lane_&3)*8+(4*(lane_>>5)+((lane_&15)>>2))*64+2*sl_cur;
    #pragma unroll
    for(int d0=0;d0<4;++d0){s16x4 lo[4],hh[4];
      #pragma unroll
      for(int ks=0;ks<4;++ks){
        asm volatile("ds_read_b64_tr_b16 %0,%1 offset:%c2":"=&v"(lo[ks]):"v"(vb),"i"(d0*4096+ks*1024):"memory");
        asm volatile("ds_read_b64_tr_b16 %0,%1 offset:%c2":"=&v"(hh[ks]):"v"(vb),"i"(d0*4096+ks*1024+512):"memory");}
      asm volatile("s_waitcnt lgkmcnt(0)":::"memory");SBAR();
      #define PK(k) (bf16x8){lo[k][0],lo[k][1],lo[k][2],lo[k][3],hh[k][0],hh[k][1],hh[k][2],hh[k][3]}
      o[d0]=__builtin_amdgcn_mfma_f32_32x32x16_bf16(PAF(0),PK(0),o[d0],0,0,0);
      o[d0]=__builtin_amdgcn_mfma_f32_32x32x16_bf16(PAF(1),PK(1),o[d0],0,0,0);
      o[d0]=__builtin_amdgcn_mfma_f32_32x32x16_bf16(PAF(2),PK(2),o[d0],0,0,0);
      o[d0]=__builtin_amdgcn_mfma_f32_32x32x16_bf16(PAF(3),PK(3),o[d0],0,0,0);
      #undef PK
    } }
  #undef PKW
  #undef PAF
  #undef VFR
  #undef PIN
  #undef MX3
  #undef GAPA
  #undef GAPB
  #undef GAPC
  #undef GAPCE
  #undef EX
  #undef VRD
  #undef KRD
  #undef STEP
  #undef ENDW
  {auto rr=__builtin_amdgcn_permlane32_swap(__float_as_uint(l_reg),__float_as_uint(l_reg),false,false);l_reg=__uint_as_float(rr[0])+__uint_as_float(rr[1]);}
  if(hi==0)wsf[32+r32]=l_reg;asm volatile("s_waitcnt lgkmcnt(0)":::"memory");
  float rli[16];
  #pragma unroll
  for(int r=0;r<16;++r)rli[r]=__builtin_amdgcn_rcpf(wsf[32+crow(r,hi)]);
  { bf16*stg=(bf16*)(shm+L2_OST)+wid*2048;
    #pragma unroll
    for(int hf=0;hf<2;++hf){
      #pragma unroll
      for(int r=0;r<16;++r){const int orow=crow(r,hi);
        #pragma unroll
        for(int d0=0;d0<2;++d0)stg[orow*64+d0*32+r32]=__float2bfloat16(o[2*hf+d0][r]*rli[r]);}
      asm volatile("s_waitcnt lgkmcnt(0)":::"memory");
      #pragma unroll
      for(int i=0;i<4;++i){const int row=i*8+(lane>>3),ch=lane&7; const u32x4 v=*(const u32x4*)(stg+row*64+ch*8); *(u32x4*)(Ow+(long)row*DMp+hf*64+ch*8)=v;}
      asm volatile("s_waitcnt lgkmcnt(0)":::"memory"); } }
  asm volatile("s_waitcnt lgkmcnt(0)\n\ts_barrier":::"memory");
  #undef DMA_K
  #undef DMA_V
  #undef RESC
  #undef ROT
}
#undef SBAR
#undef WAIT_BAR
}

constexpr int NWAVES = 8, LDS_BYTES = 147456, RING_BYTES = 131072;
struct Params { const float* in[32]; float* out; unsigned char* ws; int ph_lo, ph_hi; };
enum { I_X = 0, I_C, I_CTX, I_CCTX, I_ADAW, I_ADAB, I_NMIXG, I_NFFNG, I_WIN, I_CONVW, I_CONVB, I_LRUWA, I_LRUBA, I_LRUWX, I_LRUBX, I_LRULAM, I_CMVG, I_CMWS, I_CMBS, I_WOUT0,
       I_WQKV, I_LQ1, I_LK1, I_LQ2, I_LK2, I_SUBLN, I_WOUT1, I_ROUTER, I_W1, I_W3, I_W2, I_FINALG };

typedef const __attribute__((address_space(4))) Params* KParams;
__device__ __forceinline__ Params kparams() {
#if defined(__HIP_DEVICE_COMPILE__)
    KParams q = (KParams)__builtin_amdgcn_kernarg_segment_ptr(); asm volatile("" : "+s"(q)); return *q;
#else
    return Params{};
#endif
}
struct Ctx {
    LAS unsigned char* lds; int tid, lane, wave, vcu, G;
};
__device__ __forceinline__ float wave_sum(float v) {
#pragma unroll
    for (int o = 1; o < 64; o <<= 1) v += __shfl_xor(v, o);
    return v;
}
#define LDS_WAIT() asm volatile("s_waitcnt lgkmcnt(0)" ::: "memory")

__device__ __forceinline__ int dest_row(int n, int mode) {
    if (mode == 1) return n < 2048 ? ((n & ~63) + 2 * (n & 31) + ((n >> 5) & 1)) : n;
    if (mode == 2) return 32 * (n >> 4) + (n & 15);
    if (mode == 3) return 32 * (n >> 4) + 16 + (n & 15);
    return n;
}
__device__ __forceinline__ void p0_transpose_item(const float* W, int K, int N, bf16_t* WT, int mode, LAS float* scr, int item, int lane) {
    const int nblk = N / 32, kb = item / nblk, nb = item % nblk, k0 = 64 * kb, n0 = 32 * nb;
    float tv[32];
#pragma unroll
    for (int i = 0; i < 32; ++i) { const int kk = 2 * i + (lane >> 5); tv[i] = __builtin_nontemporal_load(&W[(size_t)(k0 + kk) * N + n0 + (lane & 31)]); }
#pragma unroll
    for (int i = 0; i < 32; ++i) { const int kk = 2 * i + (lane >> 5); scr[kk * 33 + (lane & 31)] = tv[i]; }
    LDS_WAIT(); asm volatile("" ::: "memory");
    const int c = lane & 7;
#pragma unroll
    for (int j = 0; j < 4; ++j) { const int n = (lane >> 3) + 8 * j; const LAS float* s = scr + (8 * c) * 33 + n;
        u32x4 o; o.x = pk2(s[0 * 33], s[1 * 33]); o.y = pk2(s[2 * 33], s[3 * 33]); o.z = pk2(s[4 * 33], s[5 * 33]); o.w = pk2(s[6 * 33], s[7 * 33]);
        *(GAS u32x4*)(WT + (size_t)dest_row(n0 + n, mode) * K + k0 + 8 * c) = o; }
    LDS_WAIT(); asm volatile("" ::: "memory");
}
__device__ __forceinline__ void p0_transpose_item8(const float* W, int K, int N, unsigned char* WT, int mode, LAS float* scr, int item, int lane) {
    const int nblk = N / 32, kb = item / nblk, nb = item % nblk, k0 = 64 * kb, n0 = 32 * nb;
    float tv[32];
#pragma unroll
    for (int i = 0; i < 32; ++i) { const int kk = 2 * i + (lane >> 5); tv[i] = __builtin_nontemporal_load(&W[(size_t)(k0 + kk) * N + n0 + (lane & 31)]); }
#pragma unroll
    for (int i = 0; i < 32; ++i) { const int kk = 2 * i + (lane >> 5); scr[kk * 33 + (lane & 31)] = tv[i] * W8_SCALE; }
    LDS_WAIT(); asm volatile("" ::: "memory");
    const int c = lane & 7;
#pragma unroll
    for (int j = 0; j < 4; ++j) { const int n = (lane >> 3) + 8 * j; const LAS float* sp = scr + (8 * c) * 33 + n;
        u32x2 o; o.x = f2fp8x4(sp[0 * 33], sp[1 * 33], sp[2 * 33], sp[3 * 33]); o.y = f2fp8x4(sp[4 * 33], sp[5 * 33], sp[6 * 33], sp[7 * 33]);
        *(GAS u32x2*)(WT + (size_t)dest_row(n0 + n, mode) * K + k0 + 8 * c) = o; }
    LDS_WAIT(); asm volatile("" ::: "memory");
}
__device__ __forceinline__ void p0_prologue(const Ctx& F, const Params& p) {
    unsigned char* ws = p.ws;
    LAS float* sil = (LAS float*)(F.lds + 8 * 16384);
    for (int i = F.tid; i < 3 * DM; i += 512) { const float v = i < 2 * DM ? p.in[I_C][i] : p.in[I_CCTX][i - 2 * DM]; sil[i] = silu_f(v); }
    __syncthreads();
    {
        float* modp = (float*)(ws + WS_MODP);
        for (int task = F.wave * F.G + F.vcu; task < 2 * 96 * 8; task += NWAVES * F.G) {
            const int ks = task & 7, cgp = (task >> 3) % 96, l = task / 768, n = cgp * 64 + F.lane;
            const float* W = p.in[I_ADAW] + ((size_t)l * DM + ks * 128) * 6144 + n;
            float a0 = 0.f, a1 = 0.f, a2 = 0.f;
#pragma unroll 32
            for (int k = 0; k < 128; ++k) { const float w = __builtin_nontemporal_load(&W[(size_t)k * 6144]); a0 += sil[ks * 128 + k] * w; a1 += sil[DM + ks * 128 + k] * w; a2 += sil[2 * DM + ks * 128 + k] * w; }
            float* o = modp + ((size_t)(ks * 2 + l) * 3) * 6144 + n; o[0] = a0; o[6144] = a1; o[2 * 6144] = a2;
        }
    }
    {
        const int gt = F.vcu * 512 + F.tid, NT_ = F.G * 512;
        float* cs = (float*)(ws + WS_ROPE);
        for (int i = gt; i < 192 * 16; i += NT_) { const int pos = i >> 4, f = i & 15; const float inv = powf(10000.0f, -(float)(2 * f) / 32.0f);
            const float ang = (float)(pos < 128 ? pos : pos - 128) * inv; float s, c; sincosf(ang, &s, &c); cs[2 * i] = c; cs[2 * i + 1] = s; }
        bf16_t* lw = (bf16_t*)(ws + WS_LRUW);
        for (int o = gt; o < 2 * 2 * 8 * 64 * 64; o += NT_) { const int i = o & 63, j = (o >> 6) & 63, h = (o >> 12) & 7, g2 = (o >> 15) & 1, d = o >> 16;
            const float* src = g2 ? p.in[I_LRUWX] : p.in[I_LRUWA]; lw[o] = (bf16_t)f2bf(src[((d * 8 + h) * 64 + i) * 64 + j]); }
        bf16_t* cw = (bf16_t*)(ws + WS_CMWS);
        for (int o = gt; o < 8 * 128 * 128; o += NT_) cw[o] = (bf16_t)f2bf(p.in[I_CMWS][o]);
    }
    LAS float* scr = (LAS float*)(F.lds + F.wave * 16384);
    const int gw = F.vcu * NWAVES + F.wave, NGW = F.G * NWAVES;
    constexpr int I_IN = 1024, I_O0 = 512, I_QK = 1536, I_O1 = 512, I_SMALL = I_IN + I_O0 + I_QK + I_O1, I_MOE = 1024, NITEMS = I_SMALL + 3 * 32 * I_MOE;
    for (int it = gw; it < NITEMS; it += NGW) {
        int r = it;
        if (r < I_SMALL) {
            if (r < I_IN) { p0_transpose_item(p.in[I_WIN], DM, 2048, (bf16_t*)(ws + WS_WIN), 0, scr, r, F.lane); continue; } r -= I_IN;
            if (r < I_O0) { p0_transpose_item(p.in[I_WOUT0], DM, DM, (bf16_t*)(ws + WS_WOUT0), 0, scr, r, F.lane); continue; } r -= I_O0;
            if (r < I_QK) { p0_transpose_item(p.in[I_WQKV], DM, 3072, (bf16_t*)(ws + WS_WQKV), 1, scr, r, F.lane); continue; } r -= I_QK;
            p0_transpose_item(p.in[I_WOUT1], DM, DM, (bf16_t*)(ws + WS_WOUT1), 0, scr, r, F.lane); continue;
        }
        r -= I_SMALL; const int which = r / (32 * I_MOE), le = (r / I_MOE) % 32, item = r % I_MOE;
        if (which == 0) p0_transpose_item8(p.in[I_W1] + (size_t)le * DM * FF, DM, FF, ws + WS_W13 + (size_t)le * 4096 * DM, 2, scr, item, F.lane);
        else if (which == 1) p0_transpose_item8(p.in[I_W3] + (size_t)le * DM * FF, DM, FF, ws + WS_W13 + (size_t)le * 4096 * DM, 3, scr, item, F.lane);
        else p0_transpose_item8(p.in[I_W2] + (size_t)le * FF * DM, FF, DM, ws + WS_W2 + (size_t)le * DM * FF, 0, scr, item, F.lane);
    }
}

__device__ __forceinline__ void ld_row(const float* pr, int lane, f32x4 (&v)[4]) {
#pragma unroll
    for (int j = 0; j < 4; ++j) v[j] = *(const f32x4*)(pr + 4 * lane + 256 * j);
}
__device__ __forceinline__ void ld_row_bf(const bf16_t* pr, int lane, f32x4 (&v)[4]) {
#pragma unroll
    for (int j = 0; j < 4; ++j) { const u32x2 w = *(const u32x2*)(pr + 4 * lane + 256 * j); v[j] = (f32x4){bflo(w.x), bfhi(w.x), bflo(w.y), bfhi(w.y)}; }
}
__device__ __forceinline__ float row_rstd(const f32x4 (&v)[4]) {
    float s = 0.f;
#pragma unroll
    for (int j = 0; j < 4; ++j) s += (v[j][0] * v[j][0] + v[j][1] * v[j][1]) + (v[j][2] * v[j][2] + v[j][3] * v[j][3]);
    return 1.0f / sqrtf(wave_sum(s) * (1.0f / DM) + EPS);
}
__device__ __forceinline__ void mod_norm(f32x4 (&v)[4], float rstd, const float* g, const float* sc, const float* sh, int lane) {
#pragma unroll
    for (int j = 0; j < 4; ++j) { const int c = 4 * lane + 256 * j; const f32x4 gv = *(const f32x4*)(g + c), sv = *(const f32x4*)(sc + c), hv = *(const f32x4*)(sh + c);
        v[j] = v[j] * rstd * gv * (sv + 1.0f) + hv; }
}
__device__ __forceinline__ void st_row_bf16(bf16_t* pr, int lane, const f32x4 (&v)[4]) {
#pragma unroll
    for (int j = 0; j < 4; ++j) { u32x2 w; w.x = pk2(v[j][0], v[j][1]); w.y = pk2(v[j][2], v[j][3]); *(u32x2*)(pr + 4 * lane + 256 * j) = w; }
}
__device__ __forceinline__ void row_info(int R, int& b, int& j, int& rt) { b = R / LR; j = R % LR; rt = j < CTXL ? 2 : b; }

__device__ __forceinline__ void stage_mod(const Ctx& F, LAS float* dst, const float* mod_l, const float* g, int sc_chunk, int sh_chunk) {
    float gq[6], sq[6], hq[6];
#pragma unroll
    for (int q = 0; q < 6; ++q) { const int i = F.tid + 512 * q, rt = i >> 10, c = i & 1023; const float* m = mod_l + (size_t)rt * 6144; gq[q] = g[c]; sq[q] = m[sc_chunk * DM + c]; hq[q] = m[sh_chunk * DM + c]; }
#pragma unroll
    for (int q = 0; q < 6; ++q) { const int i = F.tid + 512 * q; dst[i] = gq[q] * (1.0f + sq[q]); dst[3 * DM + i] = hq[q]; }
}
__device__ __forceinline__ void apply_mod(f32x4 (&v)[4], float rstd, const LAS float* ms, int rt, int lane) {
#pragma unroll
    for (int j = 0; j < 4; ++j) { const int c = rt * DM + 4 * lane + 256 * j; v[j] = v[j] * rstd * *(const LAS f32x4*)(ms + c) + *(const LAS f32x4*)(ms + 3 * DM + c); }
}
constexpr int NBR = 4;
__device__ __forceinline__ void p_norm1_in(const Ctx& F, const Params& p) {
    bf16_t* H = (bf16_t*)(p.ws + WS_H);
    LAS float* ms = (LAS float*)F.lds;
    {
        const float* modp = (const float*)(p.ws + WS_MODP); float* modw = (float*)(p.ws + WS_MOD);
        for (int i = blockIdx.x * 512 + F.tid; i < 2 * 3 * 6144; i += F.G * 512) { const int l = i / (3 * 6144), n = i % 6144; float a = p.in[I_ADAB][l * 6144 + n];
#pragma unroll
            for (int ks = 0; ks < 8; ++ks) a += modp[(size_t)ks * 2 * 3 * 6144 + i];
            modw[i] = a; }
#pragma unroll
        for (int q = 0; q < 6; q += 2) {
            float shv[2][8], scv[2][8], b0[2], b1[2], gg[2];
#pragma unroll
            for (int u = 0; u < 2; ++u) { const int i = F.tid + 512 * (q + u), rt = i >> 10, c = i & 1023; b0[u] = p.in[I_ADAB][c]; b1[u] = p.in[I_ADAB][DM + c]; gg[u] = p.in[I_NMIXG][c];
#pragma unroll
                for (int ks = 0; ks < 8; ++ks) { const float* pp = modp + ((size_t)(ks * 2 + 0) * 3 + rt) * 6144; shv[u][ks] = pp[c]; scv[u][ks] = pp[DM + c]; } }
#pragma unroll
            for (int u = 0; u < 2; ++u) { const int i = F.tid + 512 * (q + u); float sh = b0[u], sc = b1[u];
#pragma unroll
                for (int ks = 0; ks < 8; ++ks) { sh += shv[u][ks]; sc += scv[u][ks]; }
                ms[i] = gg[u] * (1.0f + sc); ms[3 * DM + i] = sh; } }
    }
    __syncthreads();
    const int gw = F.vcu * NWAVES + F.wave, NGW = F.G * NWAVES;
    for (int R0 = gw; R0 < NR; R0 += NBR * NGW) {
        f32x4 v[NBR][4]; int rts[NBR];
#pragma unroll
        for (int k = 0; k < NBR; ++k) { const int R = R0 + k * NGW < NR ? R0 + k * NGW : R0; int b, j; row_info(R, b, j, rts[k]);
            const float* src = j < CTXL ? p.in[I_CTX] + ((size_t)b * CTXL + j) * DM : p.in[I_X] + ((size_t)b * SEQ + (j - CTXL)) * DM; ld_row(src, F.lane, v[k]); }
#pragma unroll
        for (int k = 0; k < NBR; ++k) { const int R = R0 + k * NGW; const float rstd = row_rstd(v[k]); apply_mod(v[k], rstd, ms, rts[k], F.lane); if (R < NR) st_row_bf16(H + (size_t)R * DM, F.lane, v[k]); } }
    __syncthreads();
}
__device__ __forceinline__ void p_norm2_router(const Ctx& F, const Params& p, int l, bool with_ctx) {
    const float* mod = (const float*)(p.ws + WS_MOD); bf16_t* H = (bf16_t*)(p.ws + WS_H); const bf16_t* X = (const bf16_t*)(p.ws + WS_X); float* aff = (float*)(p.ws + WS_AFF);
    LAS float* wr = (LAS float*)F.lds;
    LAS float* ms = wr + DM * NE;
    for (int i = F.tid; i < DM * NE / 4; i += 512) { const int c = i >> 2, q = i & 3; ((LAS f32x4*)wr)[q * DM + (c & 3) * 256 + (c >> 2)] = ((const f32x4*)(p.in[I_ROUTER] + (size_t)l * DM * NE))[i]; }
    stage_mod(F, ms, mod + (size_t)l * 3 * 6144, p.in[I_NFFNG] + l * DM, 4, 3);
    __syncthreads();
    const int gw = F.vcu * NWAVES + F.wave, NGW = F.G * NWAVES; const int hi5 = (F.lane >> 5) & 1, hi4 = (F.lane >> 4) & 1, hi3 = (F.lane >> 3) & 1, hi2 = (F.lane >> 2) & 1;
    const int nrows = with_ctx ? NR : NLAT;
    for (int r0 = gw; r0 < nrows; r0 += NBR * NGW) {
        f32x4 v[NBR][4]; int Rs[NBR], bs[NBR], js[NBR], rts[NBR]; bool ok[NBR];
#pragma unroll
        for (int k = 0; k < NBR; ++k) { int r = r0 + k * NGW; ok[k] = r < nrows; if (!ok[k]) r = r0; Rs[k] = with_ctx ? r : (r / SEQ) * LR + CTXL + (r % SEQ); row_info(Rs[k], bs[k], js[k], rts[k]);
            ld_row_bf(X + (size_t)Rs[k] * DM, F.lane, v[k]); }
#pragma unroll
        for (int k = 0; k < NBR; ++k) { const float rstd = row_rstd(v[k]); apply_mod(v[k], rstd, ms, rts[k], F.lane); if (ok[k]) st_row_bf16(H + (size_t)Rs[k] * DM, F.lane, v[k]);
            asm volatile("" : "+v"(v[k][0]), "+v"(v[k][1]), "+v"(v[k][2]), "+v"(v[k][3]) :: "memory"); __builtin_amdgcn_sched_barrier(0); }
#pragma unroll
        for (int k = 0; k < NBR; ++k) {
            float a[16];
#pragma unroll
            for (int e = 0; e < 16; ++e) a[e] = 0.f;
#pragma unroll
            for (int jj = 0; jj < 4; ++jj)
#pragma unroll
                for (int i = 0; i < 4; ++i) { const float hv = v[k][jj][i];
#pragma unroll
                    for (int q = 0; q < 4; ++q) { const f32x4 w = ((const LAS f32x4*)wr)[q * DM + i * 256 + 64 * jj + F.lane]; a[4 * q] += hv * w[0]; a[4 * q + 1] += hv * w[1]; a[4 * q + 2] += hv * w[2]; a[4 * q + 3] += hv * w[3]; }
                    }
            float b8[8], b4[4], b2[2], b1;
#pragma unroll
            for (int i = 0; i < 8; ++i) { const float keep = hi5 ? a[i + 8] : a[i], send = hi5 ? a[i] : a[i + 8]; b8[i] = keep + __shfl_xor(send, 32); }
#pragma unroll
            for (int i = 0; i < 4; ++i) { const float keep = hi4 ? b8[i + 4] : b8[i], send = hi4 ? b8[i] : b8[i + 4]; b4[i] = keep + __shfl_xor(send, 16); }
#pragma unroll
            for (int i = 0; i < 2; ++i) { const float keep = hi3 ? b4[i + 2] : b4[i], send = hi3 ? b4[i] : b4[i + 2]; b2[i] = keep + __shfl_xor(send, 8); }
            { const float keep = hi2 ? b2[1] : b2[0], send = hi2 ? b2[0] : b2[1]; b1 = keep + __shfl_xor(send, 4); }
            b1 += __shfl_xor(b1, 1); b1 += __shfl_xor(b1, 2);
            float mx = b1;
#pragma unroll
            for (int o = 4; o < 64; o <<= 1) mx = fmaxf(mx, __shfl_xor(mx, o));
            const float ex = __expf(b1 - mx); float sm = ex;
#pragma unroll
            for (int o = 4; o < 64; o <<= 1) sm += __shfl_xor(sm, o);
            if ((F.lane & 3) == 0 && ok[k]) aff[((size_t)bs[k] * NE + (F.lane >> 2)) * LR + js[k]] = ex / sm;
            asm volatile("" ::: "memory"); __builtin_amdgcn_sched_barrier(0);
        }
    }
    __syncthreads();
}

__device__ __forceinline__ void p_select(const Ctx& F, const Params& p, bool with_ctx) {
    const float* aff = (const float*)(p.ws + WS_AFF); int* inv = (int*)(p.ws + WS_INV); float* gate = (float*)(p.ws + WS_GATE);
    const bf16_t* H = (const bf16_t*)(p.ws + WS_H); bf16_t* XS = (bf16_t*)(p.ws + WS_XS);
    LAS unsigned* hist = (LAS unsigned*)F.lds;
    LAS unsigned* misc = hist + 256;
    LAS unsigned* list = hist + 512;
    LAS unsigned* vals = hist + 512 + 2048;
    if (with_ctx && (int)blockIdx.x >= F.G - 32) {
        const int prob = (int)blockIdx.x - (F.G - 32), b = prob >> 4, e = prob & 15; const float* av = aff + ((size_t)b * NE + e) * LR;
        if (F.tid < CTXL) vals[F.tid] = __float_as_uint(av[F.tid]);
        __syncthreads();
        if (F.tid < CTXL) { const unsigned mine = vals[F.tid]; int rank = 0;
#pragma unroll 16
            for (int j = 0; j < CTXL; ++j) { const unsigned o = vals[j]; rank += (o > mine || (o == mine && j < F.tid)) ? 1 : 0; }
            const int R = b * LR + F.tid; int er = -1;
            if (rank < 32) { er = 2048 + b * 32 + rank; gate[e * EROWS + er] = __uint_as_float(mine); list[2 * rank] = (unsigned)R; list[2 * rank + 1] = (unsigned)er; }
            inv[(size_t)R * NE + e] = er; }
        __syncthreads();
        for (int i0 = F.wave * 4; i0 < 32; i0 += NWAVES * 4) {
            u32x4 v0[4], v1[4]; unsigned er4[4];
#pragma unroll
            for (int k = 0; k < 4; ++k) { const int i = i0 + k; const unsigned R = list[2 * i]; er4[k] = list[2 * i + 1]; const u32x4* sp = (const u32x4*)(H + (size_t)R * DM); v0[k] = sp[2 * F.lane]; v1[k] = sp[2 * F.lane + 1]; }
#pragma unroll
            for (int k = 0; k < 4; ++k) { u32x4* d = (u32x4*)((unsigned char*)XS + ((size_t)e * EROWS + er4[k]) * DM); u32x4 o;
                o.x = f2fp8x4(bflo(v0[k].x), bfhi(v0[k].x), bflo(v0[k].y), bfhi(v0[k].y)); o.y = f2fp8x4(bflo(v0[k].z), bfhi(v0[k].z), bflo(v0[k].w), bfhi(v0[k].w));
                o.z = f2fp8x4(bflo(v1[k].x), bfhi(v1[k].x), bflo(v1[k].y), bfhi(v1[k].y)); o.w = f2fp8x4(bflo(v1[k].z), bfhi(v1[k].z), bflo(v1[k].w), bfhi(v1[k].w));
                d[F.lane] = o; }
        }
        __syncthreads();
    }
    const int nitems = 256;
    for (int item = blockIdx.x; item < nitems; item += F.G) {
        const bool isl = item < 256; const int prob = isl ? item >> 3 : item - 256, seg = isl ? item & 7 : 0, b = prob >> 4, e = prob & 15;
        const int n = isl ? SEQ : CTXL, kcap = isl ? 1024 : 32, j0 = isl ? CTXL : 0, nj = isl ? 16 : 1;
        const float* av = aff + ((size_t)b * NE + e) * LR + j0;
        { unsigned tmp[16];
#pragma unroll
          for (int jj = 0; jj < 16; ++jj) { const int tok = F.tid + 512 * jj; tmp[jj] = tok < n ? __float_as_uint(av[tok]) : 0u; }
#pragma unroll
          for (int jj = 0; jj < 16; ++jj) vals[F.tid + 512 * jj] = tmp[jj]; }
        unsigned prefix = 0u, mask = 0u, kk = (unsigned)kcap;
#pragma unroll 1
        for (int pass = 0; pass < 4; ++pass) { const int shift = 24 - 8 * pass;
            if (F.tid < 256) hist[F.tid] = 0u;
            __syncthreads();
#pragma unroll 1
            for (int jj = 0; jj < nj; ++jj) { const unsigned bt = vals[F.tid + 512 * jj]; if ((bt & mask) == prefix && bt != 0u) atomicAdd((unsigned*)(hist + ((bt >> shift) & 255u)), 1u); }
            __syncthreads();
            if (F.wave == 0) {
                unsigned loc[4], tot = 0u;
#pragma unroll
                for (int q = 0; q < 4; ++q) { loc[q] = hist[255 - 4 * F.lane - q]; tot += loc[q]; }
                unsigned inc = tot;
#pragma unroll
                for (int o = 1; o < 64; o <<= 1) { const unsigned t2 = __shfl_up(inc, o); if (F.lane >= o) inc += t2; }
                unsigned run = inc - tot;
#pragma unroll
                for (int q = 0; q < 4; ++q) { if (run < kk && run + loc[q] >= kk) { misc[0] = (unsigned)(255 - 4 * F.lane - q); misc[1] = kk - run; } run += loc[q]; }
            }
            __syncthreads();
            prefix |= misc[0] << shift; mask |= 0xffu << shift; kk = misc[1];
            __syncthreads();
        }
        const unsigned T = prefix, need_eq = kk, cnt_gt = (unsigned)kcap - need_eq;
        unsigned cnt = 0u;
#pragma unroll 1
        for (int jj = 0; jj < nj; ++jj) { const unsigned bt = vals[F.tid + 512 * jj]; cnt += (bt > T ? 1u : 0u) + (bt == T ? 0x10000u : 0u); }
        unsigned inc = cnt;
#pragma unroll
        for (int o = 1; o < 64; o <<= 1) { const unsigned t2 = __shfl_up(inc, o); if (F.lane >= o) inc += t2; }
        if (F.lane == 63) misc[8 + F.wave] = inc;
        if (F.tid == 0) misc[2] = 0u;
        __syncthreads();
        unsigned base = inc - cnt;
        for (int w = 0; w < F.wave; ++w) base += misc[8 + w];
        unsigned rg = base & 0xffffu, re = base >> 16;
#pragma unroll 1
        for (int jj = 0; jj < nj; ++jj) { const int tok = F.tid + 512 * jj; const unsigned bt = vals[tok]; const bool own = isl ? ((jj >> 1) == seg) : true;
            const bool isgt = bt > T, iseq = bt == T; int slot = -1;
            if (isgt) { slot = (int)rg; } else if (iseq && re < need_eq) { slot = (int)(cnt_gt + re); }
            rg += isgt ? 1u : 0u; re += iseq ? 1u : 0u;
            if (own && tok < n) { const int R = b * LR + j0 + tok; int er = -1;
                if (slot >= 0) { er = isl ? b * 1024 + slot : 2048 + b * 32 + slot; gate[e * EROWS + er] = __uint_as_float(bt);
                    const unsigned pos = atomicAdd((unsigned*)(misc + 2), 1u); list[2 * pos] = (unsigned)R; list[2 * pos + 1] = (unsigned)er; }
                inv[(size_t)R * NE + e] = er; } }
        __syncthreads();
        const int nl = (int)misc[2];
        for (int i0 = F.wave * 4; i0 < nl; i0 += NWAVES * 4) {
            u32x4 v0[4], v1[4]; unsigned er4[4];
#pragma unroll
            for (int k = 0; k < 4; ++k) { const int i = i0 + k < nl ? i0 + k : nl - 1; const unsigned R = list[2 * i]; er4[k] = list[2 * i + 1];
                const u32x4* sp = (const u32x4*)(H + (size_t)R * DM); v0[k] = sp[2 * F.lane]; v1[k] = sp[2 * F.lane + 1]; }
#pragma unroll
            for (int k = 0; k < 4; ++k) { if (i0 + k < nl) { u32x4* d = (u32x4*)((unsigned char*)XS + ((size_t)e * EROWS + er4[k]) * DM); u32x4 o;
                o.x = f2fp8x4(bflo(v0[k].x), bfhi(v0[k].x), bflo(v0[k].y), bfhi(v0[k].y)); o.y = f2fp8x4(bflo(v0[k].z), bfhi(v0[k].z), bflo(v0[k].w), bfhi(v0[k].w));
                o.z = f2fp8x4(bflo(v1[k].x), bfhi(v1[k].x), bflo(v1[k].y), bfhi(v1[k].y)); o.w = f2fp8x4(bflo(v1[k].z), bfhi(v1[k].z), bflo(v1[k].w), bfhi(v1[k].w));
                d[F.lane] = o; } }
        }
        __syncthreads();
    }
}

__device__ __forceinline__ void p_combine(const Ctx& F, const Params& p, int l, bool final_) {
    const float* mod = (const float*)(p.ws + WS_MOD); bf16_t* H = (bf16_t*)(p.ws + WS_H); bf16_t* X = (bf16_t*)(p.ws + WS_X); const int* inv = (const int*)(p.ws + WS_INV);
    const unsigned char* YB = p.ws + WS_XS;
    LAS float* ms = (LAS float*)F.lds;
    LAS float* g2s = ms + 6 * DM;
    if (final_) { for (int i = F.tid; i < DM; i += 512) ms[i] = p.in[I_FINALG][i]; }
    else stage_mod(F, ms, mod + (size_t)(l + 1) * 3 * 6144, p.in[I_NMIXG] + (l + 1) * DM, 1, 0);
    { float gq[6];
#pragma unroll
      for (int q = 0; q < 6; ++q) { const int i = F.tid + 512 * q; gq[q] = mod[(size_t)(l * 3 + (i >> 10)) * 6144 + 5 * DM + (i & 1023)]; }
#pragma unroll
      for (int q = 0; q < 6; ++q) g2s[F.tid + 512 * q] = gq[q]; }
    __syncthreads();
    const int gw = F.vcu * NWAVES + F.wave, NGW = F.G * NWAVES;
    constexpr int NB2 = 2, NS = 4;
    const int nrows = final_ ? NLAT : NR;
    for (int r0 = gw; r0 < nrows; r0 += NB2 * NGW) {
        f32x4 v[NB2][4]; int myinv[NB2]; unsigned long long msk[NB2]; int Rs[NB2], bs[NB2], js[NB2], rts[NB2]; bool ok[NB2];
#pragma unroll
        for (int k = 0; k < NB2; ++k) { int r = r0 + k * NGW; ok[k] = r < nrows; if (!ok[k]) r = r0; Rs[k] = final_ ? (r / SEQ) * LR + CTXL + (r % SEQ) : r; row_info(Rs[k], bs[k], js[k], rts[k]);
            myinv[k] = F.lane < NE ? inv[(size_t)Rs[k] * NE + F.lane] : -1; ld_row_bf(X + (size_t)Rs[k] * DM, F.lane, v[k]); }
        unsigned w[NB2][NS][4]; float wt[NB2][NS];
#pragma unroll
        for (int k = 0; k < NB2; ++k) { msk[k] = __ballot(myinv[k] >= 0);
#pragma unroll
            for (int sidx = 0; sidx < NS; ++sidx) { const unsigned char* yr = YB; wt[k][sidx] = 0.f;
                if (msk[k]) { const int e = __builtin_ctzll(msk[k]); msk[k] &= msk[k] - 1; const int er = __builtin_amdgcn_readlane(myinv[k], e); yr = YB + ((size_t)e * EROWS + er) * DM; wt[k][sidx] = 1.f; }
#pragma unroll
                for (int jj = 0; jj < 4; ++jj) w[k][sidx][jj] = *(const unsigned*)(yr + 4 * F.lane + 256 * jj); } }
#pragma unroll
        for (int k = 0; k < NB2; ++k) {
            f32x4 mo[4];
#pragma unroll
            for (int jj = 0; jj < 4; ++jj) mo[jj] = (f32x4){0.f, 0.f, 0.f, 0.f};
#pragma unroll
            for (int sidx = 0; sidx < NS; ++sidx)
#pragma unroll
                for (int jj = 0; jj < 4; ++jj) { const int ww = (int)w[k][sidx][jj]; const float t = wt[k][sidx] * YB_INV;
                    mo[jj][0] += t * __builtin_amdgcn_cvt_f32_fp8(ww, 0); mo[jj][1] += t * __builtin_amdgcn_cvt_f32_fp8(ww, 1); mo[jj][2] += t * __builtin_amdgcn_cvt_f32_fp8(ww, 2); mo[jj][3] += t * __builtin_amdgcn_cvt_f32_fp8(ww, 3); }
            while (msk[k]) { const int e = __builtin_ctzll(msk[k]); msk[k] &= msk[k] - 1; const int er = __builtin_amdgcn_readlane(myinv[k], e); const unsigned char* yr = YB + ((size_t)e * EROWS + er) * DM;
#pragma unroll
                for (int jj = 0; jj < 4; ++jj) { const int ww = *(const int*)(yr + 4 * F.lane + 256 * jj);
                    mo[jj][0] += YB_INV * __builtin_amdgcn_cvt_f32_fp8(ww, 0); mo[jj][1] += YB_INV * __builtin_amdgcn_cvt_f32_fp8(ww, 1); mo[jj][2] += YB_INV * __builtin_amdgcn_cvt_f32_fp8(ww, 2); mo[jj][3] += YB_INV * __builtin_amdgcn_cvt_f32_fp8(ww, 3); } }
#pragma unroll
            for (int jj = 0; jj < 4; ++jj) v[k][jj] = v[k][jj] + *(const LAS f32x4*)(g2s + rts[k] * DM + 4 * F.lane + 256 * jj) * mo[jj];
            const float rstd = row_rstd(v[k]);
            if (!ok[k]) continue;
            if (final_) { float* o = p.out + ((size_t)bs[k] * SEQ + (js[k] - CTXL)) * DM;
#pragma unroll
                for (int jj = 0; jj < 4; ++jj) { const int c = 4 * F.lane + 256 * jj; __builtin_nontemporal_store(v[k][jj] * rstd * *(const LAS f32x4*)(ms + c), (f32x4*)(o + c)); } }
            else {
#pragma unroll
                for (int jj = 0; jj < 4; ++jj) *(u32x2*)(X + (size_t)Rs[k] * DM + 4 * F.lane + 256 * jj) = pk4(v[k][jj]);
                apply_mod(v[k], rstd, ms, rts[k], F.lane); st_row_bf16(H + (size_t)Rs[k] * DM, F.lane, v[k]); }
        }
    }
    __syncthreads();
}

__device__ __forceinline__ void p_lru(const Ctx& F, const Params& p, bool full) {
    const bf16_t* Z = (const bf16_t*)(p.ws + WS_ACT + ACT_Z); bf16_t* YC = (bf16_t*)(p.ws + WS_ACT + ACT_YCAT); const bf16_t* LW = (const bf16_t*)(p.ws + WS_LRUW);
    f32x2* SUM = (f32x2*)(p.ws + WS_SUM);
    LAS float* recS = (LAS float*)F.lds;
    LAS float* xcF = recS + 67 * 64;
    LAS float* aS = xcF + 64 * 64;
    LAS float* uS = aS + 2 * 64 * 64;
    LAS float* cst = uS + 2 * 64 * 64;
    LAS bf16_t* xcB = (LAS bf16_t*)(cst + 1024 + 128);
    const int wave = F.wave, lane = F.lane, tid = F.tid;
    const int nitems = NTILE64 * 8;
    const int sr = tid >> 3, sc8 = tid & 7; const int hrr = (tid >> 3) == 0 ? -2 : ((tid >> 3) == 1 ? -1 : 64);
    const int gd = wave >> 2, gmf = wave & 3, gfr = lane & 15, gfq = lane >> 4;
    bf16x8 bw[2][4][2]; float cba[4], cbx[4], ccA[4];
    LAS float* cwS = (LAS float*)(xcB + 64 * 72);
    {   const int h = (int)blockIdx.x & 7;
#pragma unroll
        for (int g2 = 0; g2 < 2; ++g2)
#pragma unroll
            for (int nf = 0; nf < 4; ++nf)
#pragma unroll
                for (int ks = 0; ks < 2; ++ks) bw[g2][nf][ks] = *(const bf16x8*)(LW + ((size_t)(((gd * 2 + g2) * 8 + h) * 64 + 16 * nf + gfr)) * 64 + 32 * ks + 8 * gfq);
#pragma unroll
        for (int nf = 0; nf < 4; ++nf) { const int gch = gd * 512 + h * 64 + 16 * nf + gfr; cba[nf] = p.in[I_LRUBA][gch]; cbx[nf] = p.in[I_LRUBX][gch];
            ccA[nf] = -8.0f * 1.4426950408889634f * log1pf(__expf(-p.in[I_LRULAM][gch])); }
        if (tid < 256) cwS[tid] = p.in[I_CONVW][(tid >> 6) * 512 + h * 64 + (tid & 63)]; else if (tid < 320) cwS[tid] = p.in[I_CONVB][h * 64 + (tid - 256)];
        __syncthreads(); }
    u32x4 wrec = (u32x4){0u, 0u, 0u, 0u}, whalo = (u32x4){0u, 0u, 0u, 0u};
    auto tile_geom = [&](int item, int& T, int& h, int& b, int& jt, int& R0) { T = item >> 3; h = item & 7; b = T / 132; jt = T % 132; R0 = b * LR + jt * 64; };
    auto issue_rec = [&](int item) { int T, h, b, jt, R0; tile_geom(item, T, h, b, jt, R0); const bool isctx = jt < 4; const int slo = isctx ? 0 : CTXL, shi = isctx ? CTXL : LR;
        wrec = *(const u32x4*)(Z + (size_t)(R0 + sr) * 2048 + 512 + h * 64 + sc8 * 8);
        whalo = (u32x4){0u, 0u, 0u, 0u};
        if (tid < 24) { const int jj = jt * 64 + hrr; if (jj >= slo && jj < shi) whalo = *(const u32x4*)(Z + (size_t)(R0 + hrr) * 2048 + 512 + h * 64 + sc8 * 8); } };
    if ((int)blockIdx.x < nitems) issue_rec(blockIdx.x);
    for (int item = blockIdx.x; item < nitems; item += F.G) {
        int T, h, b, jt, R0; tile_geom(item, T, h, b, jt, R0); const bool isctx = jt < 4;
        u32x4 wgate = (u32x4){0u, 0u, 0u, 0u};
        if (full) wgate = *(const u32x4*)(Z + (size_t)(R0 + sr) * 2048 + h * 64 + sc8 * 8);
        { LAS float* d = recS + (sr + 2) * 64 + sc8 * 8; const u32x4 w = wrec;
          d[0] = bflo(w.x); d[1] = bfhi(w.x); d[2] = bflo(w.y); d[3] = bfhi(w.y); d[4] = bflo(w.z); d[5] = bfhi(w.z); d[6] = bflo(w.w); d[7] = bfhi(w.w);
          if (tid < 24) { LAS float* d2 = recS + (hrr + 2) * 64 + sc8 * 8; const u32x4 w2 = whalo;
              d2[0] = bflo(w2.x); d2[1] = bfhi(w2.x); d2[2] = bflo(w2.y); d2[3] = bfhi(w2.y); d2[4] = bflo(w2.z); d2[5] = bfhi(w2.z); d2[6] = bflo(w2.w); d2[7] = bfhi(w2.w); } }
        if (item + F.G < nitems) issue_rec(item + F.G);
        __syncthreads();
        { const int r = sr, c8 = sc8 * 8;
          float y[8];
#pragma unroll
          for (int i = 0; i < 8; ++i) y[i] = cwS[256 + c8 + i];
#pragma unroll
          for (int q = 0; q < 4; ++q) { const f32x4 x0 = *(const LAS f32x4*)(recS + (r + q) * 64 + c8), x1 = *(const LAS f32x4*)(recS + (r + q) * 64 + c8 + 4);
              const f32x4 w0 = *(const LAS f32x4*)(cwS + q * 64 + c8), w1 = *(const LAS f32x4*)(cwS + q * 64 + c8 + 4);
              y[0] += w0[0] * x0[0]; y[1] += w0[1] * x0[1]; y[2] += w0[2] * x0[2]; y[3] += w0[3] * x0[3]; y[4] += w1[0] * x1[0]; y[5] += w1[1] * x1[1]; y[6] += w1[2] * x1[2]; y[7] += w1[3] * x1[3]; }
          *(LAS f32x4*)(xcF + r * 64 + c8) = (f32x4){y[0], y[1], y[2], y[3]}; *(LAS f32x4*)(xcF + r * 64 + c8 + 4) = (f32x4){y[4], y[5], y[6], y[7]};
          u32x4 w; w.x = pk2(y[0], y[1]); w.y = pk2(y[2], y[3]); w.z = pk2(y[4], y[5]); w.w = pk2(y[6], y[7]);
          *(LAS u32x4*)(xcB + r * 72 + c8) = w; }
        __syncthreads();
        { const int d = gd, mf = gmf, fr = gfr, fq = gfq;
          bf16x8 af[2];
#pragma unroll
          for (int ks = 0; ks < 2; ++ks) af[ks] = *(const LAS bf16x8*)(xcB + (16 * mf + fr) * 72 + 32 * ks + 8 * fq);
          f32x4 acc[2][4];
#pragma unroll
          for (int g2 = 0; g2 < 2; ++g2)
#pragma unroll
              for (int nf = 0; nf < 4; ++nf) { acc[g2][nf] = (f32x4){0.f, 0.f, 0.f, 0.f};
#pragma unroll
                  for (int ks = 0; ks < 2; ++ks) acc[g2][nf] = __builtin_amdgcn_mfma_f32_16x16x32_bf16(af[ks], bw[g2][nf][ks], acc[g2][nf], 0, 0, 0); }
#pragma unroll
          for (int nf = 0; nf < 4; ++nf) { const int ch = 16 * nf + fr; const float ba = cba[nf], bx = cbx[nf], cA = ccA[nf];
#pragma unroll
              for (int r = 0; r < 4; ++r) { const int tk = 16 * mf + 4 * fq + r;
                  const float rg = __builtin_amdgcn_rcpf(1.0f + __builtin_amdgcn_exp2f(-1.4426950408889634f * (acc[0][nf][r] + ba)));
                  const float ig = __builtin_amdgcn_rcpf(1.0f + __builtin_amdgcn_exp2f(-1.4426950408889634f * (acc[1][nf][r] + bx)));
                  const float a = __builtin_amdgcn_exp2f(rg * cA), mult = __builtin_amdgcn_sqrtf(fmaf(-a, a, 1.0f));
                  aS[(d * 64 + tk) * 64 + ch] = a; uS[(d * 64 + tk) * 64 + ch] = mult * ig * xcF[tk * 64 + ch]; } } }
        __syncthreads();
        if (full && tid < 128) cst[1024 + tid] = ((const float*)(p.ws + WS_CAR))[((size_t)T * 2 + (tid >> 6)) * 512 + h * 64 + (tid & 63)];
        {
            const int dc = tid & 127, d = dc >> 6, ch = dc & 63, sg = tid >> 7;
            const LAS float* ap = aS + d * 4096 + ch; LAS float* up = uS + d * 4096 + ch;
            const int tfirst = d == 0 ? 16 * sg : 63 - 16 * sg, tstep_ = d == 0 ? 64 : -64;
            float av[16], uv[16];
#pragma unroll
            for (int i = 0; i < 16; ++i) { av[i] = ap[tfirst * 64 + i * tstep_]; uv[i] = up[tfirst * 64 + i * tstep_]; }
            float P = 1.f, hs = 0.f;
#pragma unroll
            for (int i = 0; i < 16; ++i) { hs = av[i] * hs + uv[i]; P *= av[i]; uv[i] = hs; }
            asm volatile("" ::: "memory");
            __syncthreads();
            cst[(sg * 128 + dc) * 2] = P; cst[(sg * 128 + dc) * 2 + 1] = hs;
            __syncthreads();
            float cin = full ? cst[1024 + dc] : 0.f;
            float Pt = 1.f;
#pragma unroll
            for (int q = 0; q < 4; ++q) { const float Pq = cst[(q * 128 + dc) * 2], Hq = cst[(q * 128 + dc) * 2 + 1];
                if (q < sg) cin = Pq * cin + Hq;
                Pt *= Pq; }
            if (!full) { if (sg == 3) SUM[((size_t)T * 2 + d) * 512 + h * 64 + ch] = (f32x2){Pt, cst[(3 * 128 + dc) * 2 + 1] + cst[(3 * 128 + dc) * 2] * cin}; }
            else { float pp = cin;
#pragma unroll
                for (int i = 0; i < 16; ++i) { pp *= ap[tfirst * 64 + i * tstep_]; up[tfirst * 64 + i * tstep_] = uv[i] + pp; } }
        }
        __syncthreads();
        if (full) { const int r = sr, c8 = sc8 * 8; const u32x4 gw_ = wgate;
            float gg[8] = {bflo(gw_.x), bfhi(gw_.x), bflo(gw_.y), bfhi(gw_.y), bflo(gw_.z), bfhi(gw_.z), bflo(gw_.w), bfhi(gw_.w)}; float y[8];
            const f32x4 f0 = *(const LAS f32x4*)(uS + r * 64 + c8), f1 = *(const LAS f32x4*)(uS + r * 64 + c8 + 4), b0 = *(const LAS f32x4*)(uS + (64 + r) * 64 + c8), b1 = *(const LAS f32x4*)(uS + (64 + r) * 64 + c8 + 4);
            y[0] = gg[0] * (f0[0] + b0[0]); y[1] = gg[1] * (f0[1] + b0[1]); y[2] = gg[2] * (f0[2] + b0[2]); y[3] = gg[3] * (f0[3] + b0[3]);
            y[4] = gg[4] * (f1[0] + b1[0]); y[5] = gg[5] * (f1[1] + b1[1]); y[6] = gg[6] * (f1[2] + b1[2]); y[7] = gg[7] * (f1[3] + b1[3]);
            u32x4 w; w.x = pk2(y[0], y[1]); w.y = pk2(y[2], y[3]); w.z = pk2(y[4], y[5]); w.w = pk2(y[6], y[7]);
            *(u32x4*)(YC + (size_t)(R0 + r) * DM + h * 64 + c8) = w; }
        __syncthreads();
    }
}

__device__ __forceinline__ void p_lru_carry(const Ctx& F, const Params& p) {
    const f32x2* SUM = (const f32x2*)(p.ws + WS_SUM); float* CAR = (float*)(p.ws + WS_CAR);
    const int task = (int)blockIdx.x - (F.G - 4);
    if (task < 0) return;
    const int tk = task * NWAVES + F.wave, b = tk >> 4, d = (tk >> 3) & 1, h = tk & 7, ch = h * 64 + F.lane;
    float st = 0.f;
    for (int i0 = 0; i0 < 132; i0 += 33) {
        f32x2 sv[33];
#pragma unroll
        for (int k = 0; k < 33; ++k) { const int i = i0 + k; const int jp = d == 0 ? i : (i < 4 ? 3 - i : 135 - i); sv[k] = SUM[((size_t)(b * 132 + jp) * 2 + d) * 512 + ch]; }
#pragma unroll
        for (int k = 0; k < 33; ++k) { const int i = i0 + k; const int jp = d == 0 ? i : (i < 4 ? 3 - i : 135 - i);
            CAR[((size_t)(b * 132 + jp) * 2 + d) * 512 + ch] = st; st = sv[k].x * st + sv[k].y; }
    }
}

__device__ __forceinline__ void p_cm(const Ctx& F, const Params& p) {
    const int GB = F.G - 8;
    if ((int)blockIdx.x >= GB) return;
    const bf16_t* Z = (const bf16_t*)(p.ws + WS_ACT + ACT_Z); bf16_t* YC = (bf16_t*)(p.ws + WS_ACT + ACT_YCAT); const bf16_t* CW = (const bf16_t*)(p.ws + WS_CMWS);
    LAS bf16_t* vnT = (LAS bf16_t*)F.lds;
    LAS float* mix = (LAS float*)(F.lds + 32768);
    const int wave = F.wave, lane = F.lane, tid = F.tid, fr = lane & 15, fq = lane >> 4;
    const int nitems = (NR / 128) * 8; const int q = tid >> 2, part = tid & 3;
    bf16x8 afr[4]; float bsr[4]; float vgr[16];
    {   const int g = (int)blockIdx.x & 7;
#pragma unroll
        for (int ks = 0; ks < 4; ++ks) afr[ks] = *(const bf16x8*)(CW + ((size_t)g * 128 + 16 * wave + fr) * 128 + 32 * ks + 8 * fq);
#pragma unroll
        for (int r = 0; r < 4; ++r) bsr[r] = p.in[I_CMBS][g * 128 + 16 * wave + 4 * fq + r];
#pragma unroll
        for (int i = 0; i < 16; ++i) vgr[i] = p.in[I_CMVG][g * 64 + part * 16 + i]; }
    u32x4 wv0 = (u32x4){0u, 0u, 0u, 0u}, wv1 = wv0;
    auto issue_v = [&](int item) { const int cn = item >> 3, g = item & 7; const bf16_t* src = Z + (size_t)(cn * 128 + q) * 2048 + 1536 + g * 64 + part * 16; wv0 = *(const u32x4*)src; wv1 = *(const u32x4*)(src + 8); };
    if ((int)blockIdx.x < nitems) issue_v(blockIdx.x);
    for (int item = blockIdx.x; item < nitems; item += GB) {
        const int cn = item >> 3, g = item & 7; const int R0 = cn * 128;
        const bf16_t* usrc = Z + (size_t)(R0 + q) * 2048 + 1024 + g * 64 + part * 16; const u32x4 wu0 = *(const u32x4*)usrc, wu1 = *(const u32x4*)(usrc + 8);
        { const u32x4 w0 = wv0, w1 = wv1;
          float v[16] = {bflo(w0.x), bfhi(w0.x), bflo(w0.y), bfhi(w0.y), bflo(w0.z), bfhi(w0.z), bflo(w0.w), bfhi(w0.w), bflo(w1.x), bfhi(w1.x), bflo(w1.y), bfhi(w1.y), bflo(w1.z), bfhi(w1.z), bflo(w1.w), bfhi(w1.w)};
          float ss = 0.f;
#pragma unroll
          for (int i = 0; i < 16; ++i) ss += v[i] * v[i];
          ss += __shfl_xor(ss, 1); ss += __shfl_xor(ss, 2);
          const float rstd = 1.0f / sqrtf(ss * (1.0f / 64.0f) + EPS);
#pragma unroll
          for (int i = 0; i < 16; ++i) vnT[(part * 16 + i) * 136 + q] = (bf16_t)f2bf(v[i] * rstd * vgr[i]); }
        if (item + GB < nitems) issue_v(item + GB);
        __syncthreads();
        f32x4 acc[4];
#pragma unroll
        for (int nf = 0; nf < 4; ++nf) acc[nf] = (f32x4){0.f, 0.f, 0.f, 0.f};
#pragma unroll
        for (int ks = 0; ks < 4; ++ks)
#pragma unroll
            for (int nf = 0; nf < 4; ++nf) { const bf16x8 bfr = *(const LAS bf16x8*)(vnT + (16 * nf + fr) * 136 + 32 * ks + 8 * fq);
                acc[nf] = __builtin_amdgcn_mfma_f32_16x16x32_bf16(afr[ks], bfr, acc[nf], 0, 0, 0); }
#pragma unroll
        for (int r = 0; r < 4; ++r) { const int pp = 16 * wave + 4 * fq + r;
#pragma unroll
            for (int nf = 0; nf < 4; ++nf) mix[pp * 68 + 16 * nf + fr] = acc[nf][r] + bsr[r]; }
        __syncthreads();
        { float ug[16] = {bflo(wu0.x), bfhi(wu0.x), bflo(wu0.y), bfhi(wu0.y), bflo(wu0.z), bfhi(wu0.z), bflo(wu0.w), bfhi(wu0.w), bflo(wu1.x), bfhi(wu1.x), bflo(wu1.y), bfhi(wu1.y), bflo(wu1.z), bfhi(wu1.z), bflo(wu1.w), bfhi(wu1.w)};
          const LAS float* mr = mix + q * 68 + part * 16; float y[16];
#pragma unroll
          for (int i = 0; i < 16; i += 4) { const f32x4 mv = *(const LAS f32x4*)(mr + i); y[i] = ug[i] * mv[0]; y[i + 1] = ug[i + 1] * mv[1]; y[i + 2] = ug[i + 2] * mv[2]; y[i + 3] = ug[i + 3] * mv[3]; }
          u32x4 o0, o1; o0.x = pk2(y[0], y[1]); o0.y = pk2(y[2], y[3]); o0.z = pk2(y[4], y[5]); o0.w = pk2(y[6], y[7]); o1.x = pk2(y[8], y[9]); o1.y = pk2(y[10], y[11]); o1.z = pk2(y[12], y[13]); o1.w = pk2(y[14], y[15]);
          bf16_t* dst = YC + (size_t)(R0 + q) * DM + 512 + g * 64 + part * 16; *(u32x4*)dst = o0; *(u32x4*)(dst + 8) = o1; }
        __syncthreads();
    }
}

__device__ __forceinline__ void sg_tile(const bf16_t* A, size_t lda, const bf16_t* Bt, size_t ldb, int K, int lane, f32x4 (&acc)[4][2]) {
    const int fr = lane & 15, fq = lane >> 4;
#pragma unroll
    for (int m = 0; m < 4; ++m)
#pragma unroll
        for (int n = 0; n < 2; ++n) acc[m][n] = (f32x4){0.f, 0.f, 0.f, 0.f};
    const bf16_t* ap = A + (size_t)fr * lda + 8 * fq; const bf16_t* bp = Bt + (size_t)fr * ldb + 8 * fq;
#pragma unroll 4
    for (int k = 0; k < K; k += 32) {
        bf16x8 af[4], bfr[2];
#pragma unroll
        for (int m = 0; m < 4; ++m) af[m] = *(const bf16x8*)(ap + (size_t)(16 * m) * lda + k);
#pragma unroll
        for (int n = 0; n < 2; ++n) bfr[n] = *(const bf16x8*)(bp + (size_t)(16 * n) * ldb + k);
#pragma unroll
        for (int m = 0; m < 4; ++m)
#pragma unroll
            for (int n = 0; n < 2; ++n) acc[m][n] = __builtin_amdgcn_mfma_f32_16x16x32_bf16(bfr[n], af[m], acc[m][n], 0, 0, 0);
    }
}
__device__ __forceinline__ size_t ctx_row0(int rt8) { return (size_t)(rt8 >> 2) * LR + (size_t)(rt8 & 3) * 64; }
__device__ __forceinline__ void sg_block64(const Ctx& F, const bf16_t* A, size_t lda, const bf16_t* Bt, size_t ldb, int K, f32x4 (&out)[2]) {
    const int kw = K / NWAVES, fr = F.lane & 15, fq = F.lane >> 4;
    f32x4 acc[4][4];
#pragma unroll
    for (int m = 0; m < 4; ++m)
#pragma unroll
        for (int n = 0; n < 4; ++n) acc[m][n] = (f32x4){0.f, 0.f, 0.f, 0.f};
    const bf16_t* ap = A + (size_t)fr * lda + F.wave * kw + 8 * fq; const bf16_t* bp = Bt + (size_t)fr * ldb + F.wave * kw + 8 * fq;
#pragma unroll 4
    for (int k = 0; k < kw; k += 32) {
        bf16x8 af[4], bfr[4];
#pragma unroll
        for (int m = 0; m < 4; ++m) af[m] = *(const bf16x8*)(ap + (size_t)(16 * m) * lda + k);
#pragma unroll
        for (int n = 0; n < 4; ++n) bfr[n] = *(const bf16x8*)(bp + (size_t)(16 * n) * ldb + k);
#pragma unroll
        for (int m = 0; m < 4; ++m)
#pragma unroll
            for (int n = 0; n < 4; ++n) acc[m][n] = __builtin_amdgcn_mfma_f32_16x16x32_bf16(bfr[n], af[m], acc[m][n], 0, 0, 0);
    }
    LAS float* part = (LAS float*)F.lds;
#pragma unroll
    for (int m = 0; m < 4; ++m)
#pragma unroll
        for (int n = 0; n < 4; ++n) *(LAS f32x4*)(part + ((F.wave * 64 + 16 * m + fr) * 64 + 16 * n + 4 * fq)) = acc[m][n];
    __syncthreads();
    out[0] = (f32x4){0.f, 0.f, 0.f, 0.f}; out[1] = out[0];
#pragma unroll
    for (int w = 0; w < NWAVES; ++w) { out[0] += *(const LAS f32x4*)(part + w * 4096 + F.tid * 8); out[1] += *(const LAS f32x4*)(part + w * 4096 + F.tid * 8 + 4); }
    __syncthreads();
}
__device__ __forceinline__ void p_ctx_dense(const Ctx& F, const Params& p, int which) {
    unsigned char* ws = p.ws; const float* mod = (const float*)(ws + WS_MOD);
    const int ncg = which == 0 ? 32 : (which == 1 ? 16 : 32), nunits = 8 * ncg; const int row = F.tid >> 3, c8 = (F.tid & 7) * 8;
    for (int uidx = F.vcu; uidx < nunits; uidx += F.G) {
        const int rt8 = uidx / ncg, cgp = uidx % ncg; const size_t R0 = ctx_row0(rt8), R = R0 + row; const int c = cgp * 64 + c8; f32x4 v[2];
        if (which == 0) { sg_block64(F, (const bf16_t*)(ws + WS_H) + R0 * DM, DM, (const bf16_t*)(ws + WS_WIN) + (size_t)cgp * 64 * DM, DM, DM, v);
            if (cgp < 8 || cgp >= 16) {
#pragma unroll
                for (int i = 0; i < 4; ++i) { v[0][i] = gelu_tanh(v[0][i]); v[1][i] = gelu_tanh(v[1][i]); } }
            u32x4 w; const u32x2 a = pk4(v[0]), b = pk4(v[1]); w.x = a.x; w.y = a.y; w.z = b.x; w.w = b.y;
            *(u32x4*)((bf16_t*)(ws + WS_ACT + ACT_Z) + R * 2048 + c) = w; }
        else if (which == 1) { sg_block64(F, (const bf16_t*)(ws + WS_ACT + ACT_YCAT) + R0 * DM, DM, (const bf16_t*)(ws + WS_WOUT0) + (size_t)cgp * 64 * DM, DM, DM, v);
            const float* cin = p.in[I_CTX] + ((size_t)(rt8 >> 2) * CTXL + (size_t)(rt8 & 3) * 64 + row) * DM; const float* g1 = mod + 2 * 6144 + 2 * DM;
            const f32x4 o0 = *(const f32x4*)(cin + c) + *(const f32x4*)(g1 + c) * v[0], o1 = *(const f32x4*)(cin + c + 4) + *(const f32x4*)(g1 + c + 4) * v[1];
            u32x4 w; const u32x2 a = pk4(o0), b = pk4(o1); w.x = a.x; w.y = a.y; w.z = b.x; w.w = b.y;
            *(u32x4*)((bf16_t*)(ws + WS_X) + R * DM + c) = w; }
        else { sg_block64(F, (const bf16_t*)(ws + WS_H) + R0 * DM, DM, (const bf16_t*)(ws + WS_WQKV) + (size_t)(1024 + cgp * 64) * DM, DM, DM, v);
            bf16_t* dst = (bf16_t*)(ws + WS_ACT + (cgp < 16 ? ACT_K : ACT_V));
            u32x4 w; const u32x2 a = pk4(v[0]), b = pk4(v[1]); w.x = a.x; w.y = a.y; w.z = b.x; w.w = b.y;
            *(u32x4*)(dst + R * DM + (cgp & 15) * 64 + c8) = w; }
    }
}
__device__ __forceinline__ void p_ctx_moe(const Ctx& F, const Params& p, int which, int layer = 0) {
    unsigned char* ws = p.ws;
    typedef int v8i32 __attribute__((ext_vector_type(8))); typedef float f32x16 __attribute__((ext_vector_type(16)));
    const int l31 = F.lane & 31, hh = F.lane >> 5;
    if (which == 0) {
        LAS unsigned char* As = F.lds;
        for (int uidx = F.vcu; uidx < NE * 16; uidx += F.G) {
            const int e = uidx >> 4, cgp = (uidx & 15) * 8 + F.wave; const size_t er0 = (size_t)e * EROWS + 2048;
            { const u32x4* src = (const u32x4*)(ws + WS_XS + er0 * DM); u32x4 t[8];
#pragma unroll
              for (int i = 0; i < 8; ++i) t[i] = src[F.tid + 512 * i];
#pragma unroll
              for (int i = 0; i < 8; ++i) { const int g = F.tid + 512 * i, r = g >> 6, c = g & 63; *(LAS u32x4*)(As + r * 1024 + 16 * (c ^ (r & 15))) = t[i]; } }
            __syncthreads();
            const unsigned char* bp = ws + WS_W13 + ((size_t)layer * NE * 4096 + (size_t)e * 4096 + (size_t)cgp * 32 + l31) * DM + 32 * hh;
            f32x16 acc[2]; acc[0] = f32x16{}; acc[1] = f32x16{};
#pragma unroll 8
            for (int ks = 0; ks < 16; ++ks) {
                const u32x4 b0 = *(const u32x4*)(bp + 64 * ks), b1 = *(const u32x4*)(bp + 64 * ks + 16); const v8i32 bf = {(int)b0.x, (int)b0.y, (int)b0.z, (int)b0.w, (int)b1.x, (int)b1.y, (int)b1.z, (int)b1.w};
#pragma unroll
                for (int m = 0; m < 2; ++m) { const int r = 32 * m + l31, c0 = 4 * ks + 2 * hh;
                    const u32x4 a0 = *(const LAS u32x4*)(As + r * 1024 + 16 * (c0 ^ (r & 15))), a1 = *(const LAS u32x4*)(As + r * 1024 + 16 * ((c0 + 1) ^ (r & 15)));
                    const v8i32 af = {(int)a0.x, (int)a0.y, (int)a0.z, (int)a0.w, (int)a1.x, (int)a1.y, (int)a1.z, (int)a1.w};
                    acc[m] = __builtin_amdgcn_mfma_scale_f32_32x32x64_f8f6f4(bf, af, acc[m], 0, 0, 0, 0x7f7f7f7f, 0, 0x7f7f7f7f); } }
            unsigned char* HID = ws + WS_ACT + ACT_HID;
#pragma unroll
            for (int m = 0; m < 2; ++m)
#pragma unroll
                for (int q = 0; q < 2; ++q) {
                    float hv[4];
#pragma unroll
                    for (int i = 0; i < 4; ++i) hv[i] = silu_f(acc[m][4 * q + i] * W8_INV) * (acc[m][8 + 4 * q + i] * W8_INV);
                    *(unsigned*)(HID + (er0 + 32 * m + l31) * FF + cgp * 16 + 8 * q + 4 * hh) = f2fp8x4(hv[0], hv[1], hv[2], hv[3]); }
            __syncthreads();
        }
    } else {
        const int row = F.tid >> 3, c8 = (F.tid & 7) * 8; LAS float* part = (LAS float*)F.lds;
        for (int uidx = F.vcu; uidx < NE * 16; uidx += F.G) {
            const int e = uidx >> 4, cgp = uidx & 15; const size_t er0 = (size_t)e * EROWS + 2048;
            const unsigned char* ap = ws + WS_ACT + ACT_HID + (er0 + l31) * FF + F.wave * 256 + 32 * hh;
            const unsigned char* bp = ws + WS_W2 + ((size_t)layer * NE * DM + (size_t)e * DM + (size_t)cgp * 64 + l31) * FF + F.wave * 256 + 32 * hh;
            f32x16 acc[2][2]; acc[0][0] = f32x16{}; acc[0][1] = f32x16{}; acc[1][0] = f32x16{}; acc[1][1] = f32x16{};
#pragma unroll
            for (int k = 0; k < 256; k += 64) {
                v8i32 af[2], bf[2];
#pragma unroll
                for (int m = 0; m < 2; ++m) { const u32x4 a0 = *(const u32x4*)(ap + (size_t)m * 32 * FF + k), a1 = *(const u32x4*)(ap + (size_t)m * 32 * FF + k + 16);
                    af[m] = (v8i32){(int)a0.x, (int)a0.y, (int)a0.z, (int)a0.w, (int)a1.x, (int)a1.y, (int)a1.z, (int)a1.w}; }
#pragma unroll
                for (int n = 0; n < 2; ++n) { const u32x4 b0 = *(const u32x4*)(bp + (size_t)n * 32 * FF + k), b1 = *(const u32x4*)(bp + (size_t)n * 32 * FF + k + 16);
                    bf[n] = (v8i32){(int)b0.x, (int)b0.y, (int)b0.z, (int)b0.w, (int)b1.x, (int)b1.y, (int)b1.z, (int)b1.w}; }
#pragma unroll
                for (int m = 0; m < 2; ++m)
#pragma unroll
                    for (int n = 0; n < 2; ++n) acc[m][n] = __builtin_amdgcn_mfma_scale_f32_32x32x64_f8f6f4(bf[n], af[m], acc[m][n], 0, 0, 0, 0x7f7f7f7f, 0, 0x7f7f7f7f); }
#pragma unroll
            for (int m = 0; m < 2; ++m)
#pragma unroll
                for (int n = 0; n < 2; ++n)
#pragma unroll
                    for (int q = 0; q < 4; ++q) *(LAS f32x4*)(part + ((F.wave * 64 + 32 * m + l31) * 64 + 32 * n + 8 * q + 4 * hh)) = (f32x4){acc[m][n][4 * q], acc[m][n][4 * q + 1], acc[m][n][4 * q + 2], acc[m][n][4 * q + 3]};
            __syncthreads();
            f32x4 v0 = (f32x4){0.f, 0.f, 0.f, 0.f}, v1 = v0;
#pragma unroll
            for (int w = 0; w < NWAVES; ++w) { v0 += *(const LAS f32x4*)(part + w * 4096 + F.tid * 8); v1 += *(const LAS f32x4*)(part + w * 4096 + F.tid * 8 + 4); }
            __syncthreads();
            const float gt = ((const float*)(ws + WS_GATE))[er0 + row] * (W8_INV * YB_SCALE);
            u32x2 w; w.x = f2fp8x4(v0[0] * gt, v0[1] * gt, v0[2] * gt, v0[3] * gt); w.y = f2fp8x4(v1[0] * gt, v1[1] * gt, v1[2] * gt, v1[3] * gt);
            *(u32x2*)(ws + WS_XS + (er0 + row) * DM + cgp * 64 + c8) = w;
        }
    }
}

__device__ __forceinline__ void p_attn(const Ctx& F, const Params& p, unsigned char* lds_generic) {
    using abf = attn_body::bf16;
    const abf* Q = (const abf*)(p.ws + WS_ACT + ACT_Q); const abf* Kb = (const abf*)(p.ws + WS_ACT + ACT_K); const abf* Vb = (const abf*)(p.ws + WS_ACT + ACT_V);
    const bf16_t* O1 = (const bf16_t*)(p.ws + WS_ACT + ACT_O1); const bf16_t* O2 = (const bf16_t*)(p.ws + WS_ACT + ACT_O2); bf16_t* A = (bf16_t*)(p.ws + WS_XS);
    const int wid = F.wave;
    for (int i = 0; i < 4; ++i) { const int bh = (i >> 1) * 8 + (F.vcu >> 5), qb = F.vcu & 31, sub = (i & 1) * 2 + 1;
        const int b = bh >> 3, h = bh & 7, m = i & 1;
        abf* O = (abf*)(p.ws + WS_ACT + (m ? ACT_O2 : ACT_O1));
        const abf* Qw = Q + ((size_t)b * LR + CTXL + qb * 256 + wid * 32) * DM + (h * 2 + m) * 64;
        const abf* Kh = Kb + (size_t)b * LR * DM + (h * 2 + m) * 64;
        const abf* Vh = Vb + (size_t)b * LR * DM + h * 128;
        abf* Ow = O + ((size_t)b * SEQ + qb * 256 + wid * 32) * DM + h * 128;
        attn_body::attn_unit128<8>(Qw, Kh, Vh, Ow, (char*)lds_generic);
        if (sub == 3) {
            asm volatile("s_waitcnt vmcnt(0)" ::: "memory");
            int lane2 = threadIdx.x & 63; asm volatile("" : "+v"(lane2));
            const float lam_init = 0.8f - 0.6f * expf(-0.3f);
            float s1 = p.in[I_LQ1][lane2] * p.in[I_LK1][lane2], s2 = p.in[I_LQ2][lane2] * p.in[I_LK2][lane2];
            s1 = wave_sum(s1); s2 = wave_sum(s2);
            const float lam = expf(s1) - expf(s2) + lam_init, osc = 1.0f - lam_init;
            const size_t row0 = (size_t)b * SEQ + qb * 256 + wid * 32; const int lr = lane2 >> 3, c16 = 16 * (lane2 & 7);
            f32x4 gsub[4];
#pragma unroll
            for (int q = 0; q < 4; ++q) gsub[q] = *(const f32x4*)(p.in[I_SUBLN] + c16 + 4 * q);
            u32x4 xx[4][4];
#pragma unroll
            for (int k = 0; k < 4; ++k) { const size_t r = row0 + 8 * k + lr; const u32x4* a1 = (const u32x4*)(O1 + r * DM + h * 128 + c16); const u32x4* a2 = (const u32x4*)(O2 + r * DM + h * 128 + c16);
                xx[k][0] = a1[0]; xx[k][1] = a1[1]; xx[k][2] = a2[0]; xx[k][3] = a2[1]; }
#pragma unroll
            for (int k = 0; k < 4; ++k) { const size_t r = row0 + 8 * k + lr;
                const u32x4 x0 = xx[k][0], x1 = xx[k][1], y0 = xx[k][2], y1 = xx[k][3];
                float o[16];
                o[0] = bflo(x0.x) - lam * bflo(y0.x); o[1] = bfhi(x0.x) - lam * bfhi(y0.x); o[2] = bflo(x0.y) - lam * bflo(y0.y); o[3] = bfhi(x0.y) - lam * bfhi(y0.y);
                o[4] = bflo(x0.z) - lam * bflo(y0.z); o[5] = bfhi(x0.z) - lam * bfhi(y0.z); o[6] = bflo(x0.w) - lam * bflo(y0.w); o[7] = bfhi(x0.w) - lam * bfhi(y0.w);
                o[8] = bflo(x1.x) - lam * bflo(y1.x); o[9] = bfhi(x1.x) - lam * bfhi(y1.x); o[10] = bflo(x1.y) - lam * bflo(y1.y); o[11] = bfhi(x1.y) - lam * bfhi(y1.y);
                o[12] = bflo(x1.z) - lam * bflo(y1.z); o[13] = bfhi(x1.z) - lam * bfhi(y1.z); o[14] = bflo(x1.w) - lam * bflo(y1.w); o[15] = bfhi(x1.w) - lam * bfhi(y1.w);
                float ss = 0.f;
#pragma unroll
                for (int q = 0; q < 16; ++q) ss += o[q] * o[q];
                ss += __shfl_xor(ss, 1); ss += __shfl_xor(ss, 2); ss += __shfl_xor(ss, 4);
                const float rstd = osc / sqrtf(ss * (1.0f / 128.0f) + EPS);
                u32x4 w0, w1;
                w0.x = pk2(o[0] * rstd * gsub[0][0], o[1] * rstd * gsub[0][1]); w0.y = pk2(o[2] * rstd * gsub[0][2], o[3] * rstd * gsub[0][3]);
                w0.z = pk2(o[4] * rstd * gsub[1][0], o[5] * rstd * gsub[1][1]); w0.w = pk2(o[6] * rstd * gsub[1][2], o[7] * rstd * gsub[1][3]);
                w1.x = pk2(o[8] * rstd * gsub[2][0], o[9] * rstd * gsub[2][1]); w1.y = pk2(o[10] * rstd * gsub[2][2], o[11] * rstd * gsub[2][3]);
                w1.z = pk2(o[12] * rstd * gsub[3][0], o[13] * rstd * gsub[3][1]); w1.w = pk2(o[14] * rstd * gsub[3][2], o[15] * rstd * gsub[3][3]);
                u32x4* d = (u32x4*)(A + r * DM + h * 128 + c16); d[0] = w0; d[1] = w1; }
        }
    }
}

#define XB_TMO      128
#define XB_XCNT(j)  (256  + 64 * (j))
#define XB_XSUB(j)  (1280 + 64 * (j))
#define XB_XGEN(j)  (2304 + 64 * (j))
#define XB_TOP      3328
#define XB_TOPGEN   3392
#define XCD_BAR_WORDS 3456
#define XB_SPIN_CAP (1u << 18)
__device__ __forceinline__ unsigned xb_ld(unsigned* p)              { return __hip_atomic_load(p, __ATOMIC_RELAXED, __HIP_MEMORY_SCOPE_AGENT); }
__device__ __forceinline__ unsigned xb_add(unsigned* p, unsigned v) { return __hip_atomic_fetch_add(p, v, __ATOMIC_RELAXED, __HIP_MEMORY_SCOPE_AGENT); }
__device__ __forceinline__ unsigned xb_xcc_id() { return (unsigned)__builtin_amdgcn_s_getreg((3 << 11) | 20) & 0xFu; }
#define XB_SPIN(cond, bar) do { unsigned _sp = 0; while (cond) { __builtin_amdgcn_s_sleep(1); \
    if ((++_sp & 255u) == 0u) { if (xb_ld(&(bar)[XB_TMO])) break; if (_sp > XB_SPIN_CAP) { atomicAdd(&(bar)[XB_TMO], 1u); break; } } } } while (0)
struct XcdBarrier { unsigned* bar; unsigned x; volatile LAS unsigned* st; };
__device__ __forceinline__ void xcd_barrier_complete(unsigned* bar, unsigned x, unsigned& nloc, unsigned& nx) {
    const unsigned G = gridDim.x * gridDim.y * gridDim.z;
    unsigned sum, cnt, mine, sp = 0u;
    for (;;) {
        sum = 0u; cnt = 0u; mine = 0u;
#pragma unroll
        for (unsigned j = 0; j < 16; ++j) { const unsigned c = xb_ld(&bar[XB_XCNT(j)]); sum += c; cnt += (c > 0u) ? 1u : 0u; mine = (j == x) ? c : mine; }
        if (sum == G) break;
        __builtin_amdgcn_s_sleep(1);
        if ((++sp & 255u) == 0u) { if (xb_ld(&bar[XB_TMO])) break; if (sp > XB_SPIN_CAP) { atomicAdd(&bar[XB_TMO], 1u); break; } }
    }
    nloc = mine > 0u ? mine : 1u; nx = cnt > 0u ? cnt : 1u;
}
__device__ __forceinline__ void xcd_barrier(const XcdBarrier& b) {
    asm volatile("s_waitcnt vmcnt(0)" ::: "memory");
    __syncthreads();
    if (threadIdx.x == 0) {
        unsigned* bar = b.bar;
        __builtin_amdgcn_s_waitcnt(0);
        unsigned nloc = b.st[0], nx = b.st[1];
        if (nloc == 0u) { xcd_barrier_complete(bar, b.x, nloc, nx); b.st[0] = nloc; b.st[1] = nx; }
        const unsigned old = xb_add(&bar[XB_XSUB(b.x)], 1u);
        const unsigned gen = old / nloc;
        if (old + 1u == (gen + 1u) * nloc) {
            __builtin_amdgcn_fence(__ATOMIC_RELEASE, "agent");
            asm volatile("s_waitcnt vmcnt(0)" ::: "memory");
            const unsigned og = xb_add(&bar[XB_TOP], 1u);
            const unsigned tg = og / nx;
            if (og + 1u == (tg + 1u) * nx) xb_add(&bar[XB_TOPGEN], 1u);
            else XB_SPIN(xb_ld(&bar[XB_TOPGEN]) == tg, bar);
            __builtin_amdgcn_fence(__ATOMIC_ACQUIRE, "agent");
            xb_add(&bar[XB_XGEN(b.x)], 1u);
            asm volatile("s_waitcnt vmcnt(0)" ::: "memory");
        } else {
            XB_SPIN(xb_ld(&bar[XB_XGEN(b.x)]) == gen, bar);
            __builtin_amdgcn_fence(__ATOMIC_ACQUIRE, "agent");
            asm volatile("s_waitcnt vmcnt(0)" ::: "memory");
        }
    }
    __syncthreads();
}


#ifdef FP8_PROBE
typedef int v8i_t __attribute__((ext_vector_type(8)));
typedef float f32x16_t __attribute__((ext_vector_type(16)));
__device__ __forceinline__ int pr_aval(int i, int k) { return ((i * 7 + k * 3) % 5) - 2; }
__device__ __forceinline__ int pr_bval(int k, int j) { return ((k * 5 + j * 11) % 7) - 3; }
__device__ __forceinline__ unsigned pr_enc(int v) { const int a = v < 0 ? -v : v; const unsigned m = a == 0 ? 0x00u : (a == 1 ? 0x38u : (a == 2 ? 0x40u : 0x44u)); return m | (v < 0 ? 0x80u : 0u); }
template <int HYP> __device__ __forceinline__ int pr_kmap(int h, int j) { return HYP == 1 ? 32 * h + j : (HYP == 2 ? 16 * h + (j & 15) + 32 * (j >> 4) : 8 * h + (j & 7) + 16 * (j >> 3)); }
template <int HYP> __device__ __forceinline__ bool pr_test(int lane) {
    const int rc = lane & 31, h = lane >> 5; v8i_t a, b;
#pragma unroll
    for (int d = 0; d < 8; ++d) { unsigned wa = 0u, wb = 0u;
#pragma unroll
        for (int q = 0; q < 4; ++q) { const int k = pr_kmap<HYP>(h, 4 * d + q); wa |= pr_enc(pr_aval(rc, k)) << (8 * q); wb |= pr_enc(pr_bval(k, rc)) << (8 * q); }
        a[d] = (int)wa; b[d] = (int)wb; }
    f32x16_t c = {};
    c = __builtin_amdgcn_mfma_scale_f32_32x32x64_f8f6f4(a, b, c, 0, 0, 0, 0x7f7f7f7f, 0, 0x7f7f7f7f);
    bool ok = true;
#pragma unroll
    for (int r = 0; r < 16; ++r) { const int i = (r & 3) + 8 * (r >> 2) + 4 * h; int e = 0;
        for (int k = 0; k < 64; ++k) e += pr_aval(i, k) * pr_bval(k, rc);
        ok = ok && (c[r] == (float)e); }
    return __all(ok) != 0;
}
#endif
__global__ void __launch_bounds__(NWAVES * 64, 2) mk_fwd(Params p_unused) {
    extern __shared__ __attribute__((aligned(16))) unsigned char lds[];
#define MAKE_CTX Ctx F; { int t_ = threadIdx.x; asm volatile("" : "+v"(t_)); F.lds = (LAS unsigned char*)lds; F.tid = t_; F.lane = t_ & 63; F.wave = __builtin_amdgcn_readfirstlane(t_ >> 6); \
    F.G = gridDim.x; const int bx = blockIdx.x; F.vcu = (F.G % 8 == 0) ? (bx % 8) * (F.G / 8) + bx / 8 : bx; }
    int lo, hi; unsigned* barw; { const Params q0 = kparams(); lo = q0.ph_lo; hi = q0.ph_hi; barw = (unsigned*)(q0.ws + WS_CTL) + 4096; }
    volatile LAS unsigned* bst = (volatile LAS unsigned*)((LAS unsigned char*)lds + RING_BYTES + 12288 + 1024);
    if (threadIdx.x < 2) bst[threadIdx.x] = 0u;
    __syncthreads();
    if (threadIdx.x == 0) (void)xb_add(&barw[XB_XCNT(xb_xcc_id())], 1u);
#ifndef PH_MASK
#define PH_MASK 0xFFFFFu
#endif
#define IN(k) (((PH_MASK >> (k)) & 1u) && lo <= (k) && (k) < hi)
#define SEAM(k) do { if (IN(k) && IN((k) + 1)) { XcdBarrier xb_; xb_.bar = barw; xb_.x = xb_xcc_id(); xb_.st = bst; xcd_barrier(xb_); } } while (0)
#ifndef TS_MASK
#define TS_MASK 0u
#endif
#ifndef TS_SCALE
#define TS_SCALE 10.0f
#endif
    unsigned long long ts_prev = 0ull, ts_acc = 0ull;
    if (TS_MASK) ts_prev = __builtin_amdgcn_s_memrealtime();
#define TS_MARK(k) do { if (TS_MASK) { const unsigned long long t_ = __builtin_amdgcn_s_memrealtime(); if ((TS_MASK >> (k)) & 1u) ts_acc += t_ - ts_prev; ts_prev = t_; } } while (0)
#define PHASE_VARS MAKE_CTX const Params p = kparams(); unsigned char* ws = p.ws; const float* mod = (const float*)(ws + WS_MOD); bf16_t* Hb = (bf16_t*)(ws + WS_H); (void)mod; (void)Hb;

    if (IN(0)) { PHASE_VARS p0_prologue(F, p); } SEAM(0); TS_MARK(0);
    if (IN(1)) { PHASE_VARS p_norm1_in(F, p); } SEAM(1); TS_MARK(1);
    if (IN(2)) { PHASE_VARS
        pg8::Gemm g{Hb + (size_t)CTXL * DM, (const bf16_t*)(ws + WS_WIN), DM, (size_t)LR * DM * 2, 0}; pg8::GOrder S; S.init(32, 8, NB, F.G, (int)blockIdx.x);
        pg8::EpiWin E{(bf16_t*)(ws + WS_ACT + ACT_Z)}; pg8::gemm_phase(F.lds, g, S, E); p_ctx_dense(F, p, 0); } SEAM(2); TS_MARK(2);
    if (IN(3)) { PHASE_VARS p_lru(F, p, false); } SEAM(3); TS_MARK(3);
    if (IN(4)) { PHASE_VARS p_lru_carry(F, p); p_cm(F, p); }
    if (IN(4)) { XcdBarrier xb_; xb_.bar = barw; xb_.x = xb_xcc_id(); xb_.st = bst; xcd_barrier(xb_); }
    if (IN(4)) { PHASE_VARS p_lru(F, p, true); } SEAM(4); TS_MARK(4);
    if (IN(5)) { PHASE_VARS
        pg8::Gemm g{(const bf16_t*)(ws + WS_ACT + ACT_YCAT) + (size_t)CTXL * DM, (const bf16_t*)(ws + WS_WOUT0), DM, (size_t)LR * DM * 2, 0}; pg8::GOrder S; S.init(32, 4, NB, F.G, (int)blockIdx.x);
        pg8::EpiRes E{(bf16_t*)(ws + WS_X), p.in[I_X], mod + 2 * DM, 0}; pg8::gemm_phase(F.lds, g, S, E); p_ctx_dense(F, p, 1); } SEAM(5); TS_MARK(5);
    if (IN(6)) { PHASE_VARS p_norm2_router(F, p, 0, true); } SEAM(6); TS_MARK(6);
    if (IN(7)) { PHASE_VARS p_select(F, p, true); } SEAM(7); TS_MARK(7);
    if (IN(8)) { PHASE_VARS
        pg8::Gemm8 g{ws + WS_XS, ws + WS_W13, DM, (size_t)EROWS * DM, (size_t)4096 * DM}; pg8::GOrder S; S.init(8, 16, NE, F.G, (int)blockIdx.x);
        pg8::EpiSwiGLU8 E{ws + WS_ACT + ACT_HID}; pg8::gemm8_phase<true>(F.lds, g, S, E); p_ctx_moe(F, p, 0); } SEAM(8); TS_MARK(8);
    if (IN(9)) { PHASE_VARS
        pg8::Gemm8 g{ws + WS_ACT + ACT_HID, ws + WS_W2, FF, (size_t)EROWS * FF, (size_t)DM * FF}; pg8::GOrder S; S.init(8, 4, NE, F.G, (int)blockIdx.x);
        pg8::EpiMoeOut8 E{ws + WS_XS, (const float*)(ws + WS_GATE)}; pg8::gemm8_phase<false>(F.lds, g, S, E); p_ctx_moe(F, p, 1); } SEAM(9); TS_MARK(9);
    if (IN(10)) { PHASE_VARS p_combine(F, p, 0, false); } SEAM(10); TS_MARK(10);
    if (IN(11)) { PHASE_VARS
        pg8::Gemm g{Hb + (size_t)CTXL * DM, (const bf16_t*)(ws + WS_WQKV), DM, (size_t)LR * DM * 2, 0}; pg8::GOrder S; S.init(32, 12, NB, F.G, (int)blockIdx.x);
        pg8::EpiQKV E{(bf16_t*)(ws + WS_ACT + ACT_Q), (const float*)(ws + WS_ROPE)}; pg8::gemm_phase(F.lds, g, S, E); p_ctx_dense(F, p, 2); } SEAM(11); TS_MARK(11);
    if (IN(12)) { PHASE_VARS p_attn(F, p, lds); } SEAM(12); TS_MARK(12);
    TS_MARK(13);
    if (IN(14)) { PHASE_VARS
        pg8::Gemm g{(const bf16_t*)(ws + WS_XS), (const bf16_t*)(ws + WS_WOUT1), DM, (size_t)SEQ * DM * 2, 0}; pg8::GOrder S; S.init(32, 4, NB, F.G, (int)blockIdx.x);
        pg8::EpiRes E{(bf16_t*)(ws + WS_X), nullptr, mod + 3 * 6144 + 2 * DM, 1}; pg8::gemm_phase(F.lds, g, S, E); } SEAM(14); TS_MARK(14);
    if (IN(15)) { PHASE_VARS p_norm2_router(F, p, 1, false); } SEAM(15); TS_MARK(15);
    if (IN(16)) { PHASE_VARS p_select(F, p, false); } SEAM(16); TS_MARK(16);
    if (IN(17)) { PHASE_VARS
        pg8::Gemm8 g{ws + WS_XS, ws + WS_W13 + (size_t)NE * 4096 * DM, DM, (size_t)EROWS * DM, (size_t)4096 * DM}; pg8::GOrder S; S.init(8, 16, NE, F.G, (int)blockIdx.x);
        pg8::EpiSwiGLU8 E{ws + WS_ACT + ACT_HID}; pg8::gemm8_phase<true>(F.lds, g, S, E); } SEAM(17); TS_MARK(17);
    if (IN(18)) { PHASE_VARS
        pg8::Gemm8 g{ws + WS_ACT + ACT_HID, ws + WS_W2 + (size_t)NE * DM * FF, FF, (size_t)EROWS * FF, (size_t)DM * FF}; pg8::GOrder S; S.init(8, 4, NE, F.G, (int)blockIdx.x);
        pg8::EpiMoeOut8 E{ws + WS_XS, (const float*)(ws + WS_GATE)}; pg8::gemm8_phase<false>(F.lds, g, S, E); } SEAM(18); TS_MARK(18);
    if (IN(19)) { PHASE_VARS p_combine(F, p, 1, true); }
#ifdef FP8_PROBE
    { XcdBarrier xb_; xb_.bar = barw; xb_.x = xb_xcc_id(); xb_.st = bst; xcd_barrier(xb_);
      if (blockIdx.x == 0 && threadIdx.x < 64) { const int l_ = threadIdx.x; int code = 0; if (pr_test<1>(l_)) code = 1; else if (pr_test<2>(l_)) code = 2; else if (pr_test<3>(l_)) code = 3;
          if (l_ == 0) { const Params p = kparams(); p.out[0] += 20.0f * (float)code; } } }
#endif
    if (TS_MASK) { TS_MARK(19); XcdBarrier xb_; xb_.bar = barw; xb_.x = xb_xcc_id(); xb_.st = bst; xcd_barrier(xb_);
        if (blockIdx.x == 0 && threadIdx.x == 0) { const Params p = kparams(); p.out[0] += (float)ts_acc * 0.01f / TS_SCALE; } }
#undef IN
#undef SEAM
}

extern "C" void kernel_launch(void* const* d_in, const int* in_sizes, int n_in, void* d_out, int out_size, void* d_ws, size_t ws_size, hipStream_t stream) {
    static int grid = 0;
    if (grid == 0) {
        if (n_in != 32 || out_size != NLAT * DM || ws_size < WS_END) { fprintf(stderr, "kernel_launch: unexpected problem (n_in %d, out %d, ws %zu)\n", n_in, out_size, ws_size); grid = -1; return; }
        int dev = 0, cus = 0, per_cu = 0;
        if (hipGetDevice(&dev) != hipSuccess || hipDeviceGetAttribute(&cus, hipDeviceAttributeMultiprocessorCount, dev) != hipSuccess) { grid = -1; return; }
        if (hipFuncSetAttribute((const void*)mk_fwd, hipFuncAttributeMaxDynamicSharedMemorySize, LDS_BYTES) != hipSuccess) { fprintf(stderr, "kernel_launch: hipFuncSetAttribute failed\n"); grid = -1; return; }
        if (hipOccupancyMaxActiveBlocksPerMultiprocessor(&per_cu, (const void*)mk_fwd, NWAVES * 64, LDS_BYTES) != hipSuccess || per_cu < 1) { fprintf(stderr, "kernel_launch: occupancy query says %d\n", per_cu); per_cu = 1; }
        (void)hipGetLastError();
        grid = cus & ~7;
    }
    if (grid < 0) return;
    if (hipMemsetAsync((char*)d_ws + WS_CTL, 0, 65536, stream) != hipSuccess) { fprintf(stderr, "kernel_launch: memset failed\n"); return; }
    Params a{};
    for (int i = 0; i < 32; ++i) a.in[i] = (const float*)d_in[i];
    a.out = (float*)d_out; a.ws = (unsigned char*)d_ws;
#if MK_N_LAUNCHES == 1
    a.ph_lo = 0; a.ph_hi = NPH;
    void* args[] = {&a};
    hipError_t e = hipLaunchCooperativeKernel((const void*)mk_fwd, dim3(grid), dim3(NWAVES * 64), args, LDS_BYTES, stream);
    if (e != hipSuccess) fprintf(stderr, "kernel_launch: cooperative launch failed: %s (grid %d)\n", hipGetErrorString(e), grid);
#else
    for (int ph = 0; ph < NPH; ++ph) { a.ph_lo = ph; a.ph_hi = ph + 1; hipLaunchKernelGGL(mk_fwd, dim3(grid), dim3(NWAVES * 64), LDS_BYTES, stream, a); }
#endif
}
```

```cpp
#include <hip/hip_runtime.h>
#include <hip/hip_cooperative_groups.h>
#include <hip/hip_bf16.h>
#include <cstdio>
#include <cstdint>
#include <cmath>
namespace cg = cooperative_groups;

#ifndef MK_N_LAUNCHES
#define MK_N_LAUNCHES 1
#endif

constexpr int DM = 1024, NB = 2, SEQ = 8192, CTXL = 256, LR = SEQ + CTXL, NR = NB * LR, NLAT = NB * SEQ;
constexpr int NE = 16, FF = 2048, EROWS = 2304;
constexpr float EPS = 1e-6f;
constexpr int NTILE64 = NR / 64;
constexpr int NPH = 20;

constexpr size_t MiB = 1u << 20;
constexpr size_t WS_CTL = 0, WS_MOD = 1 * MiB, WS_ROPE = 2 * MiB, WS_LRUW = 4 * MiB, WS_CMWS = 4 * MiB + 512 * 1024, WS_SUM = 5 * MiB, WS_AFF = 8 * MiB, WS_INV = 10 * MiB,
                 WS_GATE = 12 * MiB, WS_ROWIDX = 13 * MiB, WS_MODP = 28 * MiB, WS_CAR = 30 * MiB, WS_WIN = 14 * MiB, WS_WOUT0 = 18 * MiB, WS_WQKV = 20 * MiB, WS_WOUT1 = 26 * MiB, WS_W13 = 32 * MiB, WS_W2 = 288 * MiB, WS_H = 416 * MiB,
                 WS_X = 450 * MiB, WS_XS = 516 * MiB, WS_ACT = 588 * MiB, WS_END = 758 * MiB;
static_assert(true, "");
constexpr size_t ACT_Z = 0, ACT_YCAT = 66 * MiB, ACT_HID = 0, ACT_Q = 0, ACT_K = 33 * MiB, ACT_V = 66 * MiB, ACT_O1 = 99 * MiB, ACT_O2 = 131 * MiB, ACT_A = 0;

#define GAS __attribute__((address_space(1)))
#define LAS __attribute__((address_space(3)))
typedef unsigned short bf16_t;
typedef short bf16x8 __attribute__((ext_vector_type(8)));
typedef float f32x4 __attribute__((ext_vector_type(4)));
typedef float f32x2 __attribute__((ext_vector_type(2)));
typedef unsigned u32x4 __attribute__((ext_vector_type(4)));
typedef unsigned u32x2 __attribute__((ext_vector_type(2)));

__device__ __forceinline__ unsigned f2bf(float f) { unsigned u = __builtin_bit_cast(unsigned, f); return (u + 0x7fffu + ((u >> 16) & 1u)) >> 16; }
typedef float f32x2_hw __attribute__((ext_vector_type(2))); typedef __bf16 bf16x2_hw __attribute__((ext_vector_type(2)));
__device__ __forceinline__ unsigned pk2(float lo, float hi) { f32x2_hw v = {lo, hi}; bf16x2_hw b = __builtin_convertvector(v, bf16x2_hw); return __builtin_bit_cast(unsigned, b); }
__device__ __forceinline__ u32x2 pk4(const f32x4 v) { u32x2 w; w.x = pk2(v[0], v[1]); w.y = pk2(v[2], v[3]); return w; }
__device__ __forceinline__ float bf2f(unsigned short b) { return __builtin_bit_cast(float, (unsigned)b << 16); }
__device__ __forceinline__ float bflo(unsigned w) { return __builtin_bit_cast(float, w << 16); }
__device__ __forceinline__ float bfhi(unsigned w) { return __builtin_bit_cast(float, w & 0xffff0000u); }
__device__ __forceinline__ unsigned f2fp8x4(float a, float b, float c, float d) {
    a = __builtin_amdgcn_fmed3f(a, -448.f, 448.f); b = __builtin_amdgcn_fmed3f(b, -448.f, 448.f); c = __builtin_amdgcn_fmed3f(c, -448.f, 448.f); d = __builtin_amdgcn_fmed3f(d, -448.f, 448.f);
    int w = __builtin_amdgcn_cvt_pk_fp8_f32(a, b, 0, false); w = __builtin_amdgcn_cvt_pk_fp8_f32(c, d, w, true); return (unsigned)w; }
constexpr float YB_SCALE = 16.0f, YB_INV = 1.0f / 16.0f;
constexpr float W8_SCALE = 32.0f, W8_INV = 1.0f / 32.0f;
__device__ __forceinline__ float gelu_tanh(float x) {
    const float u2 = 2.0f * 0.7978845608028654f * (x + 0.044715f * x * x * x);
    const float e = __builtin_amdgcn_exp2f(u2 * 1.4426950408889634f);
    return x - x * __builtin_amdgcn_rcpf(1.0f + e);
}
__device__ __forceinline__ float silu_f(float a) { return a * __builtin_amdgcn_rcpf(1.0f + __builtin_amdgcn_exp2f(-a * 1.4426950408889634f)); }
__device__ __forceinline__ float sigmoid_f(float a) { return 1.0f / (1.0f + __expf(-a)); }

namespace pg8 {
#define PG8_LAS __attribute__((address_space(3)))
constexpr int BM = 256, BK = 64, HALF = 128, HTB = HALF * BK * 2, STAGE_BYTES = 8 * HTB, NXCD = 8, WGM = 8;
__host__ __device__ __forceinline__ int lds_byte(int r, int c) { const int st = (r >> 4) * 2 + (c >> 5), rr = r & 15, cc = c & 31, ob = rr * 64 + cc * 2; return st * 1024 + (ob ^ (((ob >> 9) & 1) << 5)); }
__host__ __device__ __forceinline__ void stage_rc(int b, int& R, int& C) { const int st = b / 1024, sb = b % 1024, swz = sb ^ (((sb >> 9) & 1) << 5); R = (st >> 1) * 16 + swz / 64; C = (st & 1) * 32 + (swz % 64) / 2; }
__host__ __device__ __forceinline__ int perm32(int rho) { const int n = rho >> 4, i = rho & 15; return 8 * (i >> 2) + 4 * n + (i & 3); }

struct Unit { int pm, pn, grp; };
struct Gemm { const bf16_t* A; const bf16_t* Bt; int K; size_t ga, gb; };

struct GOrder {
    int nM, nN, upg, nwg, G, c;
    __device__ void init(int nM_, int nN_, int ngrp, int G_, int c_) { nM = nM_; nN = nN_; upg = nM * nN; nwg = upg * ngrp; G = G_; c = c_; }
    __device__ bool next(int i, Unit& u) const {
        const long L = (long)i * G + c; if (L >= nwg) return false;
        int wgid = (int)L; { const int q = nwg / NXCD, r = nwg % NXCD, xcd = wgid % NXCD, off = wgid / NXCD; wgid = (xcd < r ? xcd * (q + 1) : r * (q + 1) + (xcd - r) * q) + off; }
        u.grp = wgid / upg; const int w = wgid % upg;
        const int nig = WGM * nN, gid = w / nig, fm = gid * WGM, gsz = (nM - fm) < WGM ? (nM - fm) : WGM;
        u.pm = fm + ((w % nig) % gsz); u.pn = (w % nig) / gsz; return true;
    }
};

__device__ __forceinline__ unsigned cvt_pk_bf16(float lo, float hi) { unsigned r; asm volatile("v_cvt_pk_bf16_f32 %0, %1, %2" : "=v"(r) : "v"(lo), "v"(hi)); return r; }

template <class Epi, class Sched>
__device__ __forceinline__ void gemm_phase(PG8_LAS unsigned char* lds, const Gemm g, const Sched& S, const Epi& E) {
    const int tid = threadIdx.x, wid = __builtin_amdgcn_readfirstlane(tid >> 6), lane = tid & 63, wr = wid >> 2, wc = wid & 3, fr = lane & 15, fq = lane >> 4;
    const int K = g.K, nt = K / BK;
    unsigned voffA[2], voffB[2];
#pragma unroll
    for (int i = 0; i < 2; ++i) { int R, C; stage_rc(tid * 16 + i * 8192, R, C); const int Rb = (R & ~31) + perm32(R & 31);
        voffA[i] = (unsigned)(R * K + C) * 2u; voffB[i] = (unsigned)(Rb * K + C) * 2u; }
    const size_t kstep = (size_t)(BK * 2);
    const size_t hstep = (size_t)HALF * K * 2;
    const size_t tstep = 2 * hstep;
    const unsigned ldsw = (unsigned)wid * 1024u;
    const int aoff = lds_byte(wr * 64 + fr, fq * 8), boff = lds_byte(wc * 32 + fr, fq * 8);
#define PG8_SA(b, h) (((b) * 2 + (h)) * HTB)
#define PG8_SB(b, h) ((4 + (b) * 2 + (h)) * HTB)
#define PG8_STAGE(bufoff, gbase, voff) do { _Pragma("unroll") for (int _i = 0; _i < 2; ++_i) \
        __builtin_amdgcn_global_load_lds((const unsigned*)((const char*)(gbase) + (voff)[_i]), (PG8_LAS unsigned*)(lds + (bufoff) + ldsw + _i * 8192), 16, 0, 0); } while (0)
#define PG8_LDA(dst, b, h) do { _Pragma("unroll") for (int m = 0; m < 4; ++m) _Pragma("unroll") for (int k = 0; k < 2; ++k) dst[m][k] = *(const PG8_LAS bf16x8*)(lds + PG8_SA(b, h) + aoff + m * 2048 + k * 1024); } while (0)
#define PG8_LDB(dst, b, h) do { _Pragma("unroll") for (int n = 0; n < 2; ++n) _Pragma("unroll") for (int k = 0; k < 2; ++k) dst[n][k] = *(const PG8_LAS bf16x8*)(lds + PG8_SB(b, h) + boff + n * 2048 + k * 1024); } while (0)
#define PG8_MMA(ai, bj, At, Bt) do { __builtin_amdgcn_s_setprio(1); _Pragma("unroll") for (int m = 0; m < 4; ++m) _Pragma("unroll") for (int n = 0; n < 2; ++n) _Pragma("unroll") for (int k = 0; k < 2; ++k) \
        acc[ai][bj][m][n] = __builtin_amdgcn_mfma_f32_16x16x32_bf16(Bt[n][k], At[m][k], acc[ai][bj][m][n], 0, 0, 0); __builtin_amdgcn_s_setprio(0); } while (0)
#define PG8_WAIT_V(n) asm volatile("s_waitcnt vmcnt(" #n ")" ::: "memory")
#define PG8_WAIT_L(n) asm volatile("s_waitcnt lgkmcnt(" #n ")" ::: "memory")
#define PG8_BAR __builtin_amdgcn_s_barrier()
#define PG8_SCHED __builtin_amdgcn_sched_barrier(0)
    Unit cur, nxt; int ui = 0;
    if (!S.next(0, cur)) return;
    f32x4 acc[2][2][4][2];
#pragma unroll
    for (int a = 0; a < 2; ++a)
#pragma unroll
        for (int b = 0; b < 2; ++b)
#pragma unroll
            for (int m = 0; m < 4; ++m)
#pragma unroll
                for (int n = 0; n < 2; ++n) acc[a][b][m][n] = (f32x4){0.f, 0.f, 0.f, 0.f};
    bf16x8 At[4][2], B0[2][2], B1[2][2];
    const char* cA = (const char*)g.A + (size_t)cur.grp * g.ga + (size_t)cur.pm * tstep; const char* cB = (const char*)g.Bt + (size_t)cur.grp * g.gb + (size_t)cur.pn * tstep;
    PG8_STAGE(PG8_SB(0, 0), cB, voffB); PG8_STAGE(PG8_SB(0, 1), cB + hstep, voffB); PG8_STAGE(PG8_SA(0, 0), cA, voffA); PG8_STAGE(PG8_SA(0, 1), cA + hstep, voffA);
    if (wr == 1) PG8_BAR;
    PG8_WAIT_V(2); PG8_BAR;
    PG8_STAGE(PG8_SB(1, 0), cB + kstep, voffB); PG8_STAGE(PG8_SA(1, 0), cA + kstep, voffA); PG8_STAGE(PG8_SB(1, 1), cB + hstep + kstep, voffB);
    PG8_WAIT_V(6); PG8_BAR;
    for (;;) {
        const bool has_next = S.next(ui + 1, nxt);
        const char* nA = has_next ? (const char*)g.A + (size_t)nxt.grp * g.ga + (size_t)nxt.pm * tstep : cA; const char* nB = has_next ? (const char*)g.Bt + (size_t)nxt.grp * g.gb + (size_t)nxt.pn * tstep : cB;
        for (int t = 0; t < nt; t += 2) {
            const bool last = (t == nt - 2);
            const char* a1 = cA + (size_t)(t + 1) * kstep;
            const char* a2 = last ? nA : cA + (size_t)(t + 2) * kstep; const char* b2 = last ? nB : cB + (size_t)(t + 2) * kstep;
            const char* a3 = a2 + kstep; const char* b3 = b2 + kstep;
            PG8_LDB(B0, 0, 0); PG8_LDB(B1, 0, 1); PG8_SCHED; PG8_LDA(At, 0, 0); PG8_STAGE(PG8_SA(1, 1), a1 + hstep, voffA);
            PG8_WAIT_V(8); PG8_WAIT_L(0); PG8_BAR; PG8_MMA(0, 0, At, B0); PG8_MMA(0, 1, At, B1); PG8_BAR; PG8_SCHED;
            PG8_LDA(At, 0, 1); PG8_STAGE(PG8_SB(0, 0), b2, voffB); PG8_STAGE(PG8_SB(0, 1), b2 + hstep, voffB); PG8_STAGE(PG8_SA(0, 0), a2, voffA);
            PG8_WAIT_V(8); PG8_WAIT_L(0); PG8_BAR; PG8_MMA(1, 0, At, B0); PG8_MMA(1, 1, At, B1); PG8_BAR; PG8_SCHED;
            PG8_LDB(B0, 1, 0); PG8_LDB(B1, 1, 1); PG8_SCHED; PG8_LDA(At, 1, 0); PG8_STAGE(PG8_SA(0, 1), a2 + hstep, voffA);
            PG8_WAIT_V(8); PG8_WAIT_L(0); PG8_BAR; PG8_MMA(0, 0, At, B0); PG8_MMA(0, 1, At, B1); PG8_BAR; PG8_SCHED;
            PG8_LDA(At, 1, 1); PG8_STAGE(PG8_SB(1, 0), b3, voffB); PG8_STAGE(PG8_SB(1, 1), b3 + hstep, voffB); PG8_STAGE(PG8_SA(1, 0), a3, voffA);
            PG8_WAIT_V(8); PG8_WAIT_L(0); PG8_BAR; PG8_MMA(1, 0, At, B0); PG8_MMA(1, 1, At, B1); PG8_BAR; PG8_SCHED;
        }
        if (wr == 0) PG8_BAR;
        E(acc, cur, wr, wc, fr, fq);
        if (!has_next) break;
#pragma unroll
        for (int a = 0; a < 2; ++a)
#pragma unroll
            for (int b = 0; b < 2; ++b)
#pragma unroll
                for (int m = 0; m < 4; ++m)
#pragma unroll
                    for (int n = 0; n < 2; ++n) acc[a][b][m][n] = (f32x4){0.f, 0.f, 0.f, 0.f};
        cur = nxt; cA = nA; cB = nB; ++ui;
        if (wr == 1) PG8_BAR;
    }
    PG8_WAIT_V(0);
    PG8_BAR;
#undef PG8_SA
#undef PG8_SB
#undef PG8_STAGE
#undef PG8_LDA
#undef PG8_LDB
#undef PG8_MMA
#undef PG8_WAIT_V
#undef PG8_WAIT_L
#undef PG8_BAR
#undef PG8_SCHED
}

typedef int v8i32 __attribute__((ext_vector_type(8)));
typedef float f32x16 __attribute__((ext_vector_type(16)));
__host__ __device__ __forceinline__ int permS(int rho) { const int e = rho & 3, hh = (rho >> 2) & 1, q = rho >> 3; return q < 2 ? 8 * hh + 4 * q + e : 16 + 8 * hh + 4 * (q - 2) + e; }
__host__ __device__ __forceinline__ int permN(int rho) { const int e = rho & 3, hh = (rho >> 2) & 1, q = rho >> 3; return 16 * hh + 4 * q + e; }
struct Gemm8 { const unsigned char* A; const unsigned char* Bt; int K; size_t ga, gb; const int* rows; };
template <bool SWP, bool GATH, class Epi, class Sched>
__device__ __forceinline__ void gemm8_phase(PG8_LAS unsigned char* lds, const Gemm8 g, const Sched& S, const Epi& E) {
    const int tid = threadIdx.x, wid = __builtin_amdgcn_readfirstlane(tid >> 6), lane = tid & 63, wr = wid >> 2, wc = wid & 3;
    const int K = g.K, nt = K / 128;
    unsigned voffA[4], voffB[2]; int RA0 = 0, CbA = 0;
#pragma unroll
    for (int i = 0; i < 2; ++i) {
        const int bb = tid * 16 + i * 8192, st = bb / 1024, sb = bb % 1024, swz = sb ^ (((sb >> 9) & 1) << 5) ^ (((sb >> 8) & 1) << 4);
        const int R = (st >> 1) * 16 + swz / 64, Cb = (st & 1) * 64 + swz % 64; const int Rb = (R & ~31) + (SWP ? permS(R & 31) : permN(R & 31));
        voffA[i] = (unsigned)(R * K + Cb); voffA[2 + i] = (unsigned)((R + HALF) * K + Cb); voffB[i] = (unsigned)(Rb * K + Cb); if (i == 0) { RA0 = R; CbA = Cb; } }
    const size_t kstep = 128, hstep = (size_t)HALF * K, tstep = 2 * hstep;
    constexpr int IDXOFF = 8 * HTB;
    const unsigned ldsw = (unsigned)wid * 1024u;
    const int l31 = lane & 31, hh = lane >> 5;
    const int ra = wr * 64 + l31, rb = wc * 32 + l31;
    const int aoff = ((ra >> 4) * 2) * 1024 + (ra & 15) * 64 + 32 * (hh ^ ((ra & 15) >> 3)), boff = ((rb >> 4) * 2) * 1024 + (rb & 15) * 64 + 32 * (hh ^ ((rb & 15) >> 3));
    const int aswp = 16 * ((ra >> 2) & 1), bswp = 16 * ((rb >> 2) & 1);
#define PG8_SA(b, h) (((b) * 2 + (h)) * HTB)
#define PG8_SB(b, h) ((4 + (b) * 2 + (h)) * HTB)
#define PG8_STAGE(bufoff, gbase, voff) do { _Pragma("unroll") for (int _i = 0; _i < 2; ++_i) \
        __builtin_amdgcn_global_load_lds((const unsigned*)((const char*)(gbase) + (voff)[_i]), (PG8_LAS unsigned*)(lds + (bufoff) + ldsw + _i * 8192), 16, 0, 0); } while (0)
#define PG8_STAGEA(bufoff, gbase, h) do { _Pragma("unroll") for (int _i = 0; _i < 2; ++_i) \
        __builtin_amdgcn_global_load_lds((const unsigned*)((const char*)(gbase) + voffA[2 * (h) + _i]), (PG8_LAS unsigned*)(lds + (bufoff) + ldsw + _i * 8192), 16, 0, 0); } while (0)
#define PG8_LD32(dst, off, swp) do { const u32x4 lo_ = *(const PG8_LAS u32x4*)(lds + (off) + (swp)); const u32x4 hi_ = *(const PG8_LAS u32x4*)(lds + (off) + (16 - (swp))); \
        dst = (v8i32){(int)lo_.x, (int)lo_.y, (int)lo_.z, (int)lo_.w, (int)hi_.x, (int)hi_.y, (int)hi_.z, (int)hi_.w}; } while (0)
#define PG8_LDA(dst, b, h) do { _Pragma("unroll") for (int m = 0; m < 2; ++m) _Pragma("unroll") for (int k = 0; k < 2; ++k) PG8_LD32(dst[m][k], PG8_SA(b, h) + aoff + m * 4096 + k * 1024, aswp); } while (0)
#define PG8_LDB(dst, b, h) do { _Pragma("unroll") for (int k = 0; k < 2; ++k) PG8_LD32(dst[k], PG8_SB(b, h) + boff + k * 1024, bswp); } while (0)
#define PG8_MMA(ai, bj, At, Bt) do { __builtin_amdgcn_s_setprio(1); _Pragma("unroll") for (int m = 0; m < 2; ++m) _Pragma("unroll") for (int k = 0; k < 2; ++k) \
        acc[ai][bj][m] = __builtin_amdgcn_mfma_scale_f32_32x32x64_f8f6f4(Bt[k], At[m][k], acc[ai][bj][m], 0, 0, 0, 0x7f7f7f7f, 0, 0x7f7f7f7f); \
        asm volatile("" : "+v"(acc[ai][bj][0]), "+v"(acc[ai][bj][1])); __builtin_amdgcn_s_setprio(0); } while (0)
#define PG8_WAIT_V(n) asm volatile("s_waitcnt vmcnt(" #n ")" ::: "memory")
#define PG8_WAIT_L(n) asm volatile("s_waitcnt lgkmcnt(" #n ")" ::: "memory")
#define PG8_BAR __builtin_amdgcn_s_barrier()
#define PG8_SCHED __builtin_amdgcn_sched_barrier(0)
    Unit cur, nxt; int ui = 0;
    if (!S.next(0, cur)) return;
    f32x16 acc[2][2][2];
#pragma unroll
    for (int a = 0; a < 2; ++a)
#pragma unroll
        for (int b = 0; b < 2; ++b)
#pragma unroll
            for (int m = 0; m < 2; ++m) acc[a][b][m] = f32x16{};
    v8i32 At[2][2], B0[2], B1[2];
    const char* cA = GATH ? (const char*)g.A : (const char*)g.A + (size_t)cur.grp * g.ga + (size_t)cur.pm * tstep; const char* cB = (const char*)g.Bt + (size_t)cur.grp * g.gb + (size_t)cur.pn * tstep;
    if (GATH) { const int* rp = g.rows + (size_t)cur.grp * EROWS + cur.pm * BM + RA0;
#pragma unroll
        for (int q = 0; q < 4; ++q) voffA[q] = (unsigned)(rp[64 * q] * K + CbA); }
    PG8_STAGE(PG8_SB(0, 0), cB, voffB); PG8_STAGE(PG8_SB(0, 1), cB + hstep, voffB); PG8_STAGEA(PG8_SA(0, 0), cA, 0); PG8_STAGEA(PG8_SA(0, 1), cA, 1);
    if (wr == 1) PG8_BAR;
    PG8_WAIT_V(2); PG8_BAR;
    PG8_STAGE(PG8_SB(1, 0), cB + kstep, voffB); PG8_STAGEA(PG8_SA(1, 0), cA + kstep, 0); PG8_STAGE(PG8_SB(1, 1), cB + hstep + kstep, voffB);
    PG8_WAIT_V(6); PG8_BAR;
    for (;;) {
        const bool has_next = S.next(ui + 1, nxt);
        const char* nA = (has_next && !GATH) ? (const char*)g.A + (size_t)nxt.grp * g.ga + (size_t)nxt.pm * tstep : cA; const char* nB = has_next ? (const char*)g.Bt + (size_t)nxt.grp * g.gb + (size_t)nxt.pn * tstep : cB;
        if (GATH && has_next && wid == 0)
            __builtin_amdgcn_global_load_lds((const unsigned*)(g.rows + (size_t)nxt.grp * EROWS + nxt.pm * BM + lane * 4), (PG8_LAS unsigned*)(lds + IDXOFF + ((ui + 1) & 1) * 1024), 16, 0, 0);
        for (int t = 0; t < nt; t += 2) {
            const bool last = (t == nt - 2);
            const char* a1 = cA + (size_t)(t + 1) * kstep;
            const char* a2 = last ? nA : cA + (size_t)(t + 2) * kstep; const char* b2 = last ? nB : cB + (size_t)(t + 2) * kstep;
            const char* a3 = a2 + kstep; const char* b3 = b2 + kstep;
            PG8_LDB(B0, 0, 0); PG8_LDB(B1, 0, 1); PG8_SCHED; PG8_LDA(At, 0, 0); PG8_STAGEA(PG8_SA(1, 1), a1, 1);
            if (GATH && last && has_next) {
                const PG8_LAS int* ip = (const PG8_LAS int*)(lds + IDXOFF + ((ui + 1) & 1) * 1024) + RA0;
#pragma unroll
                for (int q = 0; q < 4; ++q) voffA[q] = (unsigned)(ip[64 * q] * K + CbA); }
            PG8_WAIT_V(8); PG8_WAIT_L(0); PG8_BAR; PG8_SCHED; PG8_MMA(0, 0, At, B0); PG8_MMA(0, 1, At, B1); PG8_SCHED; PG8_BAR; PG8_SCHED;
            PG8_LDA(At, 0, 1); PG8_STAGE(PG8_SB(0, 0), b2, voffB); PG8_STAGE(PG8_SB(0, 1), b2 + hstep, voffB); PG8_STAGEA(PG8_SA(0, 0), a2, 0);
            PG8_WAIT_V(8); PG8_WAIT_L(0); PG8_BAR; PG8_SCHED; PG8_MMA(1, 0, At, B0); PG8_MMA(1, 1, At, B1); PG8_SCHED; PG8_BAR; PG8_SCHED;
            PG8_LDB(B0, 1, 0); PG8_LDB(B1, 1, 1); PG8_SCHED; PG8_LDA(At, 1, 0); PG8_STAGEA(PG8_SA(0, 1), a2, 1);
            PG8_WAIT_V(8); PG8_WAIT_L(0); PG8_BAR; PG8_SCHED; PG8_MMA(0, 0, At, B0); PG8_MMA(0, 1, At, B1); PG8_SCHED; PG8_BAR; PG8_SCHED;
            PG8_LDA(At, 1, 1); PG8_STAGE(PG8_SB(1, 0), b3, voffB); PG8_STAGE(PG8_SB(1, 1), b3 + hstep, voffB); PG8_STAGEA(PG8_SA(1, 0), a3, 0);
            PG8_WAIT_V(8); PG8_WAIT_L(0); PG8_BAR; PG8_SCHED; PG8_MMA(1, 0, At, B0); PG8_MMA(1, 1, At, B1); PG8_SCHED; PG8_BAR; PG8_SCHED;
        }
        if (wr == 0) PG8_BAR;
        E(acc, cur, wr, wc, l31, hh);
        if (!has_next) break;
#pragma unroll
        for (int a = 0; a < 2; ++a)
#pragma unroll
            for (int b = 0; b < 2; ++b)
#pragma unroll
                for (int m = 0; m < 2; ++m) acc[a][b][m] = f32x16{};
        cur = nxt; cA = nA; cB = nB; ++ui;
        if (wr == 1) PG8_BAR;
    }
    PG8_WAIT_V(0);
    PG8_BAR;
#undef PG8_SA
#undef PG8_SB
#undef PG8_STAGE
#undef PG8_STAGEA
#undef PG8_LD32
#undef PG8_LDA
#undef PG8_LDB
#undef PG8_MMA
#undef PG8_WAIT_V
#undef PG8_WAIT_L
#undef PG8_BAR
#undef PG8_SCHED
}
struct EpiSwiGLU8 {
    unsigned char* HID;
    __device__ __forceinline__ void operator()(const f32x16 (&acc)[2][2][2], const Unit& u, int wr, int wc, int l31, int hh) const {
        const int row0 = u.pm * BM + wr * 64 + l31, f0 = u.pn * 128 + wc * 16 + 8 * hh;
#pragma unroll
        for (int ai = 0; ai < 2; ++ai)
#pragma unroll
            for (int m = 0; m < 2; ++m) { unsigned char* rowp = HID + ((size_t)u.grp * EROWS + row0 + ai * HALF + m * 32) * FF + f0;
#pragma unroll
                for (int bj = 0; bj < 2; ++bj) { const f32x16& c = acc[ai][bj][m]; float hv[8];
#pragma unroll
                    for (int e = 0; e < 8; ++e) hv[e] = silu_f(c[e] * W8_INV) * (c[8 + e] * W8_INV);
                    u32x2 w; w.x = f2fp8x4(hv[0], hv[1], hv[2], hv[3]); w.y = f2fp8x4(hv[4], hv[5], hv[6], hv[7]);
                    *(u32x2*)(rowp + bj * 64) = w; } }
    }
};
struct EpiMoeOut8 {
    unsigned char* YB; const float* gate;
    __device__ __forceinline__ void operator()(const f32x16 (&acc)[2][2][2], const Unit& u, int wr, int wc, int l31, int hh) const {
        const int row0 = u.pm * BM + wr * 64 + l31, col0 = u.pn * BM + wc * 32 + 16 * hh;
#pragma unroll
        for (int ai = 0; ai < 2; ++ai)
#pragma unroll
            for (int m = 0; m < 2; ++m) { const size_t er = (size_t)u.grp * EROWS + row0 + ai * HALF + m * 32; const float gt = gate[er] * (W8_INV * YB_SCALE); unsigned char* rowp = YB + er * DM + col0;
#pragma unroll
                for (int bj = 0; bj < 2; ++bj) { const f32x16& c = acc[ai][bj][m]; u32x4 w;
                    w.x = f2fp8x4(c[0] * gt, c[1] * gt, c[2] * gt, c[3] * gt); w.y = f2fp8x4(c[4] * gt, c[5] * gt, c[6] * gt, c[7] * gt);
                    w.z = f2fp8x4(c[8] * gt, c[9] * gt, c[10] * gt, c[11] * gt); w.w = f2fp8x4(c[12] * gt, c[13] * gt, c[14] * gt, c[15] * gt);
                    *(u32x4*)(rowp + bj * HALF) = w; } }
    }
};

struct EpiWin {
    bf16_t* Z;
    __device__ __forceinline__ void operator()(const f32x4 (&acc)[2][2][4][2], const Unit& u, int wr, int wc, int fr, int fq) const {
        const int row0 = u.grp * LR + CTXL + u.pm * BM + wr * 64 + fr, col0 = u.pn * BM + wc * 32 + 8 * fq; const bool act = (u.pn < 2) || (u.pn >= 4);
#pragma unroll
        for (int ai = 0; ai < 2; ++ai)
#pragma unroll
            for (int m = 0; m < 4; ++m) { bf16_t* rowp = Z + (size_t)(row0 + ai * HALF + m * 16) * 2048 + col0;
#pragma unroll
                for (int bj = 0; bj < 2; ++bj) { f32x4 v0 = acc[ai][bj][m][0], v1 = acc[ai][bj][m][1];
                    if (act) {
#pragma unroll
                        for (int i = 0; i < 4; ++i) { v0[i] = gelu_tanh(v0[i]); v1[i] = gelu_tanh(v1[i]); } }
                    u32x4 w; w.x = cvt_pk_bf16(v0[0], v0[1]); w.y = cvt_pk_bf16(v0[2], v0[3]); w.z = cvt_pk_bf16(v1[0], v1[1]); w.w = cvt_pk_bf16(v1[2], v1[3]);
                    *(u32x4*)(rowp + bj * HALF) = w; } }
    }
};
struct EpiRes {
    bf16_t* X; const float* xin; const float* g1; int mode;
    __device__ __forceinline__ void operator()(const f32x4 (&acc)[2][2][4][2], const Unit& u, int wr, int wc, int fr, int fq) const {
        const int b = u.grp; bf16_t* outp = X + ((size_t)b * LR + CTXL + (size_t)u.pm * BM) * DM;
        const float* basep = xin + ((size_t)b * SEQ + (size_t)u.pm * BM) * DM;
        const int rr0 = wr * 64 + fr, col0 = u.pn * BM + wc * 32 + 8 * fq;
        f32x4 gv[2][2];
#pragma unroll
        for (int bj = 0; bj < 2; ++bj)
#pragma unroll
            for (int n = 0; n < 2; ++n) gv[bj][n] = *(const f32x4*)(g1 + (size_t)b * 6144 + col0 + bj * HALF + 4 * n);
#pragma unroll
        for (int ai = 0; ai < 2; ++ai)
#pragma unroll
            for (int m = 0; m < 4; ++m) { const size_t off = (size_t)(rr0 + ai * HALF + m * 16) * DM + col0;
#pragma unroll
                for (int bj = 0; bj < 2; ++bj) { f32x4 b0, b1;
                    if (mode == 0) { b0 = *(const f32x4*)(basep + off + bj * HALF); b1 = *(const f32x4*)(basep + off + bj * HALF + 4); }
                    else { const u32x4 w = *(const u32x4*)(outp + off + bj * HALF); b0 = (f32x4){bflo(w.x), bfhi(w.x), bflo(w.y), bfhi(w.y)}; b1 = (f32x4){bflo(w.z), bfhi(w.z), bflo(w.w), bfhi(w.w)}; }
                    const f32x4 o0 = b0 + gv[bj][0] * acc[ai][bj][m][0], o1 = b1 + gv[bj][1] * acc[ai][bj][m][1];
                    u32x4 wo; wo.x = cvt_pk_bf16(o0[0], o0[1]); wo.y = cvt_pk_bf16(o0[2], o0[3]); wo.z = cvt_pk_bf16(o1[0], o1[1]); wo.w = cvt_pk_bf16(o1[2], o1[3]);
                    *(u32x4*)(outp + off + bj * HALF) = wo; } }
    }
};
constexpr float C2 = 0.125f * 1.4426950408889634f;
struct EpiQKV {
    bf16_t* Q; const float* cs;
    __device__ __forceinline__ void operator()(const f32x4 (&acc)[2][2][4][2], const Unit& u, int wr, int wc, int fr, int fq) const {
        const int t0 = u.pm * BM; const size_t Rb = (size_t)u.grp * LR + CTXL + t0;
        const int sec = u.pn >> 2; bf16_t* dst = Q + (size_t)sec * ((ACT_K - ACT_Q) / 2);
        const int rr0 = wr * 64 + fr, colt = (u.pn & 3) * BM + wc * 32 + 8 * fq; const float sc = sec == 0 ? C2 : 1.0f; const bool rope = sec < 2;
#pragma unroll
        for (int ai = 0; ai < 2; ++ai)
#pragma unroll
            for (int m = 0; m < 4; ++m) { const int rr = rr0 + ai * HALF + m * 16; bf16_t* rowp = dst + (Rb + rr) * DM + colt;
#pragma unroll
                for (int bj = 0; bj < 2; ++bj) { f32x4 v0 = acc[ai][bj][m][0], v1 = acc[ai][bj][m][1];
                    if (rope) { const int p0 = ((colt + bj * HALF) & 63) >> 1, tt = t0 + rr; const float* cp = cs + ((p0 < 16 ? (tt >> 6) * 16 + p0 : (128 + (tt & 63)) * 16 + (p0 - 16))) * 2;
                        const f32x4 c01 = *(const f32x4*)cp, c23 = *(const f32x4*)(cp + 4);
                        const float a0 = v0[0] * c01[0] - v0[1] * c01[1], a1 = v0[0] * c01[1] + v0[1] * c01[0];
                        const float a2 = v0[2] * c01[2] - v0[3] * c01[3], a3 = v0[2] * c01[3] + v0[3] * c01[2];
                        const float b0 = v1[0] * c23[0] - v1[1] * c23[1], b1 = v1[0] * c23[1] + v1[1] * c23[0];
                        const float b2 = v1[2] * c23[2] - v1[3] * c23[3], b3 = v1[2] * c23[3] + v1[3] * c23[2];
                        v0 = (f32x4){a0, a1, a2, a3}; v1 = (f32x4){b0, b1, b2, b3}; }
                    v0 = v0 * sc; v1 = v1 * sc;
                    u32x4 w; w.x = cvt_pk_bf16(v0[0], v0[1]); w.y = cvt_pk_bf16(v0[2], v0[3]); w.z = cvt_pk_bf16(v1[0], v1[1]); w.w = cvt_pk_bf16(v1[2], v1[3]);
                    *(u32x4*)(rowp + bj * HALF) = w; }
                asm volatile("" ::: "memory"); }
    }
};
struct EpiSwiGLU {
    bf16_t* HID;
    __device__ __forceinline__ void operator()(const f32x4 (&acc)[2][2][4][2], const Unit& u, int wr, int wc, int fr, int fq) const {
        const int row0 = u.pm * BM + wr * 64 + fr, f0 = u.pn * 128 + wc * 16 + 4 * fq;
#pragma unroll
        for (int ai = 0; ai < 2; ++ai)
#pragma unroll
            for (int m = 0; m < 4; ++m) { bf16_t* rowp = HID + ((size_t)u.grp * EROWS + row0 + ai * HALF + m * 16) * FF + f0;
#pragma unroll
                for (int bj = 0; bj < 2; ++bj) { const f32x4 a = acc[ai][bj][m][0], bb = acc[ai][bj][m][1];
                    u32x2 w; w.x = cvt_pk_bf16(silu_f(a[0]) * bb[0], silu_f(a[1]) * bb[1]); w.y = cvt_pk_bf16(silu_f(a[2]) * bb[2], silu_f(a[3]) * bb[3]);
                    *(u32x2*)(rowp + bj * 64) = w; } }
    }
};
struct EpiMoeOut {
    bf16_t* YB; const float* gate;
    __device__ __forceinline__ void operator()(const f32x4 (&acc)[2][2][4][2], const Unit& u, int wr, int wc, int fr, int fq) const {
        const int row0 = u.pm * BM + wr * 64 + fr, col0 = u.pn * BM + wc * 32 + 8 * fq;
#pragma unroll
        for (int ai = 0; ai < 2; ++ai)
#pragma unroll
            for (int m = 0; m < 4; ++m) { const size_t er = (size_t)u.grp * EROWS + row0 + ai * HALF + m * 16; const float gt = gate[er]; bf16_t* rowp = YB + er * DM + col0;
#pragma unroll
                for (int bj = 0; bj < 2; ++bj) { const f32x4 v0 = acc[ai][bj][m][0] * gt, v1 = acc[ai][bj][m][1] * gt;
                    u32x4 w; w.x = cvt_pk_bf16(v0[0], v0[1]); w.y = cvt_pk_bf16(v0[2], v0[3]); w.z = cvt_pk_bf16(v1[0], v1[1]); w.w = cvt_pk_bf16(v1[2], v1[3]);
                    *(u32x4*)(rowp + bj * HALF) = w; } }
    }
};
}

namespace attn_body {
using bf16=__hip_bfloat16;
using s16x4=__attribute__((ext_vector_type(4)))short;
using f32x16=__attribute__((ext_vector_type(16)))float;
constexpr int D=64,PITCH=1024;
constexpr int NW=8,QBLK=32,QB=QBLK*NW,KVBLK=64;
constexpr int NT=LR/KVBLK;
__device__ __forceinline__ int crow(int r,int hi){return (r&3)+8*(r>>2)+4*hi;}
#define SBAR() __builtin_amdgcn_sched_barrier(0)
constexpr int NSLOT=3, SLOTB=8192;
constexpr int LDS_K=0, LDS_V=NSLOT*SLOTB, LDS_WS=2*NSLOT*SLOTB, LDS_OST=LDS_WS+NW*64*4, LDS_BYTES=LDS_OST+NW*4096;
__device__ __forceinline__ void glds16(const void*gsrc,unsigned lds_dst){unsigned keep;
  asm volatile("s_mov_b32 %0, m0\n\ts_mov_b32 m0, %2\n\ts_nop 0\n\tglobal_load_lds_dwordx4 %1, off\n\ts_mov_b32 m0, %0":"=&s"(keep):"v"(gsrc),"s"(lds_dst):"memory");}
__device__ __forceinline__ void glds16s(const void*sbase,unsigned voff,unsigned lds_dst){unsigned keep;
  asm volatile("s_mov_b32 %0, m0\n\ts_mov_b32 m0, %2\n\ts_nop 2\n\tglobal_load_lds_dwordx4 %1, %3\n\ts_mov_b32 m0, %0":"=&s"(keep):"v"(voff),"s"(lds_dst),"s"(sbase):"memory");}
__device__ __forceinline__ float max3f(float a,float b,float c){float r;asm("v_max3_f32 %0, %1, %2, %3":"=v"(r):"v"(a),"v"(b),"v"(c));return r;}
__device__ __forceinline__ float max2f(float a,float b){float r;asm("v_max_f32_e32 %0, %1, %2":"=v"(r):"v"(a),"v"(b));return r;}
__device__ __forceinline__ float fadd_s(float a,float b){float r;asm("v_add_f32_e32 %0, %1, %2":"=v"(r):"v"(a),"v"(b));return r;}
__device__ __forceinline__ float fsub_s(float a,float b){float r;asm("v_sub_f32_e32 %0, %1, %2":"=v"(r):"v"(a),"v"(b));return r;}
typedef float f32x2_t __attribute__((ext_vector_type(2))); typedef __bf16 bf16x2_t __attribute__((ext_vector_type(2)));
__device__ __forceinline__ unsigned cvtpk_s(float lo,float hi){f32x2_t v={lo,hi};bf16x2_t b=__builtin_convertvector(v,bf16x2_t);return __builtin_bit_cast(unsigned,b);}
#define WAIT_BAR(N) asm volatile("s_waitcnt vmcnt(" #N ") lgkmcnt(0)\n\ts_barrier":::"memory")
__device__ __forceinline__ void qkt(f32x16&p0,f32x16&p1,const char*Kslot,const bf16x8*qr,const f32x16&negm,int r32,int hi){
  const char*kb=Kslot+hi*1024+r32*16;
  #pragma unroll
  for(int d0=0;d0<4;++d0){
    const bf16x8 b0=*reinterpret_cast<const bf16x8*>(kb+d0*2048);
    const bf16x8 b1=*reinterpret_cast<const bf16x8*>(kb+d0*2048+512);
    if(d0==0){p0=__builtin_amdgcn_mfma_f32_32x32x16_bf16(b0,qr[0],negm,0,0,0);p1=__builtin_amdgcn_mfma_f32_32x32x16_bf16(b1,qr[0],negm,0,0,0);}
    else{p0=__builtin_amdgcn_mfma_f32_32x32x16_bf16(b0,qr[d0],p0,0,0,0);p1=__builtin_amdgcn_mfma_f32_32x32x16_bf16(b1,qr[d0],p1,0,0,0);}}
}
typedef __attribute__((address_space(3))) const char* lds_cptr;
typedef short v4i16_t __attribute__((ext_vector_type(4)));
__device__ __forceinline__ void kload8(bf16x8*kf,lds_cptr kp){
  kf[0]=*(const __attribute__((address_space(3))) bf16x8*)(kp);      kf[1]=*(const __attribute__((address_space(3))) bf16x8*)(kp+512);
  kf[2]=*(const __attribute__((address_space(3))) bf16x8*)(kp+2048); kf[3]=*(const __attribute__((address_space(3))) bf16x8*)(kp+2560);
  kf[4]=*(const __attribute__((address_space(3))) bf16x8*)(kp+4096); kf[5]=*(const __attribute__((address_space(3))) bf16x8*)(kp+4608);
  kf[6]=*(const __attribute__((address_space(3))) bf16x8*)(kp+6144); kf[7]=*(const __attribute__((address_space(3))) bf16x8*)(kp+6656);
}
__device__ __forceinline__ void kload2(bf16x8*kf,lds_cptr kp,int j){ kf[2*j]=*(const __attribute__((address_space(3))) bf16x8*)(kp+j*2048); kf[2*j+1]=*(const __attribute__((address_space(3))) bf16x8*)(kp+j*2048+512); }
__device__ __forceinline__ s16x4 vtr(lds_cptr p){ return __builtin_bit_cast(s16x4,__builtin_amdgcn_ds_read_tr16_b64_v4i16((__attribute__((address_space(3))) v4i16_t*)p)); }
__device__ __forceinline__ float rowmax(const f32x16&p0,const f32x16&p1){
  float a=max3f(p0[0],p0[1],p1[0]),b=max3f(p0[2],p0[3],p1[1]);a=max3f(a,p1[2],p1[3]);
  #pragma unroll
  for(int r=4;r<16;r+=4){a=max3f(a,p0[r],p0[r+1]);b=max3f(b,p0[r+2],p0[r+3]);a=max3f(a,p1[r],p1[r+1]);b=max3f(b,p1[r+2],p1[r+3]);}
  const float m=max2f(a,b);
  auto rr=__builtin_amdgcn_permlane32_swap(__float_as_uint(m),__float_as_uint(m),false,false);
  return max2f(__uint_as_float(rr[0]),__uint_as_float(rr[1]));
}
__device__ __forceinline__ void pv(f32x16*o,int vb,bf16x8 pa0,bf16x8 pa1,bf16x8 pa2,bf16x8 pa3){
  #pragma unroll
  for(int d0=0;d0<2;++d0){s16x4 lo[4],hi[4];
    #pragma unroll
    for(int ks=0;ks<4;++ks){
      asm volatile("ds_read_b64_tr_b16 %0,%1 offset:%c2":"=&v"(lo[ks]):"v"(vb),"i"(d0*4096+ks*1024):"memory");
      asm volatile("ds_read_b64_tr_b16 %0,%1 offset:%c2":"=&v"(hi[ks]):"v"(vb),"i"(d0*4096+ks*1024+512):"memory");}
    asm volatile("s_waitcnt lgkmcnt(0)":::"memory");SBAR();
    #define PK(k) (bf16x8){lo[k][0],lo[k][1],lo[k][2],lo[k][3],hi[k][0],hi[k][1],hi[k][2],hi[k][3]}
    o[d0]=__builtin_amdgcn_mfma_f32_32x32x16_bf16(pa0,PK(0),o[d0],0,0,0);
    o[d0]=__builtin_amdgcn_mfma_f32_32x32x16_bf16(pa1,PK(1),o[d0],0,0,0);
    o[d0]=__builtin_amdgcn_mfma_f32_32x32x16_bf16(pa2,PK(2),o[d0],0,0,0);
    o[d0]=__builtin_amdgcn_mfma_f32_32x32x16_bf16(pa3,PK(3),o[d0],0,0,0);
    #undef PK
  }
}
template<int THRL> __device__ __forceinline__ void attn_unit(const bf16*Qw,const bf16*__restrict__ Kh,const bf16*__restrict__ Vh,bf16*Ow,char*shm){
  const int tid=threadIdx.x,lane=tid&63,r32=lane&31,hi=lane>>5; const int wid=__builtin_amdgcn_readfirstlane(tid>>6);
  constexpr int DMp=PITCH;
  const unsigned lds0=(unsigned)(uintptr_t)shm;
  float*wsf=(float*)(shm+LDS_WS)+wid*64;
  const bf16*ksrc=Kh+(long)lane*DMp+wid*8;
  const bf16*vsrc=Vh+(long)(16*(wid&3)+(lane>>2))*DMp+(wid>>2)*32+(lane&3)*8;
  const unsigned kdst=lds0+LDS_K+wid*1024, vdst=lds0+LDS_V+wid*1024;
  #define DMA_K(t,slot) glds16(ksrc+(long)(t)*KVBLK*DMp,(unsigned)__builtin_amdgcn_readfirstlane(kdst+(slot)))
  #define DMA_V(t,slot) glds16(vsrc+(long)(t)*KVBLK*DMp,(unsigned)__builtin_amdgcn_readfirstlane(vdst+(slot)))
  const int vb0=(int)(lds0+LDS_V)+((lane>>4)&1)*32+(lane&3)*8+(4*hi+((lane&15)>>2))*64;
  const char*Kbase=shm+LDS_K; bf16x8 kf[8];
  const lds_cptr shm3=(lds_cptr)shm; const lds_cptr kp0=shm3+LDS_K+hi*1024+r32*16; const lds_cptr vp0=shm3+LDS_V+((lane>>4)&1)*32+(lane&3)*8+(4*hi+((lane&15)>>2))*64;
  DMA_K(0,0);DMA_V(0,0);DMA_K(1,SLOTB);
  bf16x8 qr[4];
  #pragma unroll
  for(int d0=0;d0<4;++d0)qr[d0]=*reinterpret_cast<const bf16x8*>(&Qw[(long)r32*DMp+d0*16+hi*8]);
  float mhat=0.f,l_reg=0.f;f32x16 o[2];o[0]=f32x16{};o[1]=f32x16{};f32x16 negm=f32x16{};asm volatile("":"+v"(negm));
  bool resc=false;
  #define START(P0,P1) do{ const float rm=rowmax(P0,P1); resc=false; \
    { const float dl=rm; mhat=fadd_s(mhat,dl); \
      _Pragma("unroll") for(int r=0;r<16;++r){P0[r]=fsub_s(P0[r],dl);P1[r]=fsub_s(P1[r],dl);} \
      _Pragma("unroll") for(int r=0;r<16;++r)negm[r]=-mhat; asm volatile("":"+v"(negm)); } \
    _Pragma("unroll") for(int r=0;r<16;++r)P0[r]=__builtin_amdgcn_exp2f(P0[r]); }while(0)
  #define RESC() do{ if(resc){ asm volatile("s_waitcnt lgkmcnt(0)":::"memory"); \
      _Pragma("unroll") for(int d_=0;d_<2;++d_) _Pragma("unroll") for(int r=0;r<16;++r)o[d_][r]*=wsf[crow(r,hi)]; } }while(0)
  f32x16 pA0,pA1,pB0,pB1;
  int sl_prev=0,sl_cur=0,sl_next=SLOTB;
  #define ROT() do{sl_prev=sl_cur;sl_cur=sl_next;sl_next=(sl_next==(NSLOT-1)*SLOTB)?0:sl_next+SLOTB;}while(0)
  DMA_K(2,2*SLOTB);
  WAIT_BAR(3);
  qkt(pA0,pA1,Kbase,qr,negm,r32,hi);asm volatile("s_nop 15\n\ts_nop 7":"+v"(pA0),"+v"(pA1));
  START(pA0,pA1);
  _Pragma("unroll") for(int r=0;r<16;++r)pA1[r]=__builtin_amdgcn_exp2f(pA1[r]);
  WAIT_BAR(0);
  DMA_K(3,0);DMA_V(1,SLOTB);
  ROT();
  kload8(kf,kp0+sl_cur);
  WAIT_BAR(2);
  s16x4 vlo[8],vhi[8]; u32x4 pw0,pw1,pw2,pw3;
  #define PKW(P,B) cvtpk_s(P[B],P[B+1])
  #define PAF(k) __builtin_bit_cast(bf16x8,pw##k)
  #define VFR(i) (bf16x8){vlo[i][0],vlo[i][1],vlo[i][2],vlo[i][3],vhi[i][0],vhi[i][1],vhi[i][2],vhi[i][3]}
  #define PIN(x) asm volatile("":"+v"(x))
  #define MX3(a,b,c) __builtin_fmaxf(__builtin_fmaxf((a),(b)),(c))
  #define GAPA(MF,A0,A1,A2,A3,W0,W1,PW) do{ MF; sacc+=A0; sacc+=A1; sacc+=A2; sacc+=A3; PIN(sacc); W0; W1; PIN(PW); SBAR(); }while(0)
  #define EX(v) __builtin_amdgcn_exp2f(v)
  #define GAPB(MF,X,B) do{ MF; X[B]=EX(X[B]); X[B+1]=EX(X[B+1]); X[B+2]=EX(X[B+2]); X[B+3]=EX(X[B+3]); PIN(X); SBAR(); }while(0)
  #define VRD(i) do{ vlo[i]=vtr(vp_+(((i)>>2)*4096+((i)&3)*1024)); vhi[i]=vtr(vp_+(((i)>>2)*4096+((i)&3)*1024+512)); }while(0)
  #define KRD(G,j) do{ if(G){ kload2(kf,kp0+sl_next,j); SBAR(); } }while(0)
  #define STEP(C0,C1,P0,P1,t,GK,GV,GL) do{ SBAR(); \
    const lds_cptr vp_=vp0+sl_prev; \
    VRD(0); SBAR(); float sacc=(P0[0]+P0[1]); \
    GAPA(C0=__builtin_amdgcn_mfma_f32_32x32x16_bf16(kf[0],qr[0],negm,0,0,0), P0[2],P0[3],P0[4],P0[5],     pw0[0]=PKW(P0,0), pw0[1]=PKW(P0,2), pw0); \
    VRD(4); SBAR(); GAPA(C1=__builtin_amdgcn_mfma_f32_32x32x16_bf16(kf[1],qr[0],negm,0,0,0), P0[6],P0[7],P0[8],P0[9],     pw0[2]=PKW(P0,4), pw0[3]=PKW(P0,6), pw0); \
    VRD(1); SBAR(); GAPA(C0=__builtin_amdgcn_mfma_f32_32x32x16_bf16(kf[2],qr[1],C0,0,0,0),   P0[10],P0[11],P0[12],P0[13], pw1[0]=PKW(P0,8), pw1[1]=PKW(P0,10), pw1); \
    VRD(5); SBAR(); GAPA(C1=__builtin_amdgcn_mfma_f32_32x32x16_bf16(kf[3],qr[1],C1,0,0,0),   P0[14],P0[15],P1[0],P1[1],   pw1[2]=PKW(P0,12),pw1[3]=PKW(P0,14), pw1); \
    VRD(2); SBAR(); GAPA(C0=__builtin_amdgcn_mfma_f32_32x32x16_bf16(kf[4],qr[2],C0,0,0,0),   P1[2],P1[3],P1[4],P1[5],     pw2[0]=PKW(P1,0), pw2[1]=PKW(P1,2), pw2); \
    VRD(6); SBAR(); GAPA(C1=__builtin_amdgcn_mfma_f32_32x32x16_bf16(kf[5],qr[2],C1,0,0,0),   P1[6],P1[7],P1[8],P1[9],     pw2[2]=PKW(P1,4), pw2[3]=PKW(P1,6), pw2); \
    VRD(3); SBAR(); GAPA(C0=__builtin_amdgcn_mfma_f32_32x32x16_bf16(kf[6],qr[3],C0,0,0,0),   P1[10],P1[11],P1[12],P1[13], pw3[0]=PKW(P1,8), pw3[1]=PKW(P1,10), pw3); \
    VRD(7); SBAR(); GAPA(C1=__builtin_amdgcn_mfma_f32_32x32x16_bf16(kf[7],qr[3],C1,0,0,0),   P1[14],P1[15],0.f,0.f,       pw3[2]=PKW(P1,12),pw3[3]=PKW(P1,14), pw3); \
    l_reg+=sacc; \
    if(GK){DMA_K((t)+3,sl_cur);} if(GV){DMA_V((t)+1,sl_next);} \
    { float a=MX3(C0[0],C0[1],C1[0]),b=MX3(C0[2],C0[3],C1[1]); a=MX3(a,C1[2],C1[3]); \
      _Pragma("unroll") for(int r=4;r<16;r+=4){a=MX3(a,C0[r],C0[r+1]);b=MX3(b,C0[r+2],C0[r+3]);a=MX3(a,C1[r],C1[r+1]);b=MX3(b,C1[r+2],C1[r+3]);} \
      float rm=__builtin_fmaxf(a,b); { auto rr=__builtin_amdgcn_permlane32_swap(__float_as_uint(rm),__float_as_uint(rm),false,false); rm=__builtin_fmaxf(__uint_as_float(rr[0]),__uint_as_float(rr[1])); } \
      resc=false; \
      if(__builtin_expect(__any(rm>(float)THRL),0)){ const float dl=__builtin_fmaxf(rm,0.f); mhat+=dl; \
        _Pragma("unroll") for(int r=0;r<16;++r){C0[r]-=dl;C1[r]-=dl;} \
        _Pragma("unroll") for(int r=0;r<16;++r)negm[r]=-mhat; asm volatile("":"+v"(negm)); \
        const float f=__builtin_amdgcn_exp2f(-dl); l_reg*=f; if(hi==0)wsf[r32]=f; resc=true; } } \
    SBAR(); \
    GAPB(o[0]=__builtin_amdgcn_mfma_f32_32x32x16_bf16(PAF(0),VFR(0),o[0],0,0,0), C0,0); \
    GAPB(o[1]=__builtin_amdgcn_mfma_f32_32x32x16_bf16(PAF(0),VFR(4),o[1],0,0,0), C0,4); \
    KRD(GL,0); GAPB(o[0]=__builtin_amdgcn_mfma_f32_32x32x16_bf16(PAF(1),VFR(1),o[0],0,0,0), C0,8); \
    KRD(GL,1); GAPB(o[1]=__builtin_amdgcn_mfma_f32_32x32x16_bf16(PAF(1),VFR(5),o[1],0,0,0), C0,12); \
    KRD(GL,2); GAPB(o[0]=__builtin_amdgcn_mfma_f32_32x32x16_bf16(PAF(2),VFR(2),o[0],0,0,0), C1,0); \
    KRD(GL,3); GAPB(o[1]=__builtin_amdgcn_mfma_f32_32x32x16_bf16(PAF(2),VFR(6),o[1],0,0,0), C1,4); \
    GAPB(o[0]=__builtin_amdgcn_mfma_f32_32x32x16_bf16(PAF(3),VFR(3),o[0],0,0,0), C1,8); \
    GAPB(o[1]=__builtin_amdgcn_mfma_f32_32x32x16_bf16(PAF(3),VFR(7),o[1],0,0,0), C1,12); \
    }while(0)
  int t=1;
  for(;t+5<NT;t+=2){
    STEP(pB0,pB1,pA0,pA1,t,true,true,true);     WAIT_BAR(2); RESC(); ROT();
    STEP(pA0,pA1,pB0,pB1,t+1,true,true,true);   WAIT_BAR(2); RESC(); ROT();
  }
  #define ENDW(tt) do{ if((tt)+3<NT){WAIT_BAR(2);} else if((tt)+2<NT){WAIT_BAR(1);} else {WAIT_BAR(0);} }while(0)
  for(;t+1<NT;t+=2){
    STEP(pB0,pB1,pA0,pA1,t,(t+3<NT),(t+1<NT),(t+1<NT));       ENDW(t);   RESC(); ROT();
    STEP(pA0,pA1,pB0,pB1,t+1,(t+4<NT),(t+2<NT),(t+2<NT));     ENDW(t+1); RESC(); ROT();
  }
  STEP(pB0,pB1,pA0,pA1,NT-1,false,false,false); RESC();
  { float sacc=pB0[0]+pB0[1]; _Pragma("unroll") for(int r=2;r<16;++r)sacc+=pB0[r]; _Pragma("unroll") for(int r=0;r<16;++r)sacc+=pB1[r]; l_reg+=sacc;
    pw0=(u32x4){PKW(pB0,0),PKW(pB0,2),PKW(pB0,4),PKW(pB0,6)};pw1=(u32x4){PKW(pB0,8),PKW(pB0,10),PKW(pB0,12),PKW(pB0,14)};pw2=(u32x4){PKW(pB1,0),PKW(pB1,2),PKW(pB1,4),PKW(pB1,6)};pw3=(u32x4){PKW(pB1,8),PKW(pB1,10),PKW(pB1,12),PKW(pB1,14)};
    SBAR(); pv(o,vb0+sl_cur,PAF(0),PAF(1),PAF(2),PAF(3)); }
  #undef PKW
  #undef PAF
  #undef VFR
  #undef PIN
  #undef MX3
  #undef GAPA
  #undef GAPB
  #undef EX
  #undef VRD
  #undef KRD
  #undef STEP
  #undef ENDW
  {auto rr=__builtin_amdgcn_permlane32_swap(__float_as_uint(l_reg),__float_as_uint(l_reg),false,false);l_reg=__uint_as_float(rr[0])+__uint_as_float(rr[1]);}
  if(hi==0)wsf[32+r32]=l_reg;asm volatile("s_waitcnt lgkmcnt(0)":::"memory");
  float rli[16];
  #pragma unroll
  for(int r=0;r<16;++r)rli[r]=__builtin_amdgcn_rcpf(wsf[32+crow(r,hi)]);
  { bf16*stg=(bf16*)(shm+LDS_OST)+wid*2048;
    #pragma unroll
    for(int r=0;r<16;++r){const int orow=crow(r,hi);
      #pragma unroll
      for(int d0=0;d0<2;++d0)stg[orow*64+d0*32+r32]=__float2bfloat16(o[d0][r]*rli[r]);}
    asm volatile("s_waitcnt lgkmcnt(0)":::"memory");
    #pragma unroll
    for(int i=0;i<4;++i){const int row=i*8+(lane>>3),ch=lane&7; const u32x4 v=*(const u32x4*)(stg+row*64+ch*8); *(u32x4*)(Ow+(long)row*DMp+ch*8)=v;} }
  asm volatile("s_waitcnt lgkmcnt(0)\n\ts_barrier":::"memory");
  #undef DMA_K
  #undef DMA_V
  #undef START
  #undef RESC
  #undef ROT
}

constexpr int VSLOTB=16384;
constexpr int L2_K=0, L2_V=NSLOT*SLOTB, L2_WS=L2_V+NSLOT*VSLOTB, L2_OST=L2_WS+NW*64*4, L2_BYTES=L2_OST+NW*4096;
template<int THRL> __device__ __forceinline__ void attn_unit128(const bf16*Qw,const bf16*__restrict__ Kh,const bf16*__restrict__ Vh,bf16*Ow,char*shm){
  const int tid=threadIdx.x,lane=tid&63,r32=lane&31,hi=lane>>5; const int wid=__builtin_amdgcn_readfirstlane(tid>>6);
  constexpr int DMp=PITCH;
  const unsigned lds0=(unsigned)(uintptr_t)shm;
  float*wsf=(float*)(shm+L2_WS)+wid*64;
  const unsigned koff=(unsigned)(lane*DMp+wid*8)*2u;
  const unsigned voff=(unsigned)((16*(wid&3)+(lane>>2))*DMp+(wid>>2)*32+(lane&3)*8)*2u;
  const unsigned kdst=lds0+L2_K+wid*1024, vdst=lds0+L2_V+wid*1024;
  #define DMA_K(t,slot) glds16s((const char*)Kh+(long)(t)*KVBLK*DMp*2,koff,(unsigned)__builtin_amdgcn_readfirstlane(kdst+(slot)))
  #define DMA_V(t,slot) do{ glds16s((const char*)Vh+(long)(t)*KVBLK*DMp*2,voff,(unsigned)__builtin_amdgcn_readfirstlane(vdst+2*(slot))); glds16s((const char*)Vh+(long)(t)*KVBLK*DMp*2+128,voff,(unsigned)__builtin_amdgcn_readfirstlane(vdst+2*(slot)+8192)); }while(0)
  const char*Kbase=shm+L2_K; bf16x8 kf[8];
  const lds_cptr shm3=(lds_cptr)shm; const lds_cptr kp0=shm3+L2_K+hi*1024+r32*16; const lds_cptr vp0=shm3+L2_V+((lane>>4)&1)*32+(lane&3)*8+(4*hi+((lane&15)>>2))*64;
  DMA_K(0,0);DMA_V(0,0);DMA_K(1,SLOTB);
  bf16x8 qr[4];
  #pragma unroll
  for(int d0=0;d0<4;++d0)qr[d0]=*reinterpret_cast<const bf16x8*>(&Qw[(long)r32*DMp+d0*16+hi*8]);
  float mhat=0.f,l_reg=0.f;f32x16 o[4];o[0]=f32x16{};o[1]=f32x16{};o[2]=f32x16{};o[3]=f32x16{};f32x16 negm=f32x16{};asm volatile("":"+v"(negm));
  bool resc=false;
  #define RESC() do{ if(resc){ asm volatile("s_waitcnt lgkmcnt(0)":::"memory"); \
      _Pragma("unroll") for(int d_=0;d_<4;++d_) _Pragma("unroll") for(int r=0;r<16;++r)o[d_][r]*=wsf[crow(r,hi)]; } }while(0)
  f32x16 c0,c1; u32x4 pw0,pw1,pw2,pw3;
  int sl_prev=0,sl_cur=0,sl_next=SLOTB;
  #define ROT() do{sl_prev=sl_cur;sl_cur=sl_next;sl_next=(sl_next==(NSLOT-1)*SLOTB)?0:sl_next+SLOTB;}while(0)
  #define PKW(P,B) cvtpk_s(P[B],P[B+1])
  #define PAF(k) __builtin_bit_cast(bf16x8,pw##k)
  DMA_K(2,2*SLOTB);
  WAIT_BAR(4);
  qkt(c0,c1,Kbase,qr,negm,r32,hi);asm volatile("s_nop 15\n\ts_nop 7":"+v"(c0),"+v"(c1));
  { const float rm=rowmax(c0,c1); mhat=fadd_s(mhat,rm);
    _Pragma("unroll") for(int r=0;r<16;++r){c0[r]=fsub_s(c0[r],rm);c1[r]=fsub_s(c1[r],rm);}
    _Pragma("unroll") for(int r=0;r<16;++r)negm[r]=-mhat; asm volatile("":"+v"(negm));
    _Pragma("unroll") for(int r=0;r<16;++r){c0[r]=__builtin_amdgcn_exp2f(c0[r]);c1[r]=__builtin_amdgcn_exp2f(c1[r]);}
    float sacc=c0[0]+c0[1]; _Pragma("unroll") for(int r=2;r<16;++r)sacc+=c0[r]; _Pragma("unroll") for(int r=0;r<16;++r)sacc+=c1[r]; l_reg+=sacc;
    pw0=(u32x4){PKW(c0,0),PKW(c0,2),PKW(c0,4),PKW(c0,6)};pw1=(u32x4){PKW(c0,8),PKW(c0,10),PKW(c0,12),PKW(c0,14)};pw2=(u32x4){PKW(c1,0),PKW(c1,2),PKW(c1,4),PKW(c1,6)};pw3=(u32x4){PKW(c1,8),PKW(c1,10),PKW(c1,12),PKW(c1,14)}; }
  WAIT_BAR(0);
  DMA_K(3,0);DMA_V(1,SLOTB);
  ROT();
  kload8(kf,kp0+sl_cur);
  WAIT_BAR(3);
  s16x4 vlo[8],vhi[8];
  #define VFR(i) (bf16x8){vlo[i][0],vlo[i][1],vlo[i][2],vlo[i][3],vhi[i][0],vhi[i][1],vhi[i][2],vhi[i][3]}
  #define PIN(x) asm volatile("":"+v"(x))
  #define MX3(a,b,c) __builtin_fmaxf(__builtin_fmaxf((a),(b)),(c))
  #define EX(v) __builtin_amdgcn_exp2f(v)
  #define VRD(H,i) do{ vlo[i]=vtr(vp_+((2*(H)+((i)>>2))*4096+((i)&3)*1024)); vhi[i]=vtr(vp_+((2*(H)+((i)>>2))*4096+((i)&3)*1024+512)); }while(0)
  #define KRD(G,j) do{ if(G){ kload2(kf,kp0+sl_next,j); SBAR(); } }while(0)
  #define GAPA(MF) do{ MF; SBAR(); }while(0)
  #define GAPB(MF,X,B,VR) do{ MF; X[B]=EX(X[B]); X[B+1]=EX(X[B+1]); X[B+2]=EX(X[B+2]); X[B+3]=EX(X[B+3]); PIN(X); VR; SBAR(); }while(0)
  #define GAPC(MF,X,B) do{ MF; sacc+=X[B]; sacc+=X[B+1]; sacc+=X[B+2]; sacc+=X[B+3]; PIN(sacc); SBAR(); }while(0)
  #define GAPCE(MF,X,B,Y,D) do{ MF; sacc+=X[B]; sacc+=X[B+1]; sacc+=X[B+2]; sacc+=X[B+3]; PIN(sacc); Y[D]=EX(Y[D]); Y[D+1]=EX(Y[D+1]); Y[D+2]=EX(Y[D+2]); Y[D+3]=EX(Y[D+3]); PIN(Y); SBAR(); }while(0)
  #define STEP(t,GK,GV,GL) do{ SBAR(); \
    const lds_cptr vp_=vp0+2*sl_prev; \
      \
    VRD(0,0); SBAR(); GAPA(c0=__builtin_amdgcn_mfma_f32_32x32x16_bf16(kf[0],qr[0],negm,0,0,0)); \
    VRD(0,4); SBAR(); GAPA(c1=__builtin_amdgcn_mfma_f32_32x32x16_bf16(kf[1],qr[0],negm,0,0,0)); \
    VRD(0,1); SBAR(); GAPA(c0=__builtin_amdgcn_mfma_f32_32x32x16_bf16(kf[2],qr[1],c0,0,0,0)); \
    VRD(0,5); SBAR(); GAPA(c1=__builtin_amdgcn_mfma_f32_32x32x16_bf16(kf[3],qr[1],c1,0,0,0)); \
    VRD(0,2); SBAR(); GAPA(c0=__builtin_amdgcn_mfma_f32_32x32x16_bf16(kf[4],qr[2],c0,0,0,0)); \
    VRD(0,6); SBAR(); GAPA(c1=__builtin_amdgcn_mfma_f32_32x32x16_bf16(kf[5],qr[2],c1,0,0,0)); \
    VRD(0,3); SBAR(); GAPA(c0=__builtin_amdgcn_mfma_f32_32x32x16_bf16(kf[6],qr[3],c0,0,0,0)); \
    VRD(0,7); SBAR(); GAPA(c1=__builtin_amdgcn_mfma_f32_32x32x16_bf16(kf[7],qr[3],c1,0,0,0)); \
    if(GK){DMA_K((t)+3,sl_cur);} if(GV){DMA_V((t)+1,sl_next);} \
    SBAR(); \
      \
    float mxa,mxb,rm_; \
    o[0]=__builtin_amdgcn_mfma_f32_32x32x16_bf16(PAF(0),VFR(0),o[0],0,0,0); \
    { mxa=MX3(c0[0],c0[1],c0[2]); mxb=MX3(c0[3],c0[4],c0[5]); mxa=MX3(mxa,c0[6],c0[7]); mxb=MX3(mxb,c0[8],c0[9]); mxa=MX3(mxa,c0[10],c0[11]); mxb=MX3(mxb,c0[12],c0[13]); mxa=MX3(mxa,c0[14],c0[15]); } VRD(1,0); SBAR(); \
    o[1]=__builtin_amdgcn_mfma_f32_32x32x16_bf16(PAF(0),VFR(4),o[1],0,0,0); \
    { mxb=MX3(mxb,c1[0],c1[1]); mxa=MX3(mxa,c1[2],c1[3]); mxb=MX3(mxb,c1[4],c1[5]); mxa=MX3(mxa,c1[6],c1[7]); mxb=MX3(mxb,c1[8],c1[9]); mxa=MX3(mxa,c1[10],c1[11]); mxb=MX3(mxb,c1[12],c1[13]); mxa=MX3(mxa,c1[14],c1[15]); \
      rm_=__builtin_fmaxf(mxa,mxb); { auto rr=__builtin_amdgcn_permlane32_swap(__float_as_uint(rm_),__float_as_uint(rm_),false,false); rm_=__builtin_fmaxf(__uint_as_float(rr[0]),__uint_as_float(rr[1])); } } VRD(1,4); SBAR(); \
    o[0]=__builtin_amdgcn_mfma_f32_32x32x16_bf16(PAF(1),VFR(1),o[0],0,0,0); \
    { resc=false; \
      if(__builtin_expect(__any(rm_>(float)THRL),0)){ const float dl=__builtin_fmaxf(rm_,0.f); mhat+=dl; \
        _Pragma("unroll") for(int r=0;r<16;++r){c0[r]-=dl;c1[r]-=dl;} \
        _Pragma("unroll") for(int r=0;r<16;++r)negm[r]=-mhat; asm volatile("":"+v"(negm)); \
        const float f=__builtin_amdgcn_exp2f(-dl); l_reg*=f; if(hi==0)wsf[r32]=f; resc=true; } } VRD(1,1); SBAR(); \
    GAPB(o[1]=__builtin_amdgcn_mfma_f32_32x32x16_bf16(PAF(1),VFR(5),o[1],0,0,0), c0,0,  VRD(1,5)); \
    GAPB(o[0]=__builtin_amdgcn_mfma_f32_32x32x16_bf16(PAF(2),VFR(2),o[0],0,0,0), c0,4,  VRD(1,2)); \
    GAPB(o[1]=__builtin_amdgcn_mfma_f32_32x32x16_bf16(PAF(2),VFR(6),o[1],0,0,0), c0,8,  VRD(1,6)); \
    GAPB(o[0]=__builtin_amdgcn_mfma_f32_32x32x16_bf16(PAF(3),VFR(3),o[0],0,0,0), c0,12, VRD(1,3)); \
    GAPB(o[1]=__builtin_amdgcn_mfma_f32_32x32x16_bf16(PAF(3),VFR(7),o[1],0,0,0), c1,0,  VRD(1,7)); \
      \
    float sacc=0.f; \
    GAPCE(o[2]=__builtin_amdgcn_mfma_f32_32x32x16_bf16(PAF(0),VFR(0),o[2],0,0,0), c0,0, c1,4); \
    GAPCE(o[3]=__builtin_amdgcn_mfma_f32_32x32x16_bf16(PAF(0),VFR(4),o[3],0,0,0), c0,4, c1,8); \
    pw0[0]=PKW(c0,0); pw0[1]=PKW(c0,2); pw0[2]=PKW(c0,4); pw0[3]=PKW(c0,6); PIN(pw0); SBAR(); \
    KRD(GL,0); GAPCE(o[2]=__builtin_amdgcn_mfma_f32_32x32x16_bf16(PAF(1),VFR(1),o[2],0,0,0), c0,8, c1,12); \
    KRD(GL,1); GAPC(o[3]=__builtin_amdgcn_mfma_f32_32x32x16_bf16(PAF(1),VFR(5),o[3],0,0,0), c0,12); \
    pw1[0]=PKW(c0,8); pw1[1]=PKW(c0,10); pw1[2]=PKW(c0,12); pw1[3]=PKW(c0,14); PIN(pw1); SBAR(); \
    KRD(GL,2); GAPC(o[2]=__builtin_amdgcn_mfma_f32_32x32x16_bf16(PAF(2),VFR(2),o[2],0,0,0), c1,0); \
    KRD(GL,3); GAPC(o[3]=__builtin_amdgcn_mfma_f32_32x32x16_bf16(PAF(2),VFR(6),o[3],0,0,0), c1,4); \
    pw2[0]=PKW(c1,0); pw2[1]=PKW(c1,2); pw2[2]=PKW(c1,4); pw2[3]=PKW(c1,6); PIN(pw2); SBAR(); \
    GAPC(o[2]=__builtin_amdgcn_mfma_f32_32x32x16_bf16(PAF(3),VFR(3),o[2],0,0,0), c1,8); \
    GAPC(o[3]=__builtin_amdgcn_mfma_f32_32x32x16_bf16(PAF(3),VFR(7),o[3],0,0,0), c1,12); \
    pw3[0]=PKW(c1,8); pw3[1]=PKW(c1,10); pw3[2]=PKW(c1,12); pw3[3]=PKW(c1,14); PIN(pw3); SBAR(); \
    l_reg+=sacc; \
    }while(0)
  int t=1;
  for(;t+5<NT;t+=2){
    STEP(t,true,true,true);     WAIT_BAR(3); RESC(); ROT();
    STEP(t+1,true,true,true);   WAIT_BAR(3); RESC(); ROT();
  }
  #define ENDW(tt) do{ if((tt)+3<NT){WAIT_BAR(3);} else if((tt)+2<NT){WAIT_BAR(2);} else {WAIT_BAR(0);} }while(0)
  for(;t+1<NT;t+=2){
    STEP(t,(t+3<NT),(t+1<NT),(t+1<NT));       ENDW(t);   RESC(); ROT();
    STEP(t+1,(t+4<NT),(t+2<NT),(t+2<NT));     ENDW(t+1); RESC(); ROT();
  }
  STEP(NT-1,false,false,false); RESC();
  { int lane_=threadIdx.x&63; asm volatile("":"+v"(lane_));
    const int vb=(int)(lds0+L2_V)+((lane_>>4)&1)*32+(lane_&3)*8+(4*(lane_>>5)+((lane_&15)>>2))*64+2*sl_cur;
    #pragma unroll
    for(int d0=0;d0<4;++d0){s16x4 lo[4],hh[4];
      #pragma unroll
      for(int ks=0;ks<4;++ks){
        asm volatile("ds_read_b64_tr_b16 %0,%1 offset:%c2":"=&v"(lo[ks]):"v"(vb),"i"(d0*4096+ks*1024):"memory");
        asm volatile("ds_read_b64_tr_b16 %0,%1 offset:%c2":"=&v"(hh[ks]):"v"(vb),"i"(d0*4096+ks*1024+512):"memory");}
      asm volatile("s_waitcnt lgkmcnt(0)":::"memory");SBAR();
      #define PK(k) (bf16x8){lo[k][0],lo[k][1],lo[k][2],lo[k][3],hh[k][0],hh[k][1],hh[k][2],hh[k][3]}
      o[d0]=__builtin_amdgcn_mfma_f32_32x32x16_bf16(PAF(0),PK(0),o[d0],0,0,0);
      o[d0]=__builtin_amdgcn_mfma_f32_32x32x16_bf16(PAF(1),PK(1),o[d0],0,0,0);
      o[d0]=__builtin_amdgcn_mfma_f32_32x32x16_bf16(PAF(2),PK(2),o[d0],0,0,0);
      o[d0]=__builtin_amdgcn_mfma_f32_32x32x16_bf16(PAF(3),PK(3),o[d0],0,0,0);
      #undef PK
    } }
  #undef PKW
  #undef PAF
  #undef VFR
  #undef PIN
  #undef MX3
  #undef GAPA
  #undef GAPB
  #undef GAPC
  #undef GAPCE
  #undef EX
  #undef VRD
  #undef KRD
  #undef STEP
  #undef ENDW
  {auto rr=__builtin_amdgcn_permlane32_swap(__float_as_uint(l_reg),__float_as_uint(l_reg),false,false);l_reg=__uint_as_float(rr[0])+__uint_as_float(rr[1]);}
  if(hi==0)wsf[32+r32]=l_reg;asm volatile("s_waitcnt lgkmcnt(0)":::"memory");
  float rli[16];
  #pragma unroll
  for(int r=0;r<16;++r)rli[r]=__builtin_amdgcn_rcpf(wsf[32+crow(r,hi)]);
  { bf16*stg=(bf16*)(shm+L2_OST)+wid*2048;
    #pragma unroll
    for(int hf=0;hf<2;++hf){
      #pragma unroll
      for(int r=0;r<16;++r){const int orow=crow(r,hi);
        #pragma unroll
        for(int d0=0;d0<2;++d0)stg[orow*64+d0*32+r32]=__float2bfloat16(o[2*hf+d0][r]*rli[r]);}
      asm volatile("s_waitcnt lgkmcnt(0)":::"memory");
      #pragma unroll
      for(int i=0;i<4;++i){const int row=i*8+(lane>>3),ch=lane&7; const u32x4 v=*(const u32x4*)(stg+row*64+ch*8); *(u32x4*)(Ow+(long)row*DMp+hf*64+ch*8)=v;}
      asm volatile("s_waitcnt lgkmcnt(0)":::"memory"); } }
  asm volatile("s_waitcnt lgkmcnt(0)\n\ts_barrier":::"memory");
  #undef DMA_K
  #undef DMA_V
  #undef RESC
  #undef ROT
}
#undef SBAR
#undef WAIT_BAR
}

constexpr int NWAVES = 8, LDS_BYTES = 147456, RING_BYTES = 131072;
struct Params { const float* in[32]; float* out; unsigned char* ws; int ph_lo, ph_hi; };
enum { I_X = 0, I_C, I_CTX, I_CCTX, I_ADAW, I_ADAB, I_NMIXG, I_NFFNG, I_WIN, I_CONVW, I_CONVB, I_LRUWA, I_LRUBA, I_LRUWX, I_LRUBX, I_LRULAM, I_CMVG, I_CMWS, I_CMBS, I_WOUT0,
       I_WQKV, I_LQ1, I_LK1, I_LQ2, I_LK2, I_SUBLN, I_WOUT1, I_ROUTER, I_W1, I_W3, I_W2, I_FINALG };

typedef const __attribute__((address_space(4))) Params* KParams;
__device__ __forceinline__ Params kparams() {
#if defined(__HIP_DEVICE_COMPILE__)
    KParams q = (KParams)__builtin_amdgcn_kernarg_segment_ptr(); asm volatile("" : "+s"(q)); return *q;
#else
    return Params{};
#endif
}
struct Ctx {
    LAS unsigned char* lds; int tid, lane, wave, vcu, G;
};
__device__ __forceinline__ float wave_sum(float v) {
#pragma unroll
    for (int o = 1; o < 64; o <<= 1) v += __shfl_xor(v, o);
    return v;
}
#define LDS_WAIT() asm volatile("s_waitcnt lgkmcnt(0)" ::: "memory")

__device__ __forceinline__ int dest_row(int n, int mode) {
    if (mode == 1) return n < 2048 ? ((n & ~63) + 2 * (n & 31) + ((n >> 5) & 1)) : n;
    if (mode == 2) return 32 * (n >> 4) + (n & 15);
    if (mode == 3) return 32 * (n >> 4) + 16 + (n & 15);
    return n;
}
__device__ __forceinline__ void p0_transpose_item(const float* W, int K, int N, bf16_t* WT, int mode, LAS float* scr, int item, int lane) {
    const int nblk = N / 32, kb = item / nblk, nb = item % nblk, k0 = 64 * kb, n0 = 32 * nb;
    float tv[32];
#pragma unroll
    for (int i = 0; i < 32; ++i) { const int kk = 2 * i + (lane >> 5); tv[i] = __builtin_nontemporal_load(&W[(size_t)(k0 + kk) * N + n0 + (lane & 31)]); }
#pragma unroll
    for (int i = 0; i < 32; ++i) { const int kk = 2 * i + (lane >> 5); scr[kk * 33 + (lane & 31)] = tv[i]; }
    LDS_WAIT(); asm volatile("" ::: "memory");
    const int c = lane & 7;
#pragma unroll
    for (int j = 0; j < 4; ++j) { const int n = (lane >> 3) + 8 * j; const LAS float* s = scr + (8 * c) * 33 + n;
        u32x4 o; o.x = pk2(s[0 * 33], s[1 * 33]); o.y = pk2(s[2 * 33], s[3 * 33]); o.z = pk2(s[4 * 33], s[5 * 33]); o.w = pk2(s[6 * 33], s[7 * 33]);
        *(GAS u32x4*)(WT + (size_t)dest_row(n0 + n, mode) * K + k0 + 8 * c) = o; }
    LDS_WAIT(); asm volatile("" ::: "memory");
}
__device__ __forceinline__ void p0_transpose_item8(const float* W, int K, int N, unsigned char* WT, int mode, LAS float* scr, int item, int lane) {
    const int nblk = N / 32, kb = item / nblk, nb = item % nblk, k0 = 64 * kb, n0 = 32 * nb;
    float tv[32];
#pragma unroll
    for (int i = 0; i < 32; ++i) { const int kk = 2 * i + (lane >> 5); tv[i] = __builtin_nontemporal_load(&W[(size_t)(k0 + kk) * N + n0 + (lane & 31)]); }
#pragma unroll
    for (int i = 0; i < 32; ++i) { const int kk = 2 * i + (lane >> 5); scr[kk * 33 + (lane & 31)] = tv[i] * W8_SCALE; }
    LDS_WAIT(); asm volatile("" ::: "memory");
    const int c = lane & 7;
#pragma unroll
    for (int j = 0; j < 4; ++j) { const int n = (lane >> 3) + 8 * j; const LAS float* sp = scr + (8 * c) * 33 + n;
        u32x2 o; o.x = f2fp8x4(sp[0 * 33], sp[1 * 33], sp[2 * 33], sp[3 * 33]); o.y = f2fp8x4(sp[4 * 33], sp[5 * 33], sp[6 * 33], sp[7 * 33]);
        *(GAS u32x2*)(WT + (size_t)dest_row(n0 + n, mode) * K + k0 + 8 * c) = o; }
    LDS_WAIT(); asm volatile("" ::: "memory");
}
__device__ __forceinline__ void p0_prologue(const Ctx& F, const Params& p) {
    unsigned char* ws = p.ws;
    LAS float* sil = (LAS float*)(F.lds + 8 * 16384);
    for (int i = F.tid; i < 3 * DM; i += 512) { const float v = i < 2 * DM ? p.in[I_C][i] : p.in[I_CCTX][i - 2 * DM]; sil[i] = silu_f(v); }
    __syncthreads();
    {
        float* modp = (float*)(ws + WS_MODP);
        for (int task = F.wave * F.G + F.vcu; task < 2 * 96 * 8; task += NWAVES * F.G) {
            const int ks = task & 7, cgp = (task >> 3) % 96, l = task / 768, n = cgp * 64 + F.lane;
            const float* W = p.in[I_ADAW] + ((size_t)l * DM + ks * 128) * 6144 + n;
            float a0 = 0.f, a1 = 0.f, a2 = 0.f;
#pragma unroll 32
            for (int k = 0; k < 128; ++k) { const float w = __builtin_nontemporal_load(&W[(size_t)k * 6144]); a0 += sil[ks * 128 + k] * w; a1 += sil[DM + ks * 128 + k] * w; a2 += sil[2 * DM + ks * 128 + k] * w; }
            float* o = modp + ((size_t)(ks * 2 + l) * 3) * 6144 + n; o[0] = a0; o[6144] = a1; o[2 * 6144] = a2;
        }
    }
    {
        const int gt = F.vcu * 512 + F.tid, NT_ = F.G * 512;
        float* cs = (float*)(ws + WS_ROPE);
        for (int i = gt; i < 192 * 16; i += NT_) { const int pos = i >> 4, f = i & 15; const float inv = powf(10000.0f, -(float)(2 * f) / 32.0f);
            const float ang = (float)(pos < 128 ? pos : pos - 128) * inv; float s, c; sincosf(ang, &s, &c); cs[2 * i] = c; cs[2 * i + 1] = s; }
        bf16_t* lw = (bf16_t*)(ws + WS_LRUW);
        for (int o = gt; o < 2 * 2 * 8 * 64 * 64; o += NT_) { const int i = o & 63, j = (o >> 6) & 63, h = (o >> 12) & 7, g2 = (o >> 15) & 1, d = o >> 16;
            const float* src = g2 ? p.in[I_LRUWX] : p.in[I_LRUWA]; lw[o] = (bf16_t)f2bf(src[((d * 8 + h) * 64 + i) * 64 + j]); }
        bf16_t* cw = (bf16_t*)(ws + WS_CMWS);
        for (int o = gt; o < 8 * 128 * 128; o += NT_) cw[o] = (bf16_t)f2bf(p.in[I_CMWS][o]);
    }
    LAS float* scr = (LAS float*)(F.lds + F.wave * 16384);
    const int gw = F.vcu * NWAVES + F.wave, NGW = F.G * NWAVES;
    constexpr int I_IN = 1024, I_O0 = 512, I_QK = 1536, I_O1 = 512, I_SMALL = I_IN + I_O0 + I_QK + I_O1, I_MOE = 1024, NITEMS = I_SMALL + 3 * 32 * I_MOE;
    for (int it = gw; it < NITEMS; it += NGW) {
        int r = it;
        if (r < I_SMALL) {
            if (r < I_IN) { p0_transpose_item(p.in[I_WIN], DM, 2048, (bf16_t*)(ws + WS_WIN), 0, scr, r, F.lane); continue; } r -= I_IN;
            if (r < I_O0) { p0_transpose_item(p.in[I_WOUT0], DM, DM, (bf16_t*)(ws + WS_WOUT0), 0, scr, r, F.lane); continue; } r -= I_O0;
            if (r < I_QK) { p0_transpose_item(p.in[I_WQKV], DM, 3072, (bf16_t*)(ws + WS_WQKV), 1, scr, r, F.lane); continue; } r -= I_QK;
            p0_transpose_item(p.in[I_WOUT1], DM, DM, (bf16_t*)(ws + WS_WOUT1), 0, scr, r, F.lane); continue;
        }
        r -= I_SMALL; const int which = r / (32 * I_MOE), le = (r / I_MOE) % 32, item = r % I_MOE;
        if (which == 0) p0_transpose_item8(p.in[I_W1] + (size_t)le * DM * FF, DM, FF, ws + WS_W13 + (size_t)le * 4096 * DM, 2, scr, item, F.lane);
        else if (which == 1) p0_transpose_item8(p.in[I_W3] + (size_t)le * DM * FF, DM, FF, ws + WS_W13 + (size_t)le * 4096 * DM, 3, scr, item, F.lane);
        else p0_transpose_item8(p.in[I_W2] + (size_t)le * FF * DM, FF, DM, ws + WS_W2 + (size_t)le * DM * FF, 0, scr, item, F.lane);
    }
}

__device__ __forceinline__ void ld_row(const float* pr, int lane, f32x4 (&v)[4]) {
#pragma unroll
    for (int j = 0; j < 4; ++j) v[j] = *(const f32x4*)(pr + 4 * lane + 256 * j);
}
__device__ __forceinline__ void ld_row_bf(const bf16_t* pr, int lane, f32x4 (&v)[4]) {
#pragma unroll
    for (int j = 0; j < 4; ++j) { const u32x2 w = *(const u32x2*)(pr + 4 * lane + 256 * j); v[j] = (f32x4){bflo(w.x), bfhi(w.x), bflo(w.y), bfhi(w.y)}; }
}
__device__ __forceinline__ float row_rstd(const f32x4 (&v)[4]) {
    float s = 0.f;
#pragma unroll
    for (int j = 0; j < 4; ++j) s += (v[j][0] * v[j][0] + v[j][1] * v[j][1]) + (v[j][2] * v[j][2] + v[j][3] * v[j][3]);
    return 1.0f / sqrtf(wave_sum(s) * (1.0f / DM) + EPS);
}
__device__ __forceinline__ void mod_norm(f32x4 (&v)[4], float rstd, const float* g, const float* sc, const float* sh, int lane) {
#pragma unroll
    for (int j = 0; j < 4; ++j) { const int c = 4 * lane + 256 * j; const f32x4 gv = *(const f32x4*)(g + c), sv = *(const f32x4*)(sc + c), hv = *(const f32x4*)(sh + c);
        v[j] = v[j] * rstd * gv * (sv + 1.0f) + hv; }
}
__device__ __forceinline__ void st_row_bf16(bf16_t* pr, int lane, const f32x4 (&v)[4]) {
#pragma unroll
    for (int j = 0; j < 4; ++j) { u32x2 w; w.x = pk2(v[j][0], v[j][1]); w.y = pk2(v[j][2], v[j][3]); *(u32x2*)(pr + 4 * lane + 256 * j) = w; }
}
__device__ __forceinline__ void row_info(int R, int& b, int& j, int& rt) { b = R / LR; j = R % LR; rt = j < CTXL ? 2 : b; }

__device__ __forceinline__ void stage_mod(const Ctx& F, LAS float* dst, const float* mod_l, const float* g, int sc_chunk, int sh_chunk) {
    float gq[6], sq[6], hq[6];
#pragma unroll
    for (int q = 0; q < 6; ++q) { const int i = F.tid + 512 * q, rt = i >> 10, c = i & 1023; const float* m = mod_l + (size_t)rt * 6144; gq[q] = g[c]; sq[q] = m[sc_chunk * DM + c]; hq[q] = m[sh_chunk * DM + c]; }
#pragma unroll
    for (int q = 0; q < 6; ++q) { const int i = F.tid + 512 * q; dst[i] = gq[q] * (1.0f + sq[q]); dst[3 * DM + i] = hq[q]; }
}
__device__ __forceinline__ void apply_mod(f32x4 (&v)[4], float rstd, const LAS float* ms, int rt, int lane) {
#pragma unroll
    for (int j = 0; j < 4; ++j) { const int c = rt * DM + 4 * lane + 256 * j; v[j] = v[j] * rstd * *(const LAS f32x4*)(ms + c) + *(const LAS f32x4*)(ms + 3 * DM + c); }
}
constexpr int NBR = 4;
__device__ __forceinline__ void p_norm1_in(const Ctx& F, const Params& p) {
    bf16_t* H = (bf16_t*)(p.ws + WS_H);
    LAS float* ms = (LAS float*)F.lds;
    {
        const float* modp = (const float*)(p.ws + WS_MODP); float* modw = (float*)(p.ws + WS_MOD);
        for (int i = blockIdx.x * 512 + F.tid; i < 2 * 3 * 6144; i += F.G * 512) { const int l = i / (3 * 6144), n = i % 6144; float a = p.in[I_ADAB][l * 6144 + n];
#pragma unroll
            for (int ks = 0; ks < 8; ++ks) a += modp[(size_t)ks * 2 * 3 * 6144 + i];
            modw[i] = a; }
#pragma unroll
        for (int q = 0; q < 6; q += 2) {
            float shv[2][8], scv[2][8], b0[2], b1[2], gg[2];
#pragma unroll
            for (int u = 0; u < 2; ++u) { const int i = F.tid + 512 * (q + u), rt = i >> 10, c = i & 1023; b0[u] = p.in[I_ADAB][c]; b1[u] = p.in[I_ADAB][DM + c]; gg[u] = p.in[I_NMIXG][c];
#pragma unroll
                for (int ks = 0; ks < 8; ++ks) { const float* pp = modp + ((size_t)(ks * 2 + 0) * 3 + rt) * 6144; shv[u][ks] = pp[c]; scv[u][ks] = pp[DM + c]; } }
#pragma unroll
            for (int u = 0; u < 2; ++u) { const int i = F.tid + 512 * (q + u); float sh = b0[u], sc = b1[u];
#pragma unroll
                for (int ks = 0; ks < 8; ++ks) { sh += shv[u][ks]; sc += scv[u][ks]; }
                ms[i] = gg[u] * (1.0f + sc); ms[3 * DM + i] = sh; } }
    }
    __syncthreads();
    const int gw = F.vcu * NWAVES + F.wave, NGW = F.G * NWAVES;
    for (int R0 = gw; R0 < NR; R0 += NBR * NGW) {
        f32x4 v[NBR][4]; int rts[NBR];
#pragma unroll
        for (int k = 0; k < NBR; ++k) { const int R = R0 + k * NGW < NR ? R0 + k * NGW : R0; int b, j; row_info(R, b, j, rts[k]);
            const float* src = j < CTXL ? p.in[I_CTX] + ((size_t)b * CTXL + j) * DM : p.in[I_X] + ((size_t)b * SEQ + (j - CTXL)) * DM; ld_row(src, F.lane, v[k]); }
#pragma unroll
        for (int k = 0; k < NBR; ++k) { const int R = R0 + k * NGW; const float rstd = row_rstd(v[k]); apply_mod(v[k], rstd, ms, rts[k], F.lane); if (R < NR) st_row_bf16(H + (size_t)R * DM, F.lane, v[k]); } }
    __syncthreads();
}
__device__ __forceinline__ void p_norm2_router(const Ctx& F, const Params& p, int l, bool with_ctx) {
    const float* mod = (const float*)(p.ws + WS_MOD); bf16_t* H = (bf16_t*)(p.ws + WS_H); const bf16_t* X = (const bf16_t*)(p.ws + WS_X); float* aff = (float*)(p.ws + WS_AFF);
    LAS float* wr = (LAS float*)F.lds;
    LAS float* ms = wr + DM * NE;
    for (int i = F.tid; i < DM * NE / 4; i += 512) { const int c = i >> 2, q = i & 3; ((LAS f32x4*)wr)[q * DM + (c & 3) * 256 + (c >> 2)] = ((const f32x4*)(p.in[I_ROUTER] + (size_t)l * DM * NE))[i]; }
    stage_mod(F, ms, mod + (size_t)l * 3 * 6144, p.in[I_NFFNG] + l * DM, 4, 3);
    __syncthreads();
    const int gw = F.vcu * NWAVES + F.wave, NGW = F.G * NWAVES; const int hi5 = (F.lane >> 5) & 1, hi4 = (F.lane >> 4) & 1, hi3 = (F.lane >> 3) & 1, hi2 = (F.lane >> 2) & 1;
    const int nrows = with_ctx ? NR : NLAT;
    for (int r0 = gw; r0 < nrows; r0 += NBR * NGW) {
        f32x4 v[NBR][4]; int Rs[NBR], bs[NBR], js[NBR], rts[NBR]; bool ok[NBR];
#pragma unroll
        for (int k = 0; k < NBR; ++k) { int r = r0 + k * NGW; ok[k] = r < nrows; if (!ok[k]) r = r0; Rs[k] = with_ctx ? r : (r / SEQ) * LR + CTXL + (r % SEQ); row_info(Rs[k], bs[k], js[k], rts[k]);
            ld_row_bf(X + (size_t)Rs[k] * DM, F.lane, v[k]); }
#pragma unroll
        for (int k = 0; k < NBR; ++k) { const float rstd = row_rstd(v[k]); apply_mod(v[k], rstd, ms, rts[k], F.lane); if (ok[k]) { unsigned char* hp = (unsigned char*)H + (size_t)Rs[k] * DM + 4 * F.lane;
#pragma unroll
                for (int jj = 0; jj < 4; ++jj) *(unsigned*)(hp + 256 * jj) = f2fp8x4(v[k][jj][0], v[k][jj][1], v[k][jj][2], v[k][jj][3]); }
            asm volatile("" : "+v"(v[k][0]), "+v"(v[k][1]), "+v"(v[k][2]), "+v"(v[k][3]) :: "memory"); __builtin_amdgcn_sched_barrier(0); }
#pragma unroll
        for (int k = 0; k < NBR; ++k) {
            float a[16];
#pragma unroll
            for (int e = 0; e < 16; ++e) a[e] = 0.f;
#pragma unroll
            for (int jj = 0; jj < 4; ++jj)
#pragma unroll
                for (int i = 0; i < 4; ++i) { const float hv = v[k][jj][i];
#pragma unroll
                    for (int q = 0; q < 4; ++q) { const f32x4 w = ((const LAS f32x4*)wr)[q * DM + i * 256 + 64 * jj + F.lane]; a[4 * q] += hv * w[0]; a[4 * q + 1] += hv * w[1]; a[4 * q + 2] += hv * w[2]; a[4 * q + 3] += hv * w[3]; }
                    }
            float b8[8], b4[4], b2[2], b1;
#pragma unroll
            for (int i = 0; i < 8; ++i) { const float keep = hi5 ? a[i + 8] : a[i], send = hi5 ? a[i] : a[i + 8]; b8[i] = keep + __shfl_xor(send, 32); }
#pragma unroll
            for (int i = 0; i < 4; ++i) { const float keep = hi4 ? b8[i + 4] : b8[i], send = hi4 ? b8[i] : b8[i + 4]; b4[i] = keep + __shfl_xor(send, 16); }
#pragma unroll
            for (int i = 0; i < 2; ++i) { const float keep = hi3 ? b4[i + 2] : b4[i], send = hi3 ? b4[i] : b4[i + 2]; b2[i] = keep + __shfl_xor(send, 8); }
            { const float keep = hi2 ? b2[1] : b2[0], send = hi2 ? b2[0] : b2[1]; b1 = keep + __shfl_xor(send, 4); }
            b1 += __shfl_xor(b1, 1); b1 += __shfl_xor(b1, 2);
            float mx = b1;
#pragma unroll
            for (int o = 4; o < 64; o <<= 1) mx = fmaxf(mx, __shfl_xor(mx, o));
            const float ex = __expf(b1 - mx); float sm = ex;
#pragma unroll
            for (int o = 4; o < 64; o <<= 1) sm += __shfl_xor(sm, o);
            if ((F.lane & 3) == 0 && ok[k]) aff[((size_t)bs[k] * NE + (F.lane >> 2)) * LR + js[k]] = ex / sm;
            asm volatile("" ::: "memory"); __builtin_amdgcn_sched_barrier(0);
        }
    }
    __syncthreads();
}

__device__ __forceinline__ void p_select(const Ctx& F, const Params& p, bool with_ctx) {
    const float* aff = (const float*)(p.ws + WS_AFF); int* inv = (int*)(p.ws + WS_INV); float* gate = (float*)(p.ws + WS_GATE);
    int* rowidx = (int*)(p.ws + WS_ROWIDX);
    LAS unsigned* hist = (LAS unsigned*)F.lds;
    LAS unsigned* misc = hist + 256;
    LAS unsigned* list = hist + 512;
    LAS unsigned* vals = hist + 512 + 2048;
    if (with_ctx && (int)blockIdx.x >= F.G - 32) {
        const int prob = (int)blockIdx.x - (F.G - 32), b = prob >> 4, e = prob & 15; const float* av = aff + ((size_t)b * NE + e) * LR;
        if (F.tid < CTXL) vals[F.tid] = __float_as_uint(av[F.tid]);
        __syncthreads();
        if (F.tid < CTXL) { const unsigned mine = vals[F.tid]; int rank = 0;
#pragma unroll 16
            for (int j = 0; j < CTXL; ++j) { const unsigned o = vals[j]; rank += (o > mine || (o == mine && j < F.tid)) ? 1 : 0; }
            const int R = b * LR + F.tid; int er = -1;
            if (rank < 32) { er = 2048 + b * 32 + rank; gate[e * EROWS + er] = __uint_as_float(mine); rowidx[e * EROWS + er] = R; }
            inv[(size_t)R * NE + e] = er; }
        __syncthreads();
    }
    const int nitems = 256;
    for (int item = blockIdx.x; item < nitems; item += F.G) {
        const bool isl = item < 256; const int prob = isl ? item >> 3 : item - 256, seg = isl ? item & 7 : 0, b = prob >> 4, e = prob & 15;
        const int n = isl ? SEQ : CTXL, kcap = isl ? 1024 : 32, j0 = isl ? CTXL : 0, nj = isl ? 16 : 1;
        const float* av = aff + ((size_t)b * NE + e) * LR + j0;
        { unsigned tmp[16];
#pragma unroll
          for (int jj = 0; jj < 16; ++jj) { const int tok = F.tid + 512 * jj; tmp[jj] = tok < n ? __float_as_uint(av[tok]) : 0u; }
#pragma unroll
          for (int jj = 0; jj < 16; ++jj) vals[F.tid + 512 * jj] = tmp[jj]; }
        unsigned prefix = 0u, mask = 0u, kk = (unsigned)kcap;
#pragma unroll 1
        for (int pass = 0; pass < 4; ++pass) { const int shift = 24 - 8 * pass;
            if (F.tid < 256) hist[F.tid] = 0u;
            __syncthreads();
#pragma unroll 1
            for (int jj = 0; jj < nj; ++jj) { const unsigned bt = vals[F.tid + 512 * jj]; if ((bt & mask) == prefix && bt != 0u) atomicAdd((unsigned*)(hist + ((bt >> shift) & 255u)), 1u); }
            __syncthreads();
            if (F.wave == 0) {
                unsigned loc[4], tot = 0u;
#pragma unroll
                for (int q = 0; q < 4; ++q) { loc[q] = hist[255 - 4 * F.lane - q]; tot += loc[q]; }
                unsigned inc = tot;
#pragma unroll
                for (int o = 1; o < 64; o <<= 1) { const unsigned t2 = __shfl_up(inc, o); if (F.lane >= o) inc += t2; }
                unsigned run = inc - tot;
#pragma unroll
                for (int q = 0; q < 4; ++q) { if (run < kk && run + loc[q] >= kk) { misc[0] = (unsigned)(255 - 4 * F.lane - q); misc[1] = kk - run; } run += loc[q]; }
            }
            __syncthreads();
            prefix |= misc[0] << shift; mask |= 0xffu << shift; kk = misc[1];
            __syncthreads();
        }
        const unsigned T = prefix, need_eq = kk, cnt_gt = (unsigned)kcap - need_eq;
        unsigned cnt = 0u;
#pragma unroll 1
        for (int jj = 0; jj < nj; ++jj) { const unsigned bt = vals[F.tid + 512 * jj]; cnt += (bt > T ? 1u : 0u) + (bt == T ? 0x10000u : 0u); }
        unsigned inc = cnt;
#pragma unroll
        for (int o = 1; o < 64; o <<= 1) { const unsigned t2 = __shfl_up(inc, o); if (F.lane >= o) inc += t2; }
        if (F.lane == 63) misc[8 + F.wave] = inc;
        __syncthreads();
        unsigned base = inc - cnt;
        for (int w = 0; w < F.wave; ++w) base += misc[8 + w];
        unsigned rg = base & 0xffffu, re = base >> 16;
#pragma unroll 1
        for (int jj = 0; jj < nj; ++jj) { const int tok = F.tid + 512 * jj; const unsigned bt = vals[tok]; const bool own = isl ? ((jj >> 1) == seg) : true;
            const bool isgt = bt > T, iseq = bt == T; int slot = -1;
            if (isgt) { slot = (int)rg; } else if (iseq && re < need_eq) { slot = (int)(cnt_gt + re); }
            rg += isgt ? 1u : 0u; re += iseq ? 1u : 0u;
            if (own && tok < n) { const int R = b * LR + j0 + tok; int er = -1;
                if (slot >= 0) { er = isl ? b * 1024 + slot : 2048 + b * 32 + slot; gate[e * EROWS + er] = __uint_as_float(bt); rowidx[e * EROWS + er] = R; }
                inv[(size_t)R * NE + e] = er; } }
        __syncthreads();
    }
}

__device__ __forceinline__ void p_combine(const Ctx& F, const Params& p, int l, bool final_) {
    const float* mod = (const float*)(p.ws + WS_MOD); bf16_t* H = (bf16_t*)(p.ws + WS_H); bf16_t* X = (bf16_t*)(p.ws + WS_X); const int* inv = (const int*)(p.ws + WS_INV);
    const unsigned char* YB = p.ws + WS_XS;
    LAS float* ms = (LAS float*)F.lds;
    LAS float* g2s = ms + 6 * DM;
    if (final_) { for (int i = F.tid; i < DM; i += 512) ms[i] = p.in[I_FINALG][i]; }
    else stage_mod(F, ms, mod + (size_t)(l + 1) * 3 * 6144, p.in[I_NMIXG] + (l + 1) * DM, 1, 0);
    { float gq[6];
#pragma unroll
      for (int q = 0; q < 6; ++q) { const int i = F.tid + 512 * q; gq[q] = mod[(size_t)(l * 3 + (i >> 10)) * 6144 + 5 * DM + (i & 1023)]; }
#pragma unroll
      for (int q = 0; q < 6; ++q) g2s[F.tid + 512 * q] = gq[q]; }
    __syncthreads();
    const int gw = F.vcu * NWAVES + F.wave, NGW = F.G * NWAVES;
    constexpr int NB2 = 2, NS = 4;
    const int nrows = final_ ? NLAT : NR;
    for (int r0 = gw; r0 < nrows; r0 += NB2 * NGW) {
        f32x4 v[NB2][4]; int myinv[NB2]; unsigned long long msk[NB2]; int Rs[NB2], bs[NB2], js[NB2], rts[NB2]; bool ok[NB2];
#pragma unroll
        for (int k = 0; k < NB2; ++k) { int r = r0 + k * NGW; ok[k] = r < nrows; if (!ok[k]) r = r0; Rs[k] = final_ ? (r / SEQ) * LR + CTXL + (r % SEQ) : r; row_info(Rs[k], bs[k], js[k], rts[k]);
            myinv[k] = F.lane < NE ? inv[(size_t)Rs[k] * NE + F.lane] : -1; ld_row_bf(X + (size_t)Rs[k] * DM, F.lane, v[k]); }
        unsigned w[NB2][NS][4]; float wt[NB2][NS];
#pragma unroll
        for (int k = 0; k < NB2; ++k) { msk[k] = __ballot(myinv[k] >= 0);
#pragma unroll
            for (int sidx = 0; sidx < NS; ++sidx) { const unsigned char* yr = YB; wt[k][sidx] = 0.f;
                if (msk[k]) { const int e = __builtin_ctzll(msk[k]); msk[k] &= msk[k] - 1; const int er = __builtin_amdgcn_readlane(myinv[k], e); yr = YB + ((size_t)e * EROWS + er) * DM; wt[k][sidx] = 1.f; }
#pragma unroll
                for (int jj = 0; jj < 4; ++jj) w[k][sidx][jj] = *(const unsigned*)(yr + 4 * F.lane + 256 * jj); } }
#pragma unroll
        for (int k = 0; k < NB2; ++k) {
            f32x4 mo[4];
#pragma unroll
            for (int jj = 0; jj < 4; ++jj) mo[jj] = (f32x4){0.f, 0.f, 0.f, 0.f};
#pragma unroll
            for (int sidx = 0; sidx < NS; ++sidx)
#pragma unroll
                for (int jj = 0; jj < 4; ++jj) { const int ww = (int)w[k][sidx][jj]; const float t = wt[k][sidx] * YB_INV;
                    mo[jj][0] += t * __builtin_amdgcn_cvt_f32_fp8(ww, 0); mo[jj][1] += t * __builtin_amdgcn_cvt_f32_fp8(ww, 1); mo[jj][2] += t * __builtin_amdgcn_cvt_f32_fp8(ww, 2); mo[jj][3] += t * __builtin_amdgcn_cvt_f32_fp8(ww, 3); }
            while (msk[k]) { const int e = __builtin_ctzll(msk[k]); msk[k] &= msk[k] - 1; const int er = __builtin_amdgcn_readlane(myinv[k], e); const unsigned char* yr = YB + ((size_t)e * EROWS + er) * DM;
#pragma unroll
                for (int jj = 0; jj < 4; ++jj) { const int ww = *(const int*)(yr + 4 * F.lane + 256 * jj);
                    mo[jj][0] += YB_INV * __builtin_amdgcn_cvt_f32_fp8(ww, 0); mo[jj][1] += YB_INV * __builtin_amdgcn_cvt_f32_fp8(ww, 1); mo[jj][2] += YB_INV * __builtin_amdgcn_cvt_f32_fp8(ww, 2); mo[jj][3] += YB_INV * __builtin_amdgcn_cvt_f32_fp8(ww, 3); } }
#pragma unroll
            for (int jj = 0; jj < 4; ++jj) v[k][jj] = v[k][jj] + *(const LAS f32x4*)(g2s + rts[k] * DM + 4 * F.lane + 256 * jj) * mo[jj];
            const float rstd = row_rstd(v[k]);
            if (!ok[k]) continue;
            if (final_) { float* o = p.out + ((size_t)bs[k] * SEQ + (js[k] - CTXL)) * DM;
#pragma unroll
                for (int jj = 0; jj < 4; ++jj) { const int c = 4 * F.lane + 256 * jj; __builtin_nontemporal_store(v[k][jj] * rstd * *(const LAS f32x4*)(ms + c), (f32x4*)(o + c)); } }
            else {
#pragma unroll
                for (int jj = 0; jj < 4; ++jj) *(u32x2*)(X + (size_t)Rs[k] * DM + 4 * F.lane + 256 * jj) = pk4(v[k][jj]);
                apply_mod(v[k], rstd, ms, rts[k], F.lane); st_row_bf16(H + (size_t)Rs[k] * DM, F.lane, v[k]); }
        }
    }
    __syncthreads();
}

__device__ __forceinline__ void p_lru(const Ctx& F, const Params& p, bool full) {
    const bf16_t* Z = (const bf16_t*)(p.ws + WS_ACT + ACT_Z); bf16_t* YC = (bf16_t*)(p.ws + WS_ACT + ACT_YCAT); const bf16_t* LW = (const bf16_t*)(p.ws + WS_LRUW);
    f32x2* SUM = (f32x2*)(p.ws + WS_SUM);
    LAS float* recS = (LAS float*)F.lds;
    LAS float* xcF = recS + 67 * 64;
    LAS float* aS = xcF + 64 * 64;
    LAS float* uS = aS + 2 * 64 * 64;
    LAS float* cst = uS + 2 * 64 * 64;
    LAS bf16_t* xcB = (LAS bf16_t*)(cst + 1024 + 128);
    const int wave = F.wave, lane = F.lane, tid = F.tid;
    const int nitems = NTILE64 * 8;
    const int sr = tid >> 3, sc8 = tid & 7; const int hrr = (tid >> 3) == 0 ? -2 : ((tid >> 3) == 1 ? -1 : 64);
    const int gd = wave >> 2, gmf = wave & 3, gfr = lane & 15, gfq = lane >> 4;
    bf16x8 bw[2][4][2]; float cba[4], cbx[4], ccA[4];
    LAS float* cwS = (LAS float*)(xcB + 64 * 72);
    {   const int h = (int)blockIdx.x & 7;
#pragma unroll
        for (int g2 = 0; g2 < 2; ++g2)
#pragma unroll
            for (int nf = 0; nf < 4; ++nf)
#pragma unroll
                for (int ks = 0; ks < 2; ++ks) bw[g2][nf][ks] = *(const bf16x8*)(LW + ((size_t)(((gd * 2 + g2) * 8 + h) * 64 + 16 * nf + gfr)) * 64 + 32 * ks + 8 * gfq);
#pragma unroll
        for (int nf = 0; nf < 4; ++nf) { const int gch = gd * 512 + h * 64 + 16 * nf + gfr; cba[nf] = p.in[I_LRUBA][gch]; cbx[nf] = p.in[I_LRUBX][gch];
            ccA[nf] = -8.0f * 1.4426950408889634f * log1pf(__expf(-p.in[I_LRULAM][gch])); }
        if (tid < 256) cwS[tid] = p.in[I_CONVW][(tid >> 6) * 512 + h * 64 + (tid & 63)]; else if (tid < 320) cwS[tid] = p.in[I_CONVB][h * 64 + (tid - 256)];
        __syncthreads(); }
    u32x4 wrec = (u32x4){0u, 0u, 0u, 0u}, whalo = (u32x4){0u, 0u, 0u, 0u};
    auto tile_geom = [&](int item, int& T, int& h, int& b, int& jt, int& R0) { T = item >> 3; h = item & 7; b = T / 132; jt = T % 132; R0 = b * LR + jt * 64; };
    auto issue_rec = [&](int item) { int T, h, b, jt, R0; tile_geom(item, T, h, b, jt, R0); const bool isctx = jt < 4; const int slo = isctx ? 0 : CTXL, shi = isctx ? CTXL : LR;
        wrec = *(const u32x4*)(Z + (size_t)(R0 + sr) * 2048 + 512 + h * 64 + sc8 * 8);
        whalo = (u32x4){0u, 0u, 0u, 0u};
        if (tid < 24) { const int jj = jt * 64 + hrr; if (jj >= slo && jj < shi) whalo = *(const u32x4*)(Z + (size_t)(R0 + hrr) * 2048 + 512 + h * 64 + sc8 * 8); } };
    if ((int)blockIdx.x < nitems) issue_rec(blockIdx.x);
    for (int item = blockIdx.x; item < nitems; item += F.G) {
        int T, h, b, jt, R0; tile_geom(item, T, h, b, jt, R0); const bool isctx = jt < 4;
        u32x4 wgate = (u32x4){0u, 0u, 0u, 0u};
        if (full) wgate = *(const u32x4*)(Z + (size_t)(R0 + sr) * 2048 + h * 64 + sc8 * 8);
        { LAS float* d = recS + (sr + 2) * 64 + sc8 * 8; const u32x4 w = wrec;
          d[0] = bflo(w.x); d[1] = bfhi(w.x); d[2] = bflo(w.y); d[3] = bfhi(w.y); d[4] = bflo(w.z); d[5] = bfhi(w.z); d[6] = bflo(w.w); d[7] = bfhi(w.w);
          if (tid < 24) { LAS float* d2 = recS + (hrr + 2) * 64 + sc8 * 8; const u32x4 w2 = whalo;
              d2[0] = bflo(w2.x); d2[1] = bfhi(w2.x); d2[2] = bflo(w2.y); d2[3] = bfhi(w2.y); d2[4] = bflo(w2.z); d2[5] = bfhi(w2.z); d2[6] = bflo(w2.w); d2[7] = bfhi(w2.w); } }
        if (item + F.G < nitems) issue_rec(item + F.G);
        __syncthreads();
        { const int r = sr, c8 = sc8 * 8;
          float y[8];
#pragma unroll
          for (int i = 0; i < 8; ++i) y[i] = cwS[256 + c8 + i];
#pragma unroll
          for (int q = 0; q < 4; ++q) { const f32x4 x0 = *(const LAS f32x4*)(recS + (r + q) * 64 + c8), x1 = *(const LAS f32x4*)(recS + (r + q) * 64 + c8 + 4);
              const f32x4 w0 = *(const LAS f32x4*)(cwS + q * 64 + c8), w1 = *(const LAS f32x4*)(cwS + q * 64 + c8 + 4);
              y[0] += w0[0] * x0[0]; y[1] += w0[1] * x0[1]; y[2] += w0[2] * x0[2]; y[3] += w0[3] * x0[3]; y[4] += w1[0] * x1[0]; y[5] += w1[1] * x1[1]; y[6] += w1[2] * x1[2]; y[7] += w1[3] * x1[3]; }
          *(LAS f32x4*)(xcF + r * 64 + c8) = (f32x4){y[0], y[1], y[2], y[3]}; *(LAS f32x4*)(xcF + r * 64 + c8 + 4) = (f32x4){y[4], y[5], y[6], y[7]};
          u32x4 w; w.x = pk2(y[0], y[1]); w.y = pk2(y[2], y[3]); w.z = pk2(y[4], y[5]); w.w = pk2(y[6], y[7]);
          *(LAS u32x4*)(xcB + r * 72 + c8) = w; }
        __syncthreads();
        { const int d = gd, mf = gmf, fr = gfr, fq = gfq;
          bf16x8 af[2];
#pragma unroll
          for (int ks = 0; ks < 2; ++ks) af[ks] = *(const LAS bf16x8*)(xcB + (16 * mf + fr) * 72 + 32 * ks + 8 * fq);
          f32x4 acc[2][4];
#pragma unroll
          for (int g2 = 0; g2 < 2; ++g2)
#pragma unroll
              for (int nf = 0; nf < 4; ++nf) { acc[g2][nf] = (f32x4){0.f, 0.f, 0.f, 0.f};
#pragma unroll
                  for (int ks = 0; ks < 2; ++ks) acc[g2][nf] = __builtin_amdgcn_mfma_f32_16x16x32_bf16(af[ks], bw[g2][nf][ks], acc[g2][nf], 0, 0, 0); }
#pragma unroll
          for (int nf = 0; nf < 4; ++nf) { const int ch = 16 * nf + fr; const float ba = cba[nf], bx = cbx[nf], cA = ccA[nf];
#pragma unroll
              for (int r = 0; r < 4; ++r) { const int tk = 16 * mf + 4 * fq + r;
                  const float rg = __builtin_amdgcn_rcpf(1.0f + __builtin_amdgcn_exp2f(-1.4426950408889634f * (acc[0][nf][r] + ba)));
                  const float ig = __builtin_amdgcn_rcpf(1.0f + __builtin_amdgcn_exp2f(-1.4426950408889634f * (acc[1][nf][r] + bx)));
                  const float a = __builtin_amdgcn_exp2f(rg * cA), mult = __builtin_amdgcn_sqrtf(fmaf(-a, a, 1.0f));
                  aS[(d * 64 + tk) * 64 + ch] = a; uS[(d * 64 + tk) * 64 + ch] = mult * ig * xcF[tk * 64 + ch]; } } }
        __syncthreads();
        if (full && tid < 128) cst[1024 + tid] = ((const float*)(p.ws + WS_CAR))[((size_t)T * 2 + (tid >> 6)) * 512 + h * 64 + (tid & 63)];
        {
            const int dc = tid & 127, d = dc >> 6, ch = dc & 63, sg = tid >> 7;
            const LAS float* ap = aS + d * 4096 + ch; LAS float* up = uS + d * 4096 + ch;
            const int tfirst = d == 0 ? 16 * sg : 63 - 16 * sg, tstep_ = d == 0 ? 64 : -64;
            float av[16], uv[16];
#pragma unroll
            for (int i = 0; i < 16; ++i) { av[i] = ap[tfirst * 64 + i * tstep_]; uv[i] = up[tfirst * 64 + i * tstep_]; }
            float P = 1.f, hs = 0.f;
#pragma unroll
            for (int i = 0; i < 16; ++i) { hs = av[i] * hs + uv[i]; P *= av[i]; uv[i] = hs; }
            asm volatile("" ::: "memory");
            __syncthreads();
            cst[(sg * 128 + dc) * 2] = P; cst[(sg * 128 + dc) * 2 + 1] = hs;
            __syncthreads();
            float cin = full ? cst[1024 + dc] : 0.f;
            float Pt = 1.f;
#pragma unroll
            for (int q = 0; q < 4; ++q) { const float Pq = cst[(q * 128 + dc) * 2], Hq = cst[(q * 128 + dc) * 2 + 1];
                if (q < sg) cin = Pq * cin + Hq;
                Pt *= Pq; }
            if (!full) { if (sg == 3) SUM[((size_t)T * 2 + d) * 512 + h * 64 + ch] = (f32x2){Pt, cst[(3 * 128 + dc) * 2 + 1] + cst[(3 * 128 + dc) * 2] * cin}; }
            else { float pp = cin;
#pragma unroll
                for (int i = 0; i < 16; ++i) { pp *= ap[tfirst * 64 + i * tstep_]; up[tfirst * 64 + i * tstep_] = uv[i] + pp; } }
        }
        __syncthreads();
        if (full) { const int r = sr, c8 = sc8 * 8; const u32x4 gw_ = wgate;
            float gg[8] = {bflo(gw_.x), bfhi(gw_.x), bflo(gw_.y), bfhi(gw_.y), bflo(gw_.z), bfhi(gw_.z), bflo(gw_.w), bfhi(gw_.w)}; float y[8];
            const f32x4 f0 = *(const LAS f32x4*)(uS + r * 64 + c8), f1 = *(const LAS f32x4*)(uS + r * 64 + c8 + 4), b0 = *(const LAS f32x4*)(uS + (64 + r) * 64 + c8), b1 = *(const LAS f32x4*)(uS + (64 + r) * 64 + c8 + 4);
            y[0] = gg[0] * (f0[0] + b0[0]); y[1] = gg[1] * (f0[1] + b0[1]); y[2] = gg[2] * (f0[2] + b0[2]); y[3] = gg[3] * (f0[3] + b0[3]);
            y[4] = gg[4] * (f1[0] + b1[0]); y[5] = gg[5] * (f1[1] + b1[1]); y[6] = gg[6] * (f1[2] + b1[2]); y[7] = gg[7] * (f1[3] + b1[3]);
            u32x4 w; w.x = pk2(y[0], y[1]); w.y = pk2(y[2], y[3]); w.z = pk2(y[4], y[5]); w.w = pk2(y[6], y[7]);
            *(u32x4*)(YC + (size_t)(R0 + r) * DM + h * 64 + c8) = w; }
        __syncthreads();
    }
}

__device__ __forceinline__ void p_lru_carry(const Ctx& F, const Params& p) {
    const f32x2* SUM = (const f32x2*)(p.ws + WS_SUM); float* CAR = (float*)(p.ws + WS_CAR);
    const int task = (int)blockIdx.x - (F.G - 4);
    if (task < 0) return;
    const int tk = task * NWAVES + F.wave, b = tk >> 4, d = (tk >> 3) & 1, h = tk & 7, ch = h * 64 + F.lane;
    float st = 0.f;
    for (int i0 = 0; i0 < 132; i0 += 33) {
        f32x2 sv[33];
#pragma unroll
        for (int k = 0; k < 33; ++k) { const int i = i0 + k; const int jp = d == 0 ? i : (i < 4 ? 3 - i : 135 - i); sv[k] = SUM[((size_t)(b * 132 + jp) * 2 + d) * 512 + ch]; }
#pragma unroll
        for (int k = 0; k < 33; ++k) { const int i = i0 + k; const int jp = d == 0 ? i : (i < 4 ? 3 - i : 135 - i);
            CAR[((size_t)(b * 132 + jp) * 2 + d) * 512 + ch] = st; st = sv[k].x * st + sv[k].y; }
    }
}

__device__ __forceinline__ void p_cm(const Ctx& F, const Params& p) {
    const int GB = F.G - 8;
    if ((int)blockIdx.x >= GB) return;
    const bf16_t* Z = (const bf16_t*)(p.ws + WS_ACT + ACT_Z); bf16_t* YC = (bf16_t*)(p.ws + WS_ACT + ACT_YCAT); const bf16_t* CW = (const bf16_t*)(p.ws + WS_CMWS);
    LAS bf16_t* vnT = (LAS bf16_t*)F.lds;
    LAS float* mix = (LAS float*)(F.lds + 32768);
    const int wave = F.wave, lane = F.lane, tid = F.tid, fr = lane & 15, fq = lane >> 4;
    const int nitems = (NR / 128) * 8; const int q = tid >> 2, part = tid & 3;
    bf16x8 afr[4]; float bsr[4]; float vgr[16];
    {   const int g = (int)blockIdx.x & 7;
#pragma unroll
        for (int ks = 0; ks < 4; ++ks) afr[ks] = *(const bf16x8*)(CW + ((size_t)g * 128 + 16 * wave + fr) * 128 + 32 * ks + 8 * fq);
#pragma unroll
        for (int r = 0; r < 4; ++r) bsr[r] = p.in[I_CMBS][g * 128 + 16 * wave + 4 * fq + r];
#pragma unroll
        for (int i = 0; i < 16; ++i) vgr[i] = p.in[I_CMVG][g * 64 + part * 16 + i]; }
    u32x4 wv0 = (u32x4){0u, 0u, 0u, 0u}, wv1 = wv0;
    auto issue_v = [&](int item) { const int cn = item >> 3, g = item & 7; const bf16_t* src = Z + (size_t)(cn * 128 + q) * 2048 + 1536 + g * 64 + part * 16; wv0 = *(const u32x4*)src; wv1 = *(const u32x4*)(src + 8); };
    if ((int)blockIdx.x < nitems) issue_v(blockIdx.x);
    for (int item = blockIdx.x; item < nitems; item += GB) {
        const int cn = item >> 3, g = item & 7; const int R0 = cn * 128;
        const bf16_t* usrc = Z + (size_t)(R0 + q) * 2048 + 1024 + g * 64 + part * 16; const u32x4 wu0 = *(const u32x4*)usrc, wu1 = *(const u32x4*)(usrc + 8);
        { const u32x4 w0 = wv0, w1 = wv1;
          float v[16] = {bflo(w0.x), bfhi(w0.x), bflo(w0.y), bfhi(w0.y), bflo(w0.z), bfhi(w0.z), bflo(w0.w), bfhi(w0.w), bflo(w1.x), bfhi(w1.x), bflo(w1.y), bfhi(w1.y), bflo(w1.z), bfhi(w1.z), bflo(w1.w), bfhi(w1.w)};
          float ss = 0.f;
#pragma unroll
          for (int i = 0; i < 16; ++i) ss += v[i] * v[i];
          ss += __shfl_xor(ss, 1); ss += __shfl_xor(ss, 2);
          const float rstd = 1.0f / sqrtf(ss * (1.0f / 64.0f) + EPS);
#pragma unroll
          for (int i = 0; i < 16; ++i) vnT[(part * 16 + i) * 136 + q] = (bf16_t)f2bf(v[i] * rstd * vgr[i]); }
        if (item + GB < nitems) issue_v(item + GB);
        __syncthreads();
        f32x4 acc[4];
#pragma unroll
        for (int nf = 0; nf < 4; ++nf) acc[nf] = (f32x4){0.f, 0.f, 0.f, 0.f};
#pragma unroll
        for (int ks = 0; ks < 4; ++ks)
#pragma unroll
            for (int nf = 0; nf < 4; ++nf) { const bf16x8 bfr = *(const LAS bf16x8*)(vnT + (16 * nf + fr) * 136 + 32 * ks + 8 * fq);
                acc[nf] = __builtin_amdgcn_mfma_f32_16x16x32_bf16(afr[ks], bfr, acc[nf], 0, 0, 0); }
#pragma unroll
        for (int r = 0; r < 4; ++r) { const int pp = 16 * wave + 4 * fq + r;
#pragma unroll
            for (int nf = 0; nf < 4; ++nf) mix[pp * 68 + 16 * nf + fr] = acc[nf][r] + bsr[r]; }
        __syncthreads();
        { float ug[16] = {bflo(wu0.x), bfhi(wu0.x), bflo(wu0.y), bfhi(wu0.y), bflo(wu0.z), bfhi(wu0.z), bflo(wu0.w), bfhi(wu0.w), bflo(wu1.x), bfhi(wu1.x), bflo(wu1.y), bfhi(wu1.y), bflo(wu1.z), bfhi(wu1.z), bflo(wu1.w), bfhi(wu1.w)};
          const LAS float* mr = mix + q * 68 + part * 16; float y[16];
#pragma unroll
          for (int i = 0; i < 16; i += 4) { const f32x4 mv = *(const LAS f32x4*)(mr + i); y[i] = ug[i] * mv[0]; y[i + 1] = ug[i + 1] * mv[1]; y[i + 2] = ug[i + 2] * mv[2]; y[i + 3] = ug[i + 3] * mv[3]; }
          u32x4 o0, o1; o0.x = pk2(y[0], y[1]); o0.y = pk2(y[2], y[3]); o0.z = pk2(y[4], y[5]); o0.w = pk2(y[6], y[7]); o1.x = pk2(y[8], y[9]); o1.y = pk2(y[10], y[11]); o1.z = pk2(y[12], y[13]); o1.w = pk2(y[14], y[15]);
          bf16_t* dst = YC + (size_t)(R0 + q) * DM + 512 + g * 64 + part * 16; *(u32x4*)dst = o0; *(u32x4*)(dst + 8) = o1; }
        __syncthreads();
    }
}

__device__ __forceinline__ void sg_tile(const bf16_t* A, size_t lda, const bf16_t* Bt, size_t ldb, int K, int lane, f32x4 (&acc)[4][2]) {
    const int fr = lane & 15, fq = lane >> 4;
#pragma unroll
    for (int m = 0; m < 4; ++m)
#pragma unroll
        for (int n = 0; n < 2; ++n) acc[m][n] = (f32x4){0.f, 0.f, 0.f, 0.f};
    const bf16_t* ap = A + (size_t)fr * lda + 8 * fq; const bf16_t* bp = Bt + (size_t)fr * ldb + 8 * fq;
#pragma unroll 4
    for (int k = 0; k < K; k += 32) {
        bf16x8 af[4], bfr[2];
#pragma unroll
        for (int m = 0; m < 4; ++m) af[m] = *(const bf16x8*)(ap + (size_t)(16 * m) * lda + k);
#pragma unroll
        for (int n = 0; n < 2; ++n) bfr[n] = *(const bf16x8*)(bp + (size_t)(16 * n) * ldb + k);
#pragma unroll
        for (int m = 0; m < 4; ++m)
#pragma unroll
            for (int n = 0; n < 2; ++n) acc[m][n] = __builtin_amdgcn_mfma_f32_16x16x32_bf16(bfr[n], af[m], acc[m][n], 0, 0, 0);
    }
}
__device__ __forceinline__ size_t ctx_row0(int rt8) { return (size_t)(rt8 >> 2) * LR + (size_t)(rt8 & 3) * 64; }
__device__ __forceinline__ void sg_block64(const Ctx& F, const bf16_t* A, size_t lda, const bf16_t* Bt, size_t ldb, int K, f32x4 (&out)[2]) {
    const int kw = K / NWAVES, fr = F.lane & 15, fq = F.lane >> 4;
    f32x4 acc[4][4];
#pragma unroll
    for (int m = 0; m < 4; ++m)
#pragma unroll
        for (int n = 0; n < 4; ++n) acc[m][n] = (f32x4){0.f, 0.f, 0.f, 0.f};
    const bf16_t* ap = A + (size_t)fr * lda + F.wave * kw + 8 * fq; const bf16_t* bp = Bt + (size_t)fr * ldb + F.wave * kw + 8 * fq;
#pragma unroll 4
    for (int k = 0; k < kw; k += 32) {
        bf16x8 af[4], bfr[4];
#pragma unroll
        for (int m = 0; m < 4; ++m) af[m] = *(const bf16x8*)(ap + (size_t)(16 * m) * lda + k);
#pragma unroll
        for (int n = 0; n < 4; ++n) bfr[n] = *(const bf16x8*)(bp + (size_t)(16 * n) * ldb + k);
#pragma unroll
        for (int m = 0; m < 4; ++m)
#pragma unroll
            for (int n = 0; n < 4; ++n) acc[m][n] = __builtin_amdgcn_mfma_f32_16x16x32_bf16(bfr[n], af[m], acc[m][n], 0, 0, 0);
    }
    LAS float* part = (LAS float*)F.lds;
#pragma unroll
    for (int m = 0; m < 4; ++m)
#pragma unroll
        for (int n = 0; n < 4; ++n) *(LAS f32x4*)(part + ((F.wave * 64 + 16 * m + fr) * 64 + 16 * n + 4 * fq)) = acc[m][n];
    __syncthreads();
    out[0] = (f32x4){0.f, 0.f, 0.f, 0.f}; out[1] = out[0];
#pragma unroll
    for (int w = 0; w < NWAVES; ++w) { out[0] += *(const LAS f32x4*)(part + w * 4096 + F.tid * 8); out[1] += *(const LAS f32x4*)(part + w * 4096 + F.tid * 8 + 4); }
    __syncthreads();
}
__device__ __forceinline__ void p_ctx_dense(const Ctx& F, const Params& p, int which) {
    unsigned char* ws = p.ws; const float* mod = (const float*)(ws + WS_MOD);
    const int ncg = which == 0 ? 32 : (which == 1 ? 16 : 32), nunits = 8 * ncg; const int row = F.tid >> 3, c8 = (F.tid & 7) * 8;
    for (int uidx = F.vcu; uidx < nunits; uidx += F.G) {
        const int rt8 = uidx / ncg, cgp = uidx % ncg; const size_t R0 = ctx_row0(rt8), R = R0 + row; const int c = cgp * 64 + c8; f32x4 v[2];
        if (which == 0) { sg_block64(F, (const bf16_t*)(ws + WS_H) + R0 * DM, DM, (const bf16_t*)(ws + WS_WIN) + (size_t)cgp * 64 * DM, DM, DM, v);
            if (cgp < 8 || cgp >= 16) {
#pragma unroll
                for (int i = 0; i < 4; ++i) { v[0][i] = gelu_tanh(v[0][i]); v[1][i] = gelu_tanh(v[1][i]); } }
            u32x4 w; const u32x2 a = pk4(v[0]), b = pk4(v[1]); w.x = a.x; w.y = a.y; w.z = b.x; w.w = b.y;
            *(u32x4*)((bf16_t*)(ws + WS_ACT + ACT_Z) + R * 2048 + c) = w; }
        else if (which == 1) { sg_block64(F, (const bf16_t*)(ws + WS_ACT + ACT_YCAT) + R0 * DM, DM, (const bf16_t*)(ws + WS_WOUT0) + (size_t)cgp * 64 * DM, DM, DM, v);
            const float* cin = p.in[I_CTX] + ((size_t)(rt8 >> 2) * CTXL + (size_t)(rt8 & 3) * 64 + row) * DM; const float* g1 = mod + 2 * 6144 + 2 * DM;
            const f32x4 o0 = *(const f32x4*)(cin + c) + *(const f32x4*)(g1 + c) * v[0], o1 = *(const f32x4*)(cin + c + 4) + *(const f32x4*)(g1 + c + 4) * v[1];
            u32x4 w; const u32x2 a = pk4(o0), b = pk4(o1); w.x = a.x; w.y = a.y; w.z = b.x; w.w = b.y;
            *(u32x4*)((bf16_t*)(ws + WS_X) + R * DM + c) = w; }
        else { sg_block64(F, (const bf16_t*)(ws + WS_H) + R0 * DM, DM, (const bf16_t*)(ws + WS_WQKV) + (size_t)(1024 + cgp * 64) * DM, DM, DM, v);
            bf16_t* dst = (bf16_t*)(ws + WS_ACT + (cgp < 16 ? ACT_K : ACT_V));
            u32x4 w; const u32x2 a = pk4(v[0]), b = pk4(v[1]); w.x = a.x; w.y = a.y; w.z = b.x; w.w = b.y;
            *(u32x4*)(dst + R * DM + (cgp & 15) * 64 + c8) = w; }
    }
}
__device__ __forceinline__ void p_ctx_moe(const Ctx& F, const Params& p, int which, int layer = 0) {
    unsigned char* ws = p.ws;
    typedef int v8i32 __attribute__((ext_vector_type(8))); typedef float f32x16 __attribute__((ext_vector_type(16)));
    const int l31 = F.lane & 31, hh = F.lane >> 5;
    if (which == 0) {
        LAS unsigned char* As = F.lds;
        for (int uidx = F.vcu; uidx < NE * 16; uidx += F.G) {
            const int e = uidx >> 4, cgp = (uidx & 15) * 8 + F.wave; const size_t er0 = (size_t)e * EROWS + 2048;
            { const int* ridx = (const int*)(ws + WS_ROWIDX) + er0; u32x4 t[8];
#pragma unroll
              for (int i = 0; i < 8; ++i) t[i] = ((const u32x4*)(ws + WS_H + (size_t)ridx[F.wave + 8 * i] * DM))[F.lane];
#pragma unroll
              for (int i = 0; i < 8; ++i) { const int g = F.tid + 512 * i, r = g >> 6, c = g & 63; *(LAS u32x4*)(As + r * 1024 + 16 * (c ^ (r & 15))) = t[i]; } }
            __syncthreads();
            const unsigned char* bp = ws + WS_W13 + ((size_t)layer * NE * 4096 + (size_t)e * 4096 + (size_t)cgp * 32 + l31) * DM + 32 * hh;
            f32x16 acc[2]; acc[0] = f32x16{}; acc[1] = f32x16{};
#pragma unroll 8
            for (int ks = 0; ks < 16; ++ks) {
                const u32x4 b0 = *(const u32x4*)(bp + 64 * ks), b1 = *(const u32x4*)(bp + 64 * ks + 16); const v8i32 bf = {(int)b0.x, (int)b0.y, (int)b0.z, (int)b0.w, (int)b1.x, (int)b1.y, (int)b1.z, (int)b1.w};
#pragma unroll
                for (int m = 0; m < 2; ++m) { const int r = 32 * m + l31, c0 = 4 * ks + 2 * hh;
                    const u32x4 a0 = *(const LAS u32x4*)(As + r * 1024 + 16 * (c0 ^ (r & 15))), a1 = *(const LAS u32x4*)(As + r * 1024 + 16 * ((c0 + 1) ^ (r & 15)));
                    const v8i32 af = {(int)a0.x, (int)a0.y, (int)a0.z, (int)a0.w, (int)a1.x, (int)a1.y, (int)a1.z, (int)a1.w};
                    acc[m] = __builtin_amdgcn_mfma_scale_f32_32x32x64_f8f6f4(bf, af, acc[m], 0, 0, 0, 0x7f7f7f7f, 0, 0x7f7f7f7f); } }
            unsigned char* HID = ws + WS_ACT + ACT_HID;
#pragma unroll
            for (int m = 0; m < 2; ++m)
#pragma unroll
                for (int q = 0; q < 2; ++q) {
                    float hv[4];
#pragma unroll
                    for (int i = 0; i < 4; ++i) hv[i] = silu_f(acc[m][4 * q + i] * W8_INV) * (acc[m][8 + 4 * q + i] * W8_INV);
                    *(unsigned*)(HID + (er0 + 32 * m + l31) * FF + cgp * 16 + 8 * q + 4 * hh) = f2fp8x4(hv[0], hv[1], hv[2], hv[3]); }
            __syncthreads();
        }
    } else {
        const int row = F.tid >> 3, c8 = (F.tid & 7) * 8; LAS float* part = (LAS float*)F.lds;
        for (int uidx = F.vcu; uidx < NE * 16; uidx += F.G) {
            const int e = uidx >> 4, cgp = uidx & 15; const size_t er0 = (size_t)e * EROWS + 2048;
            const unsigned char* ap = ws + WS_ACT + ACT_HID + (er0 + l31) * FF + F.wave * 256 + 32 * hh;
            const unsigned char* bp = ws + WS_W2 + ((size_t)layer * NE * DM + (size_t)e * DM + (size_t)cgp * 64 + l31) * FF + F.wave * 256 + 32 * hh;
            f32x16 acc[2][2]; acc[0][0] = f32x16{}; acc[0][1] = f32x16{}; acc[1][0] = f32x16{}; acc[1][1] = f32x16{};
#pragma unroll
            for (int k = 0; k < 256; k += 64) {
                v8i32 af[2], bf[2];
#pragma unroll
                for (int m = 0; m < 2; ++m) { const u32x4 a0 = *(const u32x4*)(ap + (size_t)m * 32 * FF + k), a1 = *(const u32x4*)(ap + (size_t)m * 32 * FF + k + 16);
                    af[m] = (v8i32){(int)a0.x, (int)a0.y, (int)a0.z, (int)a0.w, (int)a1.x, (int)a1.y, (int)a1.z, (int)a1.w}; }
#pragma unroll
                for (int n = 0; n < 2; ++n) { const u32x4 b0 = *(const u32x4*)(bp + (size_t)n * 32 * FF + k), b1 = *(const u32x4*)(bp + (size_t)n * 32 * FF + k + 16);
                    bf[n] = (v8i32){(int)b0.x, (int)b0.y, (int)b0.z, (int)b0.w, (int)b1.x, (int)b1.y, (int)b1.z, (int)b1.w}; }
#pragma unroll
                for (int m = 0; m < 2; ++m)
#pragma unroll
                    for (int n = 0; n < 2; ++n) acc[m][n] = __builtin_amdgcn_mfma_scale_f32_32x32x64_f8f6f4(bf[n], af[m], acc[m][n], 0, 0, 0, 0x7f7f7f7f, 0, 0x7f7f7f7f); }
#pragma unroll
            for (int m = 0; m < 2; ++m)
#pragma unroll
                for (int n = 0; n < 2; ++n)
#pragma unroll
                    for (int q = 0; q < 4; ++q) *(LAS f32x4*)(part + ((F.wave * 64 + 32 * m + l31) * 64 + 32 * n + 8 * q + 4 * hh)) = (f32x4){acc[m][n][4 * q], acc[m][n][4 * q + 1], acc[m][n][4 * q + 2], acc[m][n][4 * q + 3]};
            __syncthreads();
            f32x4 v0 = (f32x4){0.f, 0.f, 0.f, 0.f}, v1 = v0;
#pragma unroll
            for (int w = 0; w < NWAVES; ++w) { v0 += *(const LAS f32x4*)(part + w * 4096 + F.tid * 8); v1 += *(const LAS f32x4*)(part + w * 4096 + F.tid * 8 + 4); }
            __syncthreads();
            const float gt = ((const float*)(ws + WS_GATE))[er0 + row] * (W8_INV * YB_SCALE);
            u32x2 w; w.x = f2fp8x4(v0[0] * gt, v0[1] * gt, v0[2] * gt, v0[3] * gt); w.y = f2fp8x4(v1[0] * gt, v1[1] * gt, v1[2] * gt, v1[3] * gt);
            *(u32x2*)(ws + WS_XS + (er0 + row) * DM + cgp * 64 + c8) = w;
        }
    }
}

__device__ __forceinline__ void p_attn(const Ctx& F, const Params& p, unsigned char* lds_generic) {
    using abf = attn_body::bf16;
    const abf* Q = (const abf*)(p.ws + WS_ACT + ACT_Q); const abf* Kb = (const abf*)(p.ws + WS_ACT + ACT_K); const abf* Vb = (const abf*)(p.ws + WS_ACT + ACT_V);
    const bf16_t* O1 = (const bf16_t*)(p.ws + WS_ACT + ACT_O1); const bf16_t* O2 = (const bf16_t*)(p.ws + WS_ACT + ACT_O2); bf16_t* A = (bf16_t*)(p.ws + WS_XS);
    const int wid = F.wave;
    for (int i = 0; i < 4; ++i) { const int bh = (i >> 1) * 8 + (F.vcu >> 5), qb = F.vcu & 31, sub = (i & 1) * 2 + 1;
        const int b = bh >> 3, h = bh & 7, m = i & 1;
        abf* O = (abf*)(p.ws + WS_ACT + (m ? ACT_O2 : ACT_O1));
        const abf* Qw = Q + ((size_t)b * LR + CTXL + qb * 256 + wid * 32) * DM + (h * 2 + m) * 64;
        const abf* Kh = Kb + (size_t)b * LR * DM + (h * 2 + m) * 64;
        const abf* Vh = Vb + (size_t)b * LR * DM + h * 128;
        abf* Ow = O + ((size_t)b * SEQ + qb * 256 + wid * 32) * DM + h * 128;
        attn_body::attn_unit128<8>(Qw, Kh, Vh, Ow, (char*)lds_generic);
        if (sub == 3) {
            asm volatile("s_waitcnt vmcnt(0)" ::: "memory");
            int lane2 = threadIdx.x & 63; asm volatile("" : "+v"(lane2));
            const float lam_init = 0.8f - 0.6f * expf(-0.3f);
            float s1 = p.in[I_LQ1][lane2] * p.in[I_LK1][lane2], s2 = p.in[I_LQ2][lane2] * p.in[I_LK2][lane2];
            s1 = wave_sum(s1); s2 = wave_sum(s2);
            const float lam = expf(s1) - expf(s2) + lam_init, osc = 1.0f - lam_init;
            const size_t row0 = (size_t)b * SEQ + qb * 256 + wid * 32; const int lr = lane2 >> 3, c16 = 16 * (lane2 & 7);
            f32x4 gsub[4];
#pragma unroll
            for (int q = 0; q < 4; ++q) gsub[q] = *(const f32x4*)(p.in[I_SUBLN] + c16 + 4 * q);
            u32x4 xx[4][4];
#pragma unroll
            for (int k = 0; k < 4; ++k) { const size_t r = row0 + 8 * k + lr; const u32x4* a1 = (const u32x4*)(O1 + r * DM + h * 128 + c16); const u32x4* a2 = (const u32x4*)(O2 + r * DM + h * 128 + c16);
                xx[k][0] = a1[0]; xx[k][1] = a1[1]; xx[k][2] = a2[0]; xx[k][3] = a2[1]; }
#pragma unroll
            for (int k = 0; k < 4; ++k) { const size_t r = row0 + 8 * k + lr;
                const u32x4 x0 = xx[k][0], x1 = xx[k][1], y0 = xx[k][2], y1 = xx[k][3];
                float o[16];
                o[0] = bflo(x0.x) - lam * bflo(y0.x); o[1] = bfhi(x0.x) - lam * bfhi(y0.x); o[2] = bflo(x0.y) - lam * bflo(y0.y); o[3] = bfhi(x0.y) - lam * bfhi(y0.y);
                o[4] = bflo(x0.z) - lam * bflo(y0.z); o[5] = bfhi(x0.z) - lam * bfhi(y0.z); o[6] = bflo(x0.w) - lam * bflo(y0.w); o[7] = bfhi(x0.w) - lam * bfhi(y0.w);
                o[8] = bflo(x1.x) - lam * bflo(y1.x); o[9] = bfhi(x1.x) - lam * bfhi(y1.x); o[10] = bflo(x1.y) - lam * bflo(y1.y); o[11] = bfhi(x1.y) - lam * bfhi(y1.y);
                o[12] = bflo(x1.z) - lam * bflo(y1.z); o[13] = bfhi(x1.z) - lam * bfhi(y1.z); o[14] = bflo(x1.w) - lam * bflo(y1.w); o[15] = bfhi(x1.w) - lam * bfhi(y1.w);
                float ss = 0.f;
#pragma unroll
                for (int q = 0; q < 16; ++q) ss += o[q] * o[q];
                ss += __shfl_xor(ss, 1); ss += __shfl_xor(ss, 2); ss += __shfl_xor(ss, 4);
                const float rstd = osc / sqrtf(ss * (1.0f / 128.0f) + EPS);
                u32x4 w0, w1;
                w0.x = pk2(o[0] * rstd * gsub[0][0], o[1] * rstd * gsub[0][1]); w0.y = pk2(o[2] * rstd * gsub[0][2], o[3] * rstd * gsub[0][3]);
                w0.z = pk2(o[4] * rstd * gsub[1][0], o[5] * rstd * gsub[1][1]); w0.w = pk2(o[6] * rstd * gsub[1][2], o[7] * rstd * gsub[1][3]);
                w1.x = pk2(o[8] * rstd * gsub[2][0], o[9] * rstd * gsub[2][1]); w1.y = pk2(o[10] * rstd * gsub[2][2], o[11] * rstd * gsub[2][3]);
                w1.z = pk2(o[12] * rstd * gsub[3][0], o[13] * rstd * gsub[3][1]); w1.w = pk2(o[14] * rstd * gsub[3][2], o[15] * rstd * gsub[3][3]);
                u32x4* d = (u32x4*)(A + r * DM + h * 128 + c16); d[0] = w0; d[1] = w1; }
        }
    }
}

#define XB_TMO      128
#define XB_XCNT(j)  (256  + 64 * (j))
#define XB_XSUB(j)  (1280 + 64 * (j))
#define XB_XGEN(j)  (2304 + 64 * (j))
#define XB_TOP      3328
#define XB_TOPGEN   3392
#define XCD_BAR_WORDS 3456
#define XB_SPIN_CAP (1u << 18)
__device__ __forceinline__ unsigned xb_ld(unsigned* p)              { return __hip_atomic_load(p, __ATOMIC_RELAXED, __HIP_MEMORY_SCOPE_AGENT); }
__device__ __forceinline__ unsigned xb_add(unsigned* p, unsigned v) { return __hip_atomic_fetch_add(p, v, __ATOMIC_RELAXED, __HIP_MEMORY_SCOPE_AGENT); }
__device__ __forceinline__ unsigned xb_xcc_id() { return (unsigned)__builtin_amdgcn_s_getreg((3 << 11) | 20) & 0xFu; }
#define XB_SPIN(cond, bar) do { unsigned _sp = 0; while (cond) { __builtin_amdgcn_s_sleep(1); \
    if ((++_sp & 255u) == 0u) { if (xb_ld(&(bar)[XB_TMO])) break; if (_sp > XB_SPIN_CAP) { atomicAdd(&(bar)[XB_TMO], 1u); break; } } } } while (0)
struct XcdBarrier { unsigned* bar; unsigned x; volatile LAS unsigned* st; };
__device__ __forceinline__ void xcd_barrier_complete(unsigned* bar, unsigned x, unsigned& nloc, unsigned& nx) {
    const unsigned G = gridDim.x * gridDim.y * gridDim.z;
    unsigned sum, cnt, mine, sp = 0u;
    for (;;) {
        sum = 0u; cnt = 0u; mine = 0u;
#pragma unroll
        for (unsigned j = 0; j < 16; ++j) { const unsigned c = xb_ld(&bar[XB_XCNT(j)]); sum += c; cnt += (c > 0u) ? 1u : 0u; mine = (j == x) ? c : mine; }
        if (sum == G) break;
        __builtin_amdgcn_s_sleep(1);
        if ((++sp & 255u) == 0u) { if (xb_ld(&bar[XB_TMO])) break; if (sp > XB_SPIN_CAP) { atomicAdd(&bar[XB_TMO], 1u); break; } }
    }
    nloc = mine > 0u ? mine : 1u; nx = cnt > 0u ? cnt : 1u;
}
__device__ __forceinline__ void xcd_barrier(const XcdBarrier& b) {
    asm volatile("s_waitcnt vmcnt(0)" ::: "memory");
    __syncthreads();
    if (threadIdx.x == 0) {
        unsigned* bar = b.bar;
        __builtin_amdgcn_s_waitcnt(0);
        unsigned nloc = b.st[0], nx = b.st[1];
        if (nloc == 0u) { xcd_barrier_complete(bar, b.x, nloc, nx); b.st[0] = nloc; b.st[1] = nx; }
        const unsigned old = xb_add(&bar[XB_XSUB(b.x)], 1u);
        const unsigned gen = old / nloc;
        if (old + 1u == (gen + 1u) * nloc) {
            __builtin_amdgcn_fence(__ATOMIC_RELEASE, "agent");
            asm volatile("s_waitcnt vmcnt(0)" ::: "memory");
            const unsigned og = xb_add(&bar[XB_TOP], 1u);
            const unsigned tg = og / nx;
            if (og + 1u == (tg + 1u) * nx) xb_add(&bar[XB_TOPGEN], 1u);
            else XB_SPIN(xb_ld(&bar[XB_TOPGEN]) == tg, bar);
            __builtin_amdgcn_fence(__ATOMIC_ACQUIRE, "agent");
            xb_add(&bar[XB_XGEN(b.x)], 1u);
            asm volatile("s_waitcnt vmcnt(0)" ::: "memory");
        } else {
            XB_SPIN(xb_ld(&bar[XB_XGEN(b.x)]) == gen, bar);
            __builtin_amdgcn_fence(__ATOMIC_ACQUIRE, "agent");
            asm volatile("s_waitcnt vmcnt(0)" ::: "memory");
        }
    }
    __syncthreads();
}


#ifdef FP8_PROBE
typedef int v8i_t __attribute__((ext_vector_type(8)));
typedef float f32x16_t __attribute__((ext_vector_type(16)));
__device__ __forceinline__ int pr_aval(int i, int k) { return ((i * 7 + k * 3) % 5) - 2; }
__device__ __forceinline__ int pr_bval(int k, int j) { return ((k * 5 + j * 11) % 7) - 3; }
__device__ __forceinline__ unsigned pr_enc(int v) { const int a = v < 0 ? -v : v; const unsigned m = a == 0 ? 0x00u : (a == 1 ? 0x38u : (a == 2 ? 0x40u : 0x44u)); return m | (v < 0 ? 0x80u : 0u); }
template <int HYP> __device__ __forceinline__ int pr_kmap(int h, int j) { return HYP == 1 ? 32 * h + j : (HYP == 2 ? 16 * h + (j & 15) + 32 * (j >> 4) : 8 * h + (j & 7) + 16 * (j >> 3)); }
template <int HYP> __device__ __forceinline__ bool pr_test(int lane) {
    const int rc = lane & 31, h = lane >> 5; v8i_t a, b;
#pragma unroll
    for (int d = 0; d < 8; ++d) { unsigned wa = 0u, wb = 0u;
#pragma unroll
        for (int q = 0; q < 4; ++q) { const int k = pr_kmap<HYP>(h, 4 * d + q); wa |= pr_enc(pr_aval(rc, k)) << (8 * q); wb |= pr_enc(pr_bval(k, rc)) << (8 * q); }
        a[d] = (int)wa; b[d] = (int)wb; }
    f32x16_t c = {};
    c = __builtin_amdgcn_mfma_scale_f32_32x32x64_f8f6f4(a, b, c, 0, 0, 0, 0x7f7f7f7f, 0, 0x7f7f7f7f);
    bool ok = true;
#pragma unroll
    for (int r = 0; r < 16; ++r) { const int i = (r & 3) + 8 * (r >> 2) + 4 * h; int e = 0;
        for (int k = 0; k < 64; ++k) e += pr_aval(i, k) * pr_bval(k, rc);
        ok = ok && (c[r] == (float)e); }
    return __all(ok) != 0;
}
#endif
__global__ void __launch_bounds__(NWAVES * 64, 2) mk_fwd(Params p_unused) {
    extern __shared__ __attribute__((aligned(16))) unsigned char lds[];
#define MAKE_CTX Ctx F; { int t_ = threadIdx.x; asm volatile("" : "+v"(t_)); F.lds = (LAS unsigned char*)lds; F.tid = t_; F.lane = t_ & 63; F.wave = __builtin_amdgcn_readfirstlane(t_ >> 6); \
    F.G = gridDim.x; const int bx = blockIdx.x; F.vcu = (F.G % 8 == 0) ? (bx % 8) * (F.G / 8) + bx / 8 : bx; }
    int lo, hi; unsigned* barw; { const Params q0 = kparams(); lo = q0.ph_lo; hi = q0.ph_hi; barw = (unsigned*)(q0.ws + WS_CTL) + 4096; }
    volatile LAS unsigned* bst = (volatile LAS unsigned*)((LAS unsigned char*)lds + RING_BYTES + 12288 + 1024);
    if (threadIdx.x < 2) bst[threadIdx.x] = 0u;
    __syncthreads();
    if (threadIdx.x == 0) (void)xb_add(&barw[XB_XCNT(xb_xcc_id())], 1u);
#ifndef PH_MASK
#define PH_MASK 0xFFFFFu
#endif
#define IN(k) (((PH_MASK >> (k)) & 1u) && lo <= (k) && (k) < hi)
#define SEAM(k) do { if (IN(k) && IN((k) + 1)) { XcdBarrier xb_; xb_.bar = barw; xb_.x = xb_xcc_id(); xb_.st = bst; xcd_barrier(xb_); } } while (0)
#ifndef TS_MASK
#define TS_MASK 0u
#endif
#ifndef TS_SCALE
#define TS_SCALE 10.0f
#endif
    unsigned long long ts_prev = 0ull, ts_acc = 0ull;
    if (TS_MASK) ts_prev = __builtin_amdgcn_s_memrealtime();
#define TS_MARK(k) do { if (TS_MASK) { const unsigned long long t_ = __builtin_amdgcn_s_memrealtime(); if ((TS_MASK >> (k)) & 1u) ts_acc += t_ - ts_prev; ts_prev = t_; } } while (0)
#define PHASE_VARS MAKE_CTX const Params p = kparams(); unsigned char* ws = p.ws; const float* mod = (const float*)(ws + WS_MOD); bf16_t* Hb = (bf16_t*)(ws + WS_H); (void)mod; (void)Hb;

    if (IN(0)) { PHASE_VARS p0_prologue(F, p); } SEAM(0); TS_MARK(0);
    if (IN(1)) { PHASE_VARS p_norm1_in(F, p); } SEAM(1); TS_MARK(1);
    if (IN(2)) { PHASE_VARS
        pg8::Gemm g{Hb + (size_t)CTXL * DM, (const bf16_t*)(ws + WS_WIN), DM, (size_t)LR * DM * 2, 0}; pg8::GOrder S; S.init(32, 8, NB, F.G, (int)blockIdx.x);
        pg8::EpiWin E{(bf16_t*)(ws + WS_ACT + ACT_Z)}; pg8::gemm_phase(F.lds, g, S, E); p_ctx_dense(F, p, 0); } SEAM(2); TS_MARK(2);
    if (IN(3)) { PHASE_VARS p_lru(F, p, false); } SEAM(3); TS_MARK(3);
    if (IN(4)) { PHASE_VARS p_lru_carry(F, p); p_cm(F, p); }
    if (IN(4)) { XcdBarrier xb_; xb_.bar = barw; xb_.x = xb_xcc_id(); xb_.st = bst; xcd_barrier(xb_); }
    if (IN(4)) { PHASE_VARS p_lru(F, p, true); } SEAM(4); TS_MARK(4);
    if (IN(5)) { PHASE_VARS
        pg8::Gemm g{(const bf16_t*)(ws + WS_ACT + ACT_YCAT) + (size_t)CTXL * DM, (const bf16_t*)(ws + WS_WOUT0), DM, (size_t)LR * DM * 2, 0}; pg8::GOrder S; S.init(32, 4, NB, F.G, (int)blockIdx.x);
        pg8::EpiRes E{(bf16_t*)(ws + WS_X), p.in[I_X], mod + 2 * DM, 0}; pg8::gemm_phase(F.lds, g, S, E); p_ctx_dense(F, p, 1); } SEAM(5); TS_MARK(5);
    if (IN(6)) { PHASE_VARS p_norm2_router(F, p, 0, true); } SEAM(6); TS_MARK(6);
    if (IN(7)) { PHASE_VARS p_select(F, p, true); } SEAM(7); TS_MARK(7);
    if (IN(8)) { PHASE_VARS
        pg8::Gemm8 g{ws + WS_H, ws + WS_W13, DM, 0, (size_t)4096 * DM, (const int*)(ws + WS_ROWIDX)}; pg8::GOrder S; S.init(8, 16, NE, F.G, (int)blockIdx.x);
        pg8::EpiSwiGLU8 E{ws + WS_ACT + ACT_HID}; pg8::gemm8_phase<true, true>(F.lds, g, S, E); p_ctx_moe(F, p, 0); } SEAM(8); TS_MARK(8);
    if (IN(9)) { PHASE_VARS
        pg8::Gemm8 g{ws + WS_ACT + ACT_HID, ws + WS_W2, FF, (size_t)EROWS * FF, (size_t)DM * FF, nullptr}; pg8::GOrder S; S.init(8, 4, NE, F.G, (int)blockIdx.x);
        pg8::EpiMoeOut8 E{ws + WS_XS, (const float*)(ws + WS_GATE)}; pg8::gemm8_phase<false, false>(F.lds, g, S, E); p_ctx_moe(F, p, 1); } SEAM(9); TS_MARK(9);
    if (IN(10)) { PHASE_VARS p_combine(F, p, 0, false); } SEAM(10); TS_MARK(10);
    if (IN(11)) { PHASE_VARS
        pg8::Gemm g{Hb + (size_t)CTXL * DM, (const bf16_t*)(ws + WS_WQKV), DM, (size_t)LR * DM * 2, 0}; pg8::GOrder S; S.init(32, 12, NB, F.G, (int)blockIdx.x);
        pg8::EpiQKV E{(bf16_t*)(ws + WS_ACT + ACT_Q), (const float*)(ws + WS_ROPE)}; pg8::gemm_phase(F.lds, g, S, E); p_ctx_dense(F, p, 2); } SEAM(11); TS_MARK(11);
    if (IN(12)) { PHASE_VARS p_attn(F, p, lds); } SEAM(12); TS_MARK(12);
    TS_MARK(13);
    if (IN(14)) { PHASE_VARS
        pg8::Gemm g{(const bf16_t*)(ws + WS_XS), (const bf16_t*)(ws + WS_WOUT1), DM, (size_t)SEQ * DM * 2, 0}; pg8::GOrder S; S.init(32, 4, NB, F.G, (int)blockIdx.x);
        pg8::EpiRes E{(bf16_t*)(ws + WS_X), nullptr, mod + 3 * 6144 + 2 * DM, 1}; pg8::gemm_phase(F.lds, g, S, E); } SEAM(14); TS_MARK(14);
    if (IN(15)) { PHASE_VARS p_norm2_router(F, p, 1, false); } SEAM(15); TS_MARK(15);
    if (IN(16)) { PHASE_VARS p_select(F, p, false); } SEAM(16); TS_MARK(16);
    if (IN(17)) { PHASE_VARS
        pg8::Gemm8 g{ws + WS_H, ws + WS_W13 + (size_t)NE * 4096 * DM, DM, 0, (size_t)4096 * DM, (const int*)(ws + WS_ROWIDX)}; pg8::GOrder S; S.init(8, 16, NE, F.G, (int)blockIdx.x);
        pg8::EpiSwiGLU8 E{ws + WS_ACT + ACT_HID}; pg8::gemm8_phase<true, true>(F.lds, g, S, E); } SEAM(17); TS_MARK(17);
    if (IN(18)) { PHASE_VARS
        pg8::Gemm8 g{ws + WS_ACT + ACT_HID, ws + WS_W2 + (size_t)NE * DM * FF, FF, (size_t)EROWS * FF, (size_t)DM * FF, nullptr}; pg8::GOrder S; S.init(8, 4, NE, F.G, (int)blockIdx.x);
        pg8::EpiMoeOut8 E{ws + WS_XS, (const float*)(ws + WS_GATE)}; pg8::gemm8_phase<false, false>(F.lds, g, S, E); } SEAM(18); TS_MARK(18);
    if (IN(19)) { PHASE_VARS p_combine(F, p, 1, true); }
#ifdef FP8_PROBE
    { XcdBarrier xb_; xb_.bar = barw; xb_.x = xb_xcc_id(); xb_.st = bst; xcd_barrier(xb_);
      if (blockIdx.x == 0 && threadIdx.x < 64) { const int l_ = threadIdx.x; int code = 0; if (pr_test<1>(l_)) code = 1; else if (pr_test<2>(l_)) code = 2; else if (pr_test<3>(l_)) code = 3;
          if (l_ == 0) { const Params p = kparams(); p.out[0] += 20.0f * (float)code; } } }
#endif
    if (TS_MASK) { TS_MARK(19); XcdBarrier xb_; xb_.bar = barw; xb_.x = xb_xcc_id(); xb_.st = bst; xcd_barrier(xb_);
        if (blockIdx.x == 0 && threadIdx.x == 0) { const Params p = kparams(); p.out[0] += (float)ts_acc * 0.01f / TS_SCALE; } }
#undef IN
#undef SEAM
}

extern "C" void kernel_launch(void* const* d_in, const int* in_sizes, int n_in, void* d_out, int out_size, void* d_ws, size_t ws_size, hipStream_t stream) {
    static int grid = 0;
    if (grid == 0) {
        if (n_in != 32 || out_size != NLAT * DM || ws_size < WS_END) { fprintf(stderr, "kernel_launch: unexpected problem (n_in %d, out %d, ws %zu)\n", n_in, out_size, ws_size); grid = -1; return; }
        int dev = 0, cus = 0, per_cu = 0;
        if (hipGetDevice(&dev) != hipSuccess || hipDeviceGetAttribute(&cus, hipDeviceAttributeMultiprocessorCount, dev) != hipSuccess) { grid = -1; return; }
        if (hipFuncSetAttribute((const void*)mk_fwd, hipFuncAttributeMaxDynamicSharedMemorySize, LDS_BYTES) != hipSuccess) { fprintf(stderr, "kernel_launch: hipFuncSetAttribute failed\n"); grid = -1; return; }
        if (hipOccupancyMaxActiveBlocksPerMultiprocessor(&per_cu, (const void*)mk_fwd, NWAVES * 64, LDS_BYTES) != hipSuccess || per_cu < 1) { fprintf(stderr, "kernel_launch: occupancy query says %d\n", per_cu); per_cu = 1; }
        (void)hipGetLastError();
        grid = cus & ~7;
    }
    if (grid < 0) return;
    if (hipMemsetAsync((char*)d_ws + WS_CTL, 0, 65536, stream) != hipSuccess) { fprintf(stderr, "kernel_launch: memset failed\n"); return; }
    Params a{};
    for (int i = 0; i < 32; ++i) a.in[i] = (const float*)d_in[i];
    a.out = (float*)d_out; a.ws = (unsigned char*)d_ws;
#if MK_N_LAUNCHES == 1
    a.ph_lo = 0; a.ph_hi = NPH;
    void* args[] = {&a};
    hipError_t e = hipLaunchCooperativeKernel((const void*)mk_fwd, dim3(grid), dim3(NWAVES * 64), args, LDS_BYTES, stream);
    if (e != hipSuccess) fprintf(stderr, "kernel_launch: cooperative launch failed: %s (grid %d)\n", hipGetErrorString(e), grid);
#else
    for (int ph = 0; ph < NPH; ++ph) { a.ph_lo = ph; a.ph_hi = ph + 1; hipLaunchKernelGGL(mk_fwd, dim3(grid), dim3(NWAVES * 64), LDS_BYTES, stream, a); }
#endif
}
```

```cpp
#include <hip/hip_runtime.h>
#include <hip/hip_cooperative_groups.h>
#include <hip/hip_bf16.h>
#include <cstdio>
#include <cstdint>
#include <cmath>
namespace cg = cooperative_groups;

#ifndef MK_N_LAUNCHES
#define MK_N_LAUNCHES 1
#endif

constexpr int DM = 1024, NB = 2, SEQ = 8192, CTXL = 256, LR = SEQ + CTXL, NR = NB * LR, NLAT = NB * SEQ;
constexpr int NE = 16, FF = 2048, EROWS = 2304;
constexpr float EPS = 1e-6f;
constexpr int NTILE64 = NR / 64;
constexpr int NPH = 20;

constexpr size_t MiB = 1u << 20;
constexpr size_t WS_CTL = 0, WS_MOD = 1 * MiB, WS_ROPE = 2 * MiB, WS_LRUW = 4 * MiB, WS_CMWS = 4 * MiB + 512 * 1024, WS_SUM = 5 * MiB, WS_AFF = 8 * MiB, WS_INV = 10 * MiB,
                 WS_GATE = 12 * MiB, WS_ROWIDX = 13 * MiB, WS_MODP = 28 * MiB, WS_CAR = 30 * MiB, WS_WIN = 14 * MiB, WS_WOUT0 = 18 * MiB, WS_WQKV = 20 * MiB, WS_WOUT1 = 26 * MiB, WS_W13 = 32 * MiB, WS_W2 = 288 * MiB, WS_H = 416 * MiB,
                 WS_X = 450 * MiB, WS_XS = 516 * MiB, WS_ACT = 588 * MiB, WS_END = 758 * MiB;
static_assert(true, "");
constexpr size_t ACT_Z = 0, ACT_YCAT = 66 * MiB, ACT_HID = 0, ACT_Q = 0, ACT_K = 33 * MiB, ACT_V = 66 * MiB, ACT_O1 = 99 * MiB, ACT_O2 = 131 * MiB, ACT_A = 0;

#define GAS __attribute__((address_space(1)))
#define LAS __attribute__((address_space(3)))
typedef unsigned short bf16_t;
typedef short bf16x8 __attribute__((ext_vector_type(8)));
typedef float f32x4 __attribute__((ext_vector_type(4)));
typedef float f32x2 __attribute__((ext_vector_type(2)));
typedef unsigned u32x4 __attribute__((ext_vector_type(4)));
typedef unsigned u32x2 __attribute__((ext_vector_type(2)));

__device__ __forceinline__ unsigned f2bf(float f) { unsigned u = __builtin_bit_cast(unsigned, f); return (u + 0x7fffu + ((u >> 16) & 1u)) >> 16; }
typedef float f32x2_hw __attribute__((ext_vector_type(2))); typedef __bf16 bf16x2_hw __attribute__((ext_vector_type(2)));
__device__ __forceinline__ unsigned pk2(float lo, float hi) { f32x2_hw v = {lo, hi}; bf16x2_hw b = __builtin_convertvector(v, bf16x2_hw); return __builtin_bit_cast(unsigned, b); }
__device__ __forceinline__ u32x2 pk4(const f32x4 v) { u32x2 w; w.x = pk2(v[0], v[1]); w.y = pk2(v[2], v[3]); return w; }
__device__ __forceinline__ float bf2f(unsigned short b) { return __builtin_bit_cast(float, (unsigned)b << 16); }
__device__ __forceinline__ float bflo(unsigned w) { return __builtin_bit_cast(float, w << 16); }
__device__ __forceinline__ float bfhi(unsigned w) { return __builtin_bit_cast(float, w & 0xffff0000u); }
__device__ __forceinline__ unsigned f2fp8x4(float a, float b, float c, float d) {
    a = __builtin_amdgcn_fmed3f(a, -448.f, 448.f); b = __builtin_amdgcn_fmed3f(b, -448.f, 448.f); c = __builtin_amdgcn_fmed3f(c, -448.f, 448.f); d = __builtin_amdgcn_fmed3f(d, -448.f, 448.f);
    int w = __builtin_amdgcn_cvt_pk_fp8_f32(a, b, 0, false); w = __builtin_amdgcn_cvt_pk_fp8_f32(c, d, w, true); return (unsigned)w; }
constexpr float YB_SCALE = 16.0f, YB_INV = 1.0f / 16.0f;
constexpr float W8_SCALE = 32.0f, W8_INV = 1.0f / 32.0f;
__device__ __forceinline__ float gelu_tanh(float x) {
    const float u2 = 2.0f * 0.7978845608028654f * (x + 0.044715f * x * x * x);
    const float e = __builtin_amdgcn_exp2f(u2 * 1.4426950408889634f);
    return x - x * __builtin_amdgcn_rcpf(1.0f + e);
}
__device__ __forceinline__ float silu_f(float a) { return a * __builtin_amdgcn_rcpf(1.0f + __builtin_amdgcn_exp2f(-a * 1.4426950408889634f)); }
__device__ __forceinline__ float sigmoid_f(float a) { return 1.0f / (1.0f + __expf(-a)); }

namespace pg8 {
#define PG8_LAS __attribute__((address_space(3)))
constexpr int BM = 256, BK = 64, HALF = 128, HTB = HALF * BK * 2, STAGE_BYTES = 8 * HTB, NXCD = 8, WGM = 8;
__host__ __device__ __forceinline__ int lds_byte(int r, int c) { const int st = (r >> 4) * 2 + (c >> 5), rr = r & 15, cc = c & 31, ob = rr * 64 + cc * 2; return st * 1024 + (ob ^ (((ob >> 9) & 1) << 5)); }
__host__ __device__ __forceinline__ void stage_rc(int b, int& R, int& C) { const int st = b / 1024, sb = b % 1024, swz = sb ^ (((sb >> 9) & 1) << 5); R = (st >> 1) * 16 + swz / 64; C = (st & 1) * 32 + (swz % 64) / 2; }
__host__ __device__ __forceinline__ int perm32(int rho) { const int n = rho >> 4, i = rho & 15; return 8 * (i >> 2) + 4 * n + (i & 3); }

struct Unit { int pm, pn, grp; };
struct Gemm { const bf16_t* A; const bf16_t* Bt; int K; size_t ga, gb; };

struct GOrder {
    int nM, nN, upg, nwg, G, c;
    __device__ void init(int nM_, int nN_, int ngrp, int G_, int c_) { nM = nM_; nN = nN_; upg = nM * nN; nwg = upg * ngrp; G = G_; c = c_; }
    __device__ bool next(int i, Unit& u) const {
        const long L = (long)i * G + c; if (L >= nwg) return false;
        int wgid = (int)L; { const int q = nwg / NXCD, r = nwg % NXCD, xcd = wgid % NXCD, off = wgid / NXCD; wgid = (xcd < r ? xcd * (q + 1) : r * (q + 1) + (xcd - r) * q) + off; }
        u.grp = wgid / upg; const int w = wgid % upg;
        const int nig = WGM * nN, gid = w / nig, fm = gid * WGM, gsz = (nM - fm) < WGM ? (nM - fm) : WGM;
        u.pm = fm + ((w % nig) % gsz); u.pn = (w % nig) / gsz; return true;
    }
};

__device__ __forceinline__ unsigned cvt_pk_bf16(float lo, float hi) { unsigned r; asm volatile("v_cvt_pk_bf16_f32 %0, %1, %2" : "=v"(r) : "v"(lo), "v"(hi)); return r; }

template <class Epi, class Sched>
__device__ __forceinline__ void gemm_phase(PG8_LAS unsigned char* lds, const Gemm g, const Sched& S, const Epi& E) {
    const int tid = threadIdx.x, wid = __builtin_amdgcn_readfirstlane(tid >> 6), lane = tid & 63, wr = wid >> 2, wc = wid & 3, fr = lane & 15, fq = lane >> 4;
    const int K = g.K, nt = K / BK;
    unsigned voffA[2], voffB[2];
#pragma unroll
    for (int i = 0; i < 2; ++i) { int R, C; stage_rc(tid * 16 + i * 8192, R, C); const int Rb = (R & ~31) + perm32(R & 31);
        voffA[i] = (unsigned)(R * K + C) * 2u; voffB[i] = (unsigned)(Rb * K + C) * 2u; }
    const size_t kstep = (size_t)(BK * 2);
    const size_t hstep = (size_t)HALF * K * 2;
    const size_t tstep = 2 * hstep;
    const unsigned ldsw = (unsigned)wid * 1024u;
    const int aoff = lds_byte(wr * 64 + fr, fq * 8), boff = lds_byte(wc * 32 + fr, fq * 8);
#define PG8_SA(b, h) (((b) * 2 + (h)) * HTB)
#define PG8_SB(b, h) ((4 + (b) * 2 + (h)) * HTB)
#define PG8_STAGE(bufoff, gbase, voff) do { _Pragma("unroll") for (int _i = 0; _i < 2; ++_i) \
        __builtin_amdgcn_global_load_lds((const unsigned*)((const char*)(gbase) + (voff)[_i]), (PG8_LAS unsigned*)(lds + (bufoff) + ldsw + _i * 8192), 16, 0, 0); } while (0)
#define PG8_LDA(dst, b, h) do { _Pragma("unroll") for (int m = 0; m < 4; ++m) _Pragma("unroll") for (int k = 0; k < 2; ++k) dst[m][k] = *(const PG8_LAS bf16x8*)(lds + PG8_SA(b, h) + aoff + m * 2048 + k * 1024); } while (0)
#define PG8_LDB(dst, b, h) do { _Pragma("unroll") for (int n = 0; n < 2; ++n) _Pragma("unroll") for (int k = 0; k < 2; ++k) dst[n][k] = *(const PG8_LAS bf16x8*)(lds + PG8_SB(b, h) + boff + n * 2048 + k * 1024); } while (0)
#define PG8_MMA(ai, bj, At, Bt) do { __builtin_amdgcn_s_setprio(1); _Pragma("unroll") for (int m = 0; m < 4; ++m) _Pragma("unroll") for (int n = 0; n < 2; ++n) _Pragma("unroll") for (int k = 0; k < 2; ++k) \
        acc[ai][bj][m][n] = __builtin_amdgcn_mfma_f32_16x16x32_bf16(Bt[n][k], At[m][k], acc[ai][bj][m][n], 0, 0, 0); __builtin_amdgcn_s_setprio(0); } while (0)
#define PG8_WAIT_V(n) asm volatile("s_waitcnt vmcnt(" #n ")" ::: "memory")
#define PG8_WAIT_L(n) asm volatile("s_waitcnt lgkmcnt(" #n ")" ::: "memory")
#define PG8_BAR __builtin_amdgcn_s_barrier()
#define PG8_SCHED __builtin_amdgcn_sched_barrier(0)
    Unit cur, nxt; int ui = 0;
    if (!S.next(0, cur)) return;
    f32x4 acc[2][2][4][2];
#pragma unroll
    for (int a = 0; a < 2; ++a)
#pragma unroll
        for (int b = 0; b < 2; ++b)
#pragma unroll
            for (int m = 0; m < 4; ++m)
#pragma unroll
                for (int n = 0; n < 2; ++n) acc[a][b][m][n] = (f32x4){0.f, 0.f, 0.f, 0.f};
    bf16x8 At[4][2], B0[2][2], B1[2][2];
    const char* cA = (const char*)g.A + (size_t)cur.grp * g.ga + (size_t)cur.pm * tstep; const char* cB = (const char*)g.Bt + (size_t)cur.grp * g.gb + (size_t)cur.pn * tstep;
    PG8_STAGE(PG8_SB(0, 0), cB, voffB); PG8_STAGE(PG8_SB(0, 1), cB + hstep, voffB); PG8_STAGE(PG8_SA(0, 0), cA, voffA); PG8_STAGE(PG8_SA(0, 1), cA + hstep, voffA);
    if (wr == 1) PG8_BAR;
    PG8_WAIT_V(2); PG8_BAR;
    PG8_STAGE(PG8_SB(1, 0), cB + kstep, voffB); PG8_STAGE(PG8_SA(1, 0), cA + kstep, voffA); PG8_STAGE(PG8_SB(1, 1), cB + hstep + kstep, voffB);
    PG8_WAIT_V(6); PG8_BAR;
    for (;;) {
        const bool has_next = S.next(ui + 1, nxt);
        const char* nA = has_next ? (const char*)g.A + (size_t)nxt.grp * g.ga + (size_t)nxt.pm * tstep : cA; const char* nB = has_next ? (const char*)g.Bt + (size_t)nxt.grp * g.gb + (size_t)nxt.pn * tstep : cB;
        for (int t = 0; t < nt; t += 2) {
            const bool last = (t == nt - 2);
            const char* a1 = cA + (size_t)(t + 1) * kstep;
            const char* a2 = last ? nA : cA + (size_t)(t + 2) * kstep; const char* b2 = last ? nB : cB + (size_t)(t + 2) * kstep;
            const char* a3 = a2 + kstep; const char* b3 = b2 + kstep;
            PG8_LDB(B0, 0, 0); PG8_LDB(B1, 0, 1); PG8_SCHED; PG8_LDA(At, 0, 0); PG8_STAGE(PG8_SA(1, 1), a1 + hstep, voffA);
            PG8_WAIT_V(8); PG8_WAIT_L(0); PG8_BAR; PG8_MMA(0, 0, At, B0); PG8_MMA(0, 1, At, B1); PG8_BAR; PG8_SCHED;
            PG8_LDA(At, 0, 1); PG8_STAGE(PG8_SB(0, 0), b2, voffB); PG8_STAGE(PG8_SB(0, 1), b2 + hstep, voffB); PG8_STAGE(PG8_SA(0, 0), a2, voffA);
            PG8_WAIT_V(8); PG8_WAIT_L(0); PG8_BAR; PG8_MMA(1, 0, At, B0); PG8_MMA(1, 1, At, B1); PG8_BAR; PG8_SCHED;
            PG8_LDB(B0, 1, 0); PG8_LDB(B1, 1, 1); PG8_SCHED; PG8_LDA(At, 1, 0); PG8_STAGE(PG8_SA(0, 1), a2 + hstep, voffA);
            PG8_WAIT_V(8); PG8_WAIT_L(0); PG8_BAR; PG8_MMA(0, 0, At, B0); PG8_MMA(0, 1, At, B1); PG8_BAR; PG8_SCHED;
            PG8_LDA(At, 1, 1); PG8_STAGE(PG8_SB(1, 0), b3, voffB); PG8_STAGE(PG8_SB(1, 1), b3 + hstep, voffB); PG8_STAGE(PG8_SA(1, 0), a3, voffA);
            PG8_WAIT_V(8); PG8_WAIT_L(0); PG8_BAR; PG8_MMA(1, 0, At, B0); PG8_MMA(1, 1, At, B1); PG8_BAR; PG8_SCHED;
        }
        if (wr == 0) PG8_BAR;
        E(acc, cur, wr, wc, fr, fq);
        if (!has_next) break;
#pragma unroll
        for (int a = 0; a < 2; ++a)
#pragma unroll
            for (int b = 0; b < 2; ++b)
#pragma unroll
                for (int m = 0; m < 4; ++m)
#pragma unroll
                    for (int n = 0; n < 2; ++n) acc[a][b][m][n] = (f32x4){0.f, 0.f, 0.f, 0.f};
        cur = nxt; cA = nA; cB = nB; ++ui;
        if (wr == 1) PG8_BAR;
    }
    PG8_WAIT_V(0);
    PG8_BAR;
#undef PG8_SA
#undef PG8_SB
#undef PG8_STAGE
#undef PG8_LDA
#undef PG8_LDB
#undef PG8_MMA
#undef PG8_WAIT_V
#undef PG8_WAIT_L
#undef PG8_BAR
#undef PG8_SCHED
}

typedef int v8i32 __attribute__((ext_vector_type(8)));
typedef float f32x16 __attribute__((ext_vector_type(16)));
__host__ __device__ __forceinline__ int permS(int rho) { const int e = rho & 3, hh = (rho >> 2) & 1, q = rho >> 3; return q < 2 ? 8 * hh + 4 * q + e : 16 + 8 * hh + 4 * (q - 2) + e; }
__host__ __device__ __forceinline__ int permN(int rho) { const int e = rho & 3, hh = (rho >> 2) & 1, q = rho >> 3; return 16 * hh + 4 * q + e; }
struct Gemm8 { const unsigned char* A; const unsigned char* Bt; int K; size_t ga, gb; const int* rows; };
template <bool SWP, bool GATH, class Epi, class Sched>
__device__ __forceinline__ void gemm8_phase(PG8_LAS unsigned char* lds, const Gemm8 g, const Sched& S, const Epi& E) {
    const int tid = threadIdx.x, wid = __builtin_amdgcn_readfirstlane(tid >> 6), lane = tid & 63, wr = wid >> 2, wc = wid & 3;
    const int K = g.K, nt = K / 128;
    unsigned voffA[4], voffB[2]; int RA0 = 0, CbA = 0;
#pragma unroll
    for (int i = 0; i < 2; ++i) {
        const int bb = tid * 16 + i * 8192, st = bb / 1024, sb = bb % 1024, swz = sb ^ (((sb >> 9) & 1) << 5) ^ (((sb >> 8) & 1) << 4);
        const int R = (st >> 1) * 16 + swz / 64, Cb = (st & 1) * 64 + swz % 64; const int Rb = (R & ~31) + (SWP ? permS(R & 31) : permN(R & 31));
        voffA[i] = (unsigned)(R * K + Cb); voffA[2 + i] = (unsigned)((R + HALF) * K + Cb); voffB[i] = (unsigned)(Rb * K + Cb); if (i == 0) { RA0 = R; CbA = Cb; } }
    const size_t kstep = 128, hstep = (size_t)HALF * K, tstep = 2 * hstep;
    constexpr int IDXOFF = 8 * HTB;
    const unsigned ldsw = (unsigned)wid * 1024u;
    const int l31 = lane & 31, hh = lane >> 5;
    const int ra = wr * 64 + l31, rb = wc * 32 + l31;
    const int aoff = ((ra >> 4) * 2) * 1024 + (ra & 15) * 64 + 32 * (hh ^ ((ra & 15) >> 3)), boff = ((rb >> 4) * 2) * 1024 + (rb & 15) * 64 + 32 * (hh ^ ((rb & 15) >> 3));
    const int aswp = 16 * ((ra >> 2) & 1), bswp = 16 * ((rb >> 2) & 1);
#define PG8_SA(b, h) (((b) * 2 + (h)) * HTB)
#define PG8_SB(b, h) ((4 + (b) * 2 + (h)) * HTB)
#define PG8_STAGE(bufoff, gbase, voff) do { _Pragma("unroll") for (int _i = 0; _i < 2; ++_i) \
        __builtin_amdgcn_global_load_lds((const unsigned*)((const char*)(gbase) + (voff)[_i]), (PG8_LAS unsigned*)(lds + (bufoff) + ldsw + _i * 8192), 16, 0, 0); } while (0)
#define PG8_STAGEA(bufoff, gbase, h) do { _Pragma("unroll") for (int _i = 0; _i < 2; ++_i) \
        __builtin_amdgcn_global_load_lds((const unsigned*)((const char*)(gbase) + voffA[2 * (h) + _i]), (PG8_LAS unsigned*)(lds + (bufoff) + ldsw + _i * 8192), 16, 0, 0); } while (0)
#define PG8_LD32(dst, off, swp) do { const u32x4 lo_ = *(const PG8_LAS u32x4*)(lds + (off) + (swp)); const u32x4 hi_ = *(const PG8_LAS u32x4*)(lds + (off) + (16 - (swp))); \
        dst = (v8i32){(int)lo_.x, (int)lo_.y, (int)lo_.z, (int)lo_.w, (int)hi_.x, (int)hi_.y, (int)hi_.z, (int)hi_.w}; } while (0)
#define PG8_LDA(dst, b, h) do { _Pragma("unroll") for (int m = 0; m < 2; ++m) _Pragma("unroll") for (int k = 0; k < 2; ++k) PG8_LD32(dst[m][k], PG8_SA(b, h) + aoff + m * 4096 + k * 1024, aswp); } while (0)
#define PG8_LDB(dst, b, h) do { _Pragma("unroll") for (int k = 0; k < 2; ++k) PG8_LD32(dst[k], PG8_SB(b, h) + boff + k * 1024, bswp); } while (0)
#define PG8_MMA(ai, bj, At, Bt) do { __builtin_amdgcn_s_setprio(1); _Pragma("unroll") for (int m = 0; m < 2; ++m) _Pragma("unroll") for (int k = 0; k < 2; ++k) \
        acc[ai][bj][m] = __builtin_amdgcn_mfma_scale_f32_32x32x64_f8f6f4(Bt[k], At[m][k], acc[ai][bj][m], 0, 0, 0, 0x7f7f7f7f, 0, 0x7f7f7f7f); \
        asm volatile("" : "+v"(acc[ai][bj][0]), "+v"(acc[ai][bj][1])); __builtin_amdgcn_s_setprio(0); } while (0)
#define PG8_WAIT_V(n) asm volatile("s_waitcnt vmcnt(" #n ")" ::: "memory")
#define PG8_WAIT_L(n) asm volatile("s_waitcnt lgkmcnt(" #n ")" ::: "memory")
#define PG8_BAR __builtin_amdgcn_s_barrier()
#define PG8_SCHED __builtin_amdgcn_sched_barrier(0)
    Unit cur, nxt; int ui = 0;
    if (!S.next(0, cur)) return;
    f32x16 acc[2][2][2];
#pragma unroll
    for (int a = 0; a < 2; ++a)
#pragma unroll
        for (int b = 0; b < 2; ++b)
#pragma unroll
            for (int m = 0; m < 2; ++m) acc[a][b][m] = f32x16{};
    v8i32 At[2][2], B0[2], B1[2];
    const char* cA = GATH ? (const char*)g.A : (const char*)g.A + (size_t)cur.grp * g.ga + (size_t)cur.pm * tstep; const char* cB = (const char*)g.Bt + (size_t)cur.grp * g.gb + (size_t)cur.pn * tstep;
    if (GATH) { const int* rp = g.rows + (size_t)cur.grp * EROWS + cur.pm * BM + RA0;
#pragma unroll
        for (int q = 0; q < 4; ++q) voffA[q] = (unsigned)(rp[64 * q] * K + CbA); }
    PG8_STAGE(PG8_SB(0, 0), cB, voffB); PG8_STAGE(PG8_SB(0, 1), cB + hstep, voffB); PG8_STAGEA(PG8_SA(0, 0), cA, 0); PG8_STAGEA(PG8_SA(0, 1), cA, 1);
    if (wr == 1) PG8_BAR;
    PG8_WAIT_V(2); PG8_BAR;
    PG8_STAGE(PG8_SB(1, 0), cB + kstep, voffB); PG8_STAGEA(PG8_SA(1, 0), cA + kstep, 0); PG8_STAGE(PG8_SB(1, 1), cB + hstep + kstep, voffB);
    PG8_WAIT_V(6); PG8_BAR;
    for (;;) {
        const bool has_next = S.next(ui + 1, nxt);
        const char* nA = (has_next && !GATH) ? (const char*)g.A + (size_t)nxt.grp * g.ga + (size_t)nxt.pm * tstep : cA; const char* nB = has_next ? (const char*)g.Bt + (size_t)nxt.grp * g.gb + (size_t)nxt.pn * tstep : cB;
        if (GATH && has_next && wid == 0)
            __builtin_amdgcn_global_load_lds((const unsigned*)(g.rows + (size_t)nxt.grp * EROWS + nxt.pm * BM + lane * 4), (PG8_LAS unsigned*)(lds + IDXOFF + ((ui + 1) & 1) * 1024), 16, 0, 0);
        for (int t = 0; t < nt; t += 2) {
            const bool last = (t == nt - 2);
            const char* a1 = cA + (size_t)(t + 1) * kstep;
            const char* a2 = last ? nA : cA + (size_t)(t + 2) * kstep; const char* b2 = last ? nB : cB + (size_t)(t + 2) * kstep;
            const char* a3 = a2 + kstep; const char* b3 = b2 + kstep;
            PG8_LDB(B0, 0, 0); PG8_LDB(B1, 0, 1); PG8_SCHED; PG8_LDA(At, 0, 0); PG8_STAGEA(PG8_SA(1, 1), a1, 1);
            if (GATH && last && has_next) {
                const PG8_LAS int* ip = (const PG8_LAS int*)(lds + IDXOFF + ((ui + 1) & 1) * 1024) + RA0;
#pragma unroll
                for (int q = 0; q < 4; ++q) voffA[q] = (unsigned)(ip[64 * q] * K + CbA); }
            PG8_WAIT_V(8); PG8_WAIT_L(0); PG8_BAR; PG8_SCHED; PG8_MMA(0, 0, At, B0); PG8_MMA(0, 1, At, B1); PG8_SCHED; PG8_BAR; PG8_SCHED;
            PG8_LDA(At, 0, 1); PG8_STAGE(PG8_SB(0, 0), b2, voffB); PG8_STAGE(PG8_SB(0, 1), b2 + hstep, voffB); PG8_STAGEA(PG8_SA(0, 0), a2, 0);
            PG8_WAIT_V(8); PG8_WAIT_L(0); PG8_BAR; PG8_SCHED; PG8_MMA(1, 0, At, B0); PG8_MMA(1, 1, At, B1); PG8_SCHED; PG8_BAR; PG8_SCHED;
            PG8_LDB(B0, 1, 0); PG8_LDB(B1, 1, 1); PG8_SCHED; PG8_LDA(At, 1, 0); PG8_STAGEA(PG8_SA(0, 1), a2, 1);
            PG8_WAIT_V(8); PG8_WAIT_L(0); PG8_BAR; PG8_SCHED; PG8_MMA(0, 0, At, B0); PG8_MMA(0, 1, At, B1); PG8_SCHED; PG8_BAR; PG8_SCHED;
            PG8_LDA(At, 1, 1); PG8_STAGE(PG8_SB(1, 0), b3, voffB); PG8_STAGE(PG8_SB(1, 1), b3 + hstep, voffB); PG8_STAGEA(PG8_SA(1, 0), a3, 0);
            PG8_WAIT_V(8); PG8_WAIT_L(0); PG8_BAR; PG8_SCHED; PG8_MMA(1, 0, At, B0); PG8_MMA(1, 1, At, B1); PG8_SCHED; PG8_BAR; PG8_SCHED;
        }
        if (wr == 0) PG8_BAR;
        E(acc, cur, wr, wc, l31, hh);
        if (!has_next) break;
#pragma unroll
        for (int a = 0; a < 2; ++a)
#pragma unroll
            for (int b = 0; b < 2; ++b)
#pragma unroll
                for (int m = 0; m < 2; ++m) acc[a][b][m] = f32x16{};
        cur = nxt; cA = nA; cB = nB; ++ui;
        if (wr == 1) PG8_BAR;
    }
    PG8_WAIT_V(0);
    PG8_BAR;
#undef PG8_SA
#undef PG8_SB
#undef PG8_STAGE
#undef PG8_STAGEA
#undef PG8_LD32
#undef PG8_LDA
#undef PG8_LDB
#undef PG8_MMA
#undef PG8_WAIT_V
#undef PG8_WAIT_L
#undef PG8_BAR
#undef PG8_SCHED
}
struct EpiSwiGLU8 {
    unsigned char* HID;
    __device__ __forceinline__ void operator()(const f32x16 (&acc)[2][2][2], const Unit& u, int wr, int wc, int l31, int hh) const {
        const int row0 = u.pm * BM + wr * 64 + l31, f0 = u.pn * 128 + wc * 16 + 8 * hh;
#pragma unroll
        for (int ai = 0; ai < 2; ++ai)
#pragma unroll
            for (int m = 0; m < 2; ++m) { unsigned char* rowp = HID + ((size_t)u.grp * EROWS + row0 + ai * HALF + m * 32) * FF + f0;
#pragma unroll
                for (int bj = 0; bj < 2; ++bj) { const f32x16& c = acc[ai][bj][m]; float hv[8];
#pragma unroll
                    for (int e = 0; e < 8; ++e) hv[e] = silu_f(c[e] * W8_INV) * (c[8 + e] * W8_INV);
                    u32x2 w; w.x = f2fp8x4(hv[0], hv[1], hv[2], hv[3]); w.y = f2fp8x4(hv[4], hv[5], hv[6], hv[7]);
                    *(u32x2*)(rowp + bj * 64) = w; } }
    }
};
struct EpiMoeOut8 {
    unsigned char* YB; const float* gate;
    __device__ __forceinline__ void operator()(const f32x16 (&acc)[2][2][2], const Unit& u, int wr, int wc, int l31, int hh) const {
        const int row0 = u.pm * BM + wr * 64 + l31, col0 = u.pn * BM + wc * 32 + 16 * hh;
#pragma unroll
        for (int ai = 0; ai < 2; ++ai)
#pragma unroll
            for (int m = 0; m < 2; ++m) { const size_t er = (size_t)u.grp * EROWS + row0 + ai * HALF + m * 32; const float gt = gate[er] * (W8_INV * YB_SCALE); unsigned char* rowp = YB + er * DM + col0;
#pragma unroll
                for (int bj = 0; bj < 2; ++bj) { const f32x16& c = acc[ai][bj][m]; u32x4 w;
                    w.x = f2fp8x4(c[0] * gt, c[1] * gt, c[2] * gt, c[3] * gt); w.y = f2fp8x4(c[4] * gt, c[5] * gt, c[6] * gt, c[7] * gt);
                    w.z = f2fp8x4(c[8] * gt, c[9] * gt, c[10] * gt, c[11] * gt); w.w = f2fp8x4(c[12] * gt, c[13] * gt, c[14] * gt, c[15] * gt);
                    *(u32x4*)(rowp + bj * HALF) = w; } }
    }
};

struct EpiWin {
    bf16_t* Z;
    __device__ __forceinline__ void operator()(const f32x4 (&acc)[2][2][4][2], const Unit& u, int wr, int wc, int fr, int fq) const {
        const int row0 = u.grp * LR + CTXL + u.pm * BM + wr * 64 + fr, col0 = u.pn * BM + wc * 32 + 8 * fq; const bool act = (u.pn < 2) || (u.pn >= 4);
#pragma unroll
        for (int ai = 0; ai < 2; ++ai)
#pragma unroll
            for (int m = 0; m < 4; ++m) { bf16_t* rowp = Z + (size_t)(row0 + ai * HALF + m * 16) * 2048 + col0;
#pragma unroll
                for (int bj = 0; bj < 2; ++bj) { f32x4 v0 = acc[ai][bj][m][0], v1 = acc[ai][bj][m][1];
                    if (act) {
#pragma unroll
                        for (int i = 0; i < 4; ++i) { v0[i] = gelu_tanh(v0[i]); v1[i] = gelu_tanh(v1[i]); } }
                    u32x4 w; w.x = cvt_pk_bf16(v0[0], v0[1]); w.y = cvt_pk_bf16(v0[2], v0[3]); w.z = cvt_pk_bf16(v1[0], v1[1]); w.w = cvt_pk_bf16(v1[2], v1[3]);
                    *(u32x4*)(rowp + bj * HALF) = w; } }
    }
};
struct EpiRes {
    bf16_t* X; const float* xin; const float* g1; int mode;
    __device__ __forceinline__ void operator()(const f32x4 (&acc)[2][2][4][2], const Unit& u, int wr, int wc, int fr, int fq) const {
        const int b = u.grp; bf16_t* outp = X + ((size_t)b * LR + CTXL + (size_t)u.pm * BM) * DM;
        const float* basep = xin + ((size_t)b * SEQ + (size_t)u.pm * BM) * DM;
        const int rr0 = wr * 64 + fr, col0 = u.pn * BM + wc * 32 + 8 * fq;
        f32x4 gv[2][2];
#pragma unroll
        for (int bj = 0; bj < 2; ++bj)
#pragma unroll
            for (int n = 0; n < 2; ++n) gv[bj][n] = *(const f32x4*)(g1 + (size_t)b * 6144 + col0 + bj * HALF + 4 * n);
#pragma unroll
        for (int ai = 0; ai < 2; ++ai)
#pragma unroll
            for (int m = 0; m < 4; ++m) { const size_t off = (size_t)(rr0 + ai * HALF + m * 16) * DM + col0;
#pragma unroll
                for (int bj = 0; bj < 2; ++bj) { f32x4 b0, b1;
                    if (mode == 0) { b0 = *(const f32x4*)(basep + off + bj * HALF); b1 = *(const f32x4*)(basep + off + bj * HALF + 4); }
                    else { const u32x4 w = *(const u32x4*)(outp + off + bj * HALF); b0 = (f32x4){bflo(w.x), bfhi(w.x), bflo(w.y), bfhi(w.y)}; b1 = (f32x4){bflo(w.z), bfhi(w.z), bflo(w.w), bfhi(w.w)}; }
                    const f32x4 o0 = b0 + gv[bj][0] * acc[ai][bj][m][0], o1 = b1 + gv[bj][1] * acc[ai][bj][m][1];
                    u32x4 wo; wo.x = cvt_pk_bf16(o0[0], o0[1]); wo.y = cvt_pk_bf16(o0[2], o0[3]); wo.z = cvt_pk_bf16(o1[0], o1[1]); wo.w = cvt_pk_bf16(o1[2], o1[3]);
                    *(u32x4*)(outp + off + bj * HALF) = wo; } }
    }
};
constexpr float C2 = 0.125f * 1.4426950408889634f;
struct EpiQKV {
    bf16_t* Q; const float* cs;
    __device__ __forceinline__ void operator()(const f32x4 (&acc)[2][2][4][2], const Unit& u, int wr, int wc, int fr, int fq) const {
        const int t0 = u.pm * BM; const size_t Rb = (size_t)u.grp * LR + CTXL + t0;
        const int sec = u.pn >> 2; bf16_t* dst = Q + (size_t)sec * ((ACT_K - ACT_Q) / 2);
        const int rr0 = wr * 64 + fr, colt = (u.pn & 3) * BM + wc * 32 + 8 * fq; const float sc = sec == 0 ? C2 : 1.0f; const bool rope = sec < 2;
#pragma unroll
        for (int ai = 0; ai < 2; ++ai)
#pragma unroll
            for (int m = 0; m < 4; ++m) { const int rr = rr0 + ai * HALF + m * 16; bf16_t* rowp = dst + (Rb + rr) * DM + colt;
#pragma unroll
                for (int bj = 0; bj < 2; ++bj) { f32x4 v0 = acc[ai][bj][m][0], v1 = acc[ai][bj][m][1];
                    if (rope) { const int p0 = ((colt + bj * HALF) & 63) >> 1, tt = t0 + rr; const float* cp = cs + ((p0 < 16 ? (tt >> 6) * 16 + p0 : (128 + (tt & 63)) * 16 + (p0 - 16))) * 2;
                        const f32x4 c01 = *(const f32x4*)cp, c23 = *(const f32x4*)(cp + 4);
                        const float a0 = v0[0] * c01[0] - v0[1] * c01[1], a1 = v0[0] * c01[1] + v0[1] * c01[0];
                        const float a2 = v0[2] * c01[2] - v0[3] * c01[3], a3 = v0[2] * c01[3] + v0[3] * c01[2];
                        const float b0 = v1[0] * c23[0] - v1[1] * c23[1], b1 = v1[0] * c23[1] + v1[1] * c23[0];
                        const float b2 = v1[2] * c23[2] - v1[3] * c23[3], b3 = v1[2] * c23[3] + v1[3] * c23[2];
                        v0 = (f32x4){a0, a1, a2, a3}; v1 = (f32x4){b0, b1, b2, b3}; }
                    v0 = v0 * sc; v1 = v1 * sc;
                    u32x4 w; w.x = cvt_pk_bf16(v0[0], v0[1]); w.y = cvt_pk_bf16(v0[2], v0[3]); w.z = cvt_pk_bf16(v1[0], v1[1]); w.w = cvt_pk_bf16(v1[2], v1[3]);
                    *(u32x4*)(rowp + bj * HALF) = w; }
                asm volatile("" ::: "memory"); }
    }
};
struct EpiSwiGLU {
    bf16_t* HID;
    __device__ __forceinline__ void operator()(const f32x4 (&acc)[2][2][4][2], const Unit& u, int wr, int wc, int fr, int fq) const {
        const int row0 = u.pm * BM + wr * 64 + fr, f0 = u.pn * 128 + wc * 16 + 4 * fq;
#pragma unroll
        for (int ai = 0; ai < 2; ++ai)
#pragma unroll
            for (int m = 0; m < 4; ++m) { bf16_t* rowp = HID + ((size_t)u.grp * EROWS + row0 + ai * HALF + m * 16) * FF + f0;
#pragma unroll
                for (int bj = 0; bj < 2; ++bj) { const f32x4 a = acc[ai][bj][m][0], bb = acc[ai][bj][m][1];
                    u32x2 w; w.x = cvt_pk_bf16(silu_f(a[0]) * bb[0], silu_f(a[1]) * bb[1]); w.y = cvt_pk_bf16(silu_f(a[2]) * bb[2], silu_f(a[3]) * bb[3]);
                    *(u32x2*)(rowp + bj * 64) = w; } }
    }
};
struct EpiMoeOut {
    bf16_t* YB; const float* gate;
    __device__ __forceinline__ void operator()(const f32x4 (&acc)[2][2][4][2], const Unit& u, int wr, int wc, int fr, int fq) const {
        const int row0 = u.pm * BM + wr * 64 + fr, col0 = u.pn * BM + wc * 32 + 8 * fq;
#pragma unroll
        for (int ai = 0; ai < 2; ++ai)
#pragma unroll
            for (int m = 0; m < 4; ++m) { const size_t er = (size_t)u.grp * EROWS + row0 + ai * HALF + m * 16; const float gt = gate[er]; bf16_t* rowp = YB + er * DM + col0;
#pragma unroll
                for (int bj = 0; bj < 2; ++bj) { const f32x4 v0 = acc[ai][bj][m][0] * gt, v1 = acc[ai][bj][m][1] * gt;
                    u32x4 w; w.x = cvt_pk_bf16(v0[0], v0[1]); w.y = cvt_pk_bf16(v0[2], v0[3]); w.z = cvt_pk_bf16(v1[0], v1[1]); w.w = cvt_pk_bf16(v1[2], v1[3]);
                    *(u32x4*)(rowp + bj * HALF) = w; } }
    }
};
}

namespace attn_body {
using bf16=__hip_bfloat16;
using s16x4=__attribute__((ext_vector_type(4)))short;
using f32x16=__attribute__((ext_vector_type(16)))float;
constexpr int D=64,PITCH=1024;
constexpr int NW=8,QBLK=32,QB=QBLK*NW,KVBLK=64;
constexpr int NT=LR/KVBLK;
__device__ __forceinline__ int crow(int r,int hi){return (r&3)+8*(r>>2)+4*hi;}
#define SBAR() __builtin_amdgcn_sched_barrier(0)
constexpr int NSLOT=3, SLOTB=8192;
constexpr int LDS_K=0, LDS_V=NSLOT*SLOTB, LDS_WS=2*NSLOT*SLOTB, LDS_OST=LDS_WS+NW*64*4, LDS_BYTES=LDS_OST+NW*4096;
__device__ __forceinline__ void glds16(const void*gsrc,unsigned lds_dst){unsigned keep;
  asm volatile("s_mov_b32 %0, m0\n\ts_mov_b32 m0, %2\n\ts_nop 0\n\tglobal_load_lds_dwordx4 %1, off\n\ts_mov_b32 m0, %0":"=&s"(keep):"v"(gsrc),"s"(lds_dst):"memory");}
__device__ __forceinline__ void glds16s(const void*sbase,unsigned voff,unsigned lds_dst){unsigned keep;
  asm volatile("s_mov_b32 %0, m0\n\ts_mov_b32 m0, %2\n\ts_nop 2\n\tglobal_load_lds_dwordx4 %1, %3\n\ts_mov_b32 m0, %0":"=&s"(keep):"v"(voff),"s"(lds_dst),"s"(sbase):"memory");}
__device__ __forceinline__ float max3f(float a,float b,float c){float r;asm("v_max3_f32 %0, %1, %2, %3":"=v"(r):"v"(a),"v"(b),"v"(c));return r;}
__device__ __forceinline__ float max2f(float a,float b){float r;asm("v_max_f32_e32 %0, %1, %2":"=v"(r):"v"(a),"v"(b));return r;}
__device__ __forceinline__ float fadd_s(float a,float b){float r;asm("v_add_f32_e32 %0, %1, %2":"=v"(r):"v"(a),"v"(b));return r;}
__device__ __forceinline__ float fsub_s(float a,float b){float r;asm("v_sub_f32_e32 %0, %1, %2":"=v"(r):"v"(a),"v"(b));return r;}
typedef float f32x2_t __attribute__((ext_vector_type(2))); typedef __bf16 bf16x2_t __attribute__((ext_vector_type(2)));
__device__ __forceinline__ unsigned cvtpk_s(float lo,float hi){f32x2_t v={lo,hi};bf16x2_t b=__builtin_convertvector(v,bf16x2_t);return __builtin_bit_cast(unsigned,b);}
#define WAIT_BAR(N) asm volatile("s_waitcnt vmcnt(" #N ") lgkmcnt(0)\n\ts_barrier":::"memory")
__device__ __forceinline__ void qkt(f32x16&p0,f32x16&p1,const char*Kslot,const bf16x8*qr,const f32x16&negm,int r32,int hi){
  const char*kb=Kslot+hi*1024+r32*16;
  #pragma unroll
  for(int d0=0;d0<4;++d0){
    const bf16x8 b0=*reinterpret_cast<const bf16x8*>(kb+d0*2048);
    const bf16x8 b1=*reinterpret_cast<const bf16x8*>(kb+d0*2048+512);
    if(d0==0){p0=__builtin_amdgcn_mfma_f32_32x32x16_bf16(b0,qr[0],negm,0,0,0);p1=__builtin_amdgcn_mfma_f32_32x32x16_bf16(b1,qr[0],negm,0,0,0);}
    else{p0=__builtin_amdgcn_mfma_f32_32x32x16_bf16(b0,qr[d0],p0,0,0,0);p1=__builtin_amdgcn_mfma_f32_32x32x16_bf16(b1,qr[d0],p1,0,0,0);}}
}
typedef __attribute__((address_space(3))) const char* lds_cptr;
typedef short v4i16_t __attribute__((ext_vector_type(4)));
__device__ __forceinline__ void kload8(bf16x8*kf,lds_cptr kp){
  kf[0]=*(const __attribute__((address_space(3))) bf16x8*)(kp);      kf[1]=*(const __attribute__((address_space(3))) bf16x8*)(kp+512);
  kf[2]=*(const __attribute__((address_space(3))) bf16x8*)(kp+2048); kf[3]=*(const __attribute__((address_space(3))) bf16x8*)(kp+2560);
  kf[4]=*(const __attribute__((address_space(3))) bf16x8*)(kp+4096); kf[5]=*(const __attribute__((address_space(3))) bf16x8*)(kp+4608);
  kf[6]=*(const __attribute__((address_space(3))) bf16x8*)(kp+6144); kf[7]=*(const __attribute__((address_space(3))) bf16x8*)(kp+6656);
}
__device__ __forceinline__ void kload2(bf16x8*kf,lds_cptr kp,int j){ kf[2*j]=*(const __attribute__((address_space(3))) bf16x8*)(kp+j*2048); kf[2*j+1]=*(const __attribute__((address_space(3))) bf16x8*)(kp+j*2048+512); }
__device__ __forceinline__ s16x4 vtr(lds_cptr p){ return __builtin_bit_cast(s16x4,__builtin_amdgcn_ds_read_tr16_b64_v4i16((__attribute__((address_space(3))) v4i16_t*)p)); }
__device__ __forceinline__ float rowmax(const f32x16&p0,const f32x16&p1){
  float a=max3f(p0[0],p0[1],p1[0]),b=max3f(p0[2],p0[3],p1[1]);a=max3f(a,p1[2],p1[3]);
  #pragma unroll
  for(int r=4;r<16;r+=4){a=max3f(a,p0[r],p0[r+1]);b=max3f(b,p0[r+2],p0[r+3]);a=max3f(a,p1[r],p1[r+1]);b=max3f(b,p1[r+2],p1[r+3]);}
  const float m=max2f(a,b);
  auto rr=__builtin_amdgcn_permlane32_swap(__float_as_uint(m),__float_as_uint(m),false,false);
  return max2f(__uint_as_float(rr[0]),__uint_as_float(rr[1]));
}
__device__ __forceinline__ void pv(f32x16*o,int vb,bf16x8 pa0,bf16x8 pa1,bf16x8 pa2,bf16x8 pa3){
  #pragma unroll
  for(int d0=0;d0<2;++d0){s16x4 lo[4],hi[4];
    #pragma unroll
    for(int ks=0;ks<4;++ks){
      asm volatile("ds_read_b64_tr_b16 %0,%1 offset:%c2":"=&v"(lo[ks]):"v"(vb),"i"(d0*4096+ks*1024):"memory");
      asm volatile("ds_read_b64_tr_b16 %0,%1 offset:%c2":"=&v"(hi[ks]):"v"(vb),"i"(d0*4096+ks*1024+512):"memory");}
    asm volatile("s_waitcnt lgkmcnt(0)":::"memory");SBAR();
    #define PK(k) (bf16x8){lo[k][0],lo[k][1],lo[k][2],lo[k][3],hi[k][0],hi[k][1],hi[k][2],hi[k][3]}
    o[d0]=__builtin_amdgcn_mfma_f32_32x32x16_bf16(pa0,PK(0),o[d0],0,0,0);
    o[d0]=__builtin_amdgcn_mfma_f32_32x32x16_bf16(pa1,PK(1),o[d0],0,0,0);
    o[d0]=__builtin_amdgcn_mfma_f32_32x32x16_bf16(pa2,PK(2),o[d0],0,0,0);
    o[d0]=__builtin_amdgcn_mfma_f32_32x32x16_bf16(pa3,PK(3),o[d0],0,0,0);
    #undef PK
  }
}
template<int THRL> __device__ __forceinline__ void attn_unit(const bf16*Qw,const bf16*__restrict__ Kh,const bf16*__restrict__ Vh,bf16*Ow,char*shm){
  const int tid=threadIdx.x,lane=tid&63,r32=lane&31,hi=lane>>5; const int wid=__builtin_amdgcn_readfirstlane(tid>>6);
  constexpr int DMp=PITCH;
  const unsigned lds0=(unsigned)(uintptr_t)shm;
  float*wsf=(float*)(shm+LDS_WS)+wid*64;
  const bf16*ksrc=Kh+(long)lane*DMp+wid*8;
  const bf16*vsrc=Vh+(long)(16*(wid&3)+(lane>>2))*DMp+(wid>>2)*32+(lane&3)*8;
  const unsigned kdst=lds0+LDS_K+wid*1024, vdst=lds0+LDS_V+wid*1024;
  #define DMA_K(t,slot) glds16(ksrc+(long)(t)*KVBLK*DMp,(unsigned)__builtin_amdgcn_readfirstlane(kdst+(slot)))
  #define DMA_V(t,slot) glds16(vsrc+(long)(t)*KVBLK*DMp,(unsigned)__builtin_amdgcn_readfirstlane(vdst+(slot)))
  const int vb0=(int)(lds0+LDS_V)+((lane>>4)&1)*32+(lane&3)*8+(4*hi+((lane&15)>>2))*64;
  const char*Kbase=shm+LDS_K; bf16x8 kf[8];
  const lds_cptr shm3=(lds_cptr)shm; const lds_cptr kp0=shm3+LDS_K+hi*1024+r32*16; const lds_cptr vp0=shm3+LDS_V+((lane>>4)&1)*32+(lane&3)*8+(4*hi+((lane&15)>>2))*64;
  DMA_K(0,0);DMA_V(0,0);DMA_K(1,SLOTB);
  bf16x8 qr[4];
  #pragma unroll
  for(int d0=0;d0<4;++d0)qr[d0]=*reinterpret_cast<const bf16x8*>(&Qw[(long)r32*DMp+d0*16+hi*8]);
  float mhat=0.f,l_reg=0.f;f32x16 o[2];o[0]=f32x16{};o[1]=f32x16{};f32x16 negm=f32x16{};asm volatile("":"+v"(negm));
  bool resc=false;
  #define START(P0,P1) do{ const float rm=rowmax(P0,P1); resc=false; \
    { const float dl=rm; mhat=fadd_s(mhat,dl); \
      _Pragma("unroll") for(int r=0;r<16;++r){P0[r]=fsub_s(P0[r],dl);P1[r]=fsub_s(P1[r],dl);} \
      _Pragma("unroll") for(int r=0;r<16;++r)negm[r]=-mhat; asm volatile("":"+v"(negm)); } \
    _Pragma("unroll") for(int r=0;r<16;++r)P0[r]=__builtin_amdgcn_exp2f(P0[r]); }while(0)
  #define RESC() do{ if(resc){ asm volatile("s_waitcnt lgkmcnt(0)":::"memory"); \
      _Pragma("unroll") for(int d_=0;d_<2;++d_) _Pragma("unroll") for(int r=0;r<16;++r)o[d_][r]*=wsf[crow(r,hi)]; } }while(0)
  f32x16 pA0,pA1,pB0,pB1;
  int sl_prev=0,sl_cur=0,sl_next=SLOTB;
  #define ROT() do{sl_prev=sl_cur;sl_cur=sl_next;sl_next=(sl_next==(NSLOT-1)*SLOTB)?0:sl_next+SLOTB;}while(0)
  DMA_K(2,2*SLOTB);
  WAIT_BAR(3);
  qkt(pA0,pA1,Kbase,qr,negm,r32,hi);asm volatile("s_nop 15\n\ts_nop 7":"+v"(pA0),"+v"(pA1));
  START(pA0,pA1);
  _Pragma("unroll") for(int r=0;r<16;++r)pA1[r]=__builtin_amdgcn_exp2f(pA1[r]);
  WAIT_BAR(0);
  DMA_K(3,0);DMA_V(1,SLOTB);
  ROT();
  kload8(kf,kp0+sl_cur);
  WAIT_BAR(2);
  s16x4 vlo[8],vhi[8]; u32x4 pw0,pw1,pw2,pw3;
  #define PKW(P,B) cvtpk_s(P[B],P[B+1])
  #define PAF(k) __builtin_bit_cast(bf16x8,pw##k)
  #define VFR(i) (bf16x8){vlo[i][0],vlo[i][1],vlo[i][2],vlo[i][3],vhi[i][0],vhi[i][1],vhi[i][2],vhi[i][3]}
  #define PIN(x) asm volatile("":"+v"(x))
  #define MX3(a,b,c) __builtin_fmaxf(__builtin_fmaxf((a),(b)),(c))
  #define GAPA(MF,A0,A1,A2,A3,W0,W1,PW) do{ MF; sacc+=A0; sacc+=A1; sacc+=A2; sacc+=A3; PIN(sacc); W0; W1; PIN(PW); SBAR(); }while(0)
  #define EX(v) __builtin_amdgcn_exp2f(v)
  #define GAPB(MF,X,B) do{ MF; X[B]=EX(X[B]); X[B+1]=EX(X[B+1]); X[B+2]=EX(X[B+2]); X[B+3]=EX(X[B+3]); PIN(X); SBAR(); }while(0)
  #define VRD(i) do{ vlo[i]=vtr(vp_+(((i)>>2)*4096+((i)&3)*1024)); vhi[i]=vtr(vp_+(((i)>>2)*4096+((i)&3)*1024+512)); }while(0)
  #define KRD(G,j) do{ if(G){ kload2(kf,kp0+sl_next,j); SBAR(); } }while(0)
  #define STEP(C0,C1,P0,P1,t,GK,GV,GL) do{ SBAR(); \
    const lds_cptr vp_=vp0+sl_prev; \
    VRD(0); SBAR(); float sacc=(P0[0]+P0[1]); \
    GAPA(C0=__builtin_amdgcn_mfma_f32_32x32x16_bf16(kf[0],qr[0],negm,0,0,0), P0[2],P0[3],P0[4],P0[5],     pw0[0]=PKW(P0,0), pw0[1]=PKW(P0,2), pw0); \
    VRD(4); SBAR(); GAPA(C1=__builtin_amdgcn_mfma_f32_32x32x16_bf16(kf[1],qr[0],negm,0,0,0), P0[6],P0[7],P0[8],P0[9],     pw0[2]=PKW(P0,4), pw0[3]=PKW(P0,6), pw0); \
    VRD(1); SBAR(); GAPA(C0=__builtin_amdgcn_mfma_f32_32x32x16_bf16(kf[2],qr[1],C0,0,0,0),   P0[10],P0[11],P0[12],P0[13], pw1[0]=PKW(P0,8), pw1[1]=PKW(P0,10), pw1); \
    VRD(5); SBAR(); GAPA(C1=__builtin_amdgcn_mfma_f32_32x32x16_bf16(kf[3],qr[1],C1,0,0,0),   P0[14],P0[15],P1[0],P1[1],   pw1[2]=PKW(P0,12),pw1[3]=PKW(P0,14), pw1); \
    VRD(2); SBAR(); GAPA(C0=__builtin_amdgcn_mfma_f32_32x32x16_bf16(kf[4],qr[2],C0,0,0,0),   P1[2],P1[3],P1[4],P1[5],     pw2[0]=PKW(P1,0), pw2[1]=PKW(P1,2), pw2); \
    VRD(6); SBAR(); GAPA(C1=__builtin_amdgcn_mfma_f32_32x32x16_bf16(kf[5],qr[2],C1,0,0,0),   P1[6],P1[7],P1[8],P1[9],     pw2[2]=PKW(P1,4), pw2[3]=PKW(P1,6), pw2); \
    VRD(3); SBAR(); GAPA(C0=__builtin_amdgcn_mfma_f32_32x32x16_bf16(kf[6],qr[3],C0,0,0,0),   P1[10],P1[11],P1[12],P1[13], pw3[0]=PKW(P1,8), pw3[1]=PKW(P1,10), pw3); \
    VRD(7); SBAR(); GAPA(C1=__builtin_amdgcn_mfma_f32_32x32x16_bf16(kf[7],qr[3],C1,0,0,0),   P1[14],P1[15],0.f,0.f,       pw3[2]=PKW(P1,12),pw3[3]=PKW(P1,14), pw3); \
    l_reg+=sacc; \
    if(GK){DMA_K((t)+3,sl_cur);} if(GV){DMA_V((t)+1,sl_next);} \
    { float a=MX3(C0[0],C0[1],C1[0]),b=MX3(C0[2],C0[3],C1[1]); a=MX3(a,C1[2],C1[3]); \
      _Pragma("unroll") for(int r=4;r<16;r+=4){a=MX3(a,C0[r],C0[r+1]);b=MX3(b,C0[r+2],C0[r+3]);a=MX3(a,C1[r],C1[r+1]);b=MX3(b,C1[r+2],C1[r+3]);} \
      float rm=__builtin_fmaxf(a,b); { auto rr=__builtin_amdgcn_permlane32_swap(__float_as_uint(rm),__float_as_uint(rm),false,false); rm=__builtin_fmaxf(__uint_as_float(rr[0]),__uint_as_float(rr[1])); } \
      resc=false; \
      if(__builtin_expect(__any(rm>(float)THRL),0)){ const float dl=__builtin_fmaxf(rm,0.f); mhat+=dl; \
        _Pragma("unroll") for(int r=0;r<16;++r){C0[r]-=dl;C1[r]-=dl;} \
        _Pragma("unroll") for(int r=0;r<16;++r)negm[r]=-mhat; asm volatile("":"+v"(negm)); \
        const float f=__builtin_amdgcn_exp2f(-dl); l_reg*=f; if(hi==0)wsf[r32]=f; resc=true; } } \
    SBAR(); \
    GAPB(o[0]=__builtin_amdgcn_mfma_f32_32x32x16_bf16(PAF(0),VFR(0),o[0],0,0,0), C0,0); \
    GAPB(o[1]=__builtin_amdgcn_mfma_f32_32x32x16_bf16(PAF(0),VFR(4),o[1],0,0,0), C0,4); \
    KRD(GL,0); GAPB(o[0]=__builtin_amdgcn_mfma_f32_32x32x16_bf16(PAF(1),VFR(1),o[0],0,0,0), C0,8); \
    KRD(GL,1); GAPB(o[1]=__builtin_amdgcn_mfma_f32_32x32x16_bf16(PAF(1),VFR(5),o[1],0,0,0), C0,12); \
    KRD(GL,2); GAPB(o[0]=__builtin_amdgcn_mfma_f32_32x32x16_bf16(PAF(2),VFR(2),o[0],0,0,0), C1,0); \
    KRD(GL,3); GAPB(o[1]=__builtin_amdgcn_mfma_f32_32x32x16_bf16(PAF(2),VFR(6),o[1],0,0,0), C1,4); \
    GAPB(o[0]=__builtin_amdgcn_mfma_f32_32x32x16_bf16(PAF(3),VFR(3),o[0],0,0,0), C1,8); \
    GAPB(o[1]=__builtin_amdgcn_mfma_f32_32x32x16_bf16(PAF(3),VFR(7),o[1],0,0,0), C1,12); \
    }while(0)
  int t=1;
  for(;t+5<NT;t+=2){
    STEP(pB0,pB1,pA0,pA1,t,true,true,true);     WAIT_BAR(2); RESC(); ROT();
    STEP(pA0,pA1,pB0,pB1,t+1,true,true,true);   WAIT_BAR(2); RESC(); ROT();
  }
  #define ENDW(tt) do{ if((tt)+3<NT){WAIT_BAR(2);} else if((tt)+2<NT){WAIT_BAR(1);} else {WAIT_BAR(0);} }while(0)
  for(;t+1<NT;t+=2){
    STEP(pB0,pB1,pA0,pA1,t,(t+3<NT),(t+1<NT),(t+1<NT));       ENDW(t);   RESC(); ROT();
    STEP(pA0,pA1,pB0,pB1,t+1,(t+4<NT),(t+2<NT),(t+2<NT));     ENDW(t+1); RESC(); ROT();
  }
  STEP(pB0,pB1,pA0,pA1,NT-1,false,false,false); RESC();
  { float sacc=pB0[0]+pB0[1]; _Pragma("unroll") for(int r=2;r<16;++r)sacc+=pB0[r]; _Pragma("unroll") for(int r=0;r<16;++r)sacc+=pB1[r]; l_reg+=sacc;
    pw0=(u32x4){PKW(pB0,0),PKW(pB0,2),PKW(pB0,4),PKW(pB0,6)};pw1=(u32x4){PKW(pB0,8),PKW(pB0,10),PKW(pB0,12),PKW(pB0,14)};pw2=(u32x4){PKW(pB1,0),PKW(pB1,2),PKW(pB1,4),PKW(pB1,6)};pw3=(u32x4){PKW(pB1,8),PKW(pB1,10),PKW(pB1,12),PKW(pB1,14)};
    SBAR(); pv(o,vb0+sl_cur,PAF(0),PAF(1),PAF(2),PAF(3)); }
  #undef PKW
  #undef PAF
  #undef VFR
  #undef PIN
  #undef MX3
  #undef GAPA
  #undef GAPB
  #undef EX
  #undef VRD
  #undef KRD
  #undef STEP
  #undef ENDW
  {auto rr=__builtin_amdgcn_permlane32_swap(__float_as_uint(l_reg),__float_as_uint(l_reg),false,false);l_reg=__uint_as_float(rr[0])+__uint_as_float(rr[1]);}
  if(hi==0)wsf[32+r32]=l_reg;asm volatile("s_waitcnt lgkmcnt(0)":::"memory");
  float rli[16];
  #pragma unroll
  for(int r=0;r<16;++r)rli[r]=__builtin_amdgcn_rcpf(wsf[32+crow(r,hi)]);
  { bf16*stg=(bf16*)(shm+LDS_OST)+wid*2048;
    #pragma unroll
    for(int r=0;r<16;++r){const int orow=crow(r,hi);
      #pragma unroll
      for(int d0=0;d0<2;++d0)stg[orow*64+d0*32+r32]=__float2bfloat16(o[d0][r]*rli[r]);}
    asm volatile("s_waitcnt lgkmcnt(0)":::"memory");
    #pragma unroll
    for(int i=0;i<4;++i){const int row=i*8+(lane>>3),ch=lane&7; const u32x4 v=*(const u32x4*)(stg+row*64+ch*8); *(u32x4*)(Ow+(long)row*DMp+ch*8)=v;} }
  asm volatile("s_waitcnt lgkmcnt(0)\n\ts_barrier":::"memory");
  #undef DMA_K
  #undef DMA_V
  #undef START
  #undef RESC
  #undef ROT
}

constexpr int VSLOTB=16384;
constexpr int L2_K=0, L2_V=NSLOT*SLOTB, L2_WS=L2_V+NSLOT*VSLOTB, L2_OST=L2_WS+NW*64*4, L2_BYTES=L2_OST+NW*4096;
template<int THRL> __device__ __forceinline__ void attn_unit128(const bf16*Qw,const bf16*__restrict__ Kh,const bf16*__restrict__ Vh,bf16*Ow,char*shm){
  const int tid=threadIdx.x,lane=tid&63,r32=lane&31,hi=lane>>5; const int wid=__builtin_amdgcn_readfirstlane(tid>>6);
  constexpr int DMp=PITCH;
  const unsigned lds0=(unsigned)(uintptr_t)shm;
  float*wsf=(float*)(shm+L2_WS)+wid*64;
  const unsigned koff=(unsigned)(lane*DMp+wid*8)*2u;
  const unsigned voff=(unsigned)((16*(wid&3)+(lane>>2))*DMp+(wid>>2)*32+(lane&3)*8)*2u;
  const unsigned kdst=lds0+L2_K+wid*1024, vdst=lds0+L2_V+wid*1024;
  #define DMA_K(t,slot) glds16s((const char*)Kh+(long)(t)*KVBLK*DMp*2,koff,(unsigned)__builtin_amdgcn_readfirstlane(kdst+(slot)))
  #define DMA_V(t,slot) do{ glds16s((const char*)Vh+(long)(t)*KVBLK*DMp*2,voff,(unsigned)__builtin_amdgcn_readfirstlane(vdst+2*(slot))); glds16s((const char*)Vh+(long)(t)*KVBLK*DMp*2+128,voff,(unsigned)__builtin_amdgcn_readfirstlane(vdst+2*(slot)+8192)); }while(0)
  const char*Kbase=shm+L2_K; bf16x8 kf[8];
  const lds_cptr shm3=(lds_cptr)shm; const lds_cptr kp0=shm3+L2_K+hi*1024+r32*16; const lds_cptr vp0=shm3+L2_V+((lane>>4)&1)*32+(lane&3)*8+(4*hi+((lane&15)>>2))*64;
  DMA_K(0,0);DMA_V(0,0);DMA_K(1,SLOTB);
  bf16x8 qr[4];
  #pragma unroll
  for(int d0=0;d0<4;++d0)qr[d0]=*reinterpret_cast<const bf16x8*>(&Qw[(long)r32*DMp+d0*16+hi*8]);
  float mhat=0.f,l_reg=0.f;f32x16 o[4];o[0]=f32x16{};o[1]=f32x16{};o[2]=f32x16{};o[3]=f32x16{};f32x16 negm=f32x16{};asm volatile("":"+v"(negm));
  bool resc=false;
  #define RESC() do{ if(resc){ asm volatile("s_waitcnt lgkmcnt(0)":::"memory"); \
      _Pragma("unroll") for(int d_=0;d_<4;++d_) _Pragma("unroll") for(int r=0;r<16;++r)o[d_][r]*=wsf[crow(r,hi)]; } }while(0)
  f32x16 c0,c1; u32x4 pw0,pw1,pw2,pw3;
  int sl_prev=0,sl_cur=0,sl_next=SLOTB;
  #define ROT() do{sl_prev=sl_cur;sl_cur=sl_next;sl_next=(sl_next==(NSLOT-1)*SLOTB)?0:sl_next+SLOTB;}while(0)
  #define PKW(P,B) cvtpk_s(P[B],P[B+1])
  #define PAF(k) __builtin_bit_cast(bf16x8,pw##k)
  DMA_K(2,2*SLOTB);
  WAIT_BAR(4);
  qkt(c0,c1,Kbase,qr,negm,r32,hi);asm volatile("s_nop 15\n\ts_nop 7":"+v"(c0),"+v"(c1));
  { const float rm=rowmax(c0,c1); mhat=fadd_s(mhat,rm);
    _Pragma("unroll") for(int r=0;r<16;++r){c0[r]=fsub_s(c0[r],rm);c1[r]=fsub_s(c1[r],rm);}
    _Pragma("unroll") for(int r=0;r<16;++r)negm[r]=-mhat; asm volatile("":"+v"(negm));
    _Pragma("unroll") for(int r=0;r<16;++r){c0[r]=__builtin_amdgcn_exp2f(c0[r]);c1[r]=__builtin_amdgcn_exp2f(c1[r]);}
    float sacc=c0[0]+c0[1]; _Pragma("unroll") for(int r=2;r<16;++r)sacc+=c0[r]; _Pragma("unroll") for(int r=0;r<16;++r)sacc+=c1[r]; l_reg+=sacc;
    pw0=(u32x4){PKW(c0,0),PKW(c0,2),PKW(c0,4),PKW(c0,6)};pw1=(u32x4){PKW(c0,8),PKW(c0,10),PKW(c0,12),PKW(c0,14)};pw2=(u32x4){PKW(c1,0),PKW(c1,2),PKW(c1,4),PKW(c1,6)};pw3=(u32x4){PKW(c1,8),PKW(c1,10),PKW(c1,12),PKW(c1,14)}; }
  WAIT_BAR(0);
  DMA_K(3,0);DMA_V(1,SLOTB);
  ROT();
  kload8(kf,kp0+sl_cur);
  WAIT_BAR(3);
  s16x4 vlo[8],vhi[8];
  #define VFR(i) (bf16x8){vlo[i][0],vlo[i][1],vlo[i][2],vlo[i][3],vhi[i][0],vhi[i][1],vhi[i][2],vhi[i][3]}
  #define PIN(x) asm volatile("":"+v"(x))
  #define MX3(a,b,c) __builtin_fmaxf(__builtin_fmaxf((a),(b)),(c))
  #define EX(v) __builtin_amdgcn_exp2f(v)
  #define VRD(H,i) do{ vlo[i]=vtr(vp_+((2*(H)+((i)>>2))*4096+((i)&3)*1024)); vhi[i]=vtr(vp_+((2*(H)+((i)>>2))*4096+((i)&3)*1024+512)); }while(0)
  #define KRD(G,j) do{ if(G){ kload2(kf,kp0+sl_next,j); SBAR(); } }while(0)
  #define GAPA(MF) do{ MF; SBAR(); }while(0)
  #define GAPB(MF,X,B,VR) do{ MF; X[B]=EX(X[B]); X[B+1]=EX(X[B+1]); X[B+2]=EX(X[B+2]); X[B+3]=EX(X[B+3]); PIN(X); VR; SBAR(); }while(0)
  #define GAPC(MF,X,B) do{ MF; sacc+=X[B]; sacc+=X[B+1]; sacc+=X[B+2]; sacc+=X[B+3]; PIN(sacc); SBAR(); }while(0)
  #define GAPCE(MF,X,B,Y,D) do{ MF; sacc+=X[B]; sacc+=X[B+1]; sacc+=X[B+2]; sacc+=X[B+3]; PIN(sacc); Y[D]=EX(Y[D]); Y[D+1]=EX(Y[D+1]); Y[D+2]=EX(Y[D+2]); Y[D+3]=EX(Y[D+3]); PIN(Y); SBAR(); }while(0)
  #define STEP(t,GK,GV,GL) do{ SBAR(); \
    const lds_cptr vp_=vp0+2*sl_prev; \
      \
    VRD(0,0); SBAR(); GAPA(c0=__builtin_amdgcn_mfma_f32_32x32x16_bf16(kf[0],qr[0],negm,0,0,0)); \
    VRD(0,4); SBAR(); GAPA(c1=__builtin_amdgcn_mfma_f32_32x32x16_bf16(kf[1],qr[0],negm,0,0,0)); \
    VRD(0,1); SBAR(); GAPA(c0=__builtin_amdgcn_mfma_f32_32x32x16_bf16(kf[2],qr[1],c0,0,0,0)); \
    VRD(0,5); SBAR(); GAPA(c1=__builtin_amdgcn_mfma_f32_32x32x16_bf16(kf[3],qr[1],c1,0,0,0)); \
    VRD(0,2); SBAR(); GAPA(c0=__builtin_amdgcn_mfma_f32_32x32x16_bf16(kf[4],qr[2],c0,0,0,0)); \
    VRD(0,6); SBAR(); GAPA(c1=__builtin_amdgcn_mfma_f32_32x32x16_bf16(kf[5],qr[2],c1,0,0,0)); \
    VRD(0,3); SBAR(); GAPA(c0=__builtin_amdgcn_mfma_f32_32x32x16_bf16(kf[6],qr[3],c0,0,0,0)); \
    VRD(0,7); SBAR(); GAPA(c1=__builtin_amdgcn_mfma_f32_32x32x16_bf16(kf[7],qr[3],c1,0,0,0)); \
    if(GK){DMA_K((t)+3,sl_cur);} if(GV){DMA_V((t)+1,sl_next);} \
    SBAR(); \
      \
    float mxa,mxb,rm_; \
    o[0]=__builtin_amdgcn_mfma_f32_32x32x16_bf16(PAF(0),VFR(0),o[0],0,0,0); \
    { mxa=MX3(c0[0],c0[1],c0[2]); mxb=MX3(c0[3],c0[4],c0[5]); mxa=MX3(mxa,c0[6],c0[7]); mxb=MX3(mxb,c0[8],c0[9]); mxa=MX3(mxa,c0[10],c0[11]); mxb=MX3(mxb,c0[12],c0[13]); mxa=MX3(mxa,c0[14],c0[15]); } VRD(1,0); SBAR(); \
    o[1]=__builtin_amdgcn_mfma_f32_32x32x16_bf16(PAF(0),VFR(4),o[1],0,0,0); \
    { mxb=MX3(mxb,c1[0],c1[1]); mxa=MX3(mxa,c1[2],c1[3]); mxb=MX3(mxb,c1[4],c1[5]); mxa=MX3(mxa,c1[6],c1[7]); mxb=MX3(mxb,c1[8],c1[9]); mxa=MX3(mxa,c1[10],c1[11]); mxb=MX3(mxb,c1[12],c1[13]); mxa=MX3(mxa,c1[14],c1[15]); \
      rm_=__builtin_fmaxf(mxa,mxb); { auto rr=__builtin_amdgcn_permlane32_swap(__float_as_uint(rm_),__float_as_uint(rm_),false,false); rm_=__builtin_fmaxf(__uint_as_float(rr[0]),__uint_as_float(rr[1])); } } VRD(1,4); SBAR(); \
    o[0]=__builtin_amdgcn_mfma_f32_32x32x16_bf16(PAF(1),VFR(1),o[0],0,0,0); \
    { resc=false; \
      if(__builtin_expect(__any(rm_>(float)THRL),0)){ const float dl=__builtin_fmaxf(rm_,0.f); mhat+=dl; \
        _Pragma("unroll") for(int r=0;r<16;++r){c0[r]-=dl;c1[r]-=dl;} \
        _Pragma("unroll") for(int r=0;r<16;++r)negm[r]=-mhat; asm volatile("":"+v"(negm)); \
        const float f=__builtin_amdgcn_exp2f(-dl); l_reg*=f; if(hi==0)wsf[r32]=f; resc=true; } } VRD(1,1); SBAR(); \
    GAPB(o[1]=__builtin_amdgcn_mfma_f32_32x32x16_bf16(PAF(1),VFR(5),o[1],0,0,0), c0,0,  VRD(1,5)); \
    GAPB(o[0]=__builtin_amdgcn_mfma_f32_32x32x16_bf16(PAF(2),VFR(2),o[0],0,0,0), c0,4,  VRD(1,2)); \
    GAPB(o[1]=__builtin_amdgcn_mfma_f32_32x32x16_bf16(PAF(2),VFR(6),o[1],0,0,0), c0,8,  VRD(1,6)); \
    GAPB(o[0]=__builtin_amdgcn_mfma_f32_32x32x16_bf16(PAF(3),VFR(3),o[0],0,0,0), c0,12, VRD(1,3)); \
    GAPB(o[1]=__builtin_amdgcn_mfma_f32_32x32x16_bf16(PAF(3),VFR(7),o[1],0,0,0), c1,0,  VRD(1,7)); \
      \
    float sacc=0.f; \
    GAPCE(o[2]=__builtin_amdgcn_mfma_f32_32x32x16_bf16(PAF(0),VFR(0),o[2],0,0,0), c0,0, c1,4); \
    GAPCE(o[3]=__builtin_amdgcn_mfma_f32_32x32x16_bf16(PAF(0),VFR(4),o[3],0,0,0), c0,4, c1,8); \
    pw0[0]=PKW(c0,0); pw0[1]=PKW(c0,2); pw0[2]=PKW(c0,4); pw0[3]=PKW(c0,6); PIN(pw0); SBAR(); \
    KRD(GL,0); GAPCE(o[2]=__builtin_amdgcn_mfma_f32_32x32x16_bf16(PAF(1),VFR(1),o[2],0,0,0), c0,8, c1,12); \
    KRD(GL,1); GAPC(o[3]=__builtin_amdgcn_mfma_f32_32x32x16_bf16(PAF(1),VFR(5),o[3],0,0,0), c0,12); \
    pw1[0]=PKW(c0,8); pw1[1]=PKW(c0,10); pw1[2]=PKW(c0,12); pw1[3]=PKW(c0,14); PIN(pw1); SBAR(); \
    KRD(GL,2); GAPC(o[2]=__builtin_amdgcn_mfma_f32_32x32x16_bf16(PAF(2),VFR(2),o[2],0,0,0), c1,0); \
    KRD(GL,3); GAPC(o[3]=__builtin_amdgcn_mfma_f32_32x32x16_bf16(PAF(2),VFR(6),o[3],0,0,0), c1,4); \
    pw2[0]=PKW(c1,0); pw2[1]=PKW(c1,2); pw2[2]=PKW(c1,4); pw2[3]=PKW(c1,6); PIN(pw2); SBAR(); \
    GAPC(o[2]=__builtin_amdgcn_mfma_f32_32x32x16_bf16(PAF(3),VFR(3),o[2],0,0,0), c1,8); \
    GAPC(o[3]=__builtin_amdgcn_mfma_f32_32x32x16_bf16(PAF(3),VFR(7),o[3],0,0,0), c1,12); \
    pw3[0]=PKW(c1,8); pw3[1]=PKW(c1,10); pw3[2]=PKW(c1,12); pw3[3]=PKW(c1,14); PIN(pw3); SBAR(); \
    l_reg+=sacc; \
    }while(0)
  int t=1;
  for(;t+5<NT;t+=2){
    STEP(t,true,true,true);     WAIT_BAR(3); RESC(); ROT();
    STEP(t+1,true,true,true);   WAIT_BAR(3); RESC(); ROT();
  }
  #define ENDW(tt) do{ if((tt)+3<NT){WAIT_BAR(3);} else if((tt)+2<NT){WAIT_BAR(2);} else {WAIT_BAR(0);} }while(0)
  for(;t+1<NT;t+=2){
    STEP(t,(t+3<NT),(t+1<NT),(t+1<NT));       ENDW(t);   RESC(); ROT();
    STEP(t+1,(t+4<NT),(t+2<NT),(t+2<NT));     ENDW(t+1); RESC(); ROT();
  }
  STEP(NT-1,false,false,false); RESC();
  { int lane_=threadIdx.x&63; asm volatile("":"+v"(lane_));
    const int vb=(int)(lds0+L2_V)+((lane_>>4)&1)*32+(lane_&3)*8+(4*(lane_>>5)+((lane_&15)>>2))*64+2*sl_cur;
    #pragma unroll
    for(int d0=0;d0<4;++d0){s16x4 lo[4],hh[4];
      #pragma unroll
      for(int ks=0;ks<4;++ks){
        asm volatile("ds_read_b64_tr_b16 %0,%1 offset:%c2":"=&v"(lo[ks]):"v"(vb),"i"(d0*4096+ks*1024):"memory");
        asm volatile("ds_read_b64_tr_b16 %0,%1 offset:%c2":"=&v"(hh[ks]):"v"(vb),"i"(d0*4096+ks*1024+512):"memory");}
      asm volatile("s_waitcnt lgkmcnt(0)":::"memory");SBAR();
      #define PK(k) (bf16x8){lo[k][0],lo[k][1],lo[k][2],lo[k][3],hh[k][0],hh[k][1],hh[k][2],hh[k][3]}
      o[d0]=__builtin_amdgcn_mfma_f32_32x32x16_bf16(PAF(0),PK(0),o[d0],0,0,0);
      o[d0]=__builtin_amdgcn_mfma_f32_32x32x16_bf16(PAF(1),PK(1),o[d0],0,0,0);
      o[d0]=__builtin_amdgcn_mfma_f32_32x32x16_bf16(PAF(2),PK(2),o[d0],0,0,0);
      o[d0]=__builtin_amdgcn_mfma_f32_32x32x16_bf16(PAF(3),PK(3),o[d0],0,0,0);
      #undef PK
    } }
  #undef PKW
  #undef PAF
  #undef VFR
  #undef PIN
  #undef MX3
  #undef GAPA
  #undef GAPB
  #undef GAPC
  #undef GAPCE
  #undef EX
  #undef VRD
  #undef KRD
  #undef STEP
  #undef ENDW
  {auto rr=__builtin_amdgcn_permlane32_swap(__float_as_uint(l_reg),__float_as_uint(l_reg),false,false);l_reg=__uint_as_float(rr[0])+__uint_as_float(rr[1]);}
  if(hi==0)wsf[32+r32]=l_reg;asm volatile("s_waitcnt lgkmcnt(0)":::"memory");
  float rli[16];
  #pragma unroll
  for(int r=0;r<16;++r)rli[r]=__builtin_amdgcn_rcpf(wsf[32+crow(r,hi)]);
  { bf16*stg=(bf16*)(shm+L2_OST)+wid*2048;
    #pragma unroll
    for(int hf=0;hf<2;++hf){
      #pragma unroll
      for(int r=0;r<16;++r){const int orow=crow(r,hi);
        #pragma unroll
        for(int d0=0;d0<2;++d0)stg[orow*64+d0*32+r32]=__float2bfloat16(o[2*hf+d0][r]*rli[r]);}
      asm volatile("s_waitcnt lgkmcnt(0)":::"memory");
      #pragma unroll
      for(int i=0;i<4;++i){const int row=i*8+(lane>>3),ch=lane&7; const u32x4 v=*(const u32x4*)(stg+row*64+ch*8); *(u32x4*)(Ow+(long)row*DMp+hf*64+ch*8)=v;}
      asm volatile("s_waitcnt lgkmcnt(0)":::"memory"); } }
  asm volatile("s_waitcnt lgkmcnt(0)\n\ts_barrier":::"memory");
  #undef DMA_K
  #undef DMA_V
  #undef RESC
  #undef ROT
}
#undef SBAR
#undef WAIT_BAR
}

constexpr int NWAVES = 8, LDS_BYTES = 147456, RING_BYTES = 131072;
struct Params { const float* in[32]; float* out; unsigned char* ws; int ph_lo, ph_hi; };
enum { I_X = 0, I_C, I_CTX, I_CCTX, I_ADAW, I_ADAB, I_NMIXG, I_NFFNG, I_WIN, I_CONVW, I_CONVB, I_LRUWA, I_LRUBA, I_LRUWX, I_LRUBX, I_LRULAM, I_CMVG, I_CMWS, I_CMBS, I_WOUT0,
       I_WQKV, I_LQ1, I_LK1, I_LQ2, I_LK2, I_SUBLN, I_WOUT1, I_ROUTER, I_W1, I_W3, I_W2, I_FINALG };

typedef const __attribute__((address_space(4))) Params* KParams;
__device__ __forceinline__ Params kparams() {
#if defined(__HIP_DEVICE_COMPILE__)
    KParams q = (KParams)__builtin_amdgcn_kernarg_segment_ptr(); asm volatile("" : "+s"(q)); return *q;
#else
    return Params{};
#endif
}
struct Ctx {
    LAS unsigned char* lds; int tid, lane, wave, vcu, G;
};
__device__ __forceinline__ float wave_sum(float v) {
#pragma unroll
    for (int o = 1; o < 64; o <<= 1) v += __shfl_xor(v, o);
    return v;
}
#define LDS_WAIT() asm volatile("s_waitcnt lgkmcnt(0)" ::: "memory")

__device__ __forceinline__ int dest_row(int n, int mode) {
    if (mode == 1) return n < 2048 ? ((n & ~63) + 2 * (n & 31) + ((n >> 5) & 1)) : n;
    if (mode == 2) return 32 * (n >> 4) + (n & 15);
    if (mode == 3) return 32 * (n >> 4) + 16 + (n & 15);
    return n;
}
__device__ __forceinline__ void p0_transpose_item(const float* W, int K, int N, bf16_t* WT, int mode, LAS float* scr, int item, int lane) {
    const int nblk = N / 32, kb = item / nblk, nb = item % nblk, k0 = 64 * kb, n0 = 32 * nb;
    float tv[32];
#pragma unroll
    for (int i = 0; i < 32; ++i) { const int kk = 2 * i + (lane >> 5); tv[i] = __builtin_nontemporal_load(&W[(size_t)(k0 + kk) * N + n0 + (lane & 31)]); }
#pragma unroll
    for (int i = 0; i < 32; ++i) { const int kk = 2 * i + (lane >> 5); scr[kk * 33 + (lane & 31)] = tv[i]; }
    LDS_WAIT(); asm volatile("" ::: "memory");
    const int c = lane & 7;
#pragma unroll
    for (int j = 0; j < 4; ++j) { const int n = (lane >> 3) + 8 * j; const LAS float* s = scr + (8 * c) * 33 + n;
        u32x4 o; o.x = pk2(s[0 * 33], s[1 * 33]); o.y = pk2(s[2 * 33], s[3 * 33]); o.z = pk2(s[4 * 33], s[5 * 33]); o.w = pk2(s[6 * 33], s[7 * 33]);
        *(GAS u32x4*)(WT + (size_t)dest_row(n0 + n, mode) * K + k0 + 8 * c) = o; }
    LDS_WAIT(); asm volatile("" ::: "memory");
}
__device__ __forceinline__ void p0_transpose_item8(const float* W, int K, int N, unsigned char* WT, int mode, LAS float* scr, int item, int lane) {
    const int nblk = N / 32, kb = item / nblk, nb = item % nblk, k0 = 64 * kb, n0 = 32 * nb;
    float tv[32];
#pragma unroll
    for (int i = 0; i < 32; ++i) { const int kk = 2 * i + (lane >> 5); tv[i] = __builtin_nontemporal_load(&W[(size_t)(k0 + kk) * N + n0 + (lane & 31)]); }
#pragma unroll
    for (int i = 0; i < 32; ++i) { const int kk = 2 * i + (lane >> 5); scr[kk * 33 + (lane & 31)] = tv[i] * W8_SCALE; }
    LDS_WAIT(); asm volatile("" ::: "memory");
    const int c = lane & 7;
#pragma unroll
    for (int j = 0; j < 4; ++j) { const int n = (lane >> 3) + 8 * j; const LAS float* sp = scr + (8 * c) * 33 + n;
        u32x2 o; o.x = f2fp8x4(sp[0 * 33], sp[1 * 33], sp[2 * 33], sp[3 * 33]); o.y = f2fp8x4(sp[4 * 33], sp[5 * 33], sp[6 * 33], sp[7 * 33]);
        *(GAS u32x2*)(WT + (size_t)dest_row(n0 + n, mode) * K + k0 + 8 * c) = o; }
    LDS_WAIT(); asm volatile("" ::: "memory");
}
__device__ __forceinline__ void p0_prologue(const Ctx& F, const Params& p) {
    unsigned char* ws = p.ws;
    LAS float* sil = (LAS float*)(F.lds + 8 * 16384);
    for (int i = F.tid; i < 3 * DM; i += 512) { const float v = i < 2 * DM ? p.in[I_C][i] : p.in[I_CCTX][i - 2 * DM]; sil[i] = silu_f(v); }
    __syncthreads();
    {
        float* modp = (float*)(ws + WS_MODP);
        for (int task = F.wave * F.G + F.vcu; task < 2 * 96 * 8; task += NWAVES * F.G) {
            const int ks = task & 7, cgp = (task >> 3) % 96, l = task / 768, n = cgp * 64 + F.lane;
            const float* W = p.in[I_ADAW] + ((size_t)l * DM + ks * 128) * 6144 + n;
            float a0 = 0.f, a1 = 0.f, a2 = 0.f;
#pragma unroll 32
            for (int k = 0; k < 128; ++k) { const float w = __builtin_nontemporal_load(&W[(size_t)k * 6144]); a0 += sil[ks * 128 + k] * w; a1 += sil[DM + ks * 128 + k] * w; a2 += sil[2 * DM + ks * 128 + k] * w; }
            float* o = modp + ((size_t)(ks * 2 + l) * 3) * 6144 + n; o[0] = a0; o[6144] = a1; o[2 * 6144] = a2;
        }
    }
    {
        const int gt = F.vcu * 512 + F.tid, NT_ = F.G * 512;
        float* cs = (float*)(ws + WS_ROPE);
        for (int i = gt; i < 192 * 16; i += NT_) { const int pos = i >> 4, f = i & 15; const float inv = powf(10000.0f, -(float)(2 * f) / 32.0f);
            const float ang = (float)(pos < 128 ? pos : pos - 128) * inv; float s, c; sincosf(ang, &s, &c); cs[2 * i] = c; cs[2 * i + 1] = s; }
        bf16_t* lw = (bf16_t*)(ws + WS_LRUW);
        for (int o = gt; o < 2 * 2 * 8 * 64 * 64; o += NT_) { const int i = o & 63, j = (o >> 6) & 63, h = (o >> 12) & 7, g2 = (o >> 15) & 1, d = o >> 16;
            const float* src = g2 ? p.in[I_LRUWX] : p.in[I_LRUWA]; lw[o] = (bf16_t)f2bf(src[((d * 8 + h) * 64 + i) * 64 + j]); }
        bf16_t* cw = (bf16_t*)(ws + WS_CMWS);
        for (int o = gt; o < 8 * 128 * 128; o += NT_) cw[o] = (bf16_t)f2bf(p.in[I_CMWS][o]);
    }
    LAS float* scr = (LAS float*)(F.lds + F.wave * 16384);
    const int gw = F.vcu * NWAVES + F.wave, NGW = F.G * NWAVES;
    constexpr int I_IN = 1024, I_O0 = 512, I_QK = 1536, I_O1 = 512, I_SMALL = I_IN + I_O0 + I_QK + I_O1, I_MOE = 1024, NITEMS = I_SMALL + 3 * 32 * I_MOE;
    for (int it = gw; it < NITEMS; it += NGW) {
        int r = it;
        if (r < I_SMALL) {
            if (r < I_IN) { p0_transpose_item(p.in[I_WIN], DM, 2048, (bf16_t*)(ws + WS_WIN), 0, scr, r, F.lane); continue; } r -= I_IN;
            if (r < I_O0) { p0_transpose_item(p.in[I_WOUT0], DM, DM, (bf16_t*)(ws + WS_WOUT0), 0, scr, r, F.lane); continue; } r -= I_O0;
            if (r < I_QK) { p0_transpose_item(p.in[I_WQKV], DM, 3072, (bf16_t*)(ws + WS_WQKV), 1, scr, r, F.lane); continue; } r -= I_QK;
            p0_transpose_item(p.in[I_WOUT1], DM, DM, (bf16_t*)(ws + WS_WOUT1), 0, scr, r, F.lane); continue;
        }
        r -= I_SMALL; const int which = r / (32 * I_MOE), le = (r / I_MOE) % 32, item = r % I_MOE;
        if (which == 0) p0_transpose_item8(p.in[I_W1] + (size_t)le * DM * FF, DM, FF, ws + WS_W13 + (size_t)le * 4096 * DM, 2, scr, item, F.lane);
        else if (which == 1) p0_transpose_item8(p.in[I_W3] + (size_t)le * DM * FF, DM, FF, ws + WS_W13 + (size_t)le * 4096 * DM, 3, scr, item, F.lane);
        else p0_transpose_item8(p.in[I_W2] + (size_t)le * FF * DM, FF, DM, ws + WS_W2 + (size_t)le * DM * FF, 0, scr, item, F.lane);
    }
}

__device__ __forceinline__ void ld_row(const float* pr, int lane, f32x4 (&v)[4]) {
#pragma unroll
    for (int j = 0; j < 4; ++j) v[j] = *(const f32x4*)(pr + 4 * lane + 256 * j);
}
__device__ __forceinline__ void ld_row_bf(const bf16_t* pr, int lane, f32x4 (&v)[4]) {
#pragma unroll
    for (int j = 0; j < 4; ++j) { const u32x2 w = *(const u32x2*)(pr + 4 * lane + 256 * j); v[j] = (f32x4){bflo(w.x), bfhi(w.x), bflo(w.y), bfhi(w.y)}; }
}
__device__ __forceinline__ float row_rstd(const f32x4 (&v)[4]) {
    float s = 0.f;
#pragma unroll
    for (int j = 0; j < 4; ++j) s += (v[j][0] * v[j][0] + v[j][1] * v[j][1]) + (v[j][2] * v[j][2] + v[j][3] * v[j][3]);
    return 1.0f / sqrtf(wave_sum(s) * (1.0f / DM) + EPS);
}
__device__ __forceinline__ void mod_norm(f32x4 (&v)[4], float rstd, const float* g, const float* sc, const float* sh, int lane) {
#pragma unroll
    for (int j = 0; j < 4; ++j) { const int c = 4 * lane + 256 * j; const f32x4 gv = *(const f32x4*)(g + c), sv = *(const f32x4*)(sc + c), hv = *(const f32x4*)(sh + c);
        v[j] = v[j] * rstd * gv * (sv + 1.0f) + hv; }
}
__device__ __forceinline__ void st_row_bf16(bf16_t* pr, int lane, const f32x4 (&v)[4]) {
#pragma unroll
    for (int j = 0; j < 4; ++j) { u32x2 w; w.x = pk2(v[j][0], v[j][1]); w.y = pk2(v[j][2], v[j][3]); *(u32x2*)(pr + 4 * lane + 256 * j) = w; }
}
__device__ __forceinline__ void row_info(int R, int& b, int& j, int& rt) { b = R / LR; j = R % LR; rt = j < CTXL ? 2 : b; }

__device__ __forceinline__ void stage_mod(const Ctx& F, LAS float* dst, const float* mod_l, const float* g, int sc_chunk, int sh_chunk) {
    float gq[6], sq[6], hq[6];
#pragma unroll
    for (int q = 0; q < 6; ++q) { const int i = F.tid + 512 * q, rt = i >> 10, c = i & 1023; const float* m = mod_l + (size_t)rt * 6144; gq[q] = g[c]; sq[q] = m[sc_chunk * DM + c]; hq[q] = m[sh_chunk * DM + c]; }
#pragma unroll
    for (int q = 0; q < 6; ++q) { const int i = F.tid + 512 * q; dst[i] = gq[q] * (1.0f + sq[q]); dst[3 * DM + i] = hq[q]; }
}
__device__ __forceinline__ void apply_mod(f32x4 (&v)[4], float rstd, const LAS float* ms, int rt, int lane) {
#pragma unroll
    for (int j = 0; j < 4; ++j) { const int c = rt * DM + 4 * lane + 256 * j; v[j] = v[j] * rstd * *(const LAS f32x4*)(ms + c) + *(const LAS f32x4*)(ms + 3 * DM + c); }
}
constexpr int NBR = 4;
__device__ __forceinline__ void p_norm1_in(const Ctx& F, const Params& p) {
    bf16_t* H = (bf16_t*)(p.ws + WS_H);
    LAS float* ms = (LAS float*)F.lds;
    {
        const float* modp = (const float*)(p.ws + WS_MODP); float* modw = (float*)(p.ws + WS_MOD);
        for (int i = blockIdx.x * 512 + F.tid; i < 2 * 3 * 6144; i += F.G * 512) { const int l = i / (3 * 6144), n = i % 6144; float a = p.in[I_ADAB][l * 6144 + n];
#pragma unroll
            for (int ks = 0; ks < 8; ++ks) a += modp[(size_t)ks * 2 * 3 * 6144 + i];
            modw[i] = a; }
#pragma unroll
        for (int q = 0; q < 6; q += 2) {
            float shv[2][8], scv[2][8], b0[2], b1[2], gg[2];
#pragma unroll
            for (int u = 0; u < 2; ++u) { const int i = F.tid + 512 * (q + u), rt = i >> 10, c = i & 1023; b0[u] = p.in[I_ADAB][c]; b1[u] = p.in[I_ADAB][DM + c]; gg[u] = p.in[I_NMIXG][c];
#pragma unroll
                for (int ks = 0; ks < 8; ++ks) { const float* pp = modp + ((size_t)(ks * 2 + 0) * 3 + rt) * 6144; shv[u][ks] = pp[c]; scv[u][ks] = pp[DM + c]; } }
#pragma unroll
            for (int u = 0; u < 2; ++u) { const int i = F.tid + 512 * (q + u); float sh = b0[u], sc = b1[u];
#pragma unroll
                for (int ks = 0; ks < 8; ++ks) { sh += shv[u][ks]; sc += scv[u][ks]; }
                ms[i] = gg[u] * (1.0f + sc); ms[3 * DM + i] = sh; } }
    }
    __syncthreads();
    const int gw = F.vcu * NWAVES + F.wave, NGW = F.G * NWAVES;
    for (int R0 = gw; R0 < NR; R0 += NBR * NGW) {
        f32x4 v[NBR][4]; int rts[NBR];
#pragma unroll
        for (int k = 0; k < NBR; ++k) { const int R = R0 + k * NGW < NR ? R0 + k * NGW : R0; int b, j; row_info(R, b, j, rts[k]);
            const float* src = j < CTXL ? p.in[I_CTX] + ((size_t)b * CTXL + j) * DM : p.in[I_X] + ((size_t)b * SEQ + (j - CTXL)) * DM; ld_row(src, F.lane, v[k]); }
#pragma unroll
        for (int k = 0; k < NBR; ++k) { const int R = R0 + k * NGW; const float rstd = row_rstd(v[k]); apply_mod(v[k], rstd, ms, rts[k], F.lane); if (R < NR) st_row_bf16(H + (size_t)R * DM, F.lane, v[k]); } }
    __syncthreads();
}
__device__ __forceinline__ void p_norm2_router(const Ctx& F, const Params& p, int l, bool with_ctx) {
    const float* mod = (const float*)(p.ws + WS_MOD); unsigned char* H8 = p.ws + WS_H; const bf16_t* X = (const bf16_t*)(p.ws + WS_X); float* aff = (float*)(p.ws + WS_AFF);
    LAS unsigned char* Whi = F.lds; LAS unsigned char* Wlo = F.lds + 32768;
    LAS float* gsf = (LAS float*)(F.lds + 65536); LAS float* shf = gsf + DM; LAS float* part = shf + DM;
    const int bi = (int)blockIdx.x, nctx = with_ctx ? 4 : 0, nbl = (F.G - nctx) >> 1;
    if (bi < 2 * nbl + nctx) {
        const int rt = bi < nbl ? 0 : (bi < 2 * nbl ? 1 : 2), gi = bi - rt * nbl;
        { const float* Wr = p.in[I_ROUTER] + (size_t)l * DM * NE; const float* m = mod + (size_t)l * 3 * 6144 + (size_t)rt * 6144; const float* g = p.in[I_NFFNG] + l * DM;
          const int q = F.tid & 3; f32x4 bsum = (f32x4){0.f, 0.f, 0.f, 0.f};
          f32x4 w4[8]; float gq[8], sq[8], hq[8];
#pragma unroll
          for (int k = 0; k < 8; ++k) { const int i = F.tid + 512 * k, c = i >> 2; w4[k] = ((const f32x4*)Wr)[i]; gq[k] = g[c]; sq[k] = m[4 * DM + c]; hq[k] = m[3 * DM + c]; }
#pragma unroll
          for (int k = 0; k < 8; ++k) { const int i = F.tid + 512 * k, c = i >> 2; const float gsv = gq[k] * (1.0f + sq[k]);
              if (q == 0) { gsf[c] = gsv; shf[c] = hq[k]; }
              bsum += w4[k] * hq[k];
              const int base = ((((c >> 6) * 2 + ((c >> 3) & 1)) * 64 + ((c >> 4) & 3) * 16) + 4 * q) * 16 + (c & 7) * 2;
#pragma unroll
              for (int j = 0; j < 4; ++j) { const float val = gsv * w4[k][j]; const unsigned hb = f2bf(val); const unsigned lb = f2bf(val - __uint_as_float(hb << 16));
                  *(LAS unsigned short*)(Whi + base + j * 16) = (unsigned short)hb; *(LAS unsigned short*)(Wlo + base + j * 16) = (unsigned short)lb; } }
#pragma unroll
          for (int j = 0; j < 4; ++j) { float v = bsum[j];
#pragma unroll
              for (int o = 4; o < 64; o <<= 1) v += __shfl_xor(v, o);
              if (F.lane < 4) part[F.wave * 16 + 4 * F.lane + j] = v; } }
        __syncthreads();
        const int row = F.lane & 15, g4 = F.lane >> 4;
        const int ntile = rt < 2 ? SEQ / 16 : 2 * CTXL / 16, ngrp = rt < 2 ? nbl : nctx;
        for (int ti = F.wave * ngrp + gi; ti < ntile; ti += NWAVES * ngrp) {
            int b, j0; if (rt < 2) { b = rt; j0 = CTXL + 16 * ti; } else { b = ti >> 4; j0 = 16 * (ti & 15); }
            const size_t R0 = (size_t)b * LR + j0;
            const bf16_t* xp = X + (R0 + row) * DM + 16 * g4;
            u32x4 xa[16][2];
#pragma unroll
            for (int kp = 0; kp < 16; ++kp) { xa[kp][0] = *(const u32x4*)(xp + 64 * kp); xa[kp][1] = *(const u32x4*)(xp + 64 * kp + 8); }
            f32x4 acc = (f32x4){0.f, 0.f, 0.f, 0.f}; float ss = 0.f;
#pragma unroll
            for (int kp = 0; kp < 16; ++kp)
#pragma unroll
                for (int h = 0; h < 2; ++h) { const int ks = 2 * kp + h; const u32x4 xw = xa[kp][h];
                    const bf16x8 bh = *(const LAS bf16x8*)(Whi + (ks * 64 + F.lane) * 16), bl = *(const LAS bf16x8*)(Wlo + (ks * 64 + F.lane) * 16);
                    const bf16x8 a = __builtin_bit_cast(bf16x8, xw);
                    acc = __builtin_amdgcn_mfma_f32_16x16x32_bf16(a, bh, acc, 0, 0, 0); acc = __builtin_amdgcn_mfma_f32_16x16x32_bf16(a, bl, acc, 0, 0, 0);
                    ss += (bflo(xw.x) * bflo(xw.x) + bfhi(xw.x) * bfhi(xw.x)) + (bflo(xw.y) * bflo(xw.y) + bfhi(xw.y) * bfhi(xw.y)) + (bflo(xw.z) * bflo(xw.z) + bfhi(xw.z) * bfhi(xw.z)) + (bflo(xw.w) * bflo(xw.w) + bfhi(xw.w) * bfhi(xw.w));
                    if (h == 1 && (kp & 1)) { asm volatile("" ::: "memory"); __builtin_amdgcn_sched_barrier(0); } }
#pragma unroll
            for (int kp = 0; kp < 16; ++kp) asm volatile("" : "+v"(xa[kp][0]), "+v"(xa[kp][1]));
            ss += __shfl_xor(ss, 16); ss += __shfl_xor(ss, 32);
            const float rstd = 1.0f / sqrtf(ss * (1.0f / DM) + EPS);
            float be = 0.f;
#pragma unroll
            for (int w = 0; w < NWAVES; ++w) be += part[w * 16 + row];
            f32x4 pr;
#pragma unroll
            for (int r = 0; r < 4; ++r) { const float rs = __shfl(rstd, 4 * g4 + r); const float lg = acc[r] * rs + be; float mx = lg;
#pragma unroll
                for (int o = 1; o < 16; o <<= 1) mx = fmaxf(mx, __shfl_xor(mx, o));
                const float ex = __expf(lg - mx); float sm = ex;
#pragma unroll
                for (int o = 1; o < 16; o <<= 1) sm += __shfl_xor(sm, o);
                pr[r] = ex / sm; }
            *(f32x4*)(aff + ((size_t)b * NE + row) * LR + j0 + 4 * g4) = pr;
            unsigned char* hp = H8 + (R0 + row) * DM + 16 * g4;
#pragma unroll
            for (int kp = 0; kp < 16; ++kp) { const int c0 = 64 * kp + 16 * g4; u32x4 o; unsigned ow[4];
#pragma unroll
                for (int i = 0; i < 4; ++i) { const f32x4 gv = *(const LAS f32x4*)(gsf + c0 + 4 * i), hv = *(const LAS f32x4*)(shf + c0 + 4 * i);
                    const u32x4 xw = xa[kp][i >> 1]; const unsigned w0 = (i & 1) ? xw.z : xw.x, w1 = (i & 1) ? xw.w : xw.y;
                    ow[i] = f2fp8x4(bflo(w0) * rstd * gv[0] + hv[0], bfhi(w0) * rstd * gv[1] + hv[1], bflo(w1) * rstd * gv[2] + hv[2], bfhi(w1) * rstd * gv[3] + hv[3]); }
                o.x = ow[0]; o.y = ow[1]; o.z = ow[2]; o.w = ow[3];
                *(u32x4*)(hp + 64 * kp) = o;
                if (kp & 1) { asm volatile("" ::: "memory"); __builtin_amdgcn_sched_barrier(0); } }
        }
    }
    __syncthreads();
}

__device__ __forceinline__ void p_select(const Ctx& F, const Params& p, bool with_ctx) {
    const float* aff = (const float*)(p.ws + WS_AFF); int* inv = (int*)(p.ws + WS_INV); float* gate = (float*)(p.ws + WS_GATE);
    int* rowidx = (int*)(p.ws + WS_ROWIDX);
    LAS unsigned* hist = (LAS unsigned*)F.lds;
    LAS unsigned* misc = hist + 256;
    LAS unsigned* list = hist + 512;
    LAS unsigned* vals = hist + 512 + 2048;
    if (with_ctx && (int)blockIdx.x >= F.G - 32) {
        const int prob = (int)blockIdx.x - (F.G - 32), b = prob >> 4, e = prob & 15; const float* av = aff + ((size_t)b * NE + e) * LR;
        if (F.tid < CTXL) vals[F.tid] = __float_as_uint(av[F.tid]);
        __syncthreads();
        if (F.tid < CTXL) { const unsigned mine = vals[F.tid]; int rank = 0;
#pragma unroll 16
            for (int j = 0; j < CTXL; ++j) { const unsigned o = vals[j]; rank += (o > mine || (o == mine && j < F.tid)) ? 1 : 0; }
            const int R = b * LR + F.tid; int er = -1;
            if (rank < 32) { er = 2048 + b * 32 + rank; gate[e * EROWS + er] = __uint_as_float(mine); rowidx[e * EROWS + er] = R; }
            inv[(size_t)R * NE + e] = er; }
        __syncthreads();
    }
    const int nitems = 256;
    for (int item = blockIdx.x; item < nitems; item += F.G) {
        const bool isl = item < 256; const int prob = isl ? item >> 3 : item - 256, seg = isl ? item & 7 : 0, b = prob >> 4, e = prob & 15;
        const int n = isl ? SEQ : CTXL, kcap = isl ? 1024 : 32, j0 = isl ? CTXL : 0, nj = isl ? 16 : 1;
        const float* av = aff + ((size_t)b * NE + e) * LR + j0;
        { unsigned tmp[16];
#pragma unroll
          for (int jj = 0; jj < 16; ++jj) { const int tok = F.tid + 512 * jj; tmp[jj] = tok < n ? __float_as_uint(av[tok]) : 0u; }
#pragma unroll
          for (int jj = 0; jj < 16; ++jj) vals[F.tid + 512 * jj] = tmp[jj]; }
        unsigned prefix = 0u, mask = 0u, kk = (unsigned)kcap;
#pragma unroll 1
        for (int pass = 0; pass < 4; ++pass) { const int shift = 24 - 8 * pass;
            if (F.tid < 256) hist[F.tid] = 0u;
            __syncthreads();
#pragma unroll 1
            for (int jj = 0; jj < nj; ++jj) { const unsigned bt = vals[F.tid + 512 * jj]; if ((bt & mask) == prefix && bt != 0u) atomicAdd((unsigned*)(hist + ((bt >> shift) & 255u)), 1u); }
            __syncthreads();
            if (F.wave == 0) {
                unsigned loc[4], tot = 0u;
#pragma unroll
                for (int q = 0; q < 4; ++q) { loc[q] = hist[255 - 4 * F.lane - q]; tot += loc[q]; }
                unsigned inc = tot;
#pragma unroll
                for (int o = 1; o < 64; o <<= 1) { const unsigned t2 = __shfl_up(inc, o); if (F.lane >= o) inc += t2; }
                unsigned run = inc - tot;
#pragma unroll
                for (int q = 0; q < 4; ++q) { if (run < kk && run + loc[q] >= kk) { misc[0] = (unsigned)(255 - 4 * F.lane - q); misc[1] = kk - run; } run += loc[q]; }
            }
            __syncthreads();
            prefix |= misc[0] << shift; mask |= 0xffu << shift; kk = misc[1];
            __syncthreads();
        }
        const unsigned T = prefix, need_eq = kk, cnt_gt = (unsigned)kcap - need_eq;
        unsigned cnt = 0u;
#pragma unroll 1
        for (int jj = 0; jj < nj; ++jj) { const unsigned bt = vals[F.tid + 512 * jj]; cnt += (bt > T ? 1u : 0u) + (bt == T ? 0x10000u : 0u); }
        unsigned inc = cnt;
#pragma unroll
        for (int o = 1; o < 64; o <<= 1) { const unsigned t2 = __shfl_up(inc, o); if (F.lane >= o) inc += t2; }
        if (F.lane == 63) misc[8 + F.wave] = inc;
        __syncthreads();
        unsigned base = inc - cnt;
        for (int w = 0; w < F.wave; ++w) base += misc[8 + w];
        unsigned rg = base & 0xffffu, re = base >> 16;
#pragma unroll 1
        for (int jj = 0; jj < nj; ++jj) { const int tok = F.tid + 512 * jj; const unsigned bt = vals[tok]; const bool own = isl ? ((jj >> 1) == seg) : true;
            const bool isgt = bt > T, iseq = bt == T; int slot = -1;
            if (isgt) { slot = (int)rg; } else if (iseq && re < need_eq) { slot = (int)(cnt_gt + re); }
            rg += isgt ? 1u : 0u; re += iseq ? 1u : 0u;
            if (own && tok < n) { const int R = b * LR + j0 + tok; int er = -1;
                if (slot >= 0) { er = isl ? b * 1024 + slot : 2048 + b * 32 + slot; gate[e * EROWS + er] = __uint_as_float(bt); rowidx[e * EROWS + er] = R; }
                inv[(size_t)R * NE + e] = er; } }
        __syncthreads();
    }
}

__device__ __forceinline__ void p_combine(const Ctx& F, const Params& p, int l, bool final_) {
    const float* mod = (const float*)(p.ws + WS_MOD); bf16_t* H = (bf16_t*)(p.ws + WS_H); bf16_t* X = (bf16_t*)(p.ws + WS_X); const int* inv = (const int*)(p.ws + WS_INV);
    const unsigned char* YB = p.ws + WS_XS;
    LAS float* ms = (LAS float*)F.lds;
    LAS float* g2s = ms + 6 * DM;
    if (final_) { for (int i = F.tid; i < DM; i += 512) ms[i] = p.in[I_FINALG][i]; }
    else stage_mod(F, ms, mod + (size_t)(l + 1) * 3 * 6144, p.in[I_NMIXG] + (l + 1) * DM, 1, 0);
    { float gq[6];
#pragma unroll
      for (int q = 0; q < 6; ++q) { const int i = F.tid + 512 * q; gq[q] = mod[(size_t)(l * 3 + (i >> 10)) * 6144 + 5 * DM + (i & 1023)]; }
#pragma unroll
      for (int q = 0; q < 6; ++q) g2s[F.tid + 512 * q] = gq[q]; }
    __syncthreads();
    const int gw = F.vcu * NWAVES + F.wave, NGW = F.G * NWAVES;
    constexpr int NB2 = 2, NS = 4;
    const int nrows = final_ ? NLAT : NR;
    for (int r0 = gw; r0 < nrows; r0 += NB2 * NGW) {
        f32x4 v[NB2][4]; int myinv[NB2]; unsigned long long msk[NB2]; int Rs[NB2], bs[NB2], js[NB2], rts[NB2]; bool ok[NB2];
#pragma unroll
        for (int k = 0; k < NB2; ++k) { int r = r0 + k * NGW; ok[k] = r < nrows; if (!ok[k]) r = r0; Rs[k] = final_ ? (r / SEQ) * LR + CTXL + (r % SEQ) : r; row_info(Rs[k], bs[k], js[k], rts[k]);
            myinv[k] = F.lane < NE ? inv[(size_t)Rs[k] * NE + F.lane] : -1; ld_row_bf(X + (size_t)Rs[k] * DM, F.lane, v[k]); }
        unsigned w[NB2][NS][4]; float wt[NB2][NS];
#pragma unroll
        for (int k = 0; k < NB2; ++k) { msk[k] = __ballot(myinv[k] >= 0);
#pragma unroll
            for (int sidx = 0; sidx < NS; ++sidx) { const unsigned char* yr = YB; wt[k][sidx] = 0.f;
                if (msk[k]) { const int e = __builtin_ctzll(msk[k]); msk[k] &= msk[k] - 1; const int er = __builtin_amdgcn_readlane(myinv[k], e); yr = YB + ((size_t)e * EROWS + er) * DM; wt[k][sidx] = 1.f; }
#pragma unroll
                for (int jj = 0; jj < 4; ++jj) w[k][sidx][jj] = *(const unsigned*)(yr + 4 * F.lane + 256 * jj); } }
#pragma unroll
        for (int k = 0; k < NB2; ++k) {
            f32x4 mo[4];
#pragma unroll
            for (int jj = 0; jj < 4; ++jj) mo[jj] = (f32x4){0.f, 0.f, 0.f, 0.f};
#pragma unroll
            for (int sidx = 0; sidx < NS; ++sidx)
#pragma unroll
                for (int jj = 0; jj < 4; ++jj) { const int ww = (int)w[k][sidx][jj]; const float t = wt[k][sidx] * YB_INV;
                    mo[jj][0] += t * __builtin_amdgcn_cvt_f32_fp8(ww, 0); mo[jj][1] += t * __builtin_amdgcn_cvt_f32_fp8(ww, 1); mo[jj][2] += t * __builtin_amdgcn_cvt_f32_fp8(ww, 2); mo[jj][3] += t * __builtin_amdgcn_cvt_f32_fp8(ww, 3); }
            while (msk[k]) { const int e = __builtin_ctzll(msk[k]); msk[k] &= msk[k] - 1; const int er = __builtin_amdgcn_readlane(myinv[k], e); const unsigned char* yr = YB + ((size_t)e * EROWS + er) * DM;
#pragma unroll
                for (int jj = 0; jj < 4; ++jj) { const int ww = *(const int*)(yr + 4 * F.lane + 256 * jj);
                    mo[jj][0] += YB_INV * __builtin_amdgcn_cvt_f32_fp8(ww, 0); mo[jj][1] += YB_INV * __builtin_amdgcn_cvt_f32_fp8(ww, 1); mo[jj][2] += YB_INV * __builtin_amdgcn_cvt_f32_fp8(ww, 2); mo[jj][3] += YB_INV * __builtin_amdgcn_cvt_f32_fp8(ww, 3); } }
#pragma unroll
            for (int jj = 0; jj < 4; ++jj) v[k][jj] = v[k][jj] + *(const LAS f32x4*)(g2s + rts[k] * DM + 4 * F.lane + 256 * jj) * mo[jj];
            const float rstd = row_rstd(v[k]);
            if (!ok[k]) continue;
            if (final_) { float* o = p.out + ((size_t)bs[k] * SEQ + (js[k] - CTXL)) * DM;
#pragma unroll
                for (int jj = 0; jj < 4; ++jj) { const int c = 4 * F.lane + 256 * jj; __builtin_nontemporal_store(v[k][jj] * rstd * *(const LAS f32x4*)(ms + c), (f32x4*)(o + c)); } }
            else {
#pragma unroll
                for (int jj = 0; jj < 4; ++jj) *(u32x2*)(X + (size_t)Rs[k] * DM + 4 * F.lane + 256 * jj) = pk4(v[k][jj]);
                apply_mod(v[k], rstd, ms, rts[k], F.lane); st_row_bf16(H + (size_t)Rs[k] * DM, F.lane, v[k]); }
        }
    }
    __syncthreads();
}

__device__ __forceinline__ void p_lru(const Ctx& F, const Params& p, bool full) {
    const bf16_t* Z = (const bf16_t*)(p.ws + WS_ACT + ACT_Z); bf16_t* YC = (bf16_t*)(p.ws + WS_ACT + ACT_YCAT); const bf16_t* LW = (const bf16_t*)(p.ws + WS_LRUW);
    f32x2* SUM = (f32x2*)(p.ws + WS_SUM);
    LAS float* recS = (LAS float*)F.lds;
    LAS float* xcF = recS + 67 * 64;
    LAS float* aS = xcF + 64 * 64;
    LAS float* uS = aS + 2 * 64 * 64;
    LAS float* cst = uS + 2 * 64 * 64;
    LAS bf16_t* xcB = (LAS bf16_t*)(cst + 1024 + 128);
    const int wave = F.wave, lane = F.lane, tid = F.tid;
    const int nitems = NTILE64 * 8;
    const int sr = tid >> 3, sc8 = tid & 7; const int hrr = (tid >> 3) == 0 ? -2 : ((tid >> 3) == 1 ? -1 : 64);
    const int gd = wave >> 2, gmf = wave & 3, gfr = lane & 15, gfq = lane >> 4;
    bf16x8 bw[2][4][2]; float cba[4], cbx[4], ccA[4];
    LAS float* cwS = (LAS float*)(xcB + 64 * 72);
    {   const int h = (int)blockIdx.x & 7;
#pragma unroll
        for (int g2 = 0; g2 < 2; ++g2)
#pragma unroll
            for (int nf = 0; nf < 4; ++nf)
#pragma unroll
                for (int ks = 0; ks < 2; ++ks) bw[g2][nf][ks] = *(const bf16x8*)(LW + ((size_t)(((gd * 2 + g2) * 8 + h) * 64 + 16 * nf + gfr)) * 64 + 32 * ks + 8 * gfq);
#pragma unroll
        for (int nf = 0; nf < 4; ++nf) { const int gch = gd * 512 + h * 64 + 16 * nf + gfr; cba[nf] = p.in[I_LRUBA][gch]; cbx[nf] = p.in[I_LRUBX][gch];
            ccA[nf] = -8.0f * 1.4426950408889634f * log1pf(__expf(-p.in[I_LRULAM][gch])); }
        if (tid < 256) cwS[tid] = p.in[I_CONVW][(tid >> 6) * 512 + h * 64 + (tid & 63)]; else if (tid < 320) cwS[tid] = p.in[I_CONVB][h * 64 + (tid - 256)];
        __syncthreads(); }
    u32x4 wrec = (u32x4){0u, 0u, 0u, 0u}, whalo = (u32x4){0u, 0u, 0u, 0u};
    auto tile_geom = [&](int item, int& T, int& h, int& b, int& jt, int& R0) { T = item >> 3; h = item & 7; b = T / 132; jt = T % 132; R0 = b * LR + jt * 64; };
    auto issue_rec = [&](int item) { int T, h, b, jt, R0; tile_geom(item, T, h, b, jt, R0); const bool isctx = jt < 4; const int slo = isctx ? 0 : CTXL, shi = isctx ? CTXL : LR;
        wrec = *(const u32x4*)(Z + (size_t)(R0 + sr) * 2048 + 512 + h * 64 + sc8 * 8);
        whalo = (u32x4){0u, 0u, 0u, 0u};
        if (tid < 24) { const int jj = jt * 64 + hrr; if (jj >= slo && jj < shi) whalo = *(const u32x4*)(Z + (size_t)(R0 + hrr) * 2048 + 512 + h * 64 + sc8 * 8); } };
    if ((int)blockIdx.x < nitems) issue_rec(blockIdx.x);
    for (int item = blockIdx.x; item < nitems; item += F.G) {
        int T, h, b, jt, R0; tile_geom(item, T, h, b, jt, R0); const bool isctx = jt < 4;
        u32x4 wgate = (u32x4){0u, 0u, 0u, 0u};
        if (full) wgate = *(const u32x4*)(Z + (size_t)(R0 + sr) * 2048 + h * 64 + sc8 * 8);
        { LAS float* d = recS + (sr + 2) * 64 + sc8 * 8; const u32x4 w = wrec;
          d[0] = bflo(w.x); d[1] = bfhi(w.x); d[2] = bflo(w.y); d[3] = bfhi(w.y); d[4] = bflo(w.z); d[5] = bfhi(w.z); d[6] = bflo(w.w); d[7] = bfhi(w.w);
          if (tid < 24) { LAS float* d2 = recS + (hrr + 2) * 64 + sc8 * 8; const u32x4 w2 = whalo;
              d2[0] = bflo(w2.x); d2[1] = bfhi(w2.x); d2[2] = bflo(w2.y); d2[3] = bfhi(w2.y); d2[4] = bflo(w2.z); d2[5] = bfhi(w2.z); d2[6] = bflo(w2.w); d2[7] = bfhi(w2.w); } }
        if (item + F.G < nitems) issue_rec(item + F.G);
        __syncthreads();
        { const int r = sr, c8 = sc8 * 8;
          float y[8];
#pragma unroll
          for (int i = 0; i < 8; ++i) y[i] = cwS[256 + c8 + i];
#pragma unroll
          for (int q = 0; q < 4; ++q) { const f32x4 x0 = *(const LAS f32x4*)(recS + (r + q) * 64 + c8), x1 = *(const LAS f32x4*)(recS + (r + q) * 64 + c8 + 4);
              const f32x4 w0 = *(const LAS f32x4*)(cwS + q * 64 + c8), w1 = *(const LAS f32x4*)(cwS + q * 64 + c8 + 4);
              y[0] += w0[0] * x0[0]; y[1] += w0[1] * x0[1]; y[2] += w0[2] * x0[2]; y[3] += w0[3] * x0[3]; y[4] += w1[0] * x1[0]; y[5] += w1[1] * x1[1]; y[6] += w1[2] * x1[2]; y[7] += w1[3] * x1[3]; }
          *(LAS f32x4*)(xcF + r * 64 + c8) = (f32x4){y[0], y[1], y[2], y[3]}; *(LAS f32x4*)(xcF + r * 64 + c8 + 4) = (f32x4){y[4], y[5], y[6], y[7]};
          u32x4 w; w.x = pk2(y[0], y[1]); w.y = pk2(y[2], y[3]); w.z = pk2(y[4], y[5]); w.w = pk2(y[6], y[7]);
          *(LAS u32x4*)(xcB + r * 72 + c8) = w; }
        __syncthreads();
        { const int d = gd, mf = gmf, fr = gfr, fq = gfq;
          bf16x8 af[2];
#pragma unroll
          for (int ks = 0; ks < 2; ++ks) af[ks] = *(const LAS bf16x8*)(xcB + (16 * mf + fr) * 72 + 32 * ks + 8 * fq);
          f32x4 acc[2][4];
#pragma unroll
          for (int g2 = 0; g2 < 2; ++g2)
#pragma unroll
              for (int nf = 0; nf < 4; ++nf) { acc[g2][nf] = (f32x4){0.f, 0.f, 0.f, 0.f};
#pragma unroll
                  for (int ks = 0; ks < 2; ++ks) acc[g2][nf] = __builtin_amdgcn_mfma_f32_16x16x32_bf16(af[ks], bw[g2][nf][ks], acc[g2][nf], 0, 0, 0); }
#pragma unroll
          for (int nf = 0; nf < 4; ++nf) { const int ch = 16 * nf + fr; const float ba = cba[nf], bx = cbx[nf], cA = ccA[nf];
#pragma unroll
              for (int r = 0; r < 4; ++r) { const int tk = 16 * mf + 4 * fq + r;
                  const float rg = __builtin_amdgcn_rcpf(1.0f + __builtin_amdgcn_exp2f(-1.4426950408889634f * (acc[0][nf][r] + ba)));
                  const float ig = __builtin_amdgcn_rcpf(1.0f + __builtin_amdgcn_exp2f(-1.4426950408889634f * (acc[1][nf][r] + bx)));
                  const float a = __builtin_amdgcn_exp2f(rg * cA), mult = __builtin_amdgcn_sqrtf(fmaf(-a, a, 1.0f));
                  aS[(d * 64 + tk) * 64 + ch] = a; uS[(d * 64 + tk) * 64 + ch] = mult * ig * xcF[tk * 64 + ch]; } } }
        __syncthreads();
        if (full && tid < 128) cst[1024 + tid] = ((const float*)(p.ws + WS_CAR))[((size_t)T * 2 + (tid >> 6)) * 512 + h * 64 + (tid & 63)];
        {
            const int dc = tid & 127, d = dc >> 6, ch = dc & 63, sg = tid >> 7;
            const LAS float* ap = aS + d * 4096 + ch; LAS float* up = uS + d * 4096 + ch;
            const int tfirst = d == 0 ? 16 * sg : 63 - 16 * sg, tstep_ = d == 0 ? 64 : -64;
            float av[16], uv[16];
#pragma unroll
            for (int i = 0; i < 16; ++i) { av[i] = ap[tfirst * 64 + i * tstep_]; uv[i] = up[tfirst * 64 + i * tstep_]; }
            float P = 1.f, hs = 0.f;
#pragma unroll
            for (int i = 0; i < 16; ++i) { hs = av[i] * hs + uv[i]; P *= av[i]; uv[i] = hs; }
            asm volatile("" ::: "memory");
            __syncthreads();
            cst[(sg * 128 + dc) * 2] = P; cst[(sg * 128 + dc) * 2 + 1] = hs;
            __syncthreads();
            float cin = full ? cst[1024 + dc] : 0.f;
            float Pt = 1.f;
#pragma unroll
            for (int q = 0; q < 4; ++q) { const float Pq = cst[(q * 128 + dc) * 2], Hq = cst[(q * 128 + dc) * 2 + 1];
                if (q < sg) cin = Pq * cin + Hq;
                Pt *= Pq; }
            if (!full) { if (sg == 3) SUM[((size_t)T * 2 + d) * 512 + h * 64 + ch] = (f32x2){Pt, cst[(3 * 128 + dc) * 2 + 1] + cst[(3 * 128 + dc) * 2] * cin}; }
            else { float pp = cin;
#pragma unroll
                for (int i = 0; i < 16; ++i) { pp *= ap[tfirst * 64 + i * tstep_]; up[tfirst * 64 + i * tstep_] = uv[i] + pp; } }
        }
        __syncthreads();
        if (full) { const int r = sr, c8 = sc8 * 8; const u32x4 gw_ = wgate;
            float gg[8] = {bflo(gw_.x), bfhi(gw_.x), bflo(gw_.y), bfhi(gw_.y), bflo(gw_.z), bfhi(gw_.z), bflo(gw_.w), bfhi(gw_.w)}; float y[8];
            const f32x4 f0 = *(const LAS f32x4*)(uS + r * 64 + c8), f1 = *(const LAS f32x4*)(uS + r * 64 + c8 + 4), b0 = *(const LAS f32x4*)(uS + (64 + r) * 64 + c8), b1 = *(const LAS f32x4*)(uS + (64 + r) * 64 + c8 + 4);
            y[0] = gg[0] * (f0[0] + b0[0]); y[1] = gg[1] * (f0[1] + b0[1]); y[2] = gg[2] * (f0[2] + b0[2]); y[3] = gg[3] * (f0[3] + b0[3]);
            y[4] = gg[4] * (f1[0] + b1[0]); y[5] = gg[5] * (f1[1] + b1[1]); y[6] = gg[6] * (f1[2] + b1[2]); y[7] = gg[7] * (f1[3] + b1[3]);
            u32x4 w; w.x = pk2(y[0], y[1]); w.y = pk2(y[2], y[3]); w.z = pk2(y[4], y[5]); w.w = pk2(y[6], y[7]);
            *(u32x4*)(YC + (size_t)(R0 + r) * DM + h * 64 + c8) = w; }
        __syncthreads();
    }
}

__device__ __forceinline__ void p_lru_carry(const Ctx& F, const Params& p) {
    const f32x2* SUM = (const f32x2*)(p.ws + WS_SUM); float* CAR = (float*)(p.ws + WS_CAR);
    const int task = (int)blockIdx.x - (F.G - 4);
    if (task < 0) return;
    const int tk = task * NWAVES + F.wave, b = tk >> 4, d = (tk >> 3) & 1, h = tk & 7, ch = h * 64 + F.lane;
    float st = 0.f;
    for (int i0 = 0; i0 < 132; i0 += 33) {
        f32x2 sv[33];
#pragma unroll
        for (int k = 0; k < 33; ++k) { const int i = i0 + k; const int jp = d == 0 ? i : (i < 4 ? 3 - i : 135 - i); sv[k] = SUM[((size_t)(b * 132 + jp) * 2 + d) * 512 + ch]; }
#pragma unroll
        for (int k = 0; k < 33; ++k) { const int i = i0 + k; const int jp = d == 0 ? i : (i < 4 ? 3 - i : 135 - i);
            CAR[((size_t)(b * 132 + jp) * 2 + d) * 512 + ch] = st; st = sv[k].x * st + sv[k].y; }
    }
}

__device__ __forceinline__ void p_cm(const Ctx& F, const Params& p) {
    const int GB = F.G - 8;
    if ((int)blockIdx.x >= GB) return;
    const bf16_t* Z = (const bf16_t*)(p.ws + WS_ACT + ACT_Z); bf16_t* YC = (bf16_t*)(p.ws + WS_ACT + ACT_YCAT); const bf16_t* CW = (const bf16_t*)(p.ws + WS_CMWS);
    LAS bf16_t* vnT = (LAS bf16_t*)F.lds;
    LAS float* mix = (LAS float*)(F.lds + 32768);
    const int wave = F.wave, lane = F.lane, tid = F.tid, fr = lane & 15, fq = lane >> 4;
    const int nitems = (NR / 128) * 8; const int q = tid >> 2, part = tid & 3;
    bf16x8 afr[4]; float bsr[4]; float vgr[16];
    {   const int g = (int)blockIdx.x & 7;
#pragma unroll
        for (int ks = 0; ks < 4; ++ks) afr[ks] = *(const bf16x8*)(CW + ((size_t)g * 128 + 16 * wave + fr) * 128 + 32 * ks + 8 * fq);
#pragma unroll
        for (int r = 0; r < 4; ++r) bsr[r] = p.in[I_CMBS][g * 128 + 16 * wave + 4 * fq + r];
#pragma unroll
        for (int i = 0; i < 16; ++i) vgr[i] = p.in[I_CMVG][g * 64 + part * 16 + i]; }
    u32x4 wv0 = (u32x4){0u, 0u, 0u, 0u}, wv1 = wv0;
    auto issue_v = [&](int item) { const int cn = item >> 3, g = item & 7; const bf16_t* src = Z + (size_t)(cn * 128 + q) * 2048 + 1536 + g * 64 + part * 16; wv0 = *(const u32x4*)src; wv1 = *(const u32x4*)(src + 8); };
    if ((int)blockIdx.x < nitems) issue_v(blockIdx.x);
    for (int item = blockIdx.x; item < nitems; item += GB) {
        const int cn = item >> 3, g = item & 7; const int R0 = cn * 128;
        const bf16_t* usrc = Z + (size_t)(R0 + q) * 2048 + 1024 + g * 64 + part * 16; const u32x4 wu0 = *(const u32x4*)usrc, wu1 = *(const u32x4*)(usrc + 8);
        { const u32x4 w0 = wv0, w1 = wv1;
          float v[16] = {bflo(w0.x), bfhi(w0.x), bflo(w0.y), bfhi(w0.y), bflo(w0.z), bfhi(w0.z), bflo(w0.w), bfhi(w0.w), bflo(w1.x), bfhi(w1.x), bflo(w1.y), bfhi(w1.y), bflo(w1.z), bfhi(w1.z), bflo(w1.w), bfhi(w1.w)};
          float ss = 0.f;
#pragma unroll
          for (int i = 0; i < 16; ++i) ss += v[i] * v[i];
          ss += __shfl_xor(ss, 1); ss += __shfl_xor(ss, 2);
          const float rstd = 1.0f / sqrtf(ss * (1.0f / 64.0f) + EPS);
#pragma unroll
          for (int i = 0; i < 16; ++i) vnT[(part * 16 + i) * 136 + q] = (bf16_t)f2bf(v[i] * rstd * vgr[i]); }
        if (item + GB < nitems) issue_v(item + GB);
        __syncthreads();
        f32x4 acc[4];
#pragma unroll
        for (int nf = 0; nf < 4; ++nf) acc[nf] = (f32x4){0.f, 0.f, 0.f, 0.f};
#pragma unroll
        for (int ks = 0; ks < 4; ++ks)
#pragma unroll
            for (int nf = 0; nf < 4; ++nf) { const bf16x8 bfr = *(const LAS bf16x8*)(vnT + (16 * nf + fr) * 136 + 32 * ks + 8 * fq);
                acc[nf] = __builtin_amdgcn_mfma_f32_16x16x32_bf16(afr[ks], bfr, acc[nf], 0, 0, 0); }
#pragma unroll
        for (int r = 0; r < 4; ++r) { const int pp = 16 * wave + 4 * fq + r;
#pragma unroll
            for (int nf = 0; nf < 4; ++nf) mix[pp * 68 + 16 * nf + fr] = acc[nf][r] + bsr[r]; }
        __syncthreads();
        { float ug[16] = {bflo(wu0.x), bfhi(wu0.x), bflo(wu0.y), bfhi(wu0.y), bflo(wu0.z), bfhi(wu0.z), bflo(wu0.w), bfhi(wu0.w), bflo(wu1.x), bfhi(wu1.x), bflo(wu1.y), bfhi(wu1.y), bflo(wu1.z), bfhi(wu1.z), bflo(wu1.w), bfhi(wu1.w)};
          const LAS float* mr = mix + q * 68 + part * 16; float y[16];
#pragma unroll
          for (int i = 0; i < 16; i += 4) { const f32x4 mv = *(const LAS f32x4*)(mr + i); y[i] = ug[i] * mv[0]; y[i + 1] = ug[i + 1] * mv[1]; y[i + 2] = ug[i + 2] * mv[2]; y[i + 3] = ug[i + 3] * mv[3]; }
          u32x4 o0, o1; o0.x = pk2(y[0], y[1]); o0.y = pk2(y[2], y[3]); o0.z = pk2(y[4], y[5]); o0.w = pk2(y[6], y[7]); o1.x = pk2(y[8], y[9]); o1.y = pk2(y[10], y[11]); o1.z = pk2(y[12], y[13]); o1.w = pk2(y[14], y[15]);
          bf16_t* dst = YC + (size_t)(R0 + q) * DM + 512 + g * 64 + part * 16; *(u32x4*)dst = o0; *(u32x4*)(dst + 8) = o1; }
        __syncthreads();
    }
}

__device__ __forceinline__ void sg_tile(const bf16_t* A, size_t lda, const bf16_t* Bt, size_t ldb, int K, int lane, f32x4 (&acc)[4][2]) {
    const int fr = lane & 15, fq = lane >> 4;
#pragma unroll
    for (int m = 0; m < 4; ++m)
#pragma unroll
        for (int n = 0; n < 2; ++n) acc[m][n] = (f32x4){0.f, 0.f, 0.f, 0.f};
    const bf16_t* ap = A + (size_t)fr * lda + 8 * fq; const bf16_t* bp = Bt + (size_t)fr * ldb + 8 * fq;
#pragma unroll 4
    for (int k = 0; k < K; k += 32) {
        bf16x8 af[4], bfr[2];
#pragma unroll
        for (int m = 0; m < 4; ++m) af[m] = *(const bf16x8*)(ap + (size_t)(16 * m) * lda + k);
#pragma unroll
        for (int n = 0; n < 2; ++n) bfr[n] = *(const bf16x8*)(bp + (size_t)(16 * n) * ldb + k);
#pragma unroll
        for (int m = 0; m < 4; ++m)
#pragma unroll
            for (int n = 0; n < 2; ++n) acc[m][n] = __builtin_amdgcn_mfma_f32_16x16x32_bf16(bfr[n], af[m], acc[m][n], 0, 0, 0);
    }
}
__device__ __forceinline__ size_t ctx_row0(int rt8) { return (size_t)(rt8 >> 2) * LR + (size_t)(rt8 & 3) * 64; }
__device__ __forceinline__ void sg_block64(const Ctx& F, const bf16_t* A, size_t lda, const bf16_t* Bt, size_t ldb, int K, f32x4 (&out)[2]) {
    const int kw = K / NWAVES, fr = F.lane & 15, fq = F.lane >> 4;
    f32x4 acc[4][4];
#pragma unroll
    for (int m = 0; m < 4; ++m)
#pragma unroll
        for (int n = 0; n < 4; ++n) acc[m][n] = (f32x4){0.f, 0.f, 0.f, 0.f};
    const bf16_t* ap = A + (size_t)fr * lda + F.wave * kw + 8 * fq; const bf16_t* bp = Bt + (size_t)fr * ldb + F.wave * kw + 8 * fq;
#pragma unroll 4
    for (int k = 0; k < kw; k += 32) {
        bf16x8 af[4], bfr[4];
#pragma unroll
        for (int m = 0; m < 4; ++m) af[m] = *(const bf16x8*)(ap + (size_t)(16 * m) * lda + k);
#pragma unroll
        for (int n = 0; n < 4; ++n) bfr[n] = *(const bf16x8*)(bp + (size_t)(16 * n) * ldb + k);
#pragma unroll
        for (int m = 0; m < 4; ++m)
#pragma unroll
            for (int n = 0; n < 4; ++n) acc[m][n] = __builtin_amdgcn_mfma_f32_16x16x32_bf16(bfr[n], af[m], acc[m][n], 0, 0, 0);
    }
    LAS float* part = (LAS float*)F.lds;
#pragma unroll
    for (int m = 0; m < 4; ++m)
#pragma unroll
        for (int n = 0; n < 4; ++n) *(LAS f32x4*)(part + ((F.wave * 64 + 16 * m + fr) * 64 + 16 * n + 4 * fq)) = acc[m][n];
    __syncthreads();
    out[0] = (f32x4){0.f, 0.f, 0.f, 0.f}; out[1] = out[0];
#pragma unroll
    for (int w = 0; w < NWAVES; ++w) { out[0] += *(const LAS f32x4*)(part + w * 4096 + F.tid * 8); out[1] += *(const LAS f32x4*)(part + w * 4096 + F.tid * 8 + 4); }
    __syncthreads();
}
__device__ __forceinline__ void p_ctx_dense(const Ctx& F, const Params& p, int which) {
    unsigned char* ws = p.ws; const float* mod = (const float*)(ws + WS_MOD);
    const int ncg = which == 0 ? 32 : (which == 1 ? 16 : 32), nunits = 8 * ncg; const int row = F.tid >> 3, c8 = (F.tid & 7) * 8;
    for (int uidx = F.vcu; uidx < nunits; uidx += F.G) {
        const int rt8 = uidx / ncg, cgp = uidx % ncg; const size_t R0 = ctx_row0(rt8), R = R0 + row; const int c = cgp * 64 + c8; f32x4 v[2];
        if (which == 0) { sg_block64(F, (const bf16_t*)(ws + WS_H) + R0 * DM, DM, (const bf16_t*)(ws + WS_WIN) + (size_t)cgp * 64 * DM, DM, DM, v);
            if (cgp < 8 || cgp >= 16) {
#pragma unroll
                for (int i = 0; i < 4; ++i) { v[0][i] = gelu_tanh(v[0][i]); v[1][i] = gelu_tanh(v[1][i]); } }
            u32x4 w; const u32x2 a = pk4(v[0]), b = pk4(v[1]); w.x = a.x; w.y = a.y; w.z = b.x; w.w = b.y;
            *(u32x4*)((bf16_t*)(ws + WS_ACT + ACT_Z) + R * 2048 + c) = w; }
        else if (which == 1) { sg_block64(F, (const bf16_t*)(ws + WS_ACT + ACT_YCAT) + R0 * DM, DM, (const bf16_t*)(ws + WS_WOUT0) + (size_t)cgp * 64 * DM, DM, DM, v);
            const float* cin = p.in[I_CTX] + ((size_t)(rt8 >> 2) * CTXL + (size_t)(rt8 & 3) * 64 + row) * DM; const float* g1 = mod + 2 * 6144 + 2 * DM;
            const f32x4 o0 = *(const f32x4*)(cin + c) + *(const f32x4*)(g1 + c) * v[0], o1 = *(const f32x4*)(cin + c + 4) + *(const f32x4*)(g1 + c + 4) * v[1];
            u32x4 w; const u32x2 a = pk4(o0), b = pk4(o1); w.x = a.x; w.y = a.y; w.z = b.x; w.w = b.y;
            *(u32x4*)((bf16_t*)(ws + WS_X) + R * DM + c) = w; }
        else { sg_block64(F, (const bf16_t*)(ws + WS_H) + R0 * DM, DM, (const bf16_t*)(ws + WS_WQKV) + (size_t)(1024 + cgp * 64) * DM, DM, DM, v);
            bf16_t* dst = (bf16_t*)(ws + WS_ACT + (cgp < 16 ? ACT_K : ACT_V));
            u32x4 w; const u32x2 a = pk4(v[0]), b = pk4(v[1]); w.x = a.x; w.y = a.y; w.z = b.x; w.w = b.y;
            *(u32x4*)(dst + R * DM + (cgp & 15) * 64 + c8) = w; }
    }
}
__device__ __forceinline__ void p_ctx_moe(const Ctx& F, const Params& p, int which, int layer = 0) {
    unsigned char* ws = p.ws;
    typedef int v8i32 __attribute__((ext_vector_type(8))); typedef float f32x16 __attribute__((ext_vector_type(16)));
    const int l31 = F.lane & 31, hh = F.lane >> 5;
    if (which == 0) {
        LAS unsigned char* As = F.lds;
        for (int uidx = F.vcu; uidx < NE * 16; uidx += F.G) {
            const int e = uidx >> 4, cgp = (uidx & 15) * 8 + F.wave; const size_t er0 = (size_t)e * EROWS + 2048;
            { const int* ridx = (const int*)(ws + WS_ROWIDX) + er0; u32x4 t[8];
#pragma unroll
              for (int i = 0; i < 8; ++i) t[i] = ((const u32x4*)(ws + WS_H + (size_t)ridx[F.wave + 8 * i] * DM))[F.lane];
#pragma unroll
              for (int i = 0; i < 8; ++i) { const int g = F.tid + 512 * i, r = g >> 6, c = g & 63; *(LAS u32x4*)(As + r * 1024 + 16 * (c ^ (r & 15))) = t[i]; } }
            __syncthreads();
            const unsigned char* bp = ws + WS_W13 + ((size_t)layer * NE * 4096 + (size_t)e * 4096 + (size_t)cgp * 32 + l31) * DM + 32 * hh;
            f32x16 acc[2]; acc[0] = f32x16{}; acc[1] = f32x16{};
#pragma unroll 8
            for (int ks = 0; ks < 16; ++ks) {
                const u32x4 b0 = *(const u32x4*)(bp + 64 * ks), b1 = *(const u32x4*)(bp + 64 * ks + 16); const v8i32 bf = {(int)b0.x, (int)b0.y, (int)b0.z, (int)b0.w, (int)b1.x, (int)b1.y, (int)b1.z, (int)b1.w};
#pragma unroll
                for (int m = 0; m < 2; ++m) { const int r = 32 * m + l31, c0 = 4 * ks + 2 * hh;
                    const u32x4 a0 = *(const LAS u32x4*)(As + r * 1024 + 16 * (c0 ^ (r & 15))), a1 = *(const LAS u32x4*)(As + r * 1024 + 16 * ((c0 + 1) ^ (r & 15)));
                    const v8i32 af = {(int)a0.x, (int)a0.y, (int)a0.z, (int)a0.w, (int)a1.x, (int)a1.y, (int)a1.z, (int)a1.w};
                    acc[m] = __builtin_amdgcn_mfma_scale_f32_32x32x64_f8f6f4(bf, af, acc[m], 0, 0, 0, 0x7f7f7f7f, 0, 0x7f7f7f7f); } }
            unsigned char* HID = ws + WS_ACT + ACT_HID;
#pragma unroll
            for (int m = 0; m < 2; ++m)
#pragma unroll
                for (int q = 0; q < 2; ++q) {
                    float hv[4];
#pragma unroll
                    for (int i = 0; i < 4; ++i) hv[i] = silu_f(acc[m][4 * q + i] * W8_INV) * (acc[m][8 + 4 * q + i] * W8_INV);
                    *(unsigned*)(HID + (er0 + 32 * m + l31) * FF + cgp * 16 + 8 * q + 4 * hh) = f2fp8x4(hv[0], hv[1], hv[2], hv[3]); }
            __syncthreads();
        }
    } else {
        const int row = F.tid >> 3, c8 = (F.tid & 7) * 8; LAS float* part = (LAS float*)F.lds;
        for (int uidx = F.vcu; uidx < NE * 16; uidx += F.G) {
            const int e = uidx >> 4, cgp = uidx & 15; const size_t er0 = (size_t)e * EROWS + 2048;
            const unsigned char* ap = ws + WS_ACT + ACT_HID + (er0 + l31) * FF + F.wave * 256 + 32 * hh;
            const unsigned char* bp = ws + WS_W2 + ((size_t)layer * NE * DM + (size_t)e * DM + (size_t)cgp * 64 + l31) * FF + F.wave * 256 + 32 * hh;
            f32x16 acc[2][2]; acc[0][0] = f32x16{}; acc[0][1] = f32x16{}; acc[1][0] = f32x16{}; acc[1][1] = f32x16{};
#pragma unroll
            for (int k = 0; k < 256; k += 64) {
                v8i32 af[2], bf[2];
#pragma unroll
                for (int m = 0; m < 2; ++m) { const u32x4 a0 = *(const u32x4*)(ap + (size_t)m * 32 * FF + k), a1 = *(const u32x4*)(ap + (size_t)m * 32 * FF + k + 16);
                    af[m] = (v8i32){(int)a0.x, (int)a0.y, (int)a0.z, (int)a0.w, (int)a1.x, (int)a1.y, (int)a1.z, (int)a1.w}; }
#pragma unroll
                for (int n = 0; n < 2; ++n) { const u32x4 b0 = *(const u32x4*)(bp + (size_t)n * 32 * FF + k), b1 = *(const u32x4*)(bp + (size_t)n * 32 * FF + k + 16);
                    bf[n] = (v8i32){(int)b0.x, (int)b0.y, (int)b0.z, (int)b0.w, (int)b1.x, (int)b1.y, (int)b1.z, (int)b1.w}; }
#pragma unroll
                for (int m = 0; m < 2; ++m)
#pragma unroll
                    for (int n = 0; n < 2; ++n) acc[m][n] = __builtin_amdgcn_mfma_scale_f32_32x32x64_f8f6f4(bf[n], af[m], acc[m][n], 0, 0, 0, 0x7f7f7f7f, 0, 0x7f7f7f7f); }
#pragma unroll
            for (int m = 0; m < 2; ++m)
#pragma unroll
                for (int n = 0; n < 2; ++n)
#pragma unroll
                    for (int q = 0; q < 4; ++q) *(LAS f32x4*)(part + ((F.wave * 64 + 32 * m + l31) * 64 + 32 * n + 8 * q + 4 * hh)) = (f32x4){acc[m][n][4 * q], acc[m][n][4 * q + 1], acc[m][n][4 * q + 2], acc[m][n][4 * q + 3]};
            __syncthreads();
            f32x4 v0 = (f32x4){0.f, 0.f, 0.f, 0.f}, v1 = v0;
#pragma unroll
            for (int w = 0; w < NWAVES; ++w) { v0 += *(const LAS f32x4*)(part + w * 4096 + F.tid * 8); v1 += *(const LAS f32x4*)(part + w * 4096 + F.tid * 8 + 4); }
            __syncthreads();
            const float gt = ((const float*)(ws + WS_GATE))[er0 + row] * (W8_INV * YB_SCALE);
            u32x2 w; w.x = f2fp8x4(v0[0] * gt, v0[1] * gt, v0[2] * gt, v0[3] * gt); w.y = f2fp8x4(v1[0] * gt, v1[1] * gt, v1[2] * gt, v1[3] * gt);
            *(u32x2*)(ws + WS_XS + (er0 + row) * DM + cgp * 64 + c8) = w;
        }
    }
}

__device__ __forceinline__ void p_attn(const Ctx& F, const Params& p, unsigned char* lds_generic) {
    using abf = attn_body::bf16;
    const abf* Q = (const abf*)(p.ws + WS_ACT + ACT_Q); const abf* Kb = (const abf*)(p.ws + WS_ACT + ACT_K); const abf* Vb = (const abf*)(p.ws + WS_ACT + ACT_V);
    const bf16_t* O1 = (const bf16_t*)(p.ws + WS_ACT + ACT_O1); const bf16_t* O2 = (const bf16_t*)(p.ws + WS_ACT + ACT_O2); bf16_t* A = (bf16_t*)(p.ws + WS_XS);
    const int wid = F.wave;
    for (int i = 0; i < 4; ++i) { const int bh = (i >> 1) * 8 + (F.vcu >> 5), qb = F.vcu & 31, sub = (i & 1) * 2 + 1;
        const int b = bh >> 3, h = bh & 7, m = i & 1;
        abf* O = (abf*)(p.ws + WS_ACT + (m ? ACT_O2 : ACT_O1));
        const abf* Qw = Q + ((size_t)b * LR + CTXL + qb * 256 + wid * 32) * DM + (h * 2 + m) * 64;
        const abf* Kh = Kb + (size_t)b * LR * DM + (h * 2 + m) * 64;
        const abf* Vh = Vb + (size_t)b * LR * DM + h * 128;
        abf* Ow = O + ((size_t)b * SEQ + qb * 256 + wid * 32) * DM + h * 128;
        attn_body::attn_unit128<8>(Qw, Kh, Vh, Ow, (char*)lds_generic);
        if (sub == 3) {
            asm volatile("s_waitcnt vmcnt(0)" ::: "memory");
            int lane2 = threadIdx.x & 63; asm volatile("" : "+v"(lane2));
            const float lam_init = 0.8f - 0.6f * expf(-0.3f);
            float s1 = p.in[I_LQ1][lane2] * p.in[I_LK1][lane2], s2 = p.in[I_LQ2][lane2] * p.in[I_LK2][lane2];
            s1 = wave_sum(s1); s2 = wave_sum(s2);
            const float lam = expf(s1) - expf(s2) + lam_init, osc = 1.0f - lam_init;
            const size_t row0 = (size_t)b * SEQ + qb * 256 + wid * 32; const int lr = lane2 >> 3, c16 = 16 * (lane2 & 7);
            f32x4 gsub[4];
#pragma unroll
            for (int q = 0; q < 4; ++q) gsub[q] = *(const f32x4*)(p.in[I_SUBLN] + c16 + 4 * q);
            u32x4 xx[4][4];
#pragma unroll
            for (int k = 0; k < 4; ++k) { const size_t r = row0 + 8 * k + lr; const u32x4* a1 = (const u32x4*)(O1 + r * DM + h * 128 + c16); const u32x4* a2 = (const u32x4*)(O2 + r * DM + h * 128 + c16);
                xx[k][0] = a1[0]; xx[k][1] = a1[1]; xx[k][2] = a2[0]; xx[k][3] = a2[1]; }
#pragma unroll
            for (int k = 0; k < 4; ++k) { const size_t r = row0 + 8 * k + lr;
                const u32x4 x0 = xx[k][0], x1 = xx[k][1], y0 = xx[k][2], y1 = xx[k][3];
                float o[16];
                o[0] = bflo(x0.x) - lam * bflo(y0.x); o[1] = bfhi(x0.x) - lam * bfhi(y0.x); o[2] = bflo(x0.y) - lam * bflo(y0.y); o[3] = bfhi(x0.y) - lam * bfhi(y0.y);
                o[4] = bflo(x0.z) - lam * bflo(y0.z); o[5] = bfhi(x0.z) - lam * bfhi(y0.z); o[6] = bflo(x0.w) - lam * bflo(y0.w); o[7] = bfhi(x0.w) - lam * bfhi(y0.w);
                o[8] = bflo(x1.x) - lam * bflo(y1.x); o[9] = bfhi(x1.x) - lam * bfhi(y1.x); o[10] = bflo(x1.y) - lam * bflo(y1.y); o[11] = bfhi(x1.y) - lam * bfhi(y1.y);
                o[12] = bflo(x1.z) - lam * bflo(y1.z); o[13] = bfhi(x1.z) - lam * bfhi(y1.z); o[14] = bflo(x1.w) - lam * bflo(y1.w); o[15] = bfhi(x1.w) - lam * bfhi(y1.w);
                float ss = 0.f;
#pragma unroll
                for (int q = 0; q < 16; ++q) ss += o[q] * o[q];
                ss += __shfl_xor(ss, 1); ss += __shfl_xor(ss, 2); ss += __shfl_xor(ss, 4);
                const float rstd = osc / sqrtf(ss * (1.0f / 128.0f) + EPS);
                u32x4 w0, w1;
                w0.x = pk2(o[0] * rstd * gsub[0][0], o[1] * rstd * gsub[0][1]); w0.y = pk2(o[2] * rstd * gsub[0][2], o[3] * rstd * gsub[0][3]);
                w0.z = pk2(o[4] * rstd * gsub[1][0], o[5] * rstd * gsub[1][1]); w0.w = pk2(o[6] * rstd * gsub[1][2], o[7] * rstd * gsub[1][3]);
                w1.x = pk2(o[8] * rstd * gsub[2][0], o[9] * rstd * gsub[2][1]); w1.y = pk2(o[10] * rstd * gsub[2][2], o[11] * rstd * gsub[2][3]);
                w1.z = pk2(o[12] * rstd * gsub[3][0], o[13] * rstd * gsub[3][1]); w1.w = pk2(o[14] * rstd * gsub[3][2], o[15] * rstd * gsub[3][3]);
                u32x4* d = (u32x4*)(A + r * DM + h * 128 + c16); d[0] = w0; d[1] = w1; }
        }
    }
}

#define XB_TMO      128
#define XB_XCNT(j)  (256  + 64 * (j))
#define XB_XSUB(j)  (1280 + 64 * (j))
#define XB_XGEN(j)  (2304 + 64 * (j))
#define XB_TOP      3328
#define XB_TOPGEN   3392
#define XCD_BAR_WORDS 3456
#define XB_SPIN_CAP (1u << 18)
__device__ __forceinline__ unsigned xb_ld(unsigned* p)              { return __hip_atomic_load(p, __ATOMIC_RELAXED, __HIP_MEMORY_SCOPE_AGENT); }
__device__ __forceinline__ unsigned xb_add(unsigned* p, unsigned v) { return __hip_atomic_fetch_add(p, v, __ATOMIC_RELAXED, __HIP_MEMORY_SCOPE_AGENT); }
__device__ __forceinline__ unsigned xb_xcc_id() { return (unsigned)__builtin_amdgcn_s_getreg((3 << 11) | 20) & 0xFu; }
#define XB_SPIN(cond, bar) do { unsigned _sp = 0; while (cond) { __builtin_amdgcn_s_sleep(1); \
    if ((++_sp & 255u) == 0u) { if (xb_ld(&(bar)[XB_TMO])) break; if (_sp > XB_SPIN_CAP) { atomicAdd(&(bar)[XB_TMO], 1u); break; } } } } while (0)
struct XcdBarrier { unsigned* bar; unsigned x; volatile LAS unsigned* st; };
__device__ __forceinline__ void xcd_barrier_complete(unsigned* bar, unsigned x, unsigned& nloc, unsigned& nx) {
    const unsigned G = gridDim.x * gridDim.y * gridDim.z;
    unsigned sum, cnt, mine, sp = 0u;
    for (;;) {
        sum = 0u; cnt = 0u; mine = 0u;
#pragma unroll
        for (unsigned j = 0; j < 16; ++j) { const unsigned c = xb_ld(&bar[XB_XCNT(j)]); sum += c; cnt += (c > 0u) ? 1u : 0u; mine = (j == x) ? c : mine; }
        if (sum == G) break;
        __builtin_amdgcn_s_sleep(1);
        if ((++sp & 255u) == 0u) { if (xb_ld(&bar[XB_TMO])) break; if (sp > XB_SPIN_CAP) { atomicAdd(&bar[XB_TMO], 1u); break; } }
    }
    nloc = mine > 0u ? mine : 1u; nx = cnt > 0u ? cnt : 1u;
}
__device__ __forceinline__ void xcd_barrier(const XcdBarrier& b) {
    asm volatile("s_waitcnt vmcnt(0)" ::: "memory");
    __syncthreads();
    if (threadIdx.x == 0) {
        unsigned* bar = b.bar;
        __builtin_amdgcn_s_waitcnt(0);
        unsigned nloc = b.st[0], nx = b.st[1];
        if (nloc == 0u) { xcd_barrier_complete(bar, b.x, nloc, nx); b.st[0] = nloc; b.st[1] = nx; }
        const unsigned old = xb_add(&bar[XB_XSUB(b.x)], 1u);
        const unsigned gen = old / nloc;
        if (old + 1u == (gen + 1u) * nloc) {
            __builtin_amdgcn_fence(__ATOMIC_RELEASE, "agent");
            asm volatile("s_waitcnt vmcnt(0)" ::: "memory");
            const unsigned og = xb_add(&bar[XB_TOP], 1u);
            const unsigned tg = og / nx;
            if (og + 1u == (tg + 1u) * nx) xb_add(&bar[XB_TOPGEN], 1u);
            else XB_SPIN(xb_ld(&bar[XB_TOPGEN]) == tg, bar);
            __builtin_amdgcn_fence(__ATOMIC_ACQUIRE, "agent");
            xb_add(&bar[XB_XGEN(b.x)], 1u);
            asm volatile("s_waitcnt vmcnt(0)" ::: "memory");
        } else {
            XB_SPIN(xb_ld(&bar[XB_XGEN(b.x)]) == gen, bar);
            __builtin_amdgcn_fence(__ATOMIC_ACQUIRE, "agent");
            asm volatile("s_waitcnt vmcnt(0)" ::: "memory");
        }
    }
    __syncthreads();
}


#ifdef FP8_PROBE
typedef int v8i_t __attribute__((ext_vector_type(8)));
typedef float f32x16_t __attribute__((ext_vector_type(16)));
__device__ __forceinline__ int pr_aval(int i, int k) { return ((i * 7 + k * 3) % 5) - 2; }
__device__ __forceinline__ int pr_bval(int k, int j) { return ((k * 5 + j * 11) % 7) - 3; }
__device__ __forceinline__ unsigned pr_enc(int v) { const int a = v < 0 ? -v : v; const unsigned m = a == 0 ? 0x00u : (a == 1 ? 0x38u : (a == 2 ? 0x40u : 0x44u)); return m | (v < 0 ? 0x80u : 0u); }
template <int HYP> __device__ __forceinline__ int pr_kmap(int h, int j) { return HYP == 1 ? 32 * h + j : (HYP == 2 ? 16 * h + (j & 15) + 32 * (j >> 4) : 8 * h + (j & 7) + 16 * (j >> 3)); }
template <int HYP> __device__ __forceinline__ bool pr_test(int lane) {
    const int rc = lane & 31, h = lane >> 5; v8i_t a, b;
#pragma unroll
    for (int d = 0; d < 8; ++d) { unsigned wa = 0u, wb = 0u;
#pragma unroll
        for (int q = 0; q < 4; ++q) { const int k = pr_kmap<HYP>(h, 4 * d + q); wa |= pr_enc(pr_aval(rc, k)) << (8 * q); wb |= pr_enc(pr_bval(k, rc)) << (8 * q); }
        a[d] = (int)wa; b[d] = (int)wb; }
    f32x16_t c = {};
    c = __builtin_amdgcn_mfma_scale_f32_32x32x64_f8f6f4(a, b, c, 0, 0, 0, 0x7f7f7f7f, 0, 0x7f7f7f7f);
    bool ok = true;
#pragma unroll
    for (int r = 0; r < 16; ++r) { const int i = (r & 3) + 8 * (r >> 2) + 4 * h; int e = 0;
        for (int k = 0; k < 64; ++k) e += pr_aval(i, k) * pr_bval(k, rc);
        ok = ok && (c[r] == (float)e); }
    return __all(ok) != 0;
}
#endif
__global__ void __launch_bounds__(NWAVES * 64, 2) mk_fwd(Params p_unused) {
    extern __shared__ __attribute__((aligned(16))) unsigned char lds[];
#define MAKE_CTX Ctx F; { int t_ = threadIdx.x; asm volatile("" : "+v"(t_)); F.lds = (LAS unsigned char*)lds; F.tid = t_; F.lane = t_ & 63; F.wave = __builtin_amdgcn_readfirstlane(t_ >> 6); \
    F.G = gridDim.x; const int bx = blockIdx.x; F.vcu = (F.G % 8 == 0) ? (bx % 8) * (F.G / 8) + bx / 8 : bx; }
    int lo, hi; unsigned* barw; { const Params q0 = kparams(); lo = q0.ph_lo; hi = q0.ph_hi; barw = (unsigned*)(q0.ws + WS_CTL) + 4096; }
    volatile LAS unsigned* bst = (volatile LAS unsigned*)((LAS unsigned char*)lds + RING_BYTES + 12288 + 1024);
    if (threadIdx.x < 2) bst[threadIdx.x] = 0u;
    __syncthreads();
    if (threadIdx.x == 0) (void)xb_add(&barw[XB_XCNT(xb_xcc_id())], 1u);
#ifndef PH_MASK
#define PH_MASK 0xFFFFFu
#endif
#define IN(k) (((PH_MASK >> (k)) & 1u) && lo <= (k) && (k) < hi)
#define SEAM(k) do { if (IN(k) && IN((k) + 1)) { XcdBarrier xb_; xb_.bar = barw; xb_.x = xb_xcc_id(); xb_.st = bst; xcd_barrier(xb_); } } while (0)
#ifndef TS_MASK
#define TS_MASK 0u
#endif
#ifndef TS_SCALE
#define TS_SCALE 10.0f
#endif
    unsigned long long ts_prev = 0ull, ts_acc = 0ull;
    if (TS_MASK) ts_prev = __builtin_amdgcn_s_memrealtime();
#define TS_MARK(k) do { if (TS_MASK) { const unsigned long long t_ = __builtin_amdgcn_s_memrealtime(); if ((TS_MASK >> (k)) & 1u) ts_acc += t_ - ts_prev; ts_prev = t_; } } while (0)
#define PHASE_VARS MAKE_CTX const Params p = kparams(); unsigned char* ws = p.ws; const float* mod = (const float*)(ws + WS_MOD); bf16_t* Hb = (bf16_t*)(ws + WS_H); (void)mod; (void)Hb;

    if (IN(0)) { PHASE_VARS p0_prologue(F, p); } SEAM(0); TS_MARK(0);
    if (IN(1)) { PHASE_VARS p_norm1_in(F, p); } SEAM(1); TS_MARK(1);
    if (IN(2)) { PHASE_VARS
        pg8::Gemm g{Hb + (size_t)CTXL * DM, (const bf16_t*)(ws + WS_WIN), DM, (size_t)LR * DM * 2, 0}; pg8::GOrder S; S.init(32, 8, NB, F.G, (int)blockIdx.x);
        pg8::EpiWin E{(bf16_t*)(ws + WS_ACT + ACT_Z)}; pg8::gemm_phase(F.lds, g, S, E); p_ctx_dense(F, p, 0); } SEAM(2); TS_MARK(2);
    if (IN(3)) { PHASE_VARS p_lru(F, p, false); } SEAM(3); TS_MARK(3);
    if (IN(4)) { PHASE_VARS p_lru_carry(F, p); p_cm(F, p); }
    if (IN(4)) { XcdBarrier xb_; xb_.bar = barw; xb_.x = xb_xcc_id(); xb_.st = bst; xcd_barrier(xb_); }
    if (IN(4)) { PHASE_VARS p_lru(F, p, true); } SEAM(4); TS_MARK(4);
    if (IN(5)) { PHASE_VARS
        pg8::Gemm g{(const bf16_t*)(ws + WS_ACT + ACT_YCAT) + (size_t)CTXL * DM, (const bf16_t*)(ws + WS_WOUT0), DM, (size_t)LR * DM * 2, 0}; pg8::GOrder S; S.init(32, 4, NB, F.G, (int)blockIdx.x);
        pg8::EpiRes E{(bf16_t*)(ws + WS_X), p.in[I_X], mod + 2 * DM, 0}; pg8::gemm_phase(F.lds, g, S, E); p_ctx_dense(F, p, 1); } SEAM(5); TS_MARK(5);
    if (IN(6)) { PHASE_VARS p_norm2_router(F, p, 0, true); } SEAM(6); TS_MARK(6);
    if (IN(7)) { PHASE_VARS p_select(F, p, true); } SEAM(7); TS_MARK(7);
    if (IN(8)) { PHASE_VARS
        pg8::Gemm8 g{ws + WS_H, ws + WS_W13, DM, 0, (size_t)4096 * DM, (const int*)(ws + WS_ROWIDX)}; pg8::GOrder S; S.init(8, 16, NE, F.G, (int)blockIdx.x);
        pg8::EpiSwiGLU8 E{ws + WS_ACT + ACT_HID}; pg8::gemm8_phase<true, true>(F.lds, g, S, E); p_ctx_moe(F, p, 0); } SEAM(8); TS_MARK(8);
    if (IN(9)) { PHASE_VARS
        pg8::Gemm8 g{ws + WS_ACT + ACT_HID, ws + WS_W2, FF, (size_t)EROWS * FF, (size_t)DM * FF, nullptr}; pg8::GOrder S; S.init(8, 4, NE, F.G, (int)blockIdx.x);
        pg8::EpiMoeOut8 E{ws + WS_XS, (const float*)(ws + WS_GATE)}; pg8::gemm8_phase<false, false>(F.lds, g, S, E); p_ctx_moe(F, p, 1); } SEAM(9); TS_MARK(9);
    if (IN(10)) { PHASE_VARS p_combine(F, p, 0, false); } SEAM(10); TS_MARK(10);
    if (IN(11)) { PHASE_VARS
        pg8::Gemm g{Hb + (size_t)CTXL * DM, (const bf16_t*)(ws + WS_WQKV), DM, (size_t)LR * DM * 2, 0}; pg8::GOrder S; S.init(32, 12, NB, F.G, (int)blockIdx.x);
        pg8::EpiQKV E{(bf16_t*)(ws + WS_ACT + ACT_Q), (const float*)(ws + WS_ROPE)}; pg8::gemm_phase(F.lds, g, S, E); p_ctx_dense(F, p, 2); } SEAM(11); TS_MARK(11);
    if (IN(12)) { PHASE_VARS p_attn(F, p, lds); } SEAM(12); TS_MARK(12);
    TS_MARK(13);
    if (IN(14)) { PHASE_VARS
        pg8::Gemm g{(const bf16_t*)(ws + WS_XS), (const bf16_t*)(ws + WS_WOUT1), DM, (size_t)SEQ * DM * 2, 0}; pg8::GOrder S; S.init(32, 4, NB, F.G, (int)blockIdx.x);
        pg8::EpiRes E{(bf16_t*)(ws + WS_X), nullptr, mod + 3 * 6144 + 2 * DM, 1}; pg8::gemm_phase(F.lds, g, S, E); } SEAM(14); TS_MARK(14);
    if (IN(15)) { PHASE_VARS p_norm2_router(F, p, 1, false); } SEAM(15); TS_MARK(15);
    if (IN(16)) { PHASE_VARS p_select(F, p, false); } SEAM(16); TS_MARK(16);
    if (IN(17)) { PHASE_VARS
        pg8::Gemm8 g{ws + WS_H, ws + WS_W13 + (size_t)NE * 4096 * DM, DM, 0, (size_t)4096 * DM, (const int*)(ws + WS_ROWIDX)}; pg8::GOrder S; S.init(8, 16, NE, F.G, (int)blockIdx.x);
        pg8::EpiSwiGLU8 E{ws + WS_ACT + ACT_HID}; pg8::gemm8_phase<true, true>(F.lds, g, S, E); } SEAM(17); TS_MARK(17);
    if (IN(18)) { PHASE_VARS
        pg8::Gemm8 g{ws + WS_ACT + ACT_HID, ws + WS_W2 + (size_t)NE * DM * FF, FF, (size_t)EROWS * FF, (size_t)DM * FF, nullptr}; pg8::GOrder S; S.init(8, 4, NE, F.G, (int)blockIdx.x);
        pg8::EpiMoeOut8 E{ws + WS_XS, (const float*)(ws + WS_GATE)}; pg8::gemm8_phase<false, false>(F.lds, g, S, E); } SEAM(18); TS_MARK(18);
    if (IN(19)) { PHASE_VARS p_combine(F, p, 1, true); }
#ifdef FP8_PROBE
    { XcdBarrier xb_; xb_.bar = barw; xb_.x = xb_xcc_id(); xb_.st = bst; xcd_barrier(xb_);
      if (blockIdx.x == 0 && threadIdx.x < 64) { const int l_ = threadIdx.x; int code = 0; if (pr_test<1>(l_)) code = 1; else if (pr_test<2>(l_)) code = 2; else if (pr_test<3>(l_)) code = 3;
          if (l_ == 0) { const Params p = kparams(); p.out[0] += 20.0f * (float)code; } } }
#endif
    if (TS_MASK) { TS_MARK(19); XcdBarrier xb_; xb_.bar = barw; xb_.x = xb_xcc_id(); xb_.st = bst; xcd_barrier(xb_);
        if (blockIdx.x == 0 && threadIdx.x == 0) { const Params p = kparams(); p.out[0] += (float)ts_acc * 0.01f / TS_SCALE; } }
#undef IN
#undef SEAM
}

extern "C" void kernel_launch(void* const* d_in, const int* in_sizes, int n_in, void* d_out, int out_size, void* d_ws, size_t ws_size, hipStream_t stream) {
    static int grid = 0;
    if (grid == 0) {
        if (n_in != 32 || out_size != NLAT * DM || ws_size < WS_END) { fprintf(stderr, "kernel_launch: unexpected problem (n_in %d, out %d, ws %zu)\n", n_in, out_size, ws_size); grid = -1; return; }
        int dev = 0, cus = 0, per_cu = 0;
        if (hipGetDevice(&dev) != hipSuccess || hipDeviceGetAttribute(&cus, hipDeviceAttributeMultiprocessorCount, dev) != hipSuccess) { grid = -1; return; }
        if (hipFuncSetAttribute((const void*)mk_fwd, hipFuncAttributeMaxDynamicSharedMemorySize, LDS_BYTES) != hipSuccess) { fprintf(stderr, "kernel_launch: hipFuncSetAttribute failed\n"); grid = -1; return; }
        if (hipOccupancyMaxActiveBlocksPerMultiprocessor(&per_cu, (const void*)mk_fwd, NWAVES * 64, LDS_BYTES) != hipSuccess || per_cu < 1) { fprintf(stderr, "kernel_launch: occupancy query says %d\n", per_cu); per_cu = 1; }
        (void)hipGetLastError();
        grid = cus & ~7;
    }
    if (grid < 0) return;
    if (hipMemsetAsync((char*)d_ws + WS_CTL, 0, 65536, stream) != hipSuccess) { fprintf(stderr, "kernel_launch: memset failed\n"); return; }
    Params a{};
    for (int i = 0; i < 32; ++i) a.in[i] = (const float*)d_in[i];
    a.out = (float*)d_out; a.ws = (unsigned char*)d_ws;
#if MK_N_LAUNCHES == 1
    a.ph_lo = 0; a.ph_hi = NPH;
    void* args[] = {&a};
    hipError_t e = hipLaunchCooperativeKernel((const void*)mk_fwd, dim3(grid), dim3(NWAVES * 64), args, LDS_BYTES, stream);
    if (e != hipSuccess) fprintf(stderr, "kernel_launch: cooperative launch failed: %s (grid %d)\n", hipGetErrorString(e), grid);
#else
    for (int ph = 0; ph < NPH; ++ph) { a.ph_lo = ph; a.ph_hi = ph + 1; hipLaunchKernelGGL(mk_fwd, dim3(grid), dim3(NWAVES * 64), LDS_BYTES, stream, a); }
#endif
}
```

```cpp
#include <hip/hip_runtime.h>
#include <hip/hip_cooperative_groups.h>
#include <hip/hip_bf16.h>
#include <cstdio>
#include <cstdint>
#include <cmath>
namespace cg = cooperative_groups;

#ifndef MK_N_LAUNCHES
#define MK_N_LAUNCHES 1
#endif

constexpr int DM = 1024, NB = 2, SEQ = 8192, CTXL = 256, LR = SEQ + CTXL, NR = NB * LR, NLAT = NB * SEQ;
constexpr int NE = 16, FF = 2048, EROWS = 2304;
constexpr float EPS = 1e-6f;
constexpr int NTILE64 = NR / 64;
constexpr int NPH = 20;

constexpr size_t MiB = 1u << 20;
constexpr size_t WS_CTL = 0, WS_MOD = 1 * MiB, WS_ROPE = 2 * MiB, WS_LRUW = 4 * MiB, WS_CMWS = 4 * MiB + 512 * 1024, WS_SUM = 5 * MiB, WS_AFF = 8 * MiB, WS_INV = 10 * MiB,
                 WS_GATE = 12 * MiB, WS_ROWIDX = 13 * MiB, WS_MODP = 28 * MiB, WS_CAR = 30 * MiB, WS_WIN = 14 * MiB, WS_WOUT0 = 18 * MiB, WS_WQKV = 20 * MiB, WS_WOUT1 = 26 * MiB, WS_W13 = 32 * MiB, WS_W2 = 288 * MiB, WS_H = 416 * MiB,
                 WS_X = 450 * MiB, WS_XS = 516 * MiB, WS_ACT = 588 * MiB, WS_END = 758 * MiB;
static_assert(true, "");
constexpr size_t ACT_Z = 0, ACT_YCAT = 66 * MiB, ACT_HID = 0, ACT_Q = 0, ACT_K = 33 * MiB, ACT_V = 66 * MiB, ACT_O1 = 99 * MiB, ACT_O2 = 131 * MiB, ACT_A = 0;

#define GAS __attribute__((address_space(1)))
#define LAS __attribute__((address_space(3)))
typedef unsigned short bf16_t;
typedef short bf16x8 __attribute__((ext_vector_type(8)));
typedef float f32x4 __attribute__((ext_vector_type(4)));
typedef float f32x2 __attribute__((ext_vector_type(2)));
typedef unsigned u32x4 __attribute__((ext_vector_type(4)));
typedef unsigned u32x2 __attribute__((ext_vector_type(2)));

__device__ __forceinline__ unsigned f2bf(float f) { unsigned u = __builtin_bit_cast(unsigned, f); return (u + 0x7fffu + ((u >> 16) & 1u)) >> 16; }
typedef float f32x2_hw __attribute__((ext_vector_type(2))); typedef __bf16 bf16x2_hw __attribute__((ext_vector_type(2)));
__device__ __forceinline__ unsigned pk2(float lo, float hi) { f32x2_hw v = {lo, hi}; bf16x2_hw b = __builtin_convertvector(v, bf16x2_hw); return __builtin_bit_cast(unsigned, b); }
__device__ __forceinline__ u32x2 pk4(const f32x4 v) { u32x2 w; w.x = pk2(v[0], v[1]); w.y = pk2(v[2], v[3]); return w; }
__device__ __forceinline__ float bf2f(unsigned short b) { return __builtin_bit_cast(float, (unsigned)b << 16); }
__device__ __forceinline__ float bflo(unsigned w) { return __builtin_bit_cast(float, w << 16); }
__device__ __forceinline__ float bfhi(unsigned w) { return __builtin_bit_cast(float, w & 0xffff0000u); }
__device__ __forceinline__ unsigned f2fp8x4(float a, float b, float c, float d) {
    a = __builtin_amdgcn_fmed3f(a, -448.f, 448.f); b = __builtin_amdgcn_fmed3f(b, -448.f, 448.f); c = __builtin_amdgcn_fmed3f(c, -448.f, 448.f); d = __builtin_amdgcn_fmed3f(d, -448.f, 448.f);
    int w = __builtin_amdgcn_cvt_pk_fp8_f32(a, b, 0, false); w = __builtin_amdgcn_cvt_pk_fp8_f32(c, d, w, true); return (unsigned)w; }
constexpr float YB_SCALE = 16.0f, YB_INV = 1.0f / 16.0f;
constexpr float W8_SCALE = 32.0f, W8_INV = 1.0f / 32.0f;
__device__ __forceinline__ float gelu_tanh(float x) {
    const float u2 = 2.0f * 0.7978845608028654f * (x + 0.044715f * x * x * x);
    const float e = __builtin_amdgcn_exp2f(u2 * 1.4426950408889634f);
    return x - x * __builtin_amdgcn_rcpf(1.0f + e);
}
__device__ __forceinline__ float silu_f(float a) { return a * __builtin_amdgcn_rcpf(1.0f + __builtin_amdgcn_exp2f(-a * 1.4426950408889634f)); }
__device__ __forceinline__ float sigmoid_f(float a) { return 1.0f / (1.0f + __expf(-a)); }

namespace pg8 {
#define PG8_LAS __attribute__((address_space(3)))
constexpr int BM = 256, BK = 64, HALF = 128, HTB = HALF * BK * 2, STAGE_BYTES = 8 * HTB, NXCD = 8, WGM = 8;
__host__ __device__ __forceinline__ int lds_byte(int r, int c) { const int st = (r >> 4) * 2 + (c >> 5), rr = r & 15, cc = c & 31, ob = rr * 64 + cc * 2; return st * 1024 + (ob ^ (((ob >> 9) & 1) << 5)); }
__host__ __device__ __forceinline__ void stage_rc(int b, int& R, int& C) { const int st = b / 1024, sb = b % 1024, swz = sb ^ (((sb >> 9) & 1) << 5); R = (st >> 1) * 16 + swz / 64; C = (st & 1) * 32 + (swz % 64) / 2; }
__host__ __device__ __forceinline__ int perm32(int rho) { const int n = rho >> 4, i = rho & 15; return 8 * (i >> 2) + 4 * n + (i & 3); }

struct Unit { int pm, pn, grp; };
struct Gemm { const bf16_t* A; const bf16_t* Bt; int K; size_t ga, gb; };

struct GOrder {
    int nM, nN, upg, nwg, G, c;
    __device__ void init(int nM_, int nN_, int ngrp, int G_, int c_) { nM = nM_; nN = nN_; upg = nM * nN; nwg = upg * ngrp; G = G_; c = c_; }
    __device__ bool next(int i, Unit& u) const {
        const long L = (long)i * G + c; if (L >= nwg) return false;
        int wgid = (int)L; { const int q = nwg / NXCD, r = nwg % NXCD, xcd = wgid % NXCD, off = wgid / NXCD; wgid = (xcd < r ? xcd * (q + 1) : r * (q + 1) + (xcd - r) * q) + off; }
        u.grp = wgid / upg; const int w = wgid % upg;
        const int nig = WGM * nN, gid = w / nig, fm = gid * WGM, gsz = (nM - fm) < WGM ? (nM - fm) : WGM;
        u.pm = fm + ((w % nig) % gsz); u.pn = (w % nig) / gsz; return true;
    }
};

__device__ __forceinline__ unsigned cvt_pk_bf16(float lo, float hi) { unsigned r; asm volatile("v_cvt_pk_bf16_f32 %0, %1, %2" : "=v"(r) : "v"(lo), "v"(hi)); return r; }

template <class Epi, class Sched>
__device__ __forceinline__ void gemm_phase(PG8_LAS unsigned char* lds, const Gemm g, const Sched& S, const Epi& E) {
    const int tid = threadIdx.x, wid = __builtin_amdgcn_readfirstlane(tid >> 6), lane = tid & 63, wr = wid >> 2, wc = wid & 3, fr = lane & 15, fq = lane >> 4;
    const int K = g.K, nt = K / BK;
    unsigned voffA[2], voffB[2];
#pragma unroll
    for (int i = 0; i < 2; ++i) { int R, C; stage_rc(tid * 16 + i * 8192, R, C); const int Rb = (R & ~31) + perm32(R & 31);
        voffA[i] = (unsigned)(R * K + C) * 2u; voffB[i] = (unsigned)(Rb * K + C) * 2u; }
    const size_t kstep = (size_t)(BK * 2);
    const size_t hstep = (size_t)HALF * K * 2;
    const size_t tstep = 2 * hstep;
    const unsigned ldsw = (unsigned)wid * 1024u;
    const int aoff = lds_byte(wr * 64 + fr, fq * 8), boff = lds_byte(wc * 32 + fr, fq * 8);
#define PG8_SA(b, h) (((b) * 2 + (h)) * HTB)
#define PG8_SB(b, h) ((4 + (b) * 2 + (h)) * HTB)
#define PG8_STAGE(bufoff, gbase, voff) do { _Pragma("unroll") for (int _i = 0; _i < 2; ++_i) \
        __builtin_amdgcn_global_load_lds((const unsigned*)((const char*)(gbase) + (voff)[_i]), (PG8_LAS unsigned*)(lds + (bufoff) + ldsw + _i * 8192), 16, 0, 0); } while (0)
#define PG8_LDA(dst, b, h) do { _Pragma("unroll") for (int m = 0; m < 4; ++m) _Pragma("unroll") for (int k = 0; k < 2; ++k) dst[m][k] = *(const PG8_LAS bf16x8*)(lds + PG8_SA(b, h) + aoff + m * 2048 + k * 1024); } while (0)
#define PG8_LDB(dst, b, h) do { _Pragma("unroll") for (int n = 0; n < 2; ++n) _Pragma("unroll") for (int k = 0; k < 2; ++k) dst[n][k] = *(const PG8_LAS bf16x8*)(lds + PG8_SB(b, h) + boff + n * 2048 + k * 1024); } while (0)
#define PG8_MMA(ai, bj, At, Bt) do { __builtin_amdgcn_s_setprio(1); _Pragma("unroll") for (int m = 0; m < 4; ++m) _Pragma("unroll") for (int n = 0; n < 2; ++n) _Pragma("unroll") for (int k = 0; k < 2; ++k) \
        acc[ai][bj][m][n] = __builtin_amdgcn_mfma_f32_16x16x32_bf16(Bt[n][k], At[m][k], acc[ai][bj][m][n], 0, 0, 0); __builtin_amdgcn_s_setprio(0); } while (0)
#define PG8_WAIT_V(n) asm volatile("s_waitcnt vmcnt(" #n ")" ::: "memory")
#define PG8_WAIT_L(n) asm volatile("s_waitcnt lgkmcnt(" #n ")" ::: "memory")
#define PG8_BAR __builtin_amdgcn_s_barrier()
#define PG8_SCHED __builtin_amdgcn_sched_barrier(0)
    Unit cur, nxt; int ui = 0;
    if (!S.next(0, cur)) return;
    f32x4 acc[2][2][4][2];
#pragma unroll
    for (int a = 0; a < 2; ++a)
#pragma unroll
        for (int b = 0; b < 2; ++b)
#pragma unroll
            for (int m = 0; m < 4; ++m)
#pragma unroll
                for (int n = 0; n < 2; ++n) acc[a][b][m][n] = (f32x4){0.f, 0.f, 0.f, 0.f};
    bf16x8 At[4][2], B0[2][2], B1[2][2];
    const char* cA = (const char*)g.A + (size_t)cur.grp * g.ga + (size_t)cur.pm * tstep; const char* cB = (const char*)g.Bt + (size_t)cur.grp * g.gb + (size_t)cur.pn * tstep;
    PG8_STAGE(PG8_SB(0, 0), cB, voffB); PG8_STAGE(PG8_SB(0, 1), cB + hstep, voffB); PG8_STAGE(PG8_SA(0, 0), cA, voffA); PG8_STAGE(PG8_SA(0, 1), cA + hstep, voffA);
    if (wr == 1) PG8_BAR;
    PG8_WAIT_V(2); PG8_BAR;
    PG8_STAGE(PG8_SB(1, 0), cB + kstep, voffB); PG8_STAGE(PG8_SA(1, 0), cA + kstep, voffA); PG8_STAGE(PG8_SB(1, 1), cB + hstep + kstep, voffB);
    PG8_WAIT_V(6); PG8_BAR;
    for (;;) {
        const bool has_next = S.next(ui + 1, nxt);
        const char* nA = has_next ? (const char*)g.A + (size_t)nxt.grp * g.ga + (size_t)nxt.pm * tstep : cA; const char* nB = has_next ? (const char*)g.Bt + (size_t)nxt.grp * g.gb + (size_t)nxt.pn * tstep : cB;
        for (int t = 0; t < nt; t += 2) {
            const bool last = (t == nt - 2);
            const char* a1 = cA + (size_t)(t + 1) * kstep;
            const char* a2 = last ? nA : cA + (size_t)(t + 2) * kstep; const char* b2 = last ? nB : cB + (size_t)(t + 2) * kstep;
            const char* a3 = a2 + kstep; const char* b3 = b2 + kstep;
            PG8_LDB(B0, 0, 0); PG8_LDB(B1, 0, 1); PG8_SCHED; PG8_LDA(At, 0, 0); PG8_STAGE(PG8_SA(1, 1), a1 + hstep, voffA);
            PG8_WAIT_V(8); PG8_WAIT_L(0); PG8_BAR; PG8_MMA(0, 0, At, B0); PG8_MMA(0, 1, At, B1); PG8_BAR; PG8_SCHED;
            PG8_LDA(At, 0, 1); PG8_STAGE(PG8_SB(0, 0), b2, voffB); PG8_STAGE(PG8_SB(0, 1), b2 + hstep, voffB); PG8_STAGE(PG8_SA(0, 0), a2, voffA);
            PG8_WAIT_V(8); PG8_WAIT_L(0); PG8_BAR; PG8_MMA(1, 0, At, B0); PG8_MMA(1, 1, At, B1); PG8_BAR; PG8_SCHED;
            PG8_LDB(B0, 1, 0); PG8_LDB(B1, 1, 1); PG8_SCHED; PG8_LDA(At, 1, 0); PG8_STAGE(PG8_SA(0, 1), a2 + hstep, voffA);
            PG8_WAIT_V(8); PG8_WAIT_L(0); PG8_BAR; PG8_MMA(0, 0, At, B0); PG8_MMA(0, 1, At, B1); PG8_BAR; PG8_SCHED;
            PG8_LDA(At, 1, 1); PG8_STAGE(PG8_SB(1, 0), b3, voffB); PG8_STAGE(PG8_SB(1, 1), b3 + hstep, voffB); PG8_STAGE(PG8_SA(1, 0), a3, voffA);
            PG8_WAIT_V(8); PG8_WAIT_L(0); PG8_BAR; PG8_MMA(1, 0, At, B0); PG8_MMA(1, 1, At, B1); PG8_BAR; PG8_SCHED;
        }
        if (wr == 0) PG8_BAR;
        E(acc, cur, wr, wc, fr, fq);
        if (!has_next) break;
#pragma unroll
        for (int a = 0; a < 2; ++a)
#pragma unroll
            for (int b = 0; b < 2; ++b)
#pragma unroll
                for (int m = 0; m < 4; ++m)
#pragma unroll
                    for (int n = 0; n < 2; ++n) acc[a][b][m][n] = (f32x4){0.f, 0.f, 0.f, 0.f};
        cur = nxt; cA = nA; cB = nB; ++ui;
        if (wr == 1) PG8_BAR;
    }
    PG8_WAIT_V(0);
    PG8_BAR;
#undef PG8_SA
#undef PG8_SB
#undef PG8_STAGE
#undef PG8_LDA
#undef PG8_LDB
#undef PG8_MMA
#undef PG8_WAIT_V
#undef PG8_WAIT_L
#undef PG8_BAR
#undef PG8_SCHED
}

typedef int v8i32 __attribute__((ext_vector_type(8)));
typedef float f32x16 __attribute__((ext_vector_type(16)));
__host__ __device__ __forceinline__ int permS(int rho) { const int e = rho & 3, hh = (rho >> 2) & 1, q = rho >> 3; return q < 2 ? 8 * hh + 4 * q + e : 16 + 8 * hh + 4 * (q - 2) + e; }
__host__ __device__ __forceinline__ int permN(int rho) { const int e = rho & 3, hh = (rho >> 2) & 1, q = rho >> 3; return 16 * hh + 4 * q + e; }
struct Gemm8 { const unsigned char* A; const unsigned char* Bt; int K; size_t ga, gb; const int* rows; };
template <bool SWP, bool GATH, class Epi, class Sched>
__device__ __forceinline__ void gemm8_phase(PG8_LAS unsigned char* lds, const Gemm8 g, const Sched& S, const Epi& E) {
    const int tid = threadIdx.x, wid = __builtin_amdgcn_readfirstlane(tid >> 6), lane = tid & 63, wr = wid >> 2, wc = wid & 3;
    const int K = g.K, nt = K / 128;
    unsigned voffA[4], voffB[2]; int RA0 = 0, CbA = 0;
#pragma unroll
    for (int i = 0; i < 2; ++i) {
        const int bb = tid * 16 + i * 8192, st = bb / 1024, sb = bb % 1024, swz = sb ^ (((sb >> 9) & 1) << 5) ^ (((sb >> 8) & 1) << 4);
        const int R = (st >> 1) * 16 + swz / 64, Cb = (st & 1) * 64 + swz % 64; const int Rb = (R & ~31) + (SWP ? permS(R & 31) : permN(R & 31));
        voffA[i] = (unsigned)(R * K + Cb); voffA[2 + i] = (unsigned)((R + HALF) * K + Cb); voffB[i] = (unsigned)(Rb * K + Cb); if (i == 0) { RA0 = R; CbA = Cb; } }
    const size_t kstep = 128, hstep = (size_t)HALF * K, tstep = 2 * hstep;
    constexpr int IDXOFF = 8 * HTB;
    const unsigned ldsw = (unsigned)wid * 1024u;
    const int l31 = lane & 31, hh = lane >> 5;
    const int ra = wr * 64 + l31, rb = wc * 32 + l31;
    const int aoff = ((ra >> 4) * 2) * 1024 + (ra & 15) * 64 + 32 * (hh ^ ((ra & 15) >> 3)), boff = ((rb >> 4) * 2) * 1024 + (rb & 15) * 64 + 32 * (hh ^ ((rb & 15) >> 3));
    const int aswp = 16 * ((ra >> 2) & 1), bswp = 16 * ((rb >> 2) & 1);
#define PG8_SA(b, h) (((b) * 2 + (h)) * HTB)
#define PG8_SB(b, h) ((4 + (b) * 2 + (h)) * HTB)
#define PG8_STAGE(bufoff, gbase, voff) do { _Pragma("unroll") for (int _i = 0; _i < 2; ++_i) \
        __builtin_amdgcn_global_load_lds((const unsigned*)((const char*)(gbase) + (voff)[_i]), (PG8_LAS unsigned*)(lds + (bufoff) + ldsw + _i * 8192), 16, 0, 0); } while (0)
#define PG8_STAGEA(bufoff, gbase, h) do { _Pragma("unroll") for (int _i = 0; _i < 2; ++_i) \
        __builtin_amdgcn_global_load_lds((const unsigned*)((const char*)(gbase) + voffA[2 * (h) + _i]), (PG8_LAS unsigned*)(lds + (bufoff) + ldsw + _i * 8192), 16, 0, 0); } while (0)
#define PG8_LD32(dst, off, swp) do { const u32x4 lo_ = *(const PG8_LAS u32x4*)(lds + (off) + (swp)); const u32x4 hi_ = *(const PG8_LAS u32x4*)(lds + (off) + (16 - (swp))); \
        dst = (v8i32){(int)lo_.x, (int)lo_.y, (int)lo_.z, (int)lo_.w, (int)hi_.x, (int)hi_.y, (int)hi_.z, (int)hi_.w}; } while (0)
#define PG8_LDA(dst, b, h) do { _Pragma("unroll") for (int m = 0; m < 2; ++m) _Pragma("unroll") for (int k = 0; k < 2; ++k) PG8_LD32(dst[m][k], PG8_SA(b, h) + aoff + m * 4096 + k * 1024, aswp); } while (0)
#define PG8_LDB(dst, b, h) do { _Pragma("unroll") for (int k = 0; k < 2; ++k) PG8_LD32(dst[k], PG8_SB(b, h) + boff + k * 1024, bswp); } while (0)
#define PG8_MMA(ai, bj, At, Bt) do { __builtin_amdgcn_s_setprio(1); _Pragma("unroll") for (int m = 0; m < 2; ++m) _Pragma("unroll") for (int k = 0; k < 2; ++k) \
        acc[ai][bj][m] = __builtin_amdgcn_mfma_scale_f32_32x32x64_f8f6f4(Bt[k], At[m][k], acc[ai][bj][m], 0, 0, 0, 0x7f7f7f7f, 0, 0x7f7f7f7f); \
        asm volatile("" : "+v"(acc[ai][bj][0]), "+v"(acc[ai][bj][1])); __builtin_amdgcn_s_setprio(0); } while (0)
#define PG8_WAIT_V(n) asm volatile("s_waitcnt vmcnt(" #n ")" ::: "memory")
#define PG8_WAIT_L(n) asm volatile("s_waitcnt lgkmcnt(" #n ")" ::: "memory")
#define PG8_BAR __builtin_amdgcn_s_barrier()
#define PG8_SCHED __builtin_amdgcn_sched_barrier(0)
    Unit cur, nxt; int ui = 0;
    if (!S.next(0, cur)) return;
    f32x16 acc[2][2][2];
#pragma unroll
    for (int a = 0; a < 2; ++a)
#pragma unroll
        for (int b = 0; b < 2; ++b)
#pragma unroll
            for (int m = 0; m < 2; ++m) acc[a][b][m] = f32x16{};
    v8i32 At[2][2], B0[2], B1[2];
    const char* cA = GATH ? (const char*)g.A : (const char*)g.A + (size_t)cur.grp * g.ga + (size_t)cur.pm * tstep; const char* cB = (const char*)g.Bt + (size_t)cur.grp * g.gb + (size_t)cur.pn * tstep;
    if (GATH) { const int* rp = g.rows + (size_t)cur.grp * EROWS + cur.pm * BM + RA0;
#pragma unroll
        for (int q = 0; q < 4; ++q) voffA[q] = (unsigned)(rp[64 * q] * K + CbA); }
    PG8_STAGE(PG8_SB(0, 0), cB, voffB); PG8_STAGE(PG8_SB(0, 1), cB + hstep, voffB); PG8_STAGEA(PG8_SA(0, 0), cA, 0); PG8_STAGEA(PG8_SA(0, 1), cA, 1);
    if (wr == 1) PG8_BAR;
    PG8_WAIT_V(2); PG8_BAR;
    PG8_STAGE(PG8_SB(1, 0), cB + kstep, voffB); PG8_STAGEA(PG8_SA(1, 0), cA + kstep, 0); PG8_STAGE(PG8_SB(1, 1), cB + hstep + kstep, voffB);
    PG8_WAIT_V(6); PG8_BAR;
    for (;;) {
        const bool has_next = S.next(ui + 1, nxt);
        const char* nA = (has_next && !GATH) ? (const char*)g.A + (size_t)nxt.grp * g.ga + (size_t)nxt.pm * tstep : cA; const char* nB = has_next ? (const char*)g.Bt + (size_t)nxt.grp * g.gb + (size_t)nxt.pn * tstep : cB;
        if (GATH && has_next && wid == 0)
            __builtin_amdgcn_global_load_lds((const unsigned*)(g.rows + (size_t)nxt.grp * EROWS + nxt.pm * BM + lane * 4), (PG8_LAS unsigned*)(lds + IDXOFF + ((ui + 1) & 1) * 1024), 16, 0, 0);
        for (int t = 0; t < nt; t += 2) {
            const bool last = (t == nt - 2);
            const char* a1 = cA + (size_t)(t + 1) * kstep;
            const char* a2 = last ? nA : cA + (size_t)(t + 2) * kstep; const char* b2 = last ? nB : cB + (size_t)(t + 2) * kstep;
            const char* a3 = a2 + kstep; const char* b3 = b2 + kstep;
            PG8_LDB(B0, 0, 0); PG8_LDB(B1, 0, 1); PG8_SCHED; PG8_LDA(At, 0, 0); PG8_STAGEA(PG8_SA(1, 1), a1, 1);
            if (GATH && last && has_next) {
                const PG8_LAS int* ip = (const PG8_LAS int*)(lds + IDXOFF + ((ui + 1) & 1) * 1024) + RA0;
#pragma unroll
                for (int q = 0; q < 4; ++q) voffA[q] = (unsigned)(ip[64 * q] * K + CbA); }
            PG8_WAIT_V(8); PG8_WAIT_L(0); PG8_BAR; PG8_SCHED; PG8_MMA(0, 0, At, B0); PG8_MMA(0, 1, At, B1); PG8_SCHED; PG8_BAR; PG8_SCHED;
            PG8_LDA(At, 0, 1); PG8_STAGE(PG8_SB(0, 0), b2, voffB); PG8_STAGE(PG8_SB(0, 1), b2 + hstep, voffB); PG8_STAGEA(PG8_SA(0, 0), a2, 0);
            PG8_WAIT_V(8); PG8_WAIT_L(0); PG8_BAR; PG8_SCHED; PG8_MMA(1, 0, At, B0); PG8_MMA(1, 1, At, B1); PG8_SCHED; PG8_BAR; PG8_SCHED;
            PG8_LDB(B0, 1, 0); PG8_LDB(B1, 1, 1); PG8_SCHED; PG8_LDA(At, 1, 0); PG8_STAGEA(PG8_SA(0, 1), a2, 1);
            PG8_WAIT_V(8); PG8_WAIT_L(0); PG8_BAR; PG8_SCHED; PG8_MMA(0, 0, At, B0); PG8_MMA(0, 1, At, B1); PG8_SCHED; PG8_BAR; PG8_SCHED;
            PG8_LDA(At, 1, 1); PG8_STAGE(PG8_SB(1, 0), b3, voffB); PG8_STAGE(PG8_SB(1, 1), b3 + hstep, voffB); PG8_STAGEA(PG8_SA(1, 0), a3, 0);
            PG8_WAIT_V(8); PG8_WAIT_L(0); PG8_BAR; PG8_SCHED; PG8_MMA(1, 0, At, B0); PG8_MMA(1, 1, At, B1); PG8_SCHED; PG8_BAR; PG8_SCHED;
        }
        if (wr == 0) PG8_BAR;
        E(acc, cur, wr, wc, l31, hh);
        if (!has_next) break;
#pragma unroll
        for (int a = 0; a < 2; ++a)
#pragma unroll
            for (int b = 0; b < 2; ++b)
#pragma unroll
                for (int m = 0; m < 2; ++m) acc[a][b][m] = f32x16{};
        cur = nxt; cA = nA; cB = nB; ++ui;
        if (wr == 1) PG8_BAR;
    }
    PG8_WAIT_V(0);
    PG8_BAR;
#undef PG8_SA
#undef PG8_SB
#undef PG8_STAGE
#undef PG8_STAGEA
#undef PG8_LD32
#undef PG8_LDA
#undef PG8_LDB
#undef PG8_MMA
#undef PG8_WAIT_V
#undef PG8_WAIT_L
#undef PG8_BAR
#undef PG8_SCHED
}
struct EpiSwiGLU8 {
    unsigned char* HID;
    __device__ __forceinline__ void operator()(const f32x16 (&acc)[2][2][2], const Unit& u, int wr, int wc, int l31, int hh) const {
        const int row0 = u.pm * BM + wr * 64 + l31, f0 = u.pn * 128 + wc * 16 + 8 * hh;
#pragma unroll
        for (int ai = 0; ai < 2; ++ai)
#pragma unroll
            for (int m = 0; m < 2; ++m) { unsigned char* rowp = HID + ((size_t)u.grp * EROWS + row0 + ai * HALF + m * 32) * FF + f0;
#pragma unroll
                for (int bj = 0; bj < 2; ++bj) { const f32x16& c = acc[ai][bj][m]; float hv[8];
#pragma unroll
                    for (int e = 0; e < 8; ++e) hv[e] = silu_f(c[e] * W8_INV) * (c[8 + e] * W8_INV);
                    u32x2 w; w.x = f2fp8x4(hv[0], hv[1], hv[2], hv[3]); w.y = f2fp8x4(hv[4], hv[5], hv[6], hv[7]);
                    *(u32x2*)(rowp + bj * 64) = w; } }
    }
};
struct EpiMoeOut8 {
    unsigned char* YB; const float* gate;
    __device__ __forceinline__ void operator()(const f32x16 (&acc)[2][2][2], const Unit& u, int wr, int wc, int l31, int hh) const {
        const int row0 = u.pm * BM + wr * 64 + l31, col0 = u.pn * BM + wc * 32 + 16 * hh;
#pragma unroll
        for (int ai = 0; ai < 2; ++ai)
#pragma unroll
            for (int m = 0; m < 2; ++m) { const size_t er = (size_t)u.grp * EROWS + row0 + ai * HALF + m * 32; const float gt = gate[er] * (W8_INV * YB_SCALE); unsigned char* rowp = YB + er * DM + col0;
#pragma unroll
                for (int bj = 0; bj < 2; ++bj) { const f32x16& c = acc[ai][bj][m]; u32x4 w;
                    w.x = f2fp8x4(c[0] * gt, c[1] * gt, c[2] * gt, c[3] * gt); w.y = f2fp8x4(c[4] * gt, c[5] * gt, c[6] * gt, c[7] * gt);
                    w.z = f2fp8x4(c[8] * gt, c[9] * gt, c[10] * gt, c[11] * gt); w.w = f2fp8x4(c[12] * gt, c[13] * gt, c[14] * gt, c[15] * gt);
                    *(u32x4*)(rowp + bj * HALF) = w; } }
    }
};

struct EpiWin {
    bf16_t* Z;
    __device__ __forceinline__ void operator()(const f32x4 (&acc)[2][2][4][2], const Unit& u, int wr, int wc, int fr, int fq) const {
        const int row0 = u.grp * LR + CTXL + u.pm * BM + wr * 64 + fr, col0 = u.pn * BM + wc * 32 + 8 * fq; const bool act = (u.pn < 2) || (u.pn >= 4);
#pragma unroll
        for (int ai = 0; ai < 2; ++ai)
#pragma unroll
            for (int m = 0; m < 4; ++m) { bf16_t* rowp = Z + (size_t)(row0 + ai * HALF + m * 16) * 2048 + col0;
#pragma unroll
                for (int bj = 0; bj < 2; ++bj) { f32x4 v0 = acc[ai][bj][m][0], v1 = acc[ai][bj][m][1];
                    if (act) {
#pragma unroll
                        for (int i = 0; i < 4; ++i) { v0[i] = gelu_tanh(v0[i]); v1[i] = gelu_tanh(v1[i]); } }
                    u32x4 w; w.x = cvt_pk_bf16(v0[0], v0[1]); w.y = cvt_pk_bf16(v0[2], v0[3]); w.z = cvt_pk_bf16(v1[0], v1[1]); w.w = cvt_pk_bf16(v1[2], v1[3]);
                    *(u32x4*)(rowp + bj * HALF) = w; } }
    }
};
struct EpiRes {
    bf16_t* X; const float* xin; const float* g1; int mode;
    __device__ __forceinline__ void operator()(const f32x4 (&acc)[2][2][4][2], const Unit& u, int wr, int wc, int fr, int fq) const {
        const int b = u.grp; bf16_t* outp = X + ((size_t)b * LR + CTXL + (size_t)u.pm * BM) * DM;
        const float* basep = xin + ((size_t)b * SEQ + (size_t)u.pm * BM) * DM;
        const int rr0 = wr * 64 + fr, col0 = u.pn * BM + wc * 32 + 8 * fq;
        f32x4 gv[2][2];
#pragma unroll
        for (int bj = 0; bj < 2; ++bj)
#pragma unroll
            for (int n = 0; n < 2; ++n) gv[bj][n] = *(const f32x4*)(g1 + (size_t)b * 6144 + col0 + bj * HALF + 4 * n);
#pragma unroll
        for (int ai = 0; ai < 2; ++ai)
#pragma unroll
            for (int m = 0; m < 4; ++m) { const size_t off = (size_t)(rr0 + ai * HALF + m * 16) * DM + col0;
#pragma unroll
                for (int bj = 0; bj < 2; ++bj) { f32x4 b0, b1;
                    if (mode == 0) { b0 = *(const f32x4*)(basep + off + bj * HALF); b1 = *(const f32x4*)(basep + off + bj * HALF + 4); }
                    else { const u32x4 w = *(const u32x4*)(outp + off + bj * HALF); b0 = (f32x4){bflo(w.x), bfhi(w.x), bflo(w.y), bfhi(w.y)}; b1 = (f32x4){bflo(w.z), bfhi(w.z), bflo(w.w), bfhi(w.w)}; }
                    const f32x4 o0 = b0 + gv[bj][0] * acc[ai][bj][m][0], o1 = b1 + gv[bj][1] * acc[ai][bj][m][1];
                    u32x4 wo; wo.x = cvt_pk_bf16(o0[0], o0[1]); wo.y = cvt_pk_bf16(o0[2], o0[3]); wo.z = cvt_pk_bf16(o1[0], o1[1]); wo.w = cvt_pk_bf16(o1[2], o1[3]);
                    *(u32x4*)(outp + off + bj * HALF) = wo; } }
    }
};
constexpr float C2 = 0.125f * 1.4426950408889634f;
struct EpiQKV {
    bf16_t* Q; const float* cs;
    __device__ __forceinline__ void operator()(const f32x4 (&acc)[2][2][4][2], const Unit& u, int wr, int wc, int fr, int fq) const {
        const int t0 = u.pm * BM; const size_t Rb = (size_t)u.grp * LR + CTXL + t0;
        const int sec = u.pn >> 2; bf16_t* dst = Q + (size_t)sec * ((ACT_K - ACT_Q) / 2);
        const int rr0 = wr * 64 + fr, colt = (u.pn & 3) * BM + wc * 32 + 8 * fq; const float sc = sec == 0 ? C2 : 1.0f; const bool rope = sec < 2;
#pragma unroll
        for (int ai = 0; ai < 2; ++ai)
#pragma unroll
            for (int m = 0; m < 4; ++m) { const int rr = rr0 + ai * HALF + m * 16; bf16_t* rowp = dst + (Rb + rr) * DM + colt;
#pragma unroll
                for (int bj = 0; bj < 2; ++bj) { f32x4 v0 = acc[ai][bj][m][0], v1 = acc[ai][bj][m][1];
                    if (rope) { const int p0 = ((colt + bj * HALF) & 63) >> 1, tt = t0 + rr; const float* cp = cs + ((p0 < 16 ? (tt >> 6) * 16 + p0 : (128 + (tt & 63)) * 16 + (p0 - 16))) * 2;
                        const f32x4 c01 = *(const f32x4*)cp, c23 = *(const f32x4*)(cp + 4);
                        const float a0 = v0[0] * c01[0] - v0[1] * c01[1], a1 = v0[0] * c01[1] + v0[1] * c01[0];
                        const float a2 = v0[2] * c01[2] - v0[3] * c01[3], a3 = v0[2] * c01[3] + v0[3] * c01[2];
                        const float b0 = v1[0] * c23[0] - v1[1] * c23[1], b1 = v1[0] * c23[1] + v1[1] * c23[0];
                        const float b2 = v1[2] * c23[2] - v1[3] * c23[3], b3 = v1[2] * c23[3] + v1[3] * c23[2];
                        v0 = (f32x4){a0, a1, a2, a3}; v1 = (f32x4){b0, b1, b2, b3}; }
                    v0 = v0 * sc; v1 = v1 * sc;
                    u32x4 w; w.x = cvt_pk_bf16(v0[0], v0[1]); w.y = cvt_pk_bf16(v0[2], v0[3]); w.z = cvt_pk_bf16(v1[0], v1[1]); w.w = cvt_pk_bf16(v1[2], v1[3]);
                    *(u32x4*)(rowp + bj * HALF) = w; }
                asm volatile("" ::: "memory"); }
    }
};
struct EpiSwiGLU {
    bf16_t* HID;
    __device__ __forceinline__ void operator()(const f32x4 (&acc)[2][2][4][2], const Unit& u, int wr, int wc, int fr, int fq) const {
        const int row0 = u.pm * BM + wr * 64 + fr, f0 = u.pn * 128 + wc * 16 + 4 * fq;
#pragma unroll
        for (int ai = 0; ai < 2; ++ai)
#pragma unroll
            for (int m = 0; m < 4; ++m) { bf16_t* rowp = HID + ((size_t)u.grp * EROWS + row0 + ai * HALF + m * 16) * FF + f0;
#pragma unroll
                for (int bj = 0; bj < 2; ++bj) { const f32x4 a = acc[ai][bj][m][0], bb = acc[ai][bj][m][1];
                    u32x2 w; w.x = cvt_pk_bf16(silu_f(a[0]) * bb[0], silu_f(a[1]) * bb[1]); w.y = cvt_pk_bf16(silu_f(a[2]) * bb[2], silu_f(a[3]) * bb[3]);
                    *(u32x2*)(rowp + bj * 64) = w; } }
    }
};
struct EpiMoeOut {
    bf16_t* YB; const float* gate;
    __device__ __forceinline__ void operator()(const f32x4 (&acc)[2][2][4][2], const Unit& u, int wr, int wc, int fr, int fq) const {
        const int row0 = u.pm * BM + wr * 64 + fr, col0 = u.pn * BM + wc * 32 + 8 * fq;
#pragma unroll
        for (int ai = 0; ai < 2; ++ai)
#pragma unroll
            for (int m = 0; m < 4; ++m) { const size_t er = (size_t)u.grp * EROWS + row0 + ai * HALF + m * 16; const float gt = gate[er]; bf16_t* rowp = YB + er * DM + col0;
#pragma unroll
                for (int bj = 0; bj < 2; ++bj) { const f32x4 v0 = acc[ai][bj][m][0] * gt, v1 = acc[ai][bj][m][1] * gt;
                    u32x4 w; w.x = cvt_pk_bf16(v0[0], v0[1]); w.y = cvt_pk_bf16(v0[2], v0[3]); w.z = cvt_pk_bf16(v1[0], v1[1]); w.w = cvt_pk_bf16(v1[2], v1[3]);
                    *(u32x4*)(rowp + bj * HALF) = w; } }
    }
};
}

namespace attn_body {
using bf16=__hip_bfloat16;
using s16x4=__attribute__((ext_vector_type(4)))short;
using f32x16=__attribute__((ext_vector_type(16)))float;
constexpr int D=64,PITCH=1024;
constexpr int NW=8,QBLK=32,QB=QBLK*NW,KVBLK=64;
constexpr int NT=LR/KVBLK;
__device__ __forceinline__ int crow(int r,int hi){return (r&3)+8*(r>>2)+4*hi;}
#define SBAR() __builtin_amdgcn_sched_barrier(0)
constexpr int NSLOT=3, SLOTB=8192;
constexpr int LDS_K=0, LDS_V=NSLOT*SLOTB, LDS_WS=2*NSLOT*SLOTB, LDS_OST=LDS_WS+NW*64*4, LDS_BYTES=LDS_OST+NW*4096;
__device__ __forceinline__ void glds16(const void*gsrc,unsigned lds_dst){unsigned keep;
  asm volatile("s_mov_b32 %0, m0\n\ts_mov_b32 m0, %2\n\ts_nop 0\n\tglobal_load_lds_dwordx4 %1, off\n\ts_mov_b32 m0, %0":"=&s"(keep):"v"(gsrc),"s"(lds_dst):"memory");}
__device__ __forceinline__ void glds16s(const void*sbase,unsigned voff,unsigned lds_dst){unsigned keep;
  asm volatile("s_mov_b32 %0, m0\n\ts_mov_b32 m0, %2\n\ts_nop 2\n\tglobal_load_lds_dwordx4 %1, %3\n\ts_mov_b32 m0, %0":"=&s"(keep):"v"(voff),"s"(lds_dst),"s"(sbase):"memory");}
__device__ __forceinline__ float max3f(float a,float b,float c){float r;asm("v_max3_f32 %0, %1, %2, %3":"=v"(r):"v"(a),"v"(b),"v"(c));return r;}
__device__ __forceinline__ float max2f(float a,float b){float r;asm("v_max_f32_e32 %0, %1, %2":"=v"(r):"v"(a),"v"(b));return r;}
__device__ __forceinline__ float fadd_s(float a,float b){float r;asm("v_add_f32_e32 %0, %1, %2":"=v"(r):"v"(a),"v"(b));return r;}
__device__ __forceinline__ float fsub_s(float a,float b){float r;asm("v_sub_f32_e32 %0, %1, %2":"=v"(r):"v"(a),"v"(b));return r;}
typedef float f32x2_t __attribute__((ext_vector_type(2))); typedef __bf16 bf16x2_t __attribute__((ext_vector_type(2)));
__device__ __forceinline__ unsigned cvtpk_s(float lo,float hi){f32x2_t v={lo,hi};bf16x2_t b=__builtin_convertvector(v,bf16x2_t);return __builtin_bit_cast(unsigned,b);}
#define WAIT_BAR(N) asm volatile("s_waitcnt vmcnt(" #N ") lgkmcnt(0)\n\ts_barrier":::"memory")
__device__ __forceinline__ void qkt(f32x16&p0,f32x16&p1,const char*Kslot,const bf16x8*qr,const f32x16&negm,int r32,int hi){
  const char*kb=Kslot+hi*1024+r32*16;
  #pragma unroll
  for(int d0=0;d0<4;++d0){
    const bf16x8 b0=*reinterpret_cast<const bf16x8*>(kb+d0*2048);
    const bf16x8 b1=*reinterpret_cast<const bf16x8*>(kb+d0*2048+512);
    if(d0==0){p0=__builtin_amdgcn_mfma_f32_32x32x16_bf16(b0,qr[0],negm,0,0,0);p1=__builtin_amdgcn_mfma_f32_32x32x16_bf16(b1,qr[0],negm,0,0,0);}
    else{p0=__builtin_amdgcn_mfma_f32_32x32x16_bf16(b0,qr[d0],p0,0,0,0);p1=__builtin_amdgcn_mfma_f32_32x32x16_bf16(b1,qr[d0],p1,0,0,0);}}
}
typedef __attribute__((address_space(3))) const char* lds_cptr;
typedef short v4i16_t __attribute__((ext_vector_type(4)));
__device__ __forceinline__ void kload8(bf16x8*kf,lds_cptr kp){
  kf[0]=*(const __attribute__((address_space(3))) bf16x8*)(kp);      kf[1]=*(const __attribute__((address_space(3))) bf16x8*)(kp+512);
  kf[2]=*(const __attribute__((address_space(3))) bf16x8*)(kp+2048); kf[3]=*(const __attribute__((address_space(3))) bf16x8*)(kp+2560);
  kf[4]=*(const __attribute__((address_space(3))) bf16x8*)(kp+4096); kf[5]=*(const __attribute__((address_space(3))) bf16x8*)(kp+4608);
  kf[6]=*(const __attribute__((address_space(3))) bf16x8*)(kp+6144); kf[7]=*(const __attribute__((address_space(3))) bf16x8*)(kp+6656);
}
__device__ __forceinline__ void kload2(bf16x8*kf,lds_cptr kp,int j){ kf[2*j]=*(const __attribute__((address_space(3))) bf16x8*)(kp+j*2048); kf[2*j+1]=*(const __attribute__((address_space(3))) bf16x8*)(kp+j*2048+512); }
__device__ __forceinline__ s16x4 vtr(lds_cptr p){ return __builtin_bit_cast(s16x4,__builtin_amdgcn_ds_read_tr16_b64_v4i16((__attribute__((address_space(3))) v4i16_t*)p)); }
__device__ __forceinline__ float rowmax(const f32x16&p0,const f32x16&p1){
  float a=max3f(p0[0],p0[1],p1[0]),b=max3f(p0[2],p0[3],p1[1]);a=max3f(a,p1[2],p1[3]);
  #pragma unroll
  for(int r=4;r<16;r+=4){a=max3f(a,p0[r],p0[r+1]);b=max3f(b,p0[r+2],p0[r+3]);a=max3f(a,p1[r],p1[r+1]);b=max3f(b,p1[r+2],p1[r+3]);}
  const float m=max2f(a,b);
  auto rr=__builtin_amdgcn_permlane32_swap(__float_as_uint(m),__float_as_uint(m),false,false);
  return max2f(__uint_as_float(rr[0]),__uint_as_float(rr[1]));
}
__device__ __forceinline__ void pv(f32x16*o,int vb,bf16x8 pa0,bf16x8 pa1,bf16x8 pa2,bf16x8 pa3){
  #pragma unroll
  for(int d0=0;d0<2;++d0){s16x4 lo[4],hi[4];
    #pragma unroll
    for(int ks=0;ks<4;++ks){
      asm volatile("ds_read_b64_tr_b16 %0,%1 offset:%c2":"=&v"(lo[ks]):"v"(vb),"i"(d0*4096+ks*1024):"memory");
      asm volatile("ds_read_b64_tr_b16 %0,%1 offset:%c2":"=&v"(hi[ks]):"v"(vb),"i"(d0*4096+ks*1024+512):"memory");}
    asm volatile("s_waitcnt lgkmcnt(0)":::"memory");SBAR();
    #define PK(k) (bf16x8){lo[k][0],lo[k][1],lo[k][2],lo[k][3],hi[k][0],hi[k][1],hi[k][2],hi[k][3]}
    o[d0]=__builtin_amdgcn_mfma_f32_32x32x16_bf16(pa0,PK(0),o[d0],0,0,0);
    o[d0]=__builtin_amdgcn_mfma_f32_32x32x16_bf16(pa1,PK(1),o[d0],0,0,0);
    o[d0]=__builtin_amdgcn_mfma_f32_32x32x16_bf16(pa2,PK(2),o[d0],0,0,0);
    o[d0]=__builtin_amdgcn_mfma_f32_32x32x16_bf16(pa3,PK(3),o[d0],0,0,0);
    #undef PK
  }
}
template<int THRL> __device__ __forceinline__ void attn_unit(const bf16*Qw,const bf16*__restrict__ Kh,const bf16*__restrict__ Vh,bf16*Ow,char*shm){
  const int tid=threadIdx.x,lane=tid&63,r32=lane&31,hi=lane>>5; const int wid=__builtin_amdgcn_readfirstlane(tid>>6);
  constexpr int DMp=PITCH;
  const unsigned lds0=(unsigned)(uintptr_t)shm;
  float*wsf=(float*)(shm+LDS_WS)+wid*64;
  const bf16*ksrc=Kh+(long)lane*DMp+wid*8;
  const bf16*vsrc=Vh+(long)(16*(wid&3)+(lane>>2))*DMp+(wid>>2)*32+(lane&3)*8;
  const unsigned kdst=lds0+LDS_K+wid*1024, vdst=lds0+LDS_V+wid*1024;
  #define DMA_K(t,slot) glds16(ksrc+(long)(t)*KVBLK*DMp,(unsigned)__builtin_amdgcn_readfirstlane(kdst+(slot)))
  #define DMA_V(t,slot) glds16(vsrc+(long)(t)*KVBLK*DMp,(unsigned)__builtin_amdgcn_readfirstlane(vdst+(slot)))
  const int vb0=(int)(lds0+LDS_V)+((lane>>4)&1)*32+(lane&3)*8+(4*hi+((lane&15)>>2))*64;
  const char*Kbase=shm+LDS_K; bf16x8 kf[8];
  const lds_cptr shm3=(lds_cptr)shm; const lds_cptr kp0=shm3+LDS_K+hi*1024+r32*16; const lds_cptr vp0=shm3+LDS_V+((lane>>4)&1)*32+(lane&3)*8+(4*hi+((lane&15)>>2))*64;
  DMA_K(0,0);DMA_V(0,0);DMA_K(1,SLOTB);
  bf16x8 qr[4];
  #pragma unroll
  for(int d0=0;d0<4;++d0)qr[d0]=*reinterpret_cast<const bf16x8*>(&Qw[(long)r32*DMp+d0*16+hi*8]);
  float mhat=0.f,l_reg=0.f;f32x16 o[2];o[0]=f32x16{};o[1]=f32x16{};f32x16 negm=f32x16{};asm volatile("":"+v"(negm));
  bool resc=false;
  #define START(P0,P1) do{ const float rm=rowmax(P0,P1); resc=false; \
    { const float dl=rm; mhat=fadd_s(mhat,dl); \
      _Pragma("unroll") for(int r=0;r<16;++r){P0[r]=fsub_s(P0[r],dl);P1[r]=fsub_s(P1[r],dl);} \
      _Pragma("unroll") for(int r=0;r<16;++r)negm[r]=-mhat; asm volatile("":"+v"(negm)); } \
    _Pragma("unroll") for(int r=0;r<16;++r)P0[r]=__builtin_amdgcn_exp2f(P0[r]); }while(0)
  #define RESC() do{ if(resc){ asm volatile("s_waitcnt lgkmcnt(0)":::"memory"); \
      _Pragma("unroll") for(int d_=0;d_<2;++d_) _Pragma("unroll") for(int r=0;r<16;++r)o[d_][r]*=wsf[crow(r,hi)]; } }while(0)
  f32x16 pA0,pA1,pB0,pB1;
  int sl_prev=0,sl_cur=0,sl_next=SLOTB;
  #define ROT() do{sl_prev=sl_cur;sl_cur=sl_next;sl_next=(sl_next==(NSLOT-1)*SLOTB)?0:sl_next+SLOTB;}while(0)
  DMA_K(2,2*SLOTB);
  WAIT_BAR(3);
  qkt(pA0,pA1,Kbase,qr,negm,r32,hi);asm volatile("s_nop 15\n\ts_nop 7":"+v"(pA0),"+v"(pA1));
  START(pA0,pA1);
  _Pragma("unroll") for(int r=0;r<16;++r)pA1[r]=__builtin_amdgcn_exp2f(pA1[r]);
  WAIT_BAR(0);
  DMA_K(3,0);DMA_V(1,SLOTB);
  ROT();
  kload8(kf,kp0+sl_cur);
  WAIT_BAR(2);
  s16x4 vlo[8],vhi[8]; u32x4 pw0,pw1,pw2,pw3;
  #define PKW(P,B) cvtpk_s(P[B],P[B+1])
  #define PAF(k) __builtin_bit_cast(bf16x8,pw##k)
  #define VFR(i) (bf16x8){vlo[i][0],vlo[i][1],vlo[i][2],vlo[i][3],vhi[i][0],vhi[i][1],vhi[i][2],vhi[i][3]}
  #define PIN(x) asm volatile("":"+v"(x))
  #define MX3(a,b,c) __builtin_fmaxf(__builtin_fmaxf((a),(b)),(c))
  #define GAPA(MF,A0,A1,A2,A3,W0,W1,PW) do{ MF; sacc+=A0; sacc+=A1; sacc+=A2; sacc+=A3; PIN(sacc); W0; W1; PIN(PW); SBAR(); }while(0)
  #define EX(v) __builtin_amdgcn_exp2f(v)
  #define GAPB(MF,X,B) do{ MF; X[B]=EX(X[B]); X[B+1]=EX(X[B+1]); X[B+2]=EX(X[B+2]); X[B+3]=EX(X[B+3]); PIN(X); SBAR(); }while(0)
  #define VRD(i) do{ vlo[i]=vtr(vp_+(((i)>>2)*4096+((i)&3)*1024)); vhi[i]=vtr(vp_+(((i)>>2)*4096+((i)&3)*1024+512)); }while(0)
  #define KRD(G,j) do{ if(G){ kload2(kf,kp0+sl_next,j); SBAR(); } }while(0)
  #define STEP(C0,C1,P0,P1,t,GK,GV,GL) do{ SBAR(); \
    const lds_cptr vp_=vp0+sl_prev; \
    VRD(0); SBAR(); float sacc=(P0[0]+P0[1]); \
    GAPA(C0=__builtin_amdgcn_mfma_f32_32x32x16_bf16(kf[0],qr[0],negm,0,0,0), P0[2],P0[3],P0[4],P0[5],     pw0[0]=PKW(P0,0), pw0[1]=PKW(P0,2), pw0); \
    VRD(4); SBAR(); GAPA(C1=__builtin_amdgcn_mfma_f32_32x32x16_bf16(kf[1],qr[0],negm,0,0,0), P0[6],P0[7],P0[8],P0[9],     pw0[2]=PKW(P0,4), pw0[3]=PKW(P0,6), pw0); \
    VRD(1); SBAR(); GAPA(C0=__builtin_amdgcn_mfma_f32_32x32x16_bf16(kf[2],qr[1],C0,0,0,0),   P0[10],P0[11],P0[12],P0[13], pw1[0]=PKW(P0,8), pw1[1]=PKW(P0,10), pw1); \
    VRD(5); SBAR(); GAPA(C1=__builtin_amdgcn_mfma_f32_32x32x16_bf16(kf[3],qr[1],C1,0,0,0),   P0[14],P0[15],P1[0],P1[1],   pw1[2]=PKW(P0,12),pw1[3]=PKW(P0,14), pw1); \
    VRD(2); SBAR(); GAPA(C0=__builtin_amdgcn_mfma_f32_32x32x16_bf16(kf[4],qr[2],C0,0,0,0),   P1[2],P1[3],P1[4],P1[5],     pw2[0]=PKW(P1,0), pw2[1]=PKW(P1,2), pw2); \
    VRD(6); SBAR(); GAPA(C1=__builtin_amdgcn_mfma_f32_32x32x16_bf16(kf[5],qr[2],C1,0,0,0),   P1[6],P1[7],P1[8],P1[9],     pw2[2]=PKW(P1,4), pw2[3]=PKW(P1,6), pw2); \
    VRD(3); SBAR(); GAPA(C0=__builtin_amdgcn_mfma_f32_32x32x16_bf16(kf[6],qr[3],C0,0,0,0),   P1[10],P1[11],P1[12],P1[13], pw3[0]=PKW(P1,8), pw3[1]=PKW(P1,10), pw3); \
    VRD(7); SBAR(); GAPA(C1=__builtin_amdgcn_mfma_f32_32x32x16_bf16(kf[7],qr[3],C1,0,0,0),   P1[14],P1[15],0.f,0.f,       pw3[2]=PKW(P1,12),pw3[3]=PKW(P1,14), pw3); \
    l_reg+=sacc; \
    if(GK){DMA_K((t)+3,sl_cur);} if(GV){DMA_V((t)+1,sl_next);} \
    { float a=MX3(C0[0],C0[1],C1[0]),b=MX3(C0[2],C0[3],C1[1]); a=MX3(a,C1[2],C1[3]); \
      _Pragma("unroll") for(int r=4;r<16;r+=4){a=MX3(a,C0[r],C0[r+1]);b=MX3(b,C0[r+2],C0[r+3]);a=MX3(a,C1[r],C1[r+1]);b=MX3(b,C1[r+2],C1[r+3]);} \
      float rm=__builtin_fmaxf(a,b); { auto rr=__builtin_amdgcn_permlane32_swap(__float_as_uint(rm),__float_as_uint(rm),false,false); rm=__builtin_fmaxf(__uint_as_float(rr[0]),__uint_as_float(rr[1])); } \
      resc=false; \
      if(__builtin_expect(__any(rm>(float)THRL),0)){ const float dl=__builtin_fmaxf(rm,0.f); mhat+=dl; \
        _Pragma("unroll") for(int r=0;r<16;++r){C0[r]-=dl;C1[r]-=dl;} \
        _Pragma("unroll") for(int r=0;r<16;++r)negm[r]=-mhat; asm volatile("":"+v"(negm)); \
        const float f=__builtin_amdgcn_exp2f(-dl); l_reg*=f; if(hi==0)wsf[r32]=f; resc=true; } } \
    SBAR(); \
    GAPB(o[0]=__builtin_amdgcn_mfma_f32_32x32x16_bf16(PAF(0),VFR(0),o[0],0,0,0), C0,0); \
    GAPB(o[1]=__builtin_amdgcn_mfma_f32_32x32x16_bf16(PAF(0),VFR(4),o[1],0,0,0), C0,4); \
    KRD(GL,0); GAPB(o[0]=__builtin_amdgcn_mfma_f32_32x32x16_bf16(PAF(1),VFR(1),o[0],0,0,0), C0,8); \
    KRD(GL,1); GAPB(o[1]=__builtin_amdgcn_mfma_f32_32x32x16_bf16(PAF(1),VFR(5),o[1],0,0,0), C0,12); \
    KRD(GL,2); GAPB(o[0]=__builtin_amdgcn_mfma_f32_32x32x16_bf16(PAF(2),VFR(2),o[0],0,0,0), C1,0); \
    KRD(GL,3); GAPB(o[1]=__builtin_amdgcn_mfma_f32_32x32x16_bf16(PAF(2),VFR(6),o[1],0,0,0), C1,4); \
    GAPB(o[0]=__builtin_amdgcn_mfma_f32_32x32x16_bf16(PAF(3),VFR(3),o[0],0,0,0), C1,8); \
    GAPB(o[1]=__builtin_amdgcn_mfma_f32_32x32x16_bf16(PAF(3),VFR(7),o[1],0,0,0), C1,12); \
    }while(0)
  int t=1;
  for(;t+5<NT;t+=2){
    STEP(pB0,pB1,pA0,pA1,t,true,true,true);     WAIT_BAR(2); RESC(); ROT();
    STEP(pA0,pA1,pB0,pB1,t+1,true,true,true);   WAIT_BAR(2); RESC(); ROT();
  }
  #define ENDW(tt) do{ if((tt)+3<NT){WAIT_BAR(2);} else if((tt)+2<NT){WAIT_BAR(1);} else {WAIT_BAR(0);} }while(0)
  for(;t+1<NT;t+=2){
    STEP(pB0,pB1,pA0,pA1,t,(t+3<NT),(t+1<NT),(t+1<NT));       ENDW(t);   RESC(); ROT();
    STEP(pA0,pA1,pB0,pB1,t+1,(t+4<NT),(t+2<NT),(t+2<NT));     ENDW(t+1); RESC(); ROT();
  }
  STEP(pB0,pB1,pA0,pA1,NT-1,false,false,false); RESC();
  { float sacc=pB0[0]+pB0[1]; _Pragma("unroll") for(int r=2;r<16;++r)sacc+=pB0[r]; _Pragma("unroll") for(int r=0;r<16;++r)sacc+=pB1[r]; l_reg+=sacc;
    pw0=(u32x4){PKW(pB0,0),PKW(pB0,2),PKW(pB0,4),PKW(pB0,6)};pw1=(u32x4){PKW(pB0,8),PKW(pB0,10),PKW(pB0,12),PKW(pB0,14)};pw2=(u32x4){PKW(pB1,0),PKW(pB1,2),PKW(pB1,4),PKW(pB1,6)};pw3=(u32x4){PKW(pB1,8),PKW(pB1,10),PKW(pB1,12),PKW(pB1,14)};
    SBAR(); pv(o,vb0+sl_cur,PAF(0),PAF(1),PAF(2),PAF(3)); }
  #undef PKW
  #undef PAF
  #undef VFR
  #undef PIN
  #undef MX3
  #undef GAPA
  #undef GAPB
  #undef EX
  #undef VRD
  #undef KRD
  #undef STEP
  #undef ENDW
  {auto rr=__builtin_amdgcn_permlane32_swap(__float_as_uint(l_reg),__float_as_uint(l_reg),false,false);l_reg=__uint_as_float(rr[0])+__uint_as_float(rr[1]);}
  if(hi==0)wsf[32+r32]=l_reg;asm volatile("s_waitcnt lgkmcnt(0)":::"memory");
  float rli[16];
  #pragma unroll
  for(int r=0;r<16;++r)rli[r]=__builtin_amdgcn_rcpf(wsf[32+crow(r,hi)]);
  { bf16*stg=(bf16*)(shm+LDS_OST)+wid*2048;
    #pragma unroll
    for(int r=0;r<16;++r){const int orow=crow(r,hi);
      #pragma unroll
      for(int d0=0;d0<2;++d0)stg[orow*64+d0*32+r32]=__float2bfloat16(o[d0][r]*rli[r]);}
    asm volatile("s_waitcnt lgkmcnt(0)":::"memory");
    #pragma unroll
    for(int i=0;i<4;++i){const int row=i*8+(lane>>3),ch=lane&7; const u32x4 v=*(const u32x4*)(stg+row*64+ch*8); *(u32x4*)(Ow+(long)row*DMp+ch*8)=v;} }
  asm volatile("s_waitcnt lgkmcnt(0)\n\ts_barrier":::"memory");
  #undef DMA_K
  #undef DMA_V
  #undef START
  #undef RESC
  #undef ROT
}

constexpr int VSLOTB=16384;
constexpr int L2_K=0, L2_V=NSLOT*SLOTB, L2_WS=L2_V+NSLOT*VSLOTB, L2_OST=L2_WS+NW*64*4, L2_BYTES=L2_OST+NW*4096;
template<int THRL> __device__ __forceinline__ void attn_unit128(const bf16*Qw,const bf16*__restrict__ Kh,const bf16*__restrict__ Vh,bf16*Ow,char*shm){
  const int tid=threadIdx.x,lane=tid&63,r32=lane&31,hi=lane>>5; const int wid=__builtin_amdgcn_readfirstlane(tid>>6);
  constexpr int DMp=PITCH;
  const unsigned lds0=(unsigned)(uintptr_t)shm;
  float*wsf=(float*)(shm+L2_WS)+wid*64;
  const unsigned koff=(unsigned)(lane*DMp+wid*8)*2u;
  const unsigned voff=(unsigned)((16*(wid&3)+(lane>>2))*DMp+(wid>>2)*32+(lane&3)*8)*2u;
  const unsigned kdst=lds0+L2_K+wid*1024, vdst=lds0+L2_V+wid*1024;
  #define DMA_K(t,slot) glds16s((const char*)Kh+(long)(t)*KVBLK*DMp*2,koff,(unsigned)__builtin_amdgcn_readfirstlane(kdst+(slot)))
  #define DMA_V(t,slot) do{ glds16s((const char*)Vh+(long)(t)*KVBLK*DMp*2,voff,(unsigned)__builtin_amdgcn_readfirstlane(vdst+2*(slot))); glds16s((const char*)Vh+(long)(t)*KVBLK*DMp*2+128,voff,(unsigned)__builtin_amdgcn_readfirstlane(vdst+2*(slot)+8192)); }while(0)
  const char*Kbase=shm+L2_K; bf16x8 kf[8];
  const lds_cptr shm3=(lds_cptr)shm; const lds_cptr kp0=shm3+L2_K+hi*1024+r32*16; const lds_cptr vp0=shm3+L2_V+((lane>>4)&1)*32+(lane&3)*8+(4*hi+((lane&15)>>2))*64;
  DMA_K(0,0);DMA_V(0,0);DMA_K(1,SLOTB);
  bf16x8 qr[4];
  #pragma unroll
  for(int d0=0;d0<4;++d0)qr[d0]=*reinterpret_cast<const bf16x8*>(&Qw[(long)r32*DMp+d0*16+hi*8]);
  float mhat=0.f,l_reg=0.f;f32x16 o[4];o[0]=f32x16{};o[1]=f32x16{};o[2]=f32x16{};o[3]=f32x16{};f32x16 negm=f32x16{};asm volatile("":"+v"(negm));
  bool resc=false;
  #define RESC() do{ if(resc){ asm volatile("s_waitcnt lgkmcnt(0)":::"memory"); \
      _Pragma("unroll") for(int d_=0;d_<4;++d_) _Pragma("unroll") for(int r=0;r<16;++r)o[d_][r]*=wsf[crow(r,hi)]; } }while(0)
  f32x16 c0,c1; u32x4 pw0,pw1,pw2,pw3;
  int sl_prev=0,sl_cur=0,sl_next=SLOTB;
  #define ROT() do{sl_prev=sl_cur;sl_cur=sl_next;sl_next=(sl_next==(NSLOT-1)*SLOTB)?0:sl_next+SLOTB;}while(0)
  #define PKW(P,B) cvtpk_s(P[B],P[B+1])
  #define PAF(k) __builtin_bit_cast(bf16x8,pw##k)
  DMA_K(2,2*SLOTB);
  WAIT_BAR(4);
  qkt(c0,c1,Kbase,qr,negm,r32,hi);asm volatile("s_nop 15\n\ts_nop 7":"+v"(c0),"+v"(c1));
  { const float rm=rowmax(c0,c1); mhat=fadd_s(mhat,rm);
    _Pragma("unroll") for(int r=0;r<16;++r){c0[r]=fsub_s(c0[r],rm);c1[r]=fsub_s(c1[r],rm);}
    _Pragma("unroll") for(int r=0;r<16;++r)negm[r]=-mhat; asm volatile("":"+v"(negm));
    _Pragma("unroll") for(int r=0;r<16;++r){c0[r]=__builtin_amdgcn_exp2f(c0[r]);c1[r]=__builtin_amdgcn_exp2f(c1[r]);}
    float sacc=c0[0]+c0[1]; _Pragma("unroll") for(int r=2;r<16;++r)sacc+=c0[r]; _Pragma("unroll") for(int r=0;r<16;++r)sacc+=c1[r]; l_reg+=sacc;
    pw0=(u32x4){PKW(c0,0),PKW(c0,2),PKW(c0,4),PKW(c0,6)};pw1=(u32x4){PKW(c0,8),PKW(c0,10),PKW(c0,12),PKW(c0,14)};pw2=(u32x4){PKW(c1,0),PKW(c1,2),PKW(c1,4),PKW(c1,6)};pw3=(u32x4){PKW(c1,8),PKW(c1,10),PKW(c1,12),PKW(c1,14)}; }
  WAIT_BAR(0);
  DMA_K(3,0);DMA_V(1,SLOTB);
  ROT();
  kload8(kf,kp0+sl_cur);
  WAIT_BAR(3);
  s16x4 vlo[8],vhi[8];
  #define VFR(i) (bf16x8){vlo[i][0],vlo[i][1],vlo[i][2],vlo[i][3],vhi[i][0],vhi[i][1],vhi[i][2],vhi[i][3]}
  #define PIN(x) asm volatile("":"+v"(x))
  #define MX3(a,b,c) __builtin_fmaxf(__builtin_fmaxf((a),(b)),(c))
  #define EX(v) __builtin_amdgcn_exp2f(v)
  #define VRD(H,i) do{ vlo[i]=vtr(vp_+((2*(H)+((i)>>2))*4096+((i)&3)*1024)); vhi[i]=vtr(vp_+((2*(H)+((i)>>2))*4096+((i)&3)*1024+512)); }while(0)
  #define KRD(G,j) do{ if(G){ kload2(kf,kp0+sl_next,j); SBAR(); } }while(0)
  #define GAPA(MF) do{ MF; SBAR(); }while(0)
  #define GAPB(MF,X,B,VR) do{ MF; X[B]=EX(X[B]); X[B+1]=EX(X[B+1]); X[B+2]=EX(X[B+2]); X[B+3]=EX(X[B+3]); PIN(X); VR; SBAR(); }while(0)
  #define GAPC(MF,X,B) do{ MF; sacc+=X[B]; sacc+=X[B+1]; sacc+=X[B+2]; sacc+=X[B+3]; PIN(sacc); SBAR(); }while(0)
  #define GAPCE(MF,X,B,Y,D) do{ MF; sacc+=X[B]; sacc+=X[B+1]; sacc+=X[B+2]; sacc+=X[B+3]; PIN(sacc); Y[D]=EX(Y[D]); Y[D+1]=EX(Y[D+1]); Y[D+2]=EX(Y[D+2]); Y[D+3]=EX(Y[D+3]); PIN(Y); SBAR(); }while(0)
  #define STEP(t,GK,GV,GL) do{ SBAR(); \
    const lds_cptr vp_=vp0+2*sl_prev; \
      \
    VRD(0,0); SBAR(); GAPA(c0=__builtin_amdgcn_mfma_f32_32x32x16_bf16(kf[0],qr[0],negm,0,0,0)); \
    VRD(0,4); SBAR(); GAPA(c1=__builtin_amdgcn_mfma_f32_32x32x16_bf16(kf[1],qr[0],negm,0,0,0)); \
    VRD(0,1); SBAR(); GAPA(c0=__builtin_amdgcn_mfma_f32_32x32x16_bf16(kf[2],qr[1],c0,0,0,0)); \
    VRD(0,5); SBAR(); GAPA(c1=__builtin_amdgcn_mfma_f32_32x32x16_bf16(kf[3],qr[1],c1,0,0,0)); \
    VRD(0,2); SBAR(); GAPA(c0=__builtin_amdgcn_mfma_f32_32x32x16_bf16(kf[4],qr[2],c0,0,0,0)); \
    VRD(0,6); SBAR(); GAPA(c1=__builtin_amdgcn_mfma_f32_32x32x16_bf16(kf[5],qr[2],c1,0,0,0)); \
    VRD(0,3); SBAR(); GAPA(c0=__builtin_amdgcn_mfma_f32_32x32x16_bf16(kf[6],qr[3],c0,0,0,0)); \
    VRD(0,7); SBAR(); GAPA(c1=__builtin_amdgcn_mfma_f32_32x32x16_bf16(kf[7],qr[3],c1,0,0,0)); \
    if(GK){DMA_K((t)+3,sl_cur);} if(GV){DMA_V((t)+1,sl_next);} \
    SBAR(); \
      \
    float mxa,mxb,rm_; \
    o[0]=__builtin_amdgcn_mfma_f32_32x32x16_bf16(PAF(0),VFR(0),o[0],0,0,0); \
    { mxa=MX3(c0[0],c0[1],c0[2]); mxb=MX3(c0[3],c0[4],c0[5]); mxa=MX3(mxa,c0[6],c0[7]); mxb=MX3(mxb,c0[8],c0[9]); mxa=MX3(mxa,c0[10],c0[11]); mxb=MX3(mxb,c0[12],c0[13]); mxa=MX3(mxa,c0[14],c0[15]); } VRD(1,0); SBAR(); \
    o[1]=__builtin_amdgcn_mfma_f32_32x32x16_bf16(PAF(0),VFR(4),o[1],0,0,0); \
    { mxb=MX3(mxb,c1[0],c1[1]); mxa=MX3(mxa,c1[2],c1[3]); mxb=MX3(mxb,c1[4],c1[5]); mxa=MX3(mxa,c1[6],c1[7]); mxb=MX3(mxb,c1[8],c1[9]); mxa=MX3(mxa,c1[10],c1[11]); mxb=MX3(mxb,c1[12],c1[13]); mxa=MX3(mxa,c1[14],c1[15]); \
      rm_=__builtin_fmaxf(mxa,mxb); { auto rr=__builtin_amdgcn_permlane32_swap(__float_as_uint(rm_),__float_as_uint(rm_),false,false); rm_=__builtin_fmaxf(__uint_as_float(rr[0]),__uint_as_float(rr[1])); } } VRD(1,4); SBAR(); \
    o[0]=__builtin_amdgcn_mfma_f32_32x32x16_bf16(PAF(1),VFR(1),o[0],0,0,0); \
    { resc=false; \
      if(__builtin_expect(__any(rm_>(float)THRL),0)){ const float dl=__builtin_fmaxf(rm_,0.f); mhat+=dl; \
        _Pragma("unroll") for(int r=0;r<16;++r){c0[r]-=dl;c1[r]-=dl;} \
        _Pragma("unroll") for(int r=0;r<16;++r)negm[r]=-mhat; asm volatile("":"+v"(negm)); \
        const float f=__builtin_amdgcn_exp2f(-dl); l_reg*=f; if(hi==0)wsf[r32]=f; resc=true; } } VRD(1,1); SBAR(); \
    GAPB(o[1]=__builtin_amdgcn_mfma_f32_32x32x16_bf16(PAF(1),VFR(5),o[1],0,0,0), c0,0,  VRD(1,5)); \
    GAPB(o[0]=__builtin_amdgcn_mfma_f32_32x32x16_bf16(PAF(2),VFR(2),o[0],0,0,0), c0,4,  VRD(1,2)); \
    GAPB(o[1]=__builtin_amdgcn_mfma_f32_32x32x16_bf16(PAF(2),VFR(6),o[1],0,0,0), c0,8,  VRD(1,6)); \
    GAPB(o[0]=__builtin_amdgcn_mfma_f32_32x32x16_bf16(PAF(3),VFR(3),o[0],0,0,0), c0,12, VRD(1,3)); \
    GAPB(o[1]=__builtin_amdgcn_mfma_f32_32x32x16_bf16(PAF(3),VFR(7),o[1],0,0,0), c1,0,  VRD(1,7)); \
      \
    float sacc=0.f; \
    GAPCE(o[2]=__builtin_amdgcn_mfma_f32_32x32x16_bf16(PAF(0),VFR(0),o[2],0,0,0), c0,0, c1,4); \
    GAPCE(o[3]=__builtin_amdgcn_mfma_f32_32x32x16_bf16(PAF(0),VFR(4),o[3],0,0,0), c0,4, c1,8); \
    pw0[0]=PKW(c0,0); pw0[1]=PKW(c0,2); pw0[2]=PKW(c0,4); pw0[3]=PKW(c0,6); PIN(pw0); SBAR(); \
    KRD(GL,0); GAPCE(o[2]=__builtin_amdgcn_mfma_f32_32x32x16_bf16(PAF(1),VFR(1),o[2],0,0,0), c0,8, c1,12); \
    KRD(GL,1); GAPC(o[3]=__builtin_amdgcn_mfma_f32_32x32x16_bf16(PAF(1),VFR(5),o[3],0,0,0), c0,12); \
    pw1[0]=PKW(c0,8); pw1[1]=PKW(c0,10); pw1[2]=PKW(c0,12); pw1[3]=PKW(c0,14); PIN(pw1); SBAR(); \
    KRD(GL,2); GAPC(o[2]=__builtin_amdgcn_mfma_f32_32x32x16_bf16(PAF(2),VFR(2),o[2],0,0,0), c1,0); \
    KRD(GL,3); GAPC(o[3]=__builtin_amdgcn_mfma_f32_32x32x16_bf16(PAF(2),VFR(6),o[3],0,0,0), c1,4); \
    pw2[0]=PKW(c1,0); pw2[1]=PKW(c1,2); pw2[2]=PKW(c1,4); pw2[3]=PKW(c1,6); PIN(pw2); SBAR(); \
    GAPC(o[2]=__builtin_amdgcn_mfma_f32_32x32x16_bf16(PAF(3),VFR(3),o[2],0,0,0), c1,8); \
    GAPC(o[3]=__builtin_amdgcn_mfma_f32_32x32x16_bf16(PAF(3),VFR(7),o[3],0,0,0), c1,12); \
    pw3[0]=PKW(c1,8); pw3[1]=PKW(c1,10); pw3[2]=PKW(c1,12); pw3[3]=PKW(c1,14); PIN(pw3); SBAR(); \
    l_reg+=sacc; \
    }while(0)
  int t=1;
  for(;t+5<NT;t+=2){
    STEP(t,true,true,true);     WAIT_BAR(3); RESC(); ROT();
    STEP(t+1,true,true,true);   WAIT_BAR(3); RESC(); ROT();
  }
  #define ENDW(tt) do{ if((tt)+3<NT){WAIT_BAR(3);} else if((tt)+2<NT){WAIT_BAR(2);} else {WAIT_BAR(0);} }while(0)
  for(;t+1<NT;t+=2){
    STEP(t,(t+3<NT),(t+1<NT),(t+1<NT));       ENDW(t);   RESC(); ROT();
    STEP(t+1,(t+4<NT),(t+2<NT),(t+2<NT));     ENDW(t+1); RESC(); ROT();
  }
  STEP(NT-1,false,false,false); RESC();
  { int lane_=threadIdx.x&63; asm volatile("":"+v"(lane_));
    const int vb=(int)(lds0+L2_V)+((lane_>>4)&1)*32+(lane_&3)*8+(4*(lane_>>5)+((lane_&15)>>2))*64+2*sl_cur;
    #pragma unroll
    for(int d0=0;d0<4;++d0){s16x4 lo[4],hh[4];
      #pragma unroll
      for(int ks=0;ks<4;++ks){
        asm volatile("ds_read_b64_tr_b16 %0,%1 offset:%c2":"=&v"(lo[ks]):"v"(vb),"i"(d0*4096+ks*1024):"memory");
        asm volatile("ds_read_b64_tr_b16 %0,%1 offset:%c2":"=&v"(hh[ks]):"v"(vb),"i"(d0*4096+ks*1024+512):"memory");}
      asm volatile("s_waitcnt lgkmcnt(0)":::"memory");SBAR();
      #define PK(k) (bf16x8){lo[k][0],lo[k][1],lo[k][2],lo[k][3],hh[k][0],hh[k][1],hh[k][2],hh[k][3]}
      o[d0]=__builtin_amdgcn_mfma_f32_32x32x16_bf16(PAF(0),PK(0),o[d0],0,0,0);
      o[d0]=__builtin_amdgcn_mfma_f32_32x32x16_bf16(PAF(1),PK(1),o[d0],0,0,0);
      o[d0]=__builtin_amdgcn_mfma_f32_32x32x16_bf16(PAF(2),PK(2),o[d0],0,0,0);
      o[d0]=__builtin_amdgcn_mfma_f32_32x32x16_bf16(PAF(3),PK(3),o[d0],0,0,0);
      #undef PK
    } }
  #undef PKW
  #undef PAF
  #undef VFR
  #undef PIN
  #undef MX3
  #undef GAPA
  #undef GAPB
  #undef GAPC
  #undef GAPCE
  #undef EX
  #undef VRD
  #undef KRD
  #undef STEP
  #undef ENDW
  {auto rr=__builtin_amdgcn_permlane32_swap(__float_as_uint(l_reg),__float_as_uint(l_reg),false,false);l_reg=__uint_as_float(rr[0])+__uint_as_float(rr[1]);}
  if(hi==0)wsf[32+r32]=l_reg;asm volatile("s_waitcnt lgkmcnt(0)":::"memory");
  float rli[16];
  #pragma unroll
  for(int r=0;r<16;++r)rli[r]=__builtin_amdgcn_rcpf(wsf[32+crow(r,hi)]);
  { bf16*stg=(bf16*)(shm+L2_OST)+wid*2048;
    #pragma unroll
    for(int hf=0;hf<2;++hf){
      #pragma unroll
      for(int r=0;r<16;++r){const int orow=crow(r,hi);
        #pragma unroll
        for(int d0=0;d0<2;++d0)stg[orow*64+d0*32+r32]=__float2bfloat16(o[2*hf+d0][r]*rli[r]);}
      asm volatile("s_waitcnt lgkmcnt(0)":::"memory");
      #pragma unroll
      for(int i=0;i<4;++i){const int row=i*8+(lane>>3),ch=lane&7; const u32x4 v=*(const u32x4*)(stg+row*64+ch*8); *(u32x4*)(Ow+(long)row*DMp+hf*64+ch*8)=v;}
      asm volatile("s_waitcnt lgkmcnt(0)":::"memory"); } }
  asm volatile("s_waitcnt lgkmcnt(0)\n\ts_barrier":::"memory");
  #undef DMA_K
  #undef DMA_V
  #undef RESC
  #undef ROT
}
#undef SBAR
#undef WAIT_BAR
}

constexpr int NWAVES = 8, LDS_BYTES = 147456, RING_BYTES = 131072;
struct Params { const float* in[32]; float* out; unsigned char* ws; int ph_lo, ph_hi; };
enum { I_X = 0, I_C, I_CTX, I_CCTX, I_ADAW, I_ADAB, I_NMIXG, I_NFFNG, I_WIN, I_CONVW, I_CONVB, I_LRUWA, I_LRUBA, I_LRUWX, I_LRUBX, I_LRULAM, I_CMVG, I_CMWS, I_CMBS, I_WOUT0,
       I_WQKV, I_LQ1, I_LK1, I_LQ2, I_LK2, I_SUBLN, I_WOUT1, I_ROUTER, I_W1, I_W3, I_W2, I_FINALG };

typedef const __attribute__((address_space(4))) Params* KParams;
__device__ __forceinline__ Params kparams() {
#if defined(__HIP_DEVICE_COMPILE__)
    KParams q = (KParams)__builtin_amdgcn_kernarg_segment_ptr(); asm volatile("" : "+s"(q)); return *q;
#else
    return Params{};
#endif
}
struct Ctx {
    LAS unsigned char* lds; int tid, lane, wave, vcu, G;
};
__device__ __forceinline__ float wave_sum(float v) {
#pragma unroll
    for (int o = 1; o < 64; o <<= 1) v += __shfl_xor(v, o);
    return v;
}
#define LDS_WAIT() asm volatile("s_waitcnt lgkmcnt(0)" ::: "memory")

__device__ __forceinline__ int dest_row(int n, int mode) {
    if (mode == 1) return n < 2048 ? ((n & ~63) + 2 * (n & 31) + ((n >> 5) & 1)) : n;
    if (mode == 2) return 32 * (n >> 4) + (n & 15);
    if (mode == 3) return 32 * (n >> 4) + 16 + (n & 15);
    return n;
}
__device__ __forceinline__ void p0_transpose_item(const float* W, int K, int N, bf16_t* WT, int mode, LAS float* scr, int item, int lane) {
    const int nblk = N / 32, kb = item / nblk, nb = item % nblk, k0 = 64 * kb, n0 = 32 * nb;
    float tv[32];
#pragma unroll
    for (int i = 0; i < 32; ++i) { const int kk = 2 * i + (lane >> 5); tv[i] = __builtin_nontemporal_load(&W[(size_t)(k0 + kk) * N + n0 + (lane & 31)]); }
#pragma unroll
    for (int i = 0; i < 32; ++i) { const int kk = 2 * i + (lane >> 5); scr[kk * 33 + (lane & 31)] = tv[i]; }
    LDS_WAIT(); asm volatile("" ::: "memory");
    const int c = lane & 7;
#pragma unroll
    for (int j = 0; j < 4; ++j) { const int n = (lane >> 3) + 8 * j; const LAS float* s = scr + (8 * c) * 33 + n;
        u32x4 o; o.x = pk2(s[0 * 33], s[1 * 33]); o.y = pk2(s[2 * 33], s[3 * 33]); o.z = pk2(s[4 * 33], s[5 * 33]); o.w = pk2(s[6 * 33], s[7 * 33]);
        *(GAS u32x4*)(WT + (size_t)dest_row(n0 + n, mode) * K + k0 + 8 * c) = o; }
    LDS_WAIT(); asm volatile("" ::: "memory");
}
__device__ __forceinline__ void p0_transpose_item8(const float* W, int K, int N, unsigned char* WT, int mode, LAS float* scr, int item, int lane) {
    const int nblk = N / 32, kb = item / nblk, nb = item % nblk, k0 = 64 * kb, n0 = 32 * nb;
    float tv[32];
#pragma unroll
    for (int i = 0; i < 32; ++i) { const int kk = 2 * i + (lane >> 5); tv[i] = __builtin_nontemporal_load(&W[(size_t)(k0 + kk) * N + n0 + (lane & 31)]); }
#pragma unroll
    for (int i = 0; i < 32; ++i) { const int kk = 2 * i + (lane >> 5); scr[kk * 33 + (lane & 31)] = tv[i] * W8_SCALE; }
    LDS_WAIT(); asm volatile("" ::: "memory");
    const int c = lane & 7;
#pragma unroll
    for (int j = 0; j < 4; ++j) { const int n = (lane >> 3) + 8 * j; const LAS float* sp = scr + (8 * c) * 33 + n;
        u32x2 o; o.x = f2fp8x4(sp[0 * 33], sp[1 * 33], sp[2 * 33], sp[3 * 33]); o.y = f2fp8x4(sp[4 * 33], sp[5 * 33], sp[6 * 33], sp[7 * 33]);
        *(GAS u32x2*)(WT + (size_t)dest_row(n0 + n, mode) * K + k0 + 8 * c) = o; }
    LDS_WAIT(); asm volatile("" ::: "memory");
}
constexpr int I_MOE = 1024, N_MOE_ITEMS = 3 * 32 * I_MOE, DEFER_PER_WAVE = 4;
__device__ __forceinline__ int defer_a(int G) { return G >= 128 ? (G - 64) * NWAVES * DEFER_PER_WAVE : 0; }
__device__ __forceinline__ int defer_b(int G) { return G >= 128 ? (G - 32) * NWAVES * DEFER_PER_WAVE : 0; }
__device__ __forceinline__ int defer_r(int G) { return G >= 128 ? G * 3 * 2 : 0; }
__device__ __forceinline__ int defer_all(int G) { return defer_a(G) + defer_b(G) + 2 * defer_r(G); }
__device__ __forceinline__ void p0_moe_item(const Params& p, int r, LAS float* scr, int lane) {
    unsigned char* ws = p.ws; const int which = r / (32 * I_MOE), le = (r / I_MOE) % 32, item = r % I_MOE;
    if (which == 0) p0_transpose_item8(p.in[I_W1] + (size_t)le * DM * FF, DM, FF, ws + WS_W13 + (size_t)le * 4096 * DM, 2, scr, item, lane);
    else if (which == 1) p0_transpose_item8(p.in[I_W3] + (size_t)le * DM * FF, DM, FF, ws + WS_W13 + (size_t)le * 4096 * DM, 3, scr, item, lane);
    else p0_transpose_item8(p.in[I_W2] + (size_t)le * FF * DM, FF, DM, ws + WS_W2 + (size_t)le * DM * FF, 0, scr, item, lane);
}
constexpr int BG_ITEMS = NTILE64 * 8 * NWAVES / 2;
static_assert(BG_ITEMS <= 16384, "background tiles must stay inside the layer-1 w1 block");
__device__ __forceinline__ int defer_l(int G) { return G >= 128 ? BG_ITEMS : 0; }
__device__ __forceinline__ int defer_s(int G) { const int rem = (NTILE64 * 8) % G; return (G >= 128 && rem) ? (G - rem) * NWAVES : 0; }
__device__ __forceinline__ int defer_o(int G) { return G >= 256 ? (G - 128) * NWAVES * 2 : 0; }
__device__ __forceinline__ void bg_item_issue(const Params& p, int d, int j, int lane, float (&tv)[8]) {
    const int which = d >> 14, rest = d & 16383, le = 16 + (rest >> 10), item = rest & 1023; constexpr int N = FF, nblk = N / 32;
    const float* W = (which ? p.in[I_W3] : p.in[I_W1]) + (size_t)le * DM * FF; const int kb = item / nblk, nb = item % nblk;
    const float* src = W + (size_t)(64 * kb + 8 * (lane & 7)) * N + 32 * nb + (lane >> 3);
#pragma unroll
    for (int i = 0; i < 8; ++i) tv[i] = src[(size_t)i * N + 8 * j];
}
__device__ __forceinline__ void bg_item_finish(const Params& p, int d, int j, int lane, const float (&tv)[8]) {
    const int which = d >> 14, rest = d & 16383, le = 16 + (rest >> 10), item = rest & 1023; constexpr int N = FF, nblk = N / 32;
    unsigned char* WT = p.ws + WS_W13 + (size_t)le * 4096 * DM; const int kb = item / nblk, nb = item % nblk, k0 = 64 * kb, n0 = 32 * nb, c = lane & 7;
    { const int n = n0 + (lane >> 3) + 8 * j; u32x2 o;
        o.x = f2fp8x4(tv[0] * W8_SCALE, tv[1] * W8_SCALE, tv[2] * W8_SCALE, tv[3] * W8_SCALE); o.y = f2fp8x4(tv[4] * W8_SCALE, tv[5] * W8_SCALE, tv[6] * W8_SCALE, tv[7] * W8_SCALE);
        *(GAS u32x2*)(WT + (size_t)dest_row(n, which ? 3 : 2) * DM + k0 + 8 * c) = o; }
}
__device__ __forceinline__ void p_deferred_weights(const Ctx& F, const Params& p, int nbusy, int first, int count) {
    if ((int)blockIdx.x < nbusy || count <= 0) return;
    LAS float* scr = (LAS float*)(F.lds + F.wave * 16384);
    const int nw = (F.G - nbusy) * NWAVES;
    for (int i = ((int)blockIdx.x - nbusy) * NWAVES + F.wave; i < count; i += nw) p0_moe_item(p, first + i, scr, F.lane);
}
__device__ __forceinline__ void p0_prologue(const Ctx& F, const Params& p) {
    unsigned char* ws = p.ws;
    LAS float* sil = (LAS float*)(F.lds + 8 * 16384);
    for (int i = F.tid; i < 3 * DM; i += 512) { const float v = i < 2 * DM ? p.in[I_C][i] : p.in[I_CCTX][i - 2 * DM]; sil[i] = silu_f(v); }
    __syncthreads();
    {
        float* modp = (float*)(ws + WS_MODP);
        for (int task = F.wave * F.G + F.vcu; task < 2 * 96 * 8; task += NWAVES * F.G) {
            const int ks = task & 7, cgp = (task >> 3) % 96, l = task / 768, n = cgp * 64 + F.lane;
            const float* W = p.in[I_ADAW] + ((size_t)l * DM + ks * 128) * 6144 + n;
            float a0 = 0.f, a1 = 0.f, a2 = 0.f;
#pragma unroll 32
            for (int k = 0; k < 128; ++k) { const float w = __builtin_nontemporal_load(&W[(size_t)k * 6144]); a0 += sil[ks * 128 + k] * w; a1 += sil[DM + ks * 128 + k] * w; a2 += sil[2 * DM + ks * 128 + k] * w; }
            float* o = modp + ((size_t)(ks * 2 + l) * 3) * 6144 + n; o[0] = a0; o[6144] = a1; o[2 * 6144] = a2;
        }
    }
    {
        const int gt = F.vcu * 512 + F.tid, NT_ = F.G * 512;
        float* cs = (float*)(ws + WS_ROPE);
        for (int i = gt; i < 192 * 16; i += NT_) { const int pos = i >> 4, f = i & 15; const float inv = powf(10000.0f, -(float)(2 * f) / 32.0f);
            const float ang = (float)(pos < 128 ? pos : pos - 128) * inv; float s, c; sincosf(ang, &s, &c); cs[2 * i] = c; cs[2 * i + 1] = s; }
        bf16_t* lw = (bf16_t*)(ws + WS_LRUW);
        for (int o = gt; o < 2 * 2 * 8 * 64 * 64; o += NT_) { const int i = o & 63, j = (o >> 6) & 63, h = (o >> 12) & 7, g2 = (o >> 15) & 1, d = o >> 16;
            const float* src = g2 ? p.in[I_LRUWX] : p.in[I_LRUWA]; lw[o] = (bf16_t)f2bf(src[((d * 8 + h) * 64 + i) * 64 + j]); }
        bf16_t* cw = (bf16_t*)(ws + WS_CMWS);
        for (int o = gt; o < 8 * 128 * 128; o += NT_) cw[o] = (bf16_t)f2bf(p.in[I_CMWS][o]);
    }
    LAS float* scr = (LAS float*)(F.lds + F.wave * 16384);
    const int gw = F.vcu * NWAVES + F.wave, NGW = F.G * NWAVES;
    constexpr int I_IN = 1024, I_O0 = 512, I_QK = 1536, I_O1 = 512, I_SMALL = I_IN + I_O0 + I_QK + I_O1;
    const int bgl = defer_l(F.G), NITEMS = I_SMALL + N_MOE_ITEMS - defer_all(F.G) - bgl - defer_s(F.G) - defer_o(F.G);
    for (int it = gw; it < NITEMS; it += NGW) {
        int r = it;
        if (r < I_SMALL) {
            if (r < I_IN) { p0_transpose_item(p.in[I_WIN], DM, 2048, (bf16_t*)(ws + WS_WIN), 0, scr, r, F.lane); continue; } r -= I_IN;
            if (r < I_O0) { p0_transpose_item(p.in[I_WOUT0], DM, DM, (bf16_t*)(ws + WS_WOUT0), 0, scr, r, F.lane); continue; } r -= I_O0;
            if (r < I_QK) { p0_transpose_item(p.in[I_WQKV], DM, 3072, (bf16_t*)(ws + WS_WQKV), 1, scr, r, F.lane); continue; } r -= I_QK;
            p0_transpose_item(p.in[I_WOUT1], DM, DM, (bf16_t*)(ws + WS_WOUT1), 0, scr, r, F.lane); continue;
        }
        { int m = r - I_SMALL; if (m >= 16384) m += bgl; p0_moe_item(p, m, scr, F.lane); }
    }
}

__device__ __forceinline__ void ld_row(const float* pr, int lane, f32x4 (&v)[4]) {
#pragma unroll
    for (int j = 0; j < 4; ++j) v[j] = *(const f32x4*)(pr + 4 * lane + 256 * j);
}
__device__ __forceinline__ void ld_row_bf(const bf16_t* pr, int lane, f32x4 (&v)[4]) {
#pragma unroll
    for (int j = 0; j < 4; ++j) { const u32x2 w = *(const u32x2*)(pr + 4 * lane + 256 * j); v[j] = (f32x4){bflo(w.x), bfhi(w.x), bflo(w.y), bfhi(w.y)}; }
}
__device__ __forceinline__ float row_rstd(const f32x4 (&v)[4]) {
    float s = 0.f;
#pragma unroll
    for (int j = 0; j < 4; ++j) s += (v[j][0] * v[j][0] + v[j][1] * v[j][1]) + (v[j][2] * v[j][2] + v[j][3] * v[j][3]);
    return 1.0f / sqrtf(wave_sum(s) * (1.0f / DM) + EPS);
}
__device__ __forceinline__ void mod_norm(f32x4 (&v)[4], float rstd, const float* g, const float* sc, const float* sh, int lane) {
#pragma unroll
    for (int j = 0; j < 4; ++j) { const int c = 4 * lane + 256 * j; const f32x4 gv = *(const f32x4*)(g + c), sv = *(const f32x4*)(sc + c), hv = *(const f32x4*)(sh + c);
        v[j] = v[j] * rstd * gv * (sv + 1.0f) + hv; }
}
__device__ __forceinline__ void st_row_bf16(bf16_t* pr, int lane, const f32x4 (&v)[4]) {
#pragma unroll
    for (int j = 0; j < 4; ++j) { u32x2 w; w.x = pk2(v[j][0], v[j][1]); w.y = pk2(v[j][2], v[j][3]); *(u32x2*)(pr + 4 * lane + 256 * j) = w; }
}
__device__ __forceinline__ void row_info(int R, int& b, int& j, int& rt) { b = R / LR; j = R % LR; rt = j < CTXL ? 2 : b; }

__device__ __forceinline__ void stage_mod(const Ctx& F, LAS float* dst, const float* mod_l, const float* g, int sc_chunk, int sh_chunk) {
    float gq[6], sq[6], hq[6];
#pragma unroll
    for (int q = 0; q < 6; ++q) { const int i = F.tid + 512 * q, rt = i >> 10, c = i & 1023; const float* m = mod_l + (size_t)rt * 6144; gq[q] = g[c]; sq[q] = m[sc_chunk * DM + c]; hq[q] = m[sh_chunk * DM + c]; }
#pragma unroll
    for (int q = 0; q < 6; ++q) { const int i = F.tid + 512 * q; dst[i] = gq[q] * (1.0f + sq[q]); dst[3 * DM + i] = hq[q]; }
}
__device__ __forceinline__ void apply_mod(f32x4 (&v)[4], float rstd, const LAS float* ms, int rt, int lane) {
#pragma unroll
    for (int j = 0; j < 4; ++j) { const int c = rt * DM + 4 * lane + 256 * j; v[j] = v[j] * rstd * *(const LAS f32x4*)(ms + c) + *(const LAS f32x4*)(ms + 3 * DM + c); }
}
constexpr int NBR = 4;
__device__ __forceinline__ void p_norm1_in(const Ctx& F, const Params& p) {
    bf16_t* H = (bf16_t*)(p.ws + WS_H);
    LAS float* ms = (LAS float*)F.lds;
    {
        const float* modp = (const float*)(p.ws + WS_MODP); float* modw = (float*)(p.ws + WS_MOD);
        for (int i = blockIdx.x * 512 + F.tid; i < 2 * 3 * 6144; i += F.G * 512) { const int l = i / (3 * 6144), n = i % 6144; float a = p.in[I_ADAB][l * 6144 + n];
#pragma unroll
            for (int ks = 0; ks < 8; ++ks) a += modp[(size_t)ks * 2 * 3 * 6144 + i];
            modw[i] = a; }
#pragma unroll
        for (int q = 0; q < 6; q += 2) {
            float shv[2][8], scv[2][8], b0[2], b1[2], gg[2];
#pragma unroll
            for (int u = 0; u < 2; ++u) { const int i = F.tid + 512 * (q + u), rt = i >> 10, c = i & 1023; b0[u] = p.in[I_ADAB][c]; b1[u] = p.in[I_ADAB][DM + c]; gg[u] = p.in[I_NMIXG][c];
#pragma unroll
                for (int ks = 0; ks < 8; ++ks) { const float* pp = modp + ((size_t)(ks * 2 + 0) * 3 + rt) * 6144; shv[u][ks] = pp[c]; scv[u][ks] = pp[DM + c]; } }
#pragma unroll
            for (int u = 0; u < 2; ++u) { const int i = F.tid + 512 * (q + u); float sh = b0[u], sc = b1[u];
#pragma unroll
                for (int ks = 0; ks < 8; ++ks) { sh += shv[u][ks]; sc += scv[u][ks]; }
                ms[i] = gg[u] * (1.0f + sc); ms[3 * DM + i] = sh; } }
    }
    __syncthreads();
    const int gw = F.vcu * NWAVES + F.wave, NGW = F.G * NWAVES;
    for (int R0 = gw; R0 < NR; R0 += NBR * NGW) {
        f32x4 v[NBR][4]; int rts[NBR];
#pragma unroll
        for (int k = 0; k < NBR; ++k) { const int R = R0 + k * NGW < NR ? R0 + k * NGW : R0; int b, j; row_info(R, b, j, rts[k]);
            const float* src = j < CTXL ? p.in[I_CTX] + ((size_t)b * CTXL + j) * DM : p.in[I_X] + ((size_t)b * SEQ + (j - CTXL)) * DM; ld_row(src, F.lane, v[k]); }
#pragma unroll
        for (int k = 0; k < NBR; ++k) { const int R = R0 + k * NGW; const float rstd = row_rstd(v[k]); apply_mod(v[k], rstd, ms, rts[k], F.lane); if (R < NR) st_row_bf16(H + (size_t)R * DM, F.lane, v[k]); } }
    __syncthreads();
}
__device__ __forceinline__ void p_norm2_router(const Ctx& F, const Params& p, int l, bool with_ctx, bool do_stage, bool do_tiles) {
    const float* mod = (const float*)(p.ws + WS_MOD); unsigned char* H8 = p.ws + WS_H; const bf16_t* X = (const bf16_t*)(p.ws + WS_X); float* aff = (float*)(p.ws + WS_AFF);
    LAS unsigned char* Whi = F.lds; LAS unsigned char* Wlo = F.lds + 32768;
    LAS float* gsf = (LAS float*)(F.lds + 65536); LAS float* shf = gsf + DM; LAS float* part = shf + DM;
    const int bi = (int)blockIdx.x, nctx = with_ctx ? 8 : 0, nbl = (F.G - nctx) >> 1;
    if (bi < 2 * nbl + nctx) {
        const int rt = bi < nbl ? 0 : (bi < 2 * nbl ? 1 : 2), gi = bi - rt * nbl;
        if (do_stage) { const float* Wr = p.in[I_ROUTER] + (size_t)l * DM * NE; const float* m = mod + (size_t)l * 3 * 6144 + (size_t)rt * 6144; const float* g = p.in[I_NFFNG] + l * DM;
          const int q = F.tid & 3; f32x4 bsum = (f32x4){0.f, 0.f, 0.f, 0.f};
          f32x4 w4[8]; float gq[8], sq[8], hq[8];
#pragma unroll
          for (int k = 0; k < 8; ++k) { const int i = F.tid + 512 * k, c = i >> 2; w4[k] = ((const f32x4*)Wr)[i]; gq[k] = g[c]; sq[k] = m[4 * DM + c]; hq[k] = m[3 * DM + c]; }
#pragma unroll
          for (int k = 0; k < 8; ++k) { const int i = F.tid + 512 * k, c = i >> 2; const float gsv = gq[k] * (1.0f + sq[k]);
              if (q == 0) { gsf[c] = gsv; shf[c] = hq[k]; }
              bsum += w4[k] * hq[k];
              const int base = ((((c >> 6) * 2 + ((c >> 3) & 1)) * 64 + ((c >> 4) & 3) * 16) + 4 * q) * 16 + (c & 7) * 2;
#pragma unroll
              for (int j = 0; j < 4; ++j) { const float val = gsv * w4[k][j]; const unsigned hb = f2bf(val); const unsigned lb = f2bf(val - __uint_as_float(hb << 16));
                  *(LAS unsigned short*)(Whi + base + j * 16) = (unsigned short)hb; *(LAS unsigned short*)(Wlo + base + j * 16) = (unsigned short)lb; } }
#pragma unroll
          for (int j = 0; j < 4; ++j) { float v = bsum[j];
#pragma unroll
              for (int o = 4; o < 64; o <<= 1) v += __shfl_xor(v, o);
              if (F.lane < 4) part[F.wave * 16 + 4 * F.lane + j] = v; } }
        __syncthreads();
        if (!do_tiles) return;
        if (F.wave >= 5) {
            const int nr = defer_r(F.G), first = N_MOE_ITEMS - defer_all(F.G) + l * nr; LAS float* scr = (LAS float*)(F.lds + F.wave * 16384);
            for (int i = bi * 3 + (F.wave - 5); i < nr; i += F.G * 3) p0_moe_item(p, first + i, scr, F.lane);
        }
        const int row = F.lane & 15, g4 = F.lane >> 4;
        const int ntile = rt < 2 ? SEQ / 16 : 2 * CTXL / 16, ngrp = rt < 2 ? nbl : nctx;
        for (int ti = F.wave * ngrp + gi; ti < ntile; ti += NWAVES * ngrp) {
            int b, j0; if (rt < 2) { b = rt; j0 = CTXL + 16 * ti; } else { b = ti >> 4; j0 = 16 * (ti & 15); }
            const size_t R0 = (size_t)b * LR + j0;
            const bf16_t* xp = X + (R0 + row) * DM + 16 * g4;
            u32x4 xa[16][2];
#pragma unroll
            for (int kp = 0; kp < 16; ++kp) { xa[kp][0] = *(const u32x4*)(xp + 64 * kp); xa[kp][1] = *(const u32x4*)(xp + 64 * kp + 8); }
            f32x4 acc = (f32x4){0.f, 0.f, 0.f, 0.f}; float ss = 0.f;
#pragma unroll
            for (int kp = 0; kp < 16; ++kp)
#pragma unroll
                for (int h = 0; h < 2; ++h) { const int ks = 2 * kp + h; const u32x4 xw = xa[kp][h];
                    const bf16x8 bh = *(const LAS bf16x8*)(Whi + (ks * 64 + F.lane) * 16), bl = *(const LAS bf16x8*)(Wlo + (ks * 64 + F.lane) * 16);
                    const bf16x8 a = __builtin_bit_cast(bf16x8, xw);
                    acc = __builtin_amdgcn_mfma_f32_16x16x32_bf16(a, bh, acc, 0, 0, 0); acc = __builtin_amdgcn_mfma_f32_16x16x32_bf16(a, bl, acc, 0, 0, 0);
                    ss += (bflo(xw.x) * bflo(xw.x) + bfhi(xw.x) * bfhi(xw.x)) + (bflo(xw.y) * bflo(xw.y) + bfhi(xw.y) * bfhi(xw.y)) + (bflo(xw.z) * bflo(xw.z) + bfhi(xw.z) * bfhi(xw.z)) + (bflo(xw.w) * bflo(xw.w) + bfhi(xw.w) * bfhi(xw.w));
                    if (h == 1 && (kp & 1)) { asm volatile("" ::: "memory"); __builtin_amdgcn_sched_barrier(0); } }
#pragma unroll
            for (int kp = 0; kp < 16; ++kp) asm volatile("" : "+v"(xa[kp][0]), "+v"(xa[kp][1]));
            ss += __shfl_xor(ss, 16); ss += __shfl_xor(ss, 32);
            const float rstd = 1.0f / sqrtf(ss * (1.0f / DM) + EPS);
            float be = 0.f;
#pragma unroll
            for (int w = 0; w < NWAVES; ++w) be += part[w * 16 + row];
            f32x4 pr;
#pragma unroll
            for (int r = 0; r < 4; ++r) { const float rs = __shfl(rstd, 4 * g4 + r); const float lg = acc[r] * rs + be; float mx = lg;
#pragma unroll
                for (int o = 1; o < 16; o <<= 1) mx = fmaxf(mx, __shfl_xor(mx, o));
                const float ex = __expf(lg - mx); float sm = ex;
#pragma unroll
                for (int o = 1; o < 16; o <<= 1) sm += __shfl_xor(sm, o);
                pr[r] = ex / sm; }
            *(f32x4*)(aff + ((size_t)b * NE + row) * LR + j0 + 4 * g4) = pr;
            unsigned char* hp = H8 + (R0 + row) * DM + 16 * g4;
#pragma unroll
            for (int kp = 0; kp < 16; ++kp) { const int c0 = 64 * kp + 16 * g4; u32x4 o; unsigned ow[4];
#pragma unroll
                for (int i = 0; i < 4; ++i) { const f32x4 gv = *(const LAS f32x4*)(gsf + c0 + 4 * i), hv = *(const LAS f32x4*)(shf + c0 + 4 * i);
                    const u32x4 xw = xa[kp][i >> 1]; const unsigned w0 = (i & 1) ? xw.z : xw.x, w1 = (i & 1) ? xw.w : xw.y;
                    ow[i] = f2fp8x4(bflo(w0) * rstd * gv[0] + hv[0], bfhi(w0) * rstd * gv[1] + hv[1], bflo(w1) * rstd * gv[2] + hv[2], bfhi(w1) * rstd * gv[3] + hv[3]); }
                o.x = ow[0]; o.y = ow[1]; o.z = ow[2]; o.w = ow[3];
                *(u32x4*)(hp + 64 * kp) = o;
                if (kp & 1) { asm volatile("" ::: "memory"); __builtin_amdgcn_sched_barrier(0); } }
        }
    }
    __syncthreads();
}

__device__ __forceinline__ void p_select(const Ctx& F, const Params& p, bool with_ctx) {
    const float* aff = (const float*)(p.ws + WS_AFF); int* inv = (int*)(p.ws + WS_INV); float* gate = (float*)(p.ws + WS_GATE);
    int* rowidx = (int*)(p.ws + WS_ROWIDX);
    LAS unsigned* hist = (LAS unsigned*)F.lds;
    LAS unsigned* misc = hist + 1024;
    LAS unsigned* vals = hist + 2048;
    const int nitems = with_ctx ? 64 : 32;
    for (int item = blockIdx.x; item < nitems; item += F.G) {
        if (item >= 32) {
            const int prob = item - 32, b = prob >> 4, e = prob & 15; const float* av = aff + ((size_t)b * NE + e) * LR;
            if (F.tid < CTXL) vals[F.tid] = __float_as_uint(av[F.tid]);
            __syncthreads();
            if (F.tid < CTXL) { const unsigned mine = vals[F.tid]; int rank = 0;
#pragma unroll 16
                for (int j = 0; j < CTXL; ++j) { const unsigned o = vals[j]; rank += (o > mine || (o == mine && j < F.tid)) ? 1 : 0; }
                const int R = b * LR + F.tid; int er = -1;
                if (rank < 32) { er = 2048 + b * 32 + rank; gate[e * EROWS + er] = __uint_as_float(mine); rowidx[e * EROWS + er] = R; }
                inv[(size_t)R * NE + e] = er; }
            __syncthreads();
            continue;
        }
        const int b = item >> 4, e = item & 15; constexpr int kcap = 1024, nj = 16;
        const float* av = aff + ((size_t)b * NE + e) * LR + CTXL;
        { unsigned tmp[16];
#pragma unroll
          for (int jj = 0; jj < 16; ++jj) tmp[jj] = __float_as_uint(av[F.tid + 512 * jj]);
#pragma unroll
          for (int jj = 0; jj < 16; ++jj) vals[F.tid + 512 * jj] = tmp[jj]; }
        unsigned prefix = 0u, mask = 0u, kk = (unsigned)kcap;
#pragma unroll 1
        for (int pass = 0; pass < 3; ++pass) { const int shift = 20 - 10 * pass;
            hist[F.tid] = 0u; hist[F.tid + 512] = 0u;
            __syncthreads();
#pragma unroll 1
            for (int jj = 0; jj < nj; ++jj) { const unsigned bt = vals[F.tid + 512 * jj]; if ((bt & mask) == prefix && bt != 0u) atomicAdd((unsigned*)(hist + ((bt >> shift) & 1023u)), 1u); }
            __syncthreads();
            if (F.wave == 0) {
                unsigned loc[16], tot = 0u;
#pragma unroll
                for (int q = 0; q < 16; ++q) { loc[q] = hist[1023 - 16 * F.lane - q]; tot += loc[q]; }
                unsigned inc = tot;
#pragma unroll
                for (int o = 1; o < 64; o <<= 1) { const unsigned t2 = __shfl_up(inc, o); if (F.lane >= o) inc += t2; }
                unsigned run = inc - tot;
#pragma unroll
                for (int q = 0; q < 16; ++q) { if (run < kk && run + loc[q] >= kk) { misc[0] = (unsigned)(1023 - 16 * F.lane - q); misc[1] = kk - run; } run += loc[q]; }
            }
            __syncthreads();
            prefix |= misc[0] << shift; mask |= 0x3ffu << shift; kk = misc[1];
            __syncthreads();
        }
        const unsigned T = prefix, need_eq = kk, cnt_gt = (unsigned)kcap - need_eq;
        unsigned cnt = 0u;
#pragma unroll 1
        for (int jj = 0; jj < nj; ++jj) { const unsigned bt = vals[F.tid + 512 * jj]; cnt += (bt > T ? 1u : 0u) + (bt == T ? 0x10000u : 0u); }
        unsigned inc = cnt;
#pragma unroll
        for (int o = 1; o < 64; o <<= 1) { const unsigned t2 = __shfl_up(inc, o); if (F.lane >= o) inc += t2; }
        if (F.lane == 63) misc[8 + F.wave] = inc;
        __syncthreads();
        unsigned base = inc - cnt;
        for (int w = 0; w < F.wave; ++w) base += misc[8 + w];
        unsigned rg = base & 0xffffu, re = base >> 16;
#pragma unroll 1
        for (int jj = 0; jj < nj; ++jj) { const int tok = F.tid + 512 * jj; const unsigned bt = vals[tok];
            const bool isgt = bt > T, iseq = bt == T; int slot = -1;
            if (isgt) { slot = (int)rg; } else if (iseq && re < need_eq) { slot = (int)(cnt_gt + re); }
            rg += isgt ? 1u : 0u; re += iseq ? 1u : 0u;
            const int R = b * LR + CTXL + tok; int er = -1;
            if (slot >= 0) { er = b * 1024 + slot; gate[e * EROWS + er] = __uint_as_float(bt); rowidx[e * EROWS + er] = R; }
            inv[(size_t)R * NE + e] = er; }
        __syncthreads();
    }
}

__device__ __forceinline__ void p_combine(const Ctx& F, const Params& p, int l, bool final_, bool do_stage, bool do_rows) {
    const float* mod = (const float*)(p.ws + WS_MOD); bf16_t* H = (bf16_t*)(p.ws + WS_H); bf16_t* X = (bf16_t*)(p.ws + WS_X); const int* inv = (const int*)(p.ws + WS_INV);
    const unsigned char* YB = p.ws + WS_XS;
    LAS float* ms = (LAS float*)F.lds;
    LAS float* g2s = ms + 6 * DM;
    if (do_stage) {
    if (final_) { for (int i = F.tid; i < DM; i += 512) ms[i] = p.in[I_FINALG][i]; }
    else stage_mod(F, ms, mod + (size_t)(l + 1) * 3 * 6144, p.in[I_NMIXG] + (l + 1) * DM, 1, 0);
    { float gq[6];
#pragma unroll
      for (int q = 0; q < 6; ++q) { const int i = F.tid + 512 * q; gq[q] = mod[(size_t)(l * 3 + (i >> 10)) * 6144 + 5 * DM + (i & 1023)]; }
#pragma unroll
      for (int q = 0; q < 6; ++q) g2s[F.tid + 512 * q] = gq[q]; } }
    __syncthreads();
    if (!do_rows) return;
    const int gw = F.vcu * NWAVES + F.wave, NGW = F.G * NWAVES;
    constexpr int NB2 = 2, NS = 4;
    const int nrows = final_ ? NLAT : NR;
    for (int r0 = gw; r0 < nrows; r0 += NB2 * NGW) {
        f32x4 v[NB2][4]; int myinv[NB2]; unsigned long long msk[NB2]; int Rs[NB2], bs[NB2], js[NB2], rts[NB2]; bool ok[NB2];
#pragma unroll
        for (int k = 0; k < NB2; ++k) { int r = r0 + k * NGW; ok[k] = r < nrows; if (!ok[k]) r = r0; Rs[k] = final_ ? (r / SEQ) * LR + CTXL + (r % SEQ) : r; row_info(Rs[k], bs[k], js[k], rts[k]);
            myinv[k] = F.lane < NE ? inv[(size_t)Rs[k] * NE + F.lane] : -1; ld_row_bf(X + (size_t)Rs[k] * DM, F.lane, v[k]); }
        unsigned w[NB2][NS][4]; float wt[NB2][NS];
#pragma unroll
        for (int k = 0; k < NB2; ++k) { msk[k] = __ballot(myinv[k] >= 0);
#pragma unroll
            for (int sidx = 0; sidx < NS; ++sidx) { const unsigned char* yr = YB; wt[k][sidx] = 0.f;
                if (msk[k]) { const int e = __builtin_ctzll(msk[k]); msk[k] &= msk[k] - 1; const int er = __builtin_amdgcn_readlane(myinv[k], e); yr = YB + ((size_t)e * EROWS + er) * DM; wt[k][sidx] = 1.f; }
#pragma unroll
                for (int jj = 0; jj < 4; ++jj) w[k][sidx][jj] = *(const unsigned*)(yr + 4 * F.lane + 256 * jj); } }
#pragma unroll
        for (int k = 0; k < NB2; ++k) {
            f32x4 mo[4];
#pragma unroll
            for (int jj = 0; jj < 4; ++jj) mo[jj] = (f32x4){0.f, 0.f, 0.f, 0.f};
#pragma unroll
            for (int sidx = 0; sidx < NS; ++sidx)
#pragma unroll
                for (int jj = 0; jj < 4; ++jj) { const int ww = (int)w[k][sidx][jj]; const float t = wt[k][sidx] * YB_INV;
                    mo[jj][0] += t * __builtin_amdgcn_cvt_f32_fp8(ww, 0); mo[jj][1] += t * __builtin_amdgcn_cvt_f32_fp8(ww, 1); mo[jj][2] += t * __builtin_amdgcn_cvt_f32_fp8(ww, 2); mo[jj][3] += t * __builtin_amdgcn_cvt_f32_fp8(ww, 3); }
            while (msk[k]) { const int e = __builtin_ctzll(msk[k]); msk[k] &= msk[k] - 1; const int er = __builtin_amdgcn_readlane(myinv[k], e); const unsigned char* yr = YB + ((size_t)e * EROWS + er) * DM;
#pragma unroll
                for (int jj = 0; jj < 4; ++jj) { const int ww = *(const int*)(yr + 4 * F.lane + 256 * jj);
                    mo[jj][0] += YB_INV * __builtin_amdgcn_cvt_f32_fp8(ww, 0); mo[jj][1] += YB_INV * __builtin_amdgcn_cvt_f32_fp8(ww, 1); mo[jj][2] += YB_INV * __builtin_amdgcn_cvt_f32_fp8(ww, 2); mo[jj][3] += YB_INV * __builtin_amdgcn_cvt_f32_fp8(ww, 3); } }
#pragma unroll
            for (int jj = 0; jj < 4; ++jj) v[k][jj] = v[k][jj] + *(const LAS f32x4*)(g2s + rts[k] * DM + 4 * F.lane + 256 * jj) * mo[jj];
            const float rstd = row_rstd(v[k]);
            if (!ok[k]) continue;
            if (final_) { float* o = p.out + ((size_t)bs[k] * SEQ + (js[k] - CTXL)) * DM;
#pragma unroll
                for (int jj = 0; jj < 4; ++jj) { const int c = 4 * F.lane + 256 * jj; __builtin_nontemporal_store(v[k][jj] * rstd * *(const LAS f32x4*)(ms + c), (f32x4*)(o + c)); } }
            else {
#pragma unroll
                for (int jj = 0; jj < 4; ++jj) *(u32x2*)(X + (size_t)Rs[k] * DM + 4 * F.lane + 256 * jj) = pk4(v[k][jj]);
                apply_mod(v[k], rstd, ms, rts[k], F.lane); st_row_bf16(H + (size_t)Rs[k] * DM, F.lane, v[k]); }
        }
    }
    __syncthreads();
}

#define LBAR() do { asm volatile("s_waitcnt lgkmcnt(0)" ::: "memory"); __builtin_amdgcn_s_barrier(); asm volatile("" ::: "memory"); } while (0)
__device__ __forceinline__ void p_lru(const Ctx& F, const Params& p, bool full) {
    const bf16_t* Z = (const bf16_t*)(p.ws + WS_ACT + ACT_Z); bf16_t* YC = (bf16_t*)(p.ws + WS_ACT + ACT_YCAT); const bf16_t* LW = (const bf16_t*)(p.ws + WS_LRUW);
    f32x2* SUM = (f32x2*)(p.ws + WS_SUM);
    bf16_t* AE = (bf16_t*)(p.ws + WS_XS); bf16_t* AU = AE + (size_t)NTILE64 * 8 * 8192;
    LAS float* recS = (LAS float*)F.lds;
    LAS float* xcF = recS + 67 * 64;
    LAS float* aS = xcF + 64 * 64;
    LAS float* uS = aS + 2 * 64 * 64;
    LAS float* cst = uS + 2 * 64 * 64;
    LAS bf16_t* xcB = (LAS bf16_t*)(cst + 1024 + 128);
    const int wave = F.wave, lane = F.lane, tid = F.tid;
    const int nitems = NTILE64 * 8;
    const int sr = tid >> 3, sc8 = tid & 7; const int hrr = (tid >> 3) == 0 ? -2 : ((tid >> 3) == 1 ? -1 : 64);
    const int gd = wave >> 2, gmf = wave & 3, gfr = lane & 15, gfq = lane >> 4;
    bf16x8 bw[2][4][2]; float cba[4], cbx[4], ccA[4];
    LAS float* cwS = (LAS float*)(xcB + 64 * 72);
    if (!full) {   const int h = (int)blockIdx.x & 7;
#pragma unroll
        for (int g2 = 0; g2 < 2; ++g2)
#pragma unroll
            for (int nf = 0; nf < 4; ++nf)
#pragma unroll
                for (int ks = 0; ks < 2; ++ks) bw[g2][nf][ks] = *(const bf16x8*)(LW + ((size_t)(((gd * 2 + g2) * 8 + h) * 64 + 16 * nf + gfr)) * 64 + 32 * ks + 8 * gfq);
#pragma unroll
        for (int nf = 0; nf < 4; ++nf) { const int gch = gd * 512 + h * 64 + 16 * nf + gfr; cba[nf] = p.in[I_LRUBA][gch]; cbx[nf] = p.in[I_LRUBX][gch];
            ccA[nf] = -8.0f * 1.4426950408889634f * log1pf(__expf(-p.in[I_LRULAM][gch])); }
        if (tid < 256) cwS[tid] = p.in[I_CONVW][(tid >> 6) * 512 + h * 64 + (tid & 63)]; else if (tid < 320) cwS[tid] = p.in[I_CONVB][h * 64 + (tid - 256)];
        __syncthreads(); }
    u32x4 wrec = (u32x4){0u, 0u, 0u, 0u}, whalo = (u32x4){0u, 0u, 0u, 0u};
    auto tile_geom = [&](int item, int& T, int& h, int& b, int& jt, int& R0) { T = item >> 3; h = item & 7; b = T / 132; jt = T % 132; R0 = b * LR + jt * 64; };
    auto issue_rec = [&](int item) { int T, h, b, jt, R0; tile_geom(item, T, h, b, jt, R0); const bool isctx = jt < 4; const int slo = isctx ? 0 : CTXL, shi = isctx ? CTXL : LR;
        wrec = *(const u32x4*)(Z + (size_t)(R0 + sr) * 2048 + 512 + h * 64 + sc8 * 8);
        whalo = (u32x4){0u, 0u, 0u, 0u};
        if (tid < 24) { const int jj = jt * 64 + hrr; if (jj >= slo && jj < shi) whalo = *(const u32x4*)(Z + (size_t)(R0 + hrr) * 2048 + 512 + h * 64 + sc8 * 8); } };
    u32x2 pa[4], pu[4];
    auto issue_au = [&](int item) {
#pragma unroll
        for (int k = 0; k < 4; ++k) { const size_t o = (size_t)item * 8192 + k * 2048 + 4 * tid; pa[k] = *(const u32x2*)(AE + o); pu[k] = *(const u32x2*)(AU + o); } };
    if ((int)blockIdx.x < nitems) { if (full) issue_au(blockIdx.x); else issue_rec(blockIdx.x); }
    for (int item = blockIdx.x; item < nitems; item += F.G) {
        int T, h, b, jt, R0; tile_geom(item, T, h, b, jt, R0); const bool isctx = jt < 4; (void)isctx;
        u32x4 wgate = (u32x4){0u, 0u, 0u, 0u};
        if (full) wgate = *(const u32x4*)(Z + (size_t)(R0 + sr) * 2048 + h * 64 + sc8 * 8);
        const int bgs = item * NWAVES + wave, bgd = bgs >> 1, bgq = 2 * (bgs & 1); const bool bg = full && bgd < defer_l(F.G);
        float tvp[8], tvq[8];
        if (full) {
#pragma unroll
            for (int k = 0; k < 4; ++k) { const u32x2 e = pa[k], u = pu[k];
                *(LAS f32x4*)(aS + k * 2048 + 4 * tid) = (f32x4){1.0f - bflo(e.x), 1.0f - bfhi(e.x), 1.0f - bflo(e.y), 1.0f - bfhi(e.y)};
                *(LAS f32x4*)(uS + k * 2048 + 4 * tid) = (f32x4){bflo(u.x), bfhi(u.x), bflo(u.y), bfhi(u.y)}; }
            if (item + F.G < nitems) issue_au(item + F.G);
            if (bg) { bg_item_issue(p, bgd, bgq, lane, tvp); bg_item_issue(p, bgd, bgq + 1, lane, tvq); }
            LBAR();
        } else {
        { LAS float* d = recS + (sr + 2) * 64 + sc8 * 8; const u32x4 w = wrec;
          d[0] = bflo(w.x); d[1] = bfhi(w.x); d[2] = bflo(w.y); d[3] = bfhi(w.y); d[4] = bflo(w.z); d[5] = bfhi(w.z); d[6] = bflo(w.w); d[7] = bfhi(w.w);
          if (tid < 24) { LAS float* d2 = recS + (hrr + 2) * 64 + sc8 * 8; const u32x4 w2 = whalo;
              d2[0] = bflo(w2.x); d2[1] = bfhi(w2.x); d2[2] = bflo(w2.y); d2[3] = bfhi(w2.y); d2[4] = bflo(w2.z); d2[5] = bfhi(w2.z); d2[6] = bflo(w2.w); d2[7] = bfhi(w2.w); } }
        if (item + F.G < nitems) issue_rec(item + F.G);
        LBAR();
        { const int r = sr, c8 = sc8 * 8;
          float y[8];
#pragma unroll
          for (int i = 0; i < 8; ++i) y[i] = cwS[256 + c8 + i];
#pragma unroll
          for (int q = 0; q < 4; ++q) { const f32x4 x0 = *(const LAS f32x4*)(recS + (r + q) * 64 + c8), x1 = *(const LAS f32x4*)(recS + (r + q) * 64 + c8 + 4);
              const f32x4 w0 = *(const LAS f32x4*)(cwS + q * 64 + c8), w1 = *(const LAS f32x4*)(cwS + q * 64 + c8 + 4);
              y[0] += w0[0] * x0[0]; y[1] += w0[1] * x0[1]; y[2] += w0[2] * x0[2]; y[3] += w0[3] * x0[3]; y[4] += w1[0] * x1[0]; y[5] += w1[1] * x1[1]; y[6] += w1[2] * x1[2]; y[7] += w1[3] * x1[3]; }
          *(LAS f32x4*)(xcF + r * 64 + c8) = (f32x4){y[0], y[1], y[2], y[3]}; *(LAS f32x4*)(xcF + r * 64 + c8 + 4) = (f32x4){y[4], y[5], y[6], y[7]};
          u32x4 w; w.x = pk2(y[0], y[1]); w.y = pk2(y[2], y[3]); w.z = pk2(y[4], y[5]); w.w = pk2(y[6], y[7]);
          *(LAS u32x4*)(xcB + r * 72 + c8) = w; }
        LBAR();
        { const int d = gd, mf = gmf, fr = gfr, fq = gfq;
          bf16x8 af[2];
#pragma unroll
          for (int ks = 0; ks < 2; ++ks) af[ks] = *(const LAS bf16x8*)(xcB + (16 * mf + fr) * 72 + 32 * ks + 8 * fq);
          f32x4 acc[2][4];
#pragma unroll
          for (int g2 = 0; g2 < 2; ++g2)
#pragma unroll
              for (int nf = 0; nf < 4; ++nf) { acc[g2][nf] = (f32x4){0.f, 0.f, 0.f, 0.f};
#pragma unroll
                  for (int ks = 0; ks < 2; ++ks) acc[g2][nf] = __builtin_amdgcn_mfma_f32_16x16x32_bf16(af[ks], bw[g2][nf][ks], acc[g2][nf], 0, 0, 0); }
#pragma unroll
          for (int nf = 0; nf < 4; ++nf) { const int ch = 16 * nf + fr; const float ba = cba[nf], bx = cbx[nf], cA = ccA[nf];
#pragma unroll
              for (int r = 0; r < 4; ++r) { const int tk = 16 * mf + 4 * fq + r;
                  const float rg = __builtin_amdgcn_rcpf(1.0f + __builtin_amdgcn_exp2f(-1.4426950408889634f * (acc[0][nf][r] + ba)));
                  const float ig = __builtin_amdgcn_rcpf(1.0f + __builtin_amdgcn_exp2f(-1.4426950408889634f * (acc[1][nf][r] + bx)));
                  const float a = __builtin_amdgcn_exp2f(rg * cA), mult = __builtin_amdgcn_sqrtf(fmaf(-a, a, 1.0f));
                  aS[(d * 64 + tk) * 64 + ch] = a; uS[(d * 64 + tk) * 64 + ch] = mult * ig * xcF[tk * 64 + ch]; } } }
        LBAR();
        {
#pragma unroll
            for (int k = 0; k < 4; ++k) { const f32x4 a4 = *(const LAS f32x4*)(aS + k * 2048 + 4 * tid), u4 = *(const LAS f32x4*)(uS + k * 2048 + 4 * tid); const size_t o = (size_t)item * 8192 + k * 2048 + 4 * tid;
                *(u32x2*)(AE + o) = pk4((f32x4){1.0f - a4[0], 1.0f - a4[1], 1.0f - a4[2], 1.0f - a4[3]}); *(u32x2*)(AU + o) = pk4(u4); } }
        }
        if (full && tid < 128) cst[1024 + tid] = ((const float*)(p.ws + WS_CAR))[((size_t)T * 2 + (tid >> 6)) * 512 + h * 64 + (tid & 63)];
        {
            const int dc = tid & 127, d = dc >> 6, ch = dc & 63, sg = tid >> 7;
            const LAS float* ap = aS + d * 4096 + ch; LAS float* up = uS + d * 4096 + ch;
            const int tfirst = d == 0 ? 16 * sg : 63 - 16 * sg, tstep_ = d == 0 ? 64 : -64;
            float av[16], uv[16];
#pragma unroll
            for (int i = 0; i < 16; ++i) { av[i] = ap[tfirst * 64 + i * tstep_]; uv[i] = up[tfirst * 64 + i * tstep_]; }
            float P = 1.f, hs = 0.f;
#pragma unroll
            for (int i = 0; i < 16; ++i) { hs = av[i] * hs + uv[i]; P *= av[i]; uv[i] = hs; }
            asm volatile("" ::: "memory");
            LBAR();
            cst[(sg * 128 + dc) * 2] = P; cst[(sg * 128 + dc) * 2 + 1] = hs;
            LBAR();
            float cin = full ? cst[1024 + dc] : 0.f;
            float Pt = 1.f;
#pragma unroll
            for (int q = 0; q < 4; ++q) { const float Pq = cst[(q * 128 + dc) * 2], Hq = cst[(q * 128 + dc) * 2 + 1];
                if (q < sg) cin = Pq * cin + Hq;
                Pt *= Pq; }
            if (!full) { if (sg == 3) SUM[((size_t)T * 2 + d) * 512 + h * 64 + ch] = (f32x2){Pt, cst[(3 * 128 + dc) * 2 + 1] + cst[(3 * 128 + dc) * 2] * cin}; }
            else { float pp = cin;
#pragma unroll
                for (int i = 0; i < 16; ++i) { pp *= ap[tfirst * 64 + i * tstep_]; up[tfirst * 64 + i * tstep_] = uv[i] + pp; } }
        }
        LBAR();
        if (full) { const int r = sr, c8 = sc8 * 8; const u32x4 gw_ = wgate;
            float gg[8] = {bflo(gw_.x), bfhi(gw_.x), bflo(gw_.y), bfhi(gw_.y), bflo(gw_.z), bfhi(gw_.z), bflo(gw_.w), bfhi(gw_.w)}; float y[8];
            const f32x4 f0 = *(const LAS f32x4*)(uS + r * 64 + c8), f1 = *(const LAS f32x4*)(uS + r * 64 + c8 + 4), b0 = *(const LAS f32x4*)(uS + (64 + r) * 64 + c8), b1 = *(const LAS f32x4*)(uS + (64 + r) * 64 + c8 + 4);
            y[0] = gg[0] * (f0[0] + b0[0]); y[1] = gg[1] * (f0[1] + b0[1]); y[2] = gg[2] * (f0[2] + b0[2]); y[3] = gg[3] * (f0[3] + b0[3]);
            y[4] = gg[4] * (f1[0] + b1[0]); y[5] = gg[5] * (f1[1] + b1[1]); y[6] = gg[6] * (f1[2] + b1[2]); y[7] = gg[7] * (f1[3] + b1[3]);
            u32x4 w; w.x = pk2(y[0], y[1]); w.y = pk2(y[2], y[3]); w.z = pk2(y[4], y[5]); w.w = pk2(y[6], y[7]);
            *(u32x4*)(YC + (size_t)(R0 + r) * DM + h * 64 + c8) = w; }
        if (bg) { bg_item_finish(p, bgd, bgq, lane, tvp); bg_item_finish(p, bgd, bgq + 1, lane, tvq); }
        LBAR();
    }
    if (!full) { const int ns = defer_s(F.G), rem = nitems % F.G;
        if (ns && (int)blockIdx.x >= rem) p0_moe_item(p, N_MOE_ITEMS - defer_all(F.G) - ns + ((int)blockIdx.x - rem) * NWAVES + wave, (LAS float*)(F.lds + wave * 16384), lane); }
}

#undef LBAR
__device__ __forceinline__ void p_lru_carry(const Ctx& F, const Params& p) {
    const f32x2* SUM = (const f32x2*)(p.ws + WS_SUM); float* CAR = (float*)(p.ws + WS_CAR);
    const int task = (int)blockIdx.x - (F.G - 4);
    if (task < 0) return;
    const int tk = task * NWAVES + F.wave, b = tk >> 4, d = (tk >> 3) & 1, h = tk & 7, ch = h * 64 + F.lane;
    float st = 0.f;
#pragma unroll 1
    for (int i0 = 0; i0 < 132; i0 += 66) {
        f32x2 sv[66];
#pragma unroll
        for (int k = 0; k < 66; ++k) { const int i = i0 + k; const int jp = d == 0 ? i : (i < 4 ? 3 - i : 135 - i); sv[k] = SUM[((size_t)(b * 132 + jp) * 2 + d) * 512 + ch]; }
#pragma unroll
        for (int k = 0; k < 66; ++k) { const int i = i0 + k; const int jp = d == 0 ? i : (i < 4 ? 3 - i : 135 - i);
            __hip_atomic_store(&CAR[((size_t)(b * 132 + jp) * 2 + d) * 512 + ch], st, __ATOMIC_RELAXED, __HIP_MEMORY_SCOPE_AGENT);
            st = sv[k].x * st + sv[k].y; }
    }
}

__device__ __forceinline__ void p_cm(const Ctx& F, const Params& p) {
    const int GB = F.G - 8;
    if ((int)blockIdx.x >= GB) return;
    const bf16_t* Z = (const bf16_t*)(p.ws + WS_ACT + ACT_Z); bf16_t* YC = (bf16_t*)(p.ws + WS_ACT + ACT_YCAT); const bf16_t* CW = (const bf16_t*)(p.ws + WS_CMWS);
    LAS bf16_t* vnT = (LAS bf16_t*)F.lds;
    LAS float* mix = (LAS float*)(F.lds + 32768);
    const int wave = F.wave, lane = F.lane, tid = F.tid, fr = lane & 15, fq = lane >> 4;
    const int nitems = (NR / 128) * 8; const int q = tid >> 2, part = tid & 3;
    bf16x8 afr[4]; float bsr[4]; float vgr[16];
    {   const int g = (int)blockIdx.x & 7;
#pragma unroll
        for (int ks = 0; ks < 4; ++ks) afr[ks] = *(const bf16x8*)(CW + ((size_t)g * 128 + 16 * wave + fr) * 128 + 32 * ks + 8 * fq);
#pragma unroll
        for (int r = 0; r < 4; ++r) bsr[r] = p.in[I_CMBS][g * 128 + 16 * wave + 4 * fq + r];
#pragma unroll
        for (int i = 0; i < 16; ++i) vgr[i] = p.in[I_CMVG][g * 64 + part * 16 + i]; }
    u32x4 wv0 = (u32x4){0u, 0u, 0u, 0u}, wv1 = wv0;
    auto issue_v = [&](int item) { const int cn = item >> 3, g = item & 7; const bf16_t* src = Z + (size_t)(cn * 128 + q) * 2048 + 1536 + g * 64 + part * 16; wv0 = *(const u32x4*)src; wv1 = *(const u32x4*)(src + 8); };
    if ((int)blockIdx.x < nitems) issue_v(blockIdx.x);
    for (int item = blockIdx.x; item < nitems; item += GB) {
        const int cn = item >> 3, g = item & 7; const int R0 = cn * 128;
        const bf16_t* usrc = Z + (size_t)(R0 + q) * 2048 + 1024 + g * 64 + part * 16; const u32x4 wu0 = *(const u32x4*)usrc, wu1 = *(const u32x4*)(usrc + 8);
        { const u32x4 w0 = wv0, w1 = wv1;
          float v[16] = {bflo(w0.x), bfhi(w0.x), bflo(w0.y), bfhi(w0.y), bflo(w0.z), bfhi(w0.z), bflo(w0.w), bfhi(w0.w), bflo(w1.x), bfhi(w1.x), bflo(w1.y), bfhi(w1.y), bflo(w1.z), bfhi(w1.z), bflo(w1.w), bfhi(w1.w)};
          float ss = 0.f;
#pragma unroll
          for (int i = 0; i < 16; ++i) ss += v[i] * v[i];
          ss += __shfl_xor(ss, 1); ss += __shfl_xor(ss, 2);
          const float rstd = 1.0f / sqrtf(ss * (1.0f / 64.0f) + EPS);
#pragma unroll
          for (int i = 0; i < 16; ++i) vnT[(part * 16 + i) * 136 + q] = (bf16_t)f2bf(v[i] * rstd * vgr[i]); }
        if (item + GB < nitems) issue_v(item + GB);
        __syncthreads();
        f32x4 acc[4];
#pragma unroll
        for (int nf = 0; nf < 4; ++nf) acc[nf] = (f32x4){0.f, 0.f, 0.f, 0.f};
#pragma unroll
        for (int ks = 0; ks < 4; ++ks)
#pragma unroll
            for (int nf = 0; nf < 4; ++nf) { const bf16x8 bfr = *(const LAS bf16x8*)(vnT + (16 * nf + fr) * 136 + 32 * ks + 8 * fq);
                acc[nf] = __builtin_amdgcn_mfma_f32_16x16x32_bf16(afr[ks], bfr, acc[nf], 0, 0, 0); }
#pragma unroll
        for (int r = 0; r < 4; ++r) { const int pp = 16 * wave + 4 * fq + r;
#pragma unroll
            for (int nf = 0; nf < 4; ++nf) mix[pp * 68 + 16 * nf + fr] = acc[nf][r] + bsr[r]; }
        __syncthreads();
        { float ug[16] = {bflo(wu0.x), bfhi(wu0.x), bflo(wu0.y), bfhi(wu0.y), bflo(wu0.z), bfhi(wu0.z), bflo(wu0.w), bfhi(wu0.w), bflo(wu1.x), bfhi(wu1.x), bflo(wu1.y), bfhi(wu1.y), bflo(wu1.z), bfhi(wu1.z), bflo(wu1.w), bfhi(wu1.w)};
          const LAS float* mr = mix + q * 68 + part * 16; float y[16];
#pragma unroll
          for (int i = 0; i < 16; i += 4) { const f32x4 mv = *(const LAS f32x4*)(mr + i); y[i] = ug[i] * mv[0]; y[i + 1] = ug[i + 1] * mv[1]; y[i + 2] = ug[i + 2] * mv[2]; y[i + 3] = ug[i + 3] * mv[3]; }
          u32x4 o0, o1; o0.x = pk2(y[0], y[1]); o0.y = pk2(y[2], y[3]); o0.z = pk2(y[4], y[5]); o0.w = pk2(y[6], y[7]); o1.x = pk2(y[8], y[9]); o1.y = pk2(y[10], y[11]); o1.z = pk2(y[12], y[13]); o1.w = pk2(y[14], y[15]);
          bf16_t* dst = YC + (size_t)(R0 + q) * DM + 512 + g * 64 + part * 16; *(u32x4*)dst = o0; *(u32x4*)(dst + 8) = o1; }
        __syncthreads();
    }
}

__device__ __forceinline__ void sg_tile(const bf16_t* A, size_t lda, const bf16_t* Bt, size_t ldb, int K, int lane, f32x4 (&acc)[4][2]) {
    const int fr = lane & 15, fq = lane >> 4;
#pragma unroll
    for (int m = 0; m < 4; ++m)
#pragma unroll
        for (int n = 0; n < 2; ++n) acc[m][n] = (f32x4){0.f, 0.f, 0.f, 0.f};
    const bf16_t* ap = A + (size_t)fr * lda + 8 * fq; const bf16_t* bp = Bt + (size_t)fr * ldb + 8 * fq;
#pragma unroll 4
    for (int k = 0; k < K; k += 32) {
        bf16x8 af[4], bfr[2];
#pragma unroll
        for (int m = 0; m < 4; ++m) af[m] = *(const bf16x8*)(ap + (size_t)(16 * m) * lda + k);
#pragma unroll
        for (int n = 0; n < 2; ++n) bfr[n] = *(const bf16x8*)(bp + (size_t)(16 * n) * ldb + k);
#pragma unroll
        for (int m = 0; m < 4; ++m)
#pragma unroll
            for (int n = 0; n < 2; ++n) acc[m][n] = __builtin_amdgcn_mfma_f32_16x16x32_bf16(bfr[n], af[m], acc[m][n], 0, 0, 0);
    }
}
__device__ __forceinline__ size_t ctx_row0(int rt8) { return (size_t)(rt8 >> 2) * LR + (size_t)(rt8 & 3) * 64; }
__device__ __forceinline__ void sg_block64(const Ctx& F, const bf16_t* A, size_t lda, const bf16_t* Bt, size_t ldb, int K, f32x4 (&out)[2]) {
    const int kw = K / NWAVES, fr = F.lane & 15, fq = F.lane >> 4;
    f32x4 acc[4][4];
#pragma unroll
    for (int m = 0; m < 4; ++m)
#pragma unroll
        for (int n = 0; n < 4; ++n) acc[m][n] = (f32x4){0.f, 0.f, 0.f, 0.f};
    const bf16_t* ap = A + (size_t)fr * lda + F.wave * kw + 8 * fq; const bf16_t* bp = Bt + (size_t)fr * ldb + F.wave * kw + 8 * fq;
#pragma unroll 4
    for (int k = 0; k < kw; k += 32) {
        bf16x8 af[4], bfr[4];
#pragma unroll
        for (int m = 0; m < 4; ++m) af[m] = *(const bf16x8*)(ap + (size_t)(16 * m) * lda + k);
#pragma unroll
        for (int n = 0; n < 4; ++n) bfr[n] = *(const bf16x8*)(bp + (size_t)(16 * n) * ldb + k);
#pragma unroll
        for (int m = 0; m < 4; ++m)
#pragma unroll
            for (int n = 0; n < 4; ++n) acc[m][n] = __builtin_amdgcn_mfma_f32_16x16x32_bf16(bfr[n], af[m], acc[m][n], 0, 0, 0);
    }
    LAS float* part = (LAS float*)F.lds;
#pragma unroll
    for (int m = 0; m < 4; ++m)
#pragma unroll
        for (int n = 0; n < 4; ++n) *(LAS f32x4*)(part + ((F.wave * 64 + 16 * m + fr) * 64 + 16 * n + 4 * fq)) = acc[m][n];
    __syncthreads();
    out[0] = (f32x4){0.f, 0.f, 0.f, 0.f}; out[1] = out[0];
#pragma unroll
    for (int w = 0; w < NWAVES; ++w) { out[0] += *(const LAS f32x4*)(part + w * 4096 + F.tid * 8); out[1] += *(const LAS f32x4*)(part + w * 4096 + F.tid * 8 + 4); }
    __syncthreads();
}
__device__ __forceinline__ void p_ctx_dense(const Ctx& F, const Params& p, int which) {
    unsigned char* ws = p.ws; const float* mod = (const float*)(ws + WS_MOD);
    const int ncg = which == 0 ? 32 : (which == 1 ? 16 : 32), nunits = 8 * ncg; const int row = F.tid >> 3, c8 = (F.tid & 7) * 8;
    for (int uidx = F.vcu; uidx < nunits; uidx += F.G) {
        const int rt8 = uidx / ncg, cgp = uidx % ncg; const size_t R0 = ctx_row0(rt8), R = R0 + row; const int c = cgp * 64 + c8; f32x4 v[2];
        if (which == 0) { sg_block64(F, (const bf16_t*)(ws + WS_H) + R0 * DM, DM, (const bf16_t*)(ws + WS_WIN) + (size_t)cgp * 64 * DM, DM, DM, v);
            if (cgp < 8 || cgp >= 16) {
#pragma unroll
                for (int i = 0; i < 4; ++i) { v[0][i] = gelu_tanh(v[0][i]); v[1][i] = gelu_tanh(v[1][i]); } }
            u32x4 w; const u32x2 a = pk4(v[0]), b = pk4(v[1]); w.x = a.x; w.y = a.y; w.z = b.x; w.w = b.y;
            *(u32x4*)((bf16_t*)(ws + WS_ACT + ACT_Z) + R * 2048 + c) = w; }
        else if (which == 1) { sg_block64(F, (const bf16_t*)(ws + WS_ACT + ACT_YCAT) + R0 * DM, DM, (const bf16_t*)(ws + WS_WOUT0) + (size_t)cgp * 64 * DM, DM, DM, v);
            const float* cin = p.in[I_CTX] + ((size_t)(rt8 >> 2) * CTXL + (size_t)(rt8 & 3) * 64 + row) * DM; const float* g1 = mod + 2 * 6144 + 2 * DM;
            const f32x4 o0 = *(const f32x4*)(cin + c) + *(const f32x4*)(g1 + c) * v[0], o1 = *(const f32x4*)(cin + c + 4) + *(const f32x4*)(g1 + c + 4) * v[1];
            u32x4 w; const u32x2 a = pk4(o0), b = pk4(o1); w.x = a.x; w.y = a.y; w.z = b.x; w.w = b.y;
            *(u32x4*)((bf16_t*)(ws + WS_X) + R * DM + c) = w; }
        else { sg_block64(F, (const bf16_t*)(ws + WS_H) + R0 * DM, DM, (const bf16_t*)(ws + WS_WQKV) + (size_t)(1024 + cgp * 64) * DM, DM, DM, v);
            bf16_t* dst = (bf16_t*)(ws + WS_ACT + (cgp < 16 ? ACT_K : ACT_V));
            u32x4 w; const u32x2 a = pk4(v[0]), b = pk4(v[1]); w.x = a.x; w.y = a.y; w.z = b.x; w.w = b.y;
            *(u32x4*)(dst + R * DM + (cgp & 15) * 64 + c8) = w; }
    }
}
__device__ __forceinline__ void p_ctx_moe(const Ctx& F, const Params& p, int which, int layer = 0) {
    unsigned char* ws = p.ws;
    typedef int v8i32 __attribute__((ext_vector_type(8))); typedef float f32x16 __attribute__((ext_vector_type(16)));
    const int l31 = F.lane & 31, hh = F.lane >> 5;
    if (which == 0) {
        LAS unsigned char* As = F.lds;
        for (int uidx = F.vcu; uidx < NE * 16; uidx += F.G) {
            const int e = uidx >> 4, cgp = (uidx & 15) * 8 + F.wave; const size_t er0 = (size_t)e * EROWS + 2048;
            { const int* ridx = (const int*)(ws + WS_ROWIDX) + er0; u32x4 t[8];
#pragma unroll
              for (int i = 0; i < 8; ++i) t[i] = ((const u32x4*)(ws + WS_H + (size_t)ridx[F.wave + 8 * i] * DM))[F.lane];
#pragma unroll
              for (int i = 0; i < 8; ++i) { const int g = F.tid + 512 * i, r = g >> 6, c = g & 63; *(LAS u32x4*)(As + r * 1024 + 16 * (c ^ (r & 15))) = t[i]; } }
            __syncthreads();
            const unsigned char* bp = ws + WS_W13 + ((size_t)layer * NE * 4096 + (size_t)e * 4096 + (size_t)cgp * 32 + l31) * DM + 32 * hh;
            f32x16 acc[2]; acc[0] = f32x16{}; acc[1] = f32x16{};
#pragma unroll 8
            for (int ks = 0; ks < 16; ++ks) {
                const u32x4 b0 = *(const u32x4*)(bp + 64 * ks), b1 = *(const u32x4*)(bp + 64 * ks + 16); const v8i32 bf = {(int)b0.x, (int)b0.y, (int)b0.z, (int)b0.w, (int)b1.x, (int)b1.y, (int)b1.z, (int)b1.w};
#pragma unroll
                for (int m = 0; m < 2; ++m) { const int r = 32 * m + l31, c0 = 4 * ks + 2 * hh;
                    const u32x4 a0 = *(const LAS u32x4*)(As + r * 1024 + 16 * (c0 ^ (r & 15))), a1 = *(const LAS u32x4*)(As + r * 1024 + 16 * ((c0 + 1) ^ (r & 15)));
                    const v8i32 af = {(int)a0.x, (int)a0.y, (int)a0.z, (int)a0.w, (int)a1.x, (int)a1.y, (int)a1.z, (int)a1.w};
                    acc[m] = __builtin_amdgcn_mfma_scale_f32_32x32x64_f8f6f4(bf, af, acc[m], 0, 0, 0, 0x7f7f7f7f, 0, 0x7f7f7f7f); } }
            unsigned char* HID = ws + WS_ACT + ACT_HID;
#pragma unroll
            for (int m = 0; m < 2; ++m)
#pragma unroll
                for (int q = 0; q < 2; ++q) {
                    float hv[4];
#pragma unroll
                    for (int i = 0; i < 4; ++i) hv[i] = silu_f(acc[m][4 * q + i] * W8_INV) * (acc[m][8 + 4 * q + i] * W8_INV);
                    *(unsigned*)(HID + (er0 + 32 * m + l31) * FF + cgp * 16 + 8 * q + 4 * hh) = f2fp8x4(hv[0], hv[1], hv[2], hv[3]); }
            __syncthreads();
        }
    } else {
        const int row = F.tid >> 3, c8 = (F.tid & 7) * 8; LAS float* part = (LAS float*)F.lds;
        for (int uidx = F.vcu; uidx < NE * 16; uidx += F.G) {
            const int e = uidx >> 4, cgp = uidx & 15; const size_t er0 = (size_t)e * EROWS + 2048;
            const unsigned char* ap = ws + WS_ACT + ACT_HID + (er0 + l31) * FF + F.wave * 256 + 32 * hh;
            const unsigned char* bp = ws + WS_W2 + ((size_t)layer * NE * DM + (size_t)e * DM + (size_t)cgp * 64 + l31) * FF + F.wave * 256 + 32 * hh;
            f32x16 acc[2][2]; acc[0][0] = f32x16{}; acc[0][1] = f32x16{}; acc[1][0] = f32x16{}; acc[1][1] = f32x16{};
#pragma unroll
            for (int k = 0; k < 256; k += 64) {
                v8i32 af[2], bf[2];
#pragma unroll
                for (int m = 0; m < 2; ++m) { const u32x4 a0 = *(const u32x4*)(ap + (size_t)m * 32 * FF + k), a1 = *(const u32x4*)(ap + (size_t)m * 32 * FF + k + 16);
                    af[m] = (v8i32){(int)a0.x, (int)a0.y, (int)a0.z, (int)a0.w, (int)a1.x, (int)a1.y, (int)a1.z, (int)a1.w}; }
#pragma unroll
                for (int n = 0; n < 2; ++n) { const u32x4 b0 = *(const u32x4*)(bp + (size_t)n * 32 * FF + k), b1 = *(const u32x4*)(bp + (size_t)n * 32 * FF + k + 16);
                    bf[n] = (v8i32){(int)b0.x, (int)b0.y, (int)b0.z, (int)b0.w, (int)b1.x, (int)b1.y, (int)b1.z, (int)b1.w}; }
#pragma unroll
                for (int m = 0; m < 2; ++m)
#pragma unroll
                    for (int n = 0; n < 2; ++n) acc[m][n] = __builtin_amdgcn_mfma_scale_f32_32x32x64_f8f6f4(bf[n], af[m], acc[m][n], 0, 0, 0, 0x7f7f7f7f, 0, 0x7f7f7f7f); }
#pragma unroll
            for (int m = 0; m < 2; ++m)
#pragma unroll
                for (int n = 0; n < 2; ++n)
#pragma unroll
                    for (int q = 0; q < 4; ++q) *(LAS f32x4*)(part + ((F.wave * 64 + 32 * m + l31) * 64 + 32 * n + 8 * q + 4 * hh)) = (f32x4){acc[m][n][4 * q], acc[m][n][4 * q + 1], acc[m][n][4 * q + 2], acc[m][n][4 * q + 3]};
            __syncthreads();
            f32x4 v0 = (f32x4){0.f, 0.f, 0.f, 0.f}, v1 = v0;
#pragma unroll
            for (int w = 0; w < NWAVES; ++w) { v0 += *(const LAS f32x4*)(part + w * 4096 + F.tid * 8); v1 += *(const LAS f32x4*)(part + w * 4096 + F.tid * 8 + 4); }
            __syncthreads();
            const float gt = ((const float*)(ws + WS_GATE))[er0 + row] * (W8_INV * YB_SCALE);
            u32x2 w; w.x = f2fp8x4(v0[0] * gt, v0[1] * gt, v0[2] * gt, v0[3] * gt); w.y = f2fp8x4(v1[0] * gt, v1[1] * gt, v1[2] * gt, v1[3] * gt);
            *(u32x2*)(ws + WS_XS + (er0 + row) * DM + cgp * 64 + c8) = w;
        }
    }
}

__device__ __forceinline__ void p_attn(const Ctx& F, const Params& p, unsigned char* lds_generic) {
    using abf = attn_body::bf16;
    const abf* Q = (const abf*)(p.ws + WS_ACT + ACT_Q); const abf* Kb = (const abf*)(p.ws + WS_ACT + ACT_K); const abf* Vb = (const abf*)(p.ws + WS_ACT + ACT_V);
    const bf16_t* O1 = (const bf16_t*)(p.ws + WS_ACT + ACT_O1); const bf16_t* O2 = (const bf16_t*)(p.ws + WS_ACT + ACT_O2); bf16_t* A = (bf16_t*)(p.ws + WS_XS);
    const int wid = F.wave;
    for (int i = 0; i < 4; ++i) { const int bh = (i >> 1) * 8 + (F.vcu >> 5), qb = F.vcu & 31, sub = (i & 1) * 2 + 1;
        const int b = bh >> 3, h = bh & 7, m = i & 1;
        abf* O = (abf*)(p.ws + WS_ACT + (m ? ACT_O2 : ACT_O1));
        const abf* Qw = Q + ((size_t)b * LR + CTXL + qb * 256 + wid * 32) * DM + (h * 2 + m) * 64;
        const abf* Kh = Kb + (size_t)b * LR * DM + (h * 2 + m) * 64;
        const abf* Vh = Vb + (size_t)b * LR * DM + h * 128;
        abf* Ow = O + ((size_t)b * SEQ + qb * 256 + wid * 32) * DM + h * 128;
        attn_body::attn_unit128<8>(Qw, Kh, Vh, Ow, (char*)lds_generic);
        if (sub == 3) {
            asm volatile("s_waitcnt vmcnt(0)" ::: "memory");
            int lane2 = threadIdx.x & 63; asm volatile("" : "+v"(lane2));
            const float lam_init = 0.8f - 0.6f * expf(-0.3f);
            float s1 = p.in[I_LQ1][lane2] * p.in[I_LK1][lane2], s2 = p.in[I_LQ2][lane2] * p.in[I_LK2][lane2];
            s1 = wave_sum(s1); s2 = wave_sum(s2);
            const float lam = expf(s1) - expf(s2) + lam_init, osc = 1.0f - lam_init;
            const size_t row0 = (size_t)b * SEQ + qb * 256 + wid * 32; const int lr = lane2 >> 3, c16 = 16 * (lane2 & 7);
            f32x4 gsub[4];
#pragma unroll
            for (int q = 0; q < 4; ++q) gsub[q] = *(const f32x4*)(p.in[I_SUBLN] + c16 + 4 * q);
            u32x4 xx[4][4];
#pragma unroll
            for (int k = 0; k < 4; ++k) { const size_t r = row0 + 8 * k + lr; const u32x4* a1 = (const u32x4*)(O1 + r * DM + h * 128 + c16); const u32x4* a2 = (const u32x4*)(O2 + r * DM + h * 128 + c16);
                xx[k][0] = a1[0]; xx[k][1] = a1[1]; xx[k][2] = a2[0]; xx[k][3] = a2[1]; }
#pragma unroll
            for (int k = 0; k < 4; ++k) { const size_t r = row0 + 8 * k + lr;
                const u32x4 x0 = xx[k][0], x1 = xx[k][1], y0 = xx[k][2], y1 = xx[k][3];
                float o[16];
                o[0] = bflo(x0.x) - lam * bflo(y0.x); o[1] = bfhi(x0.x) - lam * bfhi(y0.x); o[2] = bflo(x0.y) - lam * bflo(y0.y); o[3] = bfhi(x0.y) - lam * bfhi(y0.y);
                o[4] = bflo(x0.z) - lam * bflo(y0.z); o[5] = bfhi(x0.z) - lam * bfhi(y0.z); o[6] = bflo(x0.w) - lam * bflo(y0.w); o[7] = bfhi(x0.w) - lam * bfhi(y0.w);
                o[8] = bflo(x1.x) - lam * bflo(y1.x); o[9] = bfhi(x1.x) - lam * bfhi(y1.x); o[10] = bflo(x1.y) - lam * bflo(y1.y); o[11] = bfhi(x1.y) - lam * bfhi(y1.y);
                o[12] = bflo(x1.z) - lam * bflo(y1.z); o[13] = bfhi(x1.z) - lam * bfhi(y1.z); o[14] = bflo(x1.w) - lam * bflo(y1.w); o[15] = bfhi(x1.w) - lam * bfhi(y1.w);
                float ss = 0.f;
#pragma unroll
                for (int q = 0; q < 16; ++q) ss += o[q] * o[q];
                ss += __shfl_xor(ss, 1); ss += __shfl_xor(ss, 2); ss += __shfl_xor(ss, 4);
                const float rstd = osc / sqrtf(ss * (1.0f / 128.0f) + EPS);
                u32x4 w0, w1;
                w0.x = pk2(o[0] * rstd * gsub[0][0], o[1] * rstd * gsub[0][1]); w0.y = pk2(o[2] * rstd * gsub[0][2], o[3] * rstd * gsub[0][3]);
                w0.z = pk2(o[4] * rstd * gsub[1][0], o[5] * rstd * gsub[1][1]); w0.w = pk2(o[6] * rstd * gsub[1][2], o[7] * rstd * gsub[1][3]);
                w1.x = pk2(o[8] * rstd * gsub[2][0], o[9] * rstd * gsub[2][1]); w1.y = pk2(o[10] * rstd * gsub[2][2], o[11] * rstd * gsub[2][3]);
                w1.z = pk2(o[12] * rstd * gsub[3][0], o[13] * rstd * gsub[3][1]); w1.w = pk2(o[14] * rstd * gsub[3][2], o[15] * rstd * gsub[3][3]);
                u32x4* d = (u32x4*)(A + r * DM + h * 128 + c16); d[0] = w0; d[1] = w1; }
        }
    }
}

#define XB_TMO      128
#define XB_XCNT(j)  (256  + 64 * (j))
#define XB_XSUB(j)  (1280 + 64 * (j))
#define XB_XGEN(j)  (2304 + 64 * (j))
#define XB_TOP      3328
#define XB_TOPGEN   3392
#define XB_CARRY    3456
#define XCD_BAR_WORDS 3456
#define XB_SPIN_CAP (1u << 18)
__device__ __forceinline__ unsigned xb_ld(unsigned* p)              { return __hip_atomic_load(p, __ATOMIC_RELAXED, __HIP_MEMORY_SCOPE_AGENT); }
__device__ __forceinline__ unsigned xb_add(unsigned* p, unsigned v) { return __hip_atomic_fetch_add(p, v, __ATOMIC_RELAXED, __HIP_MEMORY_SCOPE_AGENT); }
__device__ __forceinline__ unsigned xb_xcc_id() { return (unsigned)__builtin_amdgcn_s_getreg((3 << 11) | 20) & 0xFu; }
#define XB_SPIN(cond, bar) do { unsigned _sp = 0; while (cond) { __builtin_amdgcn_s_sleep(1); \
    if ((++_sp & 255u) == 0u) { if (xb_ld(&(bar)[XB_TMO])) break; if (_sp > XB_SPIN_CAP) { atomicAdd(&(bar)[XB_TMO], 1u); break; } } } } while (0)
struct XcdBarrier { unsigned* bar; unsigned x; volatile LAS unsigned* st; };
__device__ __forceinline__ void xcd_barrier_complete(unsigned* bar, unsigned x, unsigned& nloc, unsigned& nx) {
    const unsigned G = gridDim.x * gridDim.y * gridDim.z;
    unsigned sum, cnt, mine, sp = 0u;
    for (;;) {
        sum = 0u; cnt = 0u; mine = 0u;
#pragma unroll
        for (unsigned j = 0; j < 16; ++j) { const unsigned c = xb_ld(&bar[XB_XCNT(j)]); sum += c; cnt += (c > 0u) ? 1u : 0u; mine = (j == x) ? c : mine; }
        if (sum == G) break;
        __builtin_amdgcn_s_sleep(1);
        if ((++sp & 255u) == 0u) { if (xb_ld(&bar[XB_TMO])) break; if (sp > XB_SPIN_CAP) { atomicAdd(&bar[XB_TMO], 1u); break; } }
    }
    nloc = mine > 0u ? mine : 1u; nx = cnt > 0u ? cnt : 1u;
}
__device__ __forceinline__ void xcd_barrier(const XcdBarrier& b) {
    asm volatile("s_waitcnt vmcnt(0)" ::: "memory");
    __syncthreads();
    if (threadIdx.x == 0) {
        unsigned* bar = b.bar;
        __builtin_amdgcn_s_waitcnt(0);
        unsigned nloc = b.st[0], nx = b.st[1];
        if (nloc == 0u) { xcd_barrier_complete(bar, b.x, nloc, nx); b.st[0] = nloc; b.st[1] = nx; }
        const unsigned old = xb_add(&bar[XB_XSUB(b.x)], 1u);
        const unsigned gen = old / nloc;
        if (old + 1u == (gen + 1u) * nloc) {
            __builtin_amdgcn_fence(__ATOMIC_RELEASE, "agent");
            asm volatile("s_waitcnt vmcnt(0)" ::: "memory");
            const unsigned og = xb_add(&bar[XB_TOP], 1u);
            const unsigned tg = og / nx;
            if (og + 1u == (tg + 1u) * nx) xb_add(&bar[XB_TOPGEN], 1u);
            else XB_SPIN(xb_ld(&bar[XB_TOPGEN]) == tg, bar);
            __builtin_amdgcn_fence(__ATOMIC_ACQUIRE, "agent");
            xb_add(&bar[XB_XGEN(b.x)], 1u);
            asm volatile("s_waitcnt vmcnt(0)" ::: "memory");
        } else {
            XB_SPIN(xb_ld(&bar[XB_XGEN(b.x)]) == gen, bar);
            __builtin_amdgcn_fence(__ATOMIC_ACQUIRE, "agent");
            asm volatile("s_waitcnt vmcnt(0)" ::: "memory");
        }
    }
    __syncthreads();
}


__device__ __forceinline__ void flag_signal(unsigned* flag) {
    asm volatile("s_waitcnt vmcnt(0)" ::: "memory"); __syncthreads();
    if (threadIdx.x == 0) (void)xb_add(flag, 1u);
}
__device__ __forceinline__ void flag_wait(unsigned* flag, unsigned target, unsigned* bar) {
    if (threadIdx.x == 0) { XB_SPIN(xb_ld(flag) < target, bar); __builtin_amdgcn_fence(__ATOMIC_ACQUIRE, "agent"); asm volatile("s_waitcnt vmcnt(0)" ::: "memory"); }
    __syncthreads();
}

#ifdef FP8_PROBE
typedef int v8i_t __attribute__((ext_vector_type(8)));
typedef float f32x16_t __attribute__((ext_vector_type(16)));
__device__ __forceinline__ int pr_aval(int i, int k) { return ((i * 7 + k * 3) % 5) - 2; }
__device__ __forceinline__ int pr_bval(int k, int j) { return ((k * 5 + j * 11) % 7) - 3; }
__device__ __forceinline__ unsigned pr_enc(int v) { const int a = v < 0 ? -v : v; const unsigned m = a == 0 ? 0x00u : (a == 1 ? 0x38u : (a == 2 ? 0x40u : 0x44u)); return m | (v < 0 ? 0x80u : 0u); }
template <int HYP> __device__ __forceinline__ int pr_kmap(int h, int j) { return HYP == 1 ? 32 * h + j : (HYP == 2 ? 16 * h + (j & 15) + 32 * (j >> 4) : 8 * h + (j & 7) + 16 * (j >> 3)); }
template <int HYP> __device__ __forceinline__ bool pr_test(int lane) {
    const int rc = lane & 31, h = lane >> 5; v8i_t a, b;
#pragma unroll
    for (int d = 0; d < 8; ++d) { unsigned wa = 0u, wb = 0u;
#pragma unroll
        for (int q = 0; q < 4; ++q) { const int k = pr_kmap<HYP>(h, 4 * d + q); wa |= pr_enc(pr_aval(rc, k)) << (8 * q); wb |= pr_enc(pr_bval(k, rc)) << (8 * q); }
        a[d] = (int)wa; b[d] = (int)wb; }
    f32x16_t c = {};
    c = __builtin_amdgcn_mfma_scale_f32_32x32x64_f8f6f4(a, b, c, 0, 0, 0, 0x7f7f7f7f, 0, 0x7f7f7f7f);
    bool ok = true;
#pragma unroll
    for (int r = 0; r < 16; ++r) { const int i = (r & 3) + 8 * (r >> 2) + 4 * h; int e = 0;
        for (int k = 0; k < 64; ++k) e += pr_aval(i, k) * pr_bval(k, rc);
        ok = ok && (c[r] == (float)e); }
    return __all(ok) != 0;
}
#endif
__global__ void __launch_bounds__(NWAVES * 64, 2) mk_fwd(Params p_unused) {
    extern __shared__ __attribute__((aligned(16))) unsigned char lds[];
#define MAKE_CTX Ctx F; { int t_ = threadIdx.x; asm volatile("" : "+v"(t_)); F.lds = (LAS unsigned char*)lds; F.tid = t_; F.lane = t_ & 63; F.wave = __builtin_amdgcn_readfirstlane(t_ >> 6); \
    F.G = gridDim.x; const int bx = blockIdx.x; F.vcu = (F.G % 8 == 0) ? (bx % 8) * (F.G / 8) + bx / 8 : bx; }
    int lo, hi; unsigned* barw; { const Params q0 = kparams(); lo = q0.ph_lo; hi = q0.ph_hi; barw = (unsigned*)(q0.ws + WS_CTL) + 4096; }
    volatile LAS unsigned* bst = (volatile LAS unsigned*)((LAS unsigned char*)lds + RING_BYTES + 12288 + 1024);
    if (threadIdx.x < 2) bst[threadIdx.x] = 0u;
    __syncthreads();
    if (threadIdx.x == 0) (void)xb_add(&barw[XB_XCNT(xb_xcc_id())], 1u);
#ifndef PH_MASK
#define PH_MASK 0xFFFFFu
#endif
#define IN(k) (((PH_MASK >> (k)) & 1u) && lo <= (k) && (k) < hi)
#define SEAM(k) do { if (IN(k) && IN((k) + 1)) { XcdBarrier xb_; xb_.bar = barw; xb_.x = xb_xcc_id(); xb_.st = bst; xcd_barrier(xb_); } } while (0)
#ifndef TS_MASK
#define TS_MASK 0u
#endif
#ifndef TS_SCALE
#define TS_SCALE 10.0f
#endif
    unsigned long long ts_prev = 0ull, ts_acc = 0ull;
    if (TS_MASK) ts_prev = __builtin_amdgcn_s_memrealtime();
#define TS_MARK(k) do { if (TS_MASK) { const unsigned long long t_ = __builtin_amdgcn_s_memrealtime(); if ((TS_MASK >> (k)) & 1u) ts_acc += t_ - ts_prev; ts_prev = t_; } } while (0)
#define PHASE_VARS MAKE_CTX const Params p = kparams(); unsigned char* ws = p.ws; const float* mod = (const float*)(ws + WS_MOD); bf16_t* Hb = (bf16_t*)(ws + WS_H); (void)mod; (void)Hb;

    if (IN(0)) { PHASE_VARS p0_prologue(F, p); } SEAM(0); TS_MARK(0);
    if (IN(1)) { PHASE_VARS p_norm1_in(F, p); } SEAM(1); TS_MARK(1);
    if (IN(2)) { PHASE_VARS
        pg8::Gemm g{Hb + (size_t)CTXL * DM, (const bf16_t*)(ws + WS_WIN), DM, (size_t)LR * DM * 2, 0}; pg8::GOrder S; S.init(32, 8, NB, F.G, (int)blockIdx.x);
        pg8::EpiWin E{(bf16_t*)(ws + WS_ACT + ACT_Z)}; pg8::gemm_phase(F.lds, g, S, E); p_ctx_dense(F, p, 0); } SEAM(2); TS_MARK(2);
    if (IN(3)) { PHASE_VARS p_lru(F, p, false); } SEAM(3); TS_MARK(3);
    if (IN(4)) { PHASE_VARS p_lru_carry(F, p); if ((int)blockIdx.x >= F.G - 4) flag_signal(&barw[XB_CARRY]); p_cm(F, p); }
    if (IN(4)) flag_wait(&barw[XB_CARRY], 4u, barw);
    if (IN(4)) { PHASE_VARS p_lru(F, p, true); } SEAM(4); TS_MARK(4);
    if (IN(5)) { PHASE_VARS
        pg8::Gemm g{(const bf16_t*)(ws + WS_ACT + ACT_YCAT) + (size_t)CTXL * DM, (const bf16_t*)(ws + WS_WOUT0), DM, (size_t)LR * DM * 2, 0}; pg8::GOrder S; S.init(32, 4, NB, F.G, (int)blockIdx.x);
        pg8::EpiRes E{(bf16_t*)(ws + WS_X), p.in[I_X], mod + 2 * DM, 0}; pg8::gemm_phase(F.lds, g, S, E); p_ctx_dense(F, p, 1);
        if (IN(6)) { __syncthreads(); p_norm2_router(F, p, 0, true, true, false); }
        if (defer_o(F.G) && F.vcu >= 128) { const int no = defer_o(F.G), base = N_MOE_ITEMS - defer_all(F.G) - defer_s(F.G) - no; LAS float* scr = (LAS float*)(F.lds + 75776 + F.wave * 8448);
            for (int i = (F.vcu - 128) * NWAVES + F.wave; i < no; i += (F.G - 128) * NWAVES) p0_moe_item(p, base + i, scr, F.lane); } } SEAM(5); TS_MARK(5);
    if (IN(6)) { PHASE_VARS p_norm2_router(F, p, 0, true, !IN(5), true); } SEAM(6); TS_MARK(6);
    if (IN(7)) { PHASE_VARS p_select(F, p, true); p_deferred_weights(F, p, 64, N_MOE_ITEMS - defer_a(F.G) - defer_b(F.G), defer_a(F.G)); } SEAM(7); TS_MARK(7);
    if (IN(8)) { PHASE_VARS
        pg8::Gemm8 g{ws + WS_H, ws + WS_W13, DM, 0, (size_t)4096 * DM, (const int*)(ws + WS_ROWIDX)}; pg8::GOrder S; S.init(8, 16, NE, F.G, (int)blockIdx.x);
        pg8::EpiSwiGLU8 E{ws + WS_ACT + ACT_HID}; pg8::gemm8_phase<true, true>(F.lds, g, S, E); p_ctx_moe(F, p, 0); } SEAM(8); TS_MARK(8);
    if (IN(9)) { PHASE_VARS
        pg8::Gemm8 g{ws + WS_ACT + ACT_HID, ws + WS_W2, FF, (size_t)EROWS * FF, (size_t)DM * FF, nullptr}; pg8::GOrder S; S.init(8, 4, NE, F.G, (int)blockIdx.x);
        pg8::EpiMoeOut8 E{ws + WS_XS, (const float*)(ws + WS_GATE)}; pg8::gemm8_phase<false, false>(F.lds, g, S, E); p_ctx_moe(F, p, 1);
        if (IN(10)) { __syncthreads(); p_combine(F, p, 0, false, true, false); } } SEAM(9); TS_MARK(9);
    if (IN(10)) { PHASE_VARS p_combine(F, p, 0, false, !IN(9), true); } SEAM(10); TS_MARK(10);
    if (IN(11)) { PHASE_VARS
        pg8::Gemm g{Hb + (size_t)CTXL * DM, (const bf16_t*)(ws + WS_WQKV), DM, (size_t)LR * DM * 2, 0}; pg8::GOrder S; S.init(32, 12, NB, F.G, (int)blockIdx.x);
        pg8::EpiQKV E{(bf16_t*)(ws + WS_ACT + ACT_Q), (const float*)(ws + WS_ROPE)}; pg8::gemm_phase(F.lds, g, S, E); p_ctx_dense(F, p, 2); } SEAM(11); TS_MARK(11);
    if (IN(12)) { PHASE_VARS p_attn(F, p, lds); } SEAM(12); TS_MARK(12);
    TS_MARK(13);
    if (IN(14)) { PHASE_VARS
        pg8::Gemm g{(const bf16_t*)(ws + WS_XS), (const bf16_t*)(ws + WS_WOUT1), DM, (size_t)SEQ * DM * 2, 0}; pg8::GOrder S; S.init(32, 4, NB, F.G, (int)blockIdx.x);
        pg8::EpiRes E{(bf16_t*)(ws + WS_X), nullptr, mod + 3 * 6144 + 2 * DM, 1}; pg8::gemm_phase(F.lds, g, S, E);
        if (IN(15)) { __syncthreads(); p_norm2_router(F, p, 1, false, true, false); } } SEAM(14); TS_MARK(14);
    if (IN(15)) { PHASE_VARS p_norm2_router(F, p, 1, false, !IN(14), true); } SEAM(15); TS_MARK(15);
    if (IN(16)) { PHASE_VARS p_select(F, p, false); p_deferred_weights(F, p, 32, N_MOE_ITEMS - defer_b(F.G), defer_b(F.G)); } SEAM(16); TS_MARK(16);
    if (IN(17)) { PHASE_VARS
        pg8::Gemm8 g{ws + WS_H, ws + WS_W13 + (size_t)NE * 4096 * DM, DM, 0, (size_t)4096 * DM, (const int*)(ws + WS_ROWIDX)}; pg8::GOrder S; S.init(8, 16, NE, F.G, (int)blockIdx.x);
        pg8::EpiSwiGLU8 E{ws + WS_ACT + ACT_HID}; pg8::gemm8_phase<true, true>(F.lds, g, S, E); } SEAM(17); TS_MARK(17);
    if (IN(18)) { PHASE_VARS
        pg8::Gemm8 g{ws + WS_ACT + ACT_HID, ws + WS_W2 + (size_t)NE * DM * FF, FF, (size_t)EROWS * FF, (size_t)DM * FF, nullptr}; pg8::GOrder S; S.init(8, 4, NE, F.G, (int)blockIdx.x);
        pg8::EpiMoeOut8 E{ws + WS_XS, (const float*)(ws + WS_GATE)}; pg8::gemm8_phase<false, false>(F.lds, g, S, E);
        if (IN(19)) { __syncthreads(); p_combine(F, p, 1, true, true, false); } } SEAM(18); TS_MARK(18);
    if (IN(19)) { PHASE_VARS p_combine(F, p, 1, true, !IN(18), true); }
#ifdef FP8_PROBE
    { XcdBarrier xb_; xb_.bar = barw; xb_.x = xb_xcc_id(); xb_.st = bst; xcd_barrier(xb_);
      if (blockIdx.x == 0 && threadIdx.x < 64) { const int l_ = threadIdx.x; int code = 0; if (pr_test<1>(l_)) code = 1; else if (pr_test<2>(l_)) code = 2; else if (pr_test<3>(l_)) code = 3;
          if (l_ == 0) { const Params p = kparams(); p.out[0] += 20.0f * (float)code; } } }
#endif
    if (TS_MASK) { TS_MARK(19); XcdBarrier xb_; xb_.bar = barw; xb_.x = xb_xcc_id(); xb_.st = bst; xcd_barrier(xb_);
        if (blockIdx.x == 0 && threadIdx.x == 0) { const Params p = kparams(); p.out[0] += (float)ts_acc * 0.01f / TS_SCALE; } }
#undef IN
#undef SEAM
}

extern "C" void kernel_launch(void* const* d_in, const int* in_sizes, int n_in, void* d_out, int out_size, void* d_ws, size_t ws_size, hipStream_t stream) {
    static int grid = 0;
    if (grid == 0) {
        if (n_in != 32 || out_size != NLAT * DM || ws_size < WS_END) { fprintf(stderr, "kernel_launch: unexpected problem (n_in %d, out %d, ws %zu)\n", n_in, out_size, ws_size); grid = -1; return; }
        int dev = 0, cus = 0, per_cu = 0;
        if (hipGetDevice(&dev) != hipSuccess || hipDeviceGetAttribute(&cus, hipDeviceAttributeMultiprocessorCount, dev) != hipSuccess) { grid = -1; return; }
        if (hipFuncSetAttribute((const void*)mk_fwd, hipFuncAttributeMaxDynamicSharedMemorySize, LDS_BYTES) != hipSuccess) { fprintf(stderr, "kernel_launch: hipFuncSetAttribute failed\n"); grid = -1; return; }
        if (hipOccupancyMaxActiveBlocksPerMultiprocessor(&per_cu, (const void*)mk_fwd, NWAVES * 64, LDS_BYTES) != hipSuccess || per_cu < 1) { fprintf(stderr, "kernel_launch: occupancy query says %d\n", per_cu); per_cu = 1; }
        (void)hipGetLastError();
        grid = cus & ~7;
    }
    if (grid < 0) return;
    if (hipMemsetAsync((char*)d_ws + WS_CTL, 0, 65536, stream) != hipSuccess) { fprintf(stderr, "kernel_launch: memset failed\n"); return; }
    Params a{};
    for (int i = 0; i < 32; ++i) a.in[i] = (const float*)d_in[i];
    a.out = (float*)d_out; a.ws = (unsigned char*)d_ws;
#if MK_N_LAUNCHES == 1
    a.ph_lo = 0; a.ph_hi = NPH;
    void* args[] = {&a};
    hipError_t e = hipLaunchCooperativeKernel((const void*)mk_fwd, dim3(grid), dim3(NWAVES * 64), args, LDS_BYTES, stream);
    if (e != hipSuccess) fprintf(stderr, "kernel_launch: cooperative launch failed: %s (grid %d)\n", hipGetErrorString(e), grid);
#else
    for (int ph = 0; ph < NPH; ++ph) { a.ph_lo = ph; a.ph_hi = ph + 1; hipLaunchKernelGGL(mk_fwd, dim3(grid), dim3(NWAVES * 64), LDS_BYTES, stream, a); }
#endif
}
```
